# Optimizing an MI355X kernel written in HIP

```python
import jax, jax.numpy as jnp
from jax import lax
import numpy as np

D_MODEL = 2048
BATCH = 1
SEQ = 8192
DEPTH = 2

HEAD_DIM = 128
N_HEADS_TOTAL = D_MODEL // HEAD_DIM
N_MEM_HEADS = N_HEADS_TOTAL // 4
N_MIX_HEADS = N_HEADS_TOTAL - N_MEM_HEADS
N_KV_GROUPS = 3
HEADS_PER_GROUP = N_MIX_HEADS // N_KV_GROUPS
N_MEM_TOKENS = 256
CMP_STRIDE = 16
CMP_BLOCK = 2 * CMP_STRIDE
SLC_BLOCK = 64
SLC_TOPK = 16
WINDOW = 512
Q_BLOCK = 128
D_FF = 7 * D_MODEL // 2
N_EXPERTS = 8
TOP_K = 2
N_A_LAYERS = (DEPTH + 1) // 2
N_B_LAYERS = DEPTH - N_A_LAYERS
N_DENSE = (DEPTH + 1) // 2
N_MOE = DEPTH // 2
Q_W = N_MIX_HEADS * HEAD_DIM
KV_W = N_KV_GROUPS * HEAD_DIM
GATE_W = 3 * N_MIX_HEADS
MEM_Q_W = N_MEM_HEADS * HEAD_DIM
A_IN_W = Q_W + 6 * KV_W + GATE_W + MEM_Q_W
B_IN_W = Q_W + MEM_Q_W
NEG = -1e30
BIG = 1e6
EPS = 1e-6

kernel_name = 'hybrid_nsa_stickbreaking_yoco'


def _rmsnorm(x, g):
    xf = x.astype(jnp.float32)
    y = xf * lax.rsqrt(jnp.mean(xf * xf, axis=-1, keepdims=True) + EPS)
    return (y * g.astype(jnp.float32)).astype(x.dtype)


def _heads(x, n):
    b, t, _ = x.shape
    return x.reshape(b, t, n, HEAD_DIM).transpose(0, 2, 1, 3)


def _merge(x):
    b, h, t, d = x.shape
    return x.transpose(0, 2, 1, 3).reshape(b, t, h * d)


def _alibi_slopes(n):
    return jnp.asarray(np.array([2.0 ** (-8.0 * (i + 1) / n) for i in range(n)], dtype=np.float32))


def _masked_softmax(s, mask):
    p = jax.nn.softmax(jnp.where(mask, s, NEG), axis=-1)
    return p * mask.astype(p.dtype)


def _swiglu(h, w_gu, w_down):
    g, u = jnp.split(h @ w_gu, 2, axis=-1)
    return (jax.nn.silu(g) * u) @ w_down


def _compress(kv, w, pos):
    b, g, t, d = kv.shape
    ch = kv.reshape(b, g, t // CMP_STRIDE, CMP_STRIDE, d)
    blocks = jnp.concatenate([ch[:, :, :-1], ch[:, :, 1:]], axis=3) + pos
    return blocks.reshape(b, g, t // CMP_STRIDE - 1, CMP_BLOCK * d) @ w


def _nsa(q, kc, vc, ks, vs, kw, vw, gates, q_gain, k_gain, cmp_w, cmp_pos):
    b, h, t, d = q.shape
    g, hp = N_KV_GROUPS, HEADS_PER_GROUP
    scale = d ** -0.5
    slopes = _alibi_slopes(h).reshape(g, hp)
    q = _rmsnorm(q, q_gain).reshape(b, g, hp, t, d)
    pos = jnp.arange(t)

    k_cmp = _rmsnorm(_compress(kc, cmp_w[0], cmp_pos[0]), k_gain[0])
    v_cmp = _compress(vc, cmp_w[1], cmp_pos[1])
    nc = k_cmp.shape[2]
    c_end = jnp.arange(nc) * CMP_STRIDE + (CMP_BLOCK - 1)
    dist = (pos[:, None] - c_end[None, :]).astype(jnp.float32)
    s = jnp.einsum('bgptd,bgnd->bgptn', q, k_cmp).astype(jnp.float32) * scale - slopes[:, :, None, None] * dist
    p_cmp = _masked_softmax(s, dist >= 0)
    o_cmp = jnp.einsum('bgptn,bgnd->bgptd', p_cmp.astype(v_cmp.dtype), v_cmp)

    nb = t // SLC_BLOCK
    ratio = SLC_BLOCK // CMP_STRIDE
    imp_c = jnp.pad(p_cmp.sum(axis=2), ((0, 0), (0, 0), (0, 0), (1, 1)))
    imp = imp_c[..., :ratio * nb].reshape(b, g, t, nb, ratio).sum(-1) + imp_c[..., ratio::ratio]
    blk = jnp.arange(nb)[None, :]
    cur = (pos // SLC_BLOCK)[:, None]
    score = jnp.where(blk == cur, 2 * BIG,
                      jnp.where(blk == 0, BIG,
                                jnp.where(blk * SLC_BLOCK <= pos[:, None], imp, -BIG)))
    n_sel = min(SLC_TOPK, nb)
    _, idx = lax.top_k(score, n_sel)

    k_sb = _rmsnorm(ks, k_gain[1]).reshape(b, g, nb, SLC_BLOCK, d)
    v_sb = vs.reshape(b, g, nb, SLC_BLOCK, d)
    nq = t // Q_BLOCK
    gather = jax.vmap(jax.vmap(lambda kb, ib: kb[ib]))

    def slc_step(args):
        qi, ii, ti = args
        kg = gather(k_sb, ii)
        vg = gather(v_sb, ii)
        kpos = ii[..., None] * SLC_BLOCK + jnp.arange(SLC_BLOCK)
        dd = (ti[:, None, None] - kpos).astype(jnp.float32)
        ss = jnp.einsum('bgpqd,bgqkld->bgpqkl', qi, kg).astype(jnp.float32) * scale \
            - slopes[:, :, None, None, None] * dd[:, :, None]
        pp = _masked_softmax(ss.reshape(b, g, hp, Q_BLOCK, -1), (dd >= 0).reshape(b, g, 1, Q_BLOCK, -1))
        pp = pp.reshape(b, g, hp, Q_BLOCK, n_sel, SLC_BLOCK)
        return jnp.einsum('bgpqkl,bgqkld->bgpqd', pp.astype(vg.dtype), vg)

    q_blocks = q.reshape(b, g, hp, nq, Q_BLOCK, d).transpose(3, 0, 1, 2, 4, 5)
    i_blocks = idx.reshape(b, g, nq, Q_BLOCK, n_sel).transpose(2, 0, 1, 3, 4)
    t_blocks = pos.reshape(nq, Q_BLOCK)
    o_slc = lax.map(slc_step, (q_blocks, i_blocks, t_blocks)).transpose(1, 2, 3, 0, 4, 5).reshape(b, g, hp, t, d)

    nw = WINDOW // Q_BLOCK

    def band(z):
        zp = jnp.pad(z, ((0, 0), (0, 0), (WINDOW, 0), (0, 0))).reshape(b, g, nq + nw, Q_BLOCK, d)
        return jnp.concatenate([zp[:, :, j:j + nq] for j in range(nw + 1)], axis=3)

    kband = band(_rmsnorm(kw, k_gain[2]))
    vband = band(vw)
    tq = pos.reshape(nq, Q_BLOCK, 1)
    tk = ((jnp.arange(nq) - nw) * Q_BLOCK)[:, None, None] + jnp.arange((nw + 1) * Q_BLOCK)[None, None, :]
    dw = tq - tk
    wmask = (dw >= 0) & (dw < WINDOW) & (tk >= 0)
    qw = q.reshape(b, g, hp, nq, Q_BLOCK, d)
    sw = jnp.einsum('bgpnqd,bgnkd->bgpnqk', qw, kband).astype(jnp.float32) * scale \
        - slopes[:, :, None, None, None] * dw.astype(jnp.float32)
    pw = _masked_softmax(sw, wmask)
    o_win = jnp.einsum('bgpnqk,bgnkd->bgpnqd', pw.astype(vband.dtype), vband).reshape(b, g, hp, t, d)

    gt = jax.nn.sigmoid(gates.astype(jnp.float32)).reshape(b, t, h, 3).transpose(0, 2, 1, 3)
    o = (o_cmp.reshape(b, h, t, d) * gt[..., 0:1]
         + o_slc.reshape(b, h, t, d) * gt[..., 1:2]
         + o_win.reshape(b, h, t, d) * gt[..., 2:3])
    return o.astype(q.dtype)


def _stick_breaking(q, k, v):
    b, h, t, d = q.shape
    scale = d ** -0.5
    nq = t // Q_BLOCK
    kpos = jnp.arange(t)

    def step(args):
        qi, ti = args
        z = jnp.einsum('bhqd,bhsd->bhqs', qi, k).astype(jnp.float32) * scale
        causal = kpos[None, :] < ti[:, None]
        log_keep = jnp.where(causal, jax.nn.log_sigmoid(-z), 0.0)
        after = lax.cumsum(log_keep, axis=3, reverse=True) - log_keep
        a = jnp.where(causal, jnp.exp(jax.nn.log_sigmoid(z) + after), 0.0)
        return jnp.einsum('bhqs,bhsd->bhqd', a.astype(v.dtype), v)

    qb = q.reshape(b, h, nq, Q_BLOCK, d).transpose(2, 0, 1, 3, 4)
    tb = jnp.arange(t).reshape(nq, Q_BLOCK)
    return lax.map(step, (qb, tb)).transpose(1, 2, 0, 3, 4).reshape(b, h, t, d)


def _mem_attn(qm, mem_n, w_kv, qk_gain):
    k, v = jnp.split(mem_n @ w_kv, 2, axis=-1)
    q = _rmsnorm(qm, qk_gain[0])
    k = _rmsnorm(_heads(k, N_MEM_HEADS), qk_gain[1])
    v = _heads(v, N_MEM_HEADS)
    s = jnp.einsum('bhtd,bhmd->bhtm', q, k).astype(jnp.float32) * HEAD_DIM ** -0.5
    p = jax.nn.softmax(s, axis=-1)
    return jnp.einsum('bhtm,bhmd->bhtd', p.astype(v.dtype), v)


def _moe(h, router_w, router_b, w_gu, w_down):
    logits = (h @ router_w).astype(jnp.float32)
    _, top_i = lax.top_k(logits + router_b.astype(jnp.float32), TOP_K)
    w = jax.nn.softmax(jnp.take_along_axis(logits, top_i, axis=-1), axis=-1)
    combine = jnp.sum(jax.nn.one_hot(top_i, N_EXPERTS, dtype=jnp.float32) * w[..., None], axis=-2)
    out = jnp.zeros_like(h)
    for e in range(N_EXPERTS):
        out = out + (combine[..., e:e + 1] * _swiglu(h, w_gu[e], w_down[e])).astype(h.dtype)
    return out


def setup_inputs(seed: int = 0) -> dict:
    key = jax.random.key(seed)
    ks = jax.random.split(key, 24)

    def nrm(k, shape, fan_in):
        return jax.random.normal(k, shape, jnp.float32) * (fan_in ** -0.5)

    def gain(k, shape):
        return 1.0 + 0.02 * jax.random.normal(k, shape, jnp.float32)

    return {
        'x': jax.random.normal(ks[0], (BATCH, SEQ, D_MODEL), jnp.float32),
        'mem': jax.random.normal(ks[1], (BATCH, N_MEM_TOKENS, D_MODEL), jnp.float32),
        'attn_norm': gain(ks[2], (DEPTH, D_MODEL)),
        'mem_norm': gain(ks[3], (DEPTH, D_MODEL)),
        'ffn_norm': gain(ks[4], (DEPTH, D_MODEL)),
        'w_in_a': nrm(ks[5], (N_A_LAYERS, D_MODEL, A_IN_W), D_MODEL),
        'cmp_w': nrm(ks[6], (N_A_LAYERS, 2, CMP_BLOCK * HEAD_DIM, HEAD_DIM), CMP_BLOCK * HEAD_DIM),
        'cmp_pos': 0.1 * jax.random.normal(ks[7], (N_A_LAYERS, 2, CMP_BLOCK, HEAD_DIM), jnp.float32),
        'nsa_q_norm': gain(ks[8], (N_A_LAYERS, HEAD_DIM)),
        'nsa_k_norm': gain(ks[9], (N_A_LAYERS, 3, HEAD_DIM)),
        'w_in_b': nrm(ks[10], (N_B_LAYERS, D_MODEL, B_IN_W), D_MODEL),
        'kv_norm_b': gain(ks[11], (D_MODEL,)),
        'w_kv_b': nrm(ks[12], (D_MODEL, 2 * Q_W), D_MODEL),
        'w_mem_kv': nrm(ks[13], (DEPTH, D_MODEL, 2 * MEM_Q_W), D_MODEL),
        'mem_qk_norm': gain(ks[14], (DEPTH, 2, HEAD_DIM)),
        'w_out': nrm(ks[15], (DEPTH, N_HEADS_TOTAL * HEAD_DIM, D_MODEL), N_HEADS_TOTAL * HEAD_DIM),
        'ffn_w_gu': nrm(ks[16], (N_DENSE, D_MODEL, 2 * D_FF), D_MODEL),
        'ffn_w_down': nrm(ks[17], (N_DENSE, D_FF, D_MODEL), D_FF),
        'router_w': nrm(ks[18], (N_MOE, D_MODEL, N_EXPERTS), D_MODEL),
        'router_b': 0.01 * jax.random.normal(ks[19], (N_MOE, N_EXPERTS), jnp.float32),
        'moe_w_gu': nrm(ks[20], (N_MOE, N_EXPERTS, D_MODEL, 2 * D_FF), D_MODEL),
        'moe_w_down': nrm(ks[21], (N_MOE, N_EXPERTS, D_FF, D_MODEL), D_FF),
    }


def reference(x, mem, attn_norm, mem_norm, ffn_norm, w_in_a, cmp_w, cmp_pos, nsa_q_norm, nsa_k_norm,
              w_in_b, kv_norm_b, w_kv_b, w_mem_kv, mem_qk_norm, w_out, ffn_w_gu, ffn_w_down,
              router_w, router_b, moe_w_gu, moe_w_down):
    for l in range(DEPTH):
        h = _rmsnorm(x, attn_norm[l])
        mem_n = _rmsnorm(mem, mem_norm[l])
        if l < N_A_LAYERS:
            q, kv, gts, qm = jnp.split(h @ w_in_a[l], [Q_W, Q_W + 6 * KV_W, Q_W + 6 * KV_W + GATE_W], axis=-1)
            kc, vc, ksl, vsl, kw, vw = [_heads(z, N_KV_GROUPS) for z in jnp.split(kv, 6, axis=-1)]
            mix = _nsa(_heads(q, N_MIX_HEADS), kc, vc, ksl, vsl, kw, vw, gts,
                       nsa_q_norm[l], nsa_k_norm[l], cmp_w[l], cmp_pos[l])
        else:
            if l == N_A_LAYERS:
                k_s, v_s = jnp.split(_rmsnorm(x, kv_norm_b) @ w_kv_b, 2, axis=-1)
                k_shared = _heads(k_s, N_MIX_HEADS)
                v_shared = _heads(v_s, N_MIX_HEADS)
            q, qm = jnp.split(h @ w_in_b[l - N_A_LAYERS], [Q_W], axis=-1)
            mix = _stick_breaking(_heads(q, N_MIX_HEADS), k_shared, v_shared)
        mo = _mem_attn(_heads(qm, N_MEM_HEADS), mem_n, w_mem_kv[l], mem_qk_norm[l])
        x = x + _merge(jnp.concatenate([mix, mo], axis=1)) @ w_out[l]
        h2 = _rmsnorm(x, ffn_norm[l])
        if l % 2 == 0:
            x = x + _swiglu(h2, ffn_w_gu[l // 2], ffn_w_down[l // 2])
        else:
            x = x + _moe(h2, router_w[l // 2], router_b[l // 2], moe_w_gu[l // 2], moe_w_down[l // 2])
    return x
```

```cpp
#include <hip/hip_runtime.h>
#include <cstdio>
#include <cstdint>

namespace pg8 {
#define PG8_LAS __attribute__((address_space(3)))
typedef unsigned short bf16_t;
typedef short bf16x8 __attribute__((ext_vector_type(8)));
typedef float f32x4 __attribute__((ext_vector_type(4)));
typedef unsigned u32x4 __attribute__((ext_vector_type(4)));
constexpr int BM = 256, BK = 64, HALF = 128, HTB = HALF * BK * 2  , STAGE_BYTES = 8 * HTB, NXCD = 8, WGM = 8;

__host__ __device__ __forceinline__ int lds_byte(int r, int c) { const int st = (r >> 4) * 2 + (c >> 5), rr = r & 15, cc = c & 31, ob = rr * 64 + cc * 2; return st * 1024 + (ob ^ (((ob >> 9) & 1) << 5)); }
__host__ __device__ __forceinline__ void stage_rc(int b, int& R, int& C) { const int st = b / 1024, sb = b % 1024, swz = sb ^ (((sb >> 9) & 1) << 5); R = (st >> 1) * 16 + swz / 64; C = (st & 1) * 32 + (swz % 64) / 2; }
__host__ __device__ __forceinline__ int perm32(int rho) { const int n = rho >> 4, i = rho & 15; return 8 * (i >> 2) + 4 * n + (i & 3); }

struct Unit { int pm, pn; };
struct Gemm { const bf16_t* A; const bf16_t* Bt; int K; };

struct StaticOrder {
    int nM, nN, nwg, G, c;
    __device__ void init(int nM_, int nN_, int G_, int c_) { nM = nM_; nN = nN_; nwg = nM * nN; G = G_; c = c_; }
    __device__ bool next(int i, Unit& u) const {
        const long L = (long)i * G + c; if (L >= nwg) return false;
        int wgid = (int)L; { const int q = nwg / NXCD, r = nwg % NXCD, xcd = wgid % NXCD, off = wgid / NXCD; wgid = (xcd < r ? xcd * (q + 1) : r * (q + 1) + (xcd - r) * q) + off; }
        const int nig = WGM * nN, gid = wgid / nig, fm = gid * WGM, gsz = (nM - fm) < WGM ? (nM - fm) : WGM;
        u.pm = fm + ((wgid % nig) % gsz); u.pn = (wgid % nig) / gsz; return true;
    }
    __device__ __forceinline__ const char* a_base(const Gemm& g, const Unit& u) const { return (const char*)g.A + (size_t)u.pm * ((size_t)BM * g.K * 2); }
    __device__ __forceinline__ const char* b_base(const Gemm& g, const Unit& u) const { return (const char*)g.Bt + (size_t)u.pn * ((size_t)BM * g.K * 2); }
    __device__ __forceinline__ void a_ready(const Unit&) const {}
    __device__ __forceinline__ void done(const Unit&) const {}
};
struct MoeOrder : StaticOrder {
    const int* tile_e; size_t estride;
    __device__ __forceinline__ const char* b_base(const Gemm& g, const Unit& u) const { return (const char*)g.Bt + (size_t)tile_e[u.pm] * estride + (size_t)u.pn * ((size_t)BM * g.K * 2); }
};

__device__ __forceinline__ unsigned cvt_pk_bf16(float lo, float hi) { unsigned r; asm volatile("v_cvt_pk_bf16_f32 %0, %1, %2" : "=v"(r) : "v"(lo), "v"(hi)); return r; }

struct EpiBf16 {
    static constexpr bool PERM = true, AFTER_DRAIN = false;
    bf16_t* O; int ldc;
    __device__ __forceinline__ void operator()(const f32x4 (&acc)[2][2][4][2], const Unit& u, int wr, int wc, int fr, int fq) const {
        const int row0 = u.pm * BM + wr * 64 + fr, col0 = u.pn * BM + wc * 32 + 8 * fq;
#pragma unroll
        for (int ai = 0; ai < 2; ++ai)
#pragma unroll
            for (int m = 0; m < 4; ++m) { bf16_t* rowp = O + (size_t)(row0 + ai * HALF + m * 16) * ldc + col0;
#pragma unroll
                for (int bj = 0; bj < 2; ++bj) { const f32x4 v0 = acc[ai][bj][m][0], v1 = acc[ai][bj][m][1];
                    u32x4 w; w.x = cvt_pk_bf16(v0[0], v0[1]); w.y = cvt_pk_bf16(v0[2], v0[3]); w.z = cvt_pk_bf16(v1[0], v1[1]); w.w = cvt_pk_bf16(v1[2], v1[3]);
                    *(u32x4*)(rowp + bj * HALF) = w; } }
    }
};
struct EpiSwiglu {
    static constexpr bool PERM = true, AFTER_DRAIN = false;
    bf16_t* O; int ldc;
    __device__ __forceinline__ void operator()(const f32x4 (&acc)[2][2][4][2], const Unit& u, int wr, int wc, int fr, int fq) const {
        const int row0 = u.pm * BM + wr * 64 + fr, col0 = u.pn * HALF + wc * 32 + 8 * fq;
#pragma unroll
        for (int ai = 0; ai < 2; ++ai)
#pragma unroll
            for (int m = 0; m < 4; ++m) { bf16_t* rowp = O + (size_t)(row0 + ai * HALF + m * 16) * ldc + col0;
                float h[8];
#pragma unroll
                for (int n = 0; n < 2; ++n)
#pragma unroll
                    for (int j = 0; j < 4; ++j) { const float gq = acc[ai][0][m][n][j], uq = acc[ai][1][m][n][j];
                        const float sg = __builtin_amdgcn_rcpf(1.0f + __builtin_amdgcn_exp2f(-1.4426950408889634f * gq));
                        h[n * 4 + j] = gq * sg * uq; }
                u32x4 w; w.x = cvt_pk_bf16(h[0], h[1]); w.y = cvt_pk_bf16(h[2], h[3]); w.z = cvt_pk_bf16(h[4], h[5]); w.w = cvt_pk_bf16(h[6], h[7]);
                *(u32x4*)rowp = w; }
    }
};
struct EpiResF32 {
    static constexpr bool PERM = false, AFTER_DRAIN = false;
    const float* base; float* out; int ldc;
    __device__ __forceinline__ void operator()(const f32x4 (&acc)[2][2][4][2], const Unit& u, int wr, int wc, int fr, int fq) const {
        const int row0 = u.pm * BM + wr * 64 + fr, col0 = u.pn * BM + wc * 32 + 4 * fq;
#pragma unroll
        for (int ai = 0; ai < 2; ++ai)
#pragma unroll
            for (int m = 0; m < 4; ++m) { const size_t off = (size_t)(row0 + ai * HALF + m * 16) * ldc + col0;
#pragma unroll
                for (int bj = 0; bj < 2; ++bj)
#pragma unroll
                    for (int n = 0; n < 2; ++n) { const f32x4 b = *(const f32x4*)(base + off + bj * HALF + n * 16); *(f32x4*)(out + off + bj * HALF + n * 16) = b + acc[ai][bj][m][n]; } }
    }
};
template <class Epi, class Sched, bool ALIGN_EPI = false, bool SP2 = false>
__device__ __forceinline__ void gemm_phase(PG8_LAS unsigned char* lds, const Gemm g, const Sched& S, const Epi& E) {
    const int tid = threadIdx.x, wid = __builtin_amdgcn_readfirstlane(tid >> 6), lane = tid & 63, wr = wid >> 2, wc = wid & 3, fr = lane & 15, fq = lane >> 4;
    const int K = g.K, nt = K / BK;
    unsigned voffA[2], voffB[2];
#pragma unroll
    for (int i = 0; i < 2; ++i) { int R, C; stage_rc(tid * 16 + i * 8192, R, C); const int Rb = Epi::PERM ? ((R & ~31) + perm32(R & 31)) : R;
        voffA[i] = (unsigned)(R * K + C) * 2u; voffB[i] = (unsigned)(Rb * K + C) * 2u; }
    const size_t kstep = (size_t)(BK * 2);
    const size_t hstep = (size_t)HALF * K * 2;
    const unsigned ldsw = (unsigned)wid * 1024u;
    const int aoff = lds_byte(wr * 64 + fr, fq * 8), boff = lds_byte(wc * 32 + fr, fq * 8);
#define PG8_SA(b, h) (((b) * 2 + (h)) * HTB)
#define PG8_SB(b, h) ((4 + (b) * 2 + (h)) * HTB)
#define PG8_STAGE(bufoff, gbase, voff) do { _Pragma("unroll") for (int _i = 0; _i < 2; ++_i) \
        __builtin_amdgcn_global_load_lds((const unsigned*)((const char*)(gbase) + (voff)[_i]), (PG8_LAS unsigned*)(lds + (bufoff) + ldsw + _i * 8192), 16, 0, 0); } while (0)
#define PG8_LDA(dst, b, h) do { _Pragma("unroll") for (int m = 0; m < 4; ++m) _Pragma("unroll") for (int k = 0; k < 2; ++k) dst[m][k] = *(const PG8_LAS bf16x8*)(lds + PG8_SA(b, h) + aoff + m * 2048 + k * 1024); } while (0)
#define PG8_LDB(dst, b, h) do { _Pragma("unroll") for (int n = 0; n < 2; ++n) _Pragma("unroll") for (int k = 0; k < 2; ++k) dst[n][k] = *(const PG8_LAS bf16x8*)(lds + PG8_SB(b, h) + boff + n * 2048 + k * 1024); } while (0)
#define PG8_MMA(ai, bj, At, Bt) do { __builtin_amdgcn_s_setprio(1); _Pragma("unroll") for (int m = 0; m < 4; ++m) _Pragma("unroll") for (int n = 0; n < 2; ++n) _Pragma("unroll") for (int k = 0; k < 2; ++k) \
        acc[ai][bj][m][n] = __builtin_amdgcn_mfma_f32_16x16x32_bf16(Bt[n][k], At[m][k], acc[ai][bj][m][n], 0, 0, 0); __builtin_amdgcn_s_setprio(0); } while (0)
#define PG8_WAIT_V(n) asm volatile("s_waitcnt vmcnt(" #n ")" ::: "memory")
#define PG8_WAIT_L(n) asm volatile("s_waitcnt lgkmcnt(" #n ")" ::: "memory")
#define PG8_BAR __builtin_amdgcn_s_barrier()
#define PG8_SCHED __builtin_amdgcn_sched_barrier(0)
    Unit cur, nxt; int ui = 0;
    if (!S.next(0, cur)) return;
    f32x4 acc[2][2][4][2];
#pragma unroll
    for (int a = 0; a < 2; ++a)
#pragma unroll
        for (int b = 0; b < 2; ++b)
#pragma unroll
            for (int m = 0; m < 4; ++m)
#pragma unroll
                for (int n = 0; n < 2; ++n) acc[a][b][m][n] = (f32x4){0.f, 0.f, 0.f, 0.f};
    bf16x8 At[4][2], B0[2][2], B1[2][2];
    const char* cA = S.a_base(g, cur); const char* cB = S.b_base(g, cur);
    S.a_ready(cur);
    if constexpr (SP2) {
        PG8_STAGE(PG8_SB(0, 0), cB, voffB); PG8_STAGE(PG8_SB(0, 1), cB + hstep, voffB); PG8_STAGE(PG8_SA(0, 0), cA, voffA); PG8_STAGE(PG8_SA(0, 1), cA + hstep, voffA);
        if (wr == 1) PG8_BAR;
        PG8_WAIT_V(2); PG8_BAR;
        PG8_STAGE(PG8_SB(1, 0), cB + kstep, voffB); PG8_STAGE(PG8_SA(1, 0), cA + kstep, voffA); PG8_STAGE(PG8_SB(1, 1), cB + hstep + kstep, voffB);
        PG8_WAIT_V(6); PG8_BAR;
    } else {
        PG8_STAGE(PG8_SB(0, 0), cB, voffB); PG8_STAGE(PG8_SA(0, 0), cA, voffA); PG8_STAGE(PG8_SB(0, 1), cB + hstep, voffB); PG8_STAGE(PG8_SA(0, 1), cA + hstep, voffA);
        if (wr == 1) PG8_BAR;
        PG8_WAIT_V(4); PG8_BAR;
        PG8_STAGE(PG8_SB(1, 0), cB + kstep, voffB); PG8_STAGE(PG8_SA(1, 0), cA + kstep, voffA); PG8_STAGE(PG8_SB(1, 1), cB + hstep + kstep, voffB);
        PG8_WAIT_V(6); PG8_BAR;
    }
    for (;;) {
        const bool has_next = S.next(ui + 1, nxt);
        const char* nA = has_next ? S.a_base(g, nxt) : cA; const char* nB = has_next ? S.b_base(g, nxt) : cB;
        for (int t = 0; t < nt; t += 2) {
            const bool last = (t == nt - 2);
            const char* a1 = cA + (size_t)(t + 1) * kstep;
            const char* a2 = last ? nA : cA + (size_t)(t + 2) * kstep; const char* b2 = last ? nB : cB + (size_t)(t + 2) * kstep;
            const char* a3 = a2 + kstep; const char* b3 = b2 + kstep;
            if (last && has_next) S.a_ready(nxt);
            if constexpr (SP2) {
            PG8_LDB(B0, 0, 0); PG8_LDB(B1, 0, 1); PG8_SCHED; PG8_LDA(At, 0, 0); PG8_STAGE(PG8_SA(1, 1), a1 + hstep, voffA);
            PG8_WAIT_V(8); PG8_WAIT_L(0); PG8_BAR; PG8_MMA(0, 0, At, B0); PG8_MMA(0, 1, At, B1); PG8_BAR; PG8_SCHED;
            PG8_LDA(At, 0, 1); PG8_STAGE(PG8_SB(0, 0), b2, voffB); PG8_STAGE(PG8_SB(0, 1), b2 + hstep, voffB); PG8_STAGE(PG8_SA(0, 0), a2, voffA);
            PG8_WAIT_V(8); PG8_WAIT_L(0); PG8_BAR; PG8_MMA(1, 0, At, B0); PG8_MMA(1, 1, At, B1); PG8_BAR; PG8_SCHED;
            PG8_LDB(B0, 1, 0); PG8_LDB(B1, 1, 1); PG8_SCHED; PG8_LDA(At, 1, 0); PG8_STAGE(PG8_SA(0, 1), a2 + hstep, voffA);
            PG8_WAIT_V(8); PG8_WAIT_L(0); PG8_BAR; PG8_MMA(0, 0, At, B0); PG8_MMA(0, 1, At, B1); PG8_BAR; PG8_SCHED;
            PG8_LDA(At, 1, 1); PG8_STAGE(PG8_SB(1, 0), b3, voffB); PG8_STAGE(PG8_SB(1, 1), b3 + hstep, voffB); PG8_STAGE(PG8_SA(1, 0), a3, voffA);
            PG8_WAIT_V(8); PG8_WAIT_L(0); PG8_BAR; PG8_MMA(1, 0, At, B0); PG8_MMA(1, 1, At, B1); PG8_BAR; PG8_SCHED;
            } else {
            PG8_LDB(B0, 0, 0); PG8_SCHED; PG8_LDA(At, 0, 0); PG8_STAGE(PG8_SA(1, 1), a1 + hstep, voffA);
            PG8_WAIT_L(8); PG8_BAR; PG8_WAIT_L(0); PG8_MMA(0, 0, At, B0); PG8_BAR; PG8_SCHED;
            PG8_LDB(B1, 0, 1); PG8_STAGE(PG8_SB(0, 0), b2, voffB);
            PG8_BAR; PG8_WAIT_L(0); PG8_MMA(0, 1, At, B1); PG8_BAR;
            PG8_LDA(At, 0, 1); PG8_STAGE(PG8_SA(0, 0), a2, voffA);
            PG8_BAR; PG8_WAIT_L(0); PG8_MMA(1, 0, At, B0); PG8_BAR; PG8_SCHED;
            PG8_STAGE(PG8_SB(0, 1), b2 + hstep, voffB);
            PG8_WAIT_V(6); PG8_BAR; PG8_MMA(1, 1, At, B1); PG8_BAR;
            PG8_LDB(B0, 1, 0); PG8_SCHED; PG8_LDA(At, 1, 0); PG8_STAGE(PG8_SA(0, 1), a2 + hstep, voffA);
            PG8_WAIT_L(8); PG8_BAR; PG8_WAIT_L(0); PG8_MMA(0, 0, At, B0); PG8_BAR; PG8_SCHED;
            PG8_LDB(B1, 1, 1); PG8_STAGE(PG8_SB(1, 0), b3, voffB);
            PG8_BAR; PG8_WAIT_L(0); PG8_MMA(0, 1, At, B1); PG8_BAR;
            PG8_LDA(At, 1, 1); PG8_STAGE(PG8_SA(1, 0), a3, voffA);
            PG8_BAR; PG8_WAIT_L(0); PG8_MMA(1, 0, At, B0); PG8_BAR; PG8_SCHED;
            PG8_STAGE(PG8_SB(1, 1), b3 + hstep, voffB);
            PG8_WAIT_V(6); PG8_BAR; PG8_MMA(1, 1, At, B1); PG8_BAR;
            }
        }
        if constexpr (ALIGN_EPI) { if (wr == 0) PG8_BAR; }
        if constexpr (!Epi::AFTER_DRAIN) { E(acc, cur, wr, wc, fr, fq); S.done(cur); }
        if (!has_next) break;
#pragma unroll
        for (int a = 0; a < 2; ++a)
#pragma unroll
            for (int b = 0; b < 2; ++b)
#pragma unroll
                for (int m = 0; m < 4; ++m)
#pragma unroll
                    for (int n = 0; n < 2; ++n) acc[a][b][m][n] = (f32x4){0.f, 0.f, 0.f, 0.f};
        cur = nxt; cA = nA; cB = nB; ++ui;
        if constexpr (ALIGN_EPI) { if (wr == 1) PG8_BAR; }
    }
    PG8_WAIT_V(0);
    if constexpr (!ALIGN_EPI) { if (wr == 0) PG8_BAR; }
    PG8_BAR;
    if constexpr (Epi::AFTER_DRAIN) { E.fused(acc, cur, wr, wc, fr, fq, lds, wid, lane); S.done(cur); }
#undef PG8_SA
#undef PG8_SB
#undef PG8_STAGE
#undef PG8_LDA
#undef PG8_LDB
#undef PG8_MMA
#undef PG8_WAIT_V
#undef PG8_WAIT_L
#undef PG8_BAR
#undef PG8_SCHED
}
}


constexpr int T = 8192, DM = 2048, HD = 128, NMIX = 12, NMEMH = 4, NG = 3, MEMT = 256, FF = 7168, NE = 8;
constexpr int A_IN_W = 4388, NA = 4608;
constexpr int NB = 5120;
constexpr int CA_Q = 0, CA_KC = 1536, CA_VC = 1920, CA_KS = 2304, CA_VS = 2688, CA_KW = 3072, CA_VW = 3456, CA_QM = 3840, CA_GT = 4352;
constexpr int CB_Q = 0, CB_QM = 1536, CB_K = 2048, CB_V = 3584;
constexpr int NCMP = 511, NCMP_P = 512;
constexpr int MOE_MAXT = 72;
constexpr float EPS = 1e-6f;
constexpr float QSCALE = 0.08838834764831845f;

constexpr size_t MiB = 1u << 20;
constexpr size_t WS_CTL = 0, CTL_ZERO_BYTES = 1 * MiB;
constexpr size_t WS_WT_INA = 2 * MiB;
constexpr size_t WS_WT_MEM = 20 * MiB;
constexpr size_t WS_WT_OUT = 28 * MiB;
constexpr size_t WS_WT_FGU = 44 * MiB;
constexpr size_t WS_WT_FDN = 100 * MiB;
constexpr size_t WS_WT_INB = 128 * MiB;
constexpr size_t WS_WT_MGU = 148 * MiB;
constexpr size_t WS_WT_MDN = 596 * MiB;
constexpr size_t WS_XN = 820 * MiB;
constexpr size_t WS_MEMN = 852 * MiB;
constexpr size_t WS_MKV = 853 * MiB;
constexpr size_t WS_PA = 854 * MiB;
constexpr size_t WS_KCMP = 926 * MiB;
constexpr size_t WS_MIX = 927 * MiB;
constexpr size_t WS_X1 = 959 * MiB;
constexpr size_t WS_X2 = 1023 * MiB;
constexpr size_t WS_X3 = 1087 * MiB;
constexpr size_t WS_HFF = 1151 * MiB;
constexpr size_t WS_PB = 1263 * MiB;
constexpr size_t WS_AMOE = 1343 * MiB;
constexpr size_t WS_HMOE = 1415 * MiB;
constexpr size_t WS_YMOE = 1667 * MiB;
constexpr size_t WS_ROUTE = 1739 * MiB;
constexpr size_t WS_END = 1740 * MiB;
constexpr size_t RT_TOPI = 0;
constexpr size_t RT_TOPW = 65536;
constexpr size_t RT_ROW = 131072;
constexpr size_t RT_HIST = 196608;
constexpr size_t RT_TILE = 204800;
constexpr int CW_TMO = 0, CW_CODE = 1, CW_BAR = 4096;

constexpr int RING_OFF = 0, RING_BYTES = 135168;
constexpr int LDSCTL_OFF = RING_BYTES, MISC_OFF = LDSCTL_OFF + 320;
constexpr int LDS_BYTES = 147456;
static_assert(MISC_OFF + 128 <= LDS_BYTES, "LDS map");
constexpr int NWAVES = 8;

#define GAS __attribute__((address_space(1)))
#define LAS __attribute__((address_space(3)))
typedef unsigned short bf16;
typedef unsigned v4u __attribute__((ext_vector_type(4)));
typedef unsigned v2u __attribute__((ext_vector_type(2)));
typedef float f32x4 __attribute__((ext_vector_type(4)));
typedef GAS unsigned gu32;
#define RLX_AGENT __ATOMIC_RELAXED, __HIP_MEMORY_SCOPE_AGENT
#define LDS_WAIT() asm volatile("s_waitcnt lgkmcnt(0)" ::: "memory")
#define VM_WAIT() asm volatile("s_waitcnt vmcnt(0)" ::: "memory")
__device__ __forceinline__ float bf2f(unsigned b) { return __uint_as_float(b << 16); }
__device__ __forceinline__ unsigned pk2(float lo, float hi) { return pg8::cvt_pk_bf16(lo, hi); }
__device__ __forceinline__ void unpack8(v4u w, float* f) {
    f[0] = __uint_as_float(w.x << 16); f[1] = __uint_as_float(w.x & 0xffff0000u); f[2] = __uint_as_float(w.y << 16); f[3] = __uint_as_float(w.y & 0xffff0000u);
    f[4] = __uint_as_float(w.z << 16); f[5] = __uint_as_float(w.z & 0xffff0000u); f[6] = __uint_as_float(w.w << 16); f[7] = __uint_as_float(w.w & 0xffff0000u); }
__device__ __forceinline__ float wave_sum(float v) {
#pragma unroll
    for (int o = 1; o < 64; o <<= 1) v += __shfl_xor(v, o);
    return v;
}
__device__ __forceinline__ float fast_exp(float x) { return __builtin_amdgcn_exp2f(x * 1.4426950408889634f); }

#define XB_TMO      128
#define XB_XCNT(j)  (256  + 64 * (j))
#define XB_XSUB(j)  (1280 + 64 * (j))
#define XB_XGEN(j)  (2304 + 64 * (j))
#define XB_TOP      3328
#define XB_TOPGEN   3392
#define XCD_BAR_WORDS 3456
#define XB_SPIN_CAP (1u << 18)
__device__ __forceinline__ unsigned xb_ld(unsigned* p)              { return __hip_atomic_load(p, __ATOMIC_RELAXED, __HIP_MEMORY_SCOPE_AGENT); }
__device__ __forceinline__ unsigned xb_add(unsigned* p, unsigned v) { return __hip_atomic_fetch_add(p, v, __ATOMIC_RELAXED, __HIP_MEMORY_SCOPE_AGENT); }
__device__ __forceinline__ unsigned xb_xcc_id() { return (unsigned)__builtin_amdgcn_s_getreg((3 << 11) | 20) & 0xFu; }
#define XB_SPIN(cond, bar) do { unsigned _sp = 0; while (cond) { __builtin_amdgcn_s_sleep(1); \
    if ((++_sp & 255u) == 0u) { if (xb_ld(&(bar)[XB_TMO])) break; if (_sp > XB_SPIN_CAP) { atomicAdd(&(bar)[XB_TMO], 1u); break; } } } } while (0)
struct XcdBarrier { unsigned* bar; unsigned x; volatile LAS unsigned* st; };
__device__ __forceinline__ XcdBarrier xcd_barrier_post(unsigned* bar, volatile LAS unsigned* st) {
    XcdBarrier b; b.bar = bar; b.x = xb_xcc_id(); b.st = st;
    if (threadIdx.x == 0) (void)xb_add(&bar[XB_XCNT(b.x)], 1u);
    return b;
}
__device__ __forceinline__ void xcd_barrier_complete(unsigned* bar, unsigned x, unsigned& nloc, unsigned& nx) {
    const unsigned G = gridDim.x * gridDim.y * gridDim.z;
    unsigned sum, cnt, mine, sp = 0u;
    for (;;) {
        sum = 0u; cnt = 0u; mine = 0u;
#pragma unroll
        for (unsigned j = 0; j < 16; ++j) { const unsigned c = xb_ld(&bar[XB_XCNT(j)]); sum += c; cnt += (c > 0u) ? 1u : 0u; mine = (j == x) ? c : mine; }
        if (sum == G) break;
        __builtin_amdgcn_s_sleep(1);
        if ((++sp & 255u) == 0u) { if (xb_ld(&bar[XB_TMO])) break; if (sp > XB_SPIN_CAP) { atomicAdd(&bar[XB_TMO], 1u); break; } }
    }
    nloc = mine > 0u ? mine : 1u; nx = cnt > 0u ? cnt : 1u;
}
__device__ __forceinline__ void xcd_barrier(const XcdBarrier& b) {
    asm volatile("s_waitcnt vmcnt(0)" ::: "memory");
    __syncthreads();
    if (threadIdx.x == 0) {
        unsigned* bar = b.bar;
        __builtin_amdgcn_s_waitcnt(0);
        unsigned nloc = b.st[0], nx = b.st[1];
        if (nloc == 0u) { xcd_barrier_complete(bar, b.x, nloc, nx); b.st[0] = nloc; b.st[1] = nx; }
        const unsigned old = xb_add(&bar[XB_XSUB(b.x)], 1u);
        const unsigned gen = old / nloc;
        if (old + 1u == (gen + 1u) * nloc) {
            __builtin_amdgcn_fence(__ATOMIC_RELEASE, "agent");
            asm volatile("s_waitcnt vmcnt(0)" ::: "memory");
            const unsigned og = xb_add(&bar[XB_TOP], 1u);
            const unsigned tg = og / nx;
            if (og + 1u == (tg + 1u) * nx) xb_add(&bar[XB_TOPGEN], 1u);
            else XB_SPIN(xb_ld(&bar[XB_TOPGEN]) == tg, bar);
            __builtin_amdgcn_fence(__ATOMIC_ACQUIRE, "agent");
            xb_add(&bar[XB_XGEN(b.x)], 1u);
            asm volatile("s_waitcnt vmcnt(0)" ::: "memory");
        } else {
            XB_SPIN(xb_ld(&bar[XB_XGEN(b.x)]) == gen, bar);
            __builtin_amdgcn_fence(__ATOMIC_ACQUIRE, "agent");
            asm volatile("s_waitcnt vmcnt(0)" ::: "memory");
        }
    }
    __syncthreads();
}

struct Frame {
    LAS unsigned char* lds;
    volatile LAS unsigned* MISC;
    gu32* ctl;
    int tid, lane, wave;
    int vcu, G;
    unsigned char* ws;
    const float* in[22];
    float* out;
};
#define WSP(T_, off) ((T_*)(F.ws + (off)))

__device__ __forceinline__ void conv_item(const float* __restrict__ W, int K, int Nsrc, bf16* __restrict__ WT, const float* __restrict__ gain,
                                          int kb, int nb, int mode, int delta, int nvalid, LAS float* scr, int lane) {
    const int k0 = kb * 64, n0 = nb * 64;
    int sc0;
    if (mode == 1) { const int j = n0 >> 8, r = n0 & 255; sc0 = (r < 128) ? 128 * j + r : 7168 + 128 * j + (r - 128); }
    else sc0 = n0 + delta;
    const int kr = lane >> 4, nc = (lane & 15) * 4;
    const bool ok = (n0 + nc) < nvalid;
#pragma unroll 4
    for (int i = 0; i < 16; ++i) {
        const int k = 4 * i + kr;
        f32x4 v = (f32x4){0.f, 0.f, 0.f, 0.f};
        if (ok) v = *(const f32x4*)(W + (size_t)(k0 + k) * Nsrc + sc0 + nc);
        if (gain) { const float gk = gain[k0 + k]; v = v * gk; }
        LAS float* s = scr + k * 65 + nc;
        s[0] = v[0]; s[1] = v[1]; s[2] = v[2]; s[3] = v[3];
    }
    LDS_WAIT(); asm volatile("" ::: "memory");
    const int c = lane & 7, nl = lane >> 3;
#pragma unroll
    for (int j = 0; j < 8; ++j) {
        const int n = nl + 8 * j; const LAS float* s = scr + (8 * c) * 65 + n;
        v4u o; o.x = pk2(s[0 * 65], s[1 * 65]); o.y = pk2(s[2 * 65], s[3 * 65]); o.z = pk2(s[4 * 65], s[5 * 65]); o.w = pk2(s[6 * 65], s[7 * 65]);
        *(v4u*)(WT + (size_t)(n0 + n) * K + k0 + 8 * c) = o;
    }
    LDS_WAIT(); asm volatile("" ::: "memory");
}
__device__ __forceinline__ void conv_matrix(Frame& F, const float* W, int K, int Nsrc, int Ndst, bf16* WT, const float* gain, int mode, int& base_item) {
    LAS float* scr = (LAS float*)(F.lds + RING_OFF + F.wave * 16640);
    const int gw = F.vcu * NWAVES + F.wave, NGW = F.G * NWAVES;
    const int nkb = K / 64, nnb = Ndst / 64, nitems = nkb * nnb;
    int first = (gw - (base_item % NGW) + NGW) % NGW;
    for (int it = first; it < nitems; it += NGW) {
        const int kb = it / nnb, nb = it % nnb;
        int delta = 0, nvalid = Ndst;
        if (mode == 2) {
            const int n0 = nb * 64;
            if (n0 < 3840) { delta = 0; } else if (n0 < 4352) { delta = 36; } else { delta = -512; nvalid = 4388; }
        }
        conv_item(W, K, Nsrc, WT, gain, kb, nb, mode == 1 ? 1 : 0, delta, nvalid, scr, F.lane);
    }
    base_item += nitems;
}
__device__ __forceinline__ float row_rstd_to_bf16(const float* xrow, bf16* orow, int lane) {
    const f32x4* xr = (const f32x4*)xrow + lane;
    f32x4 v[8]; float s = 0.f;
#pragma unroll
    for (int j = 0; j < 8; ++j) { v[j] = xr[64 * j]; s += (v[j].x * v[j].x + v[j].y * v[j].y) + (v[j].z * v[j].z + v[j].w * v[j].w); }
    const float rstd = 1.0f / sqrtf(wave_sum(s) * (1.f / DM) + EPS);
    v2u* o8 = (v2u*)orow + lane;
#pragma unroll
    for (int j = 0; j < 8; ++j) { v2u w; w.x = pk2(v[j].x * rstd, v[j].y * rstd); w.y = pk2(v[j].z * rstd, v[j].w * rstd); o8[64 * j] = w; }
    return rstd;
}
__device__ __forceinline__ void rmsnorm_rows(Frame& F, const float* X, bf16* XN, int rows) {
    const int gw = F.vcu * NWAVES + F.wave, NGW = F.G * NWAVES;
    for (int m = gw; m < rows; m += NGW) row_rstd_to_bf16(X + (size_t)m * DM, XN + (size_t)m * DM, F.lane);
}
__device__ __forceinline__ void p0_prologue(Frame& F) {
    int base = 0;
    conv_matrix(F, F.in[5], DM, A_IN_W, NA, WSP(bf16, WS_WT_INA), F.in[2], 2, base);
    conv_matrix(F, F.in[13], DM, 1024, 1024, WSP(bf16, WS_WT_MEM), F.in[3], 0, base);
    conv_matrix(F, F.in[13] + (size_t)DM * 1024, DM, 1024, 1024, WSP(bf16, WS_WT_MEM) + (size_t)1024 * DM, F.in[3] + DM, 0, base);
    conv_matrix(F, F.in[15], DM, DM, DM, WSP(bf16, WS_WT_OUT), nullptr, 0, base);
    conv_matrix(F, F.in[15] + (size_t)DM * DM, DM, DM, DM, WSP(bf16, WS_WT_OUT) + (size_t)DM * DM, nullptr, 0, base);
    conv_matrix(F, F.in[16], DM, 2 * FF, 2 * FF, WSP(bf16, WS_WT_FGU), F.in[4], 1, base);
    conv_matrix(F, F.in[17], FF, DM, DM, WSP(bf16, WS_WT_FDN), nullptr, 0, base);
    conv_matrix(F, F.in[10], DM, DM, DM, WSP(bf16, WS_WT_INB), F.in[2] + DM, 0, base);
    conv_matrix(F, F.in[12], DM, 3072, 3072, WSP(bf16, WS_WT_INB) + (size_t)2048 * DM, F.in[11], 0, base);
    for (int e = 0; e < NE; ++e) {
        conv_matrix(F, F.in[20] + (size_t)e * DM * 2 * FF, DM, 2 * FF, 2 * FF, WSP(bf16, WS_WT_MGU) + (size_t)e * 2 * FF * DM, F.in[4] + DM, 1, base);
        conv_matrix(F, F.in[21] + (size_t)e * FF * DM, FF, DM, DM, WSP(bf16, WS_WT_MDN) + (size_t)e * DM * FF, nullptr, 0, base);
    }
    rmsnorm_rows(F, F.in[0], WSP(bf16, WS_XN), T);
    rmsnorm_rows(F, F.in[1], WSP(bf16, WS_MEMN), MEMT);
}

__device__ __forceinline__ void p2_compress(Frame& F) {
    const bf16* PA = WSP(bf16, WS_PA);
    LAS float* red = (LAS float*)(F.lds + RING_OFF);
    const int n = F.tid & 127, kq = F.tid >> 7;
    const int nitems = 2 * NG * NCMP_P;
    for (int it = F.vcu; it < nitems; it += F.G) {
        const int kv = it / (NG * NCMP_P), g = (it / NCMP_P) % NG, j = it % NCMP_P;
        bf16* dst = WSP(bf16, WS_KCMP) + (size_t)kv * NG * NCMP_P * HD + ((size_t)g * NCMP_P + j) * HD;
        if (j >= NCMP) { if (F.tid < 128) dst[F.tid] = 0; continue; }
        const float* w = F.in[6] + (size_t)kv * 4096 * HD;
        const float* pos = F.in[7] + (size_t)kv * 4096;
        const int col = (kv ? CA_VC : CA_KC) + g * HD;
        float acc = 0.f;
        for (int k = kq * 1024; k < kq * 1024 + 1024; k += 8) {
            const int trow = 16 * j + (k >> 7), d = k & 127;
            const v4u xa = *(const v4u*)(PA + (size_t)trow * NA + col + d);
            float xf[8]; unpack8(xa, xf);
#pragma unroll
            for (int e = 0; e < 8; ++e) acc += (xf[e] + pos[k + e]) * w[(size_t)(k + e) * HD + n];
        }
        red[kq * 128 + n] = acc;
        __syncthreads();
        if (F.tid < 128) {
            float v = red[n] + red[128 + n] + red[256 + n] + red[384 + n];
            if (kv == 0) {
                float s = v * v;
                s = wave_sum(s);
                if (F.lane == 0) red[512 + F.wave] = s;
            }
            red[640 + n] = v;
        }
        __syncthreads();
        if (F.tid < 128) {
            float v = red[640 + n];
            if (kv == 0) { const float ss = red[512] + red[513]; v = v * (1.0f / sqrtf(ss * (1.f / HD) + EPS)) * F.in[9][n]; }
            dst[n] = (bf16)(pk2(v, v) & 0xffffu);
        }
        __syncthreads();
    }
}
__device__ __forceinline__ void norm_slot(bf16* p, const float* gain, int l16) {
    v4u w = *(const v4u*)(p + l16 * 8); float f[8]; unpack8(w, f);
    float s = 0.f;
#pragma unroll
    for (int e = 0; e < 8; ++e) s += f[e] * f[e];
    s += __shfl_xor(s, 1); s += __shfl_xor(s, 2); s += __shfl_xor(s, 4); s += __shfl_xor(s, 8);
    const float r = 1.0f / sqrtf(s * (1.f / HD) + EPS);
    const float* gp = gain + l16 * 8;
    v4u o; o.x = pk2(f[0] * r * gp[0], f[1] * r * gp[1]); o.y = pk2(f[2] * r * gp[2], f[3] * r * gp[3]); o.z = pk2(f[4] * r * gp[4], f[5] * r * gp[5]); o.w = pk2(f[6] * r * gp[6], f[7] * r * gp[7]);
    *(v4u*)(p + l16 * 8) = o;
}
__device__ __forceinline__ void p2_qknorm(Frame& F) {
    bf16* PA = WSP(bf16, WS_PA); bf16* MKV = WSP(bf16, WS_MKV);
    const int gs = (F.vcu * NWAVES + F.wave) * 4 + (F.lane >> 4), NS = F.G * NWAVES * 4, l16 = F.lane & 15;
    for (int s = gs; s < T * 18; s += NS) {
        const int t = s / 18, k = s % 18;
        int col; const float* gain;
        if (k < 12) { col = CA_Q + k * HD; gain = F.in[8]; }
        else if (k < 15) { col = CA_KS + (k - 12) * HD; gain = F.in[9] + HD; }
        else { col = CA_KW + (k - 15) * HD; gain = F.in[9] + 2 * HD; }
        norm_slot(PA + (size_t)t * NA + col, gain, l16);
    }
    for (int s = gs; s < MEMT * 8; s += NS) {
        const int m = s / 8, k = s % 8, l = k >> 2, h = k & 3;
        norm_slot(MKV + (size_t)m * 2048 + l * 1024 + h * HD, F.in[14] + (size_t)(l * 2 + 1) * HD, l16);
    }
}

__device__ __forceinline__ void ld32(const bf16* p, float* f) {
#pragma unroll
    for (int i = 0; i < 4; ++i) { const v4u w = *(const v4u*)(p + 8 * i); unpack8(w, f + 8 * i); }
}
__device__ __forceinline__ float dot32q(const float* q, const bf16* kp) {
    float kf[32]; ld32(kp, kf); float s = 0.f;
#pragma unroll
    for (int i = 0; i < 32; ++i) s += q[i] * kf[i];
    s += __shfl_xor(s, 1); s += __shfl_xor(s, 2);
    return s;
}
__device__ __forceinline__ void axpy32(float* o, float p, const bf16* vp) {
    float vf[32]; ld32(vp, vf);
#pragma unroll
    for (int i = 0; i < 32; ++i) o[i] += p * vf[i];
}
__device__ __forceinline__ void st32(bf16* p, const float* f) {
#pragma unroll
    for (int i = 0; i < 4; ++i) { v4u w; w.x = pk2(f[8 * i], f[8 * i + 1]); w.y = pk2(f[8 * i + 2], f[8 * i + 3]); w.z = pk2(f[8 * i + 4], f[8 * i + 5]); w.w = pk2(f[8 * i + 6], f[8 * i + 7]); *(v4u*)(p + 8 * i) = w; }
}
#define OSM_STEP(s_, valid_, vptr_) do { if (valid_) { const float mn_ = fmaxf(m, (s_)); const float al_ = fast_exp(m - mn_); const float pp_ = fast_exp((s_) - mn_); \
        l = l * al_ + pp_; _Pragma("unroll") for (int i_ = 0; i_ < 32; ++i_) o[i_] *= al_; axpy32(o, pp_, (vptr_)); m = mn_; } } while (0)

__device__ __forceinline__ void p3_nsa_naive(Frame& F) {
    const bf16* PA = WSP(bf16, WS_PA); const bf16* KC = WSP(bf16, WS_KCMP); const bf16* VC = KC + (size_t)NG * NCMP_P * HD; bf16* MIX = WSP(bf16, WS_MIX);
    LAS float* IMP = (LAS float*)(F.lds + RING_OFF + F.wave * 4096);
    LAS unsigned long long* SELW = (LAS unsigned long long*)(F.lds + RING_OFF + F.wave * 4096 + 2048);
    const int gw = F.vcu * NWAVES + F.wave, NGW = F.G * NWAVES;
    const int dq = F.lane & 3, p = (F.lane >> 2) & 3, ql = F.lane >> 4;
    for (int it = gw; it < NG * (T / 4); it += NGW) {
        const int g = it / (T / 4), tq = it % (T / 4), t = 4 * tq + ql, head = g * 4 + p;
        const float slope = exp2f(-8.0f * (float)(head + 1) / 12.0f);
        float q[32]; ld32(PA + (size_t)t * NA + CA_Q + head * HD + dq * 32, q);
#pragma unroll
        for (int i = 0; i < 32; ++i) q[i] *= QSCALE;
        const float g0 = 1.0f / (1.0f + fast_exp(-bf2f(PA[(size_t)t * NA + CA_GT + head * 3 + 0])));
        const float g1 = 1.0f / (1.0f + fast_exp(-bf2f(PA[(size_t)t * NA + CA_GT + head * 3 + 1])));
        const float g2 = 1.0f / (1.0f + fast_exp(-bf2f(PA[(size_t)t * NA + CA_GT + head * 3 + 2])));
        float otot[32];
#pragma unroll
        for (int i = 0; i < 32; ++i) otot[i] = 0.f;
        for (int i = F.lane; i < 512; i += 64) IMP[i] = 0.f;
        LDS_WAIT(); asm volatile("" ::: "memory");
        const int jmax = (t >= 31) ? (t - 31) / 16 : -1;
        const int jmax_w = (4 * tq + 3 >= 31) ? (4 * tq + 3 - 31) / 16 : -1;
        const bf16* kcg = KC + (size_t)g * NCMP_P * HD + dq * 32; const bf16* vcg = VC + (size_t)g * NCMP_P * HD + dq * 32;
        {
            float m = -1e30f, l = 0.f;
            for (int j = 0; j <= jmax_w; ++j) {
                const float s = dot32q(q, kcg + (size_t)j * HD) - slope * (float)(t - (16 * j + 31));
                if (j <= jmax) { const float mn = fmaxf(m, s); l = l * fast_exp(m - mn) + fast_exp(s - mn); m = mn; }
            }
            const float rl = (l > 0.f) ? 1.0f / l : 0.f;
            float o[32];
#pragma unroll
            for (int i = 0; i < 32; ++i) o[i] = 0.f;
            for (int j = 0; j <= jmax_w; ++j) {
                const float s = dot32q(q, kcg + (size_t)j * HD) - slope * (float)(t - (16 * j + 31));
                const float pj = (j <= jmax) ? fast_exp(s - m) * rl : 0.f;
                axpy32(o, pj, vcg + (size_t)j * HD);
                float ps = pj; ps += __shfl_xor(ps, 4); ps += __shfl_xor(ps, 8);
                if (dq == 0 && p == 0) { IMP[ql * 128 + (j >> 2)] += ps; if ((j & 3) == 3 && (j >> 2) + 1 < 128) IMP[ql * 128 + (j >> 2) + 1] += ps; }
            }
#pragma unroll
            for (int i = 0; i < 32; ++i) otot[i] += g0 * o[i];
        }
        LDS_WAIT(); asm volatile("" ::: "memory");
        for (int qq = 0; qq < 4; ++qq) {
            const int tt = 4 * tq + qq, cur = tt >> 6;
            const int b0 = F.lane, b1 = F.lane + 64;
            const float s0 = (b0 == cur) ? 2e6f : (b0 == 0 ? 1e6f : (b0 * 64 <= tt ? IMP[qq * 128 + b0] : -1e6f));
            const float s1 = (b1 == cur) ? 2e6f : (b1 * 64 <= tt ? IMP[qq * 128 + b1] : -1e6f);
            int r0 = 0, r1 = 0;
            for (int b = 0; b < 128; ++b) {
                const float sb = (b == cur) ? 2e6f : (b == 0 ? 1e6f : (b * 64 <= tt ? IMP[qq * 128 + b] : -1e6f));
                r0 += (sb > s0 || (sb == s0 && b < b0)) ? 1 : 0;
                r1 += (sb > s1 || (sb == s1 && b < b1)) ? 1 : 0;
            }
            const unsigned long long m0 = __ballot(r0 < 16 && b0 * 64 <= tt), m1 = __ballot(r1 < 16 && b1 * 64 <= tt);
            if (F.lane == 0) { SELW[qq * 2] = m0; SELW[qq * 2 + 1] = m1; }
        }
        LDS_WAIT(); asm volatile("" ::: "memory");
        {
            const unsigned long long my0 = SELW[ql * 2], my1 = SELW[ql * 2 + 1];
            const unsigned long long u0v = SELW[0] | SELW[2] | SELW[4] | SELW[6], u1v = SELW[1] | SELW[3] | SELW[5] | SELW[7];
            const unsigned long long u0 = ((unsigned long long)(unsigned)__builtin_amdgcn_readfirstlane((int)(u0v >> 32)) << 32) | (unsigned)__builtin_amdgcn_readfirstlane((int)(unsigned)u0v);
            const unsigned long long u1 = ((unsigned long long)(unsigned)__builtin_amdgcn_readfirstlane((int)(u1v >> 32)) << 32) | (unsigned)__builtin_amdgcn_readfirstlane((int)(unsigned)u1v);
            float m = -1e30f, l = 0.f, o[32];
#pragma unroll
            for (int i = 0; i < 32; ++i) o[i] = 0.f;
            const bf16* kg = PA + CA_KS + g * HD + dq * 32; const bf16* vg = PA + CA_VS + g * HD + dq * 32;
            for (int b = 0; b < 128; ++b) {
                const bool inu = (b < 64) ? ((u0 >> b) & 1ull) : ((u1 >> (b - 64)) & 1ull);
                if (!inu) continue;
                const bool mine = (b < 64) ? ((my0 >> b) & 1ull) : ((my1 >> (b - 64)) & 1ull);
                for (int k = 0; k < 64; ++k) {
                    const int kp = b * 64 + k;
                    const float s = dot32q(q, kg + (size_t)kp * NA) - slope * (float)(t - kp);
                    const bool valid = mine && kp <= t;
                    OSM_STEP(s, valid, vg + (size_t)kp * NA);
                }
            }
            const float sc = (l > 0.f) ? g1 / l : 0.f;
#pragma unroll
            for (int i = 0; i < 32; ++i) otot[i] += sc * o[i];
        }
        {
            float m = -1e30f, l = 0.f, o[32];
#pragma unroll
            for (int i = 0; i < 32; ++i) o[i] = 0.f;
            const bf16* kg = PA + CA_KW + g * HD + dq * 32; const bf16* vg = PA + CA_VW + g * HD + dq * 32;
            const int klo = (4 * tq - 511 > 0) ? 4 * tq - 511 : 0, khi = 4 * tq + 3;
            for (int kp = klo; kp <= khi; ++kp) {
                const float s = dot32q(q, kg + (size_t)kp * NA) - slope * (float)(t - kp);
                const bool valid = kp <= t && (t - kp) < 512;
                OSM_STEP(s, valid, vg + (size_t)kp * NA);
            }
            const float sc = (l > 0.f) ? g2 / l : 0.f;
#pragma unroll
            for (int i = 0; i < 32; ++i) otot[i] += sc * o[i];
        }
        st32(MIX + (size_t)t * DM + head * HD + dq * 32, otot);
    }
}
__device__ __forceinline__ void mem_attn_naive(Frame& F, const bf16* P, int ldp, int qcol, const float* qg, int layer) {
    const bf16* MKV = WSP(bf16, WS_MKV); bf16* MIX = WSP(bf16, WS_MIX);
    const int gw = F.vcu * NWAVES + F.wave, NGW = F.G * NWAVES;
    const int dq = F.lane & 3, r = F.lane >> 2;
    for (int it = gw; it < NMEMH * (T / 16); it += NGW) {
        const int hm = it / (T / 16), t = 16 * (it % (T / 16)) + r;
        float q[32]; ld32(P + (size_t)t * ldp + qcol + hm * HD + dq * 32, q);
        float ss = 0.f;
#pragma unroll
        for (int i = 0; i < 32; ++i) ss += q[i] * q[i];
        ss += __shfl_xor(ss, 1); ss += __shfl_xor(ss, 2);
        const float rs = (1.0f / sqrtf(ss * (1.f / HD) + EPS)) * QSCALE;
#pragma unroll
        for (int i = 0; i < 32; ++i) q[i] = q[i] * rs * qg[dq * 32 + i];
        float m = -1e30f, l = 0.f, o[32];
#pragma unroll
        for (int i = 0; i < 32; ++i) o[i] = 0.f;
        const bf16* kg = MKV + layer * 1024 + hm * HD + dq * 32; const bf16* vg = kg + 512;
        for (int k = 0; k < MEMT; ++k) {
            const float s = dot32q(q, kg + (size_t)k * 2048);
            OSM_STEP(s, true, vg + (size_t)k * 2048);
        }
        const float sc = 1.0f / l;
#pragma unroll
        for (int i = 0; i < 32; ++i) o[i] *= sc;
        st32(MIX + (size_t)t * DM + NMIX * HD + hm * HD + dq * 32, o);
    }
}
__device__ __forceinline__ void stick_naive(Frame& F) {
    const bf16* PB = WSP(bf16, WS_PB); bf16* MIX = WSP(bf16, WS_MIX);
    const int gw = F.vcu * NWAVES + F.wave, NGW = F.G * NWAVES;
    const int dq = F.lane & 3, r = F.lane >> 2;
    for (int it = gw; it < NMIX * (T / 16); it += NGW) {
        const int h = it / (T / 16), t = 16 * (it % (T / 16)) + r;
        float q[32]; ld32(PB + (size_t)t * NB + CB_Q + h * HD + dq * 32, q);
#pragma unroll
        for (int i = 0; i < 32; ++i) q[i] *= QSCALE;
        float R = 0.f, o[32];
#pragma unroll
        for (int i = 0; i < 32; ++i) o[i] = 0.f;
        const bf16* kg = PB + CB_K + h * HD + dq * 32; const bf16* vg = PB + CB_V + h * HD + dq * 32;
        for (int i = 1; ; ++i) {
            const int s = t - i;
            const bool act = s >= 0 && R > -80.f;
            if (!__any(act)) break;
            const int sc = s >= 0 ? s : 0;
            const float z = dot32q(q, kg + (size_t)sc * NB);
            const float sp = fmaxf(z, 0.f) + __logf(1.0f + fast_exp(-fabsf(z)));
            if (act) { const float a = fast_exp(z - sp + R); axpy32(o, a, vg + (size_t)sc * NB); R -= sp; }
        }
        st32(MIX + (size_t)t * DM + h * HD + dq * 32, o);
    }
}

__device__ __forceinline__ void p12_router(Frame& F) {
    const float* X3 = WSP(float, WS_X3); bf16* XN = WSP(bf16, WS_XN);
    int* TOPI = (int*)(F.ws + WS_ROUTE + RT_TOPI); float* TOPW = (float*)(F.ws + WS_ROUTE + RT_TOPW); int* HIST = (int*)(F.ws + WS_ROUTE + RT_HIST);
    const float* rw = F.in[18]; const float* rb = F.in[19]; const float* gn = F.in[4] + DM;
    LAS int* hist = (LAS int*)(F.lds + RING_OFF);
    for (int c = F.vcu; c < 256; c += F.G) {
        if (F.tid < 8) hist[F.tid] = 0;
        __syncthreads();
        for (int i = 0; i < 4; ++i) {
            const int t = 32 * c + 4 * F.wave + i;
            const f32x4* xr = (const f32x4*)(X3 + (size_t)t * DM) + F.lane;
            f32x4 v[8]; float s = 0.f;
#pragma unroll
            for (int j = 0; j < 8; ++j) { v[j] = xr[64 * j]; s += (v[j].x * v[j].x + v[j].y * v[j].y) + (v[j].z * v[j].z + v[j].w * v[j].w); }
            const float rstd = 1.0f / sqrtf(wave_sum(s) * (1.f / DM) + EPS);
            v2u* o8 = (v2u*)(XN + (size_t)t * DM) + F.lane;
            float lg[8];
#pragma unroll
            for (int e = 0; e < 8; ++e) lg[e] = 0.f;
#pragma unroll
            for (int j = 0; j < 8; ++j) {
                v2u w; w.x = pk2(v[j].x * rstd, v[j].y * rstd); w.y = pk2(v[j].z * rstd, v[j].w * rstd); o8[64 * j] = w;
                const int k0 = 4 * (F.lane + 64 * j);
#pragma unroll
                for (int e4 = 0; e4 < 4; ++e4) {
                    const float xg = v[j][e4] * gn[k0 + e4];
                    const f32x4 ra = *(const f32x4*)(rw + (size_t)(k0 + e4) * 8), rb4 = *(const f32x4*)(rw + (size_t)(k0 + e4) * 8 + 4);
                    lg[0] += xg * ra.x; lg[1] += xg * ra.y; lg[2] += xg * ra.z; lg[3] += xg * ra.w; lg[4] += xg * rb4.x; lg[5] += xg * rb4.y; lg[6] += xg * rb4.z; lg[7] += xg * rb4.w;
                }
            }
#pragma unroll
            for (int e = 0; e < 8; ++e) lg[e] = wave_sum(lg[e]) * rstd;
            if (F.lane == 0) {
                int i0 = 0; float b0 = lg[0] + rb[0];
#pragma unroll
                for (int e = 1; e < 8; ++e) { const float b = lg[e] + rb[e]; if (b > b0) { b0 = b; i0 = e; } }
                int i1 = -1; float b1 = -3.0e38f;
#pragma unroll
                for (int e = 0; e < 8; ++e) { const float b = lg[e] + rb[e]; if (e != i0 && b > b1) { b1 = b; i1 = e; } }
                float l0 = 0.f, l1 = 0.f;
#pragma unroll
                for (int e = 0; e < 8; ++e) { l0 = (e == i0) ? lg[e] : l0; l1 = (e == i1) ? lg[e] : l1; }
                const float w0 = 1.0f / (1.0f + expf(l1 - l0));
                TOPI[2 * t] = i0; TOPI[2 * t + 1] = i1; TOPW[2 * t] = w0; TOPW[2 * t + 1] = 1.0f - w0;
                atomicAdd((int*)&hist[i0], 1); atomicAdd((int*)&hist[i1], 1);
            }
        }
        __syncthreads();
        if (F.tid < 8) HIST[c * 8 + F.tid] = hist[F.tid];
        __syncthreads();
    }
}
__device__ __forceinline__ void p13_assign(Frame& F) {
    const bf16* XN = WSP(bf16, WS_XN); bf16* AM = WSP(bf16, WS_AMOE);
    const int* TOPI = (const int*)(F.ws + WS_ROUTE + RT_TOPI); int* ROW = (int*)(F.ws + WS_ROUTE + RT_ROW); const int* HIST = (const int*)(F.ws + WS_ROUTE + RT_HIST);
    int* TILE = (int*)(F.ws + WS_ROUTE + RT_TILE);
    LAS int* sh = (LAS int*)(F.lds + RING_OFF);
    for (int c = F.vcu; c < 256; c += F.G) {
        if (F.tid < 16) sh[16 + F.tid] = 0;
        __syncthreads();
        for (int i = F.tid; i < 2048; i += 512) { const int v = HIST[i], cc = i >> 3, ee = i & 7;
            __hip_atomic_fetch_add(&sh[16 + ee], v, __ATOMIC_RELAXED, __HIP_MEMORY_SCOPE_WORKGROUP);
            if (cc < c) __hip_atomic_fetch_add(&sh[24 + ee], v, __ATOMIC_RELAXED, __HIP_MEMORY_SCOPE_WORKGROUP); }
        __syncthreads();
        if (F.tid < 8) {
            const int e = F.tid; int off = 0;
            for (int ee = 0; ee < 8; ++ee) { if (ee == e) break; off += (sh[16 + ee] + 255) & ~255; }
            sh[e] = off + sh[24 + e];
            if (c == 0 && e == 0) {
                int nt = 0;
                for (int ee = 0; ee < 8; ++ee) { const int n = (sh[16 + ee] + 255) >> 8; for (int i = 0; i < n; ++i) TILE[16 + nt + i] = ee; nt += n; }
                TILE[0] = nt;
            }
        }
        __syncthreads();
        if (F.wave == 0) {
            const int tl = F.lane >> 1, sl = F.lane & 1, t = 32 * c + tl;
            const int e = TOPI[2 * t + sl];
            int row = 0;
            for (int ee = 0; ee < 8; ++ee) {
                const unsigned long long mk = __ballot(e == ee);
                if (e == ee) row = sh[ee] + __popcll(mk & ((1ull << F.lane) - 1ull));
            }
            ROW[2 * t + sl] = row; sh[64 + F.lane] = row;
        }
        __syncthreads();
        for (int i = 0; i < 8; ++i) {
            const int idx = 8 * F.wave + i, t = 32 * c + (idx >> 1), row = sh[64 + idx];
            const v4u* src = (const v4u*)(XN + (size_t)t * DM); v4u* dst = (v4u*)(AM + (size_t)row * DM);
#pragma unroll
            for (int j = 0; j < 4; ++j) dst[F.lane + 64 * j] = src[F.lane + 64 * j];
        }
        __syncthreads();
    }
}
__device__ __forceinline__ void p16_combine(Frame& F) {
    const float* X3 = WSP(float, WS_X3); const bf16* Y = WSP(bf16, WS_YMOE);
    const int* ROW = (const int*)(F.ws + WS_ROUTE + RT_ROW); const float* TOPW = (const float*)(F.ws + WS_ROUTE + RT_TOPW);
    const int gw = F.vcu * NWAVES + F.wave, NGW = F.G * NWAVES;
    for (int t = gw; t < T; t += NGW) {
        const int r0 = ROW[2 * t], r1 = ROW[2 * t + 1]; const float w0 = TOPW[2 * t], w1 = TOPW[2 * t + 1];
        const v4u* y0 = (const v4u*)(Y + (size_t)r0 * DM); const v4u* y1 = (const v4u*)(Y + (size_t)r1 * DM);
        const f32x4* xr = (const f32x4*)(X3 + (size_t)t * DM); f32x4* orow = (f32x4*)(F.out + (size_t)t * DM);
#pragma unroll
        for (int j = 0; j < 4; ++j) {
            const int c8 = F.lane + 64 * j;
            float a[8], b[8]; unpack8(y0[c8], a); unpack8(y1[c8], b);
            const f32x4 xa = xr[2 * c8], xb = xr[2 * c8 + 1];
            orow[2 * c8] = (f32x4){xa.x + w0 * a[0] + w1 * b[0], xa.y + w0 * a[1] + w1 * b[1], xa.z + w0 * a[2] + w1 * b[2], xa.w + w0 * a[3] + w1 * b[3]};
            orow[2 * c8 + 1] = (f32x4){xb.x + w0 * a[4] + w1 * b[4], xb.y + w0 * a[5] + w1 * b[5], xb.z + w0 * a[6] + w1 * b[6], xb.w + w0 * a[7] + w1 * b[7]};
        }
    }
}

constexpr int N_PHASES = 17;
struct Args { const float* in[22]; float* out; unsigned char* ws; int ph_lo, ph_hi, use_bar, pad; };
__global__ void __launch_bounds__(NWAVES * 64, 2) mk_fwd(Args args) {
    extern __shared__ __attribute__((aligned(16))) unsigned char lds[];
    Frame F;
    F.lds = (LAS unsigned char*)lds;
    F.MISC = (volatile LAS unsigned*)(F.lds + MISC_OFF);
    F.tid = threadIdx.x; F.lane = F.tid & 63; F.wave = __builtin_amdgcn_readfirstlane(F.tid >> 6);
    F.G = gridDim.x; { const int bx = blockIdx.x; F.vcu = (F.G % 8 == 0) ? (bx % 8) * (F.G / 8) + bx / 8 : bx; }
    F.ws = args.ws; F.ctl = (gu32*)(args.ws + WS_CTL); F.out = args.out;
#pragma unroll
    for (int i = 0; i < 22; ++i) F.in[i] = args.in[i];
    for (int u = F.tid; u < (LDS_BYTES - LDSCTL_OFF) / 4; u += NWAVES * 64) ((LAS unsigned*)(F.lds + LDSCTL_OFF))[u] = 0u;
    __syncthreads();
    XcdBarrier bar; bar.bar = (unsigned*)(F.ctl + CW_BAR); bar.x = 0; bar.st = nullptr;
    if (args.use_bar) bar = xcd_barrier_post((unsigned*)(F.ctl + CW_BAR), F.MISC + 8);
#define GRID_BAR() do { if (args.use_bar) xcd_barrier(bar); } while (0)
    const int lo = args.ph_lo, hi = args.ph_hi;
#define IN(k) (lo <= (k) && (k) < hi)
#define BOTH(k) (IN(k) && IN((k) + 1))
    typedef pg8::StaticOrder SO;

    if (IN(0)) { p0_prologue(F); if (BOTH(0)) GRID_BAR(); }
    if (IN(1)) {
        { pg8::Gemm g{WSP(bf16, WS_XN), WSP(bf16, WS_WT_INA), DM}; SO S; S.init(T / 256, NA / 256, F.G, (int)blockIdx.x);
          pg8::EpiBf16 E{WSP(bf16, WS_PA), NA}; pg8::gemm_phase<pg8::EpiBf16, SO, true, true>(F.lds + RING_OFF, g, S, E); }
        { pg8::Gemm g{WSP(bf16, WS_MEMN), WSP(bf16, WS_WT_MEM), DM}; SO S; S.init(1, 8, F.G, (int)(F.G - 1 - blockIdx.x));
          pg8::EpiBf16 E{WSP(bf16, WS_MKV), 2048}; pg8::gemm_phase<pg8::EpiBf16, SO, true, true>(F.lds + RING_OFF, g, S, E); }
        if (BOTH(1)) GRID_BAR();
    }
    if (IN(2)) { p2_compress(F); p2_qknorm(F); if (BOTH(2)) GRID_BAR(); }
    if (IN(3)) { p3_nsa_naive(F); mem_attn_naive(F, WSP(bf16, WS_PA), NA, CA_QM, F.in[14], 0); if (BOTH(3)) GRID_BAR(); }
    if (IN(4)) { pg8::Gemm g{WSP(bf16, WS_MIX), WSP(bf16, WS_WT_OUT), DM}; SO S; S.init(T / 256, DM / 256, F.G, (int)blockIdx.x);
        pg8::EpiResF32 E{F.in[0], WSP(float, WS_X1), DM}; pg8::gemm_phase<pg8::EpiResF32, SO, true, true>(F.lds + RING_OFF, g, S, E); if (BOTH(4)) GRID_BAR(); }
    if (IN(5)) { rmsnorm_rows(F, WSP(float, WS_X1), WSP(bf16, WS_XN), T); if (BOTH(5)) GRID_BAR(); }
    if (IN(6)) { pg8::Gemm g{WSP(bf16, WS_XN), WSP(bf16, WS_WT_FGU), DM}; SO S; S.init(T / 256, 2 * FF / 256, F.G, (int)blockIdx.x);
        pg8::EpiSwiglu E{WSP(bf16, WS_HFF), FF}; pg8::gemm_phase<pg8::EpiSwiglu, SO, true, true>(F.lds + RING_OFF, g, S, E); if (BOTH(6)) GRID_BAR(); }
    if (IN(7)) { pg8::Gemm g{WSP(bf16, WS_HFF), WSP(bf16, WS_WT_FDN), FF}; SO S; S.init(T / 256, DM / 256, F.G, (int)blockIdx.x);
        pg8::EpiResF32 E{WSP(float, WS_X1), WSP(float, WS_X2), DM}; pg8::gemm_phase<pg8::EpiResF32, SO, true, true>(F.lds + RING_OFF, g, S, E); if (BOTH(7)) GRID_BAR(); }
    if (IN(8)) { rmsnorm_rows(F, WSP(float, WS_X2), WSP(bf16, WS_XN), T); if (BOTH(8)) GRID_BAR(); }
    if (IN(9)) { pg8::Gemm g{WSP(bf16, WS_XN), WSP(bf16, WS_WT_INB), DM}; SO S; S.init(T / 256, NB / 256, F.G, (int)blockIdx.x);
        pg8::EpiBf16 E{WSP(bf16, WS_PB), NB}; pg8::gemm_phase<pg8::EpiBf16, SO, true, true>(F.lds + RING_OFF, g, S, E); if (BOTH(9)) GRID_BAR(); }
    if (IN(10)) { stick_naive(F); mem_attn_naive(F, WSP(bf16, WS_PB), NB, CB_QM, F.in[14] + 2 * HD, 1); if (BOTH(10)) GRID_BAR(); }
    if (IN(11)) { pg8::Gemm g{WSP(bf16, WS_MIX), WSP(bf16, WS_WT_OUT) + (size_t)DM * DM, DM}; SO S; S.init(T / 256, DM / 256, F.G, (int)blockIdx.x);
        pg8::EpiResF32 E{WSP(float, WS_X2), WSP(float, WS_X3), DM}; pg8::gemm_phase<pg8::EpiResF32, SO, true, true>(F.lds + RING_OFF, g, S, E); if (BOTH(11)) GRID_BAR(); }
    if (IN(12)) { p12_router(F); if (BOTH(12)) GRID_BAR(); }
    if (IN(13)) { p13_assign(F); if (BOTH(13)) GRID_BAR(); }
    if (IN(14)) { const int* TILE = (const int*)(F.ws + WS_ROUTE + RT_TILE); const int ntl = TILE[0];
        pg8::Gemm g{WSP(bf16, WS_AMOE), WSP(bf16, WS_WT_MGU), DM}; pg8::MoeOrder S; S.init(ntl, 2 * FF / 256, F.G, (int)blockIdx.x); S.tile_e = TILE + 16; S.estride = (size_t)2 * FF * DM * 2;
        pg8::EpiSwiglu E{WSP(bf16, WS_HMOE), FF}; pg8::gemm_phase<pg8::EpiSwiglu, pg8::MoeOrder, true, true>(F.lds + RING_OFF, g, S, E); if (BOTH(14)) GRID_BAR(); }
    if (IN(15)) { const int* TILE = (const int*)(F.ws + WS_ROUTE + RT_TILE); const int ntl = TILE[0];
        pg8::Gemm g{WSP(bf16, WS_HMOE), WSP(bf16, WS_WT_MDN), FF}; pg8::MoeOrder S; S.init(ntl, DM / 256, F.G, (int)blockIdx.x); S.tile_e = TILE + 16; S.estride = (size_t)DM * FF * 2;
        pg8::EpiBf16 E{WSP(bf16, WS_YMOE), DM}; pg8::gemm_phase<pg8::EpiBf16, pg8::MoeOrder, true, true>(F.lds + RING_OFF, g, S, E); if (BOTH(15)) GRID_BAR(); }
    if (IN(16)) { p16_combine(F); }
#undef IN
#undef BOTH
}

#ifndef MK_ONE_LAUNCH
#define MK_ONE_LAUNCH 0
#endif
extern "C" void kernel_launch(void* const* d_in, const int* in_sizes, int n_in, void* d_out, int out_size, void* d_ws, size_t ws_size, hipStream_t stream) {
    static int grid = 0;
    if (grid == 0) {
        if (n_in != 22 || in_sizes[0] != T * DM || out_size != T * DM || ws_size < WS_END) { fprintf(stderr, "kernel_launch: unexpected shapes (n_in %d, in0 %d, out %d, ws %zu < %zu)\n", n_in, n_in > 0 ? in_sizes[0] : -1, out_size, ws_size, (size_t)WS_END); grid = -1; return; }
        int dev = 0, cus = 0, per_cu = 0;
        if (hipGetDevice(&dev) != hipSuccess || hipDeviceGetAttribute(&cus, hipDeviceAttributeMultiprocessorCount, dev) != hipSuccess) { grid = -1; return; }
        if (hipFuncSetAttribute((const void*)mk_fwd, hipFuncAttributeMaxDynamicSharedMemorySize, LDS_BYTES) != hipSuccess) { fprintf(stderr, "kernel_launch: hipFuncSetAttribute failed\n"); grid = -1; return; }
        if (hipOccupancyMaxActiveBlocksPerMultiprocessor(&per_cu, (const void*)mk_fwd, NWAVES * 64, LDS_BYTES) != hipSuccess || per_cu < 1) { fprintf(stderr, "kernel_launch: occupancy query says %d blocks per CU\n", per_cu); }
        (void)hipGetLastError();
        grid = cus;
    }
    if (grid < 0) return;
    if (hipMemsetAsync((char*)d_ws + WS_CTL, 0, CTL_ZERO_BYTES, stream) != hipSuccess) return;
    Args a{};
    for (int i = 0; i < 22; ++i) a.in[i] = (const float*)d_in[i];
    a.out = (float*)d_out; a.ws = (unsigned char*)d_ws; a.pad = 0;
#if MK_ONE_LAUNCH
    a.ph_lo = 0; a.ph_hi = N_PHASES; a.use_bar = 1;
    hipLaunchKernelGGL(mk_fwd, dim3(grid), dim3(NWAVES * 64), LDS_BYTES, stream, a);
#else
    for (int p = 0; p < N_PHASES; ++p) { a.ph_lo = p; a.ph_hi = p + 1; a.use_bar = 0;
        hipLaunchKernelGGL(mk_fwd, dim3(grid), dim3(NWAVES * 64), LDS_BYTES, stream, a); }
#endif
}
```

```cpp
#include <hip/hip_runtime.h>
#include <cstdio>
#include <cstdint>

namespace pg8 {
#define PG8_LAS __attribute__((address_space(3)))
typedef unsigned short bf16_t;
typedef short bf16x8 __attribute__((ext_vector_type(8)));
typedef float f32x4 __attribute__((ext_vector_type(4)));
typedef unsigned u32x4 __attribute__((ext_vector_type(4)));
constexpr int BM = 256, BK = 64, HALF = 128, HTB = HALF * BK * 2  , STAGE_BYTES = 8 * HTB, NXCD = 8, WGM = 8;

__host__ __device__ __forceinline__ int lds_byte(int r, int c) { const int st = (r >> 4) * 2 + (c >> 5), rr = r & 15, cc = c & 31, ob = rr * 64 + cc * 2; return st * 1024 + (ob ^ (((ob >> 9) & 1) << 5)); }
__host__ __device__ __forceinline__ void stage_rc(int b, int& R, int& C) { const int st = b / 1024, sb = b % 1024, swz = sb ^ (((sb >> 9) & 1) << 5); R = (st >> 1) * 16 + swz / 64; C = (st & 1) * 32 + (swz % 64) / 2; }
__host__ __device__ __forceinline__ int perm32(int rho) { const int n = rho >> 4, i = rho & 15; return 8 * (i >> 2) + 4 * n + (i & 3); }

struct Unit { int pm, pn; };
struct Gemm { const bf16_t* A; const bf16_t* Bt; int K; };

struct StaticOrder {
    int nM, nN, nwg, G, c;
    __device__ void init(int nM_, int nN_, int G_, int c_) { nM = nM_; nN = nN_; nwg = nM * nN; G = G_; c = c_; }
    __device__ bool next(int i, Unit& u) const {
        const long L = (long)i * G + c; if (L >= nwg) return false;
        int wgid = (int)L; { const int q = nwg / NXCD, r = nwg % NXCD, xcd = wgid % NXCD, off = wgid / NXCD; wgid = (xcd < r ? xcd * (q + 1) : r * (q + 1) + (xcd - r) * q) + off; }
        const int nig = WGM * nN, gid = wgid / nig, fm = gid * WGM, gsz = (nM - fm) < WGM ? (nM - fm) : WGM;
        u.pm = fm + ((wgid % nig) % gsz); u.pn = (wgid % nig) / gsz; return true;
    }
    __device__ __forceinline__ const char* a_base(const Gemm& g, const Unit& u) const { return (const char*)g.A + (size_t)u.pm * ((size_t)BM * g.K * 2); }
    __device__ __forceinline__ const char* b_base(const Gemm& g, const Unit& u) const { return (const char*)g.Bt + (size_t)u.pn * ((size_t)BM * g.K * 2); }
    __device__ __forceinline__ void a_ready(const Unit&) const {}
    __device__ __forceinline__ void done(const Unit&) const {}
};
struct MoeOrder : StaticOrder {
    const int* tile_e; size_t estride;
    __device__ __forceinline__ const char* b_base(const Gemm& g, const Unit& u) const { return (const char*)g.Bt + (size_t)tile_e[u.pm] * estride + (size_t)u.pn * ((size_t)BM * g.K * 2); }
};

__device__ __forceinline__ unsigned cvt_pk_bf16(float lo, float hi) { unsigned r; asm volatile("v_cvt_pk_bf16_f32 %0, %1, %2" : "=v"(r) : "v"(lo), "v"(hi)); return r; }

struct EpiBf16 {
    static constexpr bool PERM = true, AFTER_DRAIN = false;
    bf16_t* O; int ldc;
    __device__ __forceinline__ void operator()(const f32x4 (&acc)[2][2][4][2], const Unit& u, int wr, int wc, int fr, int fq) const {
        const int row0 = u.pm * BM + wr * 64 + fr, col0 = u.pn * BM + wc * 32 + 8 * fq;
#pragma unroll
        for (int ai = 0; ai < 2; ++ai)
#pragma unroll
            for (int m = 0; m < 4; ++m) { bf16_t* rowp = O + (size_t)(row0 + ai * HALF + m * 16) * ldc + col0;
#pragma unroll
                for (int bj = 0; bj < 2; ++bj) { const f32x4 v0 = acc[ai][bj][m][0], v1 = acc[ai][bj][m][1];
                    u32x4 w; w.x = cvt_pk_bf16(v0[0], v0[1]); w.y = cvt_pk_bf16(v0[2], v0[3]); w.z = cvt_pk_bf16(v1[0], v1[1]); w.w = cvt_pk_bf16(v1[2], v1[3]);
                    *(u32x4*)(rowp + bj * HALF) = w; } }
    }
};
struct EpiSwiglu {
    static constexpr bool PERM = true, AFTER_DRAIN = false;
    bf16_t* O; int ldc;
    __device__ __forceinline__ void operator()(const f32x4 (&acc)[2][2][4][2], const Unit& u, int wr, int wc, int fr, int fq) const {
        const int row0 = u.pm * BM + wr * 64 + fr, col0 = u.pn * HALF + wc * 32 + 8 * fq;
#pragma unroll
        for (int ai = 0; ai < 2; ++ai)
#pragma unroll
            for (int m = 0; m < 4; ++m) { bf16_t* rowp = O + (size_t)(row0 + ai * HALF + m * 16) * ldc + col0;
                float h[8];
#pragma unroll
                for (int n = 0; n < 2; ++n)
#pragma unroll
                    for (int j = 0; j < 4; ++j) { const float gq = acc[ai][0][m][n][j], uq = acc[ai][1][m][n][j];
                        const float sg = __builtin_amdgcn_rcpf(1.0f + __builtin_amdgcn_exp2f(-1.4426950408889634f * gq));
                        h[n * 4 + j] = gq * sg * uq; }
                u32x4 w; w.x = cvt_pk_bf16(h[0], h[1]); w.y = cvt_pk_bf16(h[2], h[3]); w.z = cvt_pk_bf16(h[4], h[5]); w.w = cvt_pk_bf16(h[6], h[7]);
                *(u32x4*)rowp = w; }
    }
};
struct EpiResF32 {
    static constexpr bool PERM = false, AFTER_DRAIN = false;
    const float* base; float* out; int ldc;
    __device__ __forceinline__ void operator()(const f32x4 (&acc)[2][2][4][2], const Unit& u, int wr, int wc, int fr, int fq) const {
        const int row0 = u.pm * BM + wr * 64 + fr, col0 = u.pn * BM + wc * 32 + 4 * fq;
#pragma unroll
        for (int ai = 0; ai < 2; ++ai)
#pragma unroll
            for (int m = 0; m < 4; ++m) { const size_t off = (size_t)(row0 + ai * HALF + m * 16) * ldc + col0;
#pragma unroll
                for (int bj = 0; bj < 2; ++bj)
#pragma unroll
                    for (int n = 0; n < 2; ++n) { const f32x4 b = *(const f32x4*)(base + off + bj * HALF + n * 16); *(f32x4*)(out + off + bj * HALF + n * 16) = b + acc[ai][bj][m][n]; } }
    }
};
template <class Epi, class Sched, bool ALIGN_EPI = false, bool SP2 = false>
__device__ __forceinline__ void gemm_phase(PG8_LAS unsigned char* lds, const Gemm g, const Sched& S, const Epi& E) {
    int tid = threadIdx.x; asm volatile("" : "+v"(tid));
    const int wid = __builtin_amdgcn_readfirstlane(tid >> 6), lane = tid & 63, wr = wid >> 2, wc = wid & 3, fr = lane & 15, fq = lane >> 4;
    const int K = g.K, nt = K / BK;
    unsigned voffA[2], voffB[2];
#pragma unroll
    for (int i = 0; i < 2; ++i) { int R, C; stage_rc(tid * 16 + i * 8192, R, C); const int Rb = Epi::PERM ? ((R & ~31) + perm32(R & 31)) : R;
        voffA[i] = (unsigned)(R * K + C) * 2u; voffB[i] = (unsigned)(Rb * K + C) * 2u; }
    const size_t kstep = (size_t)(BK * 2);
    const size_t hstep = (size_t)HALF * K * 2;
    const unsigned ldsw = (unsigned)wid * 1024u;
    const int aoff = lds_byte(wr * 64 + fr, fq * 8), boff = lds_byte(wc * 32 + fr, fq * 8);
#define PG8_SA(b, h) (((b) * 2 + (h)) * HTB)
#define PG8_SB(b, h) ((4 + (b) * 2 + (h)) * HTB)
#define PG8_STAGE(bufoff, gbase, voff) do { _Pragma("unroll") for (int _i = 0; _i < 2; ++_i) \
        __builtin_amdgcn_global_load_lds((const unsigned*)((const char*)(gbase) + (voff)[_i]), (PG8_LAS unsigned*)(lds + (bufoff) + ldsw + _i * 8192), 16, 0, 0); } while (0)
#define PG8_LDA(dst, b, h) do { _Pragma("unroll") for (int m = 0; m < 4; ++m) _Pragma("unroll") for (int k = 0; k < 2; ++k) dst[m][k] = *(const PG8_LAS bf16x8*)(lds + PG8_SA(b, h) + aoff + m * 2048 + k * 1024); } while (0)
#define PG8_LDB(dst, b, h) do { _Pragma("unroll") for (int n = 0; n < 2; ++n) _Pragma("unroll") for (int k = 0; k < 2; ++k) dst[n][k] = *(const PG8_LAS bf16x8*)(lds + PG8_SB(b, h) + boff + n * 2048 + k * 1024); } while (0)
#define PG8_MMA(ai, bj, At, Bt) do { __builtin_amdgcn_s_setprio(1); _Pragma("unroll") for (int m = 0; m < 4; ++m) _Pragma("unroll") for (int n = 0; n < 2; ++n) _Pragma("unroll") for (int k = 0; k < 2; ++k) \
        acc[ai][bj][m][n] = __builtin_amdgcn_mfma_f32_16x16x32_bf16(Bt[n][k], At[m][k], acc[ai][bj][m][n], 0, 0, 0); __builtin_amdgcn_s_setprio(0); } while (0)
#define PG8_WAIT_V(n) asm volatile("s_waitcnt vmcnt(" #n ")" ::: "memory")
#define PG8_WAIT_L(n) asm volatile("s_waitcnt lgkmcnt(" #n ")" ::: "memory")
#define PG8_BAR __builtin_amdgcn_s_barrier()
#define PG8_SCHED __builtin_amdgcn_sched_barrier(0)
    Unit cur, nxt; int ui = 0;
    if (!S.next(0, cur)) return;
    f32x4 acc[2][2][4][2];
#pragma unroll
    for (int a = 0; a < 2; ++a)
#pragma unroll
        for (int b = 0; b < 2; ++b)
#pragma unroll
            for (int m = 0; m < 4; ++m)
#pragma unroll
                for (int n = 0; n < 2; ++n) acc[a][b][m][n] = (f32x4){0.f, 0.f, 0.f, 0.f};
    bf16x8 At[4][2], B0[2][2], B1[2][2];
    const char* cA = S.a_base(g, cur); const char* cB = S.b_base(g, cur);
    S.a_ready(cur);
    if constexpr (SP2) {
        PG8_STAGE(PG8_SB(0, 0), cB, voffB); PG8_STAGE(PG8_SB(0, 1), cB + hstep, voffB); PG8_STAGE(PG8_SA(0, 0), cA, voffA); PG8_STAGE(PG8_SA(0, 1), cA + hstep, voffA);
        if (wr == 1) PG8_BAR;
        PG8_WAIT_V(2); PG8_BAR;
        PG8_STAGE(PG8_SB(1, 0), cB + kstep, voffB); PG8_STAGE(PG8_SA(1, 0), cA + kstep, voffA); PG8_STAGE(PG8_SB(1, 1), cB + hstep + kstep, voffB);
        PG8_WAIT_V(6); PG8_BAR;
    } else {
        PG8_STAGE(PG8_SB(0, 0), cB, voffB); PG8_STAGE(PG8_SA(0, 0), cA, voffA); PG8_STAGE(PG8_SB(0, 1), cB + hstep, voffB); PG8_STAGE(PG8_SA(0, 1), cA + hstep, voffA);
        if (wr == 1) PG8_BAR;
        PG8_WAIT_V(4); PG8_BAR;
        PG8_STAGE(PG8_SB(1, 0), cB + kstep, voffB); PG8_STAGE(PG8_SA(1, 0), cA + kstep, voffA); PG8_STAGE(PG8_SB(1, 1), cB + hstep + kstep, voffB);
        PG8_WAIT_V(6); PG8_BAR;
    }
    for (;;) {
        const bool has_next = S.next(ui + 1, nxt);
        const char* nA = has_next ? S.a_base(g, nxt) : cA; const char* nB = has_next ? S.b_base(g, nxt) : cB;
        for (int t = 0; t < nt; t += 2) {
            const bool last = (t == nt - 2);
            const char* a1 = cA + (size_t)(t + 1) * kstep;
            const char* a2 = last ? nA : cA + (size_t)(t + 2) * kstep; const char* b2 = last ? nB : cB + (size_t)(t + 2) * kstep;
            const char* a3 = a2 + kstep; const char* b3 = b2 + kstep;
            if (last && has_next) S.a_ready(nxt);
            if constexpr (SP2) {
            PG8_LDB(B0, 0, 0); PG8_LDB(B1, 0, 1); PG8_SCHED; PG8_LDA(At, 0, 0); PG8_STAGE(PG8_SA(1, 1), a1 + hstep, voffA);
            PG8_WAIT_V(8); PG8_WAIT_L(0); PG8_BAR; PG8_MMA(0, 0, At, B0); PG8_MMA(0, 1, At, B1); PG8_BAR; PG8_SCHED;
            PG8_LDA(At, 0, 1); PG8_STAGE(PG8_SB(0, 0), b2, voffB); PG8_STAGE(PG8_SB(0, 1), b2 + hstep, voffB); PG8_STAGE(PG8_SA(0, 0), a2, voffA);
            PG8_WAIT_V(8); PG8_WAIT_L(0); PG8_BAR; PG8_MMA(1, 0, At, B0); PG8_MMA(1, 1, At, B1); PG8_BAR; PG8_SCHED;
            PG8_LDB(B0, 1, 0); PG8_LDB(B1, 1, 1); PG8_SCHED; PG8_LDA(At, 1, 0); PG8_STAGE(PG8_SA(0, 1), a2 + hstep, voffA);
            PG8_WAIT_V(8); PG8_WAIT_L(0); PG8_BAR; PG8_MMA(0, 0, At, B0); PG8_MMA(0, 1, At, B1); PG8_BAR; PG8_SCHED;
            PG8_LDA(At, 1, 1); PG8_STAGE(PG8_SB(1, 0), b3, voffB); PG8_STAGE(PG8_SB(1, 1), b3 + hstep, voffB); PG8_STAGE(PG8_SA(1, 0), a3, voffA);
            PG8_WAIT_V(8); PG8_WAIT_L(0); PG8_BAR; PG8_MMA(1, 0, At, B0); PG8_MMA(1, 1, At, B1); PG8_BAR; PG8_SCHED;
            } else {
            PG8_LDB(B0, 0, 0); PG8_SCHED; PG8_LDA(At, 0, 0); PG8_STAGE(PG8_SA(1, 1), a1 + hstep, voffA);
            PG8_WAIT_L(8); PG8_BAR; PG8_WAIT_L(0); PG8_MMA(0, 0, At, B0); PG8_BAR; PG8_SCHED;
            PG8_LDB(B1, 0, 1); PG8_STAGE(PG8_SB(0, 0), b2, voffB);
            PG8_BAR; PG8_WAIT_L(0); PG8_MMA(0, 1, At, B1); PG8_BAR;
            PG8_LDA(At, 0, 1); PG8_STAGE(PG8_SA(0, 0), a2, voffA);
            PG8_BAR; PG8_WAIT_L(0); PG8_MMA(1, 0, At, B0); PG8_BAR; PG8_SCHED;
            PG8_STAGE(PG8_SB(0, 1), b2 + hstep, voffB);
            PG8_WAIT_V(6); PG8_BAR; PG8_MMA(1, 1, At, B1); PG8_BAR;
            PG8_LDB(B0, 1, 0); PG8_SCHED; PG8_LDA(At, 1, 0); PG8_STAGE(PG8_SA(0, 1), a2 + hstep, voffA);
            PG8_WAIT_L(8); PG8_BAR; PG8_WAIT_L(0); PG8_MMA(0, 0, At, B0); PG8_BAR; PG8_SCHED;
            PG8_LDB(B1, 1, 1); PG8_STAGE(PG8_SB(1, 0), b3, voffB);
            PG8_BAR; PG8_WAIT_L(0); PG8_MMA(0, 1, At, B1); PG8_BAR;
            PG8_LDA(At, 1, 1); PG8_STAGE(PG8_SA(1, 0), a3, voffA);
            PG8_BAR; PG8_WAIT_L(0); PG8_MMA(1, 0, At, B0); PG8_BAR; PG8_SCHED;
            PG8_STAGE(PG8_SB(1, 1), b3 + hstep, voffB);
            PG8_WAIT_V(6); PG8_BAR; PG8_MMA(1, 1, At, B1); PG8_BAR;
            }
        }
        if constexpr (ALIGN_EPI) { if (wr == 0) PG8_BAR; }
        if constexpr (!Epi::AFTER_DRAIN) { E(acc, cur, wr, wc, fr, fq); S.done(cur); }
        if (!has_next) break;
#pragma unroll
        for (int a = 0; a < 2; ++a)
#pragma unroll
            for (int b = 0; b < 2; ++b)
#pragma unroll
                for (int m = 0; m < 4; ++m)
#pragma unroll
                    for (int n = 0; n < 2; ++n) acc[a][b][m][n] = (f32x4){0.f, 0.f, 0.f, 0.f};
        cur = nxt; cA = nA; cB = nB; ++ui;
        if constexpr (ALIGN_EPI) { if (wr == 1) PG8_BAR; }
    }
    PG8_WAIT_V(0);
    if constexpr (!ALIGN_EPI) { if (wr == 0) PG8_BAR; }
    PG8_BAR;
    if constexpr (Epi::AFTER_DRAIN) { E.fused(acc, cur, wr, wc, fr, fq, lds, wid, lane); S.done(cur); }
#undef PG8_SA
#undef PG8_SB
#undef PG8_STAGE
#undef PG8_LDA
#undef PG8_LDB
#undef PG8_MMA
#undef PG8_WAIT_V
#undef PG8_WAIT_L
#undef PG8_BAR
#undef PG8_SCHED
}
}


constexpr int T = 8192, DM = 2048, HD = 128, NMIX = 12, NMEMH = 4, NG = 3, MEMT = 256, FF = 7168, NE = 8;
constexpr int A_IN_W = 4388, NA = 4608;
constexpr int NB = 5120;
constexpr int CA_Q = 0, CA_KC = 1536, CA_VC = 1920, CA_KS = 2304, CA_VS = 2688, CA_KW = 3072, CA_VW = 3456, CA_QM = 3840, CA_GT = 4352;
constexpr int CB_Q = 0, CB_QM = 1536, CB_K = 2048, CB_V = 3584;
constexpr int NCMP = 511, NCMP_P = 512;
constexpr int MOE_MAXT = 72;
constexpr float EPS = 1e-6f;
constexpr float QSCALE = 0.08838834764831845f;

constexpr size_t MiB = 1u << 20;
constexpr size_t WS_CTL = 0, CTL_ZERO_BYTES = 1 * MiB;
constexpr size_t WS_WT_INA = 2 * MiB;
constexpr size_t WS_WT_MEM = 20 * MiB;
constexpr size_t WS_WT_OUT = 28 * MiB;
constexpr size_t WS_WT_FGU = 44 * MiB;
constexpr size_t WS_WT_FDN = 100 * MiB;
constexpr size_t WS_WT_INB = 128 * MiB;
constexpr size_t WS_WT_MGU = 148 * MiB;
constexpr size_t WS_WT_MDN = 596 * MiB;
constexpr size_t WS_XN = 820 * MiB;
constexpr size_t WS_MEMN = 852 * MiB;
constexpr size_t WS_MKV = 853 * MiB;
constexpr size_t WS_PA = 854 * MiB;
constexpr size_t WS_KCMP = 926 * MiB;
constexpr size_t WS_MIX = 927 * MiB;
constexpr size_t WS_X1 = 959 * MiB;
constexpr size_t WS_X2 = 1023 * MiB;
constexpr size_t WS_X3 = 1087 * MiB;
constexpr size_t WS_HFF = 1151 * MiB;
constexpr size_t WS_PB = 1263 * MiB;
constexpr size_t WS_AMOE = 1343 * MiB;
constexpr size_t WS_HMOE = 1415 * MiB;
constexpr size_t WS_YMOE = 1667 * MiB;
constexpr size_t WS_ROUTE = 1739 * MiB;
constexpr size_t WS_END = 1740 * MiB;
constexpr size_t RT_TOPI = 0;
constexpr size_t RT_TOPW = 65536;
constexpr size_t RT_ROW = 131072;
constexpr size_t RT_HIST = 196608;
constexpr size_t RT_TILE = 204800;
constexpr int CW_TMO = 0, CW_CODE = 1, CW_BAR = 4096;

constexpr int RING_OFF = 0, RING_BYTES = 135168;
constexpr int LDSCTL_OFF = RING_BYTES, MISC_OFF = LDSCTL_OFF + 320;
constexpr int LDS_BYTES = 147456;
static_assert(MISC_OFF + 128 <= LDS_BYTES, "LDS map");
constexpr int NWAVES = 8;

#define GAS __attribute__((address_space(1)))
#define LAS __attribute__((address_space(3)))
typedef unsigned short bf16;
typedef unsigned v4u __attribute__((ext_vector_type(4)));
typedef unsigned v2u __attribute__((ext_vector_type(2)));
typedef float f32x4 __attribute__((ext_vector_type(4)));
typedef GAS unsigned gu32;
#define RLX_AGENT __ATOMIC_RELAXED, __HIP_MEMORY_SCOPE_AGENT
#define LDS_WAIT() asm volatile("s_waitcnt lgkmcnt(0)" ::: "memory")
#define VM_WAIT() asm volatile("s_waitcnt vmcnt(0)" ::: "memory")
__device__ __forceinline__ float bf2f(unsigned b) { return __uint_as_float(b << 16); }
__device__ __forceinline__ unsigned pk2(float lo, float hi) { return pg8::cvt_pk_bf16(lo, hi); }
__device__ __forceinline__ void unpack8(v4u w, float* f) {
    f[0] = __uint_as_float(w.x << 16); f[1] = __uint_as_float(w.x & 0xffff0000u); f[2] = __uint_as_float(w.y << 16); f[3] = __uint_as_float(w.y & 0xffff0000u);
    f[4] = __uint_as_float(w.z << 16); f[5] = __uint_as_float(w.z & 0xffff0000u); f[6] = __uint_as_float(w.w << 16); f[7] = __uint_as_float(w.w & 0xffff0000u); }
__device__ __forceinline__ float wave_sum(float v) {
#pragma unroll
    for (int o = 1; o < 64; o <<= 1) v += __shfl_xor(v, o);
    return v;
}
__device__ __forceinline__ float fast_exp(float x) { return __builtin_amdgcn_exp2f(x * 1.4426950408889634f); }

#define XB_TMO      128
#define XB_XCNT(j)  (256  + 64 * (j))
#define XB_XSUB(j)  (1280 + 64 * (j))
#define XB_XGEN(j)  (2304 + 64 * (j))
#define XB_TOP      3328
#define XB_TOPGEN   3392
#define XCD_BAR_WORDS 3456
#define XB_SPIN_CAP (1u << 18)
__device__ __forceinline__ unsigned xb_ld(unsigned* p)              { return __hip_atomic_load(p, __ATOMIC_RELAXED, __HIP_MEMORY_SCOPE_AGENT); }
__device__ __forceinline__ unsigned xb_add(unsigned* p, unsigned v) { return __hip_atomic_fetch_add(p, v, __ATOMIC_RELAXED, __HIP_MEMORY_SCOPE_AGENT); }
__device__ __forceinline__ unsigned xb_xcc_id() { return (unsigned)__builtin_amdgcn_s_getreg((3 << 11) | 20) & 0xFu; }
#define XB_SPIN(cond, bar) do { unsigned _sp = 0; while (cond) { __builtin_amdgcn_s_sleep(1); \
    if ((++_sp & 255u) == 0u) { if (xb_ld(&(bar)[XB_TMO])) break; if (_sp > XB_SPIN_CAP) { atomicAdd(&(bar)[XB_TMO], 1u); break; } } } } while (0)
struct XcdBarrier { unsigned* bar; unsigned x; volatile LAS unsigned* st; };
__device__ __forceinline__ XcdBarrier xcd_barrier_post(unsigned* bar, volatile LAS unsigned* st) {
    XcdBarrier b; b.bar = bar; b.x = xb_xcc_id(); b.st = st;
    if (threadIdx.x == 0) (void)xb_add(&bar[XB_XCNT(b.x)], 1u);
    return b;
}
__device__ __forceinline__ void xcd_barrier_complete(unsigned* bar, unsigned x, unsigned& nloc, unsigned& nx) {
    const unsigned G = gridDim.x * gridDim.y * gridDim.z;
    unsigned sum, cnt, mine, sp = 0u;
    for (;;) {
        sum = 0u; cnt = 0u; mine = 0u;
#pragma unroll
        for (unsigned j = 0; j < 16; ++j) { const unsigned c = xb_ld(&bar[XB_XCNT(j)]); sum += c; cnt += (c > 0u) ? 1u : 0u; mine = (j == x) ? c : mine; }
        if (sum == G) break;
        __builtin_amdgcn_s_sleep(1);
        if ((++sp & 255u) == 0u) { if (xb_ld(&bar[XB_TMO])) break; if (sp > XB_SPIN_CAP) { atomicAdd(&bar[XB_TMO], 1u); break; } }
    }
    nloc = mine > 0u ? mine : 1u; nx = cnt > 0u ? cnt : 1u;
}
__device__ __forceinline__ void xcd_barrier(const XcdBarrier& b) {
    asm volatile("s_waitcnt vmcnt(0)" ::: "memory");
    __syncthreads();
    if (threadIdx.x == 0) {
        unsigned* bar = b.bar;
        __builtin_amdgcn_s_waitcnt(0);
        unsigned nloc = b.st[0], nx = b.st[1];
        if (nloc == 0u) { xcd_barrier_complete(bar, b.x, nloc, nx); b.st[0] = nloc; b.st[1] = nx; }
        const unsigned old = xb_add(&bar[XB_XSUB(b.x)], 1u);
        const unsigned gen = old / nloc;
        if (old + 1u == (gen + 1u) * nloc) {
            __builtin_amdgcn_fence(__ATOMIC_RELEASE, "agent");
            asm volatile("s_waitcnt vmcnt(0)" ::: "memory");
            const unsigned og = xb_add(&bar[XB_TOP], 1u);
            const unsigned tg = og / nx;
            if (og + 1u == (tg + 1u) * nx) xb_add(&bar[XB_TOPGEN], 1u);
            else XB_SPIN(xb_ld(&bar[XB_TOPGEN]) == tg, bar);
            __builtin_amdgcn_fence(__ATOMIC_ACQUIRE, "agent");
            xb_add(&bar[XB_XGEN(b.x)], 1u);
            asm volatile("s_waitcnt vmcnt(0)" ::: "memory");
        } else {
            XB_SPIN(xb_ld(&bar[XB_XGEN(b.x)]) == gen, bar);
            __builtin_amdgcn_fence(__ATOMIC_ACQUIRE, "agent");
            asm volatile("s_waitcnt vmcnt(0)" ::: "memory");
        }
    }
    __syncthreads();
}

struct Frame {
    LAS unsigned char* lds;
    volatile LAS unsigned* MISC;
    gu32* ctl;
    int tid, lane, wave;
    int vcu, G;
    unsigned char* ws;
    const float* in[22];
    float* out;
};
#define WSP(T_, off) ((T_*)(F.ws + (off)))

__device__ __forceinline__ void conv_item(const float* __restrict__ W, int K, int Nsrc, bf16* __restrict__ WT, const float* __restrict__ gain,
                                          int kb, int nb, int mode, int delta, int nvalid, LAS float* scr, int lane) {
    const int k0 = kb * 64, n0 = nb * 64;
    int sc0;
    if (mode == 1) { const int j = n0 >> 8, r = n0 & 255; sc0 = (r < 128) ? 128 * j + r : 7168 + 128 * j + (r - 128); }
    else sc0 = n0 + delta;
    const int kr = lane >> 4, nc = (lane & 15) * 4;
    const bool ok = (n0 + nc) < nvalid;
#pragma unroll 4
    for (int i = 0; i < 16; ++i) {
        const int k = 4 * i + kr;
        f32x4 v = (f32x4){0.f, 0.f, 0.f, 0.f};
        if (ok) v = *(const f32x4*)(W + (size_t)(k0 + k) * Nsrc + sc0 + nc);
        if (gain) { const float gk = gain[k0 + k]; v = v * gk; }
        LAS float* s = scr + k * 65 + nc;
        s[0] = v[0]; s[1] = v[1]; s[2] = v[2]; s[3] = v[3];
    }
    LDS_WAIT(); asm volatile("" ::: "memory");
    const int c = lane & 7, nl = lane >> 3;
#pragma unroll
    for (int j = 0; j < 8; ++j) {
        const int n = nl + 8 * j; const LAS float* s = scr + (8 * c) * 65 + n;
        v4u o; o.x = pk2(s[0 * 65], s[1 * 65]); o.y = pk2(s[2 * 65], s[3 * 65]); o.z = pk2(s[4 * 65], s[5 * 65]); o.w = pk2(s[6 * 65], s[7 * 65]);
        *(v4u*)(WT + (size_t)(n0 + n) * K + k0 + 8 * c) = o;
    }
    LDS_WAIT(); asm volatile("" ::: "memory");
}
__device__ __forceinline__ void conv_matrix(Frame& F, const float* W, int K, int Nsrc, int Ndst, bf16* WT, const float* gain, int mode, int& base_item) {
    LAS float* scr = (LAS float*)(F.lds + RING_OFF + F.wave * 16640);
    const int gw = F.vcu * NWAVES + F.wave, NGW = F.G * NWAVES;
    const int nkb = K / 64, nnb = Ndst / 64, nitems = nkb * nnb;
    int first = (gw - (base_item % NGW) + NGW) % NGW;
    for (int it = first; it < nitems; it += NGW) {
        const int kb = it / nnb, nb = it % nnb;
        int delta = 0, nvalid = Ndst;
        if (mode == 2) {
            const int n0 = nb * 64;
            if (n0 < 3840) { delta = 0; } else if (n0 < 4352) { delta = 36; } else { delta = -512; nvalid = 4388; }
        }
        conv_item(W, K, Nsrc, WT, gain, kb, nb, mode == 1 ? 1 : 0, delta, nvalid, scr, F.lane);
    }
    base_item += nitems;
}
__device__ __forceinline__ float row_rstd_to_bf16(const float* xrow, bf16* orow, int lane) {
    const f32x4* xr = (const f32x4*)xrow + lane;
    f32x4 v[8]; float s = 0.f;
#pragma unroll
    for (int j = 0; j < 8; ++j) { v[j] = xr[64 * j]; s += (v[j].x * v[j].x + v[j].y * v[j].y) + (v[j].z * v[j].z + v[j].w * v[j].w); }
    const float rstd = 1.0f / sqrtf(wave_sum(s) * (1.f / DM) + EPS);
    v2u* o8 = (v2u*)orow + lane;
#pragma unroll
    for (int j = 0; j < 8; ++j) { v2u w; w.x = pk2(v[j].x * rstd, v[j].y * rstd); w.y = pk2(v[j].z * rstd, v[j].w * rstd); o8[64 * j] = w; }
    return rstd;
}
__device__ __forceinline__ void rmsnorm_rows(Frame& F, const float* X, bf16* XN, int rows) {
    const int gw = F.vcu * NWAVES + F.wave, NGW = F.G * NWAVES;
    for (int m = gw; m < rows; m += NGW) row_rstd_to_bf16(X + (size_t)m * DM, XN + (size_t)m * DM, F.lane);
}
__device__ __forceinline__ void p0_prologue(Frame& F) {
    int base = 0;
    conv_matrix(F, F.in[5], DM, A_IN_W, NA, WSP(bf16, WS_WT_INA), F.in[2], 2, base);
    conv_matrix(F, F.in[13], DM, 1024, 1024, WSP(bf16, WS_WT_MEM), F.in[3], 0, base);
    conv_matrix(F, F.in[13] + (size_t)DM * 1024, DM, 1024, 1024, WSP(bf16, WS_WT_MEM) + (size_t)1024 * DM, F.in[3] + DM, 0, base);
    conv_matrix(F, F.in[15], DM, DM, DM, WSP(bf16, WS_WT_OUT), nullptr, 0, base);
    conv_matrix(F, F.in[15] + (size_t)DM * DM, DM, DM, DM, WSP(bf16, WS_WT_OUT) + (size_t)DM * DM, nullptr, 0, base);
    conv_matrix(F, F.in[16], DM, 2 * FF, 2 * FF, WSP(bf16, WS_WT_FGU), F.in[4], 1, base);
    conv_matrix(F, F.in[17], FF, DM, DM, WSP(bf16, WS_WT_FDN), nullptr, 0, base);
    conv_matrix(F, F.in[10], DM, DM, DM, WSP(bf16, WS_WT_INB), F.in[2] + DM, 0, base);
    conv_matrix(F, F.in[12], DM, 3072, 3072, WSP(bf16, WS_WT_INB) + (size_t)2048 * DM, F.in[11], 0, base);
    for (int e = 0; e < NE; ++e) {
        conv_matrix(F, F.in[20] + (size_t)e * DM * 2 * FF, DM, 2 * FF, 2 * FF, WSP(bf16, WS_WT_MGU) + (size_t)e * 2 * FF * DM, F.in[4] + DM, 1, base);
        conv_matrix(F, F.in[21] + (size_t)e * FF * DM, FF, DM, DM, WSP(bf16, WS_WT_MDN) + (size_t)e * DM * FF, nullptr, 0, base);
    }
    rmsnorm_rows(F, F.in[0], WSP(bf16, WS_XN), T);
    rmsnorm_rows(F, F.in[1], WSP(bf16, WS_MEMN), MEMT);
}

__device__ __forceinline__ void p2_compress(Frame& F) {
    const bf16* PA = WSP(bf16, WS_PA);
    LAS float* red = (LAS float*)(F.lds + RING_OFF);
    const int n = F.tid & 127, kq = F.tid >> 7;
    const int nitems = 2 * NG * NCMP_P;
    for (int it = F.vcu; it < nitems; it += F.G) {
        const int kv = it / (NG * NCMP_P), g = (it / NCMP_P) % NG, j = it % NCMP_P;
        bf16* dst = WSP(bf16, WS_KCMP) + (size_t)kv * NG * NCMP_P * HD + ((size_t)g * NCMP_P + j) * HD;
        if (j >= NCMP) { if (F.tid < 128) dst[F.tid] = 0; continue; }
        const float* w = F.in[6] + (size_t)kv * 4096 * HD;
        const float* pos = F.in[7] + (size_t)kv * 4096;
        const int col = (kv ? CA_VC : CA_KC) + g * HD;
        float acc = 0.f;
        for (int k = kq * 1024; k < kq * 1024 + 1024; k += 8) {
            const int trow = 16 * j + (k >> 7), d = k & 127;
            const v4u xa = *(const v4u*)(PA + (size_t)trow * NA + col + d);
            float xf[8]; unpack8(xa, xf);
#pragma unroll
            for (int e = 0; e < 8; ++e) acc += (xf[e] + pos[k + e]) * w[(size_t)(k + e) * HD + n];
        }
        red[kq * 128 + n] = acc;
        __syncthreads();
        if (F.tid < 128) {
            float v = red[n] + red[128 + n] + red[256 + n] + red[384 + n];
            if (kv == 0) {
                float s = v * v;
                s = wave_sum(s);
                if (F.lane == 0) red[512 + F.wave] = s;
            }
            red[640 + n] = v;
        }
        __syncthreads();
        if (F.tid < 128) {
            float v = red[640 + n];
            if (kv == 0) { const float ss = red[512] + red[513]; v = v * (1.0f / sqrtf(ss * (1.f / HD) + EPS)) * F.in[9][n]; }
            dst[n] = (bf16)(pk2(v, v) & 0xffffu);
        }
        __syncthreads();
    }
}
__device__ __forceinline__ void norm_slot(bf16* p, const float* gain, int l16) {
    v4u w = *(const v4u*)(p + l16 * 8); float f[8]; unpack8(w, f);
    float s = 0.f;
#pragma unroll
    for (int e = 0; e < 8; ++e) s += f[e] * f[e];
    s += __shfl_xor(s, 1); s += __shfl_xor(s, 2); s += __shfl_xor(s, 4); s += __shfl_xor(s, 8);
    const float r = 1.0f / sqrtf(s * (1.f / HD) + EPS);
    const float* gp = gain + l16 * 8;
    v4u o; o.x = pk2(f[0] * r * gp[0], f[1] * r * gp[1]); o.y = pk2(f[2] * r * gp[2], f[3] * r * gp[3]); o.z = pk2(f[4] * r * gp[4], f[5] * r * gp[5]); o.w = pk2(f[6] * r * gp[6], f[7] * r * gp[7]);
    *(v4u*)(p + l16 * 8) = o;
}
__device__ __forceinline__ void p2_qknorm(Frame& F) {
    bf16* PA = WSP(bf16, WS_PA); bf16* MKV = WSP(bf16, WS_MKV);
    const int gs = (F.vcu * NWAVES + F.wave) * 4 + (F.lane >> 4), NS = F.G * NWAVES * 4, l16 = F.lane & 15;
    for (int s = gs; s < T * 18; s += NS) {
        const int t = s / 18, k = s % 18;
        int col; const float* gain;
        if (k < 12) { col = CA_Q + k * HD; gain = F.in[8]; }
        else if (k < 15) { col = CA_KS + (k - 12) * HD; gain = F.in[9] + HD; }
        else { col = CA_KW + (k - 15) * HD; gain = F.in[9] + 2 * HD; }
        norm_slot(PA + (size_t)t * NA + col, gain, l16);
    }
    for (int s = gs; s < MEMT * 8; s += NS) {
        const int m = s / 8, k = s % 8, l = k >> 2, h = k & 3;
        norm_slot(MKV + (size_t)m * 2048 + l * 1024 + h * HD, F.in[14] + (size_t)(l * 2 + 1) * HD, l16);
    }
}

__device__ __forceinline__ void ld32(const bf16* p, float* f) {
#pragma unroll
    for (int i = 0; i < 4; ++i) { const v4u w = *(const v4u*)(p + 8 * i); unpack8(w, f + 8 * i); }
}
__device__ __forceinline__ float dot32q(const float* q, const bf16* kp) {
    float kf[32]; ld32(kp, kf); float s = 0.f;
#pragma unroll
    for (int i = 0; i < 32; ++i) s += q[i] * kf[i];
    s += __shfl_xor(s, 1); s += __shfl_xor(s, 2);
    return s;
}
__device__ __forceinline__ void axpy32(float* o, float p, const bf16* vp) {
    float vf[32]; ld32(vp, vf);
#pragma unroll
    for (int i = 0; i < 32; ++i) o[i] += p * vf[i];
}
__device__ __forceinline__ void st32(bf16* p, const float* f) {
#pragma unroll
    for (int i = 0; i < 4; ++i) { v4u w; w.x = pk2(f[8 * i], f[8 * i + 1]); w.y = pk2(f[8 * i + 2], f[8 * i + 3]); w.z = pk2(f[8 * i + 4], f[8 * i + 5]); w.w = pk2(f[8 * i + 6], f[8 * i + 7]); *(v4u*)(p + 8 * i) = w; }
}
#define OSM_STEP(s_, valid_, vptr_) do { if (valid_) { const float mn_ = fmaxf(m, (s_)); const float al_ = fast_exp(m - mn_); const float pp_ = fast_exp((s_) - mn_); \
        l = l * al_ + pp_; _Pragma("unroll") for (int i_ = 0; i_ < 32; ++i_) o[i_] *= al_; axpy32(o, pp_, (vptr_)); m = mn_; } } while (0)

__device__ __forceinline__ void p3_nsa_naive(Frame& F) {
    const bf16* PA = WSP(bf16, WS_PA); const bf16* KC = WSP(bf16, WS_KCMP); const bf16* VC = KC + (size_t)NG * NCMP_P * HD; bf16* MIX = WSP(bf16, WS_MIX);
    LAS float* IMP = (LAS float*)(F.lds + RING_OFF + F.wave * 4096);
    LAS unsigned long long* SELW = (LAS unsigned long long*)(F.lds + RING_OFF + F.wave * 4096 + 2048);
    const int gw = F.vcu * NWAVES + F.wave, NGW = F.G * NWAVES;
    const int dq = F.lane & 3, p = (F.lane >> 2) & 3, ql = F.lane >> 4;
    for (int it = gw; it < NG * (T / 4); it += NGW) {
        const int g = it / (T / 4), tq = it % (T / 4), t = 4 * tq + ql, head = g * 4 + p;
        const float slope = exp2f(-8.0f * (float)(head + 1) / 12.0f);
        float q[32]; ld32(PA + (size_t)t * NA + CA_Q + head * HD + dq * 32, q);
#pragma unroll
        for (int i = 0; i < 32; ++i) q[i] *= QSCALE;
        const float g0 = 1.0f / (1.0f + fast_exp(-bf2f(PA[(size_t)t * NA + CA_GT + head * 3 + 0])));
        const float g1 = 1.0f / (1.0f + fast_exp(-bf2f(PA[(size_t)t * NA + CA_GT + head * 3 + 1])));
        const float g2 = 1.0f / (1.0f + fast_exp(-bf2f(PA[(size_t)t * NA + CA_GT + head * 3 + 2])));
        float otot[32];
#pragma unroll
        for (int i = 0; i < 32; ++i) otot[i] = 0.f;
        for (int i = F.lane; i < 512; i += 64) IMP[i] = 0.f;
        LDS_WAIT(); asm volatile("" ::: "memory");
        const int jmax = (t >= 31) ? (t - 31) / 16 : -1;
        const int jmax_w = (4 * tq + 3 >= 31) ? (4 * tq + 3 - 31) / 16 : -1;
        const bf16* kcg = KC + (size_t)g * NCMP_P * HD + dq * 32; const bf16* vcg = VC + (size_t)g * NCMP_P * HD + dq * 32;
        {
            float m = -1e30f, l = 0.f;
            for (int j = 0; j <= jmax_w; ++j) {
                const float s = dot32q(q, kcg + (size_t)j * HD) - slope * (float)(t - (16 * j + 31));
                if (j <= jmax) { const float mn = fmaxf(m, s); l = l * fast_exp(m - mn) + fast_exp(s - mn); m = mn; }
            }
            const float rl = (l > 0.f) ? 1.0f / l : 0.f;
            float o[32];
#pragma unroll
            for (int i = 0; i < 32; ++i) o[i] = 0.f;
            for (int j = 0; j <= jmax_w; ++j) {
                const float s = dot32q(q, kcg + (size_t)j * HD) - slope * (float)(t - (16 * j + 31));
                const float pj = (j <= jmax) ? fast_exp(s - m) * rl : 0.f;
                axpy32(o, pj, vcg + (size_t)j * HD);
                float ps = pj; ps += __shfl_xor(ps, 4); ps += __shfl_xor(ps, 8);
                if (dq == 0 && p == 0) { IMP[ql * 128 + (j >> 2)] += ps; if ((j & 3) == 3 && (j >> 2) + 1 < 128) IMP[ql * 128 + (j >> 2) + 1] += ps; }
            }
#pragma unroll
            for (int i = 0; i < 32; ++i) otot[i] += g0 * o[i];
        }
        LDS_WAIT(); asm volatile("" ::: "memory");
        for (int qq = 0; qq < 4; ++qq) {
            const int tt = 4 * tq + qq, cur = tt >> 6;
            const int b0 = F.lane, b1 = F.lane + 64;
            const float s0 = (b0 == cur) ? 2e6f : (b0 == 0 ? 1e6f : (b0 * 64 <= tt ? IMP[qq * 128 + b0] : -1e6f));
            const float s1 = (b1 == cur) ? 2e6f : (b1 * 64 <= tt ? IMP[qq * 128 + b1] : -1e6f);
            int r0 = 0, r1 = 0;
            for (int b = 0; b < 128; ++b) {
                const float sb = (b == cur) ? 2e6f : (b == 0 ? 1e6f : (b * 64 <= tt ? IMP[qq * 128 + b] : -1e6f));
                r0 += (sb > s0 || (sb == s0 && b < b0)) ? 1 : 0;
                r1 += (sb > s1 || (sb == s1 && b < b1)) ? 1 : 0;
            }
            const unsigned long long m0 = __ballot(r0 < 16 && b0 * 64 <= tt), m1 = __ballot(r1 < 16 && b1 * 64 <= tt);
            if (F.lane == 0) { SELW[qq * 2] = m0; SELW[qq * 2 + 1] = m1; }
        }
        LDS_WAIT(); asm volatile("" ::: "memory");
        {
            const unsigned long long my0 = SELW[ql * 2], my1 = SELW[ql * 2 + 1];
            const unsigned long long u0v = SELW[0] | SELW[2] | SELW[4] | SELW[6], u1v = SELW[1] | SELW[3] | SELW[5] | SELW[7];
            const unsigned long long u0 = ((unsigned long long)(unsigned)__builtin_amdgcn_readfirstlane((int)(u0v >> 32)) << 32) | (unsigned)__builtin_amdgcn_readfirstlane((int)(unsigned)u0v);
            const unsigned long long u1 = ((unsigned long long)(unsigned)__builtin_amdgcn_readfirstlane((int)(u1v >> 32)) << 32) | (unsigned)__builtin_amdgcn_readfirstlane((int)(unsigned)u1v);
            float m = -1e30f, l = 0.f, o[32];
#pragma unroll
            for (int i = 0; i < 32; ++i) o[i] = 0.f;
            const bf16* kg = PA + CA_KS + g * HD + dq * 32; const bf16* vg = PA + CA_VS + g * HD + dq * 32;
            for (int b = 0; b < 128; ++b) {
                const bool inu = (b < 64) ? ((u0 >> b) & 1ull) : ((u1 >> (b - 64)) & 1ull);
                if (!inu) continue;
                const bool mine = (b < 64) ? ((my0 >> b) & 1ull) : ((my1 >> (b - 64)) & 1ull);
                for (int k = 0; k < 64; ++k) {
                    const int kp = b * 64 + k;
                    const float s = dot32q(q, kg + (size_t)kp * NA) - slope * (float)(t - kp);
                    const bool valid = mine && kp <= t;
                    OSM_STEP(s, valid, vg + (size_t)kp * NA);
                }
            }
            const float sc = (l > 0.f) ? g1 / l : 0.f;
#pragma unroll
            for (int i = 0; i < 32; ++i) otot[i] += sc * o[i];
        }
        {
            float m = -1e30f, l = 0.f, o[32];
#pragma unroll
            for (int i = 0; i < 32; ++i) o[i] = 0.f;
            const bf16* kg = PA + CA_KW + g * HD + dq * 32; const bf16* vg = PA + CA_VW + g * HD + dq * 32;
            const int klo = (4 * tq - 511 > 0) ? 4 * tq - 511 : 0, khi = 4 * tq + 3;
            for (int kp = klo; kp <= khi; ++kp) {
                const float s = dot32q(q, kg + (size_t)kp * NA) - slope * (float)(t - kp);
                const bool valid = kp <= t && (t - kp) < 512;
                OSM_STEP(s, valid, vg + (size_t)kp * NA);
            }
            const float sc = (l > 0.f) ? g2 / l : 0.f;
#pragma unroll
            for (int i = 0; i < 32; ++i) otot[i] += sc * o[i];
        }
        st32(MIX + (size_t)t * DM + head * HD + dq * 32, otot);
    }
}
__device__ __forceinline__ void mem_attn_naive(Frame& F, const bf16* P, int ldp, int qcol, const float* qg, int layer) {
    const bf16* MKV = WSP(bf16, WS_MKV); bf16* MIX = WSP(bf16, WS_MIX);
    const int gw = F.vcu * NWAVES + F.wave, NGW = F.G * NWAVES;
    const int dq = F.lane & 3, r = F.lane >> 2;
    for (int it = gw; it < NMEMH * (T / 16); it += NGW) {
        const int hm = it / (T / 16), t = 16 * (it % (T / 16)) + r;
        float q[32]; ld32(P + (size_t)t * ldp + qcol + hm * HD + dq * 32, q);
        float ss = 0.f;
#pragma unroll
        for (int i = 0; i < 32; ++i) ss += q[i] * q[i];
        ss += __shfl_xor(ss, 1); ss += __shfl_xor(ss, 2);
        const float rs = (1.0f / sqrtf(ss * (1.f / HD) + EPS)) * QSCALE;
#pragma unroll
        for (int i = 0; i < 32; ++i) q[i] = q[i] * rs * qg[dq * 32 + i];
        float m = -1e30f, l = 0.f, o[32];
#pragma unroll
        for (int i = 0; i < 32; ++i) o[i] = 0.f;
        const bf16* kg = MKV + layer * 1024 + hm * HD + dq * 32; const bf16* vg = kg + 512;
        for (int k = 0; k < MEMT; ++k) {
            const float s = dot32q(q, kg + (size_t)k * 2048);
            OSM_STEP(s, true, vg + (size_t)k * 2048);
        }
        const float sc = 1.0f / l;
#pragma unroll
        for (int i = 0; i < 32; ++i) o[i] *= sc;
        st32(MIX + (size_t)t * DM + NMIX * HD + hm * HD + dq * 32, o);
    }
}
__device__ __forceinline__ void stick_naive(Frame& F) {
    const bf16* PB = WSP(bf16, WS_PB); bf16* MIX = WSP(bf16, WS_MIX);
    const int gw = F.vcu * NWAVES + F.wave, NGW = F.G * NWAVES;
    const int dq = F.lane & 3, r = F.lane >> 2;
    for (int it = gw; it < NMIX * (T / 16); it += NGW) {
        const int h = it / (T / 16), t = 16 * (it % (T / 16)) + r;
        float q[32]; ld32(PB + (size_t)t * NB + CB_Q + h * HD + dq * 32, q);
#pragma unroll
        for (int i = 0; i < 32; ++i) q[i] *= QSCALE;
        float R = 0.f, o[32];
#pragma unroll
        for (int i = 0; i < 32; ++i) o[i] = 0.f;
        const bf16* kg = PB + CB_K + h * HD + dq * 32; const bf16* vg = PB + CB_V + h * HD + dq * 32;
        for (int i = 1; ; ++i) {
            const int s = t - i;
            const bool act = s >= 0 && R > -80.f;
            if (!__any(act)) break;
            const int sc = s >= 0 ? s : 0;
            const float z = dot32q(q, kg + (size_t)sc * NB);
            const float sp = fmaxf(z, 0.f) + __logf(1.0f + fast_exp(-fabsf(z)));
            if (act) { const float a = fast_exp(z - sp + R); axpy32(o, a, vg + (size_t)sc * NB); R -= sp; }
        }
        st32(MIX + (size_t)t * DM + h * HD + dq * 32, o);
    }
}

__device__ __forceinline__ void p12_router(Frame& F) {
    const float* X3 = WSP(float, WS_X3); bf16* XN = WSP(bf16, WS_XN);
    int* TOPI = (int*)(F.ws + WS_ROUTE + RT_TOPI); float* TOPW = (float*)(F.ws + WS_ROUTE + RT_TOPW); int* HIST = (int*)(F.ws + WS_ROUTE + RT_HIST);
    const float* rw = F.in[18]; const float* rb = F.in[19]; const float* gn = F.in[4] + DM;
    LAS int* hist = (LAS int*)(F.lds + RING_OFF);
    for (int c = F.vcu; c < 256; c += F.G) {
        if (F.tid < 8) hist[F.tid] = 0;
        __syncthreads();
        for (int i = 0; i < 4; ++i) {
            const int t = 32 * c + 4 * F.wave + i;
            const f32x4* xr = (const f32x4*)(X3 + (size_t)t * DM) + F.lane;
            f32x4 v[8]; float s = 0.f;
#pragma unroll
            for (int j = 0; j < 8; ++j) { v[j] = xr[64 * j]; s += (v[j].x * v[j].x + v[j].y * v[j].y) + (v[j].z * v[j].z + v[j].w * v[j].w); }
            const float rstd = 1.0f / sqrtf(wave_sum(s) * (1.f / DM) + EPS);
            v2u* o8 = (v2u*)(XN + (size_t)t * DM) + F.lane;
            float lg[8];
#pragma unroll
            for (int e = 0; e < 8; ++e) lg[e] = 0.f;
#pragma unroll
            for (int j = 0; j < 8; ++j) {
                v2u w; w.x = pk2(v[j].x * rstd, v[j].y * rstd); w.y = pk2(v[j].z * rstd, v[j].w * rstd); o8[64 * j] = w;
                const int k0 = 4 * (F.lane + 64 * j);
#pragma unroll
                for (int e4 = 0; e4 < 4; ++e4) {
                    const float xg = v[j][e4] * gn[k0 + e4];
                    const f32x4 ra = *(const f32x4*)(rw + (size_t)(k0 + e4) * 8), rb4 = *(const f32x4*)(rw + (size_t)(k0 + e4) * 8 + 4);
                    lg[0] += xg * ra.x; lg[1] += xg * ra.y; lg[2] += xg * ra.z; lg[3] += xg * ra.w; lg[4] += xg * rb4.x; lg[5] += xg * rb4.y; lg[6] += xg * rb4.z; lg[7] += xg * rb4.w;
                }
            }
#pragma unroll
            for (int e = 0; e < 8; ++e) lg[e] = wave_sum(lg[e]) * rstd;
            if (F.lane == 0) {
                int i0 = 0; float b0 = lg[0] + rb[0];
#pragma unroll
                for (int e = 1; e < 8; ++e) { const float b = lg[e] + rb[e]; if (b > b0) { b0 = b; i0 = e; } }
                int i1 = -1; float b1 = -3.0e38f;
#pragma unroll
                for (int e = 0; e < 8; ++e) { const float b = lg[e] + rb[e]; if (e != i0 && b > b1) { b1 = b; i1 = e; } }
                float l0 = 0.f, l1 = 0.f;
#pragma unroll
                for (int e = 0; e < 8; ++e) { l0 = (e == i0) ? lg[e] : l0; l1 = (e == i1) ? lg[e] : l1; }
                const float w0 = 1.0f / (1.0f + expf(l1 - l0));
                TOPI[2 * t] = i0; TOPI[2 * t + 1] = i1; TOPW[2 * t] = w0; TOPW[2 * t + 1] = 1.0f - w0;
                atomicAdd((int*)&hist[i0], 1); atomicAdd((int*)&hist[i1], 1);
            }
        }
        __syncthreads();
        if (F.tid < 8) HIST[c * 8 + F.tid] = hist[F.tid];
        __syncthreads();
    }
}
__device__ __forceinline__ void p13_assign(Frame& F) {
    const bf16* XN = WSP(bf16, WS_XN); bf16* AM = WSP(bf16, WS_AMOE);
    const int* TOPI = (const int*)(F.ws + WS_ROUTE + RT_TOPI); int* ROW = (int*)(F.ws + WS_ROUTE + RT_ROW); const int* HIST = (const int*)(F.ws + WS_ROUTE + RT_HIST);
    int* TILE = (int*)(F.ws + WS_ROUTE + RT_TILE);
    LAS int* sh = (LAS int*)(F.lds + RING_OFF);
    for (int c = F.vcu; c < 256; c += F.G) {
        if (F.tid < 16) sh[16 + F.tid] = 0;
        __syncthreads();
        for (int i = F.tid; i < 2048; i += 512) { const int v = HIST[i], cc = i >> 3, ee = i & 7;
            __hip_atomic_fetch_add(&sh[16 + ee], v, __ATOMIC_RELAXED, __HIP_MEMORY_SCOPE_WORKGROUP);
            if (cc < c) __hip_atomic_fetch_add(&sh[24 + ee], v, __ATOMIC_RELAXED, __HIP_MEMORY_SCOPE_WORKGROUP); }
        __syncthreads();
        if (F.tid < 8) {
            const int e = F.tid; int off = 0;
            for (int ee = 0; ee < 8; ++ee) { if (ee == e) break; off += (sh[16 + ee] + 255) & ~255; }
            sh[e] = off + sh[24 + e];
            if (c == 0 && e == 0) {
                int nt = 0;
                for (int ee = 0; ee < 8; ++ee) { const int n = (sh[16 + ee] + 255) >> 8; for (int i = 0; i < n; ++i) TILE[16 + nt + i] = ee; nt += n; }
                TILE[0] = nt;
            }
        }
        __syncthreads();
        if (F.wave == 0) {
            const int tl = F.lane >> 1, sl = F.lane & 1, t = 32 * c + tl;
            const int e = TOPI[2 * t + sl];
            int row = 0;
            for (int ee = 0; ee < 8; ++ee) {
                const unsigned long long mk = __ballot(e == ee);
                if (e == ee) row = sh[ee] + __popcll(mk & ((1ull << F.lane) - 1ull));
            }
            ROW[2 * t + sl] = row; sh[64 + F.lane] = row;
        }
        __syncthreads();
        for (int i = 0; i < 8; ++i) {
            const int idx = 8 * F.wave + i, t = 32 * c + (idx >> 1), row = sh[64 + idx];
            const v4u* src = (const v4u*)(XN + (size_t)t * DM); v4u* dst = (v4u*)(AM + (size_t)row * DM);
#pragma unroll
            for (int j = 0; j < 4; ++j) dst[F.lane + 64 * j] = src[F.lane + 64 * j];
        }
        __syncthreads();
    }
}
__device__ __forceinline__ void p16_combine(Frame& F) {
    const float* X3 = WSP(float, WS_X3); const bf16* Y = WSP(bf16, WS_YMOE);
    const int* ROW = (const int*)(F.ws + WS_ROUTE + RT_ROW); const float* TOPW = (const float*)(F.ws + WS_ROUTE + RT_TOPW);
    const int gw = F.vcu * NWAVES + F.wave, NGW = F.G * NWAVES;
    for (int t = gw; t < T; t += NGW) {
        const int r0 = ROW[2 * t], r1 = ROW[2 * t + 1]; const float w0 = TOPW[2 * t], w1 = TOPW[2 * t + 1];
        const v4u* y0 = (const v4u*)(Y + (size_t)r0 * DM); const v4u* y1 = (const v4u*)(Y + (size_t)r1 * DM);
        const f32x4* xr = (const f32x4*)(X3 + (size_t)t * DM); f32x4* orow = (f32x4*)(F.out + (size_t)t * DM);
#pragma unroll
        for (int j = 0; j < 4; ++j) {
            const int c8 = F.lane + 64 * j;
            float a[8], b[8]; unpack8(y0[c8], a); unpack8(y1[c8], b);
            const f32x4 xa = xr[2 * c8], xb = xr[2 * c8 + 1];
            orow[2 * c8] = (f32x4){xa.x + w0 * a[0] + w1 * b[0], xa.y + w0 * a[1] + w1 * b[1], xa.z + w0 * a[2] + w1 * b[2], xa.w + w0 * a[3] + w1 * b[3]};
            orow[2 * c8 + 1] = (f32x4){xb.x + w0 * a[4] + w1 * b[4], xb.y + w0 * a[5] + w1 * b[5], xb.z + w0 * a[6] + w1 * b[6], xb.w + w0 * a[7] + w1 * b[7]};
        }
    }
}

namespace at {
typedef short bf16x8 __attribute__((ext_vector_type(8)));
typedef short s16x4 __attribute__((ext_vector_type(4)));
typedef float f32x16 __attribute__((ext_vector_type(16)));
constexpr int SHM_T = 16384;
constexpr int L_V = 0, L_K = 2 * SHM_T, L_WS = 4 * SHM_T, L_IMP = L_WS + 8 * 256, L_SEL = L_IMP + 64 * 128 * 4, L_PS = L_SEL + 1024, L_WU = L_PS + 8 * 2176, L_LIST = L_WU + 128, L_DONE = L_LIST + 512, L_END = L_DONE + 64;
static_assert(L_END <= RING_BYTES, "attention LDS map");
constexpr float C2 = 0.08838834764831845f * 1.4426950408889634f;
constexpr float LOG2E = 1.4426950408889634f;

#define KSWZ(row, colB) ((row) * 256 + ((colB) ^ (((row) & 7) << 4)))
#define SBAR() __builtin_amdgcn_sched_barrier(0)
__device__ __forceinline__ int v_st(int k, int c) { const int kk = (k & ~0xC) | ((k & 4) << 1) | ((k & 8) >> 1); return ((kk >> 3) * 4 + (c >> 5)) * 512 + ((kk & 7) * 32 + (c & 31)) * 2; }
__device__ __forceinline__ int v_rd_base(int lane) { return ((lane & 3) << 3) | (((lane >> 2) & 3) << 6) | (((lane >> 4) & 1) << 5) | (((lane >> 5) & 1) << 8); }
constexpr int v_rd_off(int d0, int ks, int half) { return d0 * 512 + ks * 4096 + half * 2048; }
__device__ __forceinline__ int crow(int r, int hi) { return (r & 3) + 8 * (r >> 2) + 4 * hi; }
__device__ __forceinline__ unsigned cvtpk(float lo, float hi) { unsigned r; asm volatile("v_cvt_pk_bf16_f32 %0, %1, %2" : "=v"(r) : "v"(lo), "v"(hi)); return r; }
__device__ __forceinline__ float xhalf_max(float v) { auto rr = __builtin_amdgcn_permlane32_swap(__float_as_uint(v), __float_as_uint(v), false, false); return fmaxf(__uint_as_float(rr[0]), __uint_as_float(rr[1])); }
__device__ __forceinline__ float xhalf_sum(float v) { auto rr = __builtin_amdgcn_permlane32_swap(__float_as_uint(v), __float_as_uint(v), false, false); return __uint_as_float(rr[0]) + __uint_as_float(rr[1]); }
__device__ __forceinline__ float quad_sum(float x) {
    x += __int_as_float(__builtin_amdgcn_update_dpp(0, __float_as_int(x), 0xB1, 0xF, 0xF, true));
    x += __int_as_float(__builtin_amdgcn_update_dpp(0, __float_as_int(x), 0x4E, 0xF, 0xF, true));
    return x;
}
__device__ __forceinline__ void pack_p(const f32x16& p0, const f32x16& p1, bf16x8& pa0, bf16x8& pa1, bf16x8& pa2, bf16x8& pa3) {
#define PK4(P, B_, OUT) do { unsigned a0 = cvtpk(P[B_+0], P[B_+1]), a1 = cvtpk(P[B_+2], P[B_+3]);                          \
        unsigned b0 = cvtpk(P[B_+4], P[B_+5]), b1 = cvtpk(P[B_+6], P[B_+7]);                                             \
        auto r0 = __builtin_amdgcn_permlane32_swap(a0, b0, false, false); auto r1 = __builtin_amdgcn_permlane32_swap(a1, b1, false, false); \
        v4u w = {r0[0], r1[0], r0[1], r1[1]}; OUT = *reinterpret_cast<bf16x8*>(&w); } while (0)
    PK4(p0, 0, pa0); PK4(p0, 8, pa1); PK4(p1, 0, pa2); PK4(p1, 8, pa3);
#undef PK4
}
template <int KB>
__device__ __forceinline__ void qkt(f32x16& p0, f32x16& p1, LAS unsigned char* lds, int r32, int hi, const bf16x8* qr) {
    p0 = f32x16{}; p1 = f32x16{};
    LAS unsigned char* kb[4];
#pragma unroll
    for (int dd = 0; dd < 4; ++dd) kb[dd] = lds + L_K + KB * SHM_T + KSWZ(r32, (dd * 16 + hi * 8) * 2);
#pragma unroll
    for (int d0 = 0; d0 < 8; ++d0) { LAS unsigned char* a = kb[d0 & 3] + (d0 >> 2) * 128;
        const bf16x8 b0 = *(const LAS bf16x8*)a;
        const bf16x8 b1 = *(const LAS bf16x8*)(a + 32 * 256);
        p0 = __builtin_amdgcn_mfma_f32_32x32x16_bf16(b0, qr[d0], p0, 0, 0, 0);
        p1 = __builtin_amdgcn_mfma_f32_32x32x16_bf16(b1, qr[d0], p1, 0, 0, 0); }
}
template <int VB>
__device__ __forceinline__ void pv_tile(f32x16* o, int vb0, bf16x8 pa0, bf16x8 pa1, bf16x8 pa2, bf16x8 pa3) {
#define TRRD(dst, off) asm volatile("ds_read_b64_tr_b16 %0, %1 offset:%2" : "=&v"(dst) : "v"(vb0), "i"(off) : "memory")
#define PV_D0(d0) do { s16x4 l0, l1, l2, l3, h0, h1, h2, h3; constexpr int b_ = VB * SHM_T + v_rd_off(d0, 0, 0); \
        TRRD(l0, b_); TRRD(h0, b_ + 2048); TRRD(l1, b_ + 4096); TRRD(h1, b_ + 6144); TRRD(l2, b_ + 8192); TRRD(h2, b_ + 10240); TRRD(l3, b_ + 12288); TRRD(h3, b_ + 14336); \
        asm volatile("s_waitcnt lgkmcnt(0)" ::: "memory"); SBAR();   \
        o[d0] = __builtin_amdgcn_mfma_f32_32x32x16_bf16(pa0, (bf16x8){l0[0], l0[1], l0[2], l0[3], h0[0], h0[1], h0[2], h0[3]}, o[d0], 0, 0, 0);   \
        o[d0] = __builtin_amdgcn_mfma_f32_32x32x16_bf16(pa1, (bf16x8){l1[0], l1[1], l1[2], l1[3], h1[0], h1[1], h1[2], h1[3]}, o[d0], 0, 0, 0);   \
        o[d0] = __builtin_amdgcn_mfma_f32_32x32x16_bf16(pa2, (bf16x8){l2[0], l2[1], l2[2], l2[3], h2[0], h2[1], h2[2], h2[3]}, o[d0], 0, 0, 0);   \
        o[d0] = __builtin_amdgcn_mfma_f32_32x32x16_bf16(pa3, (bf16x8){l3[0], l3[1], l3[2], l3[3], h3[0], h3[1], h3[2], h3[3]}, o[d0], 0, 0, 0); } while (0)
    PV_D0(0); PV_D0(1); PV_D0(2); PV_D0(3);
#undef PV_D0
#undef TRRD
}
struct Stg { v4u a, b; };
struct Tile { const bf16* K; const bf16* V; size_t ld; };
__device__ __forceinline__ void stg_load(Stg& S, const bf16* base, size_t ld, int sr, int sc) {
    S.a = *(const v4u*)(base + (size_t)sr * ld + sc); S.b = *(const v4u*)(base + (size_t)(32 + sr) * ld + sc);
}
template <int BUF> __device__ __forceinline__ void stg_write_k(const Stg& S, LAS unsigned char* lds, int sr, int sc) {
    const int kws = KSWZ(sr, sc * 2);
    *(LAS v4u*)(lds + L_K + BUF * SHM_T + kws) = S.a; *(LAS v4u*)(lds + L_K + BUF * SHM_T + kws + 32 * 256) = S.b;
}
template <int BUF> __device__ __forceinline__ void stg_write_v(const Stg& S, LAS unsigned char* lds, int sr, int sc) {
    *(LAS v4u*)(lds + L_V + BUF * SHM_T + v_st(sr, sc)) = S.a; *(LAS v4u*)(lds + L_V + BUF * SHM_T + v_st(32 + sr, sc)) = S.b;
}

template <int PASS, int KB, class Br>
__device__ __forceinline__ void step(Br& br, int i, Stg& S, LAS unsigned char* lds, int tid, const bf16x8* qr, float& m2, float& l, float f, f32x16* o) {
    int tz = tid; asm volatile("" : "+v"(tz));
    const int lane = tz & 63, sr = tz >> 4, sc = (tz & 15) * 8, r32 = lane & 31, hi = lane >> 5;
    const int vb0 = (int)(uintptr_t)(lds + L_V) + v_rd_base(lane);
    const bool more = (i + 1 < br.nt);
    Tile nx = br.tile(more ? i + 1 : i);
    if (more) stg_load(S, nx.K, nx.ld, sr, sc);
    SBAR();
    if (br.act(i)) {
        f32x16 p0, p1;
        qkt<KB>(p0, p1, lds, r32, hi, qr);
        SBAR();
        br.scores(p0, p1, i, lane);
        if (PASS == 1) {
            float pmax = p0[0];
#pragma unroll
            for (int r = 1; r < 16; ++r) pmax = fmaxf(pmax, p0[r]);
#pragma unroll
            for (int r = 0; r < 16; ++r) pmax = fmaxf(pmax, p1[r]);
            pmax = xhalf_max(pmax);
            const float mn = fmaxf(m2, pmax);
            float ps = 0.f;
#pragma unroll
            for (int r = 0; r < 16; ++r) ps += __builtin_amdgcn_exp2f(p0[r] - mn) + __builtin_amdgcn_exp2f(p1[r] - mn);
            ps = xhalf_sum(ps);
            l = l * __builtin_amdgcn_exp2f(m2 - mn) + ps; m2 = mn;
        } else {
#pragma unroll
            for (int r = 0; r < 16; ++r) { p0[r] = __builtin_amdgcn_exp2f(p0[r] - m2) * f; p1[r] = __builtin_amdgcn_exp2f(p1[r] - m2) * f; }
            br.hook(p0, p1, i, lane);
            SBAR();
            if (more) { stg_write_k<KB ^ 1>(S, lds, sr, sc); SBAR(); stg_load(S, nx.V, nx.ld, sr, sc); SBAR(); }
            bf16x8 pa0, pa1, pa2, pa3; pack_p(p0, p1, pa0, pa1, pa2, pa3);
            SBAR();
            pv_tile<KB>(o, vb0, pa0, pa1, pa2, pa3);
            SBAR();
            if (more) stg_write_v<KB ^ 1>(S, lds, sr, sc);
        }
    } else if (PASS == 2) { if (more) { stg_write_k<KB ^ 1>(S, lds, sr, sc); SBAR(); stg_load(S, nx.V, nx.ld, sr, sc); SBAR(); stg_write_v<KB ^ 1>(S, lds, sr, sc); } }
    SBAR();
    if (PASS == 1) { if (more) stg_write_k<KB ^ 1>(S, lds, sr, sc); }
    __syncthreads();
}
template <int PASS, class Br>
__device__ __forceinline__ void run_pass(Br& br, LAS unsigned char* lds, int tid, const bf16x8* qr, float& m2, float& l, float f, f32x16* o) {
    if (br.nt <= 0) return;
    const int sr = tid >> 4, sc = (tid & 15) * 8;
    Stg S;
    { const Tile t0 = br.tile(0); stg_load(S, t0.K, t0.ld, sr, sc); stg_write_k<0>(S, lds, sr, sc);
      if (PASS == 2) { stg_load(S, t0.V, t0.ld, sr, sc); stg_write_v<0>(S, lds, sr, sc); } }
    __syncthreads();
    for (int i = 0; i < br.nt; i += 2) {
        step<PASS, 0>(br, i, S, lds, tid, qr, m2, l, f, o);
        if (i + 1 < br.nt) step<PASS, 1>(br, i + 1, S, lds, tid, qr, m2, l, f, o);
    }
}
__device__ __forceinline__ void scale_rows(f32x16* o, float frow, LAS float* ws, int lane) {
    const int r32 = lane & 31, hi = lane >> 5;
    if (hi == 0) ws[r32] = frow;
    LDS_WAIT(); asm volatile("" ::: "memory");
#pragma unroll
    for (int r = 0; r < 16; ++r) { const float a = ws[crow(r, hi)];
#pragma unroll
        for (int d0 = 0; d0 < 4; ++d0) o[d0][r] *= a; }
    LDS_WAIT(); asm volatile("" ::: "memory");
}
__device__ __forceinline__ void load_q(bf16x8* qr, const bf16* qrow, int hi) {
#pragma unroll
    for (int d0 = 0; d0 < 8; ++d0) { const v4u w = *(const v4u*)(qrow + d0 * 16 + hi * 8); qr[d0] = *reinterpret_cast<const bf16x8*>(&w); }
}

struct RowNsa { int t; float slope2; };
struct BrCmp {
    int nt; const bf16* K; const bf16* V; int jmax_w; RowNsa R;
    LAS float* ps; LAS float* imp;
    __device__ __forceinline__ Tile tile(int i) const { return Tile{K + (size_t)i * 64 * HD, V + (size_t)i * 64 * HD, (size_t)HD}; }
    __device__ __forceinline__ bool act(int i) const { return 64 * i <= jmax_w; }
    __device__ __forceinline__ void scores(f32x16& p0, f32x16& p1, int i, int lane) const {
        const float NEG = -__builtin_inff(); const int hi = lane >> 5;
        float sl = R.slope2; asm volatile("" : "+v"(sl));
        int tt = R.t; asm volatile("" : "+v"(tt));
        const int jmax = (tt >= 31) ? ((tt - 31) >> 4) : -1;
        const int jm = jmax - 64 * i - 4 * hi;
        const float b0 = -sl * (float)(tt - 31 - 16 * (64 * i + 4 * hi));
#pragma unroll
        for (int r = 0; r < 16; ++r) { const int c = (r & 3) + 8 * (r >> 2);
            p0[r] = (c <= jm) ? fmaf(p0[r], C2, fmaf(sl, (float)(16 * c), b0)) : NEG;
            p1[r] = (c + 32 <= jm) ? fmaf(p1[r], C2, fmaf(sl, (float)(16 * c + 512), b0)) : NEG; }
    }
    __device__ __forceinline__ void hook(const f32x16& p0, const f32x16& p1, int i, int lane) const {
        const int r32 = lane & 31, hi = lane >> 5, pp = r32 & 3, ql = r32 >> 2;
#pragma unroll
        for (int qd = 0; qd < 4; ++qd) {
            f32x4 a, b;
#pragma unroll
            for (int e = 0; e < 4; ++e) { a[e] = quad_sum(p0[4 * qd + e]); b[e] = quad_sum(p1[4 * qd + e]); }
            if (pp == qd) { *(LAS f32x4*)(ps + ql * 68 + 4 + 8 * qd + 4 * hi) = a; *(LAS f32x4*)(ps + ql * 68 + 4 + 32 + 8 * qd + 4 * hi) = b; }
        }
        LDS_WAIT(); asm volatile("" ::: "memory");
#pragma unroll
        for (int h2 = 0; h2 < 2; ++h2) { const int idx = lane + 64 * h2, q8 = idx >> 4, mq = idx & 15;
            const f32x4 v = *(const LAS f32x4*)(ps + q8 * 68 + 4 + 4 * mq); const float pv = ps[q8 * 68 + 3 + 4 * mq];
            imp[q8 * 128 + 16 * i + mq] = (v[0] + v[1]) + (v[2] + v[3]) + pv; }
        LDS_WAIT(); asm volatile("" ::: "memory");
        if (lane < 8) ps[lane * 68 + 3] = ps[lane * 68 + 4 + 63];
        LDS_WAIT(); asm volatile("" ::: "memory");
    }
};
struct BrSlc {
    int nt; const bf16* K; const bf16* V; RowNsa R;
    const LAS int* list; const LAS unsigned long long* sel; const LAS unsigned long long* wu;
    __device__ __forceinline__ int blk(int i) const { return list[i]; }
    __device__ __forceinline__ Tile tile(int i) const { const int b = __builtin_amdgcn_readfirstlane(blk(i)); return Tile{K + (size_t)b * 64 * NA, V + (size_t)b * 64 * NA, (size_t)NA}; }
    __device__ __forceinline__ bool act(int i) const { const int b = __builtin_amdgcn_readfirstlane(blk(i)); const unsigned long long u = wu[b >> 6]; return (u >> (b & 63)) & 1ull; }
    __device__ __forceinline__ void scores(f32x16& p0, f32x16& p1, int i, int lane) const {
        const float NEG = -__builtin_inff(); const int b = __builtin_amdgcn_readfirstlane(blk(i)); const int hi = lane >> 5, ql = (lane & 31) >> 2;
        const unsigned long long mm = sel[ql * 2 + (b >> 6)];
        const bool mine = (mm >> (b & 63)) & 1ull;
        float sl = R.slope2; asm volatile("" : "+v"(sl));
        int tt = R.t; asm volatile("" : "+v"(tt));
        const int dm = mine ? (tt - 64 * b - 4 * hi) : -1;
        const float b0 = -sl * (float)dm;
#pragma unroll
        for (int r = 0; r < 16; ++r) { const int c = (r & 3) + 8 * (r >> 2);
            p0[r] = (c <= dm) ? fmaf(p0[r], C2, fmaf(sl, (float)c, b0)) : NEG;
            p1[r] = (c + 32 <= dm) ? fmaf(p1[r], C2, fmaf(sl, (float)(c + 32), b0)) : NEG; }
    }
    __device__ __forceinline__ void hook(const f32x16&, const f32x16&, int, int) const {}
};
struct BrWin {
    int nt; const bf16* K; const bf16* V; RowNsa R; int kb0;
    __device__ __forceinline__ Tile tile(int i) const { return Tile{K + (size_t)(kb0 + i) * 64 * NA, V + (size_t)(kb0 + i) * 64 * NA, (size_t)NA}; }
    __device__ __forceinline__ bool act(int) const { return true; }
    __device__ __forceinline__ void scores(f32x16& p0, f32x16& p1, int i, int lane) const {
        const float NEG = -__builtin_inff(); const int hi = lane >> 5;
        float sl = R.slope2; asm volatile("" : "+v"(sl));
        int tt = R.t; asm volatile("" : "+v"(tt));
        const int dm = tt - 64 * (kb0 + i) - 4 * hi;
        const float b0 = -sl * (float)dm;
#pragma unroll
        for (int r = 0; r < 16; ++r) { const int c = (r & 3) + 8 * (r >> 2);
            p0[r] = ((unsigned)(dm - c) < 512u) ? fmaf(p0[r], C2, fmaf(sl, (float)c, b0)) : NEG;
            p1[r] = ((unsigned)(dm - c - 32) < 512u) ? fmaf(p1[r], C2, fmaf(sl, (float)(c + 32), b0)) : NEG; }
    }
    __device__ __forceinline__ void hook(const f32x16&, const f32x16&, int, int) const {}
};
struct BrMem {
    int nt; const bf16* K; const bf16* V;
    __device__ __forceinline__ Tile tile(int i) const { return Tile{K + (size_t)i * 64 * 2048, V + (size_t)i * 64 * 2048, (size_t)2048}; }
    __device__ __forceinline__ bool act(int) const { return true; }
    __device__ __forceinline__ void scores(f32x16& p0, f32x16& p1, int, int) const {
#pragma unroll
        for (int r = 0; r < 16; ++r) { p0[r] *= C2; p1[r] *= C2; }
    }
    __device__ __forceinline__ void hook(const f32x16&, const f32x16&, int, int) const {}
};
template <class RP> __device__ __forceinline__ void store_o(const f32x16* o, int lane, RP rowptr) {
    const int r32 = lane & 31, hi = lane >> 5;
#pragma unroll
    for (int r = 0; r < 16; ++r) { bf16* rp = rowptr(crow(r, hi));
#pragma unroll
        for (int d0 = 0; d0 < 4; ++d0) { const float v = o[d0][r]; const float vn = __shfl_xor(v, 1);
            if ((r32 & 1) == 0) *(unsigned*)(rp + d0 * 32 + r32) = cvtpk(v, vn); } }
}
}

__device__ __forceinline__ void topk_select(unsigned k0, unsigned k1, int need, int lane, unsigned long long& s0, unsigned long long& s1) {
    unsigned thr = 0u;
    for (int bit = 31; bit >= 0; --bit) {
        const unsigned cand = thr | (1u << bit);
        const int cnt = __popcll(__ballot(k0 >= cand)) + __popcll(__ballot(k1 >= cand));
        if (cnt >= need) thr = cand;
    }
    const unsigned long long g0 = __ballot(k0 > thr), g1 = __ballot(k1 > thr), e0 = __ballot(k0 == thr && thr != 0u), e1 = __ballot(k1 == thr && thr != 0u);
    const int rem = need - (__popcll(g0) + __popcll(g1));
    const unsigned long long lt = (1ull << lane) - 1ull;
    const bool t0 = (k0 == thr && thr != 0u) && (__popcll(e0 & lt) < rem);
    const bool t1 = (k1 == thr && thr != 0u) && (__popcll(e0) + __popcll(e1 & lt) < rem);
    s0 = g0 | __ballot(t0); s1 = g1 | __ballot(t1);
}

__device__ __forceinline__ void nsa_item(Frame& F, int g, int qb) {
    using namespace at;
    LAS unsigned char* lds = F.lds + RING_OFF;
    const bf16* PA = WSP(bf16, WS_PA); const bf16* KC = WSP(bf16, WS_KCMP) + (size_t)g * NCMP_P * HD; const bf16* VC = KC + (size_t)NG * NCMP_P * HD; bf16* MIX = WSP(bf16, WS_MIX);
    int tz = F.tid; asm volatile("" : "+v"(tz));
    const int lane = tz & 63, w = F.wave, r32 = lane & 31, hi = lane >> 5;
    const int t0 = 64 * qb, tw = t0 + 8 * w, ql = r32 >> 2, pp = r32 & 3, t = tw + ql, head = 4 * g + pp;
    LAS float* ws = (LAS float*)(lds + L_WS + w * 256);
    LAS float* IMP = (LAS float*)(lds + L_IMP) + w * 8 * 128;
    LAS float* PS = (LAS float*)(lds + L_PS + w * 2176);
    LAS unsigned long long* SEL = (LAS unsigned long long*)(lds + L_SEL);
    LAS unsigned long long* WU = (LAS unsigned long long*)(lds + L_WU);
    LAS int* LIST = (LAS int*)(lds + L_LIST);
    RowNsa R; R.t = t; R.slope2 = exp2f(-8.0f * (float)(head + 1) / 12.0f) * LOG2E;
    bf16x8 qr[8]; load_q(qr, PA + (size_t)t * NA + CA_Q + head * HD, hi);
#define GATE(br_) (1.0f / (1.0f + fast_exp(-bf2f(PA[(size_t)t * NA + CA_GT + head * 3 + (br_)]))))
    f32x16 o[4] = {};
    for (int i = lane; i < 8 * 128; i += 64) IMP[i] = 0.f;
    if (lane < 8) PS[lane * 68 + 3] = 0.f;
    LDS_WAIT(); asm volatile("" ::: "memory");
    {
        BrCmp br; br.K = KC; br.V = VC; br.R = R; br.ps = PS; br.imp = IMP;
        br.jmax_w = (tw + 7 >= 31) ? (tw + 7 - 31) / 16 : -1;
        const int jmax_b = (t0 + 63 - 31) / 16;
        br.nt = jmax_b / 64 + 1;
        float m2 = -1e30f, l = 0.f;
        run_pass<1>(br, lds, tz, qr, m2, l, 0.f, o);
        const float f = (l > 0.f) ? 1.0f / l : 0.f;
        run_pass<2>(br, lds, tz, qr, m2, l, f, o);
        scale_rows(o, GATE(0), ws, lane);
    }
    for (int qq = 0; qq < 8; ++qq) {
        const int tt = tw + qq, cur = tt >> 6;
        const int b0 = lane, b1 = lane + 64;
        unsigned long long s0 = 0ull, s1 = 0ull;
        const int ncand = cur - 1;
        const bool c0 = (b0 >= 1 && b0 < cur), c1 = (b1 < cur);
        if (ncand <= 14) { s0 = __ballot(c0); s1 = __ballot(c1); }
        else {
            const unsigned k0 = c0 ? (__float_as_uint(IMP[qq * 128 + b0]) + 1u) : 0u, k1 = c1 ? (__float_as_uint(IMP[qq * 128 + b1]) + 1u) : 0u;
            topk_select(k0, k1, 14, lane, s0, s1);
        }
        s0 |= 1ull;
        if (cur < 64) s0 |= (1ull << cur); else s1 |= (1ull << (cur - 64));
        if (lane == 0) { SEL[(8 * w + qq) * 2] = s0; SEL[(8 * w + qq) * 2 + 1] = s1; }
    }
    LDS_WAIT(); asm volatile("" ::: "memory");
    unsigned long long wu0 = 0ull, wu1 = 0ull;
#pragma unroll
    for (int qq = 0; qq < 8; ++qq) { wu0 |= SEL[(8 * w + qq) * 2]; wu1 |= SEL[(8 * w + qq) * 2 + 1]; }
    if (lane == 0) { WU[2 * w] = wu0; WU[2 * w + 1] = wu1; }
    __syncthreads();
    int nsl = 0;
    {
        unsigned long long u0 = 0ull, u1 = 0ull;
#pragma unroll
        for (int ww = 0; ww < 8; ++ww) { u0 |= WU[2 * ww]; u1 |= WU[2 * ww + 1]; }
        nsl = __popcll(u0) + __popcll(u1);
        if (w == 0) {
            const unsigned long long lt = (1ull << lane) - 1ull;
            if ((u0 >> lane) & 1ull) LIST[__popcll(u0 & lt)] = lane;
            if ((u1 >> lane) & 1ull) LIST[__popcll(u0) + __popcll(u1 & lt)] = lane + 64;
        }
    }
    __syncthreads();
    {
        BrSlc br; br.K = PA + CA_KS + g * HD; br.V = PA + CA_VS + g * HD; br.R = R; br.list = LIST; br.nt = nsl;
        br.sel = SEL + 16 * w; br.wu = WU + 2 * w;
        float m2 = -1e30f, l = 0.f;
        run_pass<1>(br, lds, tz, qr, m2, l, 0.f, o);
        const float f = (l > 0.f) ? GATE(1) / l : 0.f;
        run_pass<2>(br, lds, tz, qr, m2, l, f, o);
    }
    {
        BrWin br; br.K = PA + CA_KW + g * HD; br.V = PA + CA_VW + g * HD; br.R = R;
        br.kb0 = (t0 - 511 > 0) ? ((t0 - 511) >> 6) : 0; br.nt = qb - br.kb0 + 1;
        float m2 = -1e30f, l = 0.f;
        run_pass<1>(br, lds, tz, qr, m2, l, 0.f, o);
        const float f = (l > 0.f) ? GATE(2) / l : 0.f;
        run_pass<2>(br, lds, tz, qr, m2, l, f, o);
    }
    store_o(o, lane, [&](int row) { return MIX + (size_t)(tw + (row >> 2)) * DM + (4 * g + (row & 3)) * HD; });
#undef GATE
}
__device__ __forceinline__ void mem_item(Frame& F, const bf16* P, int ldp, int qcol, const float* qg, int layer, int hm, int qb) {
    using namespace at;
    LAS unsigned char* lds = F.lds + RING_OFF;
    const bf16* MKV = WSP(bf16, WS_MKV); bf16* MIX = WSP(bf16, WS_MIX);
    int tz = F.tid; asm volatile("" : "+v"(tz));
    const int lane = tz & 63, w = F.wave, r32 = lane & 31, hi = lane >> 5;
    const int tw = 256 * qb + 32 * w, t = tw + r32;
    bf16x8 qr[8];
    {
        const bf16* qrow = P + (size_t)t * ldp + qcol + hm * HD;
        float qf[64]; float ss = 0.f;
#pragma unroll
        for (int d0 = 0; d0 < 8; ++d0) { const v4u wv = *(const v4u*)(qrow + d0 * 16 + hi * 8); unpack8(wv, qf + 8 * d0); }
#pragma unroll
        for (int i = 0; i < 64; ++i) ss += qf[i] * qf[i];
        ss = xhalf_sum(ss);
        const float rs = 1.0f / sqrtf(ss * (1.f / HD) + EPS);
#pragma unroll
        for (int d0 = 0; d0 < 8; ++d0) { const float* gp = qg + d0 * 16 + hi * 8;
            v4u wv; wv.x = cvtpk(qf[8 * d0] * rs * gp[0], qf[8 * d0 + 1] * rs * gp[1]); wv.y = cvtpk(qf[8 * d0 + 2] * rs * gp[2], qf[8 * d0 + 3] * rs * gp[3]);
            wv.z = cvtpk(qf[8 * d0 + 4] * rs * gp[4], qf[8 * d0 + 5] * rs * gp[5]); wv.w = cvtpk(qf[8 * d0 + 6] * rs * gp[6], qf[8 * d0 + 7] * rs * gp[7]);
            qr[d0] = *reinterpret_cast<const bf16x8*>(&wv); }
    }
    f32x16 o[4] = {};
    BrMem br; br.nt = 4; br.K = MKV + layer * 1024 + hm * HD; br.V = br.K + 512;
    float m2 = -1e30f, l = 0.f;
    run_pass<1>(br, lds, tz, qr, m2, l, 0.f, o);
    run_pass<2>(br, lds, tz, qr, m2, l, 1.0f / l, o);
    store_o(o, lane, [&](int row) { return MIX + (size_t)(tw + row) * DM + NMIX * HD + hm * HD; });
}
__device__ __forceinline__ void p3_attn(Frame& F) {
    for (int it = F.vcu; it < 384 + 128; it += F.G) {
        if (it < 384) { const int g = it % 3, qb = 127 - it / 3; nsa_item(F, g, qb); }
        else { const int j = it - 384; mem_item(F, WSP(bf16, WS_PA), NA, CA_QM, F.in[14], 0, j & 3, j >> 2); }
        __syncthreads();
    }
}

__device__ __forceinline__ void stick_tile(at::f32x16& p0, at::f32x16& p1, int k0, int t, int hi, float& R2) {
    using namespace at;
    float L0[16], L1[16];
    const float NEG = -__builtin_inff();
#pragma unroll
    for (int r = 0; r < 16; ++r) {
        const int kk = k0 + crow(r, hi);
        { const float z = p0[r] * C2; const float sp = fmaxf(z, 0.f) + __builtin_amdgcn_logf(1.0f + __builtin_amdgcn_exp2f(-fabsf(z))); const bool v = kk < t; L0[r] = v ? -sp : 0.f; p0[r] = v ? z - sp : NEG; }
        { const float z = p1[r] * C2; const float sp = fmaxf(z, 0.f) + __builtin_amdgcn_logf(1.0f + __builtin_amdgcn_exp2f(-fabsf(z))); const bool v = kk + 32 < t; L1[r] = v ? -sp : 0.f; p1[r] = v ? z - sp : NEG; }
    }
    float ct[8], pt[8];
#pragma unroll
    for (int c = 0; c < 4; ++c) { ct[c] = (L0[4 * c] + L0[4 * c + 1]) + (L0[4 * c + 2] + L0[4 * c + 3]); ct[4 + c] = (L1[4 * c] + L1[4 * c + 1]) + (L1[4 * c + 2] + L1[4 * c + 3]); }
#pragma unroll
    for (int c = 0; c < 8; ++c) { auto rr = __builtin_amdgcn_permlane32_swap(__float_as_uint(ct[c]), __float_as_uint(ct[c]), false, false); pt[c] = __uint_as_float(hi ? rr[0] : rr[1]); }
    float E[8]; float run = 0.f;
#pragma unroll
    for (int c = 7; c >= 0; --c) { E[c] = run + (hi == 0 ? pt[c] : 0.f); run += ct[c] + pt[c]; }
#pragma unroll
    for (int c = 0; c < 4; ++c) {
        { const float a3 = R2 + E[c], a2 = a3 + L0[4 * c + 3], a1 = a2 + L0[4 * c + 2], a0 = a1 + L0[4 * c + 1];
          p0[4 * c + 3] = __builtin_amdgcn_exp2f(p0[4 * c + 3] + a3); p0[4 * c + 2] = __builtin_amdgcn_exp2f(p0[4 * c + 2] + a2); p0[4 * c + 1] = __builtin_amdgcn_exp2f(p0[4 * c + 1] + a1); p0[4 * c] = __builtin_amdgcn_exp2f(p0[4 * c] + a0); }
        { const float a3 = R2 + E[4 + c], a2 = a3 + L1[4 * c + 3], a1 = a2 + L1[4 * c + 2], a0 = a1 + L1[4 * c + 1];
          p1[4 * c + 3] = __builtin_amdgcn_exp2f(p1[4 * c + 3] + a3); p1[4 * c + 2] = __builtin_amdgcn_exp2f(p1[4 * c + 2] + a2); p1[4 * c + 1] = __builtin_amdgcn_exp2f(p1[4 * c + 1] + a1); p1[4 * c] = __builtin_amdgcn_exp2f(p1[4 * c] + a0); }
    }
    R2 += run;
}
template <int KB>
__device__ __forceinline__ bool stick_step(int kb, int kb_w, at::Stg& S, LAS unsigned char* lds, int tid, const bf16* Kh, const bf16* Vh, const at::bf16x8* qr, at::f32x16* o, int tw, float& R2, LAS int* DONE) {
    using namespace at;
    int tz = tid; asm volatile("" : "+v"(tz));
    const int lane = tz & 63, w = __builtin_amdgcn_readfirstlane(tz >> 6), r32 = lane & 31, hi = lane >> 5, sr = tz >> 4, sc = (tz & 15) * 8;
    const int vb0 = (int)(uintptr_t)(lds + L_V) + v_rd_base(lane);
    int t = tw + r32; asm volatile("" : "+v"(t));
    const float THR2 = -100.f;
    const bool more = kb > 0;
    const bf16* Kn = Kh + (size_t)(more ? kb - 1 : kb) * 64 * NB; const bf16* Vn = Vh + (size_t)(more ? kb - 1 : kb) * 64 * NB;
    if (more) stg_load(S, Kn, NB, sr, sc);
    SBAR();
    bool wdone = false, kdone = false;
    if (kb <= kb_w) {
        if (__any(R2 > THR2)) {
            f32x16 p0, p1; qkt<KB>(p0, p1, lds, r32, hi, qr);
            SBAR();
            stick_tile(p0, p1, 64 * kb, t, hi, R2);
            SBAR();
            if (more) { stg_write_k<KB ^ 1>(S, lds, sr, sc); SBAR(); stg_load(S, Vn, NB, sr, sc); SBAR(); } kdone = true;
            bf16x8 pa0, pa1, pa2, pa3; pack_p(p0, p1, pa0, pa1, pa2, pa3);
            SBAR();
            pv_tile<KB>(o, vb0, pa0, pa1, pa2, pa3);
            SBAR();
        }
        wdone = !__any(R2 > THR2);
    }
    if (lane == 0) DONE[(kb & 1) * 8 + w] = wdone ? 1 : 0;
    if (more) { if (!kdone) { stg_write_k<KB ^ 1>(S, lds, sr, sc); SBAR(); stg_load(S, Vn, NB, sr, sc); SBAR(); } stg_write_v<KB ^ 1>(S, lds, sr, sc); }
    __syncthreads();
    int alld = 1;
#pragma unroll
    for (int ww = 0; ww < 8; ++ww) alld &= DONE[(kb & 1) * 8 + ww];
    return more && !alld;
}
__device__ __forceinline__ void stick_item(Frame& F, int h, int qb) {
    using namespace at;
    LAS unsigned char* lds = F.lds + RING_OFF;
    const bf16* PB = WSP(bf16, WS_PB); bf16* MIX = WSP(bf16, WS_MIX);
    int tid = F.tid; asm volatile("" : "+v"(tid));
    const int lane = tid & 63, w = F.wave, r32 = lane & 31, hi = lane >> 5, sr = tid >> 4, sc = (tid & 15) * 8;
    const int q0 = 256 * qb, tw = q0 + 32 * w, t = tw + r32;
    LAS int* DONE = (LAS int*)(lds + L_DONE);
    bf16x8 qr[8]; load_q(qr, PB + (size_t)t * NB + CB_Q + h * HD, hi);
    f32x16 o[4] = {};
    const bf16* Kh = PB + CB_K + h * HD; const bf16* Vh = PB + CB_V + h * HD;
    const int kb_hi = q0 / 64 + 3, kb_w = q0 / 64 + (w >> 1);
    float R2 = 0.f;
    Stg S;
    stg_load(S, Kh + (size_t)kb_hi * 64 * NB, NB, sr, sc); stg_write_k<0>(S, lds, sr, sc);
    stg_load(S, Vh + (size_t)kb_hi * 64 * NB, NB, sr, sc); stg_write_v<0>(S, lds, sr, sc);
    __syncthreads();
    for (int kb = kb_hi; ; kb -= 2) {
        if (!stick_step<0>(kb, kb_w, S, lds, tid, Kh, Vh, qr, o, tw, R2, DONE)) break;
        if (!stick_step<1>(kb - 1, kb_w, S, lds, tid, Kh, Vh, qr, o, tw, R2, DONE)) break;
    }
    store_o(o, lane, [&](int row) { return MIX + (size_t)(tw + row) * DM + h * HD; });
}
__device__ __forceinline__ void p10_attn(Frame& F) {
    for (int it = F.vcu; it < 384 + 128; it += F.G) {
        if (it < 384) { const int h = it % 12, qb = 31 - it / 12; stick_item(F, h, qb); }
        else { const int j = it - 384; mem_item(F, WSP(bf16, WS_PB), NB, CB_QM, F.in[14] + 2 * HD, 1, j & 3, j >> 2); }
        __syncthreads();
    }
}

constexpr int N_PHASES = 17;
#ifndef MK_NAIVE_P3
#define MK_NAIVE_P3 0
#endif
#ifndef MK_NAIVE_P10
#define MK_NAIVE_P10 0
#endif
struct Args { const float* in[22]; float* out; unsigned char* ws; int ph_lo, ph_hi, use_bar, pad; };
__global__ void __launch_bounds__(NWAVES * 64, 2) mk_fwd(Args args) {
    extern __shared__ __attribute__((aligned(16))) unsigned char lds[];
    Frame F;
    F.lds = (LAS unsigned char*)lds;
    F.MISC = (volatile LAS unsigned*)(F.lds + MISC_OFF);
    F.tid = threadIdx.x; F.lane = F.tid & 63; F.wave = __builtin_amdgcn_readfirstlane(F.tid >> 6);
    F.G = gridDim.x; { const int bx = blockIdx.x; F.vcu = (F.G % 8 == 0) ? (bx % 8) * (F.G / 8) + bx / 8 : bx; }
    F.ws = args.ws; F.ctl = (gu32*)(args.ws + WS_CTL); F.out = args.out;
#pragma unroll
    for (int i = 0; i < 22; ++i) F.in[i] = args.in[i];
    for (int u = F.tid; u < (LDS_BYTES - LDSCTL_OFF) / 4; u += NWAVES * 64) ((LAS unsigned*)(F.lds + LDSCTL_OFF))[u] = 0u;
    __syncthreads();
    XcdBarrier bar; bar.bar = (unsigned*)(F.ctl + CW_BAR); bar.x = 0; bar.st = nullptr;
    if (args.use_bar) bar = xcd_barrier_post((unsigned*)(F.ctl + CW_BAR), F.MISC + 8);
#define GRID_BAR() do { if (args.use_bar) xcd_barrier(bar); F.tid = threadIdx.x; asm volatile("" : "+v"(F.tid)); F.lane = F.tid & 63; } while (0)
    const int lo = args.ph_lo, hi = args.ph_hi;
#ifdef MK_ONLY_PHASE
#define IN(k) ((k) == MK_ONLY_PHASE && lo <= (k) && (k) < hi)
#else
#define IN(k) (lo <= (k) && (k) < hi)
#endif
#define BOTH(k) (IN(k) && IN((k) + 1))
    typedef pg8::StaticOrder SO;

    if (IN(0)) { p0_prologue(F); if (BOTH(0)) GRID_BAR(); }
    if (IN(1)) {
        { pg8::Gemm g{WSP(bf16, WS_XN), WSP(bf16, WS_WT_INA), DM}; SO S; S.init(T / 256, NA / 256, F.G, (int)blockIdx.x);
          pg8::EpiBf16 E{WSP(bf16, WS_PA), NA}; pg8::gemm_phase<pg8::EpiBf16, SO, true, true>(F.lds + RING_OFF, g, S, E); }
        { pg8::Gemm g{WSP(bf16, WS_MEMN), WSP(bf16, WS_WT_MEM), DM}; SO S; S.init(1, 8, F.G, (int)(F.G - 1 - blockIdx.x));
          pg8::EpiBf16 E{WSP(bf16, WS_MKV), 2048}; pg8::gemm_phase<pg8::EpiBf16, SO, true, true>(F.lds + RING_OFF, g, S, E); }
        if (BOTH(1)) GRID_BAR();
    }
    if (IN(2)) { p2_compress(F); p2_qknorm(F); if (BOTH(2)) GRID_BAR(); }
#if MK_NAIVE_P3
    if (IN(3)) { p3_nsa_naive(F); mem_attn_naive(F, WSP(bf16, WS_PA), NA, CA_QM, F.in[14], 0); if (BOTH(3)) GRID_BAR(); }
#else
    if (IN(3)) { p3_attn(F); if (BOTH(3)) GRID_BAR(); }
#endif
    if (IN(4)) { pg8::Gemm g{WSP(bf16, WS_MIX), WSP(bf16, WS_WT_OUT), DM}; SO S; S.init(T / 256, DM / 256, F.G, (int)blockIdx.x);
        pg8::EpiResF32 E{F.in[0], WSP(float, WS_X1), DM}; pg8::gemm_phase<pg8::EpiResF32, SO, true, true>(F.lds + RING_OFF, g, S, E); if (BOTH(4)) GRID_BAR(); }
    if (IN(5)) { rmsnorm_rows(F, WSP(float, WS_X1), WSP(bf16, WS_XN), T); if (BOTH(5)) GRID_BAR(); }
    if (IN(6)) { pg8::Gemm g{WSP(bf16, WS_XN), WSP(bf16, WS_WT_FGU), DM}; SO S; S.init(T / 256, 2 * FF / 256, F.G, (int)blockIdx.x);
        pg8::EpiSwiglu E{WSP(bf16, WS_HFF), FF}; pg8::gemm_phase<pg8::EpiSwiglu, SO, true, true>(F.lds + RING_OFF, g, S, E); if (BOTH(6)) GRID_BAR(); }
    if (IN(7)) { pg8::Gemm g{WSP(bf16, WS_HFF), WSP(bf16, WS_WT_FDN), FF}; SO S; S.init(T / 256, DM / 256, F.G, (int)blockIdx.x);
        pg8::EpiResF32 E{WSP(float, WS_X1), WSP(float, WS_X2), DM}; pg8::gemm_phase<pg8::EpiResF32, SO, true, true>(F.lds + RING_OFF, g, S, E); if (BOTH(7)) GRID_BAR(); }
    if (IN(8)) { rmsnorm_rows(F, WSP(float, WS_X2), WSP(bf16, WS_XN), T); if (BOTH(8)) GRID_BAR(); }
    if (IN(9)) { pg8::Gemm g{WSP(bf16, WS_XN), WSP(bf16, WS_WT_INB), DM}; SO S; S.init(T / 256, NB / 256, F.G, (int)blockIdx.x);
        pg8::EpiBf16 E{WSP(bf16, WS_PB), NB}; pg8::gemm_phase<pg8::EpiBf16, SO, true, true>(F.lds + RING_OFF, g, S, E); if (BOTH(9)) GRID_BAR(); }
#if MK_NAIVE_P10
    if (IN(10)) { stick_naive(F); mem_attn_naive(F, WSP(bf16, WS_PB), NB, CB_QM, F.in[14] + 2 * HD, 1); if (BOTH(10)) GRID_BAR(); }
#else
    if (IN(10)) { p10_attn(F); if (BOTH(10)) GRID_BAR(); }
#endif
    if (IN(11)) { pg8::Gemm g{WSP(bf16, WS_MIX), WSP(bf16, WS_WT_OUT) + (size_t)DM * DM, DM}; SO S; S.init(T / 256, DM / 256, F.G, (int)blockIdx.x);
        pg8::EpiResF32 E{WSP(float, WS_X2), WSP(float, WS_X3), DM}; pg8::gemm_phase<pg8::EpiResF32, SO, true, true>(F.lds + RING_OFF, g, S, E); if (BOTH(11)) GRID_BAR(); }
    if (IN(12)) { p12_router(F); if (BOTH(12)) GRID_BAR(); }
    if (IN(13)) { p13_assign(F); if (BOTH(13)) GRID_BAR(); }
    if (IN(14)) { const int* TILE = (const int*)(F.ws + WS_ROUTE + RT_TILE); const int ntl = TILE[0];
        pg8::Gemm g{WSP(bf16, WS_AMOE), WSP(bf16, WS_WT_MGU), DM}; pg8::MoeOrder S; S.init(ntl, 2 * FF / 256, F.G, (int)blockIdx.x); S.tile_e = TILE + 16; S.estride = (size_t)2 * FF * DM * 2;
        pg8::EpiSwiglu E{WSP(bf16, WS_HMOE), FF}; pg8::gemm_phase<pg8::EpiSwiglu, pg8::MoeOrder, true, true>(F.lds + RING_OFF, g, S, E); if (BOTH(14)) GRID_BAR(); }
    if (IN(15)) { const int* TILE = (const int*)(F.ws + WS_ROUTE + RT_TILE); const int ntl = TILE[0];
        pg8::Gemm g{WSP(bf16, WS_HMOE), WSP(bf16, WS_WT_MDN), FF}; pg8::MoeOrder S; S.init(ntl, DM / 256, F.G, (int)blockIdx.x); S.tile_e = TILE + 16; S.estride = (size_t)DM * FF * 2;
        pg8::EpiBf16 E{WSP(bf16, WS_YMOE), DM}; pg8::gemm_phase<pg8::EpiBf16, pg8::MoeOrder, true, true>(F.lds + RING_OFF, g, S, E); if (BOTH(15)) GRID_BAR(); }
    if (IN(16)) { p16_combine(F); }
#undef IN
#undef BOTH
}

#ifndef MK_ONE_LAUNCH
#define MK_ONE_LAUNCH 1
#endif
extern "C" void kernel_launch(void* const* d_in, const int* in_sizes, int n_in, void* d_out, int out_size, void* d_ws, size_t ws_size, hipStream_t stream) {
    static int grid = 0;
    if (grid == 0) {
        if (n_in != 22 || in_sizes[0] != T * DM || out_size != T * DM || ws_size < WS_END) { fprintf(stderr, "kernel_launch: unexpected shapes (n_in %d, in0 %d, out %d, ws %zu < %zu)\n", n_in, n_in > 0 ? in_sizes[0] : -1, out_size, ws_size, (size_t)WS_END); grid = -1; return; }
        int dev = 0, cus = 0, per_cu = 0;
        if (hipGetDevice(&dev) != hipSuccess || hipDeviceGetAttribute(&cus, hipDeviceAttributeMultiprocessorCount, dev) != hipSuccess) { grid = -1; return; }
        if (hipFuncSetAttribute((const void*)mk_fwd, hipFuncAttributeMaxDynamicSharedMemorySize, LDS_BYTES) != hipSuccess) { fprintf(stderr, "kernel_launch: hipFuncSetAttribute failed\n"); grid = -1; return; }
        if (hipOccupancyMaxActiveBlocksPerMultiprocessor(&per_cu, (const void*)mk_fwd, NWAVES * 64, LDS_BYTES) != hipSuccess || per_cu < 1) { fprintf(stderr, "kernel_launch: occupancy query says %d blocks per CU\n", per_cu); }
        (void)hipGetLastError();
        grid = cus;
    }
    if (grid < 0) return;
    if (hipMemsetAsync((char*)d_ws + WS_CTL, 0, CTL_ZERO_BYTES, stream) != hipSuccess) return;
    Args a{};
    for (int i = 0; i < 22; ++i) a.in[i] = (const float*)d_in[i];
    a.out = (float*)d_out; a.ws = (unsigned char*)d_ws; a.pad = 0;
#if MK_ONE_LAUNCH
    a.ph_lo = 0; a.ph_hi = N_PHASES; a.use_bar = 1;
    hipLaunchKernelGGL(mk_fwd, dim3(grid), dim3(NWAVES * 64), LDS_BYTES, stream, a);
#else
    for (int p = 0; p < N_PHASES; ++p) { a.ph_lo = p; a.ph_hi = p + 1; a.use_bar = 0;
        hipLaunchKernelGGL(mk_fwd, dim3(grid), dim3(NWAVES * 64), LDS_BYTES, stream, a); }
#endif
}
```

```cpp
#include <hip/hip_runtime.h>
#include <cstdio>
#include <cstdint>

namespace pg8 {
#define PG8_LAS __attribute__((address_space(3)))
typedef unsigned short bf16_t;
typedef short bf16x8 __attribute__((ext_vector_type(8)));
typedef float f32x4 __attribute__((ext_vector_type(4)));
typedef unsigned u32x4 __attribute__((ext_vector_type(4)));
constexpr int BM = 256, BK = 64, HALF = 128, HTB = HALF * BK * 2  , STAGE_BYTES = 8 * HTB, NXCD = 8, WGM = 8;

__host__ __device__ __forceinline__ int lds_byte(int r, int c) { const int st = (r >> 4) * 2 + (c >> 5), rr = r & 15, cc = c & 31, ob = rr * 64 + cc * 2; return st * 1024 + (ob ^ (((ob >> 9) & 1) << 5)); }
__host__ __device__ __forceinline__ void stage_rc(int b, int& R, int& C) { const int st = b / 1024, sb = b % 1024, swz = sb ^ (((sb >> 9) & 1) << 5); R = (st >> 1) * 16 + swz / 64; C = (st & 1) * 32 + (swz % 64) / 2; }
__host__ __device__ __forceinline__ int perm32(int rho) { const int n = rho >> 4, i = rho & 15; return 8 * (i >> 2) + 4 * n + (i & 3); }

struct Unit { int pm, pn; };
struct Gemm { const bf16_t* A; const bf16_t* Bt; int K; };

struct StaticOrder {
    int nM, nN, nwg, G, c;
    __device__ void init(int nM_, int nN_, int G_, int c_) { nM = nM_; nN = nN_; nwg = nM * nN; G = G_; c = c_; }
    __device__ bool next(int i, Unit& u) const {
        const long L = (long)i * G + c; if (L >= nwg) return false;
        int wgid = (int)L; { const int q = nwg / NXCD, r = nwg % NXCD, xcd = wgid % NXCD, off = wgid / NXCD; wgid = (xcd < r ? xcd * (q + 1) : r * (q + 1) + (xcd - r) * q) + off; }
        const int nig = WGM * nN, gid = wgid / nig, fm = gid * WGM, gsz = (nM - fm) < WGM ? (nM - fm) : WGM;
        u.pm = fm + ((wgid % nig) % gsz); u.pn = (wgid % nig) / gsz; return true;
    }
    __device__ __forceinline__ const char* a_base(const Gemm& g, const Unit& u) const { return (const char*)g.A + (size_t)u.pm * ((size_t)BM * g.K * 2); }
    __device__ __forceinline__ const char* b_base(const Gemm& g, const Unit& u) const { return (const char*)g.Bt + (size_t)u.pn * ((size_t)BM * g.K * 2); }
    __device__ __forceinline__ void a_ready(const Unit&) const {}
    __device__ __forceinline__ void done(const Unit&) const {}
};
struct MoeOrder : StaticOrder {
    const int* tile_e; size_t estride;
    __device__ __forceinline__ const char* b_base(const Gemm& g, const Unit& u) const { return (const char*)g.Bt + (size_t)tile_e[u.pm] * estride + (size_t)u.pn * ((size_t)BM * g.K * 2); }
};

__device__ __forceinline__ unsigned cvt_pk_bf16(float lo, float hi) { unsigned r; asm volatile("v_cvt_pk_bf16_f32 %0, %1, %2" : "=v"(r) : "v"(lo), "v"(hi)); return r; }

struct EpiBf16 {
    static constexpr bool PERM = true, AFTER_DRAIN = false;
    bf16_t* O; int ldc;
    __device__ __forceinline__ void operator()(const f32x4 (&acc)[2][2][4][2], const Unit& u, int wr, int wc, int fr, int fq) const {
        const int row0 = u.pm * BM + wr * 64 + fr, col0 = u.pn * BM + wc * 32 + 8 * fq;
#pragma unroll
        for (int ai = 0; ai < 2; ++ai)
#pragma unroll
            for (int m = 0; m < 4; ++m) { bf16_t* rowp = O + (size_t)(row0 + ai * HALF + m * 16) * ldc + col0;
#pragma unroll
                for (int bj = 0; bj < 2; ++bj) { const f32x4 v0 = acc[ai][bj][m][0], v1 = acc[ai][bj][m][1];
                    u32x4 w; w.x = cvt_pk_bf16(v0[0], v0[1]); w.y = cvt_pk_bf16(v0[2], v0[3]); w.z = cvt_pk_bf16(v1[0], v1[1]); w.w = cvt_pk_bf16(v1[2], v1[3]);
                    *(u32x4*)(rowp + bj * HALF) = w; } }
    }
};
struct EpiSwiglu {
    static constexpr bool PERM = true, AFTER_DRAIN = false;
    bf16_t* O; int ldc;
    __device__ __forceinline__ void operator()(const f32x4 (&acc)[2][2][4][2], const Unit& u, int wr, int wc, int fr, int fq) const {
        const int row0 = u.pm * BM + wr * 64 + fr, col0 = u.pn * HALF + wc * 32 + 8 * fq;
#pragma unroll
        for (int ai = 0; ai < 2; ++ai)
#pragma unroll
            for (int m = 0; m < 4; ++m) { bf16_t* rowp = O + (size_t)(row0 + ai * HALF + m * 16) * ldc + col0;
                float h[8];
#pragma unroll
                for (int n = 0; n < 2; ++n)
#pragma unroll
                    for (int j = 0; j < 4; ++j) { const float gq = acc[ai][0][m][n][j], uq = acc[ai][1][m][n][j];
                        const float sg = __builtin_amdgcn_rcpf(1.0f + __builtin_amdgcn_exp2f(-1.4426950408889634f * gq));
                        h[n * 4 + j] = gq * sg * uq; }
                u32x4 w; w.x = cvt_pk_bf16(h[0], h[1]); w.y = cvt_pk_bf16(h[2], h[3]); w.z = cvt_pk_bf16(h[4], h[5]); w.w = cvt_pk_bf16(h[6], h[7]);
                *(u32x4*)rowp = w; }
    }
};
struct EpiResF32 {
    static constexpr bool PERM = false, AFTER_DRAIN = false;
    const float* base; float* out; int ldc;
    __device__ __forceinline__ void operator()(const f32x4 (&acc)[2][2][4][2], const Unit& u, int wr, int wc, int fr, int fq) const {
        const int row0 = u.pm * BM + wr * 64 + fr, col0 = u.pn * BM + wc * 32 + 4 * fq;
#pragma unroll
        for (int ai = 0; ai < 2; ++ai)
#pragma unroll
            for (int m = 0; m < 4; ++m) { const size_t off = (size_t)(row0 + ai * HALF + m * 16) * ldc + col0;
#pragma unroll
                for (int bj = 0; bj < 2; ++bj)
#pragma unroll
                    for (int n = 0; n < 2; ++n) { const f32x4 b = *(const f32x4*)(base + off + bj * HALF + n * 16); *(f32x4*)(out + off + bj * HALF + n * 16) = b + acc[ai][bj][m][n]; } }
    }
};
template <class Epi, class Sched, bool ALIGN_EPI = false, bool SP2 = false>
__device__ __forceinline__ void gemm_phase(PG8_LAS unsigned char* lds, const Gemm g, const Sched& S, const Epi& E) {
    int tid = threadIdx.x; asm volatile("" : "+v"(tid));
    const int wid = __builtin_amdgcn_readfirstlane(tid >> 6), lane = tid & 63, wr = wid >> 2, wc = wid & 3, fr = lane & 15, fq = lane >> 4;
    const int K = g.K, nt = K / BK;
    unsigned voffA[2], voffB[2];
#pragma unroll
    for (int i = 0; i < 2; ++i) { int R, C; stage_rc(tid * 16 + i * 8192, R, C); const int Rb = Epi::PERM ? ((R & ~31) + perm32(R & 31)) : R;
        voffA[i] = (unsigned)(R * K + C) * 2u; voffB[i] = (unsigned)(Rb * K + C) * 2u; }
    const size_t kstep = (size_t)(BK * 2);
    const size_t hstep = (size_t)HALF * K * 2;
    const unsigned ldsw = (unsigned)wid * 1024u;
    const int aoff = lds_byte(wr * 64 + fr, fq * 8), boff = lds_byte(wc * 32 + fr, fq * 8);
#define PG8_SA(b, h) (((b) * 2 + (h)) * HTB)
#define PG8_SB(b, h) ((4 + (b) * 2 + (h)) * HTB)
#define PG8_STAGE(bufoff, gbase, voff) do { _Pragma("unroll") for (int _i = 0; _i < 2; ++_i) \
        __builtin_amdgcn_global_load_lds((const unsigned*)((const char*)(gbase) + (voff)[_i]), (PG8_LAS unsigned*)(lds + (bufoff) + ldsw + _i * 8192), 16, 0, 0); } while (0)
#define PG8_LDA(dst, b, h) do { _Pragma("unroll") for (int m = 0; m < 4; ++m) _Pragma("unroll") for (int k = 0; k < 2; ++k) dst[m][k] = *(const PG8_LAS bf16x8*)(lds + PG8_SA(b, h) + aoff + m * 2048 + k * 1024); } while (0)
#define PG8_LDB(dst, b, h) do { _Pragma("unroll") for (int n = 0; n < 2; ++n) _Pragma("unroll") for (int k = 0; k < 2; ++k) dst[n][k] = *(const PG8_LAS bf16x8*)(lds + PG8_SB(b, h) + boff + n * 2048 + k * 1024); } while (0)
#define PG8_MMA(ai, bj, At, Bt) do { __builtin_amdgcn_s_setprio(1); _Pragma("unroll") for (int m = 0; m < 4; ++m) _Pragma("unroll") for (int n = 0; n < 2; ++n) _Pragma("unroll") for (int k = 0; k < 2; ++k) \
        acc[ai][bj][m][n] = __builtin_amdgcn_mfma_f32_16x16x32_bf16(Bt[n][k], At[m][k], acc[ai][bj][m][n], 0, 0, 0); __builtin_amdgcn_s_setprio(0); } while (0)
#define PG8_WAIT_V(n) asm volatile("s_waitcnt vmcnt(" #n ")" ::: "memory")
#define PG8_WAIT_L(n) asm volatile("s_waitcnt lgkmcnt(" #n ")" ::: "memory")
#define PG8_BAR __builtin_amdgcn_s_barrier()
#define PG8_SCHED __builtin_amdgcn_sched_barrier(0)
    Unit cur, nxt; int ui = 0;
    if (!S.next(0, cur)) return;
    f32x4 acc[2][2][4][2];
#pragma unroll
    for (int a = 0; a < 2; ++a)
#pragma unroll
        for (int b = 0; b < 2; ++b)
#pragma unroll
            for (int m = 0; m < 4; ++m)
#pragma unroll
                for (int n = 0; n < 2; ++n) acc[a][b][m][n] = (f32x4){0.f, 0.f, 0.f, 0.f};
    bf16x8 At[4][2], B0[2][2], B1[2][2];
    const char* cA = S.a_base(g, cur); const char* cB = S.b_base(g, cur);
    S.a_ready(cur);
    if constexpr (SP2) {
        PG8_STAGE(PG8_SB(0, 0), cB, voffB); PG8_STAGE(PG8_SB(0, 1), cB + hstep, voffB); PG8_STAGE(PG8_SA(0, 0), cA, voffA); PG8_STAGE(PG8_SA(0, 1), cA + hstep, voffA);
        if (wr == 1) PG8_BAR;
        PG8_WAIT_V(2); PG8_BAR;
        PG8_STAGE(PG8_SB(1, 0), cB + kstep, voffB); PG8_STAGE(PG8_SA(1, 0), cA + kstep, voffA); PG8_STAGE(PG8_SB(1, 1), cB + hstep + kstep, voffB);
        PG8_WAIT_V(6); PG8_BAR;
    } else {
        PG8_STAGE(PG8_SB(0, 0), cB, voffB); PG8_STAGE(PG8_SA(0, 0), cA, voffA); PG8_STAGE(PG8_SB(0, 1), cB + hstep, voffB); PG8_STAGE(PG8_SA(0, 1), cA + hstep, voffA);
        if (wr == 1) PG8_BAR;
        PG8_WAIT_V(4); PG8_BAR;
        PG8_STAGE(PG8_SB(1, 0), cB + kstep, voffB); PG8_STAGE(PG8_SA(1, 0), cA + kstep, voffA); PG8_STAGE(PG8_SB(1, 1), cB + hstep + kstep, voffB);
        PG8_WAIT_V(6); PG8_BAR;
    }
    for (;;) {
        const bool has_next = S.next(ui + 1, nxt);
        const char* nA = has_next ? S.a_base(g, nxt) : cA; const char* nB = has_next ? S.b_base(g, nxt) : cB;
        for (int t = 0; t < nt; t += 2) {
            const bool last = (t == nt - 2);
            const char* a1 = cA + (size_t)(t + 1) * kstep;
            const char* a2 = last ? nA : cA + (size_t)(t + 2) * kstep; const char* b2 = last ? nB : cB + (size_t)(t + 2) * kstep;
            const char* a3 = a2 + kstep; const char* b3 = b2 + kstep;
            if (last && has_next) S.a_ready(nxt);
            if constexpr (SP2) {
            PG8_LDB(B0, 0, 0); PG8_LDB(B1, 0, 1); PG8_SCHED; PG8_LDA(At, 0, 0); PG8_STAGE(PG8_SA(1, 1), a1 + hstep, voffA);
            PG8_WAIT_V(8); PG8_WAIT_L(0); PG8_BAR; PG8_MMA(0, 0, At, B0); PG8_MMA(0, 1, At, B1); PG8_BAR; PG8_SCHED;
            PG8_LDA(At, 0, 1); PG8_STAGE(PG8_SB(0, 0), b2, voffB); PG8_STAGE(PG8_SB(0, 1), b2 + hstep, voffB); PG8_STAGE(PG8_SA(0, 0), a2, voffA);
            PG8_WAIT_V(8); PG8_WAIT_L(0); PG8_BAR; PG8_MMA(1, 0, At, B0); PG8_MMA(1, 1, At, B1); PG8_BAR; PG8_SCHED;
            PG8_LDB(B0, 1, 0); PG8_LDB(B1, 1, 1); PG8_SCHED; PG8_LDA(At, 1, 0); PG8_STAGE(PG8_SA(0, 1), a2 + hstep, voffA);
            PG8_WAIT_V(8); PG8_WAIT_L(0); PG8_BAR; PG8_MMA(0, 0, At, B0); PG8_MMA(0, 1, At, B1); PG8_BAR; PG8_SCHED;
            PG8_LDA(At, 1, 1); PG8_STAGE(PG8_SB(1, 0), b3, voffB); PG8_STAGE(PG8_SB(1, 1), b3 + hstep, voffB); PG8_STAGE(PG8_SA(1, 0), a3, voffA);
            PG8_WAIT_V(8); PG8_WAIT_L(0); PG8_BAR; PG8_MMA(1, 0, At, B0); PG8_MMA(1, 1, At, B1); PG8_BAR; PG8_SCHED;
            } else {
            PG8_LDB(B0, 0, 0); PG8_SCHED; PG8_LDA(At, 0, 0); PG8_STAGE(PG8_SA(1, 1), a1 + hstep, voffA);
            PG8_WAIT_L(8); PG8_BAR; PG8_WAIT_L(0); PG8_MMA(0, 0, At, B0); PG8_BAR; PG8_SCHED;
            PG8_LDB(B1, 0, 1); PG8_STAGE(PG8_SB(0, 0), b2, voffB);
            PG8_BAR; PG8_WAIT_L(0); PG8_MMA(0, 1, At, B1); PG8_BAR;
            PG8_LDA(At, 0, 1); PG8_STAGE(PG8_SA(0, 0), a2, voffA);
            PG8_BAR; PG8_WAIT_L(0); PG8_MMA(1, 0, At, B0); PG8_BAR; PG8_SCHED;
            PG8_STAGE(PG8_SB(0, 1), b2 + hstep, voffB);
            PG8_WAIT_V(6); PG8_BAR; PG8_MMA(1, 1, At, B1); PG8_BAR;
            PG8_LDB(B0, 1, 0); PG8_SCHED; PG8_LDA(At, 1, 0); PG8_STAGE(PG8_SA(0, 1), a2 + hstep, voffA);
            PG8_WAIT_L(8); PG8_BAR; PG8_WAIT_L(0); PG8_MMA(0, 0, At, B0); PG8_BAR; PG8_SCHED;
            PG8_LDB(B1, 1, 1); PG8_STAGE(PG8_SB(1, 0), b3, voffB);
            PG8_BAR; PG8_WAIT_L(0); PG8_MMA(0, 1, At, B1); PG8_BAR;
            PG8_LDA(At, 1, 1); PG8_STAGE(PG8_SA(1, 0), a3, voffA);
            PG8_BAR; PG8_WAIT_L(0); PG8_MMA(1, 0, At, B0); PG8_BAR; PG8_SCHED;
            PG8_STAGE(PG8_SB(1, 1), b3 + hstep, voffB);
            PG8_WAIT_V(6); PG8_BAR; PG8_MMA(1, 1, At, B1); PG8_BAR;
            }
        }
        if constexpr (ALIGN_EPI) { if (wr == 0) PG8_BAR; }
        if constexpr (!Epi::AFTER_DRAIN) { E(acc, cur, wr, wc, fr, fq); S.done(cur); }
        if (!has_next) break;
#pragma unroll
        for (int a = 0; a < 2; ++a)
#pragma unroll
            for (int b = 0; b < 2; ++b)
#pragma unroll
                for (int m = 0; m < 4; ++m)
#pragma unroll
                    for (int n = 0; n < 2; ++n) acc[a][b][m][n] = (f32x4){0.f, 0.f, 0.f, 0.f};
        cur = nxt; cA = nA; cB = nB; ++ui;
        if constexpr (ALIGN_EPI) { if (wr == 1) PG8_BAR; }
    }
    PG8_WAIT_V(0);
    if constexpr (!ALIGN_EPI) { if (wr == 0) PG8_BAR; }
    PG8_BAR;
    if constexpr (Epi::AFTER_DRAIN) { E.fused(acc, cur, wr, wc, fr, fq, lds, wid, lane); S.done(cur); }
#undef PG8_SA
#undef PG8_SB
#undef PG8_STAGE
#undef PG8_LDA
#undef PG8_LDB
#undef PG8_MMA
#undef PG8_WAIT_V
#undef PG8_WAIT_L
#undef PG8_BAR
#undef PG8_SCHED
}
}


constexpr int T = 8192, DM = 2048, HD = 128, NMIX = 12, NMEMH = 4, NG = 3, MEMT = 256, FF = 7168, NE = 8;
constexpr int A_IN_W = 4388, NA = 4608;
constexpr int NB = 5120;
constexpr int CA_Q = 0, CA_KC = 1536, CA_VC = 1920, CA_KS = 2304, CA_VS = 2688, CA_KW = 3072, CA_VW = 3456, CA_QM = 3840, CA_GT = 4352;
constexpr int CB_Q = 0, CB_QM = 1536, CB_K = 2048, CB_V = 3584;
constexpr int NCMP = 511, NCMP_P = 512;
constexpr int MOE_MAXT = 72;
constexpr float EPS = 1e-6f;
constexpr float QSCALE = 0.08838834764831845f;

constexpr size_t MiB = 1u << 20;
constexpr size_t WS_CTL = 0, CTL_ZERO_BYTES = 1 * MiB;
constexpr size_t WS_WT_INA = 2 * MiB;
constexpr size_t WS_WT_MEM = 20 * MiB;
constexpr size_t WS_WT_OUT = 28 * MiB;
constexpr size_t WS_WT_FGU = 44 * MiB;
constexpr size_t WS_WT_FDN = 100 * MiB;
constexpr size_t WS_WT_INB = 128 * MiB;
constexpr size_t WS_WT_MGU = 148 * MiB;
constexpr size_t WS_WT_MDN = 596 * MiB;
constexpr size_t WS_XN = 820 * MiB;
constexpr size_t WS_MEMN = 852 * MiB;
constexpr size_t WS_MKV = 853 * MiB;
constexpr size_t WS_PA = 854 * MiB;
constexpr size_t WS_KCMP = 926 * MiB;
constexpr size_t WS_MIX = 927 * MiB;
constexpr size_t WS_X1 = 959 * MiB;
constexpr size_t WS_X2 = 1023 * MiB;
constexpr size_t WS_X3 = 1087 * MiB;
constexpr size_t WS_HFF = 1151 * MiB;
constexpr size_t WS_PB = 1263 * MiB;
constexpr size_t WS_AMOE = 1343 * MiB;
constexpr size_t WS_HMOE = 1415 * MiB;
constexpr size_t WS_YMOE = 1667 * MiB;
constexpr size_t WS_ROUTE = 1739 * MiB;
constexpr size_t WS_WT_CMP = 1740 * MiB;
constexpr size_t WS_END = 1742 * MiB;
constexpr size_t RT_TOPI = 0;
constexpr size_t RT_TOPW = 65536;
constexpr size_t RT_ROW = 131072;
constexpr size_t RT_HIST = 196608;
constexpr size_t RT_TILE = 204800;
constexpr int CW_TMO = 0, CW_CODE = 1, CW_BAR = 4096;

constexpr int RING_OFF = 0, RING_BYTES = 135168;
constexpr int LDSCTL_OFF = RING_BYTES, MISC_OFF = LDSCTL_OFF + 320;
constexpr int LDS_BYTES = 147456;
static_assert(MISC_OFF + 128 <= LDS_BYTES, "LDS map");
constexpr int NWAVES = 8;

#define GAS __attribute__((address_space(1)))
#define LAS __attribute__((address_space(3)))
typedef unsigned short bf16;
typedef unsigned v4u __attribute__((ext_vector_type(4)));
typedef unsigned v2u __attribute__((ext_vector_type(2)));
typedef float f32x4 __attribute__((ext_vector_type(4)));
typedef GAS unsigned gu32;
#define RLX_AGENT __ATOMIC_RELAXED, __HIP_MEMORY_SCOPE_AGENT
#define LDS_WAIT() asm volatile("s_waitcnt lgkmcnt(0)" ::: "memory")
#define VM_WAIT() asm volatile("s_waitcnt vmcnt(0)" ::: "memory")
__device__ __forceinline__ float bf2f(unsigned b) { return __uint_as_float(b << 16); }
__device__ __forceinline__ unsigned pk2(float lo, float hi) { return pg8::cvt_pk_bf16(lo, hi); }
__device__ __forceinline__ void unpack8(v4u w, float* f) {
    f[0] = __uint_as_float(w.x << 16); f[1] = __uint_as_float(w.x & 0xffff0000u); f[2] = __uint_as_float(w.y << 16); f[3] = __uint_as_float(w.y & 0xffff0000u);
    f[4] = __uint_as_float(w.z << 16); f[5] = __uint_as_float(w.z & 0xffff0000u); f[6] = __uint_as_float(w.w << 16); f[7] = __uint_as_float(w.w & 0xffff0000u); }
__device__ __forceinline__ float wave_sum(float v) {
#pragma unroll
    for (int o = 1; o < 64; o <<= 1) v += __shfl_xor(v, o);
    return v;
}
__device__ __forceinline__ float fast_exp(float x) { return __builtin_amdgcn_exp2f(x * 1.4426950408889634f); }

#define XB_TMO      128
#define XB_XCNT(j)  (256  + 64 * (j))
#define XB_XSUB(j)  (1280 + 64 * (j))
#define XB_XGEN(j)  (2304 + 64 * (j))
#define XB_TOP      3328
#define XB_TOPGEN   3392
#define XCD_BAR_WORDS 3456
#define XB_SPIN_CAP (1u << 18)
__device__ __forceinline__ unsigned xb_ld(unsigned* p)              { return __hip_atomic_load(p, __ATOMIC_RELAXED, __HIP_MEMORY_SCOPE_AGENT); }
__device__ __forceinline__ unsigned xb_add(unsigned* p, unsigned v) { return __hip_atomic_fetch_add(p, v, __ATOMIC_RELAXED, __HIP_MEMORY_SCOPE_AGENT); }
__device__ __forceinline__ unsigned xb_xcc_id() { return (unsigned)__builtin_amdgcn_s_getreg((3 << 11) | 20) & 0xFu; }
#define XB_SPIN(cond, bar) do { unsigned _sp = 0; while (cond) { __builtin_amdgcn_s_sleep(1); \
    if ((++_sp & 255u) == 0u) { if (xb_ld(&(bar)[XB_TMO])) break; if (_sp > XB_SPIN_CAP) { atomicAdd(&(bar)[XB_TMO], 1u); break; } } } } while (0)
struct XcdBarrier { unsigned* bar; unsigned x; volatile LAS unsigned* st; };
__device__ __forceinline__ XcdBarrier xcd_barrier_post(unsigned* bar, volatile LAS unsigned* st) {
    XcdBarrier b; b.bar = bar; b.x = xb_xcc_id(); b.st = st;
    if (threadIdx.x == 0) (void)xb_add(&bar[XB_XCNT(b.x)], 1u);
    return b;
}
__device__ __forceinline__ void xcd_barrier_complete(unsigned* bar, unsigned x, unsigned& nloc, unsigned& nx) {
    const unsigned G = gridDim.x * gridDim.y * gridDim.z;
    unsigned sum, cnt, mine, sp = 0u;
    for (;;) {
        sum = 0u; cnt = 0u; mine = 0u;
#pragma unroll
        for (unsigned j = 0; j < 16; ++j) { const unsigned c = xb_ld(&bar[XB_XCNT(j)]); sum += c; cnt += (c > 0u) ? 1u : 0u; mine = (j == x) ? c : mine; }
        if (sum == G) break;
        __builtin_amdgcn_s_sleep(1);
        if ((++sp & 255u) == 0u) { if (xb_ld(&bar[XB_TMO])) break; if (sp > XB_SPIN_CAP) { atomicAdd(&bar[XB_TMO], 1u); break; } }
    }
    nloc = mine > 0u ? mine : 1u; nx = cnt > 0u ? cnt : 1u;
}
__device__ __forceinline__ void xcd_barrier(const XcdBarrier& b) {
    asm volatile("s_waitcnt vmcnt(0)" ::: "memory");
    __syncthreads();
    if (threadIdx.x == 0) {
        unsigned* bar = b.bar;
        __builtin_amdgcn_s_waitcnt(0);
        unsigned nloc = b.st[0], nx = b.st[1];
        if (nloc == 0u) { xcd_barrier_complete(bar, b.x, nloc, nx); b.st[0] = nloc; b.st[1] = nx; }
        const unsigned old = xb_add(&bar[XB_XSUB(b.x)], 1u);
        const unsigned gen = old / nloc;
        if (old + 1u == (gen + 1u) * nloc) {
            __builtin_amdgcn_fence(__ATOMIC_RELEASE, "agent");
            asm volatile("s_waitcnt vmcnt(0)" ::: "memory");
            const unsigned og = xb_add(&bar[XB_TOP], 1u);
            const unsigned tg = og / nx;
            if (og + 1u == (tg + 1u) * nx) xb_add(&bar[XB_TOPGEN], 1u);
            else XB_SPIN(xb_ld(&bar[XB_TOPGEN]) == tg, bar);
            __builtin_amdgcn_fence(__ATOMIC_ACQUIRE, "agent");
            xb_add(&bar[XB_XGEN(b.x)], 1u);
            asm volatile("s_waitcnt vmcnt(0)" ::: "memory");
        } else {
            XB_SPIN(xb_ld(&bar[XB_XGEN(b.x)]) == gen, bar);
            __builtin_amdgcn_fence(__ATOMIC_ACQUIRE, "agent");
            asm volatile("s_waitcnt vmcnt(0)" ::: "memory");
        }
    }
    __syncthreads();
}

struct Frame {
    LAS unsigned char* lds;
    volatile LAS unsigned* MISC;
    gu32* ctl;
    int tid, lane, wave;
    int vcu, G;
    unsigned char* ws;
    const float* in[22];
    float* out;
};
#define WSP(T_, off) ((T_*)(F.ws + (off)))

__device__ __forceinline__ void conv_item(const float* __restrict__ W, int K, int Nsrc, bf16* __restrict__ WT, const float* __restrict__ gain,
                                          int kb, int nb, int mode, int delta, int nvalid, LAS float* scr, int lane) {
    const int k0 = kb * 64, n0 = nb * 64;
    int sc0;
    if (mode == 1) { const int j = n0 >> 8, r = n0 & 255; sc0 = (r < 128) ? 128 * j + r : 7168 + 128 * j + (r - 128); }
    else sc0 = n0 + delta;
    const int kr = lane >> 4, nc = (lane & 15) * 4;
    const bool ok = (n0 + nc) < nvalid;
#pragma unroll 4
    for (int i = 0; i < 16; ++i) {
        const int k = 4 * i + kr;
        f32x4 v = (f32x4){0.f, 0.f, 0.f, 0.f};
        if (ok) v = *(const f32x4*)(W + (size_t)(k0 + k) * Nsrc + sc0 + nc);
        if (gain) { const float gk = gain[k0 + k]; v = v * gk; }
        LAS float* s = scr + k * 65 + nc;
        s[0] = v[0]; s[1] = v[1]; s[2] = v[2]; s[3] = v[3];
    }
    LDS_WAIT(); asm volatile("" ::: "memory");
    const int c = lane & 7, nl = lane >> 3;
#pragma unroll
    for (int j = 0; j < 8; ++j) {
        const int n = nl + 8 * j; const LAS float* s = scr + (8 * c) * 65 + n;
        v4u o; o.x = pk2(s[0 * 65], s[1 * 65]); o.y = pk2(s[2 * 65], s[3 * 65]); o.z = pk2(s[4 * 65], s[5 * 65]); o.w = pk2(s[6 * 65], s[7 * 65]);
        *(v4u*)(WT + (size_t)(n0 + n) * K + k0 + 8 * c) = o;
    }
    LDS_WAIT(); asm volatile("" ::: "memory");
}
__device__ __forceinline__ void conv_matrix(Frame& F, const float* W, int K, int Nsrc, int Ndst, bf16* WT, const float* gain, int mode, int& base_item) {
    LAS float* scr = (LAS float*)(F.lds + RING_OFF + F.wave * 16640);
    const int gw = F.vcu * NWAVES + F.wave, NGW = F.G * NWAVES;
    const int nkb = K / 64, nnb = Ndst / 64, nitems = nkb * nnb;
    int first = (gw - (base_item % NGW) + NGW) % NGW;
    for (int it = first; it < nitems; it += NGW) {
        const int kb = it / nnb, nb = it % nnb;
        int delta = 0, nvalid = Ndst;
        if (mode == 2) {
            const int n0 = nb * 64;
            if (n0 < 3840) { delta = 0; } else if (n0 < 4352) { delta = 36; } else { delta = -512; nvalid = 4388; }
        }
        conv_item(W, K, Nsrc, WT, gain, kb, nb, mode == 1 ? 1 : 0, delta, nvalid, scr, F.lane);
    }
    base_item += nitems;
}
__device__ __forceinline__ float row_rstd_to_bf16(const float* xrow, bf16* orow, int lane) {
    const f32x4* xr = (const f32x4*)xrow + lane;
    f32x4 v[8]; float s = 0.f;
#pragma unroll
    for (int j = 0; j < 8; ++j) { v[j] = xr[64 * j]; s += (v[j].x * v[j].x + v[j].y * v[j].y) + (v[j].z * v[j].z + v[j].w * v[j].w); }
    const float rstd = 1.0f / sqrtf(wave_sum(s) * (1.f / DM) + EPS);
    v2u* o8 = (v2u*)orow + lane;
#pragma unroll
    for (int j = 0; j < 8; ++j) { v2u w; w.x = pk2(v[j].x * rstd, v[j].y * rstd); w.y = pk2(v[j].z * rstd, v[j].w * rstd); o8[64 * j] = w; }
    return rstd;
}
__device__ __forceinline__ void rmsnorm_rows(Frame& F, const float* X, bf16* XN, int rows) {
    const int gw = F.vcu * NWAVES + F.wave, NGW = F.G * NWAVES;
    for (int m = gw; m < rows; m += NGW) row_rstd_to_bf16(X + (size_t)m * DM, XN + (size_t)m * DM, F.lane);
}
__device__ __forceinline__ void p0_prologue(Frame& F) {
    int base = 0;
    conv_matrix(F, F.in[5], DM, A_IN_W, NA, WSP(bf16, WS_WT_INA), F.in[2], 2, base);
    conv_matrix(F, F.in[13], DM, 1024, 1024, WSP(bf16, WS_WT_MEM), F.in[3], 0, base);
    conv_matrix(F, F.in[13] + (size_t)DM * 1024, DM, 1024, 1024, WSP(bf16, WS_WT_MEM) + (size_t)1024 * DM, F.in[3] + DM, 0, base);
    conv_matrix(F, F.in[6], 4096, HD, HD, WSP(bf16, WS_WT_CMP), nullptr, 0, base);
    conv_matrix(F, F.in[6] + (size_t)4096 * HD, 4096, HD, HD, WSP(bf16, WS_WT_CMP) + (size_t)HD * 4096, nullptr, 0, base);
    conv_matrix(F, F.in[15], DM, DM, DM, WSP(bf16, WS_WT_OUT), nullptr, 0, base);
    conv_matrix(F, F.in[15] + (size_t)DM * DM, DM, DM, DM, WSP(bf16, WS_WT_OUT) + (size_t)DM * DM, nullptr, 0, base);
    conv_matrix(F, F.in[16], DM, 2 * FF, 2 * FF, WSP(bf16, WS_WT_FGU), F.in[4], 1, base);
    conv_matrix(F, F.in[17], FF, DM, DM, WSP(bf16, WS_WT_FDN), nullptr, 0, base);
    conv_matrix(F, F.in[10], DM, DM, DM, WSP(bf16, WS_WT_INB), F.in[2] + DM, 0, base);
    conv_matrix(F, F.in[12], DM, 3072, 3072, WSP(bf16, WS_WT_INB) + (size_t)2048 * DM, F.in[11], 0, base);
    for (int e = 0; e < NE; ++e) {
        conv_matrix(F, F.in[20] + (size_t)e * DM * 2 * FF, DM, 2 * FF, 2 * FF, WSP(bf16, WS_WT_MGU) + (size_t)e * 2 * FF * DM, F.in[4] + DM, 1, base);
        conv_matrix(F, F.in[21] + (size_t)e * FF * DM, FF, DM, DM, WSP(bf16, WS_WT_MDN) + (size_t)e * DM * FF, nullptr, 0, base);
    }
    rmsnorm_rows(F, F.in[0], WSP(bf16, WS_XN), T);
    rmsnorm_rows(F, F.in[1], WSP(bf16, WS_MEMN), MEMT);
}

__device__ __forceinline__ void p2_compress(Frame& F) {
    typedef short bf16x8 __attribute__((ext_vector_type(8)));
    typedef float f32x16 __attribute__((ext_vector_type(16)));
    const bf16* PA = WSP(bf16, WS_PA); const bf16* WC = WSP(bf16, WS_WT_CMP);
    LAS float* red = (LAS float*)(F.lds + RING_OFF);
    const int lane = F.lane, w = F.wave, r32 = lane & 31, hi = lane >> 5, nt = w & 3, kh = w >> 2;
    const int nitems = 2 * NG * 16;
    for (int it = F.vcu; it < nitems; it += F.G) {
        const int kv = it / (NG * 16), g = (it / 16) % NG, jt = it % 16;
        const int j = 32 * jt + r32;
        const float* pos = F.in[7] + (size_t)kv * 4096;
        const int col = (kv ? CA_VC : CA_KC) + g * HD;
        const bf16* wrow = WC + ((size_t)kv * HD + 32 * nt + r32) * 4096;
        f32x16 acc = {};
#pragma unroll 8
        for (int ks = 0; ks < 128; ++ks) {
            const int k = 2048 * kh + 16 * ks + 8 * hi, i = k >> 7, d = k & 127;
            int trow = 16 * j + i; trow = trow < T ? trow : T - 1;
            const v4u xa = *(const v4u*)(PA + (size_t)trow * NA + col + d);
            const f32x4 pa = *(const f32x4*)(pos + k), pb = *(const f32x4*)(pos + k + 4);
            const v4u wb = *(const v4u*)(wrow + k);
            float xf[8]; unpack8(xa, xf);
            v4u av; av.x = pk2(xf[0] + pa[0], xf[1] + pa[1]); av.y = pk2(xf[2] + pa[2], xf[3] + pa[3]); av.z = pk2(xf[4] + pb[0], xf[5] + pb[1]); av.w = pk2(xf[6] + pb[2], xf[7] + pb[3]);
            acc = __builtin_amdgcn_mfma_f32_32x32x16_bf16(*reinterpret_cast<const bf16x8*>(&av), *reinterpret_cast<const bf16x8*>(&wb), acc, 0, 0, 0);
        }
#pragma unroll
        for (int r = 0; r < 16; ++r) red[(kh * 32 + (r & 3) + 8 * (r >> 2) + 4 * hi) * 132 + 32 * nt + r32] = acc[r];
        __syncthreads();
        {
            const int row = F.tid >> 4, cp = F.tid & 15, jj = 32 * jt + row;
            float v[8]; float ss = 0.f;
#pragma unroll
            for (int e = 0; e < 8; ++e) { v[e] = red[row * 132 + 8 * cp + e] + red[(32 + row) * 132 + 8 * cp + e]; ss += v[e] * v[e]; }
            ss += __shfl_xor(ss, 1); ss += __shfl_xor(ss, 2); ss += __shfl_xor(ss, 4); ss += __shfl_xor(ss, 8);
            if (kv == 0) { const float rs = 1.0f / sqrtf(ss * (1.f / HD) + EPS); const float* gp = F.in[9] + 8 * cp;
#pragma unroll
                for (int e = 0; e < 8; ++e) v[e] = v[e] * rs * gp[e]; }
            if (jj >= NCMP) {
#pragma unroll
                for (int e = 0; e < 8; ++e) v[e] = 0.f; }
            v4u o; o.x = pk2(v[0], v[1]); o.y = pk2(v[2], v[3]); o.z = pk2(v[4], v[5]); o.w = pk2(v[6], v[7]);
            *(v4u*)(WSP(bf16, WS_KCMP) + (size_t)kv * NG * NCMP_P * HD + ((size_t)g * NCMP_P + jj) * HD + 8 * cp) = o;
        }
        __syncthreads();
    }
}
__device__ __forceinline__ void norm_slot(bf16* p, const float* gain, int l16) {
    v4u w = *(const v4u*)(p + l16 * 8); float f[8]; unpack8(w, f);
    float s = 0.f;
#pragma unroll
    for (int e = 0; e < 8; ++e) s += f[e] * f[e];
    s += __shfl_xor(s, 1); s += __shfl_xor(s, 2); s += __shfl_xor(s, 4); s += __shfl_xor(s, 8);
    const float r = 1.0f / sqrtf(s * (1.f / HD) + EPS);
    const float* gp = gain + l16 * 8;
    v4u o; o.x = pk2(f[0] * r * gp[0], f[1] * r * gp[1]); o.y = pk2(f[2] * r * gp[2], f[3] * r * gp[3]); o.z = pk2(f[4] * r * gp[4], f[5] * r * gp[5]); o.w = pk2(f[6] * r * gp[6], f[7] * r * gp[7]);
    *(v4u*)(p + l16 * 8) = o;
}
__device__ __forceinline__ void p2_qknorm(Frame& F) {
    bf16* PA = WSP(bf16, WS_PA); bf16* MKV = WSP(bf16, WS_MKV);
    const int gs = (F.vcu * NWAVES + F.wave) * 4 + (F.lane >> 4), NS = F.G * NWAVES * 4, l16 = F.lane & 15;
    for (int s = gs; s < T * 18; s += NS) {
        const int t = s / 18, k = s % 18;
        int col; const float* gain;
        if (k < 12) { col = CA_Q + k * HD; gain = F.in[8]; }
        else if (k < 15) { col = CA_KS + (k - 12) * HD; gain = F.in[9] + HD; }
        else { col = CA_KW + (k - 15) * HD; gain = F.in[9] + 2 * HD; }
        norm_slot(PA + (size_t)t * NA + col, gain, l16);
    }
    for (int s = gs; s < MEMT * 8; s += NS) {
        const int m = s / 8, k = s % 8, l = k >> 2, h = k & 3;
        norm_slot(MKV + (size_t)m * 2048 + l * 1024 + h * HD, F.in[14] + (size_t)(l * 2 + 1) * HD, l16);
    }
}

__device__ __forceinline__ void ld32(const bf16* p, float* f) {
#pragma unroll
    for (int i = 0; i < 4; ++i) { const v4u w = *(const v4u*)(p + 8 * i); unpack8(w, f + 8 * i); }
}
__device__ __forceinline__ float dot32q(const float* q, const bf16* kp) {
    float kf[32]; ld32(kp, kf); float s = 0.f;
#pragma unroll
    for (int i = 0; i < 32; ++i) s += q[i] * kf[i];
    s += __shfl_xor(s, 1); s += __shfl_xor(s, 2);
    return s;
}
__device__ __forceinline__ void axpy32(float* o, float p, const bf16* vp) {
    float vf[32]; ld32(vp, vf);
#pragma unroll
    for (int i = 0; i < 32; ++i) o[i] += p * vf[i];
}
__device__ __forceinline__ void st32(bf16* p, const float* f) {
#pragma unroll
    for (int i = 0; i < 4; ++i) { v4u w; w.x = pk2(f[8 * i], f[8 * i + 1]); w.y = pk2(f[8 * i + 2], f[8 * i + 3]); w.z = pk2(f[8 * i + 4], f[8 * i + 5]); w.w = pk2(f[8 * i + 6], f[8 * i + 7]); *(v4u*)(p + 8 * i) = w; }
}
#define OSM_STEP(s_, valid_, vptr_) do { if (valid_) { const float mn_ = fmaxf(m, (s_)); const float al_ = fast_exp(m - mn_); const float pp_ = fast_exp((s_) - mn_); \
        l = l * al_ + pp_; _Pragma("unroll") for (int i_ = 0; i_ < 32; ++i_) o[i_] *= al_; axpy32(o, pp_, (vptr_)); m = mn_; } } while (0)

__device__ __forceinline__ void p3_nsa_naive(Frame& F) {
    const bf16* PA = WSP(bf16, WS_PA); const bf16* KC = WSP(bf16, WS_KCMP); const bf16* VC = KC + (size_t)NG * NCMP_P * HD; bf16* MIX = WSP(bf16, WS_MIX);
    LAS float* IMP = (LAS float*)(F.lds + RING_OFF + F.wave * 4096);
    LAS unsigned long long* SELW = (LAS unsigned long long*)(F.lds + RING_OFF + F.wave * 4096 + 2048);
    const int gw = F.vcu * NWAVES + F.wave, NGW = F.G * NWAVES;
    const int dq = F.lane & 3, p = (F.lane >> 2) & 3, ql = F.lane >> 4;
    for (int it = gw; it < NG * (T / 4); it += NGW) {
        const int g = it / (T / 4), tq = it % (T / 4), t = 4 * tq + ql, head = g * 4 + p;
        const float slope = exp2f(-8.0f * (float)(head + 1) / 12.0f);
        float q[32]; ld32(PA + (size_t)t * NA + CA_Q + head * HD + dq * 32, q);
#pragma unroll
        for (int i = 0; i < 32; ++i) q[i] *= QSCALE;
        const float g0 = 1.0f / (1.0f + fast_exp(-bf2f(PA[(size_t)t * NA + CA_GT + head * 3 + 0])));
        const float g1 = 1.0f / (1.0f + fast_exp(-bf2f(PA[(size_t)t * NA + CA_GT + head * 3 + 1])));
        const float g2 = 1.0f / (1.0f + fast_exp(-bf2f(PA[(size_t)t * NA + CA_GT + head * 3 + 2])));
        float otot[32];
#pragma unroll
        for (int i = 0; i < 32; ++i) otot[i] = 0.f;
        for (int i = F.lane; i < 512; i += 64) IMP[i] = 0.f;
        LDS_WAIT(); asm volatile("" ::: "memory");
        const int jmax = (t >= 31) ? (t - 31) / 16 : -1;
        const int jmax_w = (4 * tq + 3 >= 31) ? (4 * tq + 3 - 31) / 16 : -1;
        const bf16* kcg = KC + (size_t)g * NCMP_P * HD + dq * 32; const bf16* vcg = VC + (size_t)g * NCMP_P * HD + dq * 32;
        {
            float m = -1e30f, l = 0.f;
            for (int j = 0; j <= jmax_w; ++j) {
                const float s = dot32q(q, kcg + (size_t)j * HD) - slope * (float)(t - (16 * j + 31));
                if (j <= jmax) { const float mn = fmaxf(m, s); l = l * fast_exp(m - mn) + fast_exp(s - mn); m = mn; }
            }
            const float rl = (l > 0.f) ? 1.0f / l : 0.f;
            float o[32];
#pragma unroll
            for (int i = 0; i < 32; ++i) o[i] = 0.f;
            for (int j = 0; j <= jmax_w; ++j) {
                const float s = dot32q(q, kcg + (size_t)j * HD) - slope * (float)(t - (16 * j + 31));
                const float pj = (j <= jmax) ? fast_exp(s - m) * rl : 0.f;
                axpy32(o, pj, vcg + (size_t)j * HD);
                float ps = pj; ps += __shfl_xor(ps, 4); ps += __shfl_xor(ps, 8);
                if (dq == 0 && p == 0) { IMP[ql * 128 + (j >> 2)] += ps; if ((j & 3) == 3 && (j >> 2) + 1 < 128) IMP[ql * 128 + (j >> 2) + 1] += ps; }
            }
#pragma unroll
            for (int i = 0; i < 32; ++i) otot[i] += g0 * o[i];
        }
        LDS_WAIT(); asm volatile("" ::: "memory");
        for (int qq = 0; qq < 4; ++qq) {
            const int tt = 4 * tq + qq, cur = tt >> 6;
            const int b0 = F.lane, b1 = F.lane + 64;
            const float s0 = (b0 == cur) ? 2e6f : (b0 == 0 ? 1e6f : (b0 * 64 <= tt ? IMP[qq * 128 + b0] : -1e6f));
            const float s1 = (b1 == cur) ? 2e6f : (b1 * 64 <= tt ? IMP[qq * 128 + b1] : -1e6f);
            int r0 = 0, r1 = 0;
            for (int b = 0; b < 128; ++b) {
                const float sb = (b == cur) ? 2e6f : (b == 0 ? 1e6f : (b * 64 <= tt ? IMP[qq * 128 + b] : -1e6f));
                r0 += (sb > s0 || (sb == s0 && b < b0)) ? 1 : 0;
                r1 += (sb > s1 || (sb == s1 && b < b1)) ? 1 : 0;
            }
            const unsigned long long m0 = __ballot(r0 < 16 && b0 * 64 <= tt), m1 = __ballot(r1 < 16 && b1 * 64 <= tt);
            if (F.lane == 0) { SELW[qq * 2] = m0; SELW[qq * 2 + 1] = m1; }
        }
        LDS_WAIT(); asm volatile("" ::: "memory");
        {
            const unsigned long long my0 = SELW[ql * 2], my1 = SELW[ql * 2 + 1];
            const unsigned long long u0v = SELW[0] | SELW[2] | SELW[4] | SELW[6], u1v = SELW[1] | SELW[3] | SELW[5] | SELW[7];
            const unsigned long long u0 = ((unsigned long long)(unsigned)__builtin_amdgcn_readfirstlane((int)(u0v >> 32)) << 32) | (unsigned)__builtin_amdgcn_readfirstlane((int)(unsigned)u0v);
            const unsigned long long u1 = ((unsigned long long)(unsigned)__builtin_amdgcn_readfirstlane((int)(u1v >> 32)) << 32) | (unsigned)__builtin_amdgcn_readfirstlane((int)(unsigned)u1v);
            float m = -1e30f, l = 0.f, o[32];
#pragma unroll
            for (int i = 0; i < 32; ++i) o[i] = 0.f;
            const bf16* kg = PA + CA_KS + g * HD + dq * 32; const bf16* vg = PA + CA_VS + g * HD + dq * 32;
            for (int b = 0; b < 128; ++b) {
                const bool inu = (b < 64) ? ((u0 >> b) & 1ull) : ((u1 >> (b - 64)) & 1ull);
                if (!inu) continue;
                const bool mine = (b < 64) ? ((my0 >> b) & 1ull) : ((my1 >> (b - 64)) & 1ull);
                for (int k = 0; k < 64; ++k) {
                    const int kp = b * 64 + k;
                    const float s = dot32q(q, kg + (size_t)kp * NA) - slope * (float)(t - kp);
                    const bool valid = mine && kp <= t;
                    OSM_STEP(s, valid, vg + (size_t)kp * NA);
                }
            }
            const float sc = (l > 0.f) ? g1 / l : 0.f;
#pragma unroll
            for (int i = 0; i < 32; ++i) otot[i] += sc * o[i];
        }
        {
            float m = -1e30f, l = 0.f, o[32];
#pragma unroll
            for (int i = 0; i < 32; ++i) o[i] = 0.f;
            const bf16* kg = PA + CA_KW + g * HD + dq * 32; const bf16* vg = PA + CA_VW + g * HD + dq * 32;
            const int klo = (4 * tq - 511 > 0) ? 4 * tq - 511 : 0, khi = 4 * tq + 3;
            for (int kp = klo; kp <= khi; ++kp) {
                const float s = dot32q(q, kg + (size_t)kp * NA) - slope * (float)(t - kp);
                const bool valid = kp <= t && (t - kp) < 512;
                OSM_STEP(s, valid, vg + (size_t)kp * NA);
            }
            const float sc = (l > 0.f) ? g2 / l : 0.f;
#pragma unroll
            for (int i = 0; i < 32; ++i) otot[i] += sc * o[i];
        }
        st32(MIX + (size_t)t * DM + head * HD + dq * 32, otot);
    }
}
__device__ __forceinline__ void mem_attn_naive(Frame& F, const bf16* P, int ldp, int qcol, const float* qg, int layer) {
    const bf16* MKV = WSP(bf16, WS_MKV); bf16* MIX = WSP(bf16, WS_MIX);
    const int gw = F.vcu * NWAVES + F.wave, NGW = F.G * NWAVES;
    const int dq = F.lane & 3, r = F.lane >> 2;
    for (int it = gw; it < NMEMH * (T / 16); it += NGW) {
        const int hm = it / (T / 16), t = 16 * (it % (T / 16)) + r;
        float q[32]; ld32(P + (size_t)t * ldp + qcol + hm * HD + dq * 32, q);
        float ss = 0.f;
#pragma unroll
        for (int i = 0; i < 32; ++i) ss += q[i] * q[i];
        ss += __shfl_xor(ss, 1); ss += __shfl_xor(ss, 2);
        const float rs = (1.0f / sqrtf(ss * (1.f / HD) + EPS)) * QSCALE;
#pragma unroll
        for (int i = 0; i < 32; ++i) q[i] = q[i] * rs * qg[dq * 32 + i];
        float m = -1e30f, l = 0.f, o[32];
#pragma unroll
        for (int i = 0; i < 32; ++i) o[i] = 0.f;
        const bf16* kg = MKV + layer * 1024 + hm * HD + dq * 32; const bf16* vg = kg + 512;
        for (int k = 0; k < MEMT; ++k) {
            const float s = dot32q(q, kg + (size_t)k * 2048);
            OSM_STEP(s, true, vg + (size_t)k * 2048);
        }
        const float sc = 1.0f / l;
#pragma unroll
        for (int i = 0; i < 32; ++i) o[i] *= sc;
        st32(MIX + (size_t)t * DM + NMIX * HD + hm * HD + dq * 32, o);
    }
}
__device__ __forceinline__ void stick_naive(Frame& F) {
    const bf16* PB = WSP(bf16, WS_PB); bf16* MIX = WSP(bf16, WS_MIX);
    const int gw = F.vcu * NWAVES + F.wave, NGW = F.G * NWAVES;
    const int dq = F.lane & 3, r = F.lane >> 2;
    for (int it = gw; it < NMIX * (T / 16); it += NGW) {
        const int h = it / (T / 16), t = 16 * (it % (T / 16)) + r;
        float q[32]; ld32(PB + (size_t)t * NB + CB_Q + h * HD + dq * 32, q);
#pragma unroll
        for (int i = 0; i < 32; ++i) q[i] *= QSCALE;
        float R = 0.f, o[32];
#pragma unroll
        for (int i = 0; i < 32; ++i) o[i] = 0.f;
        const bf16* kg = PB + CB_K + h * HD + dq * 32; const bf16* vg = PB + CB_V + h * HD + dq * 32;
        for (int i = 1; ; ++i) {
            const int s = t - i;
            const bool act = s >= 0 && R > -80.f;
            if (!__any(act)) break;
            const int sc = s >= 0 ? s : 0;
            const float z = dot32q(q, kg + (size_t)sc * NB);
            const float sp = fmaxf(z, 0.f) + __logf(1.0f + fast_exp(-fabsf(z)));
            if (act) { const float a = fast_exp(z - sp + R); axpy32(o, a, vg + (size_t)sc * NB); R -= sp; }
        }
        st32(MIX + (size_t)t * DM + h * HD + dq * 32, o);
    }
}

__device__ __forceinline__ void p12_router(Frame& F) {
    const float* X3 = WSP(float, WS_X3); bf16* XN = WSP(bf16, WS_XN);
    int* TOPI = (int*)(F.ws + WS_ROUTE + RT_TOPI); float* TOPW = (float*)(F.ws + WS_ROUTE + RT_TOPW); int* HIST = (int*)(F.ws + WS_ROUTE + RT_HIST);
    const float* rw = F.in[18]; const float* rb = F.in[19]; const float* gn = F.in[4] + DM;
    LAS int* hist = (LAS int*)(F.lds + RING_OFF);
    for (int c = F.vcu; c < 256; c += F.G) {
        if (F.tid < 8) hist[F.tid] = 0;
        __syncthreads();
        for (int i = 0; i < 4; ++i) {
            const int t = 32 * c + 4 * F.wave + i;
            const f32x4* xr = (const f32x4*)(X3 + (size_t)t * DM) + F.lane;
            f32x4 v[8]; float s = 0.f;
#pragma unroll
            for (int j = 0; j < 8; ++j) { v[j] = xr[64 * j]; s += (v[j].x * v[j].x + v[j].y * v[j].y) + (v[j].z * v[j].z + v[j].w * v[j].w); }
            const float rstd = 1.0f / sqrtf(wave_sum(s) * (1.f / DM) + EPS);
            v2u* o8 = (v2u*)(XN + (size_t)t * DM) + F.lane;
            float lg[8];
#pragma unroll
            for (int e = 0; e < 8; ++e) lg[e] = 0.f;
#pragma unroll
            for (int j = 0; j < 8; ++j) {
                v2u w; w.x = pk2(v[j].x * rstd, v[j].y * rstd); w.y = pk2(v[j].z * rstd, v[j].w * rstd); o8[64 * j] = w;
                const int k0 = 4 * (F.lane + 64 * j);
#pragma unroll
                for (int e4 = 0; e4 < 4; ++e4) {
                    const float xg = v[j][e4] * gn[k0 + e4];
                    const f32x4 ra = *(const f32x4*)(rw + (size_t)(k0 + e4) * 8), rb4 = *(const f32x4*)(rw + (size_t)(k0 + e4) * 8 + 4);
                    lg[0] += xg * ra.x; lg[1] += xg * ra.y; lg[2] += xg * ra.z; lg[3] += xg * ra.w; lg[4] += xg * rb4.x; lg[5] += xg * rb4.y; lg[6] += xg * rb4.z; lg[7] += xg * rb4.w;
                }
            }
#pragma unroll
            for (int e = 0; e < 8; ++e) lg[e] = wave_sum(lg[e]) * rstd;
            if (F.lane == 0) {
                int i0 = 0; float b0 = lg[0] + rb[0];
#pragma unroll
                for (int e = 1; e < 8; ++e) { const float b = lg[e] + rb[e]; if (b > b0) { b0 = b; i0 = e; } }
                int i1 = -1; float b1 = -3.0e38f;
#pragma unroll
                for (int e = 0; e < 8; ++e) { const float b = lg[e] + rb[e]; if (e != i0 && b > b1) { b1 = b; i1 = e; } }
                float l0 = 0.f, l1 = 0.f;
#pragma unroll
                for (int e = 0; e < 8; ++e) { l0 = (e == i0) ? lg[e] : l0; l1 = (e == i1) ? lg[e] : l1; }
                const float w0 = 1.0f / (1.0f + expf(l1 - l0));
                TOPI[2 * t] = i0; TOPI[2 * t + 1] = i1; TOPW[2 * t] = w0; TOPW[2 * t + 1] = 1.0f - w0;
                atomicAdd((int*)&hist[i0], 1); atomicAdd((int*)&hist[i1], 1);
            }
        }
        __syncthreads();
        if (F.tid < 8) HIST[c * 8 + F.tid] = hist[F.tid];
        __syncthreads();
    }
}
__device__ __forceinline__ void p13_assign(Frame& F) {
    const bf16* XN = WSP(bf16, WS_XN); bf16* AM = WSP(bf16, WS_AMOE);
    const int* TOPI = (const int*)(F.ws + WS_ROUTE + RT_TOPI); int* ROW = (int*)(F.ws + WS_ROUTE + RT_ROW); const int* HIST = (const int*)(F.ws + WS_ROUTE + RT_HIST);
    int* TILE = (int*)(F.ws + WS_ROUTE + RT_TILE);
    LAS int* sh = (LAS int*)(F.lds + RING_OFF);
    for (int c = F.vcu; c < 256; c += F.G) {
        if (F.tid < 16) sh[16 + F.tid] = 0;
        __syncthreads();
        for (int i = F.tid; i < 2048; i += 512) { const int v = HIST[i], cc = i >> 3, ee = i & 7;
            __hip_atomic_fetch_add(&sh[16 + ee], v, __ATOMIC_RELAXED, __HIP_MEMORY_SCOPE_WORKGROUP);
            if (cc < c) __hip_atomic_fetch_add(&sh[24 + ee], v, __ATOMIC_RELAXED, __HIP_MEMORY_SCOPE_WORKGROUP); }
        __syncthreads();
        if (F.tid < 8) {
            const int e = F.tid; int off = 0;
            for (int ee = 0; ee < 8; ++ee) { if (ee == e) break; off += (sh[16 + ee] + 255) & ~255; }
            sh[e] = off + sh[24 + e];
            if (c == 0 && e == 0) {
                int nt = 0;
                for (int ee = 0; ee < 8; ++ee) { const int n = (sh[16 + ee] + 255) >> 8; for (int i = 0; i < n; ++i) TILE[16 + nt + i] = ee; nt += n; }
                TILE[0] = nt;
            }
        }
        __syncthreads();
        if (F.wave == 0) {
            const int tl = F.lane >> 1, sl = F.lane & 1, t = 32 * c + tl;
            const int e = TOPI[2 * t + sl];
            int row = 0;
            for (int ee = 0; ee < 8; ++ee) {
                const unsigned long long mk = __ballot(e == ee);
                if (e == ee) row = sh[ee] + __popcll(mk & ((1ull << F.lane) - 1ull));
            }
            ROW[2 * t + sl] = row; sh[64 + F.lane] = row;
        }
        __syncthreads();
        for (int i = 0; i < 8; ++i) {
            const int idx = 8 * F.wave + i, t = 32 * c + (idx >> 1), row = sh[64 + idx];
            const v4u* src = (const v4u*)(XN + (size_t)t * DM); v4u* dst = (v4u*)(AM + (size_t)row * DM);
#pragma unroll
            for (int j = 0; j < 4; ++j) dst[F.lane + 64 * j] = src[F.lane + 64 * j];
        }
        __syncthreads();
    }
}
__device__ __forceinline__ void p16_combine(Frame& F) {
    const float* X3 = WSP(float, WS_X3); const bf16* Y = WSP(bf16, WS_YMOE);
    const int* ROW = (const int*)(F.ws + WS_ROUTE + RT_ROW); const float* TOPW = (const float*)(F.ws + WS_ROUTE + RT_TOPW);
    const int gw = F.vcu * NWAVES + F.wave, NGW = F.G * NWAVES;
    for (int t = gw; t < T; t += NGW) {
        const int r0 = ROW[2 * t], r1 = ROW[2 * t + 1]; const float w0 = TOPW[2 * t], w1 = TOPW[2 * t + 1];
        const v4u* y0 = (const v4u*)(Y + (size_t)r0 * DM); const v4u* y1 = (const v4u*)(Y + (size_t)r1 * DM);
        const f32x4* xr = (const f32x4*)(X3 + (size_t)t * DM); f32x4* orow = (f32x4*)(F.out + (size_t)t * DM);
#pragma unroll
        for (int j = 0; j < 4; ++j) {
            const int c8 = F.lane + 64 * j;
            float a[8], b[8]; unpack8(y0[c8], a); unpack8(y1[c8], b);
            const f32x4 xa = xr[2 * c8], xb = xr[2 * c8 + 1];
            orow[2 * c8] = (f32x4){xa.x + w0 * a[0] + w1 * b[0], xa.y + w0 * a[1] + w1 * b[1], xa.z + w0 * a[2] + w1 * b[2], xa.w + w0 * a[3] + w1 * b[3]};
            orow[2 * c8 + 1] = (f32x4){xb.x + w0 * a[4] + w1 * b[4], xb.y + w0 * a[5] + w1 * b[5], xb.z + w0 * a[6] + w1 * b[6], xb.w + w0 * a[7] + w1 * b[7]};
        }
    }
}

namespace at {
typedef short bf16x8 __attribute__((ext_vector_type(8)));
typedef short s16x4 __attribute__((ext_vector_type(4)));
typedef float f32x16 __attribute__((ext_vector_type(16)));
constexpr int SHM_T = 16384;
constexpr int L_V = 0, L_K = 2 * SHM_T, L_WS = 4 * SHM_T, L_IMP = L_WS + 8 * 256, L_SEL = L_IMP + 64 * 128 * 4, L_PS = L_SEL + 1024, L_WU = L_PS + 8 * 2176, L_LIST = L_WU + 128, L_DONE = L_LIST + 512, L_END = L_DONE + 64;
static_assert(L_END <= RING_BYTES, "attention LDS map");
constexpr float C2 = 0.08838834764831845f * 1.4426950408889634f;
constexpr float LOG2E = 1.4426950408889634f;

#define KSWZ(row, colB) ((row) * 256 + ((colB) ^ (((row) & 7) << 4)))
#define SBAR() __builtin_amdgcn_sched_barrier(0)
__device__ __forceinline__ int v_st(int k, int c) { const int kk = (k & ~0xC) | ((k & 4) << 1) | ((k & 8) >> 1); return ((kk >> 3) * 4 + (c >> 5)) * 512 + ((kk & 7) * 32 + (c & 31)) * 2; }
__device__ __forceinline__ int v_rd_base(int lane) { return ((lane & 3) << 3) | (((lane >> 2) & 3) << 6) | (((lane >> 4) & 1) << 5) | (((lane >> 5) & 1) << 8); }
constexpr int v_rd_off(int d0, int ks, int half) { return d0 * 512 + ks * 4096 + half * 2048; }
__device__ __forceinline__ int crow(int r, int hi) { return (r & 3) + 8 * (r >> 2) + 4 * hi; }
__device__ __forceinline__ unsigned cvtpk(float lo, float hi) { unsigned r; asm volatile("v_cvt_pk_bf16_f32 %0, %1, %2" : "=v"(r) : "v"(lo), "v"(hi)); return r; }
__device__ __forceinline__ float xhalf_max(float v) { auto rr = __builtin_amdgcn_permlane32_swap(__float_as_uint(v), __float_as_uint(v), false, false); return fmaxf(__uint_as_float(rr[0]), __uint_as_float(rr[1])); }
__device__ __forceinline__ float xhalf_sum(float v) { auto rr = __builtin_amdgcn_permlane32_swap(__float_as_uint(v), __float_as_uint(v), false, false); return __uint_as_float(rr[0]) + __uint_as_float(rr[1]); }
__device__ __forceinline__ float quad_sum(float x) {
    x += __int_as_float(__builtin_amdgcn_update_dpp(0, __float_as_int(x), 0xB1, 0xF, 0xF, true));
    x += __int_as_float(__builtin_amdgcn_update_dpp(0, __float_as_int(x), 0x4E, 0xF, 0xF, true));
    return x;
}
__device__ __forceinline__ void pack_p(const f32x16& p0, const f32x16& p1, bf16x8& pa0, bf16x8& pa1, bf16x8& pa2, bf16x8& pa3) {
#define PK4(P, B_, OUT) do { unsigned a0 = cvtpk(P[B_+0], P[B_+1]), a1 = cvtpk(P[B_+2], P[B_+3]);                          \
        unsigned b0 = cvtpk(P[B_+4], P[B_+5]), b1 = cvtpk(P[B_+6], P[B_+7]);                                             \
        auto r0 = __builtin_amdgcn_permlane32_swap(a0, b0, false, false); auto r1 = __builtin_amdgcn_permlane32_swap(a1, b1, false, false); \
        v4u w = {r0[0], r1[0], r0[1], r1[1]}; OUT = *reinterpret_cast<bf16x8*>(&w); } while (0)
    PK4(p0, 0, pa0); PK4(p0, 8, pa1); PK4(p1, 0, pa2); PK4(p1, 8, pa3);
#undef PK4
}
template <int KB>
__device__ __forceinline__ void qkt(f32x16& p0, f32x16& p1, LAS unsigned char* lds, int r32, int hi, const bf16x8* qr) {
    p0 = f32x16{}; p1 = f32x16{};
    LAS unsigned char* kb[4];
#pragma unroll
    for (int dd = 0; dd < 4; ++dd) kb[dd] = lds + L_K + KB * SHM_T + KSWZ(r32, (dd * 16 + hi * 8) * 2);
#pragma unroll
    for (int d0 = 0; d0 < 8; ++d0) { LAS unsigned char* a = kb[d0 & 3] + (d0 >> 2) * 128;
        const bf16x8 b0 = *(const LAS bf16x8*)a;
        const bf16x8 b1 = *(const LAS bf16x8*)(a + 32 * 256);
        p0 = __builtin_amdgcn_mfma_f32_32x32x16_bf16(b0, qr[d0], p0, 0, 0, 0);
        p1 = __builtin_amdgcn_mfma_f32_32x32x16_bf16(b1, qr[d0], p1, 0, 0, 0); }
}
template <int VB>
__device__ __forceinline__ void pv_tile(f32x16* o, int vb0, bf16x8 pa0, bf16x8 pa1, bf16x8 pa2, bf16x8 pa3) {
#define TRRD(dst, off) asm volatile("ds_read_b64_tr_b16 %0, %1 offset:%2" : "=&v"(dst) : "v"(vb0), "i"(off) : "memory")
#define PV_D0(d0) do { s16x4 l0, l1, l2, l3, h0, h1, h2, h3; constexpr int b_ = VB * SHM_T + v_rd_off(d0, 0, 0); \
        TRRD(l0, b_); TRRD(h0, b_ + 2048); TRRD(l1, b_ + 4096); TRRD(h1, b_ + 6144); TRRD(l2, b_ + 8192); TRRD(h2, b_ + 10240); TRRD(l3, b_ + 12288); TRRD(h3, b_ + 14336); \
        asm volatile("s_waitcnt lgkmcnt(0)" ::: "memory"); SBAR();   \
        o[d0] = __builtin_amdgcn_mfma_f32_32x32x16_bf16(pa0, (bf16x8){l0[0], l0[1], l0[2], l0[3], h0[0], h0[1], h0[2], h0[3]}, o[d0], 0, 0, 0);   \
        o[d0] = __builtin_amdgcn_mfma_f32_32x32x16_bf16(pa1, (bf16x8){l1[0], l1[1], l1[2], l1[3], h1[0], h1[1], h1[2], h1[3]}, o[d0], 0, 0, 0);   \
        o[d0] = __builtin_amdgcn_mfma_f32_32x32x16_bf16(pa2, (bf16x8){l2[0], l2[1], l2[2], l2[3], h2[0], h2[1], h2[2], h2[3]}, o[d0], 0, 0, 0);   \
        o[d0] = __builtin_amdgcn_mfma_f32_32x32x16_bf16(pa3, (bf16x8){l3[0], l3[1], l3[2], l3[3], h3[0], h3[1], h3[2], h3[3]}, o[d0], 0, 0, 0); } while (0)
    PV_D0(0); PV_D0(1); PV_D0(2); PV_D0(3);
#undef PV_D0
#undef TRRD
}
struct Stg { v4u a, b; };
struct Tile { const bf16* K; const bf16* V; size_t ld; };
__device__ __forceinline__ void stg_load(Stg& S, const bf16* base, size_t ld, int sr, int sc) {
    S.a = *(const v4u*)(base + (size_t)sr * ld + sc); S.b = *(const v4u*)(base + (size_t)(32 + sr) * ld + sc);
}
template <int BUF> __device__ __forceinline__ void stg_write_k(const Stg& S, LAS unsigned char* lds, int sr, int sc) {
    const int kws = KSWZ(sr, sc * 2);
    *(LAS v4u*)(lds + L_K + BUF * SHM_T + kws) = S.a; *(LAS v4u*)(lds + L_K + BUF * SHM_T + kws + 32 * 256) = S.b;
}
template <int BUF> __device__ __forceinline__ void stg_write_v(const Stg& S, LAS unsigned char* lds, int sr, int sc) {
    *(LAS v4u*)(lds + L_V + BUF * SHM_T + v_st(sr, sc)) = S.a; *(LAS v4u*)(lds + L_V + BUF * SHM_T + v_st(32 + sr, sc)) = S.b;
}

template <int PASS, int KB, class Br>
__device__ __forceinline__ void step(Br& br, int i, Stg& S, LAS unsigned char* lds, int tid, const bf16x8* qr, float& m2, float& l, float f, f32x16* o) {
    int tz = tid; asm volatile("" : "+v"(tz));
    const int lane = tz & 63, sr = tz >> 4, sc = (tz & 15) * 8, r32 = lane & 31, hi = lane >> 5;
    const int vb0 = (int)(uintptr_t)(lds + L_V) + v_rd_base(lane);
    const bool more = (i + 1 < br.nt);
    Tile nx = br.tile(more ? i + 1 : i);
    if (more) stg_load(S, nx.K, nx.ld, sr, sc);
    SBAR();
    if (br.act(i)) {
        f32x16 p0, p1;
        qkt<KB>(p0, p1, lds, r32, hi, qr);
        SBAR();
        br.scores(p0, p1, i, lane);
        if (PASS == 1) {
            float pmax = p0[0];
#pragma unroll
            for (int r = 1; r < 16; ++r) pmax = fmaxf(pmax, p0[r]);
#pragma unroll
            for (int r = 0; r < 16; ++r) pmax = fmaxf(pmax, p1[r]);
            pmax = xhalf_max(pmax);
            const float mn = fmaxf(m2, pmax);
            float ps = 0.f;
#pragma unroll
            for (int r = 0; r < 16; ++r) ps += __builtin_amdgcn_exp2f(p0[r] - mn) + __builtin_amdgcn_exp2f(p1[r] - mn);
            ps = xhalf_sum(ps);
            l = l * __builtin_amdgcn_exp2f(m2 - mn) + ps; m2 = mn;
        } else {
#pragma unroll
            for (int r = 0; r < 16; ++r) { p0[r] = __builtin_amdgcn_exp2f(p0[r] - m2) * f; p1[r] = __builtin_amdgcn_exp2f(p1[r] - m2) * f; }
            br.hook(p0, p1, i, lane);
            SBAR();
            if (more) { stg_write_k<KB ^ 1>(S, lds, sr, sc); SBAR(); stg_load(S, nx.V, nx.ld, sr, sc); SBAR(); }
            bf16x8 pa0, pa1, pa2, pa3; pack_p(p0, p1, pa0, pa1, pa2, pa3);
            SBAR();
            pv_tile<KB>(o, vb0, pa0, pa1, pa2, pa3);
            SBAR();
            if (more) stg_write_v<KB ^ 1>(S, lds, sr, sc);
        }
    } else if (PASS == 2) { if (more) { stg_write_k<KB ^ 1>(S, lds, sr, sc); SBAR(); stg_load(S, nx.V, nx.ld, sr, sc); SBAR(); stg_write_v<KB ^ 1>(S, lds, sr, sc); } }
    SBAR();
    if (PASS == 1) { if (more) stg_write_k<KB ^ 1>(S, lds, sr, sc); }
    __syncthreads();
}
template <int PASS, class Br>
__device__ __forceinline__ void run_pass(Br& br, LAS unsigned char* lds, int tid, const bf16x8* qr, float& m2, float& l, float f, f32x16* o) {
    if (br.nt <= 0) return;
    const int sr = tid >> 4, sc = (tid & 15) * 8;
    Stg S;
    { const Tile t0 = br.tile(0); stg_load(S, t0.K, t0.ld, sr, sc); stg_write_k<0>(S, lds, sr, sc);
      if (PASS == 2) { stg_load(S, t0.V, t0.ld, sr, sc); stg_write_v<0>(S, lds, sr, sc); } }
    __syncthreads();
    for (int i = 0; i < br.nt; i += 2) {
        step<PASS, 0>(br, i, S, lds, tid, qr, m2, l, f, o);
        if (i + 1 < br.nt) step<PASS, 1>(br, i + 1, S, lds, tid, qr, m2, l, f, o);
    }
}
__device__ __forceinline__ void scale_rows(f32x16* o, float frow, LAS float* ws, int lane) {
    const int r32 = lane & 31, hi = lane >> 5;
    if (hi == 0) ws[r32] = frow;
    LDS_WAIT(); asm volatile("" ::: "memory");
#pragma unroll
    for (int r = 0; r < 16; ++r) { const float a = ws[crow(r, hi)];
#pragma unroll
        for (int d0 = 0; d0 < 4; ++d0) o[d0][r] *= a; }
    LDS_WAIT(); asm volatile("" ::: "memory");
}
__device__ __forceinline__ void load_q(bf16x8* qr, const bf16* qrow, int hi) {
#pragma unroll
    for (int d0 = 0; d0 < 8; ++d0) { const v4u w = *(const v4u*)(qrow + d0 * 16 + hi * 8); qr[d0] = *reinterpret_cast<const bf16x8*>(&w); }
}

struct RowNsa { int t; float slope2; };
struct BrCmp {
    int nt; const bf16* K; const bf16* V; int jmax_w; RowNsa R;
    LAS float* ps; LAS float* imp;
    __device__ __forceinline__ Tile tile(int i) const { return Tile{K + (size_t)i * 64 * HD, V + (size_t)i * 64 * HD, (size_t)HD}; }
    __device__ __forceinline__ bool act(int i) const { return 64 * i <= jmax_w; }
    __device__ __forceinline__ void scores(f32x16& p0, f32x16& p1, int i, int lane) const {
        const float NEG = -__builtin_inff(); const int hi = lane >> 5;
        float sl = R.slope2; asm volatile("" : "+v"(sl));
        int tt = R.t; asm volatile("" : "+v"(tt));
        const int jmax = (tt >= 31) ? ((tt - 31) >> 4) : -1;
        const int jm = jmax - 64 * i - 4 * hi;
        const float b0 = -sl * (float)(tt - 31 - 16 * (64 * i + 4 * hi));
#pragma unroll
        for (int r = 0; r < 16; ++r) { const int c = (r & 3) + 8 * (r >> 2);
            p0[r] = (c <= jm) ? fmaf(p0[r], C2, fmaf(sl, (float)(16 * c), b0)) : NEG;
            p1[r] = (c + 32 <= jm) ? fmaf(p1[r], C2, fmaf(sl, (float)(16 * c + 512), b0)) : NEG; }
    }
    __device__ __forceinline__ void hook(const f32x16& p0, const f32x16& p1, int i, int lane) const {
        const int r32 = lane & 31, hi = lane >> 5, pp = r32 & 3, ql = r32 >> 2;
#pragma unroll
        for (int qd = 0; qd < 4; ++qd) {
            f32x4 a, b;
#pragma unroll
            for (int e = 0; e < 4; ++e) { a[e] = quad_sum(p0[4 * qd + e]); b[e] = quad_sum(p1[4 * qd + e]); }
            if (pp == qd) { *(LAS f32x4*)(ps + ql * 68 + 4 + 8 * qd + 4 * hi) = a; *(LAS f32x4*)(ps + ql * 68 + 4 + 32 + 8 * qd + 4 * hi) = b; }
        }
        LDS_WAIT(); asm volatile("" ::: "memory");
#pragma unroll
        for (int h2 = 0; h2 < 2; ++h2) { const int idx = lane + 64 * h2, q8 = idx >> 4, mq = idx & 15;
            const f32x4 v = *(const LAS f32x4*)(ps + q8 * 68 + 4 + 4 * mq); const float pv = ps[q8 * 68 + 3 + 4 * mq];
            imp[q8 * 128 + 16 * i + mq] = (v[0] + v[1]) + (v[2] + v[3]) + pv; }
        LDS_WAIT(); asm volatile("" ::: "memory");
        if (lane < 8) ps[lane * 68 + 3] = ps[lane * 68 + 4 + 63];
        LDS_WAIT(); asm volatile("" ::: "memory");
    }
};
struct BrSlc {
    int nt; const bf16* K; const bf16* V; RowNsa R;
    const LAS int* list; const LAS unsigned long long* sel; const LAS unsigned long long* wu;
    __device__ __forceinline__ int blk(int i) const { return list[i]; }
    __device__ __forceinline__ Tile tile(int i) const { const int b = __builtin_amdgcn_readfirstlane(blk(i)); return Tile{K + (size_t)b * 64 * NA, V + (size_t)b * 64 * NA, (size_t)NA}; }
    __device__ __forceinline__ bool act(int i) const { const int b = __builtin_amdgcn_readfirstlane(blk(i)); const unsigned long long u = wu[b >> 6]; return (u >> (b & 63)) & 1ull; }
    __device__ __forceinline__ void scores(f32x16& p0, f32x16& p1, int i, int lane) const {
        const float NEG = -__builtin_inff(); const int b = __builtin_amdgcn_readfirstlane(blk(i)); const int hi = lane >> 5, ql = (lane & 31) >> 2;
        const unsigned long long mm = sel[ql * 2 + (b >> 6)];
        const bool mine = (mm >> (b & 63)) & 1ull;
        float sl = R.slope2; asm volatile("" : "+v"(sl));
        int tt = R.t; asm volatile("" : "+v"(tt));
        const int dm = mine ? (tt - 64 * b - 4 * hi) : -1;
        const float b0 = -sl * (float)dm;
#pragma unroll
        for (int r = 0; r < 16; ++r) { const int c = (r & 3) + 8 * (r >> 2);
            p0[r] = (c <= dm) ? fmaf(p0[r], C2, fmaf(sl, (float)c, b0)) : NEG;
            p1[r] = (c + 32 <= dm) ? fmaf(p1[r], C2, fmaf(sl, (float)(c + 32), b0)) : NEG; }
    }
    __device__ __forceinline__ void hook(const f32x16&, const f32x16&, int, int) const {}
};
struct BrWin {
    int nt; const bf16* K; const bf16* V; RowNsa R; int kb0;
    __device__ __forceinline__ Tile tile(int i) const { return Tile{K + (size_t)(kb0 + i) * 64 * NA, V + (size_t)(kb0 + i) * 64 * NA, (size_t)NA}; }
    __device__ __forceinline__ bool act(int) const { return true; }
    __device__ __forceinline__ void scores(f32x16& p0, f32x16& p1, int i, int lane) const {
        const float NEG = -__builtin_inff(); const int hi = lane >> 5;
        float sl = R.slope2; asm volatile("" : "+v"(sl));
        int tt = R.t; asm volatile("" : "+v"(tt));
        const int dm = tt - 64 * (kb0 + i) - 4 * hi;
        const float b0 = -sl * (float)dm;
#pragma unroll
        for (int r = 0; r < 16; ++r) { const int c = (r & 3) + 8 * (r >> 2);
            p0[r] = ((unsigned)(dm - c) < 512u) ? fmaf(p0[r], C2, fmaf(sl, (float)c, b0)) : NEG;
            p1[r] = ((unsigned)(dm - c - 32) < 512u) ? fmaf(p1[r], C2, fmaf(sl, (float)(c + 32), b0)) : NEG; }
    }
    __device__ __forceinline__ void hook(const f32x16&, const f32x16&, int, int) const {}
};
struct BrMem {
    int nt; const bf16* K; const bf16* V;
    __device__ __forceinline__ Tile tile(int i) const { return Tile{K + (size_t)i * 64 * 2048, V + (size_t)i * 64 * 2048, (size_t)2048}; }
    __device__ __forceinline__ bool act(int) const { return true; }
    __device__ __forceinline__ void scores(f32x16& p0, f32x16& p1, int, int) const {
#pragma unroll
        for (int r = 0; r < 16; ++r) { p0[r] *= C2; p1[r] *= C2; }
    }
    __device__ __forceinline__ void hook(const f32x16&, const f32x16&, int, int) const {}
};
template <class RP> __device__ __forceinline__ void store_o(const f32x16* o, int lane, RP rowptr) {
    const int r32 = lane & 31, hi = lane >> 5;
#pragma unroll
    for (int r = 0; r < 16; ++r) { bf16* rp = rowptr(crow(r, hi));
#pragma unroll
        for (int d0 = 0; d0 < 4; ++d0) { const float v = o[d0][r]; const float vn = __shfl_xor(v, 1);
            if ((r32 & 1) == 0) *(unsigned*)(rp + d0 * 32 + r32) = cvtpk(v, vn); } }
}
}

__device__ __forceinline__ void topk_select(unsigned k0, unsigned k1, int need, int lane, unsigned long long& s0, unsigned long long& s1) {
    unsigned thr = 0u;
    for (int bit = 31; bit >= 0; --bit) {
        const unsigned cand = thr | (1u << bit);
        const int cnt = __popcll(__ballot(k0 >= cand)) + __popcll(__ballot(k1 >= cand));
        if (cnt >= need) thr = cand;
    }
    const unsigned long long g0 = __ballot(k0 > thr), g1 = __ballot(k1 > thr), e0 = __ballot(k0 == thr && thr != 0u), e1 = __ballot(k1 == thr && thr != 0u);
    const int rem = need - (__popcll(g0) + __popcll(g1));
    const unsigned long long lt = (1ull << lane) - 1ull;
    const bool t0 = (k0 == thr && thr != 0u) && (__popcll(e0 & lt) < rem);
    const bool t1 = (k1 == thr && thr != 0u) && (__popcll(e0) + __popcll(e1 & lt) < rem);
    s0 = g0 | __ballot(t0); s1 = g1 | __ballot(t1);
}

__device__ __forceinline__ void nsa_item(Frame& F, int g, int qb) {
    using namespace at;
    LAS unsigned char* lds = F.lds + RING_OFF;
    const bf16* PA = WSP(bf16, WS_PA); const bf16* KC = WSP(bf16, WS_KCMP) + (size_t)g * NCMP_P * HD; const bf16* VC = KC + (size_t)NG * NCMP_P * HD; bf16* MIX = WSP(bf16, WS_MIX);
    int tz = F.tid; asm volatile("" : "+v"(tz));
    const int lane = tz & 63, w = F.wave, r32 = lane & 31, hi = lane >> 5;
    const int t0 = 64 * qb, tw = t0 + 8 * w, ql = r32 >> 2, pp = r32 & 3, t = tw + ql, head = 4 * g + pp;
    LAS float* ws = (LAS float*)(lds + L_WS + w * 256);
    LAS float* IMP = (LAS float*)(lds + L_IMP) + w * 8 * 128;
    LAS float* PS = (LAS float*)(lds + L_PS + w * 2176);
    LAS unsigned long long* SEL = (LAS unsigned long long*)(lds + L_SEL);
    LAS unsigned long long* WU = (LAS unsigned long long*)(lds + L_WU);
    LAS int* LIST = (LAS int*)(lds + L_LIST);
    RowNsa R; R.t = t; R.slope2 = exp2f(-8.0f * (float)(head + 1) / 12.0f) * LOG2E;
    bf16x8 qr[8]; load_q(qr, PA + (size_t)t * NA + CA_Q + head * HD, hi);
#define GATE(br_) (1.0f / (1.0f + fast_exp(-bf2f(PA[(size_t)t * NA + CA_GT + head * 3 + (br_)]))))
    f32x16 o[4] = {};
    for (int i = lane; i < 8 * 128; i += 64) IMP[i] = 0.f;
    if (lane < 8) PS[lane * 68 + 3] = 0.f;
    LDS_WAIT(); asm volatile("" ::: "memory");
    {
        BrCmp br; br.K = KC; br.V = VC; br.R = R; br.ps = PS; br.imp = IMP;
        br.jmax_w = (tw + 7 >= 31) ? (tw + 7 - 31) / 16 : -1;
        const int jmax_b = (t0 + 63 - 31) / 16;
        br.nt = jmax_b / 64 + 1;
        float m2 = -1e30f, l = 0.f;
        run_pass<1>(br, lds, tz, qr, m2, l, 0.f, o);
        const float f = (l > 0.f) ? 1.0f / l : 0.f;
        run_pass<2>(br, lds, tz, qr, m2, l, f, o);
        scale_rows(o, GATE(0), ws, lane);
    }
    for (int qq = 0; qq < 8; ++qq) {
        const int tt = tw + qq, cur = tt >> 6;
        const int b0 = lane, b1 = lane + 64;
        unsigned long long s0 = 0ull, s1 = 0ull;
        const int ncand = cur - 1;
        const bool c0 = (b0 >= 1 && b0 < cur), c1 = (b1 < cur);
        if (ncand <= 14) { s0 = __ballot(c0); s1 = __ballot(c1); }
        else {
            const unsigned k0 = c0 ? (__float_as_uint(IMP[qq * 128 + b0]) + 1u) : 0u, k1 = c1 ? (__float_as_uint(IMP[qq * 128 + b1]) + 1u) : 0u;
            topk_select(k0, k1, 14, lane, s0, s1);
        }
        s0 |= 1ull;
        if (cur < 64) s0 |= (1ull << cur); else s1 |= (1ull << (cur - 64));
        if (lane == 0) { SEL[(8 * w + qq) * 2] = s0; SEL[(8 * w + qq) * 2 + 1] = s1; }
    }
    LDS_WAIT(); asm volatile("" ::: "memory");
    unsigned long long wu0 = 0ull, wu1 = 0ull;
#pragma unroll
    for (int qq = 0; qq < 8; ++qq) { wu0 |= SEL[(8 * w + qq) * 2]; wu1 |= SEL[(8 * w + qq) * 2 + 1]; }
    if (lane == 0) { WU[2 * w] = wu0; WU[2 * w + 1] = wu1; }
    __syncthreads();
    int nsl = 0;
    {
        unsigned long long u0 = 0ull, u1 = 0ull;
#pragma unroll
        for (int ww = 0; ww < 8; ++ww) { u0 |= WU[2 * ww]; u1 |= WU[2 * ww + 1]; }
        nsl = __popcll(u0) + __popcll(u1);
        if (w == 0) {
            const unsigned long long lt = (1ull << lane) - 1ull;
            if ((u0 >> lane) & 1ull) LIST[__popcll(u0 & lt)] = lane;
            if ((u1 >> lane) & 1ull) LIST[__popcll(u0) + __popcll(u1 & lt)] = lane + 64;
        }
    }
    __syncthreads();
    {
        BrSlc br; br.K = PA + CA_KS + g * HD; br.V = PA + CA_VS + g * HD; br.R = R; br.list = LIST; br.nt = nsl;
        br.sel = SEL + 16 * w; br.wu = WU + 2 * w;
        float m2 = -1e30f, l = 0.f;
        run_pass<1>(br, lds, tz, qr, m2, l, 0.f, o);
        const float f = (l > 0.f) ? GATE(1) / l : 0.f;
        run_pass<2>(br, lds, tz, qr, m2, l, f, o);
    }
    {
        BrWin br; br.K = PA + CA_KW + g * HD; br.V = PA + CA_VW + g * HD; br.R = R;
        br.kb0 = (t0 - 511 > 0) ? ((t0 - 511) >> 6) : 0; br.nt = qb - br.kb0 + 1;
        float m2 = -1e30f, l = 0.f;
        run_pass<1>(br, lds, tz, qr, m2, l, 0.f, o);
        const float f = (l > 0.f) ? GATE(2) / l : 0.f;
        run_pass<2>(br, lds, tz, qr, m2, l, f, o);
    }
    store_o(o, lane, [&](int row) { return MIX + (size_t)(tw + (row >> 2)) * DM + (4 * g + (row & 3)) * HD; });
#undef GATE
}
__device__ __forceinline__ void mem_item(Frame& F, const bf16* P, int ldp, int qcol, const float* qg, int layer, int hm, int qb) {
    using namespace at;
    LAS unsigned char* lds = F.lds + RING_OFF;
    const bf16* MKV = WSP(bf16, WS_MKV); bf16* MIX = WSP(bf16, WS_MIX);
    int tz = F.tid; asm volatile("" : "+v"(tz));
    const int lane = tz & 63, w = F.wave, r32 = lane & 31, hi = lane >> 5;
    const int tw = 256 * qb + 32 * w, t = tw + r32;
    bf16x8 qr[8];
    {
        const bf16* qrow = P + (size_t)t * ldp + qcol + hm * HD;
        float qf[64]; float ss = 0.f;
#pragma unroll
        for (int d0 = 0; d0 < 8; ++d0) { const v4u wv = *(const v4u*)(qrow + d0 * 16 + hi * 8); unpack8(wv, qf + 8 * d0); }
#pragma unroll
        for (int i = 0; i < 64; ++i) ss += qf[i] * qf[i];
        ss = xhalf_sum(ss);
        const float rs = 1.0f / sqrtf(ss * (1.f / HD) + EPS);
#pragma unroll
        for (int d0 = 0; d0 < 8; ++d0) { const float* gp = qg + d0 * 16 + hi * 8;
            v4u wv; wv.x = cvtpk(qf[8 * d0] * rs * gp[0], qf[8 * d0 + 1] * rs * gp[1]); wv.y = cvtpk(qf[8 * d0 + 2] * rs * gp[2], qf[8 * d0 + 3] * rs * gp[3]);
            wv.z = cvtpk(qf[8 * d0 + 4] * rs * gp[4], qf[8 * d0 + 5] * rs * gp[5]); wv.w = cvtpk(qf[8 * d0 + 6] * rs * gp[6], qf[8 * d0 + 7] * rs * gp[7]);
            qr[d0] = *reinterpret_cast<const bf16x8*>(&wv); }
    }
    f32x16 o[4] = {};
    BrMem br; br.nt = 4; br.K = MKV + layer * 1024 + hm * HD; br.V = br.K + 512;
    float m2 = -1e30f, l = 0.f;
    run_pass<1>(br, lds, tz, qr, m2, l, 0.f, o);
    run_pass<2>(br, lds, tz, qr, m2, l, 1.0f / l, o);
    store_o(o, lane, [&](int row) { return MIX + (size_t)(tw + row) * DM + NMIX * HD + hm * HD; });
}
__device__ __forceinline__ void p3_attn(Frame& F) {
    for (int it = F.vcu; it < 384 + 128; it += F.G) {
        if (it < 384) { const int g = it % 3, qb = 127 - it / 3; nsa_item(F, g, qb); }
        else { const int j = it - 384; mem_item(F, WSP(bf16, WS_PA), NA, CA_QM, F.in[14], 0, j & 3, j >> 2); }
        __syncthreads();
    }
}

__device__ __forceinline__ void stick_tile(at::f32x16& p0, at::f32x16& p1, int k0, int t, int hi, float& R2) {
    using namespace at;
    float L0[16], L1[16];
    const float NEG = -__builtin_inff();
#pragma unroll
    for (int r = 0; r < 16; ++r) {
        const int kk = k0 + crow(r, hi);
        { const float z = p0[r] * C2; const float sp = fmaxf(z, 0.f) + __builtin_amdgcn_logf(1.0f + __builtin_amdgcn_exp2f(-fabsf(z))); const bool v = kk < t; L0[r] = v ? -sp : 0.f; p0[r] = v ? z - sp : NEG; }
        { const float z = p1[r] * C2; const float sp = fmaxf(z, 0.f) + __builtin_amdgcn_logf(1.0f + __builtin_amdgcn_exp2f(-fabsf(z))); const bool v = kk + 32 < t; L1[r] = v ? -sp : 0.f; p1[r] = v ? z - sp : NEG; }
    }
    float ct[8], pt[8];
#pragma unroll
    for (int c = 0; c < 4; ++c) { ct[c] = (L0[4 * c] + L0[4 * c + 1]) + (L0[4 * c + 2] + L0[4 * c + 3]); ct[4 + c] = (L1[4 * c] + L1[4 * c + 1]) + (L1[4 * c + 2] + L1[4 * c + 3]); }
#pragma unroll
    for (int c = 0; c < 8; ++c) { auto rr = __builtin_amdgcn_permlane32_swap(__float_as_uint(ct[c]), __float_as_uint(ct[c]), false, false); pt[c] = __uint_as_float(hi ? rr[0] : rr[1]); }
    float E[8]; float run = 0.f;
#pragma unroll
    for (int c = 7; c >= 0; --c) { E[c] = run + (hi == 0 ? pt[c] : 0.f); run += ct[c] + pt[c]; }
#pragma unroll
    for (int c = 0; c < 4; ++c) {
        { const float a3 = R2 + E[c], a2 = a3 + L0[4 * c + 3], a1 = a2 + L0[4 * c + 2], a0 = a1 + L0[4 * c + 1];
          p0[4 * c + 3] = __builtin_amdgcn_exp2f(p0[4 * c + 3] + a3); p0[4 * c + 2] = __builtin_amdgcn_exp2f(p0[4 * c + 2] + a2); p0[4 * c + 1] = __builtin_amdgcn_exp2f(p0[4 * c + 1] + a1); p0[4 * c] = __builtin_amdgcn_exp2f(p0[4 * c] + a0); }
        { const float a3 = R2 + E[4 + c], a2 = a3 + L1[4 * c + 3], a1 = a2 + L1[4 * c + 2], a0 = a1 + L1[4 * c + 1];
          p1[4 * c + 3] = __builtin_amdgcn_exp2f(p1[4 * c + 3] + a3); p1[4 * c + 2] = __builtin_amdgcn_exp2f(p1[4 * c + 2] + a2); p1[4 * c + 1] = __builtin_amdgcn_exp2f(p1[4 * c + 1] + a1); p1[4 * c] = __builtin_amdgcn_exp2f(p1[4 * c] + a0); }
    }
    R2 += run;
}
template <int KB>
__device__ __forceinline__ bool stick_step(int kb, int kb_w, at::Stg& S, LAS unsigned char* lds, int tid, const bf16* Kh, const bf16* Vh, const at::bf16x8* qr, at::f32x16* o, int tw, float& R2, LAS int* DONE) {
    using namespace at;
    int tz = tid; asm volatile("" : "+v"(tz));
    const int lane = tz & 63, w = __builtin_amdgcn_readfirstlane(tz >> 6), r32 = lane & 31, hi = lane >> 5, sr = tz >> 4, sc = (tz & 15) * 8;
    const int vb0 = (int)(uintptr_t)(lds + L_V) + v_rd_base(lane);
    int t = tw + r32; asm volatile("" : "+v"(t));
    const float THR2 = -100.f;
    const bool more = kb > 0;
    const bf16* Kn = Kh + (size_t)(more ? kb - 1 : kb) * 64 * NB; const bf16* Vn = Vh + (size_t)(more ? kb - 1 : kb) * 64 * NB;
    if (more) stg_load(S, Kn, NB, sr, sc);
    SBAR();
    bool wdone = false, kdone = false;
    if (kb <= kb_w) {
        if (__any(R2 > THR2)) {
            f32x16 p0, p1; qkt<KB>(p0, p1, lds, r32, hi, qr);
            SBAR();
            stick_tile(p0, p1, 64 * kb, t, hi, R2);
            SBAR();
            if (more) { stg_write_k<KB ^ 1>(S, lds, sr, sc); SBAR(); stg_load(S, Vn, NB, sr, sc); SBAR(); } kdone = true;
            bf16x8 pa0, pa1, pa2, pa3; pack_p(p0, p1, pa0, pa1, pa2, pa3);
            SBAR();
            pv_tile<KB>(o, vb0, pa0, pa1, pa2, pa3);
            SBAR();
        }
        wdone = !__any(R2 > THR2);
    }
    if (lane == 0) DONE[(kb & 1) * 8 + w] = wdone ? 1 : 0;
    if (more) { if (!kdone) { stg_write_k<KB ^ 1>(S, lds, sr, sc); SBAR(); stg_load(S, Vn, NB, sr, sc); SBAR(); } stg_write_v<KB ^ 1>(S, lds, sr, sc); }
    __syncthreads();
    int alld = 1;
#pragma unroll
    for (int ww = 0; ww < 8; ++ww) alld &= DONE[(kb & 1) * 8 + ww];
    return more && !alld;
}
__device__ __forceinline__ void stick_item(Frame& F, int h, int qb) {
    using namespace at;
    LAS unsigned char* lds = F.lds + RING_OFF;
    const bf16* PB = WSP(bf16, WS_PB); bf16* MIX = WSP(bf16, WS_MIX);
    int tid = F.tid; asm volatile("" : "+v"(tid));
    const int lane = tid & 63, w = F.wave, r32 = lane & 31, hi = lane >> 5, sr = tid >> 4, sc = (tid & 15) * 8;
    const int q0 = 256 * qb, tw = q0 + 32 * w, t = tw + r32;
    LAS int* DONE = (LAS int*)(lds + L_DONE);
    bf16x8 qr[8]; load_q(qr, PB + (size_t)t * NB + CB_Q + h * HD, hi);
    f32x16 o[4] = {};
    const bf16* Kh = PB + CB_K + h * HD; const bf16* Vh = PB + CB_V + h * HD;
    const int kb_hi = q0 / 64 + 3, kb_w = q0 / 64 + (w >> 1);
    float R2 = 0.f;
    Stg S;
    stg_load(S, Kh + (size_t)kb_hi * 64 * NB, NB, sr, sc); stg_write_k<0>(S, lds, sr, sc);
    stg_load(S, Vh + (size_t)kb_hi * 64 * NB, NB, sr, sc); stg_write_v<0>(S, lds, sr, sc);
    __syncthreads();
    for (int kb = kb_hi; ; kb -= 2) {
        if (!stick_step<0>(kb, kb_w, S, lds, tid, Kh, Vh, qr, o, tw, R2, DONE)) break;
        if (!stick_step<1>(kb - 1, kb_w, S, lds, tid, Kh, Vh, qr, o, tw, R2, DONE)) break;
    }
    store_o(o, lane, [&](int row) { return MIX + (size_t)(tw + row) * DM + h * HD; });
}
__device__ __forceinline__ void p10_attn(Frame& F) {
    for (int it = F.vcu; it < 384 + 128; it += F.G) {
        if (it < 384) { const int h = it % 12, qb = 31 - it / 12; stick_item(F, h, qb); }
        else { const int j = it - 384; mem_item(F, WSP(bf16, WS_PB), NB, CB_QM, F.in[14] + 2 * HD, 1, j & 3, j >> 2); }
        __syncthreads();
    }
}

constexpr int N_PHASES = 17;
#ifndef MK_PROBE_MASK
#define MK_PROBE_MASK 0
#endif
#ifndef MK_NAIVE_P3
#define MK_NAIVE_P3 0
#endif
#ifndef MK_NAIVE_P10
#define MK_NAIVE_P10 0
#endif
struct Args { const float* in[22]; float* out; unsigned char* ws; int ph_lo, ph_hi, use_bar, pad; };
__global__ void __launch_bounds__(NWAVES * 64, 2) mk_fwd(Args args) {
    extern __shared__ __attribute__((aligned(16))) unsigned char lds[];
    Frame F;
    F.lds = (LAS unsigned char*)lds;
    F.MISC = (volatile LAS unsigned*)(F.lds + MISC_OFF);
    F.tid = threadIdx.x; F.lane = F.tid & 63; F.wave = __builtin_amdgcn_readfirstlane(F.tid >> 6);
    F.G = gridDim.x; { const int bx = blockIdx.x; F.vcu = (F.G % 8 == 0) ? (bx % 8) * (F.G / 8) + bx / 8 : bx; }
    F.ws = args.ws; F.ctl = (gu32*)(args.ws + WS_CTL); F.out = args.out;
#pragma unroll
    for (int i = 0; i < 22; ++i) F.in[i] = args.in[i];
    for (int u = F.tid; u < (LDS_BYTES - LDSCTL_OFF) / 4; u += NWAVES * 64) ((LAS unsigned*)(F.lds + LDSCTL_OFF))[u] = 0u;
    __syncthreads();
    XcdBarrier bar; bar.bar = (unsigned*)(F.ctl + CW_BAR); bar.x = 0; bar.st = nullptr;
    if (args.use_bar) bar = xcd_barrier_post((unsigned*)(F.ctl + CW_BAR), F.MISC + 8);
#define GRID_BAR() do { if (args.use_bar) xcd_barrier(bar); F.tid = threadIdx.x; asm volatile("" : "+v"(F.tid)); F.lane = F.tid & 63; } while (0)
    const int lo = args.ph_lo, hi = args.ph_hi;
#ifdef MK_ONLY_PHASE
#define IN(k) ((k) == MK_ONLY_PHASE && lo <= (k) && (k) < hi)
#else
#define IN(k) (lo <= (k) && (k) < hi)
#endif
#define BOTH(k) (IN(k) && IN((k) + 1))
    typedef pg8::StaticOrder SO;

    if (IN(0)) { p0_prologue(F); if (BOTH(0)) GRID_BAR(); }
    if (IN(1)) {
        { pg8::Gemm g{WSP(bf16, WS_XN), WSP(bf16, WS_WT_INA), DM}; SO S; S.init(T / 256, NA / 256, F.G, (int)blockIdx.x);
          pg8::EpiBf16 E{WSP(bf16, WS_PA), NA}; pg8::gemm_phase<pg8::EpiBf16, SO, true, true>(F.lds + RING_OFF, g, S, E); }
        { pg8::Gemm g{WSP(bf16, WS_MEMN), WSP(bf16, WS_WT_MEM), DM}; SO S; S.init(1, 8, F.G, (int)(F.G - 1 - blockIdx.x));
          pg8::EpiBf16 E{WSP(bf16, WS_MKV), 2048}; pg8::gemm_phase<pg8::EpiBf16, SO, true, true>(F.lds + RING_OFF, g, S, E); }
        if (BOTH(1)) GRID_BAR();
    }
    if (IN(2)) { p2_compress(F); p2_qknorm(F); if (BOTH(2)) GRID_BAR(); }
#if MK_NAIVE_P3
    if (IN(3)) { p3_nsa_naive(F); mem_attn_naive(F, WSP(bf16, WS_PA), NA, CA_QM, F.in[14], 0); if (BOTH(3)) GRID_BAR(); }
#else
    if (IN(3)) { p3_attn(F); if (BOTH(3)) GRID_BAR(); }
#endif
    if (IN(4)) { pg8::Gemm g{WSP(bf16, WS_MIX), WSP(bf16, WS_WT_OUT), DM}; SO S; S.init(T / 256, DM / 256, F.G, (int)blockIdx.x);
        pg8::EpiResF32 E{F.in[0], WSP(float, WS_X1), DM}; pg8::gemm_phase<pg8::EpiResF32, SO, true, true>(F.lds + RING_OFF, g, S, E); if (BOTH(4)) GRID_BAR(); }
    if (IN(5)) { rmsnorm_rows(F, WSP(float, WS_X1), WSP(bf16, WS_XN), T); if (BOTH(5)) GRID_BAR(); }
    if (IN(6)) { pg8::Gemm g{WSP(bf16, WS_XN), WSP(bf16, WS_WT_FGU), DM}; SO S; S.init(T / 256, 2 * FF / 256, F.G, (int)blockIdx.x);
        pg8::EpiSwiglu E{WSP(bf16, WS_HFF), FF}; pg8::gemm_phase<pg8::EpiSwiglu, SO, true, true>(F.lds + RING_OFF, g, S, E); if (BOTH(6)) GRID_BAR(); }
    if (IN(7)) { pg8::Gemm g{WSP(bf16, WS_HFF), WSP(bf16, WS_WT_FDN), FF}; SO S; S.init(T / 256, DM / 256, F.G, (int)blockIdx.x);
        pg8::EpiResF32 E{WSP(float, WS_X1), WSP(float, WS_X2), DM}; pg8::gemm_phase<pg8::EpiResF32, SO, true, true>(F.lds + RING_OFF, g, S, E); if (BOTH(7)) GRID_BAR(); }
    if (IN(8)) { rmsnorm_rows(F, WSP(float, WS_X2), WSP(bf16, WS_XN), T); if (BOTH(8)) GRID_BAR(); }
    if (IN(9)) { pg8::Gemm g{WSP(bf16, WS_XN), WSP(bf16, WS_WT_INB), DM}; SO S; S.init(T / 256, NB / 256, F.G, (int)blockIdx.x);
        pg8::EpiBf16 E{WSP(bf16, WS_PB), NB}; pg8::gemm_phase<pg8::EpiBf16, SO, true, true>(F.lds + RING_OFF, g, S, E); if (BOTH(9)) GRID_BAR(); }
#if MK_NAIVE_P10
    if (IN(10)) { stick_naive(F); mem_attn_naive(F, WSP(bf16, WS_PB), NB, CB_QM, F.in[14] + 2 * HD, 1); if (BOTH(10)) GRID_BAR(); }
#else
    if (IN(10)) { p10_attn(F); if (BOTH(10)) GRID_BAR(); }
#endif
    if (IN(11)) { pg8::Gemm g{WSP(bf16, WS_MIX), WSP(bf16, WS_WT_OUT) + (size_t)DM * DM, DM}; SO S; S.init(T / 256, DM / 256, F.G, (int)blockIdx.x);
        pg8::EpiResF32 E{WSP(float, WS_X2), WSP(float, WS_X3), DM}; pg8::gemm_phase<pg8::EpiResF32, SO, true, true>(F.lds + RING_OFF, g, S, E); if (BOTH(11)) GRID_BAR(); }
    if (IN(12)) { p12_router(F); if (BOTH(12)) GRID_BAR(); }
    if (IN(13)) { p13_assign(F); if (BOTH(13)) GRID_BAR(); }
    if (IN(14)) { const int* TILE = (const int*)(F.ws + WS_ROUTE + RT_TILE); const int ntl = TILE[0];
        pg8::Gemm g{WSP(bf16, WS_AMOE), WSP(bf16, WS_WT_MGU), DM}; pg8::MoeOrder S; S.init(ntl, 2 * FF / 256, F.G, (int)blockIdx.x); S.tile_e = TILE + 16; S.estride = (size_t)2 * FF * DM * 2;
        pg8::EpiSwiglu E{WSP(bf16, WS_HMOE), FF}; pg8::gemm_phase<pg8::EpiSwiglu, pg8::MoeOrder, true, true>(F.lds + RING_OFF, g, S, E); if (BOTH(14)) GRID_BAR(); }
    if (IN(15)) { const int* TILE = (const int*)(F.ws + WS_ROUTE + RT_TILE); const int ntl = TILE[0];
        pg8::Gemm g{WSP(bf16, WS_HMOE), WSP(bf16, WS_WT_MDN), FF}; pg8::MoeOrder S; S.init(ntl, DM / 256, F.G, (int)blockIdx.x); S.tile_e = TILE + 16; S.estride = (size_t)DM * FF * 2;
        pg8::EpiBf16 E{WSP(bf16, WS_YMOE), DM}; pg8::gemm_phase<pg8::EpiBf16, pg8::MoeOrder, true, true>(F.lds + RING_OFF, g, S, E); if (BOTH(15)) GRID_BAR(); }
    if (IN(16)) { p16_combine(F); }
#undef IN
#undef BOTH
}

#ifndef MK_ONE_LAUNCH
#define MK_ONE_LAUNCH 1
#endif
extern "C" void kernel_launch(void* const* d_in, const int* in_sizes, int n_in, void* d_out, int out_size, void* d_ws, size_t ws_size, hipStream_t stream) {
    static int grid = 0;
    if (grid == 0) {
        if (n_in != 22 || in_sizes[0] != T * DM || out_size != T * DM || ws_size < WS_END) { fprintf(stderr, "kernel_launch: unexpected shapes (n_in %d, in0 %d, out %d, ws %zu < %zu)\n", n_in, n_in > 0 ? in_sizes[0] : -1, out_size, ws_size, (size_t)WS_END); grid = -1; return; }
        int dev = 0, cus = 0, per_cu = 0;
        if (hipGetDevice(&dev) != hipSuccess || hipDeviceGetAttribute(&cus, hipDeviceAttributeMultiprocessorCount, dev) != hipSuccess) { grid = -1; return; }
        if (hipFuncSetAttribute((const void*)mk_fwd, hipFuncAttributeMaxDynamicSharedMemorySize, LDS_BYTES) != hipSuccess) { fprintf(stderr, "kernel_launch: hipFuncSetAttribute failed\n"); grid = -1; return; }
        if (hipOccupancyMaxActiveBlocksPerMultiprocessor(&per_cu, (const void*)mk_fwd, NWAVES * 64, LDS_BYTES) != hipSuccess || per_cu < 1) { fprintf(stderr, "kernel_launch: occupancy query says %d blocks per CU\n", per_cu); }
        (void)hipGetLastError();
        grid = cus;
    }
    if (grid < 0) return;
    if (hipMemsetAsync((char*)d_ws + WS_CTL, 0, CTL_ZERO_BYTES, stream) != hipSuccess) return;
    Args a{};
    for (int i = 0; i < 22; ++i) a.in[i] = (const float*)d_in[i];
    a.out = (float*)d_out; a.ws = (unsigned char*)d_ws; a.pad = 0;
#if MK_ONE_LAUNCH
    a.ph_lo = 0; a.ph_hi = N_PHASES; a.use_bar = 1;
    hipLaunchKernelGGL(mk_fwd, dim3(grid), dim3(NWAVES * 64), LDS_BYTES, stream, a);
    for (int p = 0; p < N_PHASES; ++p) if ((MK_PROBE_MASK >> p) & 1) { a.ph_lo = p; a.ph_hi = p + 1; a.use_bar = 0;
        hipLaunchKernelGGL(mk_fwd, dim3(grid), dim3(NWAVES * 64), LDS_BYTES, stream, a); }
#else
    for (int p = 0; p < N_PHASES; ++p) { a.ph_lo = p; a.ph_hi = p + 1; a.use_bar = 0;
        hipLaunchKernelGGL(mk_fwd, dim3(grid), dim3(NWAVES * 64), LDS_BYTES, stream, a); }
#endif
}
```

```cpp
#include <hip/hip_runtime.h>
#include <cstdio>
#include <cstdint>

namespace pg8 {
#define PG8_LAS __attribute__((address_space(3)))
typedef unsigned short bf16_t;
typedef short bf16x8 __attribute__((ext_vector_type(8)));
typedef float f32x4 __attribute__((ext_vector_type(4)));
typedef unsigned u32x4 __attribute__((ext_vector_type(4)));
constexpr int BM = 256, BK = 64, HALF = 128, HTB = HALF * BK * 2  , STAGE_BYTES = 8 * HTB, NXCD = 8, WGM = 8;

__host__ __device__ __forceinline__ int lds_byte(int r, int c) { const int st = (r >> 4) * 2 + (c >> 5), rr = r & 15, cc = c & 31, ob = rr * 64 + cc * 2; return st * 1024 + (ob ^ (((ob >> 9) & 1) << 5)); }
__host__ __device__ __forceinline__ void stage_rc(int b, int& R, int& C) { const int st = b / 1024, sb = b % 1024, swz = sb ^ (((sb >> 9) & 1) << 5); R = (st >> 1) * 16 + swz / 64; C = (st & 1) * 32 + (swz % 64) / 2; }
__host__ __device__ __forceinline__ int perm32(int rho) { const int n = rho >> 4, i = rho & 15; return 8 * (i >> 2) + 4 * n + (i & 3); }

struct Unit { int pm, pn; };
struct Gemm { const bf16_t* A; const bf16_t* Bt; int K; };

struct StaticOrder {
    int nM, nN, nwg, G, c;
    __device__ void init(int nM_, int nN_, int G_, int c_) { nM = nM_; nN = nN_; nwg = nM * nN; G = G_; c = c_; }
    __device__ bool next(int i, Unit& u) const {
        const long L = (long)i * G + c; if (L >= nwg) return false;
        int wgid = (int)L; { const int q = nwg / NXCD, r = nwg % NXCD, xcd = wgid % NXCD, off = wgid / NXCD; wgid = (xcd < r ? xcd * (q + 1) : r * (q + 1) + (xcd - r) * q) + off; }
        const int nig = WGM * nN, gid = wgid / nig, fm = gid * WGM, gsz = (nM - fm) < WGM ? (nM - fm) : WGM;
        u.pm = fm + ((wgid % nig) % gsz); u.pn = (wgid % nig) / gsz; return true;
    }
    __device__ __forceinline__ const char* a_base(const Gemm& g, const Unit& u) const { return (const char*)g.A + (size_t)u.pm * ((size_t)BM * g.K * 2); }
    __device__ __forceinline__ const char* b_base(const Gemm& g, const Unit& u) const { return (const char*)g.Bt + (size_t)u.pn * ((size_t)BM * g.K * 2); }
    __device__ __forceinline__ void a_ready(const Unit&) const {}
    __device__ __forceinline__ void done(const Unit&) const {}
};
struct MoeOrder : StaticOrder {
    const int* tile_e; size_t estride;
    __device__ __forceinline__ const char* b_base(const Gemm& g, const Unit& u) const { return (const char*)g.Bt + (size_t)tile_e[u.pm] * estride + (size_t)u.pn * ((size_t)BM * g.K * 2); }
};

__device__ __forceinline__ unsigned cvt_pk_bf16(float lo, float hi) { unsigned r; asm volatile("v_cvt_pk_bf16_f32 %0, %1, %2" : "=v"(r) : "v"(lo), "v"(hi)); return r; }

struct EpiBf16 {
    static constexpr bool PERM = true, AFTER_DRAIN = false;
    bf16_t* O; int ldc;
    __device__ __forceinline__ void operator()(const f32x4 (&acc)[2][2][4][2], const Unit& u, int wr, int wc, int fr, int fq) const {
        const int row0 = u.pm * BM + wr * 64 + fr, col0 = u.pn * BM + wc * 32 + 8 * fq;
#pragma unroll
        for (int ai = 0; ai < 2; ++ai)
#pragma unroll
            for (int m = 0; m < 4; ++m) { bf16_t* rowp = O + (size_t)(row0 + ai * HALF + m * 16) * ldc + col0;
#pragma unroll
                for (int bj = 0; bj < 2; ++bj) { const f32x4 v0 = acc[ai][bj][m][0], v1 = acc[ai][bj][m][1];
                    u32x4 w; w.x = cvt_pk_bf16(v0[0], v0[1]); w.y = cvt_pk_bf16(v0[2], v0[3]); w.z = cvt_pk_bf16(v1[0], v1[1]); w.w = cvt_pk_bf16(v1[2], v1[3]);
                    *(u32x4*)(rowp + bj * HALF) = w; } }
    }
};
struct EpiSwiglu {
    static constexpr bool PERM = true, AFTER_DRAIN = false;
    bf16_t* O; int ldc;
    __device__ __forceinline__ void operator()(const f32x4 (&acc)[2][2][4][2], const Unit& u, int wr, int wc, int fr, int fq) const {
        const int row0 = u.pm * BM + wr * 64 + fr, col0 = u.pn * HALF + wc * 32 + 8 * fq;
#pragma unroll
        for (int ai = 0; ai < 2; ++ai)
#pragma unroll
            for (int m = 0; m < 4; ++m) { bf16_t* rowp = O + (size_t)(row0 + ai * HALF + m * 16) * ldc + col0;
                float h[8];
#pragma unroll
                for (int n = 0; n < 2; ++n)
#pragma unroll
                    for (int j = 0; j < 4; ++j) { const float gq = acc[ai][0][m][n][j], uq = acc[ai][1][m][n][j];
                        const float sg = __builtin_amdgcn_rcpf(1.0f + __builtin_amdgcn_exp2f(-1.4426950408889634f * gq));
                        h[n * 4 + j] = gq * sg * uq; }
                u32x4 w; w.x = cvt_pk_bf16(h[0], h[1]); w.y = cvt_pk_bf16(h[2], h[3]); w.z = cvt_pk_bf16(h[4], h[5]); w.w = cvt_pk_bf16(h[6], h[7]);
                *(u32x4*)rowp = w; }
    }
};
struct EpiResF32 {
    static constexpr bool PERM = false, AFTER_DRAIN = false;
    const float* base; float* out; int ldc;
    __device__ __forceinline__ void operator()(const f32x4 (&acc)[2][2][4][2], const Unit& u, int wr, int wc, int fr, int fq) const {
        const int row0 = u.pm * BM + wr * 64 + fr, col0 = u.pn * BM + wc * 32 + 4 * fq;
#pragma unroll
        for (int ai = 0; ai < 2; ++ai)
#pragma unroll
            for (int m = 0; m < 4; ++m) { const size_t off = (size_t)(row0 + ai * HALF + m * 16) * ldc + col0;
#pragma unroll
                for (int bj = 0; bj < 2; ++bj)
#pragma unroll
                    for (int n = 0; n < 2; ++n) { const f32x4 b = *(const f32x4*)(base + off + bj * HALF + n * 16); *(f32x4*)(out + off + bj * HALF + n * 16) = b + acc[ai][bj][m][n]; } }
    }
};
template <class Epi, class Sched, bool ALIGN_EPI = false, bool SP2 = false>
__device__ __forceinline__ void gemm_phase(PG8_LAS unsigned char* lds, const Gemm g, const Sched& S, const Epi& E) {
    int tid = threadIdx.x; asm volatile("" : "+v"(tid));
    const int wid = __builtin_amdgcn_readfirstlane(tid >> 6), lane = tid & 63, wr = wid >> 2, wc = wid & 3, fr = lane & 15, fq = lane >> 4;
    const int K = g.K, nt = K / BK;
    unsigned voffA[2], voffB[2];
#pragma unroll
    for (int i = 0; i < 2; ++i) { int R, C; stage_rc(tid * 16 + i * 8192, R, C); const int Rb = Epi::PERM ? ((R & ~31) + perm32(R & 31)) : R;
        voffA[i] = (unsigned)(R * K + C) * 2u; voffB[i] = (unsigned)(Rb * K + C) * 2u; }
    const size_t kstep = (size_t)(BK * 2);
    const size_t hstep = (size_t)HALF * K * 2;
    const unsigned ldsw = (unsigned)wid * 1024u;
    const int aoff = lds_byte(wr * 64 + fr, fq * 8), boff = lds_byte(wc * 32 + fr, fq * 8);
#define PG8_SA(b, h) (((b) * 2 + (h)) * HTB)
#define PG8_SB(b, h) ((4 + (b) * 2 + (h)) * HTB)
#define PG8_STAGE(bufoff, gbase, voff) do { _Pragma("unroll") for (int _i = 0; _i < 2; ++_i) \
        __builtin_amdgcn_global_load_lds((const unsigned*)((const char*)(gbase) + (voff)[_i]), (PG8_LAS unsigned*)(lds + (bufoff) + ldsw + _i * 8192), 16, 0, 0); } while (0)
#define PG8_LDA(dst, b, h) do { _Pragma("unroll") for (int m = 0; m < 4; ++m) _Pragma("unroll") for (int k = 0; k < 2; ++k) dst[m][k] = *(const PG8_LAS bf16x8*)(lds + PG8_SA(b, h) + aoff + m * 2048 + k * 1024); } while (0)
#define PG8_LDB(dst, b, h) do { _Pragma("unroll") for (int n = 0; n < 2; ++n) _Pragma("unroll") for (int k = 0; k < 2; ++k) dst[n][k] = *(const PG8_LAS bf16x8*)(lds + PG8_SB(b, h) + boff + n * 2048 + k * 1024); } while (0)
#define PG8_MMA(ai, bj, At, Bt) do { __builtin_amdgcn_s_setprio(1); _Pragma("unroll") for (int m = 0; m < 4; ++m) _Pragma("unroll") for (int n = 0; n < 2; ++n) _Pragma("unroll") for (int k = 0; k < 2; ++k) \
        acc[ai][bj][m][n] = __builtin_amdgcn_mfma_f32_16x16x32_bf16(Bt[n][k], At[m][k], acc[ai][bj][m][n], 0, 0, 0); __builtin_amdgcn_s_setprio(0); } while (0)
#define PG8_WAIT_V(n) asm volatile("s_waitcnt vmcnt(" #n ")" ::: "memory")
#define PG8_WAIT_L(n) asm volatile("s_waitcnt lgkmcnt(" #n ")" ::: "memory")
#define PG8_BAR __builtin_amdgcn_s_barrier()
#define PG8_SCHED __builtin_amdgcn_sched_barrier(0)
    Unit cur, nxt; int ui = 0;
    if (!S.next(0, cur)) return;
    f32x4 acc[2][2][4][2];
#pragma unroll
    for (int a = 0; a < 2; ++a)
#pragma unroll
        for (int b = 0; b < 2; ++b)
#pragma unroll
            for (int m = 0; m < 4; ++m)
#pragma unroll
                for (int n = 0; n < 2; ++n) acc[a][b][m][n] = (f32x4){0.f, 0.f, 0.f, 0.f};
    bf16x8 At[4][2], B0[2][2], B1[2][2];
    const char* cA = S.a_base(g, cur); const char* cB = S.b_base(g, cur);
    S.a_ready(cur);
    if constexpr (SP2) {
        PG8_STAGE(PG8_SB(0, 0), cB, voffB); PG8_STAGE(PG8_SB(0, 1), cB + hstep, voffB); PG8_STAGE(PG8_SA(0, 0), cA, voffA); PG8_STAGE(PG8_SA(0, 1), cA + hstep, voffA);
        if (wr == 1) PG8_BAR;
        PG8_WAIT_V(2); PG8_BAR;
        PG8_STAGE(PG8_SB(1, 0), cB + kstep, voffB); PG8_STAGE(PG8_SA(1, 0), cA + kstep, voffA); PG8_STAGE(PG8_SB(1, 1), cB + hstep + kstep, voffB);
        PG8_WAIT_V(6); PG8_BAR;
    } else {
        PG8_STAGE(PG8_SB(0, 0), cB, voffB); PG8_STAGE(PG8_SA(0, 0), cA, voffA); PG8_STAGE(PG8_SB(0, 1), cB + hstep, voffB); PG8_STAGE(PG8_SA(0, 1), cA + hstep, voffA);
        if (wr == 1) PG8_BAR;
        PG8_WAIT_V(4); PG8_BAR;
        PG8_STAGE(PG8_SB(1, 0), cB + kstep, voffB); PG8_STAGE(PG8_SA(1, 0), cA + kstep, voffA); PG8_STAGE(PG8_SB(1, 1), cB + hstep + kstep, voffB);
        PG8_WAIT_V(6); PG8_BAR;
    }
    for (;;) {
        const bool has_next = S.next(ui + 1, nxt);
        const char* nA = has_next ? S.a_base(g, nxt) : cA; const char* nB = has_next ? S.b_base(g, nxt) : cB;
        for (int t = 0; t < nt; t += 2) {
            const bool last = (t == nt - 2);
            const char* a1 = cA + (size_t)(t + 1) * kstep;
            const char* a2 = last ? nA : cA + (size_t)(t + 2) * kstep; const char* b2 = last ? nB : cB + (size_t)(t + 2) * kstep;
            const char* a3 = a2 + kstep; const char* b3 = b2 + kstep;
            if (last && has_next) S.a_ready(nxt);
            if constexpr (SP2) {
            PG8_LDB(B0, 0, 0); PG8_LDB(B1, 0, 1); PG8_SCHED; PG8_LDA(At, 0, 0); PG8_STAGE(PG8_SA(1, 1), a1 + hstep, voffA);
            PG8_WAIT_V(8); PG8_WAIT_L(0); PG8_BAR; PG8_MMA(0, 0, At, B0); PG8_MMA(0, 1, At, B1); PG8_BAR; PG8_SCHED;
            PG8_LDA(At, 0, 1); PG8_STAGE(PG8_SB(0, 0), b2, voffB); PG8_STAGE(PG8_SB(0, 1), b2 + hstep, voffB); PG8_STAGE(PG8_SA(0, 0), a2, voffA);
            PG8_WAIT_V(8); PG8_WAIT_L(0); PG8_BAR; PG8_MMA(1, 0, At, B0); PG8_MMA(1, 1, At, B1); PG8_BAR; PG8_SCHED;
            PG8_LDB(B0, 1, 0); PG8_LDB(B1, 1, 1); PG8_SCHED; PG8_LDA(At, 1, 0); PG8_STAGE(PG8_SA(0, 1), a2 + hstep, voffA);
            PG8_WAIT_V(8); PG8_WAIT_L(0); PG8_BAR; PG8_MMA(0, 0, At, B0); PG8_MMA(0, 1, At, B1); PG8_BAR; PG8_SCHED;
            PG8_LDA(At, 1, 1); PG8_STAGE(PG8_SB(1, 0), b3, voffB); PG8_STAGE(PG8_SB(1, 1), b3 + hstep, voffB); PG8_STAGE(PG8_SA(1, 0), a3, voffA);
            PG8_WAIT_V(8); PG8_WAIT_L(0); PG8_BAR; PG8_MMA(1, 0, At, B0); PG8_MMA(1, 1, At, B1); PG8_BAR; PG8_SCHED;
            } else {
            PG8_LDB(B0, 0, 0); PG8_SCHED; PG8_LDA(At, 0, 0); PG8_STAGE(PG8_SA(1, 1), a1 + hstep, voffA);
            PG8_WAIT_L(8); PG8_BAR; PG8_WAIT_L(0); PG8_MMA(0, 0, At, B0); PG8_BAR; PG8_SCHED;
            PG8_LDB(B1, 0, 1); PG8_STAGE(PG8_SB(0, 0), b2, voffB);
            PG8_BAR; PG8_WAIT_L(0); PG8_MMA(0, 1, At, B1); PG8_BAR;
            PG8_LDA(At, 0, 1); PG8_STAGE(PG8_SA(0, 0), a2, voffA);
            PG8_BAR; PG8_WAIT_L(0); PG8_MMA(1, 0, At, B0); PG8_BAR; PG8_SCHED;
            PG8_STAGE(PG8_SB(0, 1), b2 + hstep, voffB);
            PG8_WAIT_V(6); PG8_BAR; PG8_MMA(1, 1, At, B1); PG8_BAR;
            PG8_LDB(B0, 1, 0); PG8_SCHED; PG8_LDA(At, 1, 0); PG8_STAGE(PG8_SA(0, 1), a2 + hstep, voffA);
            PG8_WAIT_L(8); PG8_BAR; PG8_WAIT_L(0); PG8_MMA(0, 0, At, B0); PG8_BAR; PG8_SCHED;
            PG8_LDB(B1, 1, 1); PG8_STAGE(PG8_SB(1, 0), b3, voffB);
            PG8_BAR; PG8_WAIT_L(0); PG8_MMA(0, 1, At, B1); PG8_BAR;
            PG8_LDA(At, 1, 1); PG8_STAGE(PG8_SA(1, 0), a3, voffA);
            PG8_BAR; PG8_WAIT_L(0); PG8_MMA(1, 0, At, B0); PG8_BAR; PG8_SCHED;
            PG8_STAGE(PG8_SB(1, 1), b3 + hstep, voffB);
            PG8_WAIT_V(6); PG8_BAR; PG8_MMA(1, 1, At, B1); PG8_BAR;
            }
        }
        if constexpr (ALIGN_EPI) { if (wr == 0) PG8_BAR; }
        if constexpr (!Epi::AFTER_DRAIN) { E(acc, cur, wr, wc, fr, fq); S.done(cur); }
        if (!has_next) break;
#pragma unroll
        for (int a = 0; a < 2; ++a)
#pragma unroll
            for (int b = 0; b < 2; ++b)
#pragma unroll
                for (int m = 0; m < 4; ++m)
#pragma unroll
                    for (int n = 0; n < 2; ++n) acc[a][b][m][n] = (f32x4){0.f, 0.f, 0.f, 0.f};
        cur = nxt; cA = nA; cB = nB; ++ui;
        if constexpr (ALIGN_EPI) { if (wr == 1) PG8_BAR; }
    }
    PG8_WAIT_V(0);
    if constexpr (!ALIGN_EPI) { if (wr == 0) PG8_BAR; }
    PG8_BAR;
    if constexpr (Epi::AFTER_DRAIN) { E.fused(acc, cur, wr, wc, fr, fq, lds, wid, lane); S.done(cur); }
#undef PG8_SA
#undef PG8_SB
#undef PG8_STAGE
#undef PG8_LDA
#undef PG8_LDB
#undef PG8_MMA
#undef PG8_WAIT_V
#undef PG8_WAIT_L
#undef PG8_BAR
#undef PG8_SCHED
}
}


constexpr int T = 8192, DM = 2048, HD = 128, NMIX = 12, NMEMH = 4, NG = 3, MEMT = 256, FF = 7168, NE = 8;
constexpr int A_IN_W = 4388, NA = 4608;
constexpr int NB = 5120;
constexpr int CA_Q = 0, CA_KC = 1536, CA_VC = 1920, CA_KS = 2304, CA_VS = 2688, CA_KW = 3072, CA_VW = 3456, CA_QM = 3840, CA_GT = 4352;
constexpr int CB_Q = 0, CB_QM = 1536, CB_K = 2048, CB_V = 3584;
constexpr int NCMP = 511, NCMP_P = 512;
constexpr int MOE_MAXT = 72;
constexpr float EPS = 1e-6f;
constexpr float QSCALE = 0.08838834764831845f;

constexpr size_t MiB = 1u << 20;
constexpr size_t WS_CTL = 0, CTL_ZERO_BYTES = 1 * MiB;
constexpr size_t WS_WT_INA = 2 * MiB;
constexpr size_t WS_WT_MEM = 20 * MiB;
constexpr size_t WS_WT_OUT = 28 * MiB;
constexpr size_t WS_WT_FGU = 44 * MiB;
constexpr size_t WS_WT_FDN = 100 * MiB;
constexpr size_t WS_WT_INB = 128 * MiB;
constexpr size_t WS_WT_MGU = 148 * MiB;
constexpr size_t WS_WT_MDN = 596 * MiB;
constexpr size_t WS_XN = 820 * MiB;
constexpr size_t WS_MEMN = 852 * MiB;
constexpr size_t WS_MKV = 853 * MiB;
constexpr size_t WS_PA = 854 * MiB;
constexpr size_t WS_KCMP = 926 * MiB;
constexpr size_t WS_MIX = 927 * MiB;
constexpr size_t WS_X1 = 959 * MiB;
constexpr size_t WS_X2 = 1023 * MiB;
constexpr size_t WS_X3 = 1087 * MiB;
constexpr size_t WS_HFF = 1151 * MiB;
constexpr size_t WS_PB = 1263 * MiB;
constexpr size_t WS_AMOE = 1343 * MiB;
constexpr size_t WS_HMOE = 1415 * MiB;
constexpr size_t WS_YMOE = 1667 * MiB;
constexpr size_t WS_ROUTE = 1739 * MiB;
constexpr size_t WS_WT_CMP = 1740 * MiB;
constexpr size_t WS_END = 1742 * MiB;
constexpr size_t RT_TOPI = 0;
constexpr size_t RT_TOPW = 65536;
constexpr size_t RT_ROW = 131072;
constexpr size_t RT_HIST = 196608;
constexpr size_t RT_TILE = 204800;
constexpr int CW_TMO = 0, CW_CODE = 1, CW_BAR = 4096;

constexpr int RING_OFF = 0, RING_BYTES = 135168;
constexpr int LDSCTL_OFF = RING_BYTES, MISC_OFF = LDSCTL_OFF + 320;
constexpr int LDS_BYTES = 147456;
static_assert(MISC_OFF + 128 <= LDS_BYTES, "LDS map");
constexpr int NWAVES = 8;

#define GAS __attribute__((address_space(1)))
#define LAS __attribute__((address_space(3)))
typedef unsigned short bf16;
typedef unsigned v4u __attribute__((ext_vector_type(4)));
typedef unsigned v2u __attribute__((ext_vector_type(2)));
typedef float f32x4 __attribute__((ext_vector_type(4)));
typedef GAS unsigned gu32;
#define RLX_AGENT __ATOMIC_RELAXED, __HIP_MEMORY_SCOPE_AGENT
#define LDS_WAIT() asm volatile("s_waitcnt lgkmcnt(0)" ::: "memory")
#define VM_WAIT() asm volatile("s_waitcnt vmcnt(0)" ::: "memory")
__device__ __forceinline__ float bf2f(unsigned b) { return __uint_as_float(b << 16); }
__device__ __forceinline__ unsigned pk2(float lo, float hi) { return pg8::cvt_pk_bf16(lo, hi); }
__device__ __forceinline__ void unpack8(v4u w, float* f) {
    f[0] = __uint_as_float(w.x << 16); f[1] = __uint_as_float(w.x & 0xffff0000u); f[2] = __uint_as_float(w.y << 16); f[3] = __uint_as_float(w.y & 0xffff0000u);
    f[4] = __uint_as_float(w.z << 16); f[5] = __uint_as_float(w.z & 0xffff0000u); f[6] = __uint_as_float(w.w << 16); f[7] = __uint_as_float(w.w & 0xffff0000u); }
__device__ __forceinline__ float wave_sum(float v) {
#pragma unroll
    for (int o = 1; o < 64; o <<= 1) v += __shfl_xor(v, o);
    return v;
}
__device__ __forceinline__ float fast_exp(float x) { return __builtin_amdgcn_exp2f(x * 1.4426950408889634f); }

#define XB_TMO      128
#define XB_XCNT(j)  (256  + 64 * (j))
#define XB_XSUB(j)  (1280 + 64 * (j))
#define XB_XGEN(j)  (2304 + 64 * (j))
#define XB_TOP      3328
#define XB_TOPGEN   3392
#define XCD_BAR_WORDS 3456
#define XB_SPIN_CAP (1u << 18)
__device__ __forceinline__ unsigned xb_ld(unsigned* p)              { return __hip_atomic_load(p, __ATOMIC_RELAXED, __HIP_MEMORY_SCOPE_AGENT); }
__device__ __forceinline__ unsigned xb_add(unsigned* p, unsigned v) { return __hip_atomic_fetch_add(p, v, __ATOMIC_RELAXED, __HIP_MEMORY_SCOPE_AGENT); }
__device__ __forceinline__ unsigned xb_xcc_id() { return (unsigned)__builtin_amdgcn_s_getreg((3 << 11) | 20) & 0xFu; }
#define XB_SPIN(cond, bar) do { unsigned _sp = 0; while (cond) { __builtin_amdgcn_s_sleep(1); \
    if ((++_sp & 255u) == 0u) { if (xb_ld(&(bar)[XB_TMO])) break; if (_sp > XB_SPIN_CAP) { atomicAdd(&(bar)[XB_TMO], 1u); break; } } } } while (0)
struct XcdBarrier { unsigned* bar; unsigned x; volatile LAS unsigned* st; };
__device__ __forceinline__ XcdBarrier xcd_barrier_post(unsigned* bar, volatile LAS unsigned* st) {
    XcdBarrier b; b.bar = bar; b.x = xb_xcc_id(); b.st = st;
    if (threadIdx.x == 0) (void)xb_add(&bar[XB_XCNT(b.x)], 1u);
    return b;
}
__device__ __forceinline__ void xcd_barrier_complete(unsigned* bar, unsigned x, unsigned& nloc, unsigned& nx) {
    const unsigned G = gridDim.x * gridDim.y * gridDim.z;
    unsigned sum, cnt, mine, sp = 0u;
    for (;;) {
        sum = 0u; cnt = 0u; mine = 0u;
#pragma unroll
        for (unsigned j = 0; j < 16; ++j) { const unsigned c = xb_ld(&bar[XB_XCNT(j)]); sum += c; cnt += (c > 0u) ? 1u : 0u; mine = (j == x) ? c : mine; }
        if (sum == G) break;
        __builtin_amdgcn_s_sleep(1);
        if ((++sp & 255u) == 0u) { if (xb_ld(&bar[XB_TMO])) break; if (sp > XB_SPIN_CAP) { atomicAdd(&bar[XB_TMO], 1u); break; } }
    }
    nloc = mine > 0u ? mine : 1u; nx = cnt > 0u ? cnt : 1u;
}
__device__ __forceinline__ void xcd_barrier(const XcdBarrier& b) {
    asm volatile("s_waitcnt vmcnt(0)" ::: "memory");
    __syncthreads();
    if (threadIdx.x == 0) {
        unsigned* bar = b.bar;
        __builtin_amdgcn_s_waitcnt(0);
        unsigned nloc = b.st[0], nx = b.st[1];
        if (nloc == 0u) { xcd_barrier_complete(bar, b.x, nloc, nx); b.st[0] = nloc; b.st[1] = nx; }
        const unsigned old = xb_add(&bar[XB_XSUB(b.x)], 1u);
        const unsigned gen = old / nloc;
        if (old + 1u == (gen + 1u) * nloc) {
            __builtin_amdgcn_fence(__ATOMIC_RELEASE, "agent");
            asm volatile("s_waitcnt vmcnt(0)" ::: "memory");
            const unsigned og = xb_add(&bar[XB_TOP], 1u);
            const unsigned tg = og / nx;
            if (og + 1u == (tg + 1u) * nx) xb_add(&bar[XB_TOPGEN], 1u);
            else XB_SPIN(xb_ld(&bar[XB_TOPGEN]) == tg, bar);
            __builtin_amdgcn_fence(__ATOMIC_ACQUIRE, "agent");
            xb_add(&bar[XB_XGEN(b.x)], 1u);
            asm volatile("s_waitcnt vmcnt(0)" ::: "memory");
        } else {
            XB_SPIN(xb_ld(&bar[XB_XGEN(b.x)]) == gen, bar);
            __builtin_amdgcn_fence(__ATOMIC_ACQUIRE, "agent");
            asm volatile("s_waitcnt vmcnt(0)" ::: "memory");
        }
    }
    __syncthreads();
}

struct Frame {
    LAS unsigned char* lds;
    volatile LAS unsigned* MISC;
    gu32* ctl;
    int tid, wave;
    int vcu, G;
    unsigned char* ws;
    const float* in[22];
    float* out;
};
#define WSP(T_, off) ((T_*)(F.ws + (off)))
__device__ __forceinline__ int lane_of(const Frame& F) { int t = F.tid; asm volatile("" : "+v"(t)); return t & 63; }

constexpr int CV_INA = 0, CV_MEM = CV_INA + 32 * 72, CV_CMP = CV_MEM + 2 * 32 * 16, CV_OUT = CV_CMP + 2 * 64 * 2, CV_FGU = CV_OUT + 2 * 32 * 32, CV_FDN = CV_FGU + 32 * 224,
              CV_INB = CV_FDN + 112 * 32, CV_KVB = CV_INB + 32 * 32, CV_MGU = CV_KVB + 32 * 48, CV_MDN = CV_MGU + 8 * 32 * 224, CV_TOTAL = CV_MDN + 8 * 112 * 32;
struct ConvIt { const float* src; bf16* dst; const float* gain; int K, Nsrc, sc0, n0, k0, nvalid; };
__device__ __forceinline__ void conv_decode(Frame& F, int g, ConvIt& c) {
    int loc, nnb, mode = 0, batch = 0; c.gain = nullptr;
    if (g < CV_MEM) { loc = g - CV_INA; c.src = F.in[5]; c.dst = WSP(bf16, WS_WT_INA); c.gain = F.in[2]; c.K = DM; c.Nsrc = A_IN_W; nnb = NA / 64; mode = 2; }
    else if (g < CV_CMP) { loc = g - CV_MEM; batch = loc / (32 * 16); loc -= batch * 32 * 16; c.src = F.in[13] + (size_t)batch * DM * 1024; c.dst = WSP(bf16, WS_WT_MEM) + (size_t)batch * 1024 * DM; c.gain = F.in[3] + batch * DM; c.K = DM; c.Nsrc = 1024; nnb = 16; }
    else if (g < CV_OUT) { loc = g - CV_CMP; batch = loc / 128; loc -= batch * 128; c.src = F.in[6] + (size_t)batch * 4096 * HD; c.dst = WSP(bf16, WS_WT_CMP) + (size_t)batch * HD * 4096; c.K = 4096; c.Nsrc = HD; nnb = 2; }
    else if (g < CV_FGU) { loc = g - CV_OUT; batch = loc / 1024; loc -= batch * 1024; c.src = F.in[15] + (size_t)batch * DM * DM; c.dst = WSP(bf16, WS_WT_OUT) + (size_t)batch * DM * DM; c.K = DM; c.Nsrc = DM; nnb = 32; }
    else if (g < CV_FDN) { loc = g - CV_FGU; c.src = F.in[16]; c.dst = WSP(bf16, WS_WT_FGU); c.gain = F.in[4]; c.K = DM; c.Nsrc = 2 * FF; nnb = 224; mode = 1; }
    else if (g < CV_INB) { loc = g - CV_FDN; c.src = F.in[17]; c.dst = WSP(bf16, WS_WT_FDN); c.K = FF; c.Nsrc = DM; nnb = 32; }
    else if (g < CV_KVB) { loc = g - CV_INB; c.src = F.in[10]; c.dst = WSP(bf16, WS_WT_INB); c.gain = F.in[2] + DM; c.K = DM; c.Nsrc = DM; nnb = 32; }
    else if (g < CV_MGU) { loc = g - CV_KVB; c.src = F.in[12]; c.dst = WSP(bf16, WS_WT_INB) + (size_t)2048 * DM; c.gain = F.in[11]; c.K = DM; c.Nsrc = 3072; nnb = 48; }
    else if (g < CV_MDN) { loc = g - CV_MGU; batch = loc / 7168; loc -= batch * 7168; c.src = F.in[20] + (size_t)batch * DM * 2 * FF; c.dst = WSP(bf16, WS_WT_MGU) + (size_t)batch * 2 * FF * DM; c.gain = F.in[4] + DM; c.K = DM; c.Nsrc = 2 * FF; nnb = 224; mode = 1; }
    else { loc = g - CV_MDN; batch = loc / 3584; loc -= batch * 3584; c.src = F.in[21] + (size_t)batch * FF * DM; c.dst = WSP(bf16, WS_WT_MDN) + (size_t)batch * DM * FF; c.K = FF; c.Nsrc = DM; nnb = 32; }
    const int kb = loc / nnb, nb = loc - kb * nnb;
    c.k0 = kb * 64; c.n0 = nb * 64; c.nvalid = nnb * 64;
    if (mode == 1) { const int j = c.n0 >> 8, r = c.n0 & 255; c.sc0 = (r < 128) ? 128 * j + r : 7168 + 128 * j + (r - 128); }
    else if (mode == 2) { if (c.n0 < 3840) c.sc0 = c.n0; else if (c.n0 < 4352) c.sc0 = c.n0 + 36; else if (c.n0 < 4416) { c.sc0 = c.n0 - 512; c.nvalid = 4388; } else { c.sc0 = 0; c.nvalid = 0; } }
    else c.sc0 = c.n0;
}
struct ConvRegs { f32x4 v[16]; float gn[8]; };
__device__ __forceinline__ void conv_load(const ConvIt& c, ConvRegs& R, int lane) {
    const int kr = lane >> 4, nc = (lane & 15) * 4;
    const bool ok = (c.n0 + nc) < c.nvalid;
    const int cc = ok ? c.sc0 + nc : 0;
    const float* p = c.src + (size_t)(c.k0 + kr) * c.Nsrc + cc;
#pragma unroll
    for (int i = 0; i < 16; ++i) { const f32x4 t = __builtin_nontemporal_load((const f32x4*)(p + (size_t)(4 * i) * c.Nsrc)); R.v[i] = ok ? t : (f32x4){0.f, 0.f, 0.f, 0.f}; }
    const int c8 = lane & 7;
#pragma unroll
    for (int i = 0; i < 8; ++i) R.gn[i] = c.gain ? c.gain[c.k0 + 8 * c8 + i] : 1.0f;
}
__device__ __forceinline__ void conv_proc(const ConvIt& c, const ConvRegs& R, LAS float* scr, int lane) {
    const int kr = lane >> 4, nc = (lane & 15) * 4;
#pragma unroll
    for (int i = 0; i < 16; ++i) { LAS float* s = scr + (4 * i + kr) * 65 + nc; s[0] = R.v[i][0]; s[1] = R.v[i][1]; s[2] = R.v[i][2]; s[3] = R.v[i][3]; }
    LDS_WAIT(); asm volatile("" ::: "memory");
    const int c8 = lane & 7, nl = lane >> 3;
#pragma unroll
    for (int j = 0; j < 8; ++j) {
        const int n = nl + 8 * j; const LAS float* s = scr + (8 * c8) * 65 + n;
        v4u o; o.x = pk2(s[0 * 65] * R.gn[0], s[1 * 65] * R.gn[1]); o.y = pk2(s[2 * 65] * R.gn[2], s[3 * 65] * R.gn[3]); o.z = pk2(s[4 * 65] * R.gn[4], s[5 * 65] * R.gn[5]); o.w = pk2(s[6 * 65] * R.gn[6], s[7 * 65] * R.gn[7]);
        *(v4u*)(c.dst + (size_t)(c.n0 + n) * c.K + c.k0 + 8 * c8) = o;
    }
    LDS_WAIT(); asm volatile("" ::: "memory");
}
__device__ __forceinline__ void conv_range(Frame& F, int g_lo, int g_hi) {
    LAS float* scr = (LAS float*)(F.lds + RING_OFF + F.wave * 16640);
    const int gw = F.vcu * NWAVES + F.wave, NGW = F.G * NWAVES;
    int g = g_lo + gw;
    if (g >= g_hi) return;
    ConvIt cA, cB; ConvRegs RA, RB;
    conv_decode(F, g, cA); conv_load(cA, RA, lane_of(F));
    for (;;) {
        const int g1 = g + NGW; const bool h1 = g1 < g_hi;
        if (h1) { conv_decode(F, g1, cB); conv_load(cB, RB, lane_of(F)); }
        asm volatile("" ::: "memory");
        conv_proc(cA, RA, scr, lane_of(F));
        if (!h1) break;
        const int g2 = g1 + NGW; const bool h2 = g2 < g_hi;
        if (h2) { conv_decode(F, g2, cA); conv_load(cA, RA, lane_of(F)); }
        asm volatile("" ::: "memory");
        conv_proc(cB, RB, scr, lane_of(F));
        if (!h2) break;
        g = g2;
    }
}
__device__ __forceinline__ float row_rstd_to_bf16(const float* xrow, bf16* orow, int lane) {
    const f32x4* xr = (const f32x4*)xrow + lane;
    f32x4 v[8]; float s = 0.f;
#pragma unroll
    for (int j = 0; j < 8; ++j) { v[j] = xr[64 * j]; s += (v[j].x * v[j].x + v[j].y * v[j].y) + (v[j].z * v[j].z + v[j].w * v[j].w); }
    const float rstd = 1.0f / sqrtf(wave_sum(s) * (1.f / DM) + EPS);
    v2u* o8 = (v2u*)orow + lane;
#pragma unroll
    for (int j = 0; j < 8; ++j) { v2u w; w.x = pk2(v[j].x * rstd, v[j].y * rstd); w.y = pk2(v[j].z * rstd, v[j].w * rstd); o8[64 * j] = w; }
    return rstd;
}
__device__ __forceinline__ void rmsnorm_rows(Frame& F, const float* X, bf16* XN, int rows) {
    const int gw = F.vcu * NWAVES + F.wave, NGW = F.G * NWAVES;
    for (int m = gw; m < rows; m += NGW) row_rstd_to_bf16(X + (size_t)m * DM, XN + (size_t)m * DM, lane_of(F));
}
__device__ __forceinline__ void p0_prologue(Frame& F) {
    conv_range(F, 0, CV_TOTAL);
    rmsnorm_rows(F, F.in[0], WSP(bf16, WS_XN), T);
    rmsnorm_rows(F, F.in[1], WSP(bf16, WS_MEMN), MEMT);
}

__device__ __forceinline__ void p2_compress(Frame& F) {
    typedef short bf16x8 __attribute__((ext_vector_type(8)));
    const bf16* PA = WSP(bf16, WS_PA); const bf16* WC = WSP(bf16, WS_WT_CMP);
    LAS float* red = (LAS float*)(F.lds + RING_OFF);
    LAS float* posl = red + 16 * 132;
    const int lane = lane_of(F), w = F.wave, fr = lane & 15, fq = lane >> 4;
    for (int i = F.tid; i < 2 * 4096 / 4; i += NWAVES * 64) *(LAS f32x4*)(posl + 4 * i) = *(const f32x4*)(F.in[7] + 4 * i);
    __syncthreads();
    const int nitems = 2 * NG * 32;
    for (int it = F.vcu; it < nitems; it += F.G) {
        const int kv = it / (NG * 32), g = (it / 32) % NG, jt = it % 32;
        const int j = 16 * jt + fr;
        const LAS float* pos = posl + kv * 4096;
        const int col = (kv ? CA_VC : CA_KC) + g * HD;
        const bf16* wrow = WC + ((size_t)kv * HD + 16 * w + fr) * 4096;
        f32x4 acc = {0.f, 0.f, 0.f, 0.f};
        for (int ks0 = 0; ks0 < 128; ks0 += 16) {
            v4u xa[16], wb[16];
#pragma unroll
            for (int u = 0; u < 16; ++u) {
                const int k = 32 * (ks0 + u) + 8 * fq, i = k >> 7, d = k & 127;
                int trow = 16 * j + i; trow = trow < T ? trow : T - 1;
                xa[u] = *(const v4u*)(PA + (size_t)trow * NA + col + d);
                wb[u] = *(const v4u*)(wrow + k);
            }
            asm volatile("" ::: "memory");
#pragma unroll
            for (int u = 0; u < 16; ++u) {
                const int k = 32 * (ks0 + u) + 8 * fq;
                const f32x4 pa = *(const LAS f32x4*)(pos + k), pb = *(const LAS f32x4*)(pos + k + 4);
                float xf[8]; unpack8(xa[u], xf);
                v4u av; av.x = pk2(xf[0] + pa[0], xf[1] + pa[1]); av.y = pk2(xf[2] + pa[2], xf[3] + pa[3]); av.z = pk2(xf[4] + pb[0], xf[5] + pb[1]); av.w = pk2(xf[6] + pb[2], xf[7] + pb[3]);
                acc = __builtin_amdgcn_mfma_f32_16x16x32_bf16(*reinterpret_cast<const bf16x8*>(&av), *reinterpret_cast<const bf16x8*>(&wb[u]), acc, 0, 0, 0);
            }
        }
#pragma unroll
        for (int r = 0; r < 4; ++r) red[(4 * fq + r) * 132 + 16 * w + fr] = acc[r];
        __syncthreads();
        {
            const int row = F.tid >> 5, cp = F.tid & 31, jj = 16 * jt + row;
            float v[4]; float ss = 0.f;
#pragma unroll
            for (int e = 0; e < 4; ++e) { v[e] = red[row * 132 + 4 * cp + e]; ss += v[e] * v[e]; }
            ss += __shfl_xor(ss, 1); ss += __shfl_xor(ss, 2); ss += __shfl_xor(ss, 4); ss += __shfl_xor(ss, 8); ss += __shfl_xor(ss, 16);
            if (kv == 0) { const float rs = 1.0f / sqrtf(ss * (1.f / HD) + EPS); const float* gp = F.in[9] + 4 * cp;
#pragma unroll
                for (int e = 0; e < 4; ++e) v[e] = v[e] * rs * gp[e]; }
            if (jj >= NCMP) {
#pragma unroll
                for (int e = 0; e < 4; ++e) v[e] = 0.f; }
            v2u o; o.x = pk2(v[0], v[1]); o.y = pk2(v[2], v[3]);
            *(v2u*)(WSP(bf16, WS_KCMP) + (size_t)kv * NG * NCMP_P * HD + ((size_t)g * NCMP_P + jj) * HD + 4 * cp) = o;
        }
        __syncthreads();
    }
}
__device__ __forceinline__ void norm_slot(bf16* p, const float* gain, int l16) {
    v4u w = *(const v4u*)(p + l16 * 8); float f[8]; unpack8(w, f);
    float s = 0.f;
#pragma unroll
    for (int e = 0; e < 8; ++e) s += f[e] * f[e];
    s += __shfl_xor(s, 1); s += __shfl_xor(s, 2); s += __shfl_xor(s, 4); s += __shfl_xor(s, 8);
    const float r = 1.0f / sqrtf(s * (1.f / HD) + EPS);
    const float* gp = gain + l16 * 8;
    v4u o; o.x = pk2(f[0] * r * gp[0], f[1] * r * gp[1]); o.y = pk2(f[2] * r * gp[2], f[3] * r * gp[3]); o.z = pk2(f[4] * r * gp[4], f[5] * r * gp[5]); o.w = pk2(f[6] * r * gp[6], f[7] * r * gp[7]);
    *(v4u*)(p + l16 * 8) = o;
}
__device__ __forceinline__ void norm_vals(v4u w, bf16* p, const float* gain, int l16) {
    float f[8]; unpack8(w, f);
    float s = 0.f;
#pragma unroll
    for (int e = 0; e < 8; ++e) s += f[e] * f[e];
    s += __shfl_xor(s, 1); s += __shfl_xor(s, 2); s += __shfl_xor(s, 4); s += __shfl_xor(s, 8);
    const float r = 1.0f / sqrtf(s * (1.f / HD) + EPS);
    const float* gp = gain + l16 * 8;
    v4u o; o.x = pk2(f[0] * r * gp[0], f[1] * r * gp[1]); o.y = pk2(f[2] * r * gp[2], f[3] * r * gp[3]); o.z = pk2(f[4] * r * gp[4], f[5] * r * gp[5]); o.w = pk2(f[6] * r * gp[6], f[7] * r * gp[7]);
    *(v4u*)(p + l16 * 8) = o;
}
__device__ __forceinline__ void p2_qknorm(Frame& F) {
    bf16* PA = WSP(bf16, WS_PA); bf16* MKV = WSP(bf16, WS_MKV);
    const int gs = (F.vcu * NWAVES + F.wave) * 4 + (lane_of(F) >> 4), NS = F.G * NWAVES * 4, l16 = lane_of(F) & 15;
    for (int s0 = gs; s0 < T * 18; s0 += 6 * NS) {
        bf16* ptr[6]; const float* gn[6]; v4u w[6];
#pragma unroll
        for (int u = 0; u < 6; ++u) {
            int s = s0 + u * NS; s = s < T * 18 ? s : gs;
            const int t = s / 18, k = s % 18;
            int col; const float* gain;
            if (k < 12) { col = CA_Q + k * HD; gain = F.in[8]; }
            else if (k < 15) { col = CA_KS + (k - 12) * HD; gain = F.in[9] + HD; }
            else { col = CA_KW + (k - 15) * HD; gain = F.in[9] + 2 * HD; }
            ptr[u] = PA + (size_t)t * NA + col; gn[u] = gain; w[u] = *(const v4u*)(ptr[u] + l16 * 8);
        }
        asm volatile("" ::: "memory");
#pragma unroll
        for (int u = 0; u < 6; ++u) if (s0 + u * NS < T * 18) norm_vals(w[u], ptr[u], gn[u], l16);
    }
    for (int s = gs; s < MEMT * 8; s += NS) {
        const int m = s / 8, k = s % 8, l = k >> 2, h = k & 3;
        norm_slot(MKV + (size_t)m * 2048 + l * 1024 + h * HD, F.in[14] + (size_t)(l * 2 + 1) * HD, l16);
    }
}

__device__ __forceinline__ void ld32(const bf16* p, float* f) {
#pragma unroll
    for (int i = 0; i < 4; ++i) { const v4u w = *(const v4u*)(p + 8 * i); unpack8(w, f + 8 * i); }
}
__device__ __forceinline__ float dot32q(const float* q, const bf16* kp) {
    float kf[32]; ld32(kp, kf); float s = 0.f;
#pragma unroll
    for (int i = 0; i < 32; ++i) s += q[i] * kf[i];
    s += __shfl_xor(s, 1); s += __shfl_xor(s, 2);
    return s;
}
__device__ __forceinline__ void axpy32(float* o, float p, const bf16* vp) {
    float vf[32]; ld32(vp, vf);
#pragma unroll
    for (int i = 0; i < 32; ++i) o[i] += p * vf[i];
}
__device__ __forceinline__ void st32(bf16* p, const float* f) {
#pragma unroll
    for (int i = 0; i < 4; ++i) { v4u w; w.x = pk2(f[8 * i], f[8 * i + 1]); w.y = pk2(f[8 * i + 2], f[8 * i + 3]); w.z = pk2(f[8 * i + 4], f[8 * i + 5]); w.w = pk2(f[8 * i + 6], f[8 * i + 7]); *(v4u*)(p + 8 * i) = w; }
}
#define OSM_STEP(s_, valid_, vptr_) do { if (valid_) { const float mn_ = fmaxf(m, (s_)); const float al_ = fast_exp(m - mn_); const float pp_ = fast_exp((s_) - mn_); \
        l = l * al_ + pp_; _Pragma("unroll") for (int i_ = 0; i_ < 32; ++i_) o[i_] *= al_; axpy32(o, pp_, (vptr_)); m = mn_; } } while (0)

__device__ __forceinline__ void p3_nsa_naive(Frame& F) {
    const bf16* PA = WSP(bf16, WS_PA); const bf16* KC = WSP(bf16, WS_KCMP); const bf16* VC = KC + (size_t)NG * NCMP_P * HD; bf16* MIX = WSP(bf16, WS_MIX);
    LAS float* IMP = (LAS float*)(F.lds + RING_OFF + F.wave * 4096);
    LAS unsigned long long* SELW = (LAS unsigned long long*)(F.lds + RING_OFF + F.wave * 4096 + 2048);
    const int gw = F.vcu * NWAVES + F.wave, NGW = F.G * NWAVES;
    const int dq = lane_of(F) & 3, p = (lane_of(F) >> 2) & 3, ql = lane_of(F) >> 4;
    for (int it = gw; it < NG * (T / 4); it += NGW) {
        const int g = it / (T / 4), tq = it % (T / 4), t = 4 * tq + ql, head = g * 4 + p;
        const float slope = exp2f(-8.0f * (float)(head + 1) / 12.0f);
        float q[32]; ld32(PA + (size_t)t * NA + CA_Q + head * HD + dq * 32, q);
#pragma unroll
        for (int i = 0; i < 32; ++i) q[i] *= QSCALE;
        const float g0 = 1.0f / (1.0f + fast_exp(-bf2f(PA[(size_t)t * NA + CA_GT + head * 3 + 0])));
        const float g1 = 1.0f / (1.0f + fast_exp(-bf2f(PA[(size_t)t * NA + CA_GT + head * 3 + 1])));
        const float g2 = 1.0f / (1.0f + fast_exp(-bf2f(PA[(size_t)t * NA + CA_GT + head * 3 + 2])));
        float otot[32];
#pragma unroll
        for (int i = 0; i < 32; ++i) otot[i] = 0.f;
        for (int i = lane_of(F); i < 512; i += 64) IMP[i] = 0.f;
        LDS_WAIT(); asm volatile("" ::: "memory");
        const int jmax = (t >= 31) ? (t - 31) / 16 : -1;
        const int jmax_w = (4 * tq + 3 >= 31) ? (4 * tq + 3 - 31) / 16 : -1;
        const bf16* kcg = KC + (size_t)g * NCMP_P * HD + dq * 32; const bf16* vcg = VC + (size_t)g * NCMP_P * HD + dq * 32;
        {
            float m = -1e30f, l = 0.f;
            for (int j = 0; j <= jmax_w; ++j) {
                const float s = dot32q(q, kcg + (size_t)j * HD) - slope * (float)(t - (16 * j + 31));
                if (j <= jmax) { const float mn = fmaxf(m, s); l = l * fast_exp(m - mn) + fast_exp(s - mn); m = mn; }
            }
            const float rl = (l > 0.f) ? 1.0f / l : 0.f;
            float o[32];
#pragma unroll
            for (int i = 0; i < 32; ++i) o[i] = 0.f;
            for (int j = 0; j <= jmax_w; ++j) {
                const float s = dot32q(q, kcg + (size_t)j * HD) - slope * (float)(t - (16 * j + 31));
                const float pj = (j <= jmax) ? fast_exp(s - m) * rl : 0.f;
                axpy32(o, pj, vcg + (size_t)j * HD);
                float ps = pj; ps += __shfl_xor(ps, 4); ps += __shfl_xor(ps, 8);
                if (dq == 0 && p == 0) { IMP[ql * 128 + (j >> 2)] += ps; if ((j & 3) == 3 && (j >> 2) + 1 < 128) IMP[ql * 128 + (j >> 2) + 1] += ps; }
            }
#pragma unroll
            for (int i = 0; i < 32; ++i) otot[i] += g0 * o[i];
        }
        LDS_WAIT(); asm volatile("" ::: "memory");
        for (int qq = 0; qq < 4; ++qq) {
            const int tt = 4 * tq + qq, cur = tt >> 6;
            const int b0 = lane_of(F), b1 = lane_of(F) + 64;
            const float s0 = (b0 == cur) ? 2e6f : (b0 == 0 ? 1e6f : (b0 * 64 <= tt ? IMP[qq * 128 + b0] : -1e6f));
            const float s1 = (b1 == cur) ? 2e6f : (b1 * 64 <= tt ? IMP[qq * 128 + b1] : -1e6f);
            int r0 = 0, r1 = 0;
            for (int b = 0; b < 128; ++b) {
                const float sb = (b == cur) ? 2e6f : (b == 0 ? 1e6f : (b * 64 <= tt ? IMP[qq * 128 + b] : -1e6f));
                r0 += (sb > s0 || (sb == s0 && b < b0)) ? 1 : 0;
                r1 += (sb > s1 || (sb == s1 && b < b1)) ? 1 : 0;
            }
            const unsigned long long m0 = __ballot(r0 < 16 && b0 * 64 <= tt), m1 = __ballot(r1 < 16 && b1 * 64 <= tt);
            if (lane_of(F) == 0) { SELW[qq * 2] = m0; SELW[qq * 2 + 1] = m1; }
        }
        LDS_WAIT(); asm volatile("" ::: "memory");
        {
            const unsigned long long my0 = SELW[ql * 2], my1 = SELW[ql * 2 + 1];
            const unsigned long long u0v = SELW[0] | SELW[2] | SELW[4] | SELW[6], u1v = SELW[1] | SELW[3] | SELW[5] | SELW[7];
            const unsigned long long u0 = ((unsigned long long)(unsigned)__builtin_amdgcn_readfirstlane((int)(u0v >> 32)) << 32) | (unsigned)__builtin_amdgcn_readfirstlane((int)(unsigned)u0v);
            const unsigned long long u1 = ((unsigned long long)(unsigned)__builtin_amdgcn_readfirstlane((int)(u1v >> 32)) << 32) | (unsigned)__builtin_amdgcn_readfirstlane((int)(unsigned)u1v);
            float m = -1e30f, l = 0.f, o[32];
#pragma unroll
            for (int i = 0; i < 32; ++i) o[i] = 0.f;
            const bf16* kg = PA + CA_KS + g * HD + dq * 32; const bf16* vg = PA + CA_VS + g * HD + dq * 32;
            for (int b = 0; b < 128; ++b) {
                const bool inu = (b < 64) ? ((u0 >> b) & 1ull) : ((u1 >> (b - 64)) & 1ull);
                if (!inu) continue;
                const bool mine = (b < 64) ? ((my0 >> b) & 1ull) : ((my1 >> (b - 64)) & 1ull);
                for (int k = 0; k < 64; ++k) {
                    const int kp = b * 64 + k;
                    const float s = dot32q(q, kg + (size_t)kp * NA) - slope * (float)(t - kp);
                    const bool valid = mine && kp <= t;
                    OSM_STEP(s, valid, vg + (size_t)kp * NA);
                }
            }
            const float sc = (l > 0.f) ? g1 / l : 0.f;
#pragma unroll
            for (int i = 0; i < 32; ++i) otot[i] += sc * o[i];
        }
        {
            float m = -1e30f, l = 0.f, o[32];
#pragma unroll
            for (int i = 0; i < 32; ++i) o[i] = 0.f;
            const bf16* kg = PA + CA_KW + g * HD + dq * 32; const bf16* vg = PA + CA_VW + g * HD + dq * 32;
            const int klo = (4 * tq - 511 > 0) ? 4 * tq - 511 : 0, khi = 4 * tq + 3;
            for (int kp = klo; kp <= khi; ++kp) {
                const float s = dot32q(q, kg + (size_t)kp * NA) - slope * (float)(t - kp);
                const bool valid = kp <= t && (t - kp) < 512;
                OSM_STEP(s, valid, vg + (size_t)kp * NA);
            }
            const float sc = (l > 0.f) ? g2 / l : 0.f;
#pragma unroll
            for (int i = 0; i < 32; ++i) otot[i] += sc * o[i];
        }
        st32(MIX + (size_t)t * DM + head * HD + dq * 32, otot);
    }
}
__device__ __forceinline__ void mem_attn_naive(Frame& F, const bf16* P, int ldp, int qcol, const float* qg, int layer) {
    const bf16* MKV = WSP(bf16, WS_MKV); bf16* MIX = WSP(bf16, WS_MIX);
    const int gw = F.vcu * NWAVES + F.wave, NGW = F.G * NWAVES;
    const int dq = lane_of(F) & 3, r = lane_of(F) >> 2;
    for (int it = gw; it < NMEMH * (T / 16); it += NGW) {
        const int hm = it / (T / 16), t = 16 * (it % (T / 16)) + r;
        float q[32]; ld32(P + (size_t)t * ldp + qcol + hm * HD + dq * 32, q);
        float ss = 0.f;
#pragma unroll
        for (int i = 0; i < 32; ++i) ss += q[i] * q[i];
        ss += __shfl_xor(ss, 1); ss += __shfl_xor(ss, 2);
        const float rs = (1.0f / sqrtf(ss * (1.f / HD) + EPS)) * QSCALE;
#pragma unroll
        for (int i = 0; i < 32; ++i) q[i] = q[i] * rs * qg[dq * 32 + i];
        float m = -1e30f, l = 0.f, o[32];
#pragma unroll
        for (int i = 0; i < 32; ++i) o[i] = 0.f;
        const bf16* kg = MKV + layer * 1024 + hm * HD + dq * 32; const bf16* vg = kg + 512;
        for (int k = 0; k < MEMT; ++k) {
            const float s = dot32q(q, kg + (size_t)k * 2048);
            OSM_STEP(s, true, vg + (size_t)k * 2048);
        }
        const float sc = 1.0f / l;
#pragma unroll
        for (int i = 0; i < 32; ++i) o[i] *= sc;
        st32(MIX + (size_t)t * DM + NMIX * HD + hm * HD + dq * 32, o);
    }
}
__device__ __forceinline__ void stick_naive(Frame& F) {
    const bf16* PB = WSP(bf16, WS_PB); bf16* MIX = WSP(bf16, WS_MIX);
    const int gw = F.vcu * NWAVES + F.wave, NGW = F.G * NWAVES;
    const int dq = lane_of(F) & 3, r = lane_of(F) >> 2;
    for (int it = gw; it < NMIX * (T / 16); it += NGW) {
        const int h = it / (T / 16), t = 16 * (it % (T / 16)) + r;
        float q[32]; ld32(PB + (size_t)t * NB + CB_Q + h * HD + dq * 32, q);
#pragma unroll
        for (int i = 0; i < 32; ++i) q[i] *= QSCALE;
        float R = 0.f, o[32];
#pragma unroll
        for (int i = 0; i < 32; ++i) o[i] = 0.f;
        const bf16* kg = PB + CB_K + h * HD + dq * 32; const bf16* vg = PB + CB_V + h * HD + dq * 32;
        for (int i = 1; ; ++i) {
            const int s = t - i;
            const bool act = s >= 0 && R > -80.f;
            if (!__any(act)) break;
            const int sc = s >= 0 ? s : 0;
            const float z = dot32q(q, kg + (size_t)sc * NB);
            const float sp = fmaxf(z, 0.f) + __logf(1.0f + fast_exp(-fabsf(z)));
            if (act) { const float a = fast_exp(z - sp + R); axpy32(o, a, vg + (size_t)sc * NB); R -= sp; }
        }
        st32(MIX + (size_t)t * DM + h * HD + dq * 32, o);
    }
}

__device__ __forceinline__ void p12_router(Frame& F) {
    const float* X3 = WSP(float, WS_X3); bf16* XN = WSP(bf16, WS_XN);
    int* TOPI = (int*)(F.ws + WS_ROUTE + RT_TOPI); float* TOPW = (float*)(F.ws + WS_ROUTE + RT_TOPW); int* HIST = (int*)(F.ws + WS_ROUTE + RT_HIST);
    const float* rw = F.in[18]; const float* rb = F.in[19]; const float* gn = F.in[4] + DM;
    LAS int* hist = (LAS int*)(F.lds + RING_OFF);
    for (int c = F.vcu; c < 256; c += F.G) {
        if (F.tid < 8) hist[F.tid] = 0;
        __syncthreads();
        for (int i = 0; i < 4; ++i) {
            const int t = 32 * c + 4 * F.wave + i;
            const f32x4* xr = (const f32x4*)(X3 + (size_t)t * DM) + lane_of(F);
            f32x4 v[8]; float s = 0.f;
#pragma unroll
            for (int j = 0; j < 8; ++j) { v[j] = xr[64 * j]; s += (v[j].x * v[j].x + v[j].y * v[j].y) + (v[j].z * v[j].z + v[j].w * v[j].w); }
            const float rstd = 1.0f / sqrtf(wave_sum(s) * (1.f / DM) + EPS);
            v2u* o8 = (v2u*)(XN + (size_t)t * DM) + lane_of(F);
            float lg[8];
#pragma unroll
            for (int e = 0; e < 8; ++e) lg[e] = 0.f;
#pragma unroll
            for (int j = 0; j < 8; ++j) {
                v2u w; w.x = pk2(v[j].x * rstd, v[j].y * rstd); w.y = pk2(v[j].z * rstd, v[j].w * rstd); o8[64 * j] = w;
                const int k0 = 4 * (lane_of(F) + 64 * j);
#pragma unroll
                for (int e4 = 0; e4 < 4; ++e4) {
                    const float xg = v[j][e4] * gn[k0 + e4];
                    const f32x4 ra = *(const f32x4*)(rw + (size_t)(k0 + e4) * 8), rb4 = *(const f32x4*)(rw + (size_t)(k0 + e4) * 8 + 4);
                    lg[0] += xg * ra.x; lg[1] += xg * ra.y; lg[2] += xg * ra.z; lg[3] += xg * ra.w; lg[4] += xg * rb4.x; lg[5] += xg * rb4.y; lg[6] += xg * rb4.z; lg[7] += xg * rb4.w;
                }
            }
#pragma unroll
            for (int e = 0; e < 8; ++e) lg[e] = wave_sum(lg[e]) * rstd;
            if (lane_of(F) == 0) {
                int i0 = 0; float b0 = lg[0] + rb[0];
#pragma unroll
                for (int e = 1; e < 8; ++e) { const float b = lg[e] + rb[e]; if (b > b0) { b0 = b; i0 = e; } }
                int i1 = -1; float b1 = -3.0e38f;
#pragma unroll
                for (int e = 0; e < 8; ++e) { const float b = lg[e] + rb[e]; if (e != i0 && b > b1) { b1 = b; i1 = e; } }
                float l0 = 0.f, l1 = 0.f;
#pragma unroll
                for (int e = 0; e < 8; ++e) { l0 = (e == i0) ? lg[e] : l0; l1 = (e == i1) ? lg[e] : l1; }
                const float w0 = 1.0f / (1.0f + expf(l1 - l0));
                TOPI[2 * t] = i0; TOPI[2 * t + 1] = i1; TOPW[2 * t] = w0; TOPW[2 * t + 1] = 1.0f - w0;
                atomicAdd((int*)&hist[i0], 1); atomicAdd((int*)&hist[i1], 1);
            }
        }
        __syncthreads();
        if (F.tid < 8) HIST[c * 8 + F.tid] = hist[F.tid];
        __syncthreads();
    }
}
__device__ __forceinline__ void p13_assign(Frame& F) {
    const bf16* XN = WSP(bf16, WS_XN); bf16* AM = WSP(bf16, WS_AMOE);
    const int* TOPI = (const int*)(F.ws + WS_ROUTE + RT_TOPI); int* ROW = (int*)(F.ws + WS_ROUTE + RT_ROW); const int* HIST = (const int*)(F.ws + WS_ROUTE + RT_HIST);
    int* TILE = (int*)(F.ws + WS_ROUTE + RT_TILE);
    LAS int* sh = (LAS int*)(F.lds + RING_OFF);
    for (int c = F.vcu; c < 256; c += F.G) {
        if (F.tid < 16) sh[16 + F.tid] = 0;
        __syncthreads();
        for (int i = F.tid; i < 2048; i += 512) { const int v = HIST[i], cc = i >> 3, ee = i & 7;
            __hip_atomic_fetch_add(&sh[16 + ee], v, __ATOMIC_RELAXED, __HIP_MEMORY_SCOPE_WORKGROUP);
            if (cc < c) __hip_atomic_fetch_add(&sh[24 + ee], v, __ATOMIC_RELAXED, __HIP_MEMORY_SCOPE_WORKGROUP); }
        __syncthreads();
        if (F.tid < 8) {
            const int e = F.tid; int off = 0;
            for (int ee = 0; ee < 8; ++ee) { if (ee == e) break; off += (sh[16 + ee] + 255) & ~255; }
            sh[e] = off + sh[24 + e];
            if (c == 0 && e == 0) {
                int nt = 0;
                for (int ee = 0; ee < 8; ++ee) { const int n = (sh[16 + ee] + 255) >> 8; for (int i = 0; i < n; ++i) TILE[16 + nt + i] = ee; nt += n; }
                TILE[0] = nt;
            }
        }
        __syncthreads();
        if (F.wave == 0) {
            const int tl = lane_of(F) >> 1, sl = lane_of(F) & 1, t = 32 * c + tl;
            const int e = TOPI[2 * t + sl];
            int row = 0;
            for (int ee = 0; ee < 8; ++ee) {
                const unsigned long long mk = __ballot(e == ee);
                if (e == ee) row = sh[ee] + __popcll(mk & ((1ull << lane_of(F)) - 1ull));
            }
            ROW[2 * t + sl] = row; sh[64 + lane_of(F)] = row;
        }
        __syncthreads();
        for (int i = 0; i < 8; ++i) {
            const int idx = 8 * F.wave + i, t = 32 * c + (idx >> 1), row = sh[64 + idx];
            const v4u* src = (const v4u*)(XN + (size_t)t * DM); v4u* dst = (v4u*)(AM + (size_t)row * DM);
#pragma unroll
            for (int j = 0; j < 4; ++j) dst[lane_of(F) + 64 * j] = src[lane_of(F) + 64 * j];
        }
        __syncthreads();
    }
}
__device__ __forceinline__ void p16_combine(Frame& F) {
    const float* X3 = WSP(float, WS_X3); const bf16* Y = WSP(bf16, WS_YMOE);
    const int* ROW = (const int*)(F.ws + WS_ROUTE + RT_ROW); const float* TOPW = (const float*)(F.ws + WS_ROUTE + RT_TOPW);
    const int gw = F.vcu * NWAVES + F.wave, NGW = F.G * NWAVES;
    for (int t = gw; t < T; t += NGW) {
        const int r0 = ROW[2 * t], r1 = ROW[2 * t + 1]; const float w0 = TOPW[2 * t], w1 = TOPW[2 * t + 1];
        const v4u* y0 = (const v4u*)(Y + (size_t)r0 * DM); const v4u* y1 = (const v4u*)(Y + (size_t)r1 * DM);
        const f32x4* xr = (const f32x4*)(X3 + (size_t)t * DM); f32x4* orow = (f32x4*)(F.out + (size_t)t * DM);
#pragma unroll
        for (int j = 0; j < 4; ++j) {
            const int c8 = lane_of(F) + 64 * j;
            float a[8], b[8]; unpack8(y0[c8], a); unpack8(y1[c8], b);
            const f32x4 xa = xr[2 * c8], xb = xr[2 * c8 + 1];
            orow[2 * c8] = (f32x4){xa.x + w0 * a[0] + w1 * b[0], xa.y + w0 * a[1] + w1 * b[1], xa.z + w0 * a[2] + w1 * b[2], xa.w + w0 * a[3] + w1 * b[3]};
            orow[2 * c8 + 1] = (f32x4){xb.x + w0 * a[4] + w1 * b[4], xb.y + w0 * a[5] + w1 * b[5], xb.z + w0 * a[6] + w1 * b[6], xb.w + w0 * a[7] + w1 * b[7]};
        }
    }
}

namespace at {
typedef short bf16x8 __attribute__((ext_vector_type(8)));
typedef short s16x4 __attribute__((ext_vector_type(4)));
typedef float f32x16 __attribute__((ext_vector_type(16)));
constexpr int SHM_T = 16384;
constexpr int L_V = 0, L_K = 2 * SHM_T, L_WS = 4 * SHM_T, L_IMP = L_WS + 8 * 256, L_SEL = L_IMP + 64 * 128 * 4, L_PS = L_SEL + 1024, L_WU = L_PS + 8 * 2176, L_LIST = L_WU + 128, L_DONE = L_LIST + 512, L_END = L_DONE + 64;
static_assert(L_END <= RING_BYTES, "attention LDS map");
constexpr float C2 = 0.08838834764831845f * 1.4426950408889634f;
constexpr float LOG2E = 1.4426950408889634f;

#define KSWZ(row, colB) ((row) * 256 + ((colB) ^ (((row) & 7) << 4)))
#define SBAR() __builtin_amdgcn_sched_barrier(0)
__device__ __forceinline__ int v_st(int k, int c) { const int kk = (k & ~0xC) | ((k & 4) << 1) | ((k & 8) >> 1); return ((kk >> 3) * 4 + (c >> 5)) * 512 + ((kk & 7) * 32 + (c & 31)) * 2; }
__device__ __forceinline__ int v_rd_base(int lane) { return ((lane & 3) << 3) | (((lane >> 2) & 3) << 6) | (((lane >> 4) & 1) << 5) | (((lane >> 5) & 1) << 8); }
constexpr int v_rd_off(int d0, int ks, int half) { return d0 * 512 + ks * 4096 + half * 2048; }
__device__ __forceinline__ int crow(int r, int hi) { return (r & 3) + 8 * (r >> 2) + 4 * hi; }
__device__ __forceinline__ unsigned cvtpk(float lo, float hi) { unsigned r; asm volatile("v_cvt_pk_bf16_f32 %0, %1, %2" : "=v"(r) : "v"(lo), "v"(hi)); return r; }
__device__ __forceinline__ float xhalf_max(float v) { auto rr = __builtin_amdgcn_permlane32_swap(__float_as_uint(v), __float_as_uint(v), false, false); return fmaxf(__uint_as_float(rr[0]), __uint_as_float(rr[1])); }
__device__ __forceinline__ float xhalf_sum(float v) { auto rr = __builtin_amdgcn_permlane32_swap(__float_as_uint(v), __float_as_uint(v), false, false); return __uint_as_float(rr[0]) + __uint_as_float(rr[1]); }
__device__ __forceinline__ float quad_sum(float x) {
    x += __int_as_float(__builtin_amdgcn_update_dpp(0, __float_as_int(x), 0xB1, 0xF, 0xF, true));
    x += __int_as_float(__builtin_amdgcn_update_dpp(0, __float_as_int(x), 0x4E, 0xF, 0xF, true));
    return x;
}
__device__ __forceinline__ void pack_p(const f32x16& p0, const f32x16& p1, bf16x8& pa0, bf16x8& pa1, bf16x8& pa2, bf16x8& pa3) {
#define PK4(P, B_, OUT) do { unsigned a0 = cvtpk(P[B_+0], P[B_+1]), a1 = cvtpk(P[B_+2], P[B_+3]);                          \
        unsigned b0 = cvtpk(P[B_+4], P[B_+5]), b1 = cvtpk(P[B_+6], P[B_+7]);                                             \
        auto r0 = __builtin_amdgcn_permlane32_swap(a0, b0, false, false); auto r1 = __builtin_amdgcn_permlane32_swap(a1, b1, false, false); \
        v4u w = {r0[0], r1[0], r0[1], r1[1]}; OUT = *reinterpret_cast<bf16x8*>(&w); } while (0)
    PK4(p0, 0, pa0); PK4(p0, 8, pa1); PK4(p1, 0, pa2); PK4(p1, 8, pa3);
#undef PK4
}
template <int KB>
__device__ __forceinline__ void qkt(f32x16& p0, f32x16& p1, LAS unsigned char* lds, int r32, int hi, const bf16x8* qr) {
    p0 = f32x16{}; p1 = f32x16{};
    LAS unsigned char* kb[4];
#pragma unroll
    for (int dd = 0; dd < 4; ++dd) kb[dd] = lds + L_K + KB * SHM_T + KSWZ(r32, (dd * 16 + hi * 8) * 2);
#pragma unroll
    for (int d0 = 0; d0 < 8; ++d0) { LAS unsigned char* a = kb[d0 & 3] + (d0 >> 2) * 128;
        const bf16x8 b0 = *(const LAS bf16x8*)a;
        const bf16x8 b1 = *(const LAS bf16x8*)(a + 32 * 256);
        p0 = __builtin_amdgcn_mfma_f32_32x32x16_bf16(b0, qr[d0], p0, 0, 0, 0);
        p1 = __builtin_amdgcn_mfma_f32_32x32x16_bf16(b1, qr[d0], p1, 0, 0, 0); }
}
template <int VB>
__device__ __forceinline__ void pv_tile(f32x16* o, int vb0, bf16x8 pa0, bf16x8 pa1, bf16x8 pa2, bf16x8 pa3) {
#define TRRD(dst, off) asm volatile("ds_read_b64_tr_b16 %0, %1 offset:%2" : "=&v"(dst) : "v"(vb0), "i"(off) : "memory")
#define PV_D0(d0) do { s16x4 l0, l1, l2, l3, h0, h1, h2, h3; constexpr int b_ = VB * SHM_T + v_rd_off(d0, 0, 0); \
        TRRD(l0, b_); TRRD(h0, b_ + 2048); TRRD(l1, b_ + 4096); TRRD(h1, b_ + 6144); TRRD(l2, b_ + 8192); TRRD(h2, b_ + 10240); TRRD(l3, b_ + 12288); TRRD(h3, b_ + 14336); \
        asm volatile("s_waitcnt lgkmcnt(0)" ::: "memory"); SBAR();   \
        o[d0] = __builtin_amdgcn_mfma_f32_32x32x16_bf16(pa0, (bf16x8){l0[0], l0[1], l0[2], l0[3], h0[0], h0[1], h0[2], h0[3]}, o[d0], 0, 0, 0);   \
        o[d0] = __builtin_amdgcn_mfma_f32_32x32x16_bf16(pa1, (bf16x8){l1[0], l1[1], l1[2], l1[3], h1[0], h1[1], h1[2], h1[3]}, o[d0], 0, 0, 0);   \
        o[d0] = __builtin_amdgcn_mfma_f32_32x32x16_bf16(pa2, (bf16x8){l2[0], l2[1], l2[2], l2[3], h2[0], h2[1], h2[2], h2[3]}, o[d0], 0, 0, 0);   \
        o[d0] = __builtin_amdgcn_mfma_f32_32x32x16_bf16(pa3, (bf16x8){l3[0], l3[1], l3[2], l3[3], h3[0], h3[1], h3[2], h3[3]}, o[d0], 0, 0, 0); } while (0)
    PV_D0(0); PV_D0(1); PV_D0(2); PV_D0(3);
#undef PV_D0
#undef TRRD
}
struct Stg { v4u a, b; };
struct Tile { const bf16* K; const bf16* V; size_t ld; };
__device__ __forceinline__ void stg_load(Stg& S, const bf16* base, size_t ld, int sr, int sc) {
    S.a = *(const v4u*)(base + (size_t)sr * ld + sc); S.b = *(const v4u*)(base + (size_t)(32 + sr) * ld + sc);
}
template <int BUF> __device__ __forceinline__ void stg_write_k(const Stg& S, LAS unsigned char* lds, int sr, int sc) {
    const int kws = KSWZ(sr, sc * 2);
    *(LAS v4u*)(lds + L_K + BUF * SHM_T + kws) = S.a; *(LAS v4u*)(lds + L_K + BUF * SHM_T + kws + 32 * 256) = S.b;
}
template <int BUF> __device__ __forceinline__ void stg_write_v(const Stg& S, LAS unsigned char* lds, int sr, int sc) {
    *(LAS v4u*)(lds + L_V + BUF * SHM_T + v_st(sr, sc)) = S.a; *(LAS v4u*)(lds + L_V + BUF * SHM_T + v_st(32 + sr, sc)) = S.b;
}

template <int PASS, int KB, class Br>
__device__ __forceinline__ void step(Br& br, int i, Stg& S, LAS unsigned char* lds, int tid, const bf16x8* qr, float& m2, float& l, float f, f32x16* o) {
    int tz = tid; asm volatile("" : "+v"(tz));
    const int lane = tz & 63, sr = tz >> 4, sc = (tz & 15) * 8, r32 = lane & 31, hi = lane >> 5;
    const int vb0 = (int)(uintptr_t)(lds + L_V) + v_rd_base(lane);
    const bool more = (i + 1 < br.nt);
    Tile nx = br.tile(more ? i + 1 : i);
    if (more) stg_load(S, nx.K, nx.ld, sr, sc);
    SBAR();
    if (br.act(i)) {
        f32x16 p0, p1;
        qkt<KB>(p0, p1, lds, r32, hi, qr);
        SBAR();
        br.scores(p0, p1, i, lane);
        if (PASS == 1) {
            float pmax = p0[0];
#pragma unroll
            for (int r = 1; r < 16; ++r) pmax = fmaxf(pmax, p0[r]);
#pragma unroll
            for (int r = 0; r < 16; ++r) pmax = fmaxf(pmax, p1[r]);
            pmax = xhalf_max(pmax);
            const float mn = fmaxf(m2, pmax);
            float ps = 0.f;
#pragma unroll
            for (int r = 0; r < 16; ++r) ps += __builtin_amdgcn_exp2f(p0[r] - mn) + __builtin_amdgcn_exp2f(p1[r] - mn);
            ps = xhalf_sum(ps);
            l = l * __builtin_amdgcn_exp2f(m2 - mn) + ps; m2 = mn;
        } else {
#pragma unroll
            for (int r = 0; r < 16; ++r) { p0[r] = __builtin_amdgcn_exp2f(p0[r] - m2) * f; p1[r] = __builtin_amdgcn_exp2f(p1[r] - m2) * f; }
            br.hook(p0, p1, i, lane);
            SBAR();
            if (more) { stg_write_k<KB ^ 1>(S, lds, sr, sc); SBAR(); stg_load(S, nx.V, nx.ld, sr, sc); SBAR(); }
            bf16x8 pa0, pa1, pa2, pa3; pack_p(p0, p1, pa0, pa1, pa2, pa3);
            SBAR();
            pv_tile<KB>(o, vb0, pa0, pa1, pa2, pa3);
            SBAR();
            if (more) stg_write_v<KB ^ 1>(S, lds, sr, sc);
        }
    } else if (PASS == 2) { if (more) { stg_write_k<KB ^ 1>(S, lds, sr, sc); SBAR(); stg_load(S, nx.V, nx.ld, sr, sc); SBAR(); stg_write_v<KB ^ 1>(S, lds, sr, sc); } }
    SBAR();
    if (PASS == 1) { if (more) stg_write_k<KB ^ 1>(S, lds, sr, sc); }
    __syncthreads();
}
template <int PASS, class Br>
__device__ __forceinline__ void run_pass(Br& br, LAS unsigned char* lds, int tid, const bf16x8* qr, float& m2, float& l, float f, f32x16* o) {
    if (br.nt <= 0) return;
    const int sr = tid >> 4, sc = (tid & 15) * 8;
    Stg S;
    { const Tile t0 = br.tile(0); stg_load(S, t0.K, t0.ld, sr, sc); stg_write_k<0>(S, lds, sr, sc);
      if (PASS == 2) { stg_load(S, t0.V, t0.ld, sr, sc); stg_write_v<0>(S, lds, sr, sc); } }
    __syncthreads();
    for (int i = 0; i < br.nt; i += 2) {
        step<PASS, 0>(br, i, S, lds, tid, qr, m2, l, f, o);
        if (i + 1 < br.nt) step<PASS, 1>(br, i + 1, S, lds, tid, qr, m2, l, f, o);
    }
}
__device__ __forceinline__ void scale_rows(f32x16* o, float frow, LAS float* ws, int lane) {
    const int r32 = lane & 31, hi = lane >> 5;
    if (hi == 0) ws[r32] = frow;
    LDS_WAIT(); asm volatile("" ::: "memory");
#pragma unroll
    for (int r = 0; r < 16; ++r) { const float a = ws[crow(r, hi)];
#pragma unroll
        for (int d0 = 0; d0 < 4; ++d0) o[d0][r] *= a; }
    LDS_WAIT(); asm volatile("" ::: "memory");
}
__device__ __forceinline__ void load_q(bf16x8* qr, const bf16* qrow, int hi) {
#pragma unroll
    for (int d0 = 0; d0 < 8; ++d0) { const v4u w = *(const v4u*)(qrow + d0 * 16 + hi * 8); qr[d0] = *reinterpret_cast<const bf16x8*>(&w); }
}

struct RowNsa { int t; float slope2; };
struct BrCmp {
    int nt; const bf16* K; const bf16* V; int jmax_w; RowNsa R;
    LAS float* ps; LAS float* imp;
    __device__ __forceinline__ Tile tile(int i) const { return Tile{K + (size_t)i * 64 * HD, V + (size_t)i * 64 * HD, (size_t)HD}; }
    __device__ __forceinline__ bool act(int i) const { return 64 * i <= jmax_w; }
    __device__ __forceinline__ void scores(f32x16& p0, f32x16& p1, int i, int lane) const {
        const float NEG = -__builtin_inff(); const int hi = lane >> 5;
        float sl = R.slope2; asm volatile("" : "+v"(sl));
        int tt = R.t; asm volatile("" : "+v"(tt));
        const int jmax = (tt >= 31) ? ((tt - 31) >> 4) : -1;
        const int jm = jmax - 64 * i - 4 * hi;
        const float b0 = -sl * (float)(tt - 31 - 16 * (64 * i + 4 * hi));
#pragma unroll
        for (int r = 0; r < 16; ++r) { const int c = (r & 3) + 8 * (r >> 2);
            p0[r] = (c <= jm) ? fmaf(p0[r], C2, fmaf(sl, (float)(16 * c), b0)) : NEG;
            p1[r] = (c + 32 <= jm) ? fmaf(p1[r], C2, fmaf(sl, (float)(16 * c + 512), b0)) : NEG; }
    }
    __device__ __forceinline__ void hook(const f32x16& p0, const f32x16& p1, int i, int lane) const {
        const int r32 = lane & 31, hi = lane >> 5, pp = r32 & 3, ql = r32 >> 2;
#pragma unroll
        for (int qd = 0; qd < 4; ++qd) {
            f32x4 a, b;
#pragma unroll
            for (int e = 0; e < 4; ++e) { a[e] = quad_sum(p0[4 * qd + e]); b[e] = quad_sum(p1[4 * qd + e]); }
            if (pp == qd) { *(LAS f32x4*)(ps + ql * 68 + 4 + 8 * qd + 4 * hi) = a; *(LAS f32x4*)(ps + ql * 68 + 4 + 32 + 8 * qd + 4 * hi) = b; }
        }
        LDS_WAIT(); asm volatile("" ::: "memory");
#pragma unroll
        for (int h2 = 0; h2 < 2; ++h2) { const int idx = lane + 64 * h2, q8 = idx >> 4, mq = idx & 15;
            const f32x4 v = *(const LAS f32x4*)(ps + q8 * 68 + 4 + 4 * mq); const float pv = ps[q8 * 68 + 3 + 4 * mq];
            imp[q8 * 128 + 16 * i + mq] = (v[0] + v[1]) + (v[2] + v[3]) + pv; }
        LDS_WAIT(); asm volatile("" ::: "memory");
        if (lane < 8) ps[lane * 68 + 3] = ps[lane * 68 + 4 + 63];
        LDS_WAIT(); asm volatile("" ::: "memory");
    }
};
struct BrSlc {
    int nt; const bf16* K; const bf16* V; RowNsa R;
    const LAS int* list; const LAS unsigned long long* sel; const LAS unsigned long long* wu;
    __device__ __forceinline__ int blk(int i) const { return list[i]; }
    __device__ __forceinline__ Tile tile(int i) const { const int b = __builtin_amdgcn_readfirstlane(blk(i)); return Tile{K + (size_t)b * 64 * NA, V + (size_t)b * 64 * NA, (size_t)NA}; }
    __device__ __forceinline__ bool act(int i) const { const int b = __builtin_amdgcn_readfirstlane(blk(i)); const unsigned long long u = wu[b >> 6]; return (u >> (b & 63)) & 1ull; }
    __device__ __forceinline__ void scores(f32x16& p0, f32x16& p1, int i, int lane) const {
        const float NEG = -__builtin_inff(); const int b = __builtin_amdgcn_readfirstlane(blk(i)); const int hi = lane >> 5, ql = (lane & 31) >> 2;
        const unsigned long long mm = sel[ql * 2 + (b >> 6)];
        const bool mine = (mm >> (b & 63)) & 1ull;
        float sl = R.slope2; asm volatile("" : "+v"(sl));
        int tt = R.t; asm volatile("" : "+v"(tt));
        const int dm = mine ? (tt - 64 * b - 4 * hi) : -1;
        const float b0 = -sl * (float)dm;
#pragma unroll
        for (int r = 0; r < 16; ++r) { const int c = (r & 3) + 8 * (r >> 2);
            p0[r] = (c <= dm) ? fmaf(p0[r], C2, fmaf(sl, (float)c, b0)) : NEG;
            p1[r] = (c + 32 <= dm) ? fmaf(p1[r], C2, fmaf(sl, (float)(c + 32), b0)) : NEG; }
    }
    __device__ __forceinline__ void hook(const f32x16&, const f32x16&, int, int) const {}
};
struct BrWin {
    int nt; const bf16* K; const bf16* V; RowNsa R; int kb0;
    __device__ __forceinline__ Tile tile(int i) const { return Tile{K + (size_t)(kb0 + i) * 64 * NA, V + (size_t)(kb0 + i) * 64 * NA, (size_t)NA}; }
    __device__ __forceinline__ bool act(int) const { return true; }
    __device__ __forceinline__ void scores(f32x16& p0, f32x16& p1, int i, int lane) const {
        const float NEG = -__builtin_inff(); const int hi = lane >> 5;
        float sl = R.slope2; asm volatile("" : "+v"(sl));
        int tt = R.t; asm volatile("" : "+v"(tt));
        const int dm = tt - 64 * (kb0 + i) - 4 * hi;
        const float b0 = -sl * (float)dm;
#pragma unroll
        for (int r = 0; r < 16; ++r) { const int c = (r & 3) + 8 * (r >> 2);
            p0[r] = ((unsigned)(dm - c) < 512u) ? fmaf(p0[r], C2, fmaf(sl, (float)c, b0)) : NEG;
            p1[r] = ((unsigned)(dm - c - 32) < 512u) ? fmaf(p1[r], C2, fmaf(sl, (float)(c + 32), b0)) : NEG; }
    }
    __device__ __forceinline__ void hook(const f32x16&, const f32x16&, int, int) const {}
};
struct BrMem {
    int nt; const bf16* K; const bf16* V;
    __device__ __forceinline__ Tile tile(int i) const { return Tile{K + (size_t)i * 64 * 2048, V + (size_t)i * 64 * 2048, (size_t)2048}; }
    __device__ __forceinline__ bool act(int) const { return true; }
    __device__ __forceinline__ void scores(f32x16& p0, f32x16& p1, int, int) const {
#pragma unroll
        for (int r = 0; r < 16; ++r) { p0[r] *= C2; p1[r] *= C2; }
    }
    __device__ __forceinline__ void hook(const f32x16&, const f32x16&, int, int) const {}
};
template <class RP> __device__ __forceinline__ void store_o(const f32x16* o, int lane, RP rowptr) {
    const int r32 = lane & 31, hi = lane >> 5;
#pragma unroll
    for (int r = 0; r < 16; ++r) { bf16* rp = rowptr(crow(r, hi));
#pragma unroll
        for (int d0 = 0; d0 < 4; ++d0) { const float v = o[d0][r]; const float vn = __shfl_xor(v, 1);
            if ((r32 & 1) == 0) *(unsigned*)(rp + d0 * 32 + r32) = cvtpk(v, vn); } }
}
}

__device__ __forceinline__ void topk_select(unsigned k0, unsigned k1, int need, int lane, unsigned long long& s0, unsigned long long& s1) {
    unsigned thr = 0u;
    for (int bit = 31; bit >= 0; --bit) {
        const unsigned cand = thr | (1u << bit);
        const int cnt = __popcll(__ballot(k0 >= cand)) + __popcll(__ballot(k1 >= cand));
        if (cnt >= need) thr = cand;
    }
    const unsigned long long g0 = __ballot(k0 > thr), g1 = __ballot(k1 > thr), e0 = __ballot(k0 == thr && thr != 0u), e1 = __ballot(k1 == thr && thr != 0u);
    const int rem = need - (__popcll(g0) + __popcll(g1));
    const unsigned long long lt = (1ull << lane) - 1ull;
    const bool t0 = (k0 == thr && thr != 0u) && (__popcll(e0 & lt) < rem);
    const bool t1 = (k1 == thr && thr != 0u) && (__popcll(e0) + __popcll(e1 & lt) < rem);
    s0 = g0 | __ballot(t0); s1 = g1 | __ballot(t1);
}

__device__ __forceinline__ void nsa_item(Frame& F, int g, int qb) {
    using namespace at;
    LAS unsigned char* lds = F.lds + RING_OFF;
    const bf16* PA = WSP(bf16, WS_PA); const bf16* KC = WSP(bf16, WS_KCMP) + (size_t)g * NCMP_P * HD; const bf16* VC = KC + (size_t)NG * NCMP_P * HD; bf16* MIX = WSP(bf16, WS_MIX);
    int tz = F.tid; asm volatile("" : "+v"(tz));
    const int lane = tz & 63, w = F.wave, r32 = lane & 31, hi = lane >> 5;
    const int t0 = 64 * qb, tw = t0 + 8 * w, ql = r32 >> 2, pp = r32 & 3, t = tw + ql, head = 4 * g + pp;
    LAS float* ws = (LAS float*)(lds + L_WS + w * 256);
    LAS float* IMP = (LAS float*)(lds + L_IMP) + w * 8 * 128;
    LAS float* PS = (LAS float*)(lds + L_PS + w * 2176);
    LAS unsigned long long* SEL = (LAS unsigned long long*)(lds + L_SEL);
    LAS unsigned long long* WU = (LAS unsigned long long*)(lds + L_WU);
    LAS int* LIST = (LAS int*)(lds + L_LIST);
    RowNsa R; R.t = t; R.slope2 = exp2f(-8.0f * (float)(head + 1) / 12.0f) * LOG2E;
    bf16x8 qr[8]; load_q(qr, PA + (size_t)t * NA + CA_Q + head * HD, hi);
#define GATE(br_) (1.0f / (1.0f + fast_exp(-bf2f(PA[(size_t)t * NA + CA_GT + head * 3 + (br_)]))))
    f32x16 o[4] = {};
    for (int i = lane; i < 8 * 128; i += 64) IMP[i] = 0.f;
    if (lane < 8) PS[lane * 68 + 3] = 0.f;
    LDS_WAIT(); asm volatile("" ::: "memory");
    {
        BrCmp br; br.K = KC; br.V = VC; br.R = R; br.ps = PS; br.imp = IMP;
        br.jmax_w = (tw + 7 >= 31) ? (tw + 7 - 31) / 16 : -1;
        const int jmax_b = (t0 + 63 - 31) / 16;
        br.nt = jmax_b / 64 + 1;
        float m2 = -1e30f, l = 0.f;
        run_pass<1>(br, lds, tz, qr, m2, l, 0.f, o);
        const float f = (l > 0.f) ? 1.0f / l : 0.f;
        run_pass<2>(br, lds, tz, qr, m2, l, f, o);
        scale_rows(o, GATE(0), ws, lane);
    }
    for (int qq = 0; qq < 8; ++qq) {
        const int tt = tw + qq, cur = tt >> 6;
        const int b0 = lane, b1 = lane + 64;
        unsigned long long s0 = 0ull, s1 = 0ull;
        const int ncand = cur - 1;
        const bool c0 = (b0 >= 1 && b0 < cur), c1 = (b1 < cur);
        if (ncand <= 14) { s0 = __ballot(c0); s1 = __ballot(c1); }
        else {
            const unsigned k0 = c0 ? (__float_as_uint(IMP[qq * 128 + b0]) + 1u) : 0u, k1 = c1 ? (__float_as_uint(IMP[qq * 128 + b1]) + 1u) : 0u;
            topk_select(k0, k1, 14, lane, s0, s1);
        }
        s0 |= 1ull;
        if (cur < 64) s0 |= (1ull << cur); else s1 |= (1ull << (cur - 64));
        if (lane == 0) { SEL[(8 * w + qq) * 2] = s0; SEL[(8 * w + qq) * 2 + 1] = s1; }
    }
    LDS_WAIT(); asm volatile("" ::: "memory");
    unsigned long long wu0 = 0ull, wu1 = 0ull;
#pragma unroll
    for (int qq = 0; qq < 8; ++qq) { wu0 |= SEL[(8 * w + qq) * 2]; wu1 |= SEL[(8 * w + qq) * 2 + 1]; }
    if (lane == 0) { WU[2 * w] = wu0; WU[2 * w + 1] = wu1; }
    __syncthreads();
    int nsl = 0;
    {
        unsigned long long u0 = 0ull, u1 = 0ull;
#pragma unroll
        for (int ww = 0; ww < 8; ++ww) { u0 |= WU[2 * ww]; u1 |= WU[2 * ww + 1]; }
        nsl = __popcll(u0) + __popcll(u1);
        if (w == 0) {
            const unsigned long long lt = (1ull << lane) - 1ull;
            if ((u0 >> lane) & 1ull) LIST[__popcll(u0 & lt)] = lane;
            if ((u1 >> lane) & 1ull) LIST[__popcll(u0) + __popcll(u1 & lt)] = lane + 64;
        }
    }
    __syncthreads();
    {
        BrSlc br; br.K = PA + CA_KS + g * HD; br.V = PA + CA_VS + g * HD; br.R = R; br.list = LIST; br.nt = nsl;
        br.sel = SEL + 16 * w; br.wu = WU + 2 * w;
        float m2 = -1e30f, l = 0.f;
        run_pass<1>(br, lds, tz, qr, m2, l, 0.f, o);
        const float f = (l > 0.f) ? GATE(1) / l : 0.f;
        run_pass<2>(br, lds, tz, qr, m2, l, f, o);
    }
    {
        BrWin br; br.K = PA + CA_KW + g * HD; br.V = PA + CA_VW + g * HD; br.R = R;
        br.kb0 = (t0 - 511 > 0) ? ((t0 - 511) >> 6) : 0; br.nt = qb - br.kb0 + 1;
        float m2 = -1e30f, l = 0.f;
        run_pass<1>(br, lds, tz, qr, m2, l, 0.f, o);
        const float f = (l > 0.f) ? GATE(2) / l : 0.f;
        run_pass<2>(br, lds, tz, qr, m2, l, f, o);
    }
    store_o(o, lane, [&](int row) { return MIX + (size_t)(tw + (row >> 2)) * DM + (4 * g + (row & 3)) * HD; });
#undef GATE
}
__device__ __forceinline__ void mem_item(Frame& F, const bf16* P, int ldp, int qcol, const float* qg, int layer, int hm, int qb) {
    using namespace at;
    LAS unsigned char* lds = F.lds + RING_OFF;
    const bf16* MKV = WSP(bf16, WS_MKV); bf16* MIX = WSP(bf16, WS_MIX);
    int tz = F.tid; asm volatile("" : "+v"(tz));
    const int lane = tz & 63, w = F.wave, r32 = lane & 31, hi = lane >> 5;
    const int tw = 256 * qb + 32 * w, t = tw + r32;
    bf16x8 qr[8];
    {
        const bf16* qrow = P + (size_t)t * ldp + qcol + hm * HD;
        float qf[64]; float ss = 0.f;
#pragma unroll
        for (int d0 = 0; d0 < 8; ++d0) { const v4u wv = *(const v4u*)(qrow + d0 * 16 + hi * 8); unpack8(wv, qf + 8 * d0); }
#pragma unroll
        for (int i = 0; i < 64; ++i) ss += qf[i] * qf[i];
        ss = xhalf_sum(ss);
        const float rs = 1.0f / sqrtf(ss * (1.f / HD) + EPS);
#pragma unroll
        for (int d0 = 0; d0 < 8; ++d0) { const float* gp = qg + d0 * 16 + hi * 8;
            v4u wv; wv.x = cvtpk(qf[8 * d0] * rs * gp[0], qf[8 * d0 + 1] * rs * gp[1]); wv.y = cvtpk(qf[8 * d0 + 2] * rs * gp[2], qf[8 * d0 + 3] * rs * gp[3]);
            wv.z = cvtpk(qf[8 * d0 + 4] * rs * gp[4], qf[8 * d0 + 5] * rs * gp[5]); wv.w = cvtpk(qf[8 * d0 + 6] * rs * gp[6], qf[8 * d0 + 7] * rs * gp[7]);
            qr[d0] = *reinterpret_cast<const bf16x8*>(&wv); }
    }
    f32x16 o[4] = {};
    BrMem br; br.nt = 4; br.K = MKV + layer * 1024 + hm * HD; br.V = br.K + 512;
    float m2 = -1e30f, l = 0.f;
    run_pass<1>(br, lds, tz, qr, m2, l, 0.f, o);
    run_pass<2>(br, lds, tz, qr, m2, l, 1.0f / l, o);
    store_o(o, lane, [&](int row) { return MIX + (size_t)(tw + row) * DM + NMIX * HD + hm * HD; });
}
__device__ __forceinline__ void p3_attn(Frame& F) {
    for (int it = F.vcu; it < 384 + 128; it += F.G) {
        if (it < 384) { const int g = it % 3, qb = 127 - it / 3; nsa_item(F, g, qb); }
        else { const int j = it - 384; mem_item(F, WSP(bf16, WS_PA), NA, CA_QM, F.in[14], 0, j & 3, j >> 2); }
        __syncthreads();
    }
}

__device__ __forceinline__ void stick_tile(at::f32x16& p0, at::f32x16& p1, int k0, int t, int hi, float& R2) {
    using namespace at;
    float L0[16], L1[16];
    const float NEG = -__builtin_inff();
#pragma unroll
    for (int r = 0; r < 16; ++r) {
        const int kk = k0 + crow(r, hi);
        { const float z = p0[r] * C2; const float sp = fmaxf(z, 0.f) + __builtin_amdgcn_logf(1.0f + __builtin_amdgcn_exp2f(-fabsf(z))); const bool v = kk < t; L0[r] = v ? -sp : 0.f; p0[r] = v ? z - sp : NEG; }
        { const float z = p1[r] * C2; const float sp = fmaxf(z, 0.f) + __builtin_amdgcn_logf(1.0f + __builtin_amdgcn_exp2f(-fabsf(z))); const bool v = kk + 32 < t; L1[r] = v ? -sp : 0.f; p1[r] = v ? z - sp : NEG; }
    }
    float ct[8], pt[8];
#pragma unroll
    for (int c = 0; c < 4; ++c) { ct[c] = (L0[4 * c] + L0[4 * c + 1]) + (L0[4 * c + 2] + L0[4 * c + 3]); ct[4 + c] = (L1[4 * c] + L1[4 * c + 1]) + (L1[4 * c + 2] + L1[4 * c + 3]); }
#pragma unroll
    for (int c = 0; c < 8; ++c) { auto rr = __builtin_amdgcn_permlane32_swap(__float_as_uint(ct[c]), __float_as_uint(ct[c]), false, false); pt[c] = __uint_as_float(hi ? rr[0] : rr[1]); }
    float E[8]; float run = 0.f;
#pragma unroll
    for (int c = 7; c >= 0; --c) { E[c] = run + (hi == 0 ? pt[c] : 0.f); run += ct[c] + pt[c]; }
#pragma unroll
    for (int c = 0; c < 4; ++c) {
        { const float a3 = R2 + E[c], a2 = a3 + L0[4 * c + 3], a1 = a2 + L0[4 * c + 2], a0 = a1 + L0[4 * c + 1];
          p0[4 * c + 3] = __builtin_amdgcn_exp2f(p0[4 * c + 3] + a3); p0[4 * c + 2] = __builtin_amdgcn_exp2f(p0[4 * c + 2] + a2); p0[4 * c + 1] = __builtin_amdgcn_exp2f(p0[4 * c + 1] + a1); p0[4 * c] = __builtin_amdgcn_exp2f(p0[4 * c] + a0); }
        { const float a3 = R2 + E[4 + c], a2 = a3 + L1[4 * c + 3], a1 = a2 + L1[4 * c + 2], a0 = a1 + L1[4 * c + 1];
          p1[4 * c + 3] = __builtin_amdgcn_exp2f(p1[4 * c + 3] + a3); p1[4 * c + 2] = __builtin_amdgcn_exp2f(p1[4 * c + 2] + a2); p1[4 * c + 1] = __builtin_amdgcn_exp2f(p1[4 * c + 1] + a1); p1[4 * c] = __builtin_amdgcn_exp2f(p1[4 * c] + a0); }
    }
    R2 += run;
}
template <int KB>
__device__ __forceinline__ bool stick_step(int kb, int kb_w, at::Stg& S, LAS unsigned char* lds, int tid, const bf16* Kh, const bf16* Vh, const at::bf16x8* qr, at::f32x16* o, int tw, float& R2, LAS int* DONE) {
    using namespace at;
    int tz = tid; asm volatile("" : "+v"(tz));
    const int lane = tz & 63, w = __builtin_amdgcn_readfirstlane(tz >> 6), r32 = lane & 31, hi = lane >> 5, sr = tz >> 4, sc = (tz & 15) * 8;
    const int vb0 = (int)(uintptr_t)(lds + L_V) + v_rd_base(lane);
    int t = tw + r32; asm volatile("" : "+v"(t));
    const float THR2 = -100.f;
    const bool more = kb > 0;
    const bf16* Kn = Kh + (size_t)(more ? kb - 1 : kb) * 64 * NB; const bf16* Vn = Vh + (size_t)(more ? kb - 1 : kb) * 64 * NB;
    if (more) stg_load(S, Kn, NB, sr, sc);
    SBAR();
    bool wdone = false, kdone = false;
    if (kb <= kb_w) {
        if (__any(R2 > THR2)) {
            f32x16 p0, p1; qkt<KB>(p0, p1, lds, r32, hi, qr);
            SBAR();
            stick_tile(p0, p1, 64 * kb, t, hi, R2);
            SBAR();
            if (more) { stg_write_k<KB ^ 1>(S, lds, sr, sc); SBAR(); stg_load(S, Vn, NB, sr, sc); SBAR(); } kdone = true;
            bf16x8 pa0, pa1, pa2, pa3; pack_p(p0, p1, pa0, pa1, pa2, pa3);
            SBAR();
            pv_tile<KB>(o, vb0, pa0, pa1, pa2, pa3);
            SBAR();
        }
        wdone = !__any(R2 > THR2);
    }
    if (lane == 0) DONE[(kb & 1) * 8 + w] = wdone ? 1 : 0;
    if (more) { if (!kdone) { stg_write_k<KB ^ 1>(S, lds, sr, sc); SBAR(); stg_load(S, Vn, NB, sr, sc); SBAR(); } stg_write_v<KB ^ 1>(S, lds, sr, sc); }
    __syncthreads();
    int alld = 1;
#pragma unroll
    for (int ww = 0; ww < 8; ++ww) alld &= DONE[(kb & 1) * 8 + ww];
    return more && !alld;
}
__device__ __forceinline__ void stick_item(Frame& F, int h, int qb) {
    using namespace at;
    LAS unsigned char* lds = F.lds + RING_OFF;
    const bf16* PB = WSP(bf16, WS_PB); bf16* MIX = WSP(bf16, WS_MIX);
    int tid = F.tid; asm volatile("" : "+v"(tid));
    const int lane = tid & 63, w = F.wave, r32 = lane & 31, hi = lane >> 5, sr = tid >> 4, sc = (tid & 15) * 8;
    const int q0 = 256 * qb, tw = q0 + 32 * w, t = tw + r32;
    LAS int* DONE = (LAS int*)(lds + L_DONE);
    bf16x8 qr[8]; load_q(qr, PB + (size_t)t * NB + CB_Q + h * HD, hi);
    f32x16 o[4] = {};
    const bf16* Kh = PB + CB_K + h * HD; const bf16* Vh = PB + CB_V + h * HD;
    const int kb_hi = q0 / 64 + 3, kb_w = q0 / 64 + (w >> 1);
    float R2 = 0.f;
    Stg S;
    stg_load(S, Kh + (size_t)kb_hi * 64 * NB, NB, sr, sc); stg_write_k<0>(S, lds, sr, sc);
    stg_load(S, Vh + (size_t)kb_hi * 64 * NB, NB, sr, sc); stg_write_v<0>(S, lds, sr, sc);
    __syncthreads();
    for (int kb = kb_hi; ; kb -= 2) {
        if (!stick_step<0>(kb, kb_w, S, lds, tid, Kh, Vh, qr, o, tw, R2, DONE)) break;
        if (!stick_step<1>(kb - 1, kb_w, S, lds, tid, Kh, Vh, qr, o, tw, R2, DONE)) break;
    }
    store_o(o, lane, [&](int row) { return MIX + (size_t)(tw + row) * DM + h * HD; });
}
__device__ __forceinline__ void p10_attn(Frame& F) {
    for (int it = F.vcu; it < 384 + 128; it += F.G) {
        if (it < 384) { const int h = it % 12, qb = 31 - it / 12; stick_item(F, h, qb); }
        else { const int j = it - 384; mem_item(F, WSP(bf16, WS_PB), NB, CB_QM, F.in[14] + 2 * HD, 1, j & 3, j >> 2); }
        __syncthreads();
    }
}

constexpr int N_PHASES = 17;
#ifndef MK_PROBE_SUB
#define MK_PROBE_SUB 0
#endif
#ifndef MK_PROBE_MASK
#define MK_PROBE_MASK 0
#endif
#ifndef MK_NAIVE_P3
#define MK_NAIVE_P3 0
#endif
#ifndef MK_NAIVE_P10
#define MK_NAIVE_P10 0
#endif
struct Args { const float* in[22]; float* out; unsigned char* ws; int ph_lo, ph_hi, use_bar, pad; };
__global__ void __launch_bounds__(NWAVES * 64, 2) mk_fwd(Args args) {
    extern __shared__ __attribute__((aligned(16))) unsigned char lds[];
    Frame F;
    F.lds = (LAS unsigned char*)lds;
    F.MISC = (volatile LAS unsigned*)(F.lds + MISC_OFF);
    F.tid = threadIdx.x;  F.wave = __builtin_amdgcn_readfirstlane(F.tid >> 6);
    F.G = gridDim.x; { const int bx = blockIdx.x; F.vcu = (F.G % 8 == 0) ? (bx % 8) * (F.G / 8) + bx / 8 : bx; }
    F.ws = args.ws; F.ctl = (gu32*)(args.ws + WS_CTL); F.out = args.out;
#pragma unroll
    for (int i = 0; i < 22; ++i) F.in[i] = args.in[i];
    for (int u = F.tid; u < (LDS_BYTES - LDSCTL_OFF) / 4; u += NWAVES * 64) ((LAS unsigned*)(F.lds + LDSCTL_OFF))[u] = 0u;
    __syncthreads();
    XcdBarrier bar; bar.bar = (unsigned*)(F.ctl + CW_BAR); bar.x = 0; bar.st = nullptr;
    if (args.use_bar) bar = xcd_barrier_post((unsigned*)(F.ctl + CW_BAR), F.MISC + 8);
#define GRID_BAR() do { if (args.use_bar) xcd_barrier(bar); F.tid = threadIdx.x; asm volatile("" : "+v"(F.tid));  } while (0)
    const int lo = args.ph_lo, hi = args.ph_hi;
#ifdef MK_ONLY_PHASE
#define IN(k) ((k) == MK_ONLY_PHASE && lo <= (k) && (k) < hi)
#else
#define IN(k) (lo <= (k) && (k) < hi)
#endif
#define BOTH(k) (IN(k) && IN((k) + 1))
    typedef pg8::StaticOrder SO;

    if (IN(0)) { p0_prologue(F); if (BOTH(0)) GRID_BAR(); }
    if (IN(1)) {
        { pg8::Gemm g{WSP(bf16, WS_XN), WSP(bf16, WS_WT_INA), DM}; SO S; S.init(T / 256, NA / 256, F.G, (int)blockIdx.x);
          pg8::EpiBf16 E{WSP(bf16, WS_PA), NA}; pg8::gemm_phase<pg8::EpiBf16, SO, true, true>(F.lds + RING_OFF, g, S, E); }
        { pg8::Gemm g{WSP(bf16, WS_MEMN), WSP(bf16, WS_WT_MEM), DM}; SO S; S.init(1, 8, F.G, (int)(F.G - 1 - blockIdx.x));
          pg8::EpiBf16 E{WSP(bf16, WS_MKV), 2048}; pg8::gemm_phase<pg8::EpiBf16, SO, true, true>(F.lds + RING_OFF, g, S, E); }
        if (BOTH(1)) GRID_BAR();
    }
    if (IN(2)) { if (args.pad != 2) p2_compress(F); if (args.pad != 1) p2_qknorm(F); if (BOTH(2)) GRID_BAR(); }
#if MK_NAIVE_P3
    if (IN(3)) { p3_nsa_naive(F); mem_attn_naive(F, WSP(bf16, WS_PA), NA, CA_QM, F.in[14], 0); if (BOTH(3)) GRID_BAR(); }
#else
    if (IN(3)) { p3_attn(F); if (BOTH(3)) GRID_BAR(); }
#endif
    if (IN(4)) { pg8::Gemm g{WSP(bf16, WS_MIX), WSP(bf16, WS_WT_OUT), DM}; SO S; S.init(T / 256, DM / 256, F.G, (int)blockIdx.x);
        pg8::EpiResF32 E{F.in[0], WSP(float, WS_X1), DM}; pg8::gemm_phase<pg8::EpiResF32, SO, true, true>(F.lds + RING_OFF, g, S, E); if (BOTH(4)) GRID_BAR(); }
    if (IN(5)) { rmsnorm_rows(F, WSP(float, WS_X1), WSP(bf16, WS_XN), T); if (BOTH(5)) GRID_BAR(); }
    if (IN(6)) { pg8::Gemm g{WSP(bf16, WS_XN), WSP(bf16, WS_WT_FGU), DM}; SO S; S.init(T / 256, 2 * FF / 256, F.G, (int)blockIdx.x);
        pg8::EpiSwiglu E{WSP(bf16, WS_HFF), FF}; pg8::gemm_phase<pg8::EpiSwiglu, SO, true, true>(F.lds + RING_OFF, g, S, E); if (BOTH(6)) GRID_BAR(); }
    if (IN(7)) { pg8::Gemm g{WSP(bf16, WS_HFF), WSP(bf16, WS_WT_FDN), FF}; SO S; S.init(T / 256, DM / 256, F.G, (int)blockIdx.x);
        pg8::EpiResF32 E{WSP(float, WS_X1), WSP(float, WS_X2), DM}; pg8::gemm_phase<pg8::EpiResF32, SO, true, true>(F.lds + RING_OFF, g, S, E); if (BOTH(7)) GRID_BAR(); }
    if (IN(8)) { rmsnorm_rows(F, WSP(float, WS_X2), WSP(bf16, WS_XN), T); if (BOTH(8)) GRID_BAR(); }
    if (IN(9)) { pg8::Gemm g{WSP(bf16, WS_XN), WSP(bf16, WS_WT_INB), DM}; SO S; S.init(T / 256, NB / 256, F.G, (int)blockIdx.x);
        pg8::EpiBf16 E{WSP(bf16, WS_PB), NB}; pg8::gemm_phase<pg8::EpiBf16, SO, true, true>(F.lds + RING_OFF, g, S, E); if (BOTH(9)) GRID_BAR(); }
#if MK_NAIVE_P10
    if (IN(10)) { stick_naive(F); mem_attn_naive(F, WSP(bf16, WS_PB), NB, CB_QM, F.in[14] + 2 * HD, 1); if (BOTH(10)) GRID_BAR(); }
#else
    if (IN(10)) { p10_attn(F); if (BOTH(10)) GRID_BAR(); }
#endif
    if (IN(11)) { pg8::Gemm g{WSP(bf16, WS_MIX), WSP(bf16, WS_WT_OUT) + (size_t)DM * DM, DM}; SO S; S.init(T / 256, DM / 256, F.G, (int)blockIdx.x);
        pg8::EpiResF32 E{WSP(float, WS_X2), WSP(float, WS_X3), DM}; pg8::gemm_phase<pg8::EpiResF32, SO, true, true>(F.lds + RING_OFF, g, S, E); if (BOTH(11)) GRID_BAR(); }
    if (IN(12)) { p12_router(F); if (BOTH(12)) GRID_BAR(); }
    if (IN(13)) { p13_assign(F); if (BOTH(13)) GRID_BAR(); }
    if (IN(14)) { const int* TILE = (const int*)(F.ws + WS_ROUTE + RT_TILE); const int ntl = TILE[0];
        pg8::Gemm g{WSP(bf16, WS_AMOE), WSP(bf16, WS_WT_MGU), DM}; pg8::MoeOrder S; S.init(ntl, 2 * FF / 256, F.G, (int)blockIdx.x); S.tile_e = TILE + 16; S.estride = (size_t)2 * FF * DM * 2;
        pg8::EpiSwiglu E{WSP(bf16, WS_HMOE), FF}; pg8::gemm_phase<pg8::EpiSwiglu, pg8::MoeOrder, true, true>(F.lds + RING_OFF, g, S, E); if (BOTH(14)) GRID_BAR(); }
    if (IN(15)) { const int* TILE = (const int*)(F.ws + WS_ROUTE + RT_TILE); const int ntl = TILE[0];
        pg8::Gemm g{WSP(bf16, WS_HMOE), WSP(bf16, WS_WT_MDN), FF}; pg8::MoeOrder S; S.init(ntl, DM / 256, F.G, (int)blockIdx.x); S.tile_e = TILE + 16; S.estride = (size_t)DM * FF * 2;
        pg8::EpiBf16 E{WSP(bf16, WS_YMOE), DM}; pg8::gemm_phase<pg8::EpiBf16, pg8::MoeOrder, true, true>(F.lds + RING_OFF, g, S, E); if (BOTH(15)) GRID_BAR(); }
    if (IN(16)) { p16_combine(F); }
#undef IN
#undef BOTH
}

#ifndef MK_ONE_LAUNCH
#define MK_ONE_LAUNCH 1
#endif
extern "C" void kernel_launch(void* const* d_in, const int* in_sizes, int n_in, void* d_out, int out_size, void* d_ws, size_t ws_size, hipStream_t stream) {
    static int grid = 0;
    if (grid == 0) {
        if (n_in != 22 || in_sizes[0] != T * DM || out_size != T * DM || ws_size < WS_END) { fprintf(stderr, "kernel_launch: unexpected shapes (n_in %d, in0 %d, out %d, ws %zu < %zu)\n", n_in, n_in > 0 ? in_sizes[0] : -1, out_size, ws_size, (size_t)WS_END); grid = -1; return; }
        int dev = 0, cus = 0, per_cu = 0;
        if (hipGetDevice(&dev) != hipSuccess || hipDeviceGetAttribute(&cus, hipDeviceAttributeMultiprocessorCount, dev) != hipSuccess) { grid = -1; return; }
        if (hipFuncSetAttribute((const void*)mk_fwd, hipFuncAttributeMaxDynamicSharedMemorySize, LDS_BYTES) != hipSuccess) { fprintf(stderr, "kernel_launch: hipFuncSetAttribute failed\n"); grid = -1; return; }
        if (hipOccupancyMaxActiveBlocksPerMultiprocessor(&per_cu, (const void*)mk_fwd, NWAVES * 64, LDS_BYTES) != hipSuccess || per_cu < 1) { fprintf(stderr, "kernel_launch: occupancy query says %d blocks per CU\n", per_cu); }
        (void)hipGetLastError();
        grid = cus;
    }
    if (grid < 0) return;
    if (hipMemsetAsync((char*)d_ws + WS_CTL, 0, CTL_ZERO_BYTES, stream) != hipSuccess) return;
    Args a{};
    for (int i = 0; i < 22; ++i) a.in[i] = (const float*)d_in[i];
    a.out = (float*)d_out; a.ws = (unsigned char*)d_ws; a.pad = 0;
#if MK_ONE_LAUNCH
    a.ph_lo = 0; a.ph_hi = N_PHASES; a.use_bar = 1;
    hipLaunchKernelGGL(mk_fwd, dim3(grid), dim3(NWAVES * 64), LDS_BYTES, stream, a);
    for (int p = 0; p < N_PHASES; ++p) if ((MK_PROBE_MASK >> p) & 1) { a.ph_lo = p; a.ph_hi = p + 1; a.use_bar = 0; a.pad = MK_PROBE_SUB;
        hipLaunchKernelGGL(mk_fwd, dim3(grid), dim3(NWAVES * 64), LDS_BYTES, stream, a); }
#else
    for (int p = 0; p < N_PHASES; ++p) { a.ph_lo = p; a.ph_hi = p + 1; a.use_bar = 0;
        hipLaunchKernelGGL(mk_fwd, dim3(grid), dim3(NWAVES * 64), LDS_BYTES, stream, a); }
#endif
}
```

```cpp
#include <hip/hip_runtime.h>
#include <cstdio>
#include <cstdint>

namespace pg8 {
#define PG8_LAS __attribute__((address_space(3)))
typedef unsigned short bf16_t;
typedef short bf16x8 __attribute__((ext_vector_type(8)));
typedef float f32x4 __attribute__((ext_vector_type(4)));
typedef unsigned u32x4 __attribute__((ext_vector_type(4)));
constexpr int BM = 256, BK = 64, HALF = 128, HTB = HALF * BK * 2  , STAGE_BYTES = 8 * HTB, NXCD = 8, WGM = 8;

__host__ __device__ __forceinline__ int lds_byte(int r, int c) { const int st = (r >> 4) * 2 + (c >> 5), rr = r & 15, cc = c & 31, ob = rr * 64 + cc * 2; return st * 1024 + (ob ^ (((ob >> 9) & 1) << 5)); }
__host__ __device__ __forceinline__ void stage_rc(int b, int& R, int& C) { const int st = b / 1024, sb = b % 1024, swz = sb ^ (((sb >> 9) & 1) << 5); R = (st >> 1) * 16 + swz / 64; C = (st & 1) * 32 + (swz % 64) / 2; }
__host__ __device__ __forceinline__ int perm32(int rho) { const int n = rho >> 4, i = rho & 15; return 8 * (i >> 2) + 4 * n + (i & 3); }

struct Unit { int pm, pn; };
struct Gemm { const bf16_t* A; const bf16_t* Bt; int K; };

struct StaticOrder {
    int nM, nN, nwg, G, c;
    __device__ void init(int nM_, int nN_, int G_, int c_) { nM = nM_; nN = nN_; nwg = nM * nN; G = G_; c = c_; }
    __device__ bool next(int i, Unit& u) const {
        const long L = (long)i * G + c; if (L >= nwg) return false;
        int wgid = (int)L; { const int q = nwg / NXCD, r = nwg % NXCD, xcd = wgid % NXCD, off = wgid / NXCD; wgid = (xcd < r ? xcd * (q + 1) : r * (q + 1) + (xcd - r) * q) + off; }
        const int nig = WGM * nN, gid = wgid / nig, fm = gid * WGM, gsz = (nM - fm) < WGM ? (nM - fm) : WGM;
        u.pm = fm + ((wgid % nig) % gsz); u.pn = (wgid % nig) / gsz; return true;
    }
    __device__ __forceinline__ const char* a_base(const Gemm& g, const Unit& u) const { return (const char*)g.A + (size_t)u.pm * ((size_t)BM * g.K * 2); }
    __device__ __forceinline__ const char* b_base(const Gemm& g, const Unit& u) const { return (const char*)g.Bt + (size_t)u.pn * ((size_t)BM * g.K * 2); }
    __device__ __forceinline__ void a_ready(const Unit&) const {}
    __device__ __forceinline__ void done(const Unit&) const {}
};
struct MoeOrder : StaticOrder {
    const int* tile_e; size_t estride;
    __device__ __forceinline__ const char* b_base(const Gemm& g, const Unit& u) const { return (const char*)g.Bt + (size_t)tile_e[u.pm] * estride + (size_t)u.pn * ((size_t)BM * g.K * 2); }
};

__device__ __forceinline__ unsigned cvt_pk_bf16(float lo, float hi) { unsigned r; asm volatile("v_cvt_pk_bf16_f32 %0, %1, %2" : "=v"(r) : "v"(lo), "v"(hi)); return r; }

struct EpiBf16 {
    static constexpr bool PERM = true, AFTER_DRAIN = false;
    bf16_t* O; int ldc;
    __device__ __forceinline__ void operator()(const f32x4 (&acc)[2][2][4][2], const Unit& u, int wr, int wc, int fr, int fq) const {
        const int row0 = u.pm * BM + wr * 64 + fr, col0 = u.pn * BM + wc * 32 + 8 * fq;
#pragma unroll
        for (int ai = 0; ai < 2; ++ai)
#pragma unroll
            for (int m = 0; m < 4; ++m) { bf16_t* rowp = O + (size_t)(row0 + ai * HALF + m * 16) * ldc + col0;
#pragma unroll
                for (int bj = 0; bj < 2; ++bj) { const f32x4 v0 = acc[ai][bj][m][0], v1 = acc[ai][bj][m][1];
                    u32x4 w; w.x = cvt_pk_bf16(v0[0], v0[1]); w.y = cvt_pk_bf16(v0[2], v0[3]); w.z = cvt_pk_bf16(v1[0], v1[1]); w.w = cvt_pk_bf16(v1[2], v1[3]);
                    *(u32x4*)(rowp + bj * HALF) = w; } }
    }
};
struct EpiSwiglu {
    static constexpr bool PERM = true, AFTER_DRAIN = false;
    bf16_t* O; int ldc;
    __device__ __forceinline__ void operator()(const f32x4 (&acc)[2][2][4][2], const Unit& u, int wr, int wc, int fr, int fq) const {
        const int row0 = u.pm * BM + wr * 64 + fr, col0 = u.pn * HALF + wc * 32 + 8 * fq;
#pragma unroll
        for (int ai = 0; ai < 2; ++ai)
#pragma unroll
            for (int m = 0; m < 4; ++m) { bf16_t* rowp = O + (size_t)(row0 + ai * HALF + m * 16) * ldc + col0;
                float h[8];
#pragma unroll
                for (int n = 0; n < 2; ++n)
#pragma unroll
                    for (int j = 0; j < 4; ++j) { const float gq = acc[ai][0][m][n][j], uq = acc[ai][1][m][n][j];
                        const float sg = __builtin_amdgcn_rcpf(1.0f + __builtin_amdgcn_exp2f(-1.4426950408889634f * gq));
                        h[n * 4 + j] = gq * sg * uq; }
                u32x4 w; w.x = cvt_pk_bf16(h[0], h[1]); w.y = cvt_pk_bf16(h[2], h[3]); w.z = cvt_pk_bf16(h[4], h[5]); w.w = cvt_pk_bf16(h[6], h[7]);
                *(u32x4*)rowp = w; }
    }
};
struct EpiResF32 {
    static constexpr bool PERM = false, AFTER_DRAIN = false;
    const float* base; float* out; int ldc;
    __device__ __forceinline__ void operator()(const f32x4 (&acc)[2][2][4][2], const Unit& u, int wr, int wc, int fr, int fq) const {
        const int row0 = u.pm * BM + wr * 64 + fr, col0 = u.pn * BM + wc * 32 + 4 * fq;
#pragma unroll
        for (int ai = 0; ai < 2; ++ai)
#pragma unroll
            for (int m = 0; m < 4; ++m) { const size_t off = (size_t)(row0 + ai * HALF + m * 16) * ldc + col0;
#pragma unroll
                for (int bj = 0; bj < 2; ++bj)
#pragma unroll
                    for (int n = 0; n < 2; ++n) { const f32x4 b = *(const f32x4*)(base + off + bj * HALF + n * 16); *(f32x4*)(out + off + bj * HALF + n * 16) = b + acc[ai][bj][m][n]; } }
    }
};
template <class Epi, class Sched, bool ALIGN_EPI = false, bool SP2 = false>
__device__ __forceinline__ void gemm_phase(PG8_LAS unsigned char* lds, const Gemm g, const Sched& S, const Epi& E) {
    int tid = threadIdx.x; asm volatile("" : "+v"(tid));
    const int wid = __builtin_amdgcn_readfirstlane(tid >> 6), lane = tid & 63, wr = wid >> 2, wc = wid & 3, fr = lane & 15, fq = lane >> 4;
    const int K = g.K, nt = K / BK;
    unsigned voffA[2], voffB[2];
#pragma unroll
    for (int i = 0; i < 2; ++i) { int R, C; stage_rc(tid * 16 + i * 8192, R, C); const int Rb = Epi::PERM ? ((R & ~31) + perm32(R & 31)) : R;
        voffA[i] = (unsigned)(R * K + C) * 2u; voffB[i] = (unsigned)(Rb * K + C) * 2u; }
    const size_t kstep = (size_t)(BK * 2);
    const size_t hstep = (size_t)HALF * K * 2;
    const unsigned ldsw = (unsigned)wid * 1024u;
    const int aoff = lds_byte(wr * 64 + fr, fq * 8), boff = lds_byte(wc * 32 + fr, fq * 8);
#define PG8_SA(b, h) (((b) * 2 + (h)) * HTB)
#define PG8_SB(b, h) ((4 + (b) * 2 + (h)) * HTB)
#define PG8_STAGE(bufoff, gbase, voff) do { _Pragma("unroll") for (int _i = 0; _i < 2; ++_i) \
        __builtin_amdgcn_global_load_lds((const unsigned*)((const char*)(gbase) + (voff)[_i]), (PG8_LAS unsigned*)(lds + (bufoff) + ldsw + _i * 8192), 16, 0, 0); } while (0)
#define PG8_LDA(dst, b, h) do { _Pragma("unroll") for (int m = 0; m < 4; ++m) _Pragma("unroll") for (int k = 0; k < 2; ++k) dst[m][k] = *(const PG8_LAS bf16x8*)(lds + PG8_SA(b, h) + aoff + m * 2048 + k * 1024); } while (0)
#define PG8_LDB(dst, b, h) do { _Pragma("unroll") for (int n = 0; n < 2; ++n) _Pragma("unroll") for (int k = 0; k < 2; ++k) dst[n][k] = *(const PG8_LAS bf16x8*)(lds + PG8_SB(b, h) + boff + n * 2048 + k * 1024); } while (0)
#define PG8_MMA(ai, bj, At, Bt) do { __builtin_amdgcn_s_setprio(1); _Pragma("unroll") for (int m = 0; m < 4; ++m) _Pragma("unroll") for (int n = 0; n < 2; ++n) _Pragma("unroll") for (int k = 0; k < 2; ++k) \
        acc[ai][bj][m][n] = __builtin_amdgcn_mfma_f32_16x16x32_bf16(Bt[n][k], At[m][k], acc[ai][bj][m][n], 0, 0, 0); __builtin_amdgcn_s_setprio(0); } while (0)
#define PG8_WAIT_V(n) asm volatile("s_waitcnt vmcnt(" #n ")" ::: "memory")
#define PG8_WAIT_L(n) asm volatile("s_waitcnt lgkmcnt(" #n ")" ::: "memory")
#define PG8_BAR __builtin_amdgcn_s_barrier()
#define PG8_SCHED __builtin_amdgcn_sched_barrier(0)
    Unit cur, nxt; int ui = 0;
    if (!S.next(0, cur)) return;
    f32x4 acc[2][2][4][2];
#pragma unroll
    for (int a = 0; a < 2; ++a)
#pragma unroll
        for (int b = 0; b < 2; ++b)
#pragma unroll
            for (int m = 0; m < 4; ++m)
#pragma unroll
                for (int n = 0; n < 2; ++n) acc[a][b][m][n] = (f32x4){0.f, 0.f, 0.f, 0.f};
    bf16x8 At[4][2], B0[2][2], B1[2][2];
    const char* cA = S.a_base(g, cur); const char* cB = S.b_base(g, cur);
    S.a_ready(cur);
    if constexpr (SP2) {
        PG8_STAGE(PG8_SB(0, 0), cB, voffB); PG8_STAGE(PG8_SB(0, 1), cB + hstep, voffB); PG8_STAGE(PG8_SA(0, 0), cA, voffA); PG8_STAGE(PG8_SA(0, 1), cA + hstep, voffA);
        if (wr == 1) PG8_BAR;
        PG8_WAIT_V(2); PG8_BAR;
        PG8_STAGE(PG8_SB(1, 0), cB + kstep, voffB); PG8_STAGE(PG8_SA(1, 0), cA + kstep, voffA); PG8_STAGE(PG8_SB(1, 1), cB + hstep + kstep, voffB);
        PG8_WAIT_V(6); PG8_BAR;
    } else {
        PG8_STAGE(PG8_SB(0, 0), cB, voffB); PG8_STAGE(PG8_SA(0, 0), cA, voffA); PG8_STAGE(PG8_SB(0, 1), cB + hstep, voffB); PG8_STAGE(PG8_SA(0, 1), cA + hstep, voffA);
        if (wr == 1) PG8_BAR;
        PG8_WAIT_V(4); PG8_BAR;
        PG8_STAGE(PG8_SB(1, 0), cB + kstep, voffB); PG8_STAGE(PG8_SA(1, 0), cA + kstep, voffA); PG8_STAGE(PG8_SB(1, 1), cB + hstep + kstep, voffB);
        PG8_WAIT_V(6); PG8_BAR;
    }
    for (;;) {
        const bool has_next = S.next(ui + 1, nxt);
        const char* nA = has_next ? S.a_base(g, nxt) : cA; const char* nB = has_next ? S.b_base(g, nxt) : cB;
        for (int t = 0; t < nt; t += 2) {
            const bool last = (t == nt - 2);
            const char* a1 = cA + (size_t)(t + 1) * kstep;
            const char* a2 = last ? nA : cA + (size_t)(t + 2) * kstep; const char* b2 = last ? nB : cB + (size_t)(t + 2) * kstep;
            const char* a3 = a2 + kstep; const char* b3 = b2 + kstep;
            if (last && has_next) S.a_ready(nxt);
            if constexpr (SP2) {
            PG8_LDB(B0, 0, 0); PG8_LDB(B1, 0, 1); PG8_SCHED; PG8_LDA(At, 0, 0); PG8_STAGE(PG8_SA(1, 1), a1 + hstep, voffA);
            PG8_WAIT_V(8); PG8_WAIT_L(0); PG8_BAR; PG8_MMA(0, 0, At, B0); PG8_MMA(0, 1, At, B1); PG8_BAR; PG8_SCHED;
            PG8_LDA(At, 0, 1); PG8_STAGE(PG8_SB(0, 0), b2, voffB); PG8_STAGE(PG8_SB(0, 1), b2 + hstep, voffB); PG8_STAGE(PG8_SA(0, 0), a2, voffA);
            PG8_WAIT_V(8); PG8_WAIT_L(0); PG8_BAR; PG8_MMA(1, 0, At, B0); PG8_MMA(1, 1, At, B1); PG8_BAR; PG8_SCHED;
            PG8_LDB(B0, 1, 0); PG8_LDB(B1, 1, 1); PG8_SCHED; PG8_LDA(At, 1, 0); PG8_STAGE(PG8_SA(0, 1), a2 + hstep, voffA);
            PG8_WAIT_V(8); PG8_WAIT_L(0); PG8_BAR; PG8_MMA(0, 0, At, B0); PG8_MMA(0, 1, At, B1); PG8_BAR; PG8_SCHED;
            PG8_LDA(At, 1, 1); PG8_STAGE(PG8_SB(1, 0), b3, voffB); PG8_STAGE(PG8_SB(1, 1), b3 + hstep, voffB); PG8_STAGE(PG8_SA(1, 0), a3, voffA);
            PG8_WAIT_V(8); PG8_WAIT_L(0); PG8_BAR; PG8_MMA(1, 0, At, B0); PG8_MMA(1, 1, At, B1); PG8_BAR; PG8_SCHED;
            } else {
            PG8_LDB(B0, 0, 0); PG8_SCHED; PG8_LDA(At, 0, 0); PG8_STAGE(PG8_SA(1, 1), a1 + hstep, voffA);
            PG8_WAIT_L(8); PG8_BAR; PG8_WAIT_L(0); PG8_MMA(0, 0, At, B0); PG8_BAR; PG8_SCHED;
            PG8_LDB(B1, 0, 1); PG8_STAGE(PG8_SB(0, 0), b2, voffB);
            PG8_BAR; PG8_WAIT_L(0); PG8_MMA(0, 1, At, B1); PG8_BAR;
            PG8_LDA(At, 0, 1); PG8_STAGE(PG8_SA(0, 0), a2, voffA);
            PG8_BAR; PG8_WAIT_L(0); PG8_MMA(1, 0, At, B0); PG8_BAR; PG8_SCHED;
            PG8_STAGE(PG8_SB(0, 1), b2 + hstep, voffB);
            PG8_WAIT_V(6); PG8_BAR; PG8_MMA(1, 1, At, B1); PG8_BAR;
            PG8_LDB(B0, 1, 0); PG8_SCHED; PG8_LDA(At, 1, 0); PG8_STAGE(PG8_SA(0, 1), a2 + hstep, voffA);
            PG8_WAIT_L(8); PG8_BAR; PG8_WAIT_L(0); PG8_MMA(0, 0, At, B0); PG8_BAR; PG8_SCHED;
            PG8_LDB(B1, 1, 1); PG8_STAGE(PG8_SB(1, 0), b3, voffB);
            PG8_BAR; PG8_WAIT_L(0); PG8_MMA(0, 1, At, B1); PG8_BAR;
            PG8_LDA(At, 1, 1); PG8_STAGE(PG8_SA(1, 0), a3, voffA);
            PG8_BAR; PG8_WAIT_L(0); PG8_MMA(1, 0, At, B0); PG8_BAR; PG8_SCHED;
            PG8_STAGE(PG8_SB(1, 1), b3 + hstep, voffB);
            PG8_WAIT_V(6); PG8_BAR; PG8_MMA(1, 1, At, B1); PG8_BAR;
            }
        }
        if constexpr (ALIGN_EPI) { if (wr == 0) PG8_BAR; }
        if constexpr (!Epi::AFTER_DRAIN) { E(acc, cur, wr, wc, fr, fq); S.done(cur); }
        if (!has_next) break;
#pragma unroll
        for (int a = 0; a < 2; ++a)
#pragma unroll
            for (int b = 0; b < 2; ++b)
#pragma unroll
                for (int m = 0; m < 4; ++m)
#pragma unroll
                    for (int n = 0; n < 2; ++n) acc[a][b][m][n] = (f32x4){0.f, 0.f, 0.f, 0.f};
        cur = nxt; cA = nA; cB = nB; ++ui;
        if constexpr (ALIGN_EPI) { if (wr == 1) PG8_BAR; }
    }
    PG8_WAIT_V(0);
    if constexpr (!ALIGN_EPI) { if (wr == 0) PG8_BAR; }
    PG8_BAR;
    if constexpr (Epi::AFTER_DRAIN) { E.fused(acc, cur, wr, wc, fr, fq, lds, wid, lane); S.done(cur); }
#undef PG8_SA
#undef PG8_SB
#undef PG8_STAGE
#undef PG8_LDA
#undef PG8_LDB
#undef PG8_MMA
#undef PG8_WAIT_V
#undef PG8_WAIT_L
#undef PG8_BAR
#undef PG8_SCHED
}
}


constexpr int T = 8192, DM = 2048, HD = 128, NMIX = 12, NMEMH = 4, NG = 3, MEMT = 256, FF = 7168, NE = 8;
constexpr int A_IN_W = 4388, NA = 4608;
constexpr int NB = 5120;
constexpr int CA_Q = 0, CA_KC = 1536, CA_VC = 1920, CA_KS = 2304, CA_VS = 2688, CA_KW = 3072, CA_VW = 3456, CA_QM = 3840, CA_GT = 4352;
constexpr int CB_Q = 0, CB_QM = 1536, CB_K = 2048, CB_V = 3584;
constexpr int NCMP = 511, NCMP_P = 512;
constexpr int MOE_MAXT = 72;
constexpr float EPS = 1e-6f;
constexpr float QSCALE = 0.08838834764831845f;

constexpr size_t MiB = 1u << 20;
constexpr size_t WS_CTL = 0, CTL_ZERO_BYTES = 1 * MiB;
constexpr size_t WS_WT_INA = 2 * MiB;
constexpr size_t WS_WT_MEM = 20 * MiB;
constexpr size_t WS_WT_OUT = 28 * MiB;
constexpr size_t WS_WT_FGU = 44 * MiB;
constexpr size_t WS_WT_FDN = 100 * MiB;
constexpr size_t WS_WT_INB = 128 * MiB;
constexpr size_t WS_WT_MGU = 148 * MiB;
constexpr size_t WS_WT_MDN = 596 * MiB;
constexpr size_t WS_XN = 820 * MiB;
constexpr size_t WS_MEMN = 852 * MiB;
constexpr size_t WS_MKV = 853 * MiB;
constexpr size_t WS_PA = 854 * MiB;
constexpr size_t WS_KCMP = 926 * MiB;
constexpr size_t WS_MIX = 927 * MiB;
constexpr size_t WS_X1 = 959 * MiB;
constexpr size_t WS_X2 = 1023 * MiB;
constexpr size_t WS_X3 = 1087 * MiB;
constexpr size_t WS_HFF = 1151 * MiB;
constexpr size_t WS_PB = 1263 * MiB;
constexpr size_t WS_AMOE = 1343 * MiB;
constexpr size_t WS_HMOE = 1415 * MiB;
constexpr size_t WS_YMOE = 1667 * MiB;
constexpr size_t WS_ROUTE = 1739 * MiB;
constexpr size_t WS_WT_CMP = 1740 * MiB;
constexpr size_t WS_OACC = 1742 * MiB;
constexpr size_t WS_END = 1790 * MiB;
constexpr size_t RT_TOPI = 0;
constexpr size_t RT_TOPW = 65536;
constexpr size_t RT_ROW = 131072;
constexpr size_t RT_HIST = 196608;
constexpr size_t RT_TILE = 204800;
constexpr int CW_TMO = 0, CW_CODE = 1, CW_BAR = 4096;

constexpr int RING_OFF = 0, RING_BYTES = 135168;
constexpr int LDSCTL_OFF = RING_BYTES, MISC_OFF = LDSCTL_OFF + 320;
constexpr int LDS_BYTES = 147456;
static_assert(MISC_OFF + 128 <= LDS_BYTES, "LDS map");
constexpr int NWAVES = 8;

#define GAS __attribute__((address_space(1)))
#define LAS __attribute__((address_space(3)))
typedef unsigned short bf16;
typedef unsigned v4u __attribute__((ext_vector_type(4)));
typedef unsigned v2u __attribute__((ext_vector_type(2)));
typedef float f32x4 __attribute__((ext_vector_type(4)));
typedef GAS unsigned gu32;
#define RLX_AGENT __ATOMIC_RELAXED, __HIP_MEMORY_SCOPE_AGENT
#define LDS_WAIT() asm volatile("s_waitcnt lgkmcnt(0)" ::: "memory")
#define VM_WAIT() asm volatile("s_waitcnt vmcnt(0)" ::: "memory")
__device__ __forceinline__ float bf2f(unsigned b) { return __uint_as_float(b << 16); }
__device__ __forceinline__ unsigned pk2(float lo, float hi) { return pg8::cvt_pk_bf16(lo, hi); }
__device__ __forceinline__ void unpack8(v4u w, float* f) {
    f[0] = __uint_as_float(w.x << 16); f[1] = __uint_as_float(w.x & 0xffff0000u); f[2] = __uint_as_float(w.y << 16); f[3] = __uint_as_float(w.y & 0xffff0000u);
    f[4] = __uint_as_float(w.z << 16); f[5] = __uint_as_float(w.z & 0xffff0000u); f[6] = __uint_as_float(w.w << 16); f[7] = __uint_as_float(w.w & 0xffff0000u); }
__device__ __forceinline__ float wave_sum(float v) {
#pragma unroll
    for (int o = 1; o < 64; o <<= 1) v += __shfl_xor(v, o);
    return v;
}
__device__ __forceinline__ float fast_exp(float x) { return __builtin_amdgcn_exp2f(x * 1.4426950408889634f); }

#define XB_TMO      128
#define XB_XCNT(j)  (256  + 64 * (j))
#define XB_XSUB(j)  (1280 + 64 * (j))
#define XB_XGEN(j)  (2304 + 64 * (j))
#define XB_TOP      3328
#define XB_TOPGEN   3392
#define XCD_BAR_WORDS 3456
#define XB_SPIN_CAP (1u << 18)
__device__ __forceinline__ unsigned xb_ld(unsigned* p)              { return __hip_atomic_load(p, __ATOMIC_RELAXED, __HIP_MEMORY_SCOPE_AGENT); }
__device__ __forceinline__ unsigned xb_add(unsigned* p, unsigned v) { return __hip_atomic_fetch_add(p, v, __ATOMIC_RELAXED, __HIP_MEMORY_SCOPE_AGENT); }
__device__ __forceinline__ unsigned xb_xcc_id() { return (unsigned)__builtin_amdgcn_s_getreg((3 << 11) | 20) & 0xFu; }
#define XB_SPIN(cond, bar) do { unsigned _sp = 0; while (cond) { __builtin_amdgcn_s_sleep(1); \
    if ((++_sp & 255u) == 0u) { if (xb_ld(&(bar)[XB_TMO])) break; if (_sp > XB_SPIN_CAP) { atomicAdd(&(bar)[XB_TMO], 1u); break; } } } } while (0)
struct XcdBarrier { unsigned* bar; unsigned x; volatile LAS unsigned* st; };
__device__ __forceinline__ XcdBarrier xcd_barrier_post(unsigned* bar, volatile LAS unsigned* st) {
    XcdBarrier b; b.bar = bar; b.x = xb_xcc_id(); b.st = st;
    if (threadIdx.x == 0) (void)xb_add(&bar[XB_XCNT(b.x)], 1u);
    return b;
}
__device__ __forceinline__ void xcd_barrier_complete(unsigned* bar, unsigned x, unsigned& nloc, unsigned& nx) {
    const unsigned G = gridDim.x * gridDim.y * gridDim.z;
    unsigned sum, cnt, mine, sp = 0u;
    for (;;) {
        sum = 0u; cnt = 0u; mine = 0u;
#pragma unroll
        for (unsigned j = 0; j < 16; ++j) { const unsigned c = xb_ld(&bar[XB_XCNT(j)]); sum += c; cnt += (c > 0u) ? 1u : 0u; mine = (j == x) ? c : mine; }
        if (sum == G) break;
        __builtin_amdgcn_s_sleep(1);
        if ((++sp & 255u) == 0u) { if (xb_ld(&bar[XB_TMO])) break; if (sp > XB_SPIN_CAP) { atomicAdd(&bar[XB_TMO], 1u); break; } }
    }
    nloc = mine > 0u ? mine : 1u; nx = cnt > 0u ? cnt : 1u;
}
__device__ __forceinline__ void xcd_barrier(const XcdBarrier& b) {
    asm volatile("s_waitcnt vmcnt(0)" ::: "memory");
    __syncthreads();
    if (threadIdx.x == 0) {
        unsigned* bar = b.bar;
        __builtin_amdgcn_s_waitcnt(0);
        unsigned nloc = b.st[0], nx = b.st[1];
        if (nloc == 0u) { xcd_barrier_complete(bar, b.x, nloc, nx); b.st[0] = nloc; b.st[1] = nx; }
        const unsigned old = xb_add(&bar[XB_XSUB(b.x)], 1u);
        const unsigned gen = old / nloc;
        if (old + 1u == (gen + 1u) * nloc) {
            __builtin_amdgcn_fence(__ATOMIC_RELEASE, "agent");
            asm volatile("s_waitcnt vmcnt(0)" ::: "memory");
            const unsigned og = xb_add(&bar[XB_TOP], 1u);
            const unsigned tg = og / nx;
            if (og + 1u == (tg + 1u) * nx) xb_add(&bar[XB_TOPGEN], 1u);
            else XB_SPIN(xb_ld(&bar[XB_TOPGEN]) == tg, bar);
            __builtin_amdgcn_fence(__ATOMIC_ACQUIRE, "agent");
            xb_add(&bar[XB_XGEN(b.x)], 1u);
            asm volatile("s_waitcnt vmcnt(0)" ::: "memory");
        } else {
            XB_SPIN(xb_ld(&bar[XB_XGEN(b.x)]) == gen, bar);
            __builtin_amdgcn_fence(__ATOMIC_ACQUIRE, "agent");
            asm volatile("s_waitcnt vmcnt(0)" ::: "memory");
        }
    }
    __syncthreads();
}

struct Frame {
    LAS unsigned char* lds;
    volatile LAS unsigned* MISC;
    gu32* ctl;
    int tid, wave;
    int vcu, G;
    unsigned char* ws;
    const float* in[22];
    float* out;
};
#define WSP(T_, off) ((T_*)(F.ws + (off)))
__device__ __forceinline__ int lane_of(const Frame& F) { int t = F.tid; asm volatile("" : "+v"(t)); return t & 63; }

constexpr int CV_INA = 0, CV_MEM = CV_INA + 32 * 72, CV_CMP = CV_MEM + 2 * 32 * 16, CV_OUT = CV_CMP + 2 * 64 * 2, CV_FGU = CV_OUT + 2 * 32 * 32, CV_FDN = CV_FGU + 32 * 224,
              CV_INB = CV_FDN + 112 * 32, CV_KVB = CV_INB + 32 * 32, CV_MGU = CV_KVB + 32 * 48, CV_MDN = CV_MGU + 8 * 32 * 224, CV_TOTAL = CV_MDN + 8 * 112 * 32;
struct ConvIt { const float* src; bf16* dst; const float* gain; int K, Nsrc, sc0, n0, k0, nvalid; };
__device__ __forceinline__ void conv_decode(Frame& F, int g, ConvIt& c) {
    int loc, nnb, mode = 0, batch = 0; c.gain = nullptr;
    if (g < CV_MEM) { loc = g - CV_INA; c.src = F.in[5]; c.dst = WSP(bf16, WS_WT_INA); c.gain = F.in[2]; c.K = DM; c.Nsrc = A_IN_W; nnb = NA / 64; mode = 2; }
    else if (g < CV_CMP) { loc = g - CV_MEM; batch = loc / (32 * 16); loc -= batch * 32 * 16; c.src = F.in[13] + (size_t)batch * DM * 1024; c.dst = WSP(bf16, WS_WT_MEM) + (size_t)batch * 1024 * DM; c.gain = F.in[3] + batch * DM; c.K = DM; c.Nsrc = 1024; nnb = 16; }
    else if (g < CV_OUT) { loc = g - CV_CMP; batch = loc / 128; loc -= batch * 128; c.src = F.in[6] + (size_t)batch * 4096 * HD; c.dst = WSP(bf16, WS_WT_CMP) + (size_t)batch * HD * 4096; c.K = 4096; c.Nsrc = HD; nnb = 2; }
    else if (g < CV_FGU) { loc = g - CV_OUT; batch = loc / 1024; loc -= batch * 1024; c.src = F.in[15] + (size_t)batch * DM * DM; c.dst = WSP(bf16, WS_WT_OUT) + (size_t)batch * DM * DM; c.K = DM; c.Nsrc = DM; nnb = 32; }
    else if (g < CV_FDN) { loc = g - CV_FGU; c.src = F.in[16]; c.dst = WSP(bf16, WS_WT_FGU); c.gain = F.in[4]; c.K = DM; c.Nsrc = 2 * FF; nnb = 224; mode = 1; }
    else if (g < CV_INB) { loc = g - CV_FDN; c.src = F.in[17]; c.dst = WSP(bf16, WS_WT_FDN); c.K = FF; c.Nsrc = DM; nnb = 32; }
    else if (g < CV_KVB) { loc = g - CV_INB; c.src = F.in[10]; c.dst = WSP(bf16, WS_WT_INB); c.gain = F.in[2] + DM; c.K = DM; c.Nsrc = DM; nnb = 32; }
    else if (g < CV_MGU) { loc = g - CV_KVB; c.src = F.in[12]; c.dst = WSP(bf16, WS_WT_INB) + (size_t)2048 * DM; c.gain = F.in[11]; c.K = DM; c.Nsrc = 3072; nnb = 48; }
    else if (g < CV_MDN) { loc = g - CV_MGU; batch = loc / 7168; loc -= batch * 7168; c.src = F.in[20] + (size_t)batch * DM * 2 * FF; c.dst = WSP(bf16, WS_WT_MGU) + (size_t)batch * 2 * FF * DM; c.gain = F.in[4] + DM; c.K = DM; c.Nsrc = 2 * FF; nnb = 224; mode = 1; }
    else { loc = g - CV_MDN; batch = loc / 3584; loc -= batch * 3584; c.src = F.in[21] + (size_t)batch * FF * DM; c.dst = WSP(bf16, WS_WT_MDN) + (size_t)batch * DM * FF; c.K = FF; c.Nsrc = DM; nnb = 32; }
    const int kb = loc / nnb, nb = loc - kb * nnb;
    c.k0 = kb * 64; c.n0 = nb * 64; c.nvalid = nnb * 64;
    if (mode == 1) { const int j = c.n0 >> 8, r = c.n0 & 255; c.sc0 = (r < 128) ? 128 * j + r : 7168 + 128 * j + (r - 128); }
    else if (mode == 2) { if (c.n0 < 3840) c.sc0 = c.n0; else if (c.n0 < 4352) c.sc0 = c.n0 + 36; else if (c.n0 < 4416) { c.sc0 = c.n0 - 512; c.nvalid = 4388; } else { c.sc0 = 0; c.nvalid = 0; } }
    else c.sc0 = c.n0;
}
struct ConvRegs { f32x4 v[16]; float gn[8]; };
__device__ __forceinline__ void conv_load(const ConvIt& c, ConvRegs& R, int lane) {
    const int kr = lane >> 4, nc = (lane & 15) * 4;
    const bool ok = (c.n0 + nc) < c.nvalid;
    const int cc = ok ? c.sc0 + nc : 0;
    const float* p = c.src + (size_t)(c.k0 + kr) * c.Nsrc + cc;
#pragma unroll
    for (int i = 0; i < 16; ++i) { const f32x4 t = __builtin_nontemporal_load((const f32x4*)(p + (size_t)(4 * i) * c.Nsrc)); R.v[i] = ok ? t : (f32x4){0.f, 0.f, 0.f, 0.f}; }
    const int c8 = lane & 7;
#pragma unroll
    for (int i = 0; i < 8; ++i) R.gn[i] = c.gain ? c.gain[c.k0 + 8 * c8 + i] : 1.0f;
}
__device__ __forceinline__ void conv_proc(const ConvIt& c, const ConvRegs& R, LAS float* scr, int lane) {
    const int kr = lane >> 4, nc = (lane & 15) * 4;
#pragma unroll
    for (int i = 0; i < 16; ++i) { LAS float* s = scr + (4 * i + kr) * 65 + nc; s[0] = R.v[i][0]; s[1] = R.v[i][1]; s[2] = R.v[i][2]; s[3] = R.v[i][3]; }
    LDS_WAIT(); asm volatile("" ::: "memory");
    const int c8 = lane & 7, nl = lane >> 3;
#pragma unroll
    for (int j = 0; j < 8; ++j) {
        const int n = nl + 8 * j; const LAS float* s = scr + (8 * c8) * 65 + n;
        v4u o; o.x = pk2(s[0 * 65] * R.gn[0], s[1 * 65] * R.gn[1]); o.y = pk2(s[2 * 65] * R.gn[2], s[3 * 65] * R.gn[3]); o.z = pk2(s[4 * 65] * R.gn[4], s[5 * 65] * R.gn[5]); o.w = pk2(s[6 * 65] * R.gn[6], s[7 * 65] * R.gn[7]);
        *(v4u*)(c.dst + (size_t)(c.n0 + n) * c.K + c.k0 + 8 * c8) = o;
    }
    LDS_WAIT(); asm volatile("" ::: "memory");
}
__device__ __forceinline__ void conv_range(Frame& F, int g_lo, int g_hi) {
    LAS float* scr = (LAS float*)(F.lds + RING_OFF + F.wave * 16640);
    const int gw = F.vcu * NWAVES + F.wave, NGW = F.G * NWAVES;
    int g = g_lo + gw;
    if (g >= g_hi) return;
    ConvIt cA, cB; ConvRegs RA, RB;
    conv_decode(F, g, cA); conv_load(cA, RA, lane_of(F));
    for (;;) {
        const int g1 = g + NGW; const bool h1 = g1 < g_hi;
        if (h1) { conv_decode(F, g1, cB); conv_load(cB, RB, lane_of(F)); }
        asm volatile("" ::: "memory");
        conv_proc(cA, RA, scr, lane_of(F));
        if (!h1) break;
        const int g2 = g1 + NGW; const bool h2 = g2 < g_hi;
        if (h2) { conv_decode(F, g2, cA); conv_load(cA, RA, lane_of(F)); }
        asm volatile("" ::: "memory");
        conv_proc(cB, RB, scr, lane_of(F));
        if (!h2) break;
        g = g2;
    }
}
__device__ __forceinline__ float row_rstd_to_bf16(const float* xrow, bf16* orow, int lane) {
    const f32x4* xr = (const f32x4*)xrow + lane;
    f32x4 v[8]; float s = 0.f;
#pragma unroll
    for (int j = 0; j < 8; ++j) { v[j] = xr[64 * j]; s += (v[j].x * v[j].x + v[j].y * v[j].y) + (v[j].z * v[j].z + v[j].w * v[j].w); }
    const float rstd = 1.0f / sqrtf(wave_sum(s) * (1.f / DM) + EPS);
    v2u* o8 = (v2u*)orow + lane;
#pragma unroll
    for (int j = 0; j < 8; ++j) { v2u w; w.x = pk2(v[j].x * rstd, v[j].y * rstd); w.y = pk2(v[j].z * rstd, v[j].w * rstd); o8[64 * j] = w; }
    return rstd;
}
__device__ __forceinline__ void rmsnorm_rows(Frame& F, const float* X, bf16* XN, int rows) {
    const int gw = F.vcu * NWAVES + F.wave, NGW = F.G * NWAVES;
    for (int m = gw; m < rows; m += NGW) row_rstd_to_bf16(X + (size_t)m * DM, XN + (size_t)m * DM, lane_of(F));
}
__device__ __forceinline__ void p0_prologue(Frame& F) {
    conv_range(F, 0, CV_TOTAL);
    rmsnorm_rows(F, F.in[0], WSP(bf16, WS_XN), T);
    rmsnorm_rows(F, F.in[1], WSP(bf16, WS_MEMN), MEMT);
}

__device__ __forceinline__ void p2_compress(Frame& F) {
    typedef short bf16x8 __attribute__((ext_vector_type(8)));
    const bf16* PA = WSP(bf16, WS_PA); const bf16* WC = WSP(bf16, WS_WT_CMP);
    LAS float* red = (LAS float*)(F.lds + RING_OFF);
    LAS float* posl = red + 16 * 132;
    const int lane = lane_of(F), w = F.wave, fr = lane & 15, fq = lane >> 4;
    for (int i = F.tid; i < 2 * 4096 / 4; i += NWAVES * 64) *(LAS f32x4*)(posl + 4 * i) = *(const f32x4*)(F.in[7] + 4 * i);
    __syncthreads();
    const int nitems = 2 * NG * 32;
    for (int it = F.vcu; it < nitems; it += F.G) {
        const int kv = it / (NG * 32), g = (it / 32) % NG, jt = it % 32;
        const int j = 16 * jt + fr;
        const LAS float* pos = posl + kv * 4096;
        const int col = (kv ? CA_VC : CA_KC) + g * HD;
        const bf16* wrow = WC + ((size_t)kv * HD + 16 * w + fr) * 4096;
        f32x4 acc = {0.f, 0.f, 0.f, 0.f};
        for (int ks0 = 0; ks0 < 128; ks0 += 16) {
            v4u xa[16], wb[16];
#pragma unroll
            for (int u = 0; u < 16; ++u) {
                const int k = 32 * (ks0 + u) + 8 * fq, i = k >> 7, d = k & 127;
                int trow = 16 * j + i; trow = trow < T ? trow : T - 1;
                xa[u] = *(const v4u*)(PA + (size_t)trow * NA + col + d);
                wb[u] = *(const v4u*)(wrow + k);
            }
            asm volatile("" ::: "memory");
#pragma unroll
            for (int u = 0; u < 16; ++u) {
                const int k = 32 * (ks0 + u) + 8 * fq;
                const f32x4 pa = *(const LAS f32x4*)(pos + k), pb = *(const LAS f32x4*)(pos + k + 4);
                float xf[8]; unpack8(xa[u], xf);
                v4u av; av.x = pk2(xf[0] + pa[0], xf[1] + pa[1]); av.y = pk2(xf[2] + pa[2], xf[3] + pa[3]); av.z = pk2(xf[4] + pb[0], xf[5] + pb[1]); av.w = pk2(xf[6] + pb[2], xf[7] + pb[3]);
                acc = __builtin_amdgcn_mfma_f32_16x16x32_bf16(*reinterpret_cast<const bf16x8*>(&av), *reinterpret_cast<const bf16x8*>(&wb[u]), acc, 0, 0, 0);
            }
        }
#pragma unroll
        for (int r = 0; r < 4; ++r) red[(4 * fq + r) * 132 + 16 * w + fr] = acc[r];
        __syncthreads();
        {
            const int row = F.tid >> 5, cp = F.tid & 31, jj = 16 * jt + row;
            float v[4]; float ss = 0.f;
#pragma unroll
            for (int e = 0; e < 4; ++e) { v[e] = red[row * 132 + 4 * cp + e]; ss += v[e] * v[e]; }
            ss += __shfl_xor(ss, 1); ss += __shfl_xor(ss, 2); ss += __shfl_xor(ss, 4); ss += __shfl_xor(ss, 8); ss += __shfl_xor(ss, 16);
            if (kv == 0) { const float rs = 1.0f / sqrtf(ss * (1.f / HD) + EPS); const float* gp = F.in[9] + 4 * cp;
#pragma unroll
                for (int e = 0; e < 4; ++e) v[e] = v[e] * rs * gp[e]; }
            if (jj >= NCMP) {
#pragma unroll
                for (int e = 0; e < 4; ++e) v[e] = 0.f; }
            v2u o; o.x = pk2(v[0], v[1]); o.y = pk2(v[2], v[3]);
            *(v2u*)(WSP(bf16, WS_KCMP) + (size_t)kv * NG * NCMP_P * HD + ((size_t)g * NCMP_P + jj) * HD + 4 * cp) = o;
        }
        __syncthreads();
    }
}
__device__ __forceinline__ void norm_slot(bf16* p, const float* gain, int l16) {
    v4u w = *(const v4u*)(p + l16 * 8); float f[8]; unpack8(w, f);
    float s = 0.f;
#pragma unroll
    for (int e = 0; e < 8; ++e) s += f[e] * f[e];
    s += __shfl_xor(s, 1); s += __shfl_xor(s, 2); s += __shfl_xor(s, 4); s += __shfl_xor(s, 8);
    const float r = 1.0f / sqrtf(s * (1.f / HD) + EPS);
    const float* gp = gain + l16 * 8;
    v4u o; o.x = pk2(f[0] * r * gp[0], f[1] * r * gp[1]); o.y = pk2(f[2] * r * gp[2], f[3] * r * gp[3]); o.z = pk2(f[4] * r * gp[4], f[5] * r * gp[5]); o.w = pk2(f[6] * r * gp[6], f[7] * r * gp[7]);
    *(v4u*)(p + l16 * 8) = o;
}
__device__ __forceinline__ void norm_vals(v4u w, bf16* p, const float* gain, int l16) {
    float f[8]; unpack8(w, f);
    float s = 0.f;
#pragma unroll
    for (int e = 0; e < 8; ++e) s += f[e] * f[e];
    s += __shfl_xor(s, 1); s += __shfl_xor(s, 2); s += __shfl_xor(s, 4); s += __shfl_xor(s, 8);
    const float r = 1.0f / sqrtf(s * (1.f / HD) + EPS);
    const float* gp = gain + l16 * 8;
    v4u o; o.x = pk2(f[0] * r * gp[0], f[1] * r * gp[1]); o.y = pk2(f[2] * r * gp[2], f[3] * r * gp[3]); o.z = pk2(f[4] * r * gp[4], f[5] * r * gp[5]); o.w = pk2(f[6] * r * gp[6], f[7] * r * gp[7]);
    *(v4u*)(p + l16 * 8) = o;
}
__device__ __forceinline__ void p2_qknorm(Frame& F) {
    bf16* PA = WSP(bf16, WS_PA); bf16* MKV = WSP(bf16, WS_MKV);
    const int gs = (F.vcu * NWAVES + F.wave) * 4 + (lane_of(F) >> 4), NS = F.G * NWAVES * 4, l16 = lane_of(F) & 15;
    for (int s0 = gs; s0 < T * 18; s0 += 6 * NS) {
        bf16* ptr[6]; const float* gn[6]; v4u w[6];
#pragma unroll
        for (int u = 0; u < 6; ++u) {
            int s = s0 + u * NS; s = s < T * 18 ? s : gs;
            const int t = s / 18, k = s % 18;
            int col; const float* gain;
            if (k < 12) { col = CA_Q + k * HD; gain = F.in[8]; }
            else if (k < 15) { col = CA_KS + (k - 12) * HD; gain = F.in[9] + HD; }
            else { col = CA_KW + (k - 15) * HD; gain = F.in[9] + 2 * HD; }
            ptr[u] = PA + (size_t)t * NA + col; gn[u] = gain; w[u] = *(const v4u*)(ptr[u] + l16 * 8);
        }
        asm volatile("" ::: "memory");
#pragma unroll
        for (int u = 0; u < 6; ++u) if (s0 + u * NS < T * 18) norm_vals(w[u], ptr[u], gn[u], l16);
    }
    for (int s = gs; s < MEMT * 8; s += NS) {
        const int m = s / 8, k = s % 8, l = k >> 2, h = k & 3;
        norm_slot(MKV + (size_t)m * 2048 + l * 1024 + h * HD, F.in[14] + (size_t)(l * 2 + 1) * HD, l16);
    }
}

__device__ __forceinline__ void ld32(const bf16* p, float* f) {
#pragma unroll
    for (int i = 0; i < 4; ++i) { const v4u w = *(const v4u*)(p + 8 * i); unpack8(w, f + 8 * i); }
}
__device__ __forceinline__ float dot32q(const float* q, const bf16* kp) {
    float kf[32]; ld32(kp, kf); float s = 0.f;
#pragma unroll
    for (int i = 0; i < 32; ++i) s += q[i] * kf[i];
    s += __shfl_xor(s, 1); s += __shfl_xor(s, 2);
    return s;
}
__device__ __forceinline__ void axpy32(float* o, float p, const bf16* vp) {
    float vf[32]; ld32(vp, vf);
#pragma unroll
    for (int i = 0; i < 32; ++i) o[i] += p * vf[i];
}
__device__ __forceinline__ void st32(bf16* p, const float* f) {
#pragma unroll
    for (int i = 0; i < 4; ++i) { v4u w; w.x = pk2(f[8 * i], f[8 * i + 1]); w.y = pk2(f[8 * i + 2], f[8 * i + 3]); w.z = pk2(f[8 * i + 4], f[8 * i + 5]); w.w = pk2(f[8 * i + 6], f[8 * i + 7]); *(v4u*)(p + 8 * i) = w; }
}
#define OSM_STEP(s_, valid_, vptr_) do { if (valid_) { const float mn_ = fmaxf(m, (s_)); const float al_ = fast_exp(m - mn_); const float pp_ = fast_exp((s_) - mn_); \
        l = l * al_ + pp_; _Pragma("unroll") for (int i_ = 0; i_ < 32; ++i_) o[i_] *= al_; axpy32(o, pp_, (vptr_)); m = mn_; } } while (0)

__device__ __forceinline__ void p3_nsa_naive(Frame& F) {
    const bf16* PA = WSP(bf16, WS_PA); const bf16* KC = WSP(bf16, WS_KCMP); const bf16* VC = KC + (size_t)NG * NCMP_P * HD; bf16* MIX = WSP(bf16, WS_MIX);
    LAS float* IMP = (LAS float*)(F.lds + RING_OFF + F.wave * 4096);
    LAS unsigned long long* SELW = (LAS unsigned long long*)(F.lds + RING_OFF + F.wave * 4096 + 2048);
    const int gw = F.vcu * NWAVES + F.wave, NGW = F.G * NWAVES;
    const int dq = lane_of(F) & 3, p = (lane_of(F) >> 2) & 3, ql = lane_of(F) >> 4;
    for (int it = gw; it < NG * (T / 4); it += NGW) {
        const int g = it / (T / 4), tq = it % (T / 4), t = 4 * tq + ql, head = g * 4 + p;
        const float slope = exp2f(-8.0f * (float)(head + 1) / 12.0f);
        float q[32]; ld32(PA + (size_t)t * NA + CA_Q + head * HD + dq * 32, q);
#pragma unroll
        for (int i = 0; i < 32; ++i) q[i] *= QSCALE;
        const float g0 = 1.0f / (1.0f + fast_exp(-bf2f(PA[(size_t)t * NA + CA_GT + head * 3 + 0])));
        const float g1 = 1.0f / (1.0f + fast_exp(-bf2f(PA[(size_t)t * NA + CA_GT + head * 3 + 1])));
        const float g2 = 1.0f / (1.0f + fast_exp(-bf2f(PA[(size_t)t * NA + CA_GT + head * 3 + 2])));
        float otot[32];
#pragma unroll
        for (int i = 0; i < 32; ++i) otot[i] = 0.f;
        for (int i = lane_of(F); i < 512; i += 64) IMP[i] = 0.f;
        LDS_WAIT(); asm volatile("" ::: "memory");
        const int jmax = (t >= 31) ? (t - 31) / 16 : -1;
        const int jmax_w = (4 * tq + 3 >= 31) ? (4 * tq + 3 - 31) / 16 : -1;
        const bf16* kcg = KC + (size_t)g * NCMP_P * HD + dq * 32; const bf16* vcg = VC + (size_t)g * NCMP_P * HD + dq * 32;
        {
            float m = -1e30f, l = 0.f;
            for (int j = 0; j <= jmax_w; ++j) {
                const float s = dot32q(q, kcg + (size_t)j * HD) - slope * (float)(t - (16 * j + 31));
                if (j <= jmax) { const float mn = fmaxf(m, s); l = l * fast_exp(m - mn) + fast_exp(s - mn); m = mn; }
            }
            const float rl = (l > 0.f) ? 1.0f / l : 0.f;
            float o[32];
#pragma unroll
            for (int i = 0; i < 32; ++i) o[i] = 0.f;
            for (int j = 0; j <= jmax_w; ++j) {
                const float s = dot32q(q, kcg + (size_t)j * HD) - slope * (float)(t - (16 * j + 31));
                const float pj = (j <= jmax) ? fast_exp(s - m) * rl : 0.f;
                axpy32(o, pj, vcg + (size_t)j * HD);
                float ps = pj; ps += __shfl_xor(ps, 4); ps += __shfl_xor(ps, 8);
                if (dq == 0 && p == 0) { IMP[ql * 128 + (j >> 2)] += ps; if ((j & 3) == 3 && (j >> 2) + 1 < 128) IMP[ql * 128 + (j >> 2) + 1] += ps; }
            }
#pragma unroll
            for (int i = 0; i < 32; ++i) otot[i] += g0 * o[i];
        }
        LDS_WAIT(); asm volatile("" ::: "memory");
        for (int qq = 0; qq < 4; ++qq) {
            const int tt = 4 * tq + qq, cur = tt >> 6;
            const int b0 = lane_of(F), b1 = lane_of(F) + 64;
            const float s0 = (b0 == cur) ? 2e6f : (b0 == 0 ? 1e6f : (b0 * 64 <= tt ? IMP[qq * 128 + b0] : -1e6f));
            const float s1 = (b1 == cur) ? 2e6f : (b1 * 64 <= tt ? IMP[qq * 128 + b1] : -1e6f);
            int r0 = 0, r1 = 0;
            for (int b = 0; b < 128; ++b) {
                const float sb = (b == cur) ? 2e6f : (b == 0 ? 1e6f : (b * 64 <= tt ? IMP[qq * 128 + b] : -1e6f));
                r0 += (sb > s0 || (sb == s0 && b < b0)) ? 1 : 0;
                r1 += (sb > s1 || (sb == s1 && b < b1)) ? 1 : 0;
            }
            const unsigned long long m0 = __ballot(r0 < 16 && b0 * 64 <= tt), m1 = __ballot(r1 < 16 && b1 * 64 <= tt);
            if (lane_of(F) == 0) { SELW[qq * 2] = m0; SELW[qq * 2 + 1] = m1; }
        }
        LDS_WAIT(); asm volatile("" ::: "memory");
        {
            const unsigned long long my0 = SELW[ql * 2], my1 = SELW[ql * 2 + 1];
            const unsigned long long u0v = SELW[0] | SELW[2] | SELW[4] | SELW[6], u1v = SELW[1] | SELW[3] | SELW[5] | SELW[7];
            const unsigned long long u0 = ((unsigned long long)(unsigned)__builtin_amdgcn_readfirstlane((int)(u0v >> 32)) << 32) | (unsigned)__builtin_amdgcn_readfirstlane((int)(unsigned)u0v);
            const unsigned long long u1 = ((unsigned long long)(unsigned)__builtin_amdgcn_readfirstlane((int)(u1v >> 32)) << 32) | (unsigned)__builtin_amdgcn_readfirstlane((int)(unsigned)u1v);
            float m = -1e30f, l = 0.f, o[32];
#pragma unroll
            for (int i = 0; i < 32; ++i) o[i] = 0.f;
            const bf16* kg = PA + CA_KS + g * HD + dq * 32; const bf16* vg = PA + CA_VS + g * HD + dq * 32;
            for (int b = 0; b < 128; ++b) {
                const bool inu = (b < 64) ? ((u0 >> b) & 1ull) : ((u1 >> (b - 64)) & 1ull);
                if (!inu) continue;
                const bool mine = (b < 64) ? ((my0 >> b) & 1ull) : ((my1 >> (b - 64)) & 1ull);
                for (int k = 0; k < 64; ++k) {
                    const int kp = b * 64 + k;
                    const float s = dot32q(q, kg + (size_t)kp * NA) - slope * (float)(t - kp);
                    const bool valid = mine && kp <= t;
                    OSM_STEP(s, valid, vg + (size_t)kp * NA);
                }
            }
            const float sc = (l > 0.f) ? g1 / l : 0.f;
#pragma unroll
            for (int i = 0; i < 32; ++i) otot[i] += sc * o[i];
        }
        {
            float m = -1e30f, l = 0.f, o[32];
#pragma unroll
            for (int i = 0; i < 32; ++i) o[i] = 0.f;
            const bf16* kg = PA + CA_KW + g * HD + dq * 32; const bf16* vg = PA + CA_VW + g * HD + dq * 32;
            const int klo = (4 * tq - 511 > 0) ? 4 * tq - 511 : 0, khi = 4 * tq + 3;
            for (int kp = klo; kp <= khi; ++kp) {
                const float s = dot32q(q, kg + (size_t)kp * NA) - slope * (float)(t - kp);
                const bool valid = kp <= t && (t - kp) < 512;
                OSM_STEP(s, valid, vg + (size_t)kp * NA);
            }
            const float sc = (l > 0.f) ? g2 / l : 0.f;
#pragma unroll
            for (int i = 0; i < 32; ++i) otot[i] += sc * o[i];
        }
        st32(MIX + (size_t)t * DM + head * HD + dq * 32, otot);
    }
}
__device__ __forceinline__ void mem_attn_naive(Frame& F, const bf16* P, int ldp, int qcol, const float* qg, int layer) {
    const bf16* MKV = WSP(bf16, WS_MKV); bf16* MIX = WSP(bf16, WS_MIX);
    const int gw = F.vcu * NWAVES + F.wave, NGW = F.G * NWAVES;
    const int dq = lane_of(F) & 3, r = lane_of(F) >> 2;
    for (int it = gw; it < NMEMH * (T / 16); it += NGW) {
        const int hm = it / (T / 16), t = 16 * (it % (T / 16)) + r;
        float q[32]; ld32(P + (size_t)t * ldp + qcol + hm * HD + dq * 32, q);
        float ss = 0.f;
#pragma unroll
        for (int i = 0; i < 32; ++i) ss += q[i] * q[i];
        ss += __shfl_xor(ss, 1); ss += __shfl_xor(ss, 2);
        const float rs = (1.0f / sqrtf(ss * (1.f / HD) + EPS)) * QSCALE;
#pragma unroll
        for (int i = 0; i < 32; ++i) q[i] = q[i] * rs * qg[dq * 32 + i];
        float m = -1e30f, l = 0.f, o[32];
#pragma unroll
        for (int i = 0; i < 32; ++i) o[i] = 0.f;
        const bf16* kg = MKV + layer * 1024 + hm * HD + dq * 32; const bf16* vg = kg + 512;
        for (int k = 0; k < MEMT; ++k) {
            const float s = dot32q(q, kg + (size_t)k * 2048);
            OSM_STEP(s, true, vg + (size_t)k * 2048);
        }
        const float sc = 1.0f / l;
#pragma unroll
        for (int i = 0; i < 32; ++i) o[i] *= sc;
        st32(MIX + (size_t)t * DM + NMIX * HD + hm * HD + dq * 32, o);
    }
}
__device__ __forceinline__ void stick_naive(Frame& F) {
    const bf16* PB = WSP(bf16, WS_PB); bf16* MIX = WSP(bf16, WS_MIX);
    const int gw = F.vcu * NWAVES + F.wave, NGW = F.G * NWAVES;
    const int dq = lane_of(F) & 3, r = lane_of(F) >> 2;
    for (int it = gw; it < NMIX * (T / 16); it += NGW) {
        const int h = it / (T / 16), t = 16 * (it % (T / 16)) + r;
        float q[32]; ld32(PB + (size_t)t * NB + CB_Q + h * HD + dq * 32, q);
#pragma unroll
        for (int i = 0; i < 32; ++i) q[i] *= QSCALE;
        float R = 0.f, o[32];
#pragma unroll
        for (int i = 0; i < 32; ++i) o[i] = 0.f;
        const bf16* kg = PB + CB_K + h * HD + dq * 32; const bf16* vg = PB + CB_V + h * HD + dq * 32;
        for (int i = 1; ; ++i) {
            const int s = t - i;
            const bool act = s >= 0 && R > -80.f;
            if (!__any(act)) break;
            const int sc = s >= 0 ? s : 0;
            const float z = dot32q(q, kg + (size_t)sc * NB);
            const float sp = fmaxf(z, 0.f) + __logf(1.0f + fast_exp(-fabsf(z)));
            if (act) { const float a = fast_exp(z - sp + R); axpy32(o, a, vg + (size_t)sc * NB); R -= sp; }
        }
        st32(MIX + (size_t)t * DM + h * HD + dq * 32, o);
    }
}

__device__ __forceinline__ void p12_router(Frame& F) {
    const float* X3 = WSP(float, WS_X3); bf16* XN = WSP(bf16, WS_XN);
    int* TOPI = (int*)(F.ws + WS_ROUTE + RT_TOPI); float* TOPW = (float*)(F.ws + WS_ROUTE + RT_TOPW); int* HIST = (int*)(F.ws + WS_ROUTE + RT_HIST);
    const float* rw = F.in[18]; const float* rb = F.in[19]; const float* gn = F.in[4] + DM;
    LAS int* hist = (LAS int*)(F.lds + RING_OFF);
    for (int c = F.vcu; c < 256; c += F.G) {
        if (F.tid < 8) hist[F.tid] = 0;
        __syncthreads();
        for (int i = 0; i < 4; ++i) {
            const int t = 32 * c + 4 * F.wave + i;
            const f32x4* xr = (const f32x4*)(X3 + (size_t)t * DM) + lane_of(F);
            f32x4 v[8]; float s = 0.f;
#pragma unroll
            for (int j = 0; j < 8; ++j) { v[j] = xr[64 * j]; s += (v[j].x * v[j].x + v[j].y * v[j].y) + (v[j].z * v[j].z + v[j].w * v[j].w); }
            const float rstd = 1.0f / sqrtf(wave_sum(s) * (1.f / DM) + EPS);
            v2u* o8 = (v2u*)(XN + (size_t)t * DM) + lane_of(F);
            float lg[8];
#pragma unroll
            for (int e = 0; e < 8; ++e) lg[e] = 0.f;
#pragma unroll
            for (int j = 0; j < 8; ++j) {
                v2u w; w.x = pk2(v[j].x * rstd, v[j].y * rstd); w.y = pk2(v[j].z * rstd, v[j].w * rstd); o8[64 * j] = w;
                const int k0 = 4 * (lane_of(F) + 64 * j);
#pragma unroll
                for (int e4 = 0; e4 < 4; ++e4) {
                    const float xg = v[j][e4] * gn[k0 + e4];
                    const f32x4 ra = *(const f32x4*)(rw + (size_t)(k0 + e4) * 8), rb4 = *(const f32x4*)(rw + (size_t)(k0 + e4) * 8 + 4);
                    lg[0] += xg * ra.x; lg[1] += xg * ra.y; lg[2] += xg * ra.z; lg[3] += xg * ra.w; lg[4] += xg * rb4.x; lg[5] += xg * rb4.y; lg[6] += xg * rb4.z; lg[7] += xg * rb4.w;
                }
            }
#pragma unroll
            for (int e = 0; e < 8; ++e) lg[e] = wave_sum(lg[e]) * rstd;
            if (lane_of(F) == 0) {
                int i0 = 0; float b0 = lg[0] + rb[0];
#pragma unroll
                for (int e = 1; e < 8; ++e) { const float b = lg[e] + rb[e]; if (b > b0) { b0 = b; i0 = e; } }
                int i1 = -1; float b1 = -3.0e38f;
#pragma unroll
                for (int e = 0; e < 8; ++e) { const float b = lg[e] + rb[e]; if (e != i0 && b > b1) { b1 = b; i1 = e; } }
                float l0 = 0.f, l1 = 0.f;
#pragma unroll
                for (int e = 0; e < 8; ++e) { l0 = (e == i0) ? lg[e] : l0; l1 = (e == i1) ? lg[e] : l1; }
                const float w0 = 1.0f / (1.0f + expf(l1 - l0));
                TOPI[2 * t] = i0; TOPI[2 * t + 1] = i1; TOPW[2 * t] = w0; TOPW[2 * t + 1] = 1.0f - w0;
                atomicAdd((int*)&hist[i0], 1); atomicAdd((int*)&hist[i1], 1);
            }
        }
        __syncthreads();
        if (F.tid < 8) HIST[c * 8 + F.tid] = hist[F.tid];
        __syncthreads();
    }
}
__device__ __forceinline__ void p13_assign(Frame& F) {
    const bf16* XN = WSP(bf16, WS_XN); bf16* AM = WSP(bf16, WS_AMOE);
    const int* TOPI = (const int*)(F.ws + WS_ROUTE + RT_TOPI); int* ROW = (int*)(F.ws + WS_ROUTE + RT_ROW); const int* HIST = (const int*)(F.ws + WS_ROUTE + RT_HIST);
    int* TILE = (int*)(F.ws + WS_ROUTE + RT_TILE);
    LAS int* sh = (LAS int*)(F.lds + RING_OFF);
    for (int c = F.vcu; c < 256; c += F.G) {
        if (F.tid < 16) sh[16 + F.tid] = 0;
        __syncthreads();
        for (int i = F.tid; i < 2048; i += 512) { const int v = HIST[i], cc = i >> 3, ee = i & 7;
            __hip_atomic_fetch_add(&sh[16 + ee], v, __ATOMIC_RELAXED, __HIP_MEMORY_SCOPE_WORKGROUP);
            if (cc < c) __hip_atomic_fetch_add(&sh[24 + ee], v, __ATOMIC_RELAXED, __HIP_MEMORY_SCOPE_WORKGROUP); }
        __syncthreads();
        if (F.tid < 8) {
            const int e = F.tid; int off = 0;
            for (int ee = 0; ee < 8; ++ee) { if (ee == e) break; off += (sh[16 + ee] + 255) & ~255; }
            sh[e] = off + sh[24 + e];
            if (c == 0 && e == 0) {
                int nt = 0;
                for (int ee = 0; ee < 8; ++ee) { const int n = (sh[16 + ee] + 255) >> 8; for (int i = 0; i < n; ++i) TILE[16 + nt + i] = ee; nt += n; }
                TILE[0] = nt;
            }
        }
        __syncthreads();
        if (F.wave == 0) {
            const int tl = lane_of(F) >> 1, sl = lane_of(F) & 1, t = 32 * c + tl;
            const int e = TOPI[2 * t + sl];
            int row = 0;
            for (int ee = 0; ee < 8; ++ee) {
                const unsigned long long mk = __ballot(e == ee);
                if (e == ee) row = sh[ee] + __popcll(mk & ((1ull << lane_of(F)) - 1ull));
            }
            ROW[2 * t + sl] = row; sh[64 + lane_of(F)] = row;
        }
        __syncthreads();
        for (int i = 0; i < 8; ++i) {
            const int idx = 8 * F.wave + i, t = 32 * c + (idx >> 1), row = sh[64 + idx];
            const v4u* src = (const v4u*)(XN + (size_t)t * DM); v4u* dst = (v4u*)(AM + (size_t)row * DM);
#pragma unroll
            for (int j = 0; j < 4; ++j) dst[lane_of(F) + 64 * j] = src[lane_of(F) + 64 * j];
        }
        __syncthreads();
    }
}
__device__ __forceinline__ void p16_combine(Frame& F) {
    const float* X3 = WSP(float, WS_X3); const bf16* Y = WSP(bf16, WS_YMOE);
    const int* ROW = (const int*)(F.ws + WS_ROUTE + RT_ROW); const float* TOPW = (const float*)(F.ws + WS_ROUTE + RT_TOPW);
    const int gw = F.vcu * NWAVES + F.wave, NGW = F.G * NWAVES;
    for (int t = gw; t < T; t += NGW) {
        const int r0 = ROW[2 * t], r1 = ROW[2 * t + 1]; const float w0 = TOPW[2 * t], w1 = TOPW[2 * t + 1];
        const v4u* y0 = (const v4u*)(Y + (size_t)r0 * DM); const v4u* y1 = (const v4u*)(Y + (size_t)r1 * DM);
        const f32x4* xr = (const f32x4*)(X3 + (size_t)t * DM); f32x4* orow = (f32x4*)(F.out + (size_t)t * DM);
#pragma unroll
        for (int j = 0; j < 4; ++j) {
            const int c8 = lane_of(F) + 64 * j;
            float a[8], b[8]; unpack8(y0[c8], a); unpack8(y1[c8], b);
            const f32x4 xa = xr[2 * c8], xb = xr[2 * c8 + 1];
            orow[2 * c8] = (f32x4){xa.x + w0 * a[0] + w1 * b[0], xa.y + w0 * a[1] + w1 * b[1], xa.z + w0 * a[2] + w1 * b[2], xa.w + w0 * a[3] + w1 * b[3]};
            orow[2 * c8 + 1] = (f32x4){xb.x + w0 * a[4] + w1 * b[4], xb.y + w0 * a[5] + w1 * b[5], xb.z + w0 * a[6] + w1 * b[6], xb.w + w0 * a[7] + w1 * b[7]};
        }
    }
}

namespace at {
typedef short bf16x8 __attribute__((ext_vector_type(8)));
typedef short s16x4 __attribute__((ext_vector_type(4)));
typedef float f32x16 __attribute__((ext_vector_type(16)));
constexpr int SHM_T = 16384;
constexpr int L_V = 0, L_K = 2 * SHM_T, L_WS = 4 * SHM_T, L_IMP = L_WS + 8 * 256, L_SEL = L_IMP + 64 * 128 * 4, L_PS = L_SEL + 1024, L_WU = L_PS + 8 * 2176, L_LIST = L_WU + 128, L_DONE = L_LIST + 512, L_END = L_DONE + 64;
static_assert(L_END <= RING_BYTES, "attention LDS map");
constexpr float C2 = 0.08838834764831845f * 1.4426950408889634f;
constexpr float LOG2E = 1.4426950408889634f;

#define KSWZ(row, colB) ((row) * 256 + ((colB) ^ (((row) & 7) << 4)))
#define SBAR() __builtin_amdgcn_sched_barrier(0)
__device__ __forceinline__ int v_st(int k, int c) { const int kk = (k & ~0xC) | ((k & 4) << 1) | ((k & 8) >> 1); return ((kk >> 3) * 4 + (c >> 5)) * 512 + ((kk & 7) * 32 + (c & 31)) * 2; }
__device__ __forceinline__ int v_rd_base(int lane) { return ((lane & 3) << 3) | (((lane >> 2) & 3) << 6) | (((lane >> 4) & 1) << 5) | (((lane >> 5) & 1) << 8); }
constexpr int v_rd_off(int d0, int ks, int half) { return d0 * 512 + ks * 4096 + half * 2048; }
__device__ __forceinline__ int crow(int r, int hi) { return (r & 3) + 8 * (r >> 2) + 4 * hi; }
__device__ __forceinline__ unsigned cvtpk(float lo, float hi) { unsigned r; asm volatile("v_cvt_pk_bf16_f32 %0, %1, %2" : "=v"(r) : "v"(lo), "v"(hi)); return r; }
__device__ __forceinline__ float xhalf_max(float v) { auto rr = __builtin_amdgcn_permlane32_swap(__float_as_uint(v), __float_as_uint(v), false, false); return fmaxf(__uint_as_float(rr[0]), __uint_as_float(rr[1])); }
__device__ __forceinline__ float xhalf_sum(float v) { auto rr = __builtin_amdgcn_permlane32_swap(__float_as_uint(v), __float_as_uint(v), false, false); return __uint_as_float(rr[0]) + __uint_as_float(rr[1]); }
__device__ __forceinline__ float quad_sum(float x) {
    x += __int_as_float(__builtin_amdgcn_update_dpp(0, __float_as_int(x), 0xB1, 0xF, 0xF, true));
    x += __int_as_float(__builtin_amdgcn_update_dpp(0, __float_as_int(x), 0x4E, 0xF, 0xF, true));
    return x;
}
__device__ __forceinline__ void pack_p(const f32x16& p0, const f32x16& p1, bf16x8& pa0, bf16x8& pa1, bf16x8& pa2, bf16x8& pa3) {
#define PK4(P, B_, OUT) do { unsigned a0 = cvtpk(P[B_+0], P[B_+1]), a1 = cvtpk(P[B_+2], P[B_+3]);                          \
        unsigned b0 = cvtpk(P[B_+4], P[B_+5]), b1 = cvtpk(P[B_+6], P[B_+7]);                                             \
        auto r0 = __builtin_amdgcn_permlane32_swap(a0, b0, false, false); auto r1 = __builtin_amdgcn_permlane32_swap(a1, b1, false, false); \
        v4u w = {r0[0], r1[0], r0[1], r1[1]}; OUT = *reinterpret_cast<bf16x8*>(&w); } while (0)
    PK4(p0, 0, pa0); PK4(p0, 8, pa1); PK4(p1, 0, pa2); PK4(p1, 8, pa3);
#undef PK4
}
template <int KB>
__device__ __forceinline__ void qkt(f32x16& p0, f32x16& p1, LAS unsigned char* lds, int r32, int hi, const bf16x8* qr) {
    p0 = f32x16{}; p1 = f32x16{};
    LAS unsigned char* kb[4];
#pragma unroll
    for (int dd = 0; dd < 4; ++dd) kb[dd] = lds + L_K + KB * SHM_T + KSWZ(r32, (dd * 16 + hi * 8) * 2);
#pragma unroll
    for (int d0 = 0; d0 < 8; ++d0) { LAS unsigned char* a = kb[d0 & 3] + (d0 >> 2) * 128;
        const bf16x8 b0 = *(const LAS bf16x8*)a;
        const bf16x8 b1 = *(const LAS bf16x8*)(a + 32 * 256);
        p0 = __builtin_amdgcn_mfma_f32_32x32x16_bf16(b0, qr[d0], p0, 0, 0, 0);
        p1 = __builtin_amdgcn_mfma_f32_32x32x16_bf16(b1, qr[d0], p1, 0, 0, 0); }
}
template <int VB>
__device__ __forceinline__ void pv_tile(f32x16* o, int vb0, bf16x8 pa0, bf16x8 pa1, bf16x8 pa2, bf16x8 pa3) {
#define TRRD(dst, off) asm volatile("ds_read_b64_tr_b16 %0, %1 offset:%2" : "=&v"(dst) : "v"(vb0), "i"(off) : "memory")
#define PV_D0(d0) do { s16x4 l0, l1, l2, l3, h0, h1, h2, h3; constexpr int b_ = VB * SHM_T + v_rd_off(d0, 0, 0); \
        TRRD(l0, b_); TRRD(h0, b_ + 2048); TRRD(l1, b_ + 4096); TRRD(h1, b_ + 6144); TRRD(l2, b_ + 8192); TRRD(h2, b_ + 10240); TRRD(l3, b_ + 12288); TRRD(h3, b_ + 14336); \
        asm volatile("s_waitcnt lgkmcnt(0)" ::: "memory"); SBAR();   \
        o[d0] = __builtin_amdgcn_mfma_f32_32x32x16_bf16(pa0, (bf16x8){l0[0], l0[1], l0[2], l0[3], h0[0], h0[1], h0[2], h0[3]}, o[d0], 0, 0, 0);   \
        o[d0] = __builtin_amdgcn_mfma_f32_32x32x16_bf16(pa1, (bf16x8){l1[0], l1[1], l1[2], l1[3], h1[0], h1[1], h1[2], h1[3]}, o[d0], 0, 0, 0);   \
        o[d0] = __builtin_amdgcn_mfma_f32_32x32x16_bf16(pa2, (bf16x8){l2[0], l2[1], l2[2], l2[3], h2[0], h2[1], h2[2], h2[3]}, o[d0], 0, 0, 0);   \
        o[d0] = __builtin_amdgcn_mfma_f32_32x32x16_bf16(pa3, (bf16x8){l3[0], l3[1], l3[2], l3[3], h3[0], h3[1], h3[2], h3[3]}, o[d0], 0, 0, 0); } while (0)
    PV_D0(0); PV_D0(1); PV_D0(2); PV_D0(3);
#undef PV_D0
#undef TRRD
}
struct Stg { v4u a, b; };
struct Tile { const bf16* K; const bf16* V; size_t ld; };
__device__ __forceinline__ void stg_load(Stg& S, const bf16* base, size_t ld, int sr, int sc) {
    S.a = *(const v4u*)(base + (size_t)sr * ld + sc); S.b = *(const v4u*)(base + (size_t)(32 + sr) * ld + sc);
}
template <int BUF> __device__ __forceinline__ void stg_write_k(const Stg& S, LAS unsigned char* lds, int sr, int sc) {
    const int kws = KSWZ(sr, sc * 2);
    *(LAS v4u*)(lds + L_K + BUF * SHM_T + kws) = S.a; *(LAS v4u*)(lds + L_K + BUF * SHM_T + kws + 32 * 256) = S.b;
}
template <int BUF> __device__ __forceinline__ void stg_write_v(const Stg& S, LAS unsigned char* lds, int sr, int sc) {
    *(LAS v4u*)(lds + L_V + BUF * SHM_T + v_st(sr, sc)) = S.a; *(LAS v4u*)(lds + L_V + BUF * SHM_T + v_st(32 + sr, sc)) = S.b;
}

template <int PASS, int KB, class Br>
__device__ __forceinline__ void step(Br& br, int i, Stg& S, LAS unsigned char* lds, int tid, const bf16x8* qr, float& m2, float& l, float f, f32x16* o) {
    int tz = tid; asm volatile("" : "+v"(tz));
    const int lane = tz & 63, sr = tz >> 4, sc = (tz & 15) * 8, r32 = lane & 31, hi = lane >> 5;
    const int vb0 = (int)(uintptr_t)(lds + L_V) + v_rd_base(lane);
    const bool more = (i + 1 < br.nt);
    Tile nx = br.tile(more ? i + 1 : i);
    if (more) stg_load(S, nx.K, nx.ld, sr, sc);
    SBAR();
    if (br.act(i)) {
        f32x16 p0, p1;
        qkt<KB>(p0, p1, lds, r32, hi, qr);
        SBAR();
        br.scores(p0, p1, i, lane);
        if (PASS == 1) {
            float pmax = p0[0];
#pragma unroll
            for (int r = 1; r < 16; ++r) pmax = fmaxf(pmax, p0[r]);
#pragma unroll
            for (int r = 0; r < 16; ++r) pmax = fmaxf(pmax, p1[r]);
            pmax = xhalf_max(pmax);
            const float mn = fmaxf(m2, pmax);
            float ps = 0.f;
#pragma unroll
            for (int r = 0; r < 16; ++r) ps += __builtin_amdgcn_exp2f(p0[r] - mn) + __builtin_amdgcn_exp2f(p1[r] - mn);
            ps = xhalf_sum(ps);
            l = l * __builtin_amdgcn_exp2f(m2 - mn) + ps; m2 = mn;
        } else {
            if (PASS == 2) {
#pragma unroll
                for (int r = 0; r < 16; ++r) { p0[r] = __builtin_amdgcn_exp2f(p0[r] - m2) * f; p1[r] = __builtin_amdgcn_exp2f(p1[r] - m2) * f; }
                br.hook(p0, p1, i, lane);
            } else {
                float ps = 0.f;
#pragma unroll
                for (int r = 0; r < 16; ++r) { p0[r] = __builtin_amdgcn_exp2f(p0[r] - m2); p1[r] = __builtin_amdgcn_exp2f(p1[r] - m2); ps += p0[r] + p1[r]; }
                l += xhalf_sum(ps);
            }
            SBAR();
            if (more) { stg_write_k<KB ^ 1>(S, lds, sr, sc); SBAR(); stg_load(S, nx.V, nx.ld, sr, sc); SBAR(); }
            bf16x8 pa0, pa1, pa2, pa3; pack_p(p0, p1, pa0, pa1, pa2, pa3);
            SBAR();
            pv_tile<KB>(o, vb0, pa0, pa1, pa2, pa3);
            SBAR();
            if (more) stg_write_v<KB ^ 1>(S, lds, sr, sc);
        }
    } else if (PASS >= 2) { if (more) { stg_write_k<KB ^ 1>(S, lds, sr, sc); SBAR(); stg_load(S, nx.V, nx.ld, sr, sc); SBAR(); stg_write_v<KB ^ 1>(S, lds, sr, sc); } }
    SBAR();
    if (PASS == 1) { if (more) stg_write_k<KB ^ 1>(S, lds, sr, sc); }
    __syncthreads();
}
template <int PASS, class Br>
__device__ __forceinline__ void run_pass(Br& br, LAS unsigned char* lds, int tid, const bf16x8* qr, float& m2, float& l, float f, f32x16* o) {
    if (br.nt <= 0) return;
    const int sr = tid >> 4, sc = (tid & 15) * 8;
    Stg S;
    { const Tile t0 = br.tile(0); stg_load(S, t0.K, t0.ld, sr, sc); stg_write_k<0>(S, lds, sr, sc);
      if (PASS >= 2) { stg_load(S, t0.V, t0.ld, sr, sc); stg_write_v<0>(S, lds, sr, sc); } }
    __syncthreads();
    for (int i = 0; i < br.nt; i += 2) {
        step<PASS, 0>(br, i, S, lds, tid, qr, m2, l, f, o);
        if (i + 1 < br.nt) step<PASS, 1>(br, i + 1, S, lds, tid, qr, m2, l, f, o);
    }
}
__device__ __forceinline__ void scale_rows(f32x16* o, float frow, LAS float* ws, int lane) {
    const int r32 = lane & 31, hi = lane >> 5;
    if (hi == 0) ws[r32] = frow;
    LDS_WAIT(); asm volatile("" ::: "memory");
#pragma unroll
    for (int r = 0; r < 16; ++r) { const float a = ws[crow(r, hi)];
#pragma unroll
        for (int d0 = 0; d0 < 4; ++d0) o[d0][r] *= a; }
    LDS_WAIT(); asm volatile("" ::: "memory");
}
__device__ __forceinline__ float gain_absmax(const float* g, int lane) {
    float a = fmaxf(fabsf(g[lane]), fabsf(g[lane + 64]));
#pragma unroll
    for (int o = 1; o < 64; o <<= 1) a = fmaxf(a, __shfl_xor(a, o));
    return __uint_as_float((unsigned)__builtin_amdgcn_readfirstlane((int)__float_as_uint(a)));
}
__device__ __forceinline__ void o_store(const f32x16* o, float* blk, int lane) {
#pragma unroll
    for (int d0 = 0; d0 < 4; ++d0) {
        float* b = blk + d0 * 1024 + lane; asm volatile("" : "+v"(b));
#pragma unroll
        for (int r = 0; r < 16; ++r) b[r * 64] = o[d0][r];
    }
}
__device__ __forceinline__ void o_addload(f32x16* o, const float* blk, int lane) {
#pragma unroll
    for (int d0 = 0; d0 < 4; ++d0) {
        const float* b = blk + d0 * 1024 + lane; asm volatile("" : "+v"(b));
#pragma unroll
        for (int r = 0; r < 16; ++r) o[d0][r] += b[r * 64];
        asm volatile("" : "+v"(o[d0]) :: "memory");
    }
}
__device__ __forceinline__ void load_q(bf16x8* qr, const bf16* qrow, int hi) {
#pragma unroll
    for (int d0 = 0; d0 < 8; ++d0) { const v4u w = *(const v4u*)(qrow + d0 * 16 + hi * 8); qr[d0] = *reinterpret_cast<const bf16x8*>(&w); }
}

struct RowNsa { int t; float slope2; };
struct BrCmp {
    int nt; const bf16* K; const bf16* V; int jmax_w; RowNsa R;
    LAS float* ps; LAS float* imp;
    __device__ __forceinline__ Tile tile(int i) const { return Tile{K + (size_t)i * 64 * HD, V + (size_t)i * 64 * HD, (size_t)HD}; }
    __device__ __forceinline__ bool act(int i) const { return 64 * i <= jmax_w; }
    __device__ __forceinline__ void scores(f32x16& p0, f32x16& p1, int i, int lane) const {
        const float NEG = -__builtin_inff(); const int hi = lane >> 5;
        float sl = R.slope2; asm volatile("" : "+v"(sl));
        int tt = R.t; asm volatile("" : "+v"(tt));
        const int jmax = (tt >= 31) ? ((tt - 31) >> 4) : -1;
        const int jm = jmax - 64 * i - 4 * hi;
        const float b0 = -sl * (float)(tt - 31 - 16 * (64 * i + 4 * hi));
#pragma unroll
        for (int r = 0; r < 16; ++r) { const int c = (r & 3) + 8 * (r >> 2);
            p0[r] = (c <= jm) ? fmaf(p0[r], C2, fmaf(sl, (float)(16 * c), b0)) : NEG;
            p1[r] = (c + 32 <= jm) ? fmaf(p1[r], C2, fmaf(sl, (float)(16 * c + 512), b0)) : NEG; }
    }
    __device__ __forceinline__ void hook(const f32x16& p0, const f32x16& p1, int i, int lane) const {
        const int r32 = lane & 31, hi = lane >> 5, pp = r32 & 3, ql = r32 >> 2;
#pragma unroll
        for (int qd = 0; qd < 4; ++qd) {
            f32x4 a, b;
#pragma unroll
            for (int e = 0; e < 4; ++e) { a[e] = quad_sum(p0[4 * qd + e]); b[e] = quad_sum(p1[4 * qd + e]); }
            if (pp == qd) { *(LAS f32x4*)(ps + ql * 68 + 4 + 8 * qd + 4 * hi) = a; *(LAS f32x4*)(ps + ql * 68 + 4 + 32 + 8 * qd + 4 * hi) = b; }
        }
        LDS_WAIT(); asm volatile("" ::: "memory");
#pragma unroll
        for (int h2 = 0; h2 < 2; ++h2) { const int idx = lane + 64 * h2, q8 = idx >> 4, mq = idx & 15;
            const f32x4 v = *(const LAS f32x4*)(ps + q8 * 68 + 4 + 4 * mq); const float pv = ps[q8 * 68 + 3 + 4 * mq];
            imp[q8 * 128 + 16 * i + mq] = (v[0] + v[1]) + (v[2] + v[3]) + pv; }
        LDS_WAIT(); asm volatile("" ::: "memory");
        if (lane < 8) ps[lane * 68 + 3] = ps[lane * 68 + 4 + 63];
        LDS_WAIT(); asm volatile("" ::: "memory");
    }
};
struct BrSlc {
    int nt; const bf16* K; const bf16* V; RowNsa R;
    const LAS int* list; const LAS unsigned long long* sel; const LAS unsigned long long* wu;
    __device__ __forceinline__ int blk(int i) const { return list[i]; }
    __device__ __forceinline__ Tile tile(int i) const { const int b = __builtin_amdgcn_readfirstlane(blk(i)); return Tile{K + (size_t)b * 64 * NA, V + (size_t)b * 64 * NA, (size_t)NA}; }
    __device__ __forceinline__ bool act(int i) const { const int b = __builtin_amdgcn_readfirstlane(blk(i)); const unsigned long long u = wu[b >> 6]; return (u >> (b & 63)) & 1ull; }
    __device__ __forceinline__ void scores(f32x16& p0, f32x16& p1, int i, int lane) const {
        const float NEG = -__builtin_inff(); const int b = __builtin_amdgcn_readfirstlane(blk(i)); const int hi = lane >> 5, ql = (lane & 31) >> 2;
        const unsigned long long mm = sel[ql * 2 + (b >> 6)];
        const bool mine = (mm >> (b & 63)) & 1ull;
        float sl = R.slope2; asm volatile("" : "+v"(sl));
        int tt = R.t; asm volatile("" : "+v"(tt));
        const int dm = mine ? (tt - 64 * b - 4 * hi) : -1;
        const float b0 = -sl * (float)dm;
#pragma unroll
        for (int r = 0; r < 16; ++r) { const int c = (r & 3) + 8 * (r >> 2);
            p0[r] = (c <= dm) ? fmaf(p0[r], C2, fmaf(sl, (float)c, b0)) : NEG;
            p1[r] = (c + 32 <= dm) ? fmaf(p1[r], C2, fmaf(sl, (float)(c + 32), b0)) : NEG; }
    }
    __device__ __forceinline__ void hook(const f32x16&, const f32x16&, int, int) const {}
};
struct BrWin {
    int nt; const bf16* K; const bf16* V; RowNsa R; int kb0;
    __device__ __forceinline__ Tile tile(int i) const { return Tile{K + (size_t)(kb0 + i) * 64 * NA, V + (size_t)(kb0 + i) * 64 * NA, (size_t)NA}; }
    __device__ __forceinline__ bool act(int) const { return true; }
    __device__ __forceinline__ void scores(f32x16& p0, f32x16& p1, int i, int lane) const {
        const float NEG = -__builtin_inff(); const int hi = lane >> 5;
        float sl = R.slope2; asm volatile("" : "+v"(sl));
        int tt = R.t; asm volatile("" : "+v"(tt));
        const int dm = tt - 64 * (kb0 + i) - 4 * hi;
        const float b0 = -sl * (float)dm;
#pragma unroll
        for (int r = 0; r < 16; ++r) { const int c = (r & 3) + 8 * (r >> 2);
            p0[r] = ((unsigned)(dm - c) < 512u) ? fmaf(p0[r], C2, fmaf(sl, (float)c, b0)) : NEG;
            p1[r] = ((unsigned)(dm - c - 32) < 512u) ? fmaf(p1[r], C2, fmaf(sl, (float)(c + 32), b0)) : NEG; }
    }
    __device__ __forceinline__ void hook(const f32x16&, const f32x16&, int, int) const {}
};
struct BrMem {
    int nt; const bf16* K; const bf16* V;
    __device__ __forceinline__ Tile tile(int i) const { return Tile{K + (size_t)i * 64 * 2048, V + (size_t)i * 64 * 2048, (size_t)2048}; }
    __device__ __forceinline__ bool act(int) const { return true; }
    __device__ __forceinline__ void scores(f32x16& p0, f32x16& p1, int, int) const {
#pragma unroll
        for (int r = 0; r < 16; ++r) { p0[r] *= C2; p1[r] *= C2; }
    }
    __device__ __forceinline__ void hook(const f32x16&, const f32x16&, int, int) const {}
};
template <class RP> __device__ __forceinline__ void store_o(const f32x16* o, int lane, RP rowptr) {
    const int r32 = lane & 31, hi = lane >> 5;
#pragma unroll
    for (int r = 0; r < 16; ++r) { bf16* rp = rowptr(crow(r, hi));
#pragma unroll
        for (int d0 = 0; d0 < 4; ++d0) { const float v = o[d0][r]; const float vn = __shfl_xor(v, 1);
            if ((r32 & 1) == 0) *(unsigned*)(rp + d0 * 32 + r32) = cvtpk(v, vn); } }
}
}

__device__ __forceinline__ void topk_select(unsigned k0, unsigned k1, int need, int lane, unsigned long long& s0, unsigned long long& s1) {
    unsigned thr = 0u;
    for (int bit = 31; bit >= 0; --bit) {
        const unsigned cand = thr | (1u << bit);
        const int cnt = __popcll(__ballot(k0 >= cand)) + __popcll(__ballot(k1 >= cand));
        if (cnt >= need) thr = cand;
    }
    const unsigned long long g0 = __ballot(k0 > thr), g1 = __ballot(k1 > thr), e0 = __ballot(k0 == thr && thr != 0u), e1 = __ballot(k1 == thr && thr != 0u);
    const int rem = need - (__popcll(g0) + __popcll(g1));
    const unsigned long long lt = (1ull << lane) - 1ull;
    const bool t0 = (k0 == thr && thr != 0u) && (__popcll(e0 & lt) < rem);
    const bool t1 = (k1 == thr && thr != 0u) && (__popcll(e0) + __popcll(e1 & lt) < rem);
    s0 = g0 | __ballot(t0); s1 = g1 | __ballot(t1);
}

__device__ __forceinline__ void nsa_item(Frame& F, int g, int qb, float mb_slc, float mb_win) {
    using namespace at;
    LAS unsigned char* lds = F.lds + RING_OFF;
    const bf16* PA = WSP(bf16, WS_PA); const bf16* KC = WSP(bf16, WS_KCMP) + (size_t)g * NCMP_P * HD; const bf16* VC = KC + (size_t)NG * NCMP_P * HD; bf16* MIX = WSP(bf16, WS_MIX);
    int tz = F.tid; asm volatile("" : "+v"(tz));
    const int lane = tz & 63, w = F.wave, r32 = lane & 31, hi = lane >> 5;
    const int t0 = 64 * qb, tw = t0 + 8 * w, ql = r32 >> 2, pp = r32 & 3, t = tw + ql, head = 4 * g + pp;
    LAS float* ws = (LAS float*)(lds + L_WS + w * 256);
    LAS float* IMP = (LAS float*)(lds + L_IMP) + w * 8 * 128;
    LAS float* PS = (LAS float*)(lds + L_PS + w * 2176);
    LAS unsigned long long* SEL = (LAS unsigned long long*)(lds + L_SEL);
    LAS unsigned long long* WU = (LAS unsigned long long*)(lds + L_WU);
    LAS int* LIST = (LAS int*)(lds + L_LIST);
    float* oacc = WSP(float, WS_OACC) + ((size_t)((g * 128 + qb) * 8 + w)) * 4096;
    RowNsa R; R.t = t; R.slope2 = exp2f(-8.0f * (float)(head + 1) / 12.0f) * LOG2E;
    bf16x8 qr[8]; load_q(qr, PA + (size_t)t * NA + CA_Q + head * HD, hi);
#define GATE(br_) (1.0f / (1.0f + fast_exp(-bf2f(PA[(size_t)t * NA + CA_GT + head * 3 + (br_)]))))
    f32x16 o[4] = {};
    for (int i = lane; i < 8 * 128; i += 64) IMP[i] = 0.f;
    if (lane < 8) PS[lane * 68 + 3] = 0.f;
    LDS_WAIT(); asm volatile("" ::: "memory");
    {
        BrCmp br; br.K = KC; br.V = VC; br.R = R; br.ps = PS; br.imp = IMP;
        br.jmax_w = (tw + 7 >= 31) ? (tw + 7 - 31) / 16 : -1;
        const int jmax_b = (t0 + 63 - 31) / 16;
        br.nt = jmax_b / 64 + 1;
        float m2 = -1e30f, l = 0.f;
        run_pass<1>(br, lds, tz, qr, m2, l, 0.f, o);
        const float f = (l > 0.f) ? 1.0f / l : 0.f;
        run_pass<2>(br, lds, tz, qr, m2, l, f, o);
        scale_rows(o, GATE(0), ws, lane);
        o_store(o, oacc, lane);
#pragma unroll
        for (int d0 = 0; d0 < 4; ++d0) o[d0] = f32x16{};
    }
    for (int qq = 0; qq < 8; ++qq) {
        const int tt = tw + qq, cur = tt >> 6;
        const int b0 = lane, b1 = lane + 64;
        unsigned long long s0 = 0ull, s1 = 0ull;
        const int ncand = cur - 1;
        const bool c0 = (b0 >= 1 && b0 < cur), c1 = (b1 < cur);
        if (ncand <= 14) { s0 = __ballot(c0); s1 = __ballot(c1); }
        else {
            const unsigned k0 = c0 ? (__float_as_uint(IMP[qq * 128 + b0]) + 1u) : 0u, k1 = c1 ? (__float_as_uint(IMP[qq * 128 + b1]) + 1u) : 0u;
            topk_select(k0, k1, 14, lane, s0, s1);
        }
        s0 |= 1ull;
        if (cur < 64) s0 |= (1ull << cur); else s1 |= (1ull << (cur - 64));
        if (lane == 0) { SEL[(8 * w + qq) * 2] = s0; SEL[(8 * w + qq) * 2 + 1] = s1; }
    }
    LDS_WAIT(); asm volatile("" ::: "memory");
    unsigned long long wu0 = 0ull, wu1 = 0ull;
#pragma unroll
    for (int qq = 0; qq < 8; ++qq) { wu0 |= SEL[(8 * w + qq) * 2]; wu1 |= SEL[(8 * w + qq) * 2 + 1]; }
    if (lane == 0) { WU[2 * w] = wu0; WU[2 * w + 1] = wu1; }
    __syncthreads();
    int nsl = 0;
    {
        unsigned long long u0 = 0ull, u1 = 0ull;
#pragma unroll
        for (int ww = 0; ww < 8; ++ww) { u0 |= WU[2 * ww]; u1 |= WU[2 * ww + 1]; }
        nsl = __popcll(u0) + __popcll(u1);
        if (w == 0) {
            const unsigned long long lt = (1ull << lane) - 1ull;
            if ((u0 >> lane) & 1ull) LIST[__popcll(u0 & lt)] = lane;
            if ((u1 >> lane) & 1ull) LIST[__popcll(u0) + __popcll(u1 & lt)] = lane + 64;
        }
    }
    __syncthreads();
    {
        BrSlc br; br.K = PA + CA_KS + g * HD; br.V = PA + CA_VS + g * HD; br.R = R; br.list = LIST; br.nt = nsl;
        br.sel = SEL + 16 * w; br.wu = WU + 2 * w;
        float m2 = mb_slc, l = 0.f;
        run_pass<3>(br, lds, tz, qr, m2, l, 0.f, o);
        scale_rows(o, (l > 0.f) ? GATE(1) / l : 0.f, ws, lane);
        o_addload(o, oacc, lane); o_store(o, oacc, lane);
#pragma unroll
        for (int d0 = 0; d0 < 4; ++d0) o[d0] = f32x16{};
    }
    {
        BrWin br; br.K = PA + CA_KW + g * HD; br.V = PA + CA_VW + g * HD; br.R = R;
        br.kb0 = (t0 - 511 > 0) ? ((t0 - 511) >> 6) : 0; br.nt = qb - br.kb0 + 1;
        float m2 = mb_win, l = 0.f;
        run_pass<3>(br, lds, tz, qr, m2, l, 0.f, o);
        scale_rows(o, (l > 0.f) ? GATE(2) / l : 0.f, ws, lane);
        o_addload(o, oacc, lane);
    }
    store_o(o, lane, [&](int row) { return MIX + (size_t)(tw + (row >> 2)) * DM + (4 * g + (row & 3)) * HD; });
#undef GATE
}
__device__ __forceinline__ void mem_item(Frame& F, const bf16* P, int ldp, int qcol, const float* qg, int layer, int hm, int qb, float mb_mem) {
    using namespace at;
    LAS unsigned char* lds = F.lds + RING_OFF;
    const bf16* MKV = WSP(bf16, WS_MKV); bf16* MIX = WSP(bf16, WS_MIX);
    int tz = F.tid; asm volatile("" : "+v"(tz));
    const int lane = tz & 63, w = F.wave, r32 = lane & 31, hi = lane >> 5;
    const int tw = 256 * qb + 32 * w, t = tw + r32;
    bf16x8 qr[8];
    {
        const bf16* qrow = P + (size_t)t * ldp + qcol + hm * HD;
        float qf[64]; float ss = 0.f;
#pragma unroll
        for (int d0 = 0; d0 < 8; ++d0) { const v4u wv = *(const v4u*)(qrow + d0 * 16 + hi * 8); unpack8(wv, qf + 8 * d0); }
#pragma unroll
        for (int i = 0; i < 64; ++i) ss += qf[i] * qf[i];
        ss = xhalf_sum(ss);
        const float rs = 1.0f / sqrtf(ss * (1.f / HD) + EPS);
#pragma unroll
        for (int d0 = 0; d0 < 8; ++d0) { const float* gp = qg + d0 * 16 + hi * 8;
            v4u wv; wv.x = cvtpk(qf[8 * d0] * rs * gp[0], qf[8 * d0 + 1] * rs * gp[1]); wv.y = cvtpk(qf[8 * d0 + 2] * rs * gp[2], qf[8 * d0 + 3] * rs * gp[3]);
            wv.z = cvtpk(qf[8 * d0 + 4] * rs * gp[4], qf[8 * d0 + 5] * rs * gp[5]); wv.w = cvtpk(qf[8 * d0 + 6] * rs * gp[6], qf[8 * d0 + 7] * rs * gp[7]);
            qr[d0] = *reinterpret_cast<const bf16x8*>(&wv); }
    }
    f32x16 o[4] = {};
    BrMem br; br.nt = 4; br.K = MKV + layer * 1024 + hm * HD; br.V = br.K + 512;
    float m2 = mb_mem, l = 0.f;
    run_pass<3>(br, lds, tz, qr, m2, l, 0.f, o);
    scale_rows(o, 1.0f / l, (LAS float*)(lds + L_WS + w * 256), lane);
    store_o(o, lane, [&](int row) { return MIX + (size_t)(tw + row) * DM + NMIX * HD + hm * HD; });
}
__device__ __forceinline__ void p3_attn(Frame& F) {
    const int ln = lane_of(F);
    using at::gain_absmax; using at::C2;
    const float gq = gain_absmax(F.in[8], ln);
    const float mb_slc = 128.f * C2 * 1.01f * gq * gain_absmax(F.in[9] + HD, ln), mb_win = 128.f * C2 * 1.01f * gq * gain_absmax(F.in[9] + 2 * HD, ln);
    const float mb_mem = 128.f * C2 * 1.01f * gain_absmax(F.in[14], ln) * gain_absmax(F.in[14] + HD, ln);
    for (int it = F.vcu; it < 384 + 128; it += F.G) {
        if (it < 384) { const int g = it % 3, qb = 127 - it / 3; nsa_item(F, g, qb, mb_slc, mb_win); }
        else { const int j = it - 384; mem_item(F, WSP(bf16, WS_PA), NA, CA_QM, F.in[14], 0, j & 3, j >> 2, mb_mem); }
        __syncthreads();
    }
}

__device__ __forceinline__ void stick_tile(at::f32x16& p0, at::f32x16& p1, int k0, int t, int hi, float& R2) {
    using namespace at;
    float L0[16], L1[16];
    const float NEG = -__builtin_inff();
#pragma unroll
    for (int r = 0; r < 16; ++r) {
        const int kk = k0 + crow(r, hi);
        { const float z = p0[r] * C2; const float sp = fmaxf(z, 0.f) + __builtin_amdgcn_logf(1.0f + __builtin_amdgcn_exp2f(-fabsf(z))); const bool v = kk < t; L0[r] = v ? -sp : 0.f; p0[r] = v ? z - sp : NEG; }
        { const float z = p1[r] * C2; const float sp = fmaxf(z, 0.f) + __builtin_amdgcn_logf(1.0f + __builtin_amdgcn_exp2f(-fabsf(z))); const bool v = kk + 32 < t; L1[r] = v ? -sp : 0.f; p1[r] = v ? z - sp : NEG; }
    }
    float ct[8], pt[8];
#pragma unroll
    for (int c = 0; c < 4; ++c) { ct[c] = (L0[4 * c] + L0[4 * c + 1]) + (L0[4 * c + 2] + L0[4 * c + 3]); ct[4 + c] = (L1[4 * c] + L1[4 * c + 1]) + (L1[4 * c + 2] + L1[4 * c + 3]); }
#pragma unroll
    for (int c = 0; c < 8; ++c) { auto rr = __builtin_amdgcn_permlane32_swap(__float_as_uint(ct[c]), __float_as_uint(ct[c]), false, false); pt[c] = __uint_as_float(hi ? rr[0] : rr[1]); }
    float E[8]; float run = 0.f;
#pragma unroll
    for (int c = 7; c >= 0; --c) { E[c] = run + (hi == 0 ? pt[c] : 0.f); run += ct[c] + pt[c]; }
#pragma unroll
    for (int c = 0; c < 4; ++c) {
        { const float a3 = R2 + E[c], a2 = a3 + L0[4 * c + 3], a1 = a2 + L0[4 * c + 2], a0 = a1 + L0[4 * c + 1];
          p0[4 * c + 3] = __builtin_amdgcn_exp2f(p0[4 * c + 3] + a3); p0[4 * c + 2] = __builtin_amdgcn_exp2f(p0[4 * c + 2] + a2); p0[4 * c + 1] = __builtin_amdgcn_exp2f(p0[4 * c + 1] + a1); p0[4 * c] = __builtin_amdgcn_exp2f(p0[4 * c] + a0); }
        { const float a3 = R2 + E[4 + c], a2 = a3 + L1[4 * c + 3], a1 = a2 + L1[4 * c + 2], a0 = a1 + L1[4 * c + 1];
          p1[4 * c + 3] = __builtin_amdgcn_exp2f(p1[4 * c + 3] + a3); p1[4 * c + 2] = __builtin_amdgcn_exp2f(p1[4 * c + 2] + a2); p1[4 * c + 1] = __builtin_amdgcn_exp2f(p1[4 * c + 1] + a1); p1[4 * c] = __builtin_amdgcn_exp2f(p1[4 * c] + a0); }
    }
    R2 += run;
}
template <int KB>
__device__ __forceinline__ bool stick_step(int kb, int kb_w, at::Stg& S, LAS unsigned char* lds, int tid, const bf16* Kh, const bf16* Vh, const at::bf16x8* qr, at::f32x16* o, int tw, float& R2, LAS int* DONE) {
    using namespace at;
    int tz = tid; asm volatile("" : "+v"(tz));
    const int lane = tz & 63, w = __builtin_amdgcn_readfirstlane(tz >> 6), r32 = lane & 31, hi = lane >> 5, sr = tz >> 4, sc = (tz & 15) * 8;
    const int vb0 = (int)(uintptr_t)(lds + L_V) + v_rd_base(lane);
    int t = tw + r32; asm volatile("" : "+v"(t));
    const float THR2 = -100.f;
    const bool more = kb > 0;
    const bf16* Kn = Kh + (size_t)(more ? kb - 1 : kb) * 64 * NB; const bf16* Vn = Vh + (size_t)(more ? kb - 1 : kb) * 64 * NB;
    if (more) stg_load(S, Kn, NB, sr, sc);
    SBAR();
    bool wdone = false, kdone = false;
    if (kb <= kb_w) {
        if (__any(R2 > THR2)) {
            f32x16 p0, p1; qkt<KB>(p0, p1, lds, r32, hi, qr);
            SBAR();
            stick_tile(p0, p1, 64 * kb, t, hi, R2);
            SBAR();
            if (more) { stg_write_k<KB ^ 1>(S, lds, sr, sc); SBAR(); stg_load(S, Vn, NB, sr, sc); SBAR(); } kdone = true;
            bf16x8 pa0, pa1, pa2, pa3; pack_p(p0, p1, pa0, pa1, pa2, pa3);
            SBAR();
            pv_tile<KB>(o, vb0, pa0, pa1, pa2, pa3);
            SBAR();
        }
        wdone = !__any(R2 > THR2);
    }
    if (lane == 0) DONE[(kb & 1) * 8 + w] = wdone ? 1 : 0;
    if (more) { if (!kdone) { stg_write_k<KB ^ 1>(S, lds, sr, sc); SBAR(); stg_load(S, Vn, NB, sr, sc); SBAR(); } stg_write_v<KB ^ 1>(S, lds, sr, sc); }
    __syncthreads();
    int alld = 1;
#pragma unroll
    for (int ww = 0; ww < 8; ++ww) alld &= DONE[(kb & 1) * 8 + ww];
    return more && !alld;
}
__device__ __forceinline__ void stick_item(Frame& F, int h, int qb) {
    using namespace at;
    LAS unsigned char* lds = F.lds + RING_OFF;
    const bf16* PB = WSP(bf16, WS_PB); bf16* MIX = WSP(bf16, WS_MIX);
    int tid = F.tid; asm volatile("" : "+v"(tid));
    const int lane = tid & 63, w = F.wave, r32 = lane & 31, hi = lane >> 5, sr = tid >> 4, sc = (tid & 15) * 8;
    const int q0 = 256 * qb, tw = q0 + 32 * w, t = tw + r32;
    LAS int* DONE = (LAS int*)(lds + L_DONE);
    bf16x8 qr[8]; load_q(qr, PB + (size_t)t * NB + CB_Q + h * HD, hi);
    f32x16 o[4] = {};
    const bf16* Kh = PB + CB_K + h * HD; const bf16* Vh = PB + CB_V + h * HD;
    const int kb_hi = q0 / 64 + 3, kb_w = q0 / 64 + (w >> 1);
    float R2 = 0.f;
    Stg S;
    stg_load(S, Kh + (size_t)kb_hi * 64 * NB, NB, sr, sc); stg_write_k<0>(S, lds, sr, sc);
    stg_load(S, Vh + (size_t)kb_hi * 64 * NB, NB, sr, sc); stg_write_v<0>(S, lds, sr, sc);
    __syncthreads();
    for (int kb = kb_hi; ; kb -= 2) {
        if (!stick_step<0>(kb, kb_w, S, lds, tid, Kh, Vh, qr, o, tw, R2, DONE)) break;
        if (!stick_step<1>(kb - 1, kb_w, S, lds, tid, Kh, Vh, qr, o, tw, R2, DONE)) break;
    }
    store_o(o, lane, [&](int row) { return MIX + (size_t)(tw + row) * DM + h * HD; });
}
__device__ __forceinline__ void p10_attn(Frame& F) {
    const int ln = lane_of(F);
    const float mb_mem = 128.f * at::C2 * 1.01f * at::gain_absmax(F.in[14] + 2 * HD, ln) * at::gain_absmax(F.in[14] + 3 * HD, ln);
    for (int it = F.vcu; it < 384 + 128; it += F.G) {
        if (it < 384) { const int h = it % 12, qb = 31 - it / 12; stick_item(F, h, qb); }
        else { const int j = it - 384; mem_item(F, WSP(bf16, WS_PB), NB, CB_QM, F.in[14] + 2 * HD, 1, j & 3, j >> 2, mb_mem); }
        __syncthreads();
    }
}

constexpr int N_PHASES = 17;
#ifndef MK_PROBE_SUB
#define MK_PROBE_SUB 0
#endif
#ifndef MK_PROBE_MASK
#define MK_PROBE_MASK 0
#endif
#ifndef MK_NAIVE_P3
#define MK_NAIVE_P3 0
#endif
#ifndef MK_NAIVE_P10
#define MK_NAIVE_P10 0
#endif
struct Args { const float* in[22]; float* out; unsigned char* ws; int ph_lo, ph_hi, use_bar, pad; };
__global__ void __launch_bounds__(NWAVES * 64, 2) mk_fwd(Args args) {
    extern __shared__ __attribute__((aligned(16))) unsigned char lds[];
    Frame F;
    F.lds = (LAS unsigned char*)lds;
    F.MISC = (volatile LAS unsigned*)(F.lds + MISC_OFF);
    F.tid = threadIdx.x;  F.wave = __builtin_amdgcn_readfirstlane(F.tid >> 6);
    F.G = gridDim.x; { const int bx = blockIdx.x; F.vcu = (F.G % 8 == 0) ? (bx % 8) * (F.G / 8) + bx / 8 : bx; }
    F.ws = args.ws; F.ctl = (gu32*)(args.ws + WS_CTL); F.out = args.out;
#pragma unroll
    for (int i = 0; i < 22; ++i) F.in[i] = args.in[i];
    for (int u = F.tid; u < (LDS_BYTES - LDSCTL_OFF) / 4; u += NWAVES * 64) ((LAS unsigned*)(F.lds + LDSCTL_OFF))[u] = 0u;
    __syncthreads();
    XcdBarrier bar; bar.bar = (unsigned*)(F.ctl + CW_BAR); bar.x = 0; bar.st = nullptr;
    if (args.use_bar) bar = xcd_barrier_post((unsigned*)(F.ctl + CW_BAR), F.MISC + 8);
#define GRID_BAR() do { if (args.use_bar) xcd_barrier(bar); F.tid = threadIdx.x; asm volatile("" : "+v"(F.tid));  } while (0)
    const int lo = args.ph_lo, hi = args.ph_hi;
#ifdef MK_ONLY_PHASE
#define IN(k) ((k) == MK_ONLY_PHASE && lo <= (k) && (k) < hi)
#else
#define IN(k) (lo <= (k) && (k) < hi)
#endif
#define BOTH(k) (IN(k) && IN((k) + 1))
    typedef pg8::StaticOrder SO;

    if (IN(0)) { p0_prologue(F); if (BOTH(0)) GRID_BAR(); }
    if (IN(1)) {
        { pg8::Gemm g{WSP(bf16, WS_XN), WSP(bf16, WS_WT_INA), DM}; SO S; S.init(T / 256, NA / 256, F.G, (int)blockIdx.x);
          pg8::EpiBf16 E{WSP(bf16, WS_PA), NA}; pg8::gemm_phase<pg8::EpiBf16, SO, true, true>(F.lds + RING_OFF, g, S, E); }
        { pg8::Gemm g{WSP(bf16, WS_MEMN), WSP(bf16, WS_WT_MEM), DM}; SO S; S.init(1, 8, F.G, (int)(F.G - 1 - blockIdx.x));
          pg8::EpiBf16 E{WSP(bf16, WS_MKV), 2048}; pg8::gemm_phase<pg8::EpiBf16, SO, true, true>(F.lds + RING_OFF, g, S, E); }
        if (BOTH(1)) GRID_BAR();
    }
    if (IN(2)) { if (args.pad != 2) p2_compress(F); if (args.pad != 1) p2_qknorm(F); if (BOTH(2)) GRID_BAR(); }
#if MK_NAIVE_P3
    if (IN(3)) { p3_nsa_naive(F); mem_attn_naive(F, WSP(bf16, WS_PA), NA, CA_QM, F.in[14], 0); if (BOTH(3)) GRID_BAR(); }
#else
    if (IN(3)) { p3_attn(F); if (BOTH(3)) GRID_BAR(); }
#endif
    if (IN(4)) { pg8::Gemm g{WSP(bf16, WS_MIX), WSP(bf16, WS_WT_OUT), DM}; SO S; S.init(T / 256, DM / 256, F.G, (int)blockIdx.x);
        pg8::EpiResF32 E{F.in[0], WSP(float, WS_X1), DM}; pg8::gemm_phase<pg8::EpiResF32, SO, true, true>(F.lds + RING_OFF, g, S, E); if (BOTH(4)) GRID_BAR(); }
    if (IN(5)) { rmsnorm_rows(F, WSP(float, WS_X1), WSP(bf16, WS_XN), T); if (BOTH(5)) GRID_BAR(); }
    if (IN(6)) { pg8::Gemm g{WSP(bf16, WS_XN), WSP(bf16, WS_WT_FGU), DM}; SO S; S.init(T / 256, 2 * FF / 256, F.G, (int)blockIdx.x);
        pg8::EpiSwiglu E{WSP(bf16, WS_HFF), FF}; pg8::gemm_phase<pg8::EpiSwiglu, SO, true, true>(F.lds + RING_OFF, g, S, E); if (BOTH(6)) GRID_BAR(); }
    if (IN(7)) { pg8::Gemm g{WSP(bf16, WS_HFF), WSP(bf16, WS_WT_FDN), FF}; SO S; S.init(T / 256, DM / 256, F.G, (int)blockIdx.x);
        pg8::EpiResF32 E{WSP(float, WS_X1), WSP(float, WS_X2), DM}; pg8::gemm_phase<pg8::EpiResF32, SO, true, true>(F.lds + RING_OFF, g, S, E); if (BOTH(7)) GRID_BAR(); }
    if (IN(8)) { rmsnorm_rows(F, WSP(float, WS_X2), WSP(bf16, WS_XN), T); if (BOTH(8)) GRID_BAR(); }
    if (IN(9)) { pg8::Gemm g{WSP(bf16, WS_XN), WSP(bf16, WS_WT_INB), DM}; SO S; S.init(T / 256, NB / 256, F.G, (int)blockIdx.x);
        pg8::EpiBf16 E{WSP(bf16, WS_PB), NB}; pg8::gemm_phase<pg8::EpiBf16, SO, true, true>(F.lds + RING_OFF, g, S, E); if (BOTH(9)) GRID_BAR(); }
#if MK_NAIVE_P10
    if (IN(10)) { stick_naive(F); mem_attn_naive(F, WSP(bf16, WS_PB), NB, CB_QM, F.in[14] + 2 * HD, 1); if (BOTH(10)) GRID_BAR(); }
#else
    if (IN(10)) { p10_attn(F); if (BOTH(10)) GRID_BAR(); }
#endif
    if (IN(11)) { pg8::Gemm g{WSP(bf16, WS_MIX), WSP(bf16, WS_WT_OUT) + (size_t)DM * DM, DM}; SO S; S.init(T / 256, DM / 256, F.G, (int)blockIdx.x);
        pg8::EpiResF32 E{WSP(float, WS_X2), WSP(float, WS_X3), DM}; pg8::gemm_phase<pg8::EpiResF32, SO, true, true>(F.lds + RING_OFF, g, S, E); if (BOTH(11)) GRID_BAR(); }
    if (IN(12)) { p12_router(F); if (BOTH(12)) GRID_BAR(); }
    if (IN(13)) { p13_assign(F); if (BOTH(13)) GRID_BAR(); }
    if (IN(14)) { const int* TILE = (const int*)(F.ws + WS_ROUTE + RT_TILE); const int ntl = TILE[0];
        pg8::Gemm g{WSP(bf16, WS_AMOE), WSP(bf16, WS_WT_MGU), DM}; pg8::MoeOrder S; S.init(ntl, 2 * FF / 256, F.G, (int)blockIdx.x); S.tile_e = TILE + 16; S.estride = (size_t)2 * FF * DM * 2;
        pg8::EpiSwiglu E{WSP(bf16, WS_HMOE), FF}; pg8::gemm_phase<pg8::EpiSwiglu, pg8::MoeOrder, true, true>(F.lds + RING_OFF, g, S, E); if (BOTH(14)) GRID_BAR(); }
    if (IN(15)) { const int* TILE = (const int*)(F.ws + WS_ROUTE + RT_TILE); const int ntl = TILE[0];
        pg8::Gemm g{WSP(bf16, WS_HMOE), WSP(bf16, WS_WT_MDN), FF}; pg8::MoeOrder S; S.init(ntl, DM / 256, F.G, (int)blockIdx.x); S.tile_e = TILE + 16; S.estride = (size_t)DM * FF * 2;
        pg8::EpiBf16 E{WSP(bf16, WS_YMOE), DM}; pg8::gemm_phase<pg8::EpiBf16, pg8::MoeOrder, true, true>(F.lds + RING_OFF, g, S, E); if (BOTH(15)) GRID_BAR(); }
    if (IN(16)) { p16_combine(F); }
#undef IN
#undef BOTH
}

#ifndef MK_ONE_LAUNCH
#define MK_ONE_LAUNCH 1
#endif
extern "C" void kernel_launch(void* const* d_in, const int* in_sizes, int n_in, void* d_out, int out_size, void* d_ws, size_t ws_size, hipStream_t stream) {
    static int grid = 0;
    if (grid == 0) {
        if (n_in != 22 || in_sizes[0] != T * DM || out_size != T * DM || ws_size < WS_END) { fprintf(stderr, "kernel_launch: unexpected shapes (n_in %d, in0 %d, out %d, ws %zu < %zu)\n", n_in, n_in > 0 ? in_sizes[0] : -1, out_size, ws_size, (size_t)WS_END); grid = -1; return; }
        int dev = 0, cus = 0, per_cu = 0;
        if (hipGetDevice(&dev) != hipSuccess || hipDeviceGetAttribute(&cus, hipDeviceAttributeMultiprocessorCount, dev) != hipSuccess) { grid = -1; return; }
        if (hipFuncSetAttribute((const void*)mk_fwd, hipFuncAttributeMaxDynamicSharedMemorySize, LDS_BYTES) != hipSuccess) { fprintf(stderr, "kernel_launch: hipFuncSetAttribute failed\n"); grid = -1; return; }
        if (hipOccupancyMaxActiveBlocksPerMultiprocessor(&per_cu, (const void*)mk_fwd, NWAVES * 64, LDS_BYTES) != hipSuccess || per_cu < 1) { fprintf(stderr, "kernel_launch: occupancy query says %d blocks per CU\n", per_cu); }
        (void)hipGetLastError();
        grid = cus;
    }
    if (grid < 0) return;
    if (hipMemsetAsync((char*)d_ws + WS_CTL, 0, CTL_ZERO_BYTES, stream) != hipSuccess) return;
    Args a{};
    for (int i = 0; i < 22; ++i) a.in[i] = (const float*)d_in[i];
    a.out = (float*)d_out; a.ws = (unsigned char*)d_ws; a.pad = 0;
#if MK_ONE_LAUNCH
    a.ph_lo = 0; a.ph_hi = N_PHASES; a.use_bar = 1;
    hipLaunchKernelGGL(mk_fwd, dim3(grid), dim3(NWAVES * 64), LDS_BYTES, stream, a);
    for (int p = 0; p < N_PHASES; ++p) if ((MK_PROBE_MASK >> p) & 1) { a.ph_lo = p; a.ph_hi = p + 1; a.use_bar = 0; a.pad = MK_PROBE_SUB;
        hipLaunchKernelGGL(mk_fwd, dim3(grid), dim3(NWAVES * 64), LDS_BYTES, stream, a); }
#else
    for (int p = 0; p < N_PHASES; ++p) { a.ph_lo = p; a.ph_hi = p + 1; a.use_bar = 0;
        hipLaunchKernelGGL(mk_fwd, dim3(grid), dim3(NWAVES * 64), LDS_BYTES, stream, a); }
#endif
}
```

```cpp
#include <hip/hip_runtime.h>
#include <cstdio>
#include <cstdint>

namespace pg8 {
#define PG8_LAS __attribute__((address_space(3)))
typedef unsigned short bf16_t;
typedef short bf16x8 __attribute__((ext_vector_type(8)));
typedef float f32x4 __attribute__((ext_vector_type(4)));
typedef unsigned u32x4 __attribute__((ext_vector_type(4)));
constexpr int BM = 256, BK = 64, HALF = 128, HTB = HALF * BK * 2  , STAGE_BYTES = 8 * HTB, NXCD = 8, WGM = 8;

__host__ __device__ __forceinline__ int lds_byte(int r, int c) { const int st = (r >> 4) * 2 + (c >> 5), rr = r & 15, cc = c & 31, ob = rr * 64 + cc * 2; return st * 1024 + (ob ^ (((ob >> 9) & 1) << 5)); }
__host__ __device__ __forceinline__ void stage_rc(int b, int& R, int& C) { const int st = b / 1024, sb = b % 1024, swz = sb ^ (((sb >> 9) & 1) << 5); R = (st >> 1) * 16 + swz / 64; C = (st & 1) * 32 + (swz % 64) / 2; }
__host__ __device__ __forceinline__ int perm32(int rho) { const int n = rho >> 4, i = rho & 15; return 8 * (i >> 2) + 4 * n + (i & 3); }

struct Unit { int pm, pn; };
struct Gemm { const bf16_t* A; const bf16_t* Bt; int K; };

struct StaticOrder {
    int nM, nN, nwg, G, c;
    __device__ void init(int nM_, int nN_, int G_, int c_) { nM = nM_; nN = nN_; nwg = nM * nN; G = G_; c = c_; }
    __device__ bool next(int i, Unit& u) const {
        const long L = (long)i * G + c; if (L >= nwg) return false;
        int wgid = (int)L; { const int q = nwg / NXCD, r = nwg % NXCD, xcd = wgid % NXCD, off = wgid / NXCD; wgid = (xcd < r ? xcd * (q + 1) : r * (q + 1) + (xcd - r) * q) + off; }
        const int nig = WGM * nN, gid = wgid / nig, fm = gid * WGM, gsz = (nM - fm) < WGM ? (nM - fm) : WGM;
        u.pm = fm + ((wgid % nig) % gsz); u.pn = (wgid % nig) / gsz; return true;
    }
    __device__ __forceinline__ const char* a_base(const Gemm& g, const Unit& u) const { return (const char*)g.A + (size_t)u.pm * ((size_t)BM * g.K * 2); }
    __device__ __forceinline__ const char* b_base(const Gemm& g, const Unit& u) const { return (const char*)g.Bt + (size_t)u.pn * ((size_t)BM * g.K * 2); }
    __device__ __forceinline__ void a_ready(const Unit&) const {}
    __device__ __forceinline__ void done(const Unit&) const {}
};
struct MoeOrder : StaticOrder {
    const int* tile_e; size_t estride;
    __device__ __forceinline__ const char* b_base(const Gemm& g, const Unit& u) const { return (const char*)g.Bt + (size_t)tile_e[u.pm] * estride + (size_t)u.pn * ((size_t)BM * g.K * 2); }
};

__device__ __forceinline__ unsigned cvt_pk_bf16(float lo, float hi) { unsigned r; asm volatile("v_cvt_pk_bf16_f32 %0, %1, %2" : "=v"(r) : "v"(lo), "v"(hi)); return r; }

struct EpiBf16 {
    static constexpr bool PERM = true, AFTER_DRAIN = false;
    bf16_t* O; int ldc;
    __device__ __forceinline__ void operator()(const f32x4 (&acc)[2][2][4][2], const Unit& u, int wr, int wc, int fr, int fq) const {
        const int row0 = u.pm * BM + wr * 64 + fr, col0 = u.pn * BM + wc * 32 + 8 * fq;
#pragma unroll
        for (int ai = 0; ai < 2; ++ai)
#pragma unroll
            for (int m = 0; m < 4; ++m) { bf16_t* rowp = O + (size_t)(row0 + ai * HALF + m * 16) * ldc + col0;
#pragma unroll
                for (int bj = 0; bj < 2; ++bj) { const f32x4 v0 = acc[ai][bj][m][0], v1 = acc[ai][bj][m][1];
                    u32x4 w; w.x = cvt_pk_bf16(v0[0], v0[1]); w.y = cvt_pk_bf16(v0[2], v0[3]); w.z = cvt_pk_bf16(v1[0], v1[1]); w.w = cvt_pk_bf16(v1[2], v1[3]);
                    *(u32x4*)(rowp + bj * HALF) = w; } }
    }
};
struct EpiSwiglu {
    static constexpr bool PERM = true, AFTER_DRAIN = false;
    bf16_t* O; int ldc;
    __device__ __forceinline__ void operator()(const f32x4 (&acc)[2][2][4][2], const Unit& u, int wr, int wc, int fr, int fq) const {
        const int row0 = u.pm * BM + wr * 64 + fr, col0 = u.pn * HALF + wc * 32 + 8 * fq;
#pragma unroll
        for (int ai = 0; ai < 2; ++ai)
#pragma unroll
            for (int m = 0; m < 4; ++m) { bf16_t* rowp = O + (size_t)(row0 + ai * HALF + m * 16) * ldc + col0;
                float h[8];
#pragma unroll
                for (int n = 0; n < 2; ++n)
#pragma unroll
                    for (int j = 0; j < 4; ++j) { const float gq = acc[ai][0][m][n][j], uq = acc[ai][1][m][n][j];
                        const float sg = __builtin_amdgcn_rcpf(1.0f + __builtin_amdgcn_exp2f(-1.4426950408889634f * gq));
                        h[n * 4 + j] = gq * sg * uq; }
                u32x4 w; w.x = cvt_pk_bf16(h[0], h[1]); w.y = cvt_pk_bf16(h[2], h[3]); w.z = cvt_pk_bf16(h[4], h[5]); w.w = cvt_pk_bf16(h[6], h[7]);
                *(u32x4*)rowp = w; }
    }
};
struct EpiResF32 {
    static constexpr bool PERM = false, AFTER_DRAIN = false;
    const float* base; float* out; int ldc;
    __device__ __forceinline__ void operator()(const f32x4 (&acc)[2][2][4][2], const Unit& u, int wr, int wc, int fr, int fq) const {
        const int row0 = u.pm * BM + wr * 64 + fr, col0 = u.pn * BM + wc * 32 + 4 * fq;
#pragma unroll
        for (int ai = 0; ai < 2; ++ai)
#pragma unroll
            for (int m = 0; m < 4; ++m) { const size_t off = (size_t)(row0 + ai * HALF + m * 16) * ldc + col0;
#pragma unroll
                for (int bj = 0; bj < 2; ++bj)
#pragma unroll
                    for (int n = 0; n < 2; ++n) { const f32x4 b = *(const f32x4*)(base + off + bj * HALF + n * 16); *(f32x4*)(out + off + bj * HALF + n * 16) = b + acc[ai][bj][m][n]; } }
    }
};
template <class Epi, class Sched, bool ALIGN_EPI = false, bool SP2 = false>
__device__ __forceinline__ void gemm_phase(PG8_LAS unsigned char* lds, const Gemm g, const Sched& S, const Epi& E) {
    int tid = threadIdx.x; asm volatile("" : "+v"(tid));
    const int wid = __builtin_amdgcn_readfirstlane(tid >> 6), lane = tid & 63, wr = wid >> 2, wc = wid & 3, fr = lane & 15, fq = lane >> 4;
    const int K = g.K, nt = K / BK;
    unsigned voffA[2], voffB[2];
#pragma unroll
    for (int i = 0; i < 2; ++i) { int R, C; stage_rc(tid * 16 + i * 8192, R, C); const int Rb = Epi::PERM ? ((R & ~31) + perm32(R & 31)) : R;
        voffA[i] = (unsigned)(R * K + C) * 2u; voffB[i] = (unsigned)(Rb * K + C) * 2u; }
    const size_t kstep = (size_t)(BK * 2);
    const size_t hstep = (size_t)HALF * K * 2;
    const unsigned ldsw = (unsigned)wid * 1024u;
    const int aoff = lds_byte(wr * 64 + fr, fq * 8), boff = lds_byte(wc * 32 + fr, fq * 8);
#define PG8_SA(b, h) (((b) * 2 + (h)) * HTB)
#define PG8_SB(b, h) ((4 + (b) * 2 + (h)) * HTB)
#define PG8_STAGE(bufoff, gbase, voff) do { _Pragma("unroll") for (int _i = 0; _i < 2; ++_i) \
        __builtin_amdgcn_global_load_lds((const unsigned*)((const char*)(gbase) + (voff)[_i]), (PG8_LAS unsigned*)(lds + (bufoff) + ldsw + _i * 8192), 16, 0, 0); } while (0)
#define PG8_LDA(dst, b, h) do { _Pragma("unroll") for (int m = 0; m < 4; ++m) _Pragma("unroll") for (int k = 0; k < 2; ++k) dst[m][k] = *(const PG8_LAS bf16x8*)(lds + PG8_SA(b, h) + aoff + m * 2048 + k * 1024); } while (0)
#define PG8_LDB(dst, b, h) do { _Pragma("unroll") for (int n = 0; n < 2; ++n) _Pragma("unroll") for (int k = 0; k < 2; ++k) dst[n][k] = *(const PG8_LAS bf16x8*)(lds + PG8_SB(b, h) + boff + n * 2048 + k * 1024); } while (0)
#define PG8_MMA(ai, bj, At, Bt) do { __builtin_amdgcn_s_setprio(1); _Pragma("unroll") for (int m = 0; m < 4; ++m) _Pragma("unroll") for (int n = 0; n < 2; ++n) _Pragma("unroll") for (int k = 0; k < 2; ++k) \
        acc[ai][bj][m][n] = __builtin_amdgcn_mfma_f32_16x16x32_bf16(Bt[n][k], At[m][k], acc[ai][bj][m][n], 0, 0, 0); __builtin_amdgcn_s_setprio(0); } while (0)
#define PG8_WAIT_V(n) asm volatile("s_waitcnt vmcnt(" #n ")" ::: "memory")
#define PG8_WAIT_L(n) asm volatile("s_waitcnt lgkmcnt(" #n ")" ::: "memory")
#define PG8_BAR __builtin_amdgcn_s_barrier()
#define PG8_SCHED __builtin_amdgcn_sched_barrier(0)
    Unit cur, nxt; int ui = 0;
    if (!S.next(0, cur)) return;
    f32x4 acc[2][2][4][2];
#pragma unroll
    for (int a = 0; a < 2; ++a)
#pragma unroll
        for (int b = 0; b < 2; ++b)
#pragma unroll
            for (int m = 0; m < 4; ++m)
#pragma unroll
                for (int n = 0; n < 2; ++n) acc[a][b][m][n] = (f32x4){0.f, 0.f, 0.f, 0.f};
    bf16x8 At[4][2], B0[2][2], B1[2][2];
    const char* cA = S.a_base(g, cur); const char* cB = S.b_base(g, cur);
    S.a_ready(cur);
    if constexpr (SP2) {
        PG8_STAGE(PG8_SB(0, 0), cB, voffB); PG8_STAGE(PG8_SB(0, 1), cB + hstep, voffB); PG8_STAGE(PG8_SA(0, 0), cA, voffA); PG8_STAGE(PG8_SA(0, 1), cA + hstep, voffA);
        if (wr == 1) PG8_BAR;
        PG8_WAIT_V(2); PG8_BAR;
        PG8_STAGE(PG8_SB(1, 0), cB + kstep, voffB); PG8_STAGE(PG8_SA(1, 0), cA + kstep, voffA); PG8_STAGE(PG8_SB(1, 1), cB + hstep + kstep, voffB);
        PG8_WAIT_V(6); PG8_BAR;
    } else {
        PG8_STAGE(PG8_SB(0, 0), cB, voffB); PG8_STAGE(PG8_SA(0, 0), cA, voffA); PG8_STAGE(PG8_SB(0, 1), cB + hstep, voffB); PG8_STAGE(PG8_SA(0, 1), cA + hstep, voffA);
        if (wr == 1) PG8_BAR;
        PG8_WAIT_V(4); PG8_BAR;
        PG8_STAGE(PG8_SB(1, 0), cB + kstep, voffB); PG8_STAGE(PG8_SA(1, 0), cA + kstep, voffA); PG8_STAGE(PG8_SB(1, 1), cB + hstep + kstep, voffB);
        PG8_WAIT_V(6); PG8_BAR;
    }
    for (;;) {
        const bool has_next = S.next(ui + 1, nxt);
        const char* nA = has_next ? S.a_base(g, nxt) : cA; const char* nB = has_next ? S.b_base(g, nxt) : cB;
        for (int t = 0; t < nt; t += 2) {
            const bool last = (t == nt - 2);
            const char* a1 = cA + (size_t)(t + 1) * kstep;
            const char* a2 = last ? nA : cA + (size_t)(t + 2) * kstep; const char* b2 = last ? nB : cB + (size_t)(t + 2) * kstep;
            const char* a3 = a2 + kstep; const char* b3 = b2 + kstep;
            if (last && has_next) S.a_ready(nxt);
            if constexpr (SP2) {
            PG8_LDB(B0, 0, 0); PG8_LDB(B1, 0, 1); PG8_SCHED; PG8_LDA(At, 0, 0); PG8_STAGE(PG8_SA(1, 1), a1 + hstep, voffA);
            PG8_WAIT_V(8); PG8_WAIT_L(0); PG8_BAR; PG8_MMA(0, 0, At, B0); PG8_MMA(0, 1, At, B1); PG8_BAR; PG8_SCHED;
            PG8_LDA(At, 0, 1); PG8_STAGE(PG8_SB(0, 0), b2, voffB); PG8_STAGE(PG8_SB(0, 1), b2 + hstep, voffB); PG8_STAGE(PG8_SA(0, 0), a2, voffA);
            PG8_WAIT_V(8); PG8_WAIT_L(0); PG8_BAR; PG8_MMA(1, 0, At, B0); PG8_MMA(1, 1, At, B1); PG8_BAR; PG8_SCHED;
            PG8_LDB(B0, 1, 0); PG8_LDB(B1, 1, 1); PG8_SCHED; PG8_LDA(At, 1, 0); PG8_STAGE(PG8_SA(0, 1), a2 + hstep, voffA);
            PG8_WAIT_V(8); PG8_WAIT_L(0); PG8_BAR; PG8_MMA(0, 0, At, B0); PG8_MMA(0, 1, At, B1); PG8_BAR; PG8_SCHED;
            PG8_LDA(At, 1, 1); PG8_STAGE(PG8_SB(1, 0), b3, voffB); PG8_STAGE(PG8_SB(1, 1), b3 + hstep, voffB); PG8_STAGE(PG8_SA(1, 0), a3, voffA);
            PG8_WAIT_V(8); PG8_WAIT_L(0); PG8_BAR; PG8_MMA(1, 0, At, B0); PG8_MMA(1, 1, At, B1); PG8_BAR; PG8_SCHED;
            } else {
            PG8_LDB(B0, 0, 0); PG8_SCHED; PG8_LDA(At, 0, 0); PG8_STAGE(PG8_SA(1, 1), a1 + hstep, voffA);
            PG8_WAIT_L(8); PG8_BAR; PG8_WAIT_L(0); PG8_MMA(0, 0, At, B0); PG8_BAR; PG8_SCHED;
            PG8_LDB(B1, 0, 1); PG8_STAGE(PG8_SB(0, 0), b2, voffB);
            PG8_BAR; PG8_WAIT_L(0); PG8_MMA(0, 1, At, B1); PG8_BAR;
            PG8_LDA(At, 0, 1); PG8_STAGE(PG8_SA(0, 0), a2, voffA);
            PG8_BAR; PG8_WAIT_L(0); PG8_MMA(1, 0, At, B0); PG8_BAR; PG8_SCHED;
            PG8_STAGE(PG8_SB(0, 1), b2 + hstep, voffB);
            PG8_WAIT_V(6); PG8_BAR; PG8_MMA(1, 1, At, B1); PG8_BAR;
            PG8_LDB(B0, 1, 0); PG8_SCHED; PG8_LDA(At, 1, 0); PG8_STAGE(PG8_SA(0, 1), a2 + hstep, voffA);
            PG8_WAIT_L(8); PG8_BAR; PG8_WAIT_L(0); PG8_MMA(0, 0, At, B0); PG8_BAR; PG8_SCHED;
            PG8_LDB(B1, 1, 1); PG8_STAGE(PG8_SB(1, 0), b3, voffB);
            PG8_BAR; PG8_WAIT_L(0); PG8_MMA(0, 1, At, B1); PG8_BAR;
            PG8_LDA(At, 1, 1); PG8_STAGE(PG8_SA(1, 0), a3, voffA);
            PG8_BAR; PG8_WAIT_L(0); PG8_MMA(1, 0, At, B0); PG8_BAR; PG8_SCHED;
            PG8_STAGE(PG8_SB(1, 1), b3 + hstep, voffB);
            PG8_WAIT_V(6); PG8_BAR; PG8_MMA(1, 1, At, B1); PG8_BAR;
            }
        }
        if constexpr (ALIGN_EPI) { if (wr == 0) PG8_BAR; }
        if constexpr (!Epi::AFTER_DRAIN) { E(acc, cur, wr, wc, fr, fq); S.done(cur); }
        if (!has_next) break;
#pragma unroll
        for (int a = 0; a < 2; ++a)
#pragma unroll
            for (int b = 0; b < 2; ++b)
#pragma unroll
                for (int m = 0; m < 4; ++m)
#pragma unroll
                    for (int n = 0; n < 2; ++n) acc[a][b][m][n] = (f32x4){0.f, 0.f, 0.f, 0.f};
        cur = nxt; cA = nA; cB = nB; ++ui;
        if constexpr (ALIGN_EPI) { if (wr == 1) PG8_BAR; }
    }
    PG8_WAIT_V(0);
    if constexpr (!ALIGN_EPI) { if (wr == 0) PG8_BAR; }
    PG8_BAR;
    if constexpr (Epi::AFTER_DRAIN) { E.fused(acc, cur, wr, wc, fr, fq, lds, wid, lane); S.done(cur); }
#undef PG8_SA
#undef PG8_SB
#undef PG8_STAGE
#undef PG8_LDA
#undef PG8_LDB
#undef PG8_MMA
#undef PG8_WAIT_V
#undef PG8_WAIT_L
#undef PG8_BAR
#undef PG8_SCHED
}
}


constexpr int T = 8192, DM = 2048, HD = 128, NMIX = 12, NMEMH = 4, NG = 3, MEMT = 256, FF = 7168, NE = 8;
constexpr int A_IN_W = 4388, NA = 4608;
constexpr int NB = 5120;
constexpr int CA_Q = 0, CA_KC = 1536, CA_VC = 1920, CA_KS = 2304, CA_VS = 2688, CA_KW = 3072, CA_VW = 3456, CA_QM = 3840, CA_GT = 4352;
constexpr int CB_Q = 0, CB_QM = 1536, CB_K = 2048, CB_V = 3584;
constexpr int NCMP = 511, NCMP_P = 512;
constexpr int MOE_MAXT = 72;
constexpr float EPS = 1e-6f;
constexpr float QSCALE = 0.08838834764831845f;

constexpr size_t MiB = 1u << 20;
constexpr size_t WS_CTL = 0, CTL_ZERO_BYTES = 1 * MiB;
constexpr size_t WS_WT_INA = 2 * MiB;
constexpr size_t WS_WT_MEM = 20 * MiB;
constexpr size_t WS_WT_OUT = 28 * MiB;
constexpr size_t WS_WT_FGU = 44 * MiB;
constexpr size_t WS_WT_FDN = 100 * MiB;
constexpr size_t WS_WT_INB = 128 * MiB;
constexpr size_t WS_WT_MGU = 148 * MiB;
constexpr size_t WS_WT_MDN = 596 * MiB;
constexpr size_t WS_XN = 820 * MiB;
constexpr size_t WS_MEMN = 852 * MiB;
constexpr size_t WS_MKV = 853 * MiB;
constexpr size_t WS_PA = 854 * MiB;
constexpr size_t WS_KCMP = 926 * MiB;
constexpr size_t WS_MIX = 927 * MiB;
constexpr size_t WS_X1 = 959 * MiB;
constexpr size_t WS_X2 = 1023 * MiB;
constexpr size_t WS_X3 = 1087 * MiB;
constexpr size_t WS_HFF = 1151 * MiB;
constexpr size_t WS_PB = 1263 * MiB;
constexpr size_t WS_AMOE = 1343 * MiB;
constexpr size_t WS_HMOE = 1415 * MiB;
constexpr size_t WS_YMOE = 1667 * MiB;
constexpr size_t WS_ROUTE = 1739 * MiB;
constexpr size_t WS_WT_CMP = 1740 * MiB;
constexpr size_t WS_OACC = 1742 * MiB;
constexpr size_t WS_END = 1790 * MiB;
constexpr size_t RT_TOPI = 0;
constexpr size_t RT_TOPW = 65536;
constexpr size_t RT_ROW = 131072;
constexpr size_t RT_HIST = 196608;
constexpr size_t RT_TILE = 204800;
constexpr int CW_TMO = 0, CW_CODE = 1, CW_BAR = 4096;

constexpr int RING_OFF = 0, RING_BYTES = 135168;
constexpr int LDSCTL_OFF = RING_BYTES, MISC_OFF = LDSCTL_OFF + 320;
constexpr int LDS_BYTES = 147456;
static_assert(MISC_OFF + 128 <= LDS_BYTES, "LDS map");
constexpr int NWAVES = 8;

#define GAS __attribute__((address_space(1)))
#define LAS __attribute__((address_space(3)))
typedef unsigned short bf16;
typedef unsigned v4u __attribute__((ext_vector_type(4)));
typedef unsigned v2u __attribute__((ext_vector_type(2)));
typedef float f32x4 __attribute__((ext_vector_type(4)));
typedef GAS unsigned gu32;
#define RLX_AGENT __ATOMIC_RELAXED, __HIP_MEMORY_SCOPE_AGENT
#define LDS_WAIT() asm volatile("s_waitcnt lgkmcnt(0)" ::: "memory")
#define VM_WAIT() asm volatile("s_waitcnt vmcnt(0)" ::: "memory")
__device__ __forceinline__ float bf2f(unsigned b) { return __uint_as_float(b << 16); }
__device__ __forceinline__ unsigned pk2(float lo, float hi) { return pg8::cvt_pk_bf16(lo, hi); }
__device__ __forceinline__ void unpack8(v4u w, float* f) {
    f[0] = __uint_as_float(w.x << 16); f[1] = __uint_as_float(w.x & 0xffff0000u); f[2] = __uint_as_float(w.y << 16); f[3] = __uint_as_float(w.y & 0xffff0000u);
    f[4] = __uint_as_float(w.z << 16); f[5] = __uint_as_float(w.z & 0xffff0000u); f[6] = __uint_as_float(w.w << 16); f[7] = __uint_as_float(w.w & 0xffff0000u); }
__device__ __forceinline__ float wave_sum(float v) {
#pragma unroll
    for (int o = 1; o < 64; o <<= 1) v += __shfl_xor(v, o);
    return v;
}
__device__ __forceinline__ float fast_exp(float x) { return __builtin_amdgcn_exp2f(x * 1.4426950408889634f); }

#define XB_TMO      128
#define XB_XCNT(j)  (256  + 64 * (j))
#define XB_XSUB(j)  (1280 + 64 * (j))
#define XB_XGEN(j)  (2304 + 64 * (j))
#define XB_TOP      3328
#define XB_TOPGEN   3392
#define XCD_BAR_WORDS 3456
#define XB_SPIN_CAP (1u << 18)
__device__ __forceinline__ unsigned xb_ld(unsigned* p)              { return __hip_atomic_load(p, __ATOMIC_RELAXED, __HIP_MEMORY_SCOPE_AGENT); }
__device__ __forceinline__ unsigned xb_add(unsigned* p, unsigned v) { return __hip_atomic_fetch_add(p, v, __ATOMIC_RELAXED, __HIP_MEMORY_SCOPE_AGENT); }
__device__ __forceinline__ unsigned xb_xcc_id() { return (unsigned)__builtin_amdgcn_s_getreg((3 << 11) | 20) & 0xFu; }
#define XB_SPIN(cond, bar) do { unsigned _sp = 0; while (cond) { __builtin_amdgcn_s_sleep(1); \
    if ((++_sp & 255u) == 0u) { if (xb_ld(&(bar)[XB_TMO])) break; if (_sp > XB_SPIN_CAP) { atomicAdd(&(bar)[XB_TMO], 1u); break; } } } } while (0)
struct XcdBarrier { unsigned* bar; unsigned x; volatile LAS unsigned* st; };
__device__ __forceinline__ XcdBarrier xcd_barrier_post(unsigned* bar, volatile LAS unsigned* st) {
    XcdBarrier b; b.bar = bar; b.x = xb_xcc_id(); b.st = st;
    if (threadIdx.x == 0) (void)xb_add(&bar[XB_XCNT(b.x)], 1u);
    return b;
}
__device__ __forceinline__ void xcd_barrier_complete(unsigned* bar, unsigned x, unsigned& nloc, unsigned& nx) {
    const unsigned G = gridDim.x * gridDim.y * gridDim.z;
    unsigned sum, cnt, mine, sp = 0u;
    for (;;) {
        sum = 0u; cnt = 0u; mine = 0u;
#pragma unroll
        for (unsigned j = 0; j < 16; ++j) { const unsigned c = xb_ld(&bar[XB_XCNT(j)]); sum += c; cnt += (c > 0u) ? 1u : 0u; mine = (j == x) ? c : mine; }
        if (sum == G) break;
        __builtin_amdgcn_s_sleep(1);
        if ((++sp & 255u) == 0u) { if (xb_ld(&bar[XB_TMO])) break; if (sp > XB_SPIN_CAP) { atomicAdd(&bar[XB_TMO], 1u); break; } }
    }
    nloc = mine > 0u ? mine : 1u; nx = cnt > 0u ? cnt : 1u;
}
__device__ __forceinline__ void xcd_barrier(const XcdBarrier& b) {
    asm volatile("s_waitcnt vmcnt(0)" ::: "memory");
    __syncthreads();
    if (threadIdx.x == 0) {
        unsigned* bar = b.bar;
        __builtin_amdgcn_s_waitcnt(0);
        unsigned nloc = b.st[0], nx = b.st[1];
        if (nloc == 0u) { xcd_barrier_complete(bar, b.x, nloc, nx); b.st[0] = nloc; b.st[1] = nx; }
        const unsigned old = xb_add(&bar[XB_XSUB(b.x)], 1u);
        const unsigned gen = old / nloc;
        if (old + 1u == (gen + 1u) * nloc) {
            __builtin_amdgcn_fence(__ATOMIC_RELEASE, "agent");
            asm volatile("s_waitcnt vmcnt(0)" ::: "memory");
            const unsigned og = xb_add(&bar[XB_TOP], 1u);
            const unsigned tg = og / nx;
            if (og + 1u == (tg + 1u) * nx) xb_add(&bar[XB_TOPGEN], 1u);
            else XB_SPIN(xb_ld(&bar[XB_TOPGEN]) == tg, bar);
            __builtin_amdgcn_fence(__ATOMIC_ACQUIRE, "agent");
            xb_add(&bar[XB_XGEN(b.x)], 1u);
            asm volatile("s_waitcnt vmcnt(0)" ::: "memory");
        } else {
            XB_SPIN(xb_ld(&bar[XB_XGEN(b.x)]) == gen, bar);
            __builtin_amdgcn_fence(__ATOMIC_ACQUIRE, "agent");
            asm volatile("s_waitcnt vmcnt(0)" ::: "memory");
        }
    }
    __syncthreads();
}

struct Frame {
    LAS unsigned char* lds;
    volatile LAS unsigned* MISC;
    gu32* ctl;
    int tid, wave;
    int vcu, G;
    unsigned char* ws;
    const float* in[22];
    float* out;
};
#define WSP(T_, off) ((T_*)(F.ws + (off)))
__device__ __forceinline__ int lane_of(const Frame& F) { int t = F.tid; asm volatile("" : "+v"(t)); return t & 63; }

constexpr int CV_INA = 0, CV_MEM = CV_INA + 32 * 72, CV_CMP = CV_MEM + 2 * 32 * 16, CV_OUT = CV_CMP + 2 * 64 * 2, CV_FGU = CV_OUT + 2 * 32 * 32, CV_FDN = CV_FGU + 32 * 224,
              CV_INB = CV_FDN + 112 * 32, CV_KVB = CV_INB + 32 * 32, CV_MGU = CV_KVB + 32 * 48, CV_MDN = CV_MGU + 8 * 32 * 224, CV_TOTAL = CV_MDN + 8 * 112 * 32;
struct ConvIt { const float* src; bf16* dst; const float* gain; int K, Nsrc, sc0, n0, k0, nvalid; };
__device__ __forceinline__ void conv_decode(Frame& F, int g, ConvIt& c) {
    int loc, nnb, mode = 0, batch = 0; c.gain = nullptr;
    if (g < CV_MEM) { loc = g - CV_INA; c.src = F.in[5]; c.dst = WSP(bf16, WS_WT_INA); c.gain = F.in[2]; c.K = DM; c.Nsrc = A_IN_W; nnb = NA / 64; mode = 2; }
    else if (g < CV_CMP) { loc = g - CV_MEM; batch = loc / (32 * 16); loc -= batch * 32 * 16; c.src = F.in[13] + (size_t)batch * DM * 1024; c.dst = WSP(bf16, WS_WT_MEM) + (size_t)batch * 1024 * DM; c.gain = F.in[3] + batch * DM; c.K = DM; c.Nsrc = 1024; nnb = 16; }
    else if (g < CV_OUT) { loc = g - CV_CMP; batch = loc / 128; loc -= batch * 128; c.src = F.in[6] + (size_t)batch * 4096 * HD; c.dst = WSP(bf16, WS_WT_CMP) + (size_t)batch * HD * 4096; c.K = 4096; c.Nsrc = HD; nnb = 2; }
    else if (g < CV_FGU) { loc = g - CV_OUT; batch = loc / 1024; loc -= batch * 1024; c.src = F.in[15] + (size_t)batch * DM * DM; c.dst = WSP(bf16, WS_WT_OUT) + (size_t)batch * DM * DM; c.K = DM; c.Nsrc = DM; nnb = 32; }
    else if (g < CV_FDN) { loc = g - CV_FGU; c.src = F.in[16]; c.dst = WSP(bf16, WS_WT_FGU); c.gain = F.in[4]; c.K = DM; c.Nsrc = 2 * FF; nnb = 224; mode = 1; }
    else if (g < CV_INB) { loc = g - CV_FDN; c.src = F.in[17]; c.dst = WSP(bf16, WS_WT_FDN); c.K = FF; c.Nsrc = DM; nnb = 32; }
    else if (g < CV_KVB) { loc = g - CV_INB; c.src = F.in[10]; c.dst = WSP(bf16, WS_WT_INB); c.gain = F.in[2] + DM; c.K = DM; c.Nsrc = DM; nnb = 32; }
    else if (g < CV_MGU) { loc = g - CV_KVB; c.src = F.in[12]; c.dst = WSP(bf16, WS_WT_INB) + (size_t)2048 * DM; c.gain = F.in[11]; c.K = DM; c.Nsrc = 3072; nnb = 48; }
    else if (g < CV_MDN) { loc = g - CV_MGU; batch = loc / 7168; loc -= batch * 7168; c.src = F.in[20] + (size_t)batch * DM * 2 * FF; c.dst = WSP(bf16, WS_WT_MGU) + (size_t)batch * 2 * FF * DM; c.gain = F.in[4] + DM; c.K = DM; c.Nsrc = 2 * FF; nnb = 224; mode = 1; }
    else { loc = g - CV_MDN; batch = loc / 3584; loc -= batch * 3584; c.src = F.in[21] + (size_t)batch * FF * DM; c.dst = WSP(bf16, WS_WT_MDN) + (size_t)batch * DM * FF; c.K = FF; c.Nsrc = DM; nnb = 32; }
    const int kb = loc / nnb, nb = loc - kb * nnb;
    c.k0 = kb * 64; c.n0 = nb * 64; c.nvalid = nnb * 64;
    if (mode == 1) { const int j = c.n0 >> 8, r = c.n0 & 255; c.sc0 = (r < 128) ? 128 * j + r : 7168 + 128 * j + (r - 128); }
    else if (mode == 2) { if (c.n0 < 3840) c.sc0 = c.n0; else if (c.n0 < 4352) c.sc0 = c.n0 + 36; else if (c.n0 < 4416) { c.sc0 = c.n0 - 512; c.nvalid = 4388; } else { c.sc0 = 0; c.nvalid = 0; } }
    else c.sc0 = c.n0;
}
struct ConvRegs { f32x4 v[16]; float gn[8]; };
__device__ __forceinline__ void conv_load(const ConvIt& c, ConvRegs& R, int lane) {
    const int kr = lane >> 4, nc = (lane & 15) * 4;
    const bool ok = (c.n0 + nc) < c.nvalid;
    const int cc = ok ? c.sc0 + nc : 0;
    const float* p = c.src + (size_t)(c.k0 + kr) * c.Nsrc + cc;
#pragma unroll
    for (int i = 0; i < 16; ++i) { const f32x4 t = __builtin_nontemporal_load((const f32x4*)(p + (size_t)(4 * i) * c.Nsrc)); R.v[i] = ok ? t : (f32x4){0.f, 0.f, 0.f, 0.f}; }
    const int c8 = lane & 7;
#pragma unroll
    for (int i = 0; i < 8; ++i) R.gn[i] = c.gain ? c.gain[c.k0 + 8 * c8 + i] : 1.0f;
}
__device__ __forceinline__ void conv_proc(const ConvIt& c, const ConvRegs& R, LAS float* scr, int lane) {
    const int kr = lane >> 4, nc = (lane & 15) * 4;
#pragma unroll
    for (int i = 0; i < 16; ++i) { LAS float* s = scr + (4 * i + kr) * 65 + nc; s[0] = R.v[i][0]; s[1] = R.v[i][1]; s[2] = R.v[i][2]; s[3] = R.v[i][3]; }
    LDS_WAIT(); asm volatile("" ::: "memory");
    const int c8 = lane & 7, nl = lane >> 3;
#pragma unroll
    for (int j = 0; j < 8; ++j) {
        const int n = nl + 8 * j; const LAS float* s = scr + (8 * c8) * 65 + n;
        v4u o; o.x = pk2(s[0 * 65] * R.gn[0], s[1 * 65] * R.gn[1]); o.y = pk2(s[2 * 65] * R.gn[2], s[3 * 65] * R.gn[3]); o.z = pk2(s[4 * 65] * R.gn[4], s[5 * 65] * R.gn[5]); o.w = pk2(s[6 * 65] * R.gn[6], s[7 * 65] * R.gn[7]);
        *(v4u*)(c.dst + (size_t)(c.n0 + n) * c.K + c.k0 + 8 * c8) = o;
    }
    LDS_WAIT(); asm volatile("" ::: "memory");
}
__device__ __forceinline__ void conv_list(Frame& F, int first, int stride, int g_hi) {
    LAS float* scr = (LAS float*)(F.lds + RING_OFF + F.wave * 16640);
    int g = first;
    if (g >= g_hi) return;
    ConvIt cA, cB; ConvRegs RA, RB;
    conv_decode(F, g, cA); conv_load(cA, RA, lane_of(F));
    for (;;) {
        const int g1 = g + stride; const bool h1 = g1 < g_hi;
        if (h1) { conv_decode(F, g1, cB); conv_load(cB, RB, lane_of(F)); }
        asm volatile("" ::: "memory");
        conv_proc(cA, RA, scr, lane_of(F));
        if (!h1) break;
        const int g2 = g1 + stride; const bool h2 = g2 < g_hi;
        if (h2) { conv_decode(F, g2, cA); conv_load(cA, RA, lane_of(F)); }
        asm volatile("" ::: "memory");
        conv_proc(cB, RB, scr, lane_of(F));
        if (!h2) break;
        g = g2;
    }
}
constexpr int CV_DEFER0 = CV_MGU, CV_CHUNK = 32;
constexpr int CW_CVNEXT = 8192, CW_DONE0 = 8192 + 64;
__device__ __forceinline__ bool conv_grab(Frame& F) {
    volatile LAS int* sh = (volatile LAS int*)(F.lds + LDSCTL_OFF + 64);
    if (F.tid == 0) sh[0] = CV_DEFER0 + (int)__hip_atomic_fetch_add((unsigned*)(F.ctl + CW_CVNEXT), (unsigned)CV_CHUNK, __ATOMIC_RELAXED, __HIP_MEMORY_SCOPE_AGENT);
    __syncthreads();
    const int base = sh[0];
    __syncthreads();
    if (base >= CV_TOTAL) return false;
    const int hi = base + CV_CHUNK < CV_TOTAL ? base + CV_CHUNK : CV_TOTAL;
    conv_list(F, base + F.wave, NWAVES, hi);
    return true;
}
__device__ __forceinline__ void idle_fill(Frame& F, int ph) {
    volatile LAS int* sh = (volatile LAS int*)(F.lds + LDSCTL_OFF + 64);
    asm volatile("s_waitcnt vmcnt(0)" ::: "memory");
    __syncthreads();
    if (F.tid == 0) __hip_atomic_fetch_add((unsigned*)(F.ctl + CW_DONE0 + 64 * ph), 1u, __ATOMIC_RELAXED, __HIP_MEMORY_SCOPE_AGENT);
    for (;;) {
        if (F.tid == 0) sh[1] = (__hip_atomic_load((unsigned*)(F.ctl + CW_DONE0 + 64 * ph), __ATOMIC_RELAXED, __HIP_MEMORY_SCOPE_AGENT) >= (unsigned)F.G) ? 1 : 0;
        __syncthreads();
        const int alld = sh[1];
        __syncthreads();
        if (alld) break;
        if (!conv_grab(F)) break;
    }
}
__device__ __forceinline__ void conv_drain(Frame& F) { while (conv_grab(F)) {} }
__device__ __forceinline__ float row_rstd_to_bf16(const float* xrow, bf16* orow, int lane) {
    const f32x4* xr = (const f32x4*)xrow + lane;
    f32x4 v[8]; float s = 0.f;
#pragma unroll
    for (int j = 0; j < 8; ++j) { v[j] = xr[64 * j]; s += (v[j].x * v[j].x + v[j].y * v[j].y) + (v[j].z * v[j].z + v[j].w * v[j].w); }
    const float rstd = 1.0f / sqrtf(wave_sum(s) * (1.f / DM) + EPS);
    v2u* o8 = (v2u*)orow + lane;
#pragma unroll
    for (int j = 0; j < 8; ++j) { v2u w; w.x = pk2(v[j].x * rstd, v[j].y * rstd); w.y = pk2(v[j].z * rstd, v[j].w * rstd); o8[64 * j] = w; }
    return rstd;
}
__device__ __forceinline__ void rmsnorm_rows(Frame& F, const float* X, bf16* XN, int rows) {
    const int gw = F.vcu * NWAVES + F.wave, NGW = F.G * NWAVES;
    for (int m = gw; m < rows; m += NGW) row_rstd_to_bf16(X + (size_t)m * DM, XN + (size_t)m * DM, lane_of(F));
}
__device__ __forceinline__ void p0_prologue(Frame& F) {
    conv_list(F, F.vcu * NWAVES + F.wave, F.G * NWAVES, CV_DEFER0);
    rmsnorm_rows(F, F.in[0], WSP(bf16, WS_XN), T);
    rmsnorm_rows(F, F.in[1], WSP(bf16, WS_MEMN), MEMT);
}

__device__ __forceinline__ void p2_compress(Frame& F) {
    typedef short bf16x8 __attribute__((ext_vector_type(8)));
    const bf16* PA = WSP(bf16, WS_PA); const bf16* WC = WSP(bf16, WS_WT_CMP);
    LAS float* red = (LAS float*)(F.lds + RING_OFF);
    LAS float* posl = red + 16 * 132;
    const int lane = lane_of(F), w = F.wave, fr = lane & 15, fq = lane >> 4;
    for (int i = F.tid; i < 2 * 4096 / 4; i += NWAVES * 64) *(LAS f32x4*)(posl + 4 * i) = *(const f32x4*)(F.in[7] + 4 * i);
    __syncthreads();
    const int nitems = 2 * NG * 32;
    for (int it = F.vcu; it < nitems; it += F.G) {
        const int kv = it / (NG * 32), g = (it / 32) % NG, jt = it % 32;
        const int j = 16 * jt + fr;
        const LAS float* pos = posl + kv * 4096;
        const int col = (kv ? CA_VC : CA_KC) + g * HD;
        const bf16* wrow = WC + ((size_t)kv * HD + 16 * w + fr) * 4096;
        f32x4 acc = {0.f, 0.f, 0.f, 0.f};
        for (int ks0 = 0; ks0 < 128; ks0 += 16) {
            v4u xa[16], wb[16];
#pragma unroll
            for (int u = 0; u < 16; ++u) {
                const int k = 32 * (ks0 + u) + 8 * fq, i = k >> 7, d = k & 127;
                int trow = 16 * j + i; trow = trow < T ? trow : T - 1;
                xa[u] = *(const v4u*)(PA + (size_t)trow * NA + col + d);
                wb[u] = *(const v4u*)(wrow + k);
            }
            asm volatile("" ::: "memory");
#pragma unroll
            for (int u = 0; u < 16; ++u) {
                const int k = 32 * (ks0 + u) + 8 * fq;
                const f32x4 pa = *(const LAS f32x4*)(pos + k), pb = *(const LAS f32x4*)(pos + k + 4);
                float xf[8]; unpack8(xa[u], xf);
                v4u av; av.x = pk2(xf[0] + pa[0], xf[1] + pa[1]); av.y = pk2(xf[2] + pa[2], xf[3] + pa[3]); av.z = pk2(xf[4] + pb[0], xf[5] + pb[1]); av.w = pk2(xf[6] + pb[2], xf[7] + pb[3]);
                acc = __builtin_amdgcn_mfma_f32_16x16x32_bf16(*reinterpret_cast<const bf16x8*>(&av), *reinterpret_cast<const bf16x8*>(&wb[u]), acc, 0, 0, 0);
            }
        }
#pragma unroll
        for (int r = 0; r < 4; ++r) red[(4 * fq + r) * 132 + 16 * w + fr] = acc[r];
        __syncthreads();
        {
            const int row = F.tid >> 5, cp = F.tid & 31, jj = 16 * jt + row;
            float v[4]; float ss = 0.f;
#pragma unroll
            for (int e = 0; e < 4; ++e) { v[e] = red[row * 132 + 4 * cp + e]; ss += v[e] * v[e]; }
            ss += __shfl_xor(ss, 1); ss += __shfl_xor(ss, 2); ss += __shfl_xor(ss, 4); ss += __shfl_xor(ss, 8); ss += __shfl_xor(ss, 16);
            if (kv == 0) { const float rs = 1.0f / sqrtf(ss * (1.f / HD) + EPS); const float* gp = F.in[9] + 4 * cp;
#pragma unroll
                for (int e = 0; e < 4; ++e) v[e] = v[e] * rs * gp[e]; }
            if (jj >= NCMP) {
#pragma unroll
                for (int e = 0; e < 4; ++e) v[e] = 0.f; }
            v2u o; o.x = pk2(v[0], v[1]); o.y = pk2(v[2], v[3]);
            *(v2u*)(WSP(bf16, WS_KCMP) + (size_t)kv * NG * NCMP_P * HD + ((size_t)g * NCMP_P + jj) * HD + 4 * cp) = o;
        }
        __syncthreads();
    }
}
__device__ __forceinline__ void norm_slot(bf16* p, const float* gain, int l16) {
    v4u w = *(const v4u*)(p + l16 * 8); float f[8]; unpack8(w, f);
    float s = 0.f;
#pragma unroll
    for (int e = 0; e < 8; ++e) s += f[e] * f[e];
    s += __shfl_xor(s, 1); s += __shfl_xor(s, 2); s += __shfl_xor(s, 4); s += __shfl_xor(s, 8);
    const float r = 1.0f / sqrtf(s * (1.f / HD) + EPS);
    const float* gp = gain + l16 * 8;
    v4u o; o.x = pk2(f[0] * r * gp[0], f[1] * r * gp[1]); o.y = pk2(f[2] * r * gp[2], f[3] * r * gp[3]); o.z = pk2(f[4] * r * gp[4], f[5] * r * gp[5]); o.w = pk2(f[6] * r * gp[6], f[7] * r * gp[7]);
    *(v4u*)(p + l16 * 8) = o;
}
__device__ __forceinline__ void norm_vals(v4u w, bf16* p, const float* gain, int l16) {
    float f[8]; unpack8(w, f);
    float s = 0.f;
#pragma unroll
    for (int e = 0; e < 8; ++e) s += f[e] * f[e];
    s += __shfl_xor(s, 1); s += __shfl_xor(s, 2); s += __shfl_xor(s, 4); s += __shfl_xor(s, 8);
    const float r = 1.0f / sqrtf(s * (1.f / HD) + EPS);
    const float* gp = gain + l16 * 8;
    v4u o; o.x = pk2(f[0] * r * gp[0], f[1] * r * gp[1]); o.y = pk2(f[2] * r * gp[2], f[3] * r * gp[3]); o.z = pk2(f[4] * r * gp[4], f[5] * r * gp[5]); o.w = pk2(f[6] * r * gp[6], f[7] * r * gp[7]);
    *(v4u*)(p + l16 * 8) = o;
}
__device__ __forceinline__ void p2_qknorm(Frame& F) {
    bf16* PA = WSP(bf16, WS_PA); bf16* MKV = WSP(bf16, WS_MKV);
    const int gs = (F.vcu * NWAVES + F.wave) * 4 + (lane_of(F) >> 4), NS = F.G * NWAVES * 4, l16 = lane_of(F) & 15;
    for (int s0 = gs; s0 < T * 18; s0 += 6 * NS) {
        bf16* ptr[6]; const float* gn[6]; v4u w[6];
#pragma unroll
        for (int u = 0; u < 6; ++u) {
            int s = s0 + u * NS; s = s < T * 18 ? s : gs;
            const int t = s / 18, k = s % 18;
            int col; const float* gain;
            if (k < 12) { col = CA_Q + k * HD; gain = F.in[8]; }
            else if (k < 15) { col = CA_KS + (k - 12) * HD; gain = F.in[9] + HD; }
            else { col = CA_KW + (k - 15) * HD; gain = F.in[9] + 2 * HD; }
            ptr[u] = PA + (size_t)t * NA + col; gn[u] = gain; w[u] = *(const v4u*)(ptr[u] + l16 * 8);
        }
        asm volatile("" ::: "memory");
#pragma unroll
        for (int u = 0; u < 6; ++u) if (s0 + u * NS < T * 18) norm_vals(w[u], ptr[u], gn[u], l16);
    }
    for (int s = gs; s < MEMT * 8; s += NS) {
        const int m = s / 8, k = s % 8, l = k >> 2, h = k & 3;
        norm_slot(MKV + (size_t)m * 2048 + l * 1024 + h * HD, F.in[14] + (size_t)(l * 2 + 1) * HD, l16);
    }
}

__device__ __forceinline__ void ld32(const bf16* p, float* f) {
#pragma unroll
    for (int i = 0; i < 4; ++i) { const v4u w = *(const v4u*)(p + 8 * i); unpack8(w, f + 8 * i); }
}
__device__ __forceinline__ float dot32q(const float* q, const bf16* kp) {
    float kf[32]; ld32(kp, kf); float s = 0.f;
#pragma unroll
    for (int i = 0; i < 32; ++i) s += q[i] * kf[i];
    s += __shfl_xor(s, 1); s += __shfl_xor(s, 2);
    return s;
}
__device__ __forceinline__ void axpy32(float* o, float p, const bf16* vp) {
    float vf[32]; ld32(vp, vf);
#pragma unroll
    for (int i = 0; i < 32; ++i) o[i] += p * vf[i];
}
__device__ __forceinline__ void st32(bf16* p, const float* f) {
#pragma unroll
    for (int i = 0; i < 4; ++i) { v4u w; w.x = pk2(f[8 * i], f[8 * i + 1]); w.y = pk2(f[8 * i + 2], f[8 * i + 3]); w.z = pk2(f[8 * i + 4], f[8 * i + 5]); w.w = pk2(f[8 * i + 6], f[8 * i + 7]); *(v4u*)(p + 8 * i) = w; }
}
#define OSM_STEP(s_, valid_, vptr_) do { if (valid_) { const float mn_ = fmaxf(m, (s_)); const float al_ = fast_exp(m - mn_); const float pp_ = fast_exp((s_) - mn_); \
        l = l * al_ + pp_; _Pragma("unroll") for (int i_ = 0; i_ < 32; ++i_) o[i_] *= al_; axpy32(o, pp_, (vptr_)); m = mn_; } } while (0)

__device__ __forceinline__ void p3_nsa_naive(Frame& F) {
    const bf16* PA = WSP(bf16, WS_PA); const bf16* KC = WSP(bf16, WS_KCMP); const bf16* VC = KC + (size_t)NG * NCMP_P * HD; bf16* MIX = WSP(bf16, WS_MIX);
    LAS float* IMP = (LAS float*)(F.lds + RING_OFF + F.wave * 4096);
    LAS unsigned long long* SELW = (LAS unsigned long long*)(F.lds + RING_OFF + F.wave * 4096 + 2048);
    const int gw = F.vcu * NWAVES + F.wave, NGW = F.G * NWAVES;
    const int dq = lane_of(F) & 3, p = (lane_of(F) >> 2) & 3, ql = lane_of(F) >> 4;
    for (int it = gw; it < NG * (T / 4); it += NGW) {
        const int g = it / (T / 4), tq = it % (T / 4), t = 4 * tq + ql, head = g * 4 + p;
        const float slope = exp2f(-8.0f * (float)(head + 1) / 12.0f);
        float q[32]; ld32(PA + (size_t)t * NA + CA_Q + head * HD + dq * 32, q);
#pragma unroll
        for (int i = 0; i < 32; ++i) q[i] *= QSCALE;
        const float g0 = 1.0f / (1.0f + fast_exp(-bf2f(PA[(size_t)t * NA + CA_GT + head * 3 + 0])));
        const float g1 = 1.0f / (1.0f + fast_exp(-bf2f(PA[(size_t)t * NA + CA_GT + head * 3 + 1])));
        const float g2 = 1.0f / (1.0f + fast_exp(-bf2f(PA[(size_t)t * NA + CA_GT + head * 3 + 2])));
        float otot[32];
#pragma unroll
        for (int i = 0; i < 32; ++i) otot[i] = 0.f;
        for (int i = lane_of(F); i < 512; i += 64) IMP[i] = 0.f;
        LDS_WAIT(); asm volatile("" ::: "memory");
        const int jmax = (t >= 31) ? (t - 31) / 16 : -1;
        const int jmax_w = (4 * tq + 3 >= 31) ? (4 * tq + 3 - 31) / 16 : -1;
        const bf16* kcg = KC + (size_t)g * NCMP_P * HD + dq * 32; const bf16* vcg = VC + (size_t)g * NCMP_P * HD + dq * 32;
        {
            float m = -1e30f, l = 0.f;
            for (int j = 0; j <= jmax_w; ++j) {
                const float s = dot32q(q, kcg + (size_t)j * HD) - slope * (float)(t - (16 * j + 31));
                if (j <= jmax) { const float mn = fmaxf(m, s); l = l * fast_exp(m - mn) + fast_exp(s - mn); m = mn; }
            }
            const float rl = (l > 0.f) ? 1.0f / l : 0.f;
            float o[32];
#pragma unroll
            for (int i = 0; i < 32; ++i) o[i] = 0.f;
            for (int j = 0; j <= jmax_w; ++j) {
                const float s = dot32q(q, kcg + (size_t)j * HD) - slope * (float)(t - (16 * j + 31));
                const float pj = (j <= jmax) ? fast_exp(s - m) * rl : 0.f;
                axpy32(o, pj, vcg + (size_t)j * HD);
                float ps = pj; ps += __shfl_xor(ps, 4); ps += __shfl_xor(ps, 8);
                if (dq == 0 && p == 0) { IMP[ql * 128 + (j >> 2)] += ps; if ((j & 3) == 3 && (j >> 2) + 1 < 128) IMP[ql * 128 + (j >> 2) + 1] += ps; }
            }
#pragma unroll
            for (int i = 0; i < 32; ++i) otot[i] += g0 * o[i];
        }
        LDS_WAIT(); asm volatile("" ::: "memory");
        for (int qq = 0; qq < 4; ++qq) {
            const int tt = 4 * tq + qq, cur = tt >> 6;
            const int b0 = lane_of(F), b1 = lane_of(F) + 64;
            const float s0 = (b0 == cur) ? 2e6f : (b0 == 0 ? 1e6f : (b0 * 64 <= tt ? IMP[qq * 128 + b0] : -1e6f));
            const float s1 = (b1 == cur) ? 2e6f : (b1 * 64 <= tt ? IMP[qq * 128 + b1] : -1e6f);
            int r0 = 0, r1 = 0;
            for (int b = 0; b < 128; ++b) {
                const float sb = (b == cur) ? 2e6f : (b == 0 ? 1e6f : (b * 64 <= tt ? IMP[qq * 128 + b] : -1e6f));
                r0 += (sb > s0 || (sb == s0 && b < b0)) ? 1 : 0;
                r1 += (sb > s1 || (sb == s1 && b < b1)) ? 1 : 0;
            }
            const unsigned long long m0 = __ballot(r0 < 16 && b0 * 64 <= tt), m1 = __ballot(r1 < 16 && b1 * 64 <= tt);
            if (lane_of(F) == 0) { SELW[qq * 2] = m0; SELW[qq * 2 + 1] = m1; }
        }
        LDS_WAIT(); asm volatile("" ::: "memory");
        {
            const unsigned long long my0 = SELW[ql * 2], my1 = SELW[ql * 2 + 1];
            const unsigned long long u0v = SELW[0] | SELW[2] | SELW[4] | SELW[6], u1v = SELW[1] | SELW[3] | SELW[5] | SELW[7];
            const unsigned long long u0 = ((unsigned long long)(unsigned)__builtin_amdgcn_readfirstlane((int)(u0v >> 32)) << 32) | (unsigned)__builtin_amdgcn_readfirstlane((int)(unsigned)u0v);
            const unsigned long long u1 = ((unsigned long long)(unsigned)__builtin_amdgcn_readfirstlane((int)(u1v >> 32)) << 32) | (unsigned)__builtin_amdgcn_readfirstlane((int)(unsigned)u1v);
            float m = -1e30f, l = 0.f, o[32];
#pragma unroll
            for (int i = 0; i < 32; ++i) o[i] = 0.f;
            const bf16* kg = PA + CA_KS + g * HD + dq * 32; const bf16* vg = PA + CA_VS + g * HD + dq * 32;
            for (int b = 0; b < 128; ++b) {
                const bool inu = (b < 64) ? ((u0 >> b) & 1ull) : ((u1 >> (b - 64)) & 1ull);
                if (!inu) continue;
                const bool mine = (b < 64) ? ((my0 >> b) & 1ull) : ((my1 >> (b - 64)) & 1ull);
                for (int k = 0; k < 64; ++k) {
                    const int kp = b * 64 + k;
                    const float s = dot32q(q, kg + (size_t)kp * NA) - slope * (float)(t - kp);
                    const bool valid = mine && kp <= t;
                    OSM_STEP(s, valid, vg + (size_t)kp * NA);
                }
            }
            const float sc = (l > 0.f) ? g1 / l : 0.f;
#pragma unroll
            for (int i = 0; i < 32; ++i) otot[i] += sc * o[i];
        }
        {
            float m = -1e30f, l = 0.f, o[32];
#pragma unroll
            for (int i = 0; i < 32; ++i) o[i] = 0.f;
            const bf16* kg = PA + CA_KW + g * HD + dq * 32; const bf16* vg = PA + CA_VW + g * HD + dq * 32;
            const int klo = (4 * tq - 511 > 0) ? 4 * tq - 511 : 0, khi = 4 * tq + 3;
            for (int kp = klo; kp <= khi; ++kp) {
                const float s = dot32q(q, kg + (size_t)kp * NA) - slope * (float)(t - kp);
                const bool valid = kp <= t && (t - kp) < 512;
                OSM_STEP(s, valid, vg + (size_t)kp * NA);
            }
            const float sc = (l > 0.f) ? g2 / l : 0.f;
#pragma unroll
            for (int i = 0; i < 32; ++i) otot[i] += sc * o[i];
        }
        st32(MIX + (size_t)t * DM + head * HD + dq * 32, otot);
    }
}
__device__ __forceinline__ void mem_attn_naive(Frame& F, const bf16* P, int ldp, int qcol, const float* qg, int layer) {
    const bf16* MKV = WSP(bf16, WS_MKV); bf16* MIX = WSP(bf16, WS_MIX);
    const int gw = F.vcu * NWAVES + F.wave, NGW = F.G * NWAVES;
    const int dq = lane_of(F) & 3, r = lane_of(F) >> 2;
    for (int it = gw; it < NMEMH * (T / 16); it += NGW) {
        const int hm = it / (T / 16), t = 16 * (it % (T / 16)) + r;
        float q[32]; ld32(P + (size_t)t * ldp + qcol + hm * HD + dq * 32, q);
        float ss = 0.f;
#pragma unroll
        for (int i = 0; i < 32; ++i) ss += q[i] * q[i];
        ss += __shfl_xor(ss, 1); ss += __shfl_xor(ss, 2);
        const float rs = (1.0f / sqrtf(ss * (1.f / HD) + EPS)) * QSCALE;
#pragma unroll
        for (int i = 0; i < 32; ++i) q[i] = q[i] * rs * qg[dq * 32 + i];
        float m = -1e30f, l = 0.f, o[32];
#pragma unroll
        for (int i = 0; i < 32; ++i) o[i] = 0.f;
        const bf16* kg = MKV + layer * 1024 + hm * HD + dq * 32; const bf16* vg = kg + 512;
        for (int k = 0; k < MEMT; ++k) {
            const float s = dot32q(q, kg + (size_t)k * 2048);
            OSM_STEP(s, true, vg + (size_t)k * 2048);
        }
        const float sc = 1.0f / l;
#pragma unroll
        for (int i = 0; i < 32; ++i) o[i] *= sc;
        st32(MIX + (size_t)t * DM + NMIX * HD + hm * HD + dq * 32, o);
    }
}
__device__ __forceinline__ void stick_naive(Frame& F) {
    const bf16* PB = WSP(bf16, WS_PB); bf16* MIX = WSP(bf16, WS_MIX);
    const int gw = F.vcu * NWAVES + F.wave, NGW = F.G * NWAVES;
    const int dq = lane_of(F) & 3, r = lane_of(F) >> 2;
    for (int it = gw; it < NMIX * (T / 16); it += NGW) {
        const int h = it / (T / 16), t = 16 * (it % (T / 16)) + r;
        float q[32]; ld32(PB + (size_t)t * NB + CB_Q + h * HD + dq * 32, q);
#pragma unroll
        for (int i = 0; i < 32; ++i) q[i] *= QSCALE;
        float R = 0.f, o[32];
#pragma unroll
        for (int i = 0; i < 32; ++i) o[i] = 0.f;
        const bf16* kg = PB + CB_K + h * HD + dq * 32; const bf16* vg = PB + CB_V + h * HD + dq * 32;
        for (int i = 1; ; ++i) {
            const int s = t - i;
            const bool act = s >= 0 && R > -80.f;
            if (!__any(act)) break;
            const int sc = s >= 0 ? s : 0;
            const float z = dot32q(q, kg + (size_t)sc * NB);
            const float sp = fmaxf(z, 0.f) + __logf(1.0f + fast_exp(-fabsf(z)));
            if (act) { const float a = fast_exp(z - sp + R); axpy32(o, a, vg + (size_t)sc * NB); R -= sp; }
        }
        st32(MIX + (size_t)t * DM + h * HD + dq * 32, o);
    }
}

__device__ __forceinline__ void p12_router(Frame& F) {
    const float* X3 = WSP(float, WS_X3); bf16* XN = WSP(bf16, WS_XN);
    int* TOPI = (int*)(F.ws + WS_ROUTE + RT_TOPI); float* TOPW = (float*)(F.ws + WS_ROUTE + RT_TOPW); int* HIST = (int*)(F.ws + WS_ROUTE + RT_HIST);
    const float* rw = F.in[18]; const float* rb = F.in[19]; const float* gn = F.in[4] + DM;
    LAS int* hist = (LAS int*)(F.lds + RING_OFF);
    for (int c = F.vcu; c < 256; c += F.G) {
        if (F.tid < 8) hist[F.tid] = 0;
        __syncthreads();
        for (int i = 0; i < 4; ++i) {
            const int t = 32 * c + 4 * F.wave + i;
            const f32x4* xr = (const f32x4*)(X3 + (size_t)t * DM) + lane_of(F);
            f32x4 v[8]; float s = 0.f;
#pragma unroll
            for (int j = 0; j < 8; ++j) { v[j] = xr[64 * j]; s += (v[j].x * v[j].x + v[j].y * v[j].y) + (v[j].z * v[j].z + v[j].w * v[j].w); }
            const float rstd = 1.0f / sqrtf(wave_sum(s) * (1.f / DM) + EPS);
            v2u* o8 = (v2u*)(XN + (size_t)t * DM) + lane_of(F);
            float lg[8];
#pragma unroll
            for (int e = 0; e < 8; ++e) lg[e] = 0.f;
#pragma unroll
            for (int j = 0; j < 8; ++j) {
                v2u w; w.x = pk2(v[j].x * rstd, v[j].y * rstd); w.y = pk2(v[j].z * rstd, v[j].w * rstd); o8[64 * j] = w;
                const int k0 = 4 * (lane_of(F) + 64 * j);
#pragma unroll
                for (int e4 = 0; e4 < 4; ++e4) {
                    const float xg = v[j][e4] * gn[k0 + e4];
                    const f32x4 ra = *(const f32x4*)(rw + (size_t)(k0 + e4) * 8), rb4 = *(const f32x4*)(rw + (size_t)(k0 + e4) * 8 + 4);
                    lg[0] += xg * ra.x; lg[1] += xg * ra.y; lg[2] += xg * ra.z; lg[3] += xg * ra.w; lg[4] += xg * rb4.x; lg[5] += xg * rb4.y; lg[6] += xg * rb4.z; lg[7] += xg * rb4.w;
                }
            }
#pragma unroll
            for (int e = 0; e < 8; ++e) lg[e] = wave_sum(lg[e]) * rstd;
            if (lane_of(F) == 0) {
                int i0 = 0; float b0 = lg[0] + rb[0];
#pragma unroll
                for (int e = 1; e < 8; ++e) { const float b = lg[e] + rb[e]; if (b > b0) { b0 = b; i0 = e; } }
                int i1 = -1; float b1 = -3.0e38f;
#pragma unroll
                for (int e = 0; e < 8; ++e) { const float b = lg[e] + rb[e]; if (e != i0 && b > b1) { b1 = b; i1 = e; } }
                float l0 = 0.f, l1 = 0.f;
#pragma unroll
                for (int e = 0; e < 8; ++e) { l0 = (e == i0) ? lg[e] : l0; l1 = (e == i1) ? lg[e] : l1; }
                const float w0 = 1.0f / (1.0f + expf(l1 - l0));
                TOPI[2 * t] = i0; TOPI[2 * t + 1] = i1; TOPW[2 * t] = w0; TOPW[2 * t + 1] = 1.0f - w0;
                atomicAdd((int*)&hist[i0], 1); atomicAdd((int*)&hist[i1], 1);
            }
        }
        __syncthreads();
        if (F.tid < 8) HIST[c * 8 + F.tid] = hist[F.tid];
        __syncthreads();
    }
}
__device__ __forceinline__ void p13_assign(Frame& F) {
    const bf16* XN = WSP(bf16, WS_XN); bf16* AM = WSP(bf16, WS_AMOE);
    const int* TOPI = (const int*)(F.ws + WS_ROUTE + RT_TOPI); int* ROW = (int*)(F.ws + WS_ROUTE + RT_ROW); const int* HIST = (const int*)(F.ws + WS_ROUTE + RT_HIST);
    int* TILE = (int*)(F.ws + WS_ROUTE + RT_TILE);
    LAS int* sh = (LAS int*)(F.lds + RING_OFF);
    for (int c = F.vcu; c < 256; c += F.G) {
        if (F.tid < 16) sh[16 + F.tid] = 0;
        __syncthreads();
        for (int i = F.tid; i < 2048; i += 512) { const int v = HIST[i], cc = i >> 3, ee = i & 7;
            __hip_atomic_fetch_add(&sh[16 + ee], v, __ATOMIC_RELAXED, __HIP_MEMORY_SCOPE_WORKGROUP);
            if (cc < c) __hip_atomic_fetch_add(&sh[24 + ee], v, __ATOMIC_RELAXED, __HIP_MEMORY_SCOPE_WORKGROUP); }
        __syncthreads();
        if (F.tid < 8) {
            const int e = F.tid; int off = 0;
            for (int ee = 0; ee < 8; ++ee) { if (ee == e) break; off += (sh[16 + ee] + 255) & ~255; }
            sh[e] = off + sh[24 + e];
            if (c == 0 && e == 0) {
                int nt = 0;
                for (int ee = 0; ee < 8; ++ee) { const int n = (sh[16 + ee] + 255) >> 8; for (int i = 0; i < n; ++i) TILE[16 + nt + i] = ee; nt += n; }
                TILE[0] = nt;
            }
        }
        __syncthreads();
        if (F.wave == 0) {
            const int tl = lane_of(F) >> 1, sl = lane_of(F) & 1, t = 32 * c + tl;
            const int e = TOPI[2 * t + sl];
            int row = 0;
            for (int ee = 0; ee < 8; ++ee) {
                const unsigned long long mk = __ballot(e == ee);
                if (e == ee) row = sh[ee] + __popcll(mk & ((1ull << lane_of(F)) - 1ull));
            }
            ROW[2 * t + sl] = row; sh[64 + lane_of(F)] = row;
        }
        __syncthreads();
        for (int i = 0; i < 8; ++i) {
            const int idx = 8 * F.wave + i, t = 32 * c + (idx >> 1), row = sh[64 + idx];
            const v4u* src = (const v4u*)(XN + (size_t)t * DM); v4u* dst = (v4u*)(AM + (size_t)row * DM);
#pragma unroll
            for (int j = 0; j < 4; ++j) dst[lane_of(F) + 64 * j] = src[lane_of(F) + 64 * j];
        }
        __syncthreads();
    }
}
__device__ __forceinline__ void p16_combine(Frame& F) {
    const float* X3 = WSP(float, WS_X3); const bf16* Y = WSP(bf16, WS_YMOE);
    const int* ROW = (const int*)(F.ws + WS_ROUTE + RT_ROW); const float* TOPW = (const float*)(F.ws + WS_ROUTE + RT_TOPW);
    const int gw = F.vcu * NWAVES + F.wave, NGW = F.G * NWAVES;
    for (int t = gw; t < T; t += NGW) {
        const int r0 = ROW[2 * t], r1 = ROW[2 * t + 1]; const float w0 = TOPW[2 * t], w1 = TOPW[2 * t + 1];
        const v4u* y0 = (const v4u*)(Y + (size_t)r0 * DM); const v4u* y1 = (const v4u*)(Y + (size_t)r1 * DM);
        const f32x4* xr = (const f32x4*)(X3 + (size_t)t * DM); f32x4* orow = (f32x4*)(F.out + (size_t)t * DM);
#pragma unroll
        for (int j = 0; j < 4; ++j) {
            const int c8 = lane_of(F) + 64 * j;
            float a[8], b[8]; unpack8(y0[c8], a); unpack8(y1[c8], b);
            const f32x4 xa = xr[2 * c8], xb = xr[2 * c8 + 1];
            orow[2 * c8] = (f32x4){xa.x + w0 * a[0] + w1 * b[0], xa.y + w0 * a[1] + w1 * b[1], xa.z + w0 * a[2] + w1 * b[2], xa.w + w0 * a[3] + w1 * b[3]};
            orow[2 * c8 + 1] = (f32x4){xb.x + w0 * a[4] + w1 * b[4], xb.y + w0 * a[5] + w1 * b[5], xb.z + w0 * a[6] + w1 * b[6], xb.w + w0 * a[7] + w1 * b[7]};
        }
    }
}

namespace at {
typedef short bf16x8 __attribute__((ext_vector_type(8)));
typedef short s16x4 __attribute__((ext_vector_type(4)));
typedef float f32x16 __attribute__((ext_vector_type(16)));
constexpr int SHM_T = 16384;
constexpr int L_V = 0, L_K = 2 * SHM_T, L_WS = 4 * SHM_T, L_IMP = L_WS + 8 * 256, L_SEL = L_IMP + 64 * 128 * 4, L_PS = L_SEL + 1024, L_WU = L_PS + 8 * 2176, L_LIST = L_WU + 128, L_DONE = L_LIST + 512, L_END = L_DONE + 64;
static_assert(L_END <= RING_BYTES, "attention LDS map");
constexpr float C2 = 0.08838834764831845f * 1.4426950408889634f;
constexpr float LOG2E = 1.4426950408889634f;

#define KSWZ(row, colB) ((row) * 256 + ((colB) ^ (((row) & 7) << 4)))
#define SBAR() __builtin_amdgcn_sched_barrier(0)
__device__ __forceinline__ int v_st(int k, int c) { const int kk = (k & ~0xC) | ((k & 4) << 1) | ((k & 8) >> 1); return ((kk >> 3) * 4 + (c >> 5)) * 512 + ((kk & 7) * 32 + (c & 31)) * 2; }
__device__ __forceinline__ int v_rd_base(int lane) { return ((lane & 3) << 3) | (((lane >> 2) & 3) << 6) | (((lane >> 4) & 1) << 5) | (((lane >> 5) & 1) << 8); }
constexpr int v_rd_off(int d0, int ks, int half) { return d0 * 512 + ks * 4096 + half * 2048; }
__device__ __forceinline__ int crow(int r, int hi) { return (r & 3) + 8 * (r >> 2) + 4 * hi; }
__device__ __forceinline__ unsigned cvtpk(float lo, float hi) { unsigned r; asm volatile("v_cvt_pk_bf16_f32 %0, %1, %2" : "=v"(r) : "v"(lo), "v"(hi)); return r; }
__device__ __forceinline__ float xhalf_max(float v) { auto rr = __builtin_amdgcn_permlane32_swap(__float_as_uint(v), __float_as_uint(v), false, false); return fmaxf(__uint_as_float(rr[0]), __uint_as_float(rr[1])); }
__device__ __forceinline__ float xhalf_sum(float v) { auto rr = __builtin_amdgcn_permlane32_swap(__float_as_uint(v), __float_as_uint(v), false, false); return __uint_as_float(rr[0]) + __uint_as_float(rr[1]); }
__device__ __forceinline__ float quad_sum(float x) {
    x += __int_as_float(__builtin_amdgcn_update_dpp(0, __float_as_int(x), 0xB1, 0xF, 0xF, true));
    x += __int_as_float(__builtin_amdgcn_update_dpp(0, __float_as_int(x), 0x4E, 0xF, 0xF, true));
    return x;
}
__device__ __forceinline__ void pack_p(const f32x16& p0, const f32x16& p1, bf16x8& pa0, bf16x8& pa1, bf16x8& pa2, bf16x8& pa3) {
#define PK4(P, B_, OUT) do { unsigned a0 = cvtpk(P[B_+0], P[B_+1]), a1 = cvtpk(P[B_+2], P[B_+3]);                          \
        unsigned b0 = cvtpk(P[B_+4], P[B_+5]), b1 = cvtpk(P[B_+6], P[B_+7]);                                             \
        auto r0 = __builtin_amdgcn_permlane32_swap(a0, b0, false, false); auto r1 = __builtin_amdgcn_permlane32_swap(a1, b1, false, false); \
        v4u w = {r0[0], r1[0], r0[1], r1[1]}; OUT = *reinterpret_cast<bf16x8*>(&w); } while (0)
    PK4(p0, 0, pa0); PK4(p0, 8, pa1); PK4(p1, 0, pa2); PK4(p1, 8, pa3);
#undef PK4
}
template <int KB>
__device__ __forceinline__ void qkt(f32x16& p0, f32x16& p1, LAS unsigned char* lds, int r32, int hi, const bf16x8* qr) {
    p0 = f32x16{}; p1 = f32x16{};
    LAS unsigned char* kb[4];
#pragma unroll
    for (int dd = 0; dd < 4; ++dd) kb[dd] = lds + L_K + KB * SHM_T + KSWZ(r32, (dd * 16 + hi * 8) * 2);
#pragma unroll
    for (int d0 = 0; d0 < 8; ++d0) { LAS unsigned char* a = kb[d0 & 3] + (d0 >> 2) * 128;
        const bf16x8 b0 = *(const LAS bf16x8*)a;
        const bf16x8 b1 = *(const LAS bf16x8*)(a + 32 * 256);
        p0 = __builtin_amdgcn_mfma_f32_32x32x16_bf16(b0, qr[d0], p0, 0, 0, 0);
        p1 = __builtin_amdgcn_mfma_f32_32x32x16_bf16(b1, qr[d0], p1, 0, 0, 0); }
}
template <int VB>
__device__ __forceinline__ void pv_tile(f32x16* o, int vb0, bf16x8 pa0, bf16x8 pa1, bf16x8 pa2, bf16x8 pa3) {
#define TRRD(dst, off) asm volatile("ds_read_b64_tr_b16 %0, %1 offset:%2" : "=&v"(dst) : "v"(vb0), "i"(off) : "memory")
#define PV_D0(d0) do { s16x4 l0, l1, l2, l3, h0, h1, h2, h3; constexpr int b_ = VB * SHM_T + v_rd_off(d0, 0, 0); \
        TRRD(l0, b_); TRRD(h0, b_ + 2048); TRRD(l1, b_ + 4096); TRRD(h1, b_ + 6144); TRRD(l2, b_ + 8192); TRRD(h2, b_ + 10240); TRRD(l3, b_ + 12288); TRRD(h3, b_ + 14336); \
        asm volatile("s_waitcnt lgkmcnt(0)" ::: "memory"); SBAR();   \
        o[d0] = __builtin_amdgcn_mfma_f32_32x32x16_bf16(pa0, (bf16x8){l0[0], l0[1], l0[2], l0[3], h0[0], h0[1], h0[2], h0[3]}, o[d0], 0, 0, 0);   \
        o[d0] = __builtin_amdgcn_mfma_f32_32x32x16_bf16(pa1, (bf16x8){l1[0], l1[1], l1[2], l1[3], h1[0], h1[1], h1[2], h1[3]}, o[d0], 0, 0, 0);   \
        o[d0] = __builtin_amdgcn_mfma_f32_32x32x16_bf16(pa2, (bf16x8){l2[0], l2[1], l2[2], l2[3], h2[0], h2[1], h2[2], h2[3]}, o[d0], 0, 0, 0);   \
        o[d0] = __builtin_amdgcn_mfma_f32_32x32x16_bf16(pa3, (bf16x8){l3[0], l3[1], l3[2], l3[3], h3[0], h3[1], h3[2], h3[3]}, o[d0], 0, 0, 0); } while (0)
    PV_D0(0); PV_D0(1); PV_D0(2); PV_D0(3);
#undef PV_D0
#undef TRRD
}
struct Stg { v4u a, b; };
struct Tile { const bf16* K; const bf16* V; size_t ld; };
__device__ __forceinline__ void stg_load(Stg& S, const bf16* base, size_t ld, int sr, int sc) {
    S.a = *(const v4u*)(base + (size_t)sr * ld + sc); S.b = *(const v4u*)(base + (size_t)(32 + sr) * ld + sc);
}
template <int BUF> __device__ __forceinline__ void stg_write_k(const Stg& S, LAS unsigned char* lds, int sr, int sc) {
    const int kws = KSWZ(sr, sc * 2);
    *(LAS v4u*)(lds + L_K + BUF * SHM_T + kws) = S.a; *(LAS v4u*)(lds + L_K + BUF * SHM_T + kws + 32 * 256) = S.b;
}
template <int BUF> __device__ __forceinline__ void stg_write_v(const Stg& S, LAS unsigned char* lds, int sr, int sc) {
    *(LAS v4u*)(lds + L_V + BUF * SHM_T + v_st(sr, sc)) = S.a; *(LAS v4u*)(lds + L_V + BUF * SHM_T + v_st(32 + sr, sc)) = S.b;
}

template <int PASS, int KB, class Br>
__device__ __forceinline__ void step(Br& br, int i, Stg& S, LAS unsigned char* lds, int tid, const bf16x8* qr, float& m2, float& l, float f, f32x16* o) {
    int tz = tid; asm volatile("" : "+v"(tz));
    const int lane = tz & 63, sr = tz >> 4, sc = (tz & 15) * 8, r32 = lane & 31, hi = lane >> 5;
    const int vb0 = (int)(uintptr_t)(lds + L_V) + v_rd_base(lane);
    const bool more = (i + 1 < br.nt);
    Tile nx = br.tile(more ? i + 1 : i);
    if (more) stg_load(S, nx.K, nx.ld, sr, sc);
    SBAR();
    if (br.act(i)) {
        f32x16 p0, p1;
        qkt<KB>(p0, p1, lds, r32, hi, qr);
        SBAR();
        br.scores(p0, p1, i, lane);
        if (PASS == 1) {
            float pmax = p0[0];
#pragma unroll
            for (int r = 1; r < 16; ++r) pmax = fmaxf(pmax, p0[r]);
#pragma unroll
            for (int r = 0; r < 16; ++r) pmax = fmaxf(pmax, p1[r]);
            pmax = xhalf_max(pmax);
            const float mn = fmaxf(m2, pmax);
            float ps = 0.f;
#pragma unroll
            for (int r = 0; r < 16; ++r) ps += __builtin_amdgcn_exp2f(p0[r] - mn) + __builtin_amdgcn_exp2f(p1[r] - mn);
            ps = xhalf_sum(ps);
            l = l * __builtin_amdgcn_exp2f(m2 - mn) + ps; m2 = mn;
        } else {
            if (PASS == 2) {
#pragma unroll
                for (int r = 0; r < 16; ++r) { p0[r] = __builtin_amdgcn_exp2f(p0[r] - m2) * f; p1[r] = __builtin_amdgcn_exp2f(p1[r] - m2) * f; }
                br.hook(p0, p1, i, lane);
            } else {
                float ps = 0.f;
#pragma unroll
                for (int r = 0; r < 16; ++r) { p0[r] = __builtin_amdgcn_exp2f(p0[r] - m2); p1[r] = __builtin_amdgcn_exp2f(p1[r] - m2); ps += p0[r] + p1[r]; }
                l += xhalf_sum(ps);
            }
            SBAR();
            if (more) { stg_write_k<KB ^ 1>(S, lds, sr, sc); SBAR(); stg_load(S, nx.V, nx.ld, sr, sc); SBAR(); }
            bf16x8 pa0, pa1, pa2, pa3; pack_p(p0, p1, pa0, pa1, pa2, pa3);
            SBAR();
            pv_tile<KB>(o, vb0, pa0, pa1, pa2, pa3);
            SBAR();
            if (more) stg_write_v<KB ^ 1>(S, lds, sr, sc);
        }
    } else if (PASS >= 2) { if (more) { stg_write_k<KB ^ 1>(S, lds, sr, sc); SBAR(); stg_load(S, nx.V, nx.ld, sr, sc); SBAR(); stg_write_v<KB ^ 1>(S, lds, sr, sc); } }
    SBAR();
    if (PASS == 1) { if (more) stg_write_k<KB ^ 1>(S, lds, sr, sc); }
    __syncthreads();
}
template <int PASS, class Br>
__device__ __forceinline__ void run_pass(Br& br, LAS unsigned char* lds, int tid, const bf16x8* qr, float& m2, float& l, float f, f32x16* o) {
    if (br.nt <= 0) return;
    const int sr = tid >> 4, sc = (tid & 15) * 8;
    Stg S;
    { const Tile t0 = br.tile(0); stg_load(S, t0.K, t0.ld, sr, sc); stg_write_k<0>(S, lds, sr, sc);
      if (PASS >= 2) { stg_load(S, t0.V, t0.ld, sr, sc); stg_write_v<0>(S, lds, sr, sc); } }
    __syncthreads();
    for (int i = 0; i < br.nt; i += 2) {
        step<PASS, 0>(br, i, S, lds, tid, qr, m2, l, f, o);
        if (i + 1 < br.nt) step<PASS, 1>(br, i + 1, S, lds, tid, qr, m2, l, f, o);
    }
}
__device__ __forceinline__ void scale_rows(f32x16* o, float frow, LAS float* ws, int lane) {
    const int r32 = lane & 31, hi = lane >> 5;
    if (hi == 0) ws[r32] = frow;
    LDS_WAIT(); asm volatile("" ::: "memory");
#pragma unroll
    for (int r = 0; r < 16; ++r) { const float a = ws[crow(r, hi)];
#pragma unroll
        for (int d0 = 0; d0 < 4; ++d0) o[d0][r] *= a; }
    LDS_WAIT(); asm volatile("" ::: "memory");
}
__device__ __forceinline__ float gain_absmax(const float* g, int lane) {
    float a = fmaxf(fabsf(g[lane]), fabsf(g[lane + 64]));
#pragma unroll
    for (int o = 1; o < 64; o <<= 1) a = fmaxf(a, __shfl_xor(a, o));
    return __uint_as_float((unsigned)__builtin_amdgcn_readfirstlane((int)__float_as_uint(a)));
}
__device__ __forceinline__ void o_store(const f32x16* o, float* blk, int lane) {
#pragma unroll
    for (int d0 = 0; d0 < 4; ++d0) {
        float* b = blk + d0 * 1024 + lane; asm volatile("" : "+v"(b));
#pragma unroll
        for (int r = 0; r < 16; ++r) b[r * 64] = o[d0][r];
    }
}
__device__ __forceinline__ void o_addload(f32x16* o, const float* blk, int lane) {
#pragma unroll
    for (int d0 = 0; d0 < 4; ++d0) {
        const float* b = blk + d0 * 1024 + lane; asm volatile("" : "+v"(b));
#pragma unroll
        for (int r = 0; r < 16; ++r) o[d0][r] += b[r * 64];
        asm volatile("" : "+v"(o[d0]) :: "memory");
    }
}
__device__ __forceinline__ void load_q(bf16x8* qr, const bf16* qrow, int hi) {
#pragma unroll
    for (int d0 = 0; d0 < 8; ++d0) { const v4u w = *(const v4u*)(qrow + d0 * 16 + hi * 8); qr[d0] = *reinterpret_cast<const bf16x8*>(&w); }
}

struct RowNsa { int t; float slope2; };
struct BrCmp {
    int nt; const bf16* K; const bf16* V; int jmax_w; RowNsa R;
    LAS float* ps; LAS float* imp;
    __device__ __forceinline__ Tile tile(int i) const { return Tile{K + (size_t)i * 64 * HD, V + (size_t)i * 64 * HD, (size_t)HD}; }
    __device__ __forceinline__ bool act(int i) const { return 64 * i <= jmax_w; }
    __device__ __forceinline__ void scores(f32x16& p0, f32x16& p1, int i, int lane) const {
        const float NEG = -__builtin_inff(); const int hi = lane >> 5;
        float sl = R.slope2; asm volatile("" : "+v"(sl));
        int tt = R.t; asm volatile("" : "+v"(tt));
        const int jmax = (tt >= 31) ? ((tt - 31) >> 4) : -1;
        const int jm = jmax - 64 * i - 4 * hi;
        const float b0 = -sl * (float)(tt - 31 - 16 * (64 * i + 4 * hi));
#pragma unroll
        for (int r = 0; r < 16; ++r) { const int c = (r & 3) + 8 * (r >> 2);
            p0[r] = (c <= jm) ? fmaf(p0[r], C2, fmaf(sl, (float)(16 * c), b0)) : NEG;
            p1[r] = (c + 32 <= jm) ? fmaf(p1[r], C2, fmaf(sl, (float)(16 * c + 512), b0)) : NEG; }
    }
    __device__ __forceinline__ void hook(const f32x16& p0, const f32x16& p1, int i, int lane) const {
        const int r32 = lane & 31, hi = lane >> 5, pp = r32 & 3, ql = r32 >> 2;
#pragma unroll
        for (int qd = 0; qd < 4; ++qd) {
            f32x4 a, b;
#pragma unroll
            for (int e = 0; e < 4; ++e) { a[e] = quad_sum(p0[4 * qd + e]); b[e] = quad_sum(p1[4 * qd + e]); }
            if (pp == qd) { *(LAS f32x4*)(ps + ql * 68 + 4 + 8 * qd + 4 * hi) = a; *(LAS f32x4*)(ps + ql * 68 + 4 + 32 + 8 * qd + 4 * hi) = b; }
        }
        LDS_WAIT(); asm volatile("" ::: "memory");
#pragma unroll
        for (int h2 = 0; h2 < 2; ++h2) { const int idx = lane + 64 * h2, q8 = idx >> 4, mq = idx & 15;
            const f32x4 v = *(const LAS f32x4*)(ps + q8 * 68 + 4 + 4 * mq); const float pv = ps[q8 * 68 + 3 + 4 * mq];
            imp[q8 * 128 + 16 * i + mq] = (v[0] + v[1]) + (v[2] + v[3]) + pv; }
        LDS_WAIT(); asm volatile("" ::: "memory");
        if (lane < 8) ps[lane * 68 + 3] = ps[lane * 68 + 4 + 63];
        LDS_WAIT(); asm volatile("" ::: "memory");
    }
};
struct BrSlc {
    int nt; const bf16* K; const bf16* V; RowNsa R;
    const LAS int* list; const LAS unsigned long long* sel; const LAS unsigned long long* wu;
    __device__ __forceinline__ int blk(int i) const { return list[i]; }
    __device__ __forceinline__ Tile tile(int i) const { const int b = __builtin_amdgcn_readfirstlane(blk(i)); return Tile{K + (size_t)b * 64 * NA, V + (size_t)b * 64 * NA, (size_t)NA}; }
    __device__ __forceinline__ bool act(int i) const { const int b = __builtin_amdgcn_readfirstlane(blk(i)); const unsigned long long u = wu[b >> 6]; return (u >> (b & 63)) & 1ull; }
    __device__ __forceinline__ void scores(f32x16& p0, f32x16& p1, int i, int lane) const {
        const float NEG = -__builtin_inff(); const int b = __builtin_amdgcn_readfirstlane(blk(i)); const int hi = lane >> 5, ql = (lane & 31) >> 2;
        const unsigned long long mm = sel[ql * 2 + (b >> 6)];
        const bool mine = (mm >> (b & 63)) & 1ull;
        float sl = R.slope2; asm volatile("" : "+v"(sl));
        int tt = R.t; asm volatile("" : "+v"(tt));
        const int dm = mine ? (tt - 64 * b - 4 * hi) : -1;
        const float b0 = -sl * (float)dm;
#pragma unroll
        for (int r = 0; r < 16; ++r) { const int c = (r & 3) + 8 * (r >> 2);
            p0[r] = (c <= dm) ? fmaf(p0[r], C2, fmaf(sl, (float)c, b0)) : NEG;
            p1[r] = (c + 32 <= dm) ? fmaf(p1[r], C2, fmaf(sl, (float)(c + 32), b0)) : NEG; }
    }
    __device__ __forceinline__ void hook(const f32x16&, const f32x16&, int, int) const {}
};
struct BrWin {
    int nt; const bf16* K; const bf16* V; RowNsa R; int kb0;
    __device__ __forceinline__ Tile tile(int i) const { return Tile{K + (size_t)(kb0 + i) * 64 * NA, V + (size_t)(kb0 + i) * 64 * NA, (size_t)NA}; }
    __device__ __forceinline__ bool act(int) const { return true; }
    __device__ __forceinline__ void scores(f32x16& p0, f32x16& p1, int i, int lane) const {
        const float NEG = -__builtin_inff(); const int hi = lane >> 5;
        float sl = R.slope2; asm volatile("" : "+v"(sl));
        int tt = R.t; asm volatile("" : "+v"(tt));
        const int dm = tt - 64 * (kb0 + i) - 4 * hi;
        const float b0 = -sl * (float)dm;
#pragma unroll
        for (int r = 0; r < 16; ++r) { const int c = (r & 3) + 8 * (r >> 2);
            p0[r] = ((unsigned)(dm - c) < 512u) ? fmaf(p0[r], C2, fmaf(sl, (float)c, b0)) : NEG;
            p1[r] = ((unsigned)(dm - c - 32) < 512u) ? fmaf(p1[r], C2, fmaf(sl, (float)(c + 32), b0)) : NEG; }
    }
    __device__ __forceinline__ void hook(const f32x16&, const f32x16&, int, int) const {}
};
struct BrMem {
    int nt; const bf16* K; const bf16* V;
    __device__ __forceinline__ Tile tile(int i) const { return Tile{K + (size_t)i * 64 * 2048, V + (size_t)i * 64 * 2048, (size_t)2048}; }
    __device__ __forceinline__ bool act(int) const { return true; }
    __device__ __forceinline__ void scores(f32x16& p0, f32x16& p1, int, int) const {
#pragma unroll
        for (int r = 0; r < 16; ++r) { p0[r] *= C2; p1[r] *= C2; }
    }
    __device__ __forceinline__ void hook(const f32x16&, const f32x16&, int, int) const {}
};
template <class RP> __device__ __forceinline__ void store_o(const f32x16* o, int lane, RP rowptr) {
    const int r32 = lane & 31, hi = lane >> 5;
#pragma unroll
    for (int r = 0; r < 16; ++r) { bf16* rp = rowptr(crow(r, hi));
#pragma unroll
        for (int d0 = 0; d0 < 4; ++d0) { const float v = o[d0][r]; const float vn = __shfl_xor(v, 1);
            if ((r32 & 1) == 0) *(unsigned*)(rp + d0 * 32 + r32) = cvtpk(v, vn); } }
}
}

__device__ __forceinline__ void topk_select(unsigned k0, unsigned k1, int need, int lane, unsigned long long& s0, unsigned long long& s1) {
    unsigned thr = 0u;
    for (int bit = 31; bit >= 0; --bit) {
        const unsigned cand = thr | (1u << bit);
        const int cnt = __popcll(__ballot(k0 >= cand)) + __popcll(__ballot(k1 >= cand));
        if (cnt >= need) thr = cand;
    }
    const unsigned long long g0 = __ballot(k0 > thr), g1 = __ballot(k1 > thr), e0 = __ballot(k0 == thr && thr != 0u), e1 = __ballot(k1 == thr && thr != 0u);
    const int rem = need - (__popcll(g0) + __popcll(g1));
    const unsigned long long lt = (1ull << lane) - 1ull;
    const bool t0 = (k0 == thr && thr != 0u) && (__popcll(e0 & lt) < rem);
    const bool t1 = (k1 == thr && thr != 0u) && (__popcll(e0) + __popcll(e1 & lt) < rem);
    s0 = g0 | __ballot(t0); s1 = g1 | __ballot(t1);
}

__device__ __forceinline__ void nsa_item(Frame& F, int g, int qb, float mb_slc, float mb_win) {
    using namespace at;
    LAS unsigned char* lds = F.lds + RING_OFF;
    const bf16* PA = WSP(bf16, WS_PA); const bf16* KC = WSP(bf16, WS_KCMP) + (size_t)g * NCMP_P * HD; const bf16* VC = KC + (size_t)NG * NCMP_P * HD; bf16* MIX = WSP(bf16, WS_MIX);
    int tz = F.tid; asm volatile("" : "+v"(tz));
    const int lane = tz & 63, w = F.wave, r32 = lane & 31, hi = lane >> 5;
    const int t0 = 64 * qb, tw = t0 + 8 * w, ql = r32 >> 2, pp = r32 & 3, t = tw + ql, head = 4 * g + pp;
    LAS float* ws = (LAS float*)(lds + L_WS + w * 256);
    LAS float* IMP = (LAS float*)(lds + L_IMP) + w * 8 * 128;
    LAS float* PS = (LAS float*)(lds + L_PS + w * 2176);
    LAS unsigned long long* SEL = (LAS unsigned long long*)(lds + L_SEL);
    LAS unsigned long long* WU = (LAS unsigned long long*)(lds + L_WU);
    LAS int* LIST = (LAS int*)(lds + L_LIST);
    float* oacc = WSP(float, WS_OACC) + ((size_t)((g * 128 + qb) * 8 + w)) * 4096;
    RowNsa R; R.t = t; R.slope2 = exp2f(-8.0f * (float)(head + 1) / 12.0f) * LOG2E;
    bf16x8 qr[8]; load_q(qr, PA + (size_t)t * NA + CA_Q + head * HD, hi);
#define GATE(br_) (1.0f / (1.0f + fast_exp(-bf2f(PA[(size_t)t * NA + CA_GT + head * 3 + (br_)]))))
    f32x16 o[4] = {};
    for (int i = lane; i < 8 * 128; i += 64) IMP[i] = 0.f;
    if (lane < 8) PS[lane * 68 + 3] = 0.f;
    LDS_WAIT(); asm volatile("" ::: "memory");
    {
        BrCmp br; br.K = KC; br.V = VC; br.R = R; br.ps = PS; br.imp = IMP;
        br.jmax_w = (tw + 7 >= 31) ? (tw + 7 - 31) / 16 : -1;
        const int jmax_b = (t0 + 63 - 31) / 16;
        br.nt = jmax_b / 64 + 1;
        float m2 = -1e30f, l = 0.f;
        run_pass<1>(br, lds, tz, qr, m2, l, 0.f, o);
        const float f = (l > 0.f) ? 1.0f / l : 0.f;
        run_pass<2>(br, lds, tz, qr, m2, l, f, o);
        scale_rows(o, GATE(0), ws, lane);
        o_store(o, oacc, lane);
#pragma unroll
        for (int d0 = 0; d0 < 4; ++d0) o[d0] = f32x16{};
    }
    for (int qq = 0; qq < 8; ++qq) {
        const int tt = tw + qq, cur = tt >> 6;
        const int b0 = lane, b1 = lane + 64;
        unsigned long long s0 = 0ull, s1 = 0ull;
        const int ncand = cur - 1;
        const bool c0 = (b0 >= 1 && b0 < cur), c1 = (b1 < cur);
        if (ncand <= 14) { s0 = __ballot(c0); s1 = __ballot(c1); }
        else {
            const unsigned k0 = c0 ? (__float_as_uint(IMP[qq * 128 + b0]) + 1u) : 0u, k1 = c1 ? (__float_as_uint(IMP[qq * 128 + b1]) + 1u) : 0u;
            topk_select(k0, k1, 14, lane, s0, s1);
        }
        s0 |= 1ull;
        if (cur < 64) s0 |= (1ull << cur); else s1 |= (1ull << (cur - 64));
        if (lane == 0) { SEL[(8 * w + qq) * 2] = s0; SEL[(8 * w + qq) * 2 + 1] = s1; }
    }
    LDS_WAIT(); asm volatile("" ::: "memory");
    unsigned long long wu0 = 0ull, wu1 = 0ull;
#pragma unroll
    for (int qq = 0; qq < 8; ++qq) { wu0 |= SEL[(8 * w + qq) * 2]; wu1 |= SEL[(8 * w + qq) * 2 + 1]; }
    if (lane == 0) { WU[2 * w] = wu0; WU[2 * w + 1] = wu1; }
    __syncthreads();
    int nsl = 0;
    {
        unsigned long long u0 = 0ull, u1 = 0ull;
#pragma unroll
        for (int ww = 0; ww < 8; ++ww) { u0 |= WU[2 * ww]; u1 |= WU[2 * ww + 1]; }
        nsl = __popcll(u0) + __popcll(u1);
        if (w == 0) {
            const unsigned long long lt = (1ull << lane) - 1ull;
            if ((u0 >> lane) & 1ull) LIST[__popcll(u0 & lt)] = lane;
            if ((u1 >> lane) & 1ull) LIST[__popcll(u0) + __popcll(u1 & lt)] = lane + 64;
        }
    }
    __syncthreads();
    {
        BrSlc br; br.K = PA + CA_KS + g * HD; br.V = PA + CA_VS + g * HD; br.R = R; br.list = LIST; br.nt = nsl;
        br.sel = SEL + 16 * w; br.wu = WU + 2 * w;
        float m2 = mb_slc, l = 0.f;
        run_pass<3>(br, lds, tz, qr, m2, l, 0.f, o);
        scale_rows(o, (l > 0.f) ? GATE(1) / l : 0.f, ws, lane);
        o_addload(o, oacc, lane); o_store(o, oacc, lane);
#pragma unroll
        for (int d0 = 0; d0 < 4; ++d0) o[d0] = f32x16{};
    }
    {
        BrWin br; br.K = PA + CA_KW + g * HD; br.V = PA + CA_VW + g * HD; br.R = R;
        br.kb0 = (t0 - 511 > 0) ? ((t0 - 511) >> 6) : 0; br.nt = qb - br.kb0 + 1;
        float m2 = mb_win, l = 0.f;
        run_pass<3>(br, lds, tz, qr, m2, l, 0.f, o);
        scale_rows(o, (l > 0.f) ? GATE(2) / l : 0.f, ws, lane);
        o_addload(o, oacc, lane);
    }
    store_o(o, lane, [&](int row) { return MIX + (size_t)(tw + (row >> 2)) * DM + (4 * g + (row & 3)) * HD; });
#undef GATE
}
__device__ __forceinline__ void mem_item(Frame& F, const bf16* P, int ldp, int qcol, const float* qg, int layer, int hm, int qb, float mb_mem) {
    using namespace at;
    LAS unsigned char* lds = F.lds + RING_OFF;
    const bf16* MKV = WSP(bf16, WS_MKV); bf16* MIX = WSP(bf16, WS_MIX);
    int tz = F.tid; asm volatile("" : "+v"(tz));
    const int lane = tz & 63, w = F.wave, r32 = lane & 31, hi = lane >> 5;
    const int tw = 256 * qb + 32 * w, t = tw + r32;
    bf16x8 qr[8];
    {
        const bf16* qrow = P + (size_t)t * ldp + qcol + hm * HD;
        float qf[64]; float ss = 0.f;
#pragma unroll
        for (int d0 = 0; d0 < 8; ++d0) { const v4u wv = *(const v4u*)(qrow + d0 * 16 + hi * 8); unpack8(wv, qf + 8 * d0); }
#pragma unroll
        for (int i = 0; i < 64; ++i) ss += qf[i] * qf[i];
        ss = xhalf_sum(ss);
        const float rs = 1.0f / sqrtf(ss * (1.f / HD) + EPS);
#pragma unroll
        for (int d0 = 0; d0 < 8; ++d0) { const float* gp = qg + d0 * 16 + hi * 8;
            v4u wv; wv.x = cvtpk(qf[8 * d0] * rs * gp[0], qf[8 * d0 + 1] * rs * gp[1]); wv.y = cvtpk(qf[8 * d0 + 2] * rs * gp[2], qf[8 * d0 + 3] * rs * gp[3]);
            wv.z = cvtpk(qf[8 * d0 + 4] * rs * gp[4], qf[8 * d0 + 5] * rs * gp[5]); wv.w = cvtpk(qf[8 * d0 + 6] * rs * gp[6], qf[8 * d0 + 7] * rs * gp[7]);
            qr[d0] = *reinterpret_cast<const bf16x8*>(&wv); }
    }
    f32x16 o[4] = {};
    BrMem br; br.nt = 4; br.K = MKV + layer * 1024 + hm * HD; br.V = br.K + 512;
    float m2 = mb_mem, l = 0.f;
    run_pass<3>(br, lds, tz, qr, m2, l, 0.f, o);
    scale_rows(o, 1.0f / l, (LAS float*)(lds + L_WS + w * 256), lane);
    store_o(o, lane, [&](int row) { return MIX + (size_t)(tw + row) * DM + NMIX * HD + hm * HD; });
}
__device__ __forceinline__ void p3_attn(Frame& F) {
    const int ln = lane_of(F);
    using at::gain_absmax; using at::C2;
    const float gq = gain_absmax(F.in[8], ln);
    const float mb_slc = 128.f * C2 * 1.01f * gq * gain_absmax(F.in[9] + HD, ln), mb_win = 128.f * C2 * 1.01f * gq * gain_absmax(F.in[9] + 2 * HD, ln);
    const float mb_mem = 128.f * C2 * 1.01f * gain_absmax(F.in[14], ln) * gain_absmax(F.in[14] + HD, ln);
    for (int it = F.vcu; it < 384 + 128; it += F.G) {
        if (it < 384) { const int g = it % 3, qb = 127 - it / 3; nsa_item(F, g, qb, mb_slc, mb_win); }
        else { const int j = it - 384; mem_item(F, WSP(bf16, WS_PA), NA, CA_QM, F.in[14], 0, j & 3, j >> 2, mb_mem); }
        __syncthreads();
    }
}

__device__ __forceinline__ void stick_tile(at::f32x16& p0, at::f32x16& p1, int k0, int t, int hi, float& R2) {
    using namespace at;
    float L0[16], L1[16];
    const float NEG = -__builtin_inff();
#pragma unroll
    for (int r = 0; r < 16; ++r) {
        const int kk = k0 + crow(r, hi);
        { const float z = p0[r] * C2; const float sp = fmaxf(z, 0.f) + __builtin_amdgcn_logf(1.0f + __builtin_amdgcn_exp2f(-fabsf(z))); const bool v = kk < t; L0[r] = v ? -sp : 0.f; p0[r] = v ? z - sp : NEG; }
        { const float z = p1[r] * C2; const float sp = fmaxf(z, 0.f) + __builtin_amdgcn_logf(1.0f + __builtin_amdgcn_exp2f(-fabsf(z))); const bool v = kk + 32 < t; L1[r] = v ? -sp : 0.f; p1[r] = v ? z - sp : NEG; }
    }
    float ct[8], pt[8];
#pragma unroll
    for (int c = 0; c < 4; ++c) { ct[c] = (L0[4 * c] + L0[4 * c + 1]) + (L0[4 * c + 2] + L0[4 * c + 3]); ct[4 + c] = (L1[4 * c] + L1[4 * c + 1]) + (L1[4 * c + 2] + L1[4 * c + 3]); }
#pragma unroll
    for (int c = 0; c < 8; ++c) { auto rr = __builtin_amdgcn_permlane32_swap(__float_as_uint(ct[c]), __float_as_uint(ct[c]), false, false); pt[c] = __uint_as_float(hi ? rr[0] : rr[1]); }
    float E[8]; float run = 0.f;
#pragma unroll
    for (int c = 7; c >= 0; --c) { E[c] = run + (hi == 0 ? pt[c] : 0.f); run += ct[c] + pt[c]; }
#pragma unroll
    for (int c = 0; c < 4; ++c) {
        { const float a3 = R2 + E[c], a2 = a3 + L0[4 * c + 3], a1 = a2 + L0[4 * c + 2], a0 = a1 + L0[4 * c + 1];
          p0[4 * c + 3] = __builtin_amdgcn_exp2f(p0[4 * c + 3] + a3); p0[4 * c + 2] = __builtin_amdgcn_exp2f(p0[4 * c + 2] + a2); p0[4 * c + 1] = __builtin_amdgcn_exp2f(p0[4 * c + 1] + a1); p0[4 * c] = __builtin_amdgcn_exp2f(p0[4 * c] + a0); }
        { const float a3 = R2 + E[4 + c], a2 = a3 + L1[4 * c + 3], a1 = a2 + L1[4 * c + 2], a0 = a1 + L1[4 * c + 1];
          p1[4 * c + 3] = __builtin_amdgcn_exp2f(p1[4 * c + 3] + a3); p1[4 * c + 2] = __builtin_amdgcn_exp2f(p1[4 * c + 2] + a2); p1[4 * c + 1] = __builtin_amdgcn_exp2f(p1[4 * c + 1] + a1); p1[4 * c] = __builtin_amdgcn_exp2f(p1[4 * c] + a0); }
    }
    R2 += run;
}
template <int KB>
__device__ __forceinline__ bool stick_step(int kb, int kb_w, at::Stg& S, LAS unsigned char* lds, int tid, const bf16* Kh, const bf16* Vh, const at::bf16x8* qr, at::f32x16* o, int tw, float& R2, LAS int* DONE) {
    using namespace at;
    int tz = tid; asm volatile("" : "+v"(tz));
    const int lane = tz & 63, w = __builtin_amdgcn_readfirstlane(tz >> 6), r32 = lane & 31, hi = lane >> 5, sr = tz >> 4, sc = (tz & 15) * 8;
    const int vb0 = (int)(uintptr_t)(lds + L_V) + v_rd_base(lane);
    int t = tw + r32; asm volatile("" : "+v"(t));
    const float THR2 = -100.f;
    const bool more = kb > 0;
    const bf16* Kn = Kh + (size_t)(more ? kb - 1 : kb) * 64 * NB; const bf16* Vn = Vh + (size_t)(more ? kb - 1 : kb) * 64 * NB;
    if (more) stg_load(S, Kn, NB, sr, sc);
    SBAR();
    bool wdone = false, kdone = false;
    if (kb <= kb_w) {
        if (__any(R2 > THR2)) {
            f32x16 p0, p1; qkt<KB>(p0, p1, lds, r32, hi, qr);
            SBAR();
            stick_tile(p0, p1, 64 * kb, t, hi, R2);
            SBAR();
            if (more) { stg_write_k<KB ^ 1>(S, lds, sr, sc); SBAR(); stg_load(S, Vn, NB, sr, sc); SBAR(); } kdone = true;
            bf16x8 pa0, pa1, pa2, pa3; pack_p(p0, p1, pa0, pa1, pa2, pa3);
            SBAR();
            pv_tile<KB>(o, vb0, pa0, pa1, pa2, pa3);
            SBAR();
        }
        wdone = !__any(R2 > THR2);
    }
    if (lane == 0) DONE[(kb & 1) * 8 + w] = wdone ? 1 : 0;
    if (more) { if (!kdone) { stg_write_k<KB ^ 1>(S, lds, sr, sc); SBAR(); stg_load(S, Vn, NB, sr, sc); SBAR(); } stg_write_v<KB ^ 1>(S, lds, sr, sc); }
    __syncthreads();
    int alld = 1;
#pragma unroll
    for (int ww = 0; ww < 8; ++ww) alld &= DONE[(kb & 1) * 8 + ww];
    return more && !alld;
}
__device__ __forceinline__ void stick_item(Frame& F, int h, int qb) {
    using namespace at;
    LAS unsigned char* lds = F.lds + RING_OFF;
    const bf16* PB = WSP(bf16, WS_PB); bf16* MIX = WSP(bf16, WS_MIX);
    int tid = F.tid; asm volatile("" : "+v"(tid));
    const int lane = tid & 63, w = F.wave, r32 = lane & 31, hi = lane >> 5, sr = tid >> 4, sc = (tid & 15) * 8;
    const int q0 = 256 * qb, tw = q0 + 32 * w, t = tw + r32;
    LAS int* DONE = (LAS int*)(lds + L_DONE);
    bf16x8 qr[8]; load_q(qr, PB + (size_t)t * NB + CB_Q + h * HD, hi);
    f32x16 o[4] = {};
    const bf16* Kh = PB + CB_K + h * HD; const bf16* Vh = PB + CB_V + h * HD;
    const int kb_hi = q0 / 64 + 3, kb_w = q0 / 64 + (w >> 1);
    float R2 = 0.f;
    Stg S;
    stg_load(S, Kh + (size_t)kb_hi * 64 * NB, NB, sr, sc); stg_write_k<0>(S, lds, sr, sc);
    stg_load(S, Vh + (size_t)kb_hi * 64 * NB, NB, sr, sc); stg_write_v<0>(S, lds, sr, sc);
    __syncthreads();
    for (int kb = kb_hi; ; kb -= 2) {
        if (!stick_step<0>(kb, kb_w, S, lds, tid, Kh, Vh, qr, o, tw, R2, DONE)) break;
        if (!stick_step<1>(kb - 1, kb_w, S, lds, tid, Kh, Vh, qr, o, tw, R2, DONE)) break;
    }
    store_o(o, lane, [&](int row) { return MIX + (size_t)(tw + row) * DM + h * HD; });
}
__device__ __forceinline__ void p10_attn(Frame& F) {
    const int ln = lane_of(F);
    const float mb_mem = 128.f * at::C2 * 1.01f * at::gain_absmax(F.in[14] + 2 * HD, ln) * at::gain_absmax(F.in[14] + 3 * HD, ln);
    for (int it = F.vcu; it < 384 + 128; it += F.G) {
        if (it < 384) { const int h = it % 12, qb = 31 - it / 12; stick_item(F, h, qb); }
        else { const int j = it - 384; mem_item(F, WSP(bf16, WS_PB), NB, CB_QM, F.in[14] + 2 * HD, 1, j & 3, j >> 2, mb_mem); }
        __syncthreads();
    }
}

constexpr int N_PHASES = 17;
#ifndef MK_PROBE_SUB
#define MK_PROBE_SUB 0
#endif
#ifndef MK_PROBE_MASK
#define MK_PROBE_MASK 0
#endif
#ifndef MK_NAIVE_P3
#define MK_NAIVE_P3 0
#endif
#ifndef MK_NAIVE_P10
#define MK_NAIVE_P10 0
#endif
struct Args { const float* in[22]; float* out; unsigned char* ws; int ph_lo, ph_hi, use_bar, pad; };
__global__ void __launch_bounds__(NWAVES * 64, 2) mk_fwd(Args args) {
    extern __shared__ __attribute__((aligned(16))) unsigned char lds[];
    Frame F;
    F.lds = (LAS unsigned char*)lds;
    F.MISC = (volatile LAS unsigned*)(F.lds + MISC_OFF);
    F.tid = threadIdx.x;  F.wave = __builtin_amdgcn_readfirstlane(F.tid >> 6);
    F.G = gridDim.x; { const int bx = blockIdx.x; F.vcu = (F.G % 8 == 0) ? (bx % 8) * (F.G / 8) + bx / 8 : bx; }
    F.ws = args.ws; F.ctl = (gu32*)(args.ws + WS_CTL); F.out = args.out;
#pragma unroll
    for (int i = 0; i < 22; ++i) F.in[i] = args.in[i];
    for (int u = F.tid; u < (LDS_BYTES - LDSCTL_OFF) / 4; u += NWAVES * 64) ((LAS unsigned*)(F.lds + LDSCTL_OFF))[u] = 0u;
    __syncthreads();
    XcdBarrier bar; bar.bar = (unsigned*)(F.ctl + CW_BAR); bar.x = 0; bar.st = nullptr;
    if (args.use_bar) bar = xcd_barrier_post((unsigned*)(F.ctl + CW_BAR), F.MISC + 8);
#define GRID_BAR() do { if (args.use_bar) xcd_barrier(bar); F.tid = threadIdx.x; asm volatile("" : "+v"(F.tid));  } while (0)
    const int lo = args.ph_lo, hi = args.ph_hi;
#ifdef MK_ONLY_PHASE
#define IN(k) ((k) == MK_ONLY_PHASE && lo <= (k) && (k) < hi)
#else
#define IN(k) (lo <= (k) && (k) < hi)
#endif
#define BOTH(k) (IN(k) && IN((k) + 1))
    typedef pg8::StaticOrder SO;

    if (IN(0)) { p0_prologue(F); if (!args.use_bar) conv_list(F, CV_DEFER0 + F.vcu * NWAVES + F.wave, F.G * NWAVES, CV_TOTAL); if (BOTH(0)) GRID_BAR(); }
    if (IN(1)) {
        { pg8::Gemm g{WSP(bf16, WS_XN), WSP(bf16, WS_WT_INA), DM}; SO S; S.init(T / 256, NA / 256, F.G, (int)blockIdx.x);
          pg8::EpiBf16 E{WSP(bf16, WS_PA), NA}; pg8::gemm_phase<pg8::EpiBf16, SO, true, true>(F.lds + RING_OFF, g, S, E); }
        { pg8::Gemm g{WSP(bf16, WS_MEMN), WSP(bf16, WS_WT_MEM), DM}; SO S; S.init(1, 8, F.G, (int)(F.G - 1 - blockIdx.x));
          pg8::EpiBf16 E{WSP(bf16, WS_MKV), 2048}; pg8::gemm_phase<pg8::EpiBf16, SO, true, true>(F.lds + RING_OFF, g, S, E); }
        if (args.use_bar) idle_fill(F, 1);
        if (BOTH(1)) GRID_BAR();
    }
    if (IN(2)) { if (args.pad != 2) p2_compress(F); if (args.pad != 1) p2_qknorm(F); if (args.use_bar) idle_fill(F, 2); if (BOTH(2)) GRID_BAR(); }
#if MK_NAIVE_P3
    if (IN(3)) { p3_nsa_naive(F); mem_attn_naive(F, WSP(bf16, WS_PA), NA, CA_QM, F.in[14], 0); if (BOTH(3)) GRID_BAR(); }
#else
    if (IN(3)) { p3_attn(F); if (args.use_bar) idle_fill(F, 3); if (BOTH(3)) GRID_BAR(); }
#endif
    if (IN(4)) { pg8::Gemm g{WSP(bf16, WS_MIX), WSP(bf16, WS_WT_OUT), DM}; SO S; S.init(T / 256, DM / 256, F.G, (int)blockIdx.x);
        pg8::EpiResF32 E{F.in[0], WSP(float, WS_X1), DM}; pg8::gemm_phase<pg8::EpiResF32, SO, true, true>(F.lds + RING_OFF, g, S, E); if (BOTH(4)) GRID_BAR(); }
    if (IN(5)) { rmsnorm_rows(F, WSP(float, WS_X1), WSP(bf16, WS_XN), T); if (BOTH(5)) GRID_BAR(); }
    if (IN(6)) { pg8::Gemm g{WSP(bf16, WS_XN), WSP(bf16, WS_WT_FGU), DM}; SO S; S.init(T / 256, 2 * FF / 256, F.G, (int)blockIdx.x);
        pg8::EpiSwiglu E{WSP(bf16, WS_HFF), FF}; pg8::gemm_phase<pg8::EpiSwiglu, SO, true, true>(F.lds + RING_OFF, g, S, E); if (BOTH(6)) GRID_BAR(); }
    if (IN(7)) { pg8::Gemm g{WSP(bf16, WS_HFF), WSP(bf16, WS_WT_FDN), FF}; SO S; S.init(T / 256, DM / 256, F.G, (int)blockIdx.x);
        pg8::EpiResF32 E{WSP(float, WS_X1), WSP(float, WS_X2), DM}; pg8::gemm_phase<pg8::EpiResF32, SO, true, true>(F.lds + RING_OFF, g, S, E); if (BOTH(7)) GRID_BAR(); }
    if (IN(8)) { rmsnorm_rows(F, WSP(float, WS_X2), WSP(bf16, WS_XN), T); if (BOTH(8)) GRID_BAR(); }
    if (IN(9)) { pg8::Gemm g{WSP(bf16, WS_XN), WSP(bf16, WS_WT_INB), DM}; SO S; S.init(T / 256, NB / 256, F.G, (int)blockIdx.x);
        pg8::EpiBf16 E{WSP(bf16, WS_PB), NB}; pg8::gemm_phase<pg8::EpiBf16, SO, true, true>(F.lds + RING_OFF, g, S, E); if (args.use_bar) idle_fill(F, 9); if (BOTH(9)) GRID_BAR(); }
#if MK_NAIVE_P10
    if (IN(10)) { stick_naive(F); mem_attn_naive(F, WSP(bf16, WS_PB), NB, CB_QM, F.in[14] + 2 * HD, 1); if (BOTH(10)) GRID_BAR(); }
#else
    if (IN(10)) { p10_attn(F); if (args.use_bar) idle_fill(F, 10); if (BOTH(10)) GRID_BAR(); }
#endif
    if (IN(11)) { pg8::Gemm g{WSP(bf16, WS_MIX), WSP(bf16, WS_WT_OUT) + (size_t)DM * DM, DM}; SO S; S.init(T / 256, DM / 256, F.G, (int)blockIdx.x);
        pg8::EpiResF32 E{WSP(float, WS_X2), WSP(float, WS_X3), DM}; pg8::gemm_phase<pg8::EpiResF32, SO, true, true>(F.lds + RING_OFF, g, S, E); if (BOTH(11)) GRID_BAR(); }
    if (IN(12)) { p12_router(F); if (BOTH(12)) GRID_BAR(); }
    if (IN(13)) { p13_assign(F); if (args.use_bar) conv_drain(F); if (BOTH(13)) GRID_BAR(); }
    if (IN(14)) { const int* TILE = (const int*)(F.ws + WS_ROUTE + RT_TILE); const int ntl = TILE[0];
        pg8::Gemm g{WSP(bf16, WS_AMOE), WSP(bf16, WS_WT_MGU), DM}; pg8::MoeOrder S; S.init(ntl, 2 * FF / 256, F.G, (int)blockIdx.x); S.tile_e = TILE + 16; S.estride = (size_t)2 * FF * DM * 2;
        pg8::EpiSwiglu E{WSP(bf16, WS_HMOE), FF}; pg8::gemm_phase<pg8::EpiSwiglu, pg8::MoeOrder, true, true>(F.lds + RING_OFF, g, S, E); if (BOTH(14)) GRID_BAR(); }
    if (IN(15)) { const int* TILE = (const int*)(F.ws + WS_ROUTE + RT_TILE); const int ntl = TILE[0];
        pg8::Gemm g{WSP(bf16, WS_HMOE), WSP(bf16, WS_WT_MDN), FF}; pg8::MoeOrder S; S.init(ntl, DM / 256, F.G, (int)blockIdx.x); S.tile_e = TILE + 16; S.estride = (size_t)DM * FF * 2;
        pg8::EpiBf16 E{WSP(bf16, WS_YMOE), DM}; pg8::gemm_phase<pg8::EpiBf16, pg8::MoeOrder, true, true>(F.lds + RING_OFF, g, S, E); if (BOTH(15)) GRID_BAR(); }
    if (IN(16)) { p16_combine(F); }
#undef IN
#undef BOTH
}

#ifndef MK_ONE_LAUNCH
#define MK_ONE_LAUNCH 1
#endif
extern "C" void kernel_launch(void* const* d_in, const int* in_sizes, int n_in, void* d_out, int out_size, void* d_ws, size_t ws_size, hipStream_t stream) {
    static int grid = 0;
    if (grid == 0) {
        if (n_in != 22 || in_sizes[0] != T * DM || out_size != T * DM || ws_size < WS_END) { fprintf(stderr, "kernel_launch: unexpected shapes (n_in %d, in0 %d, out %d, ws %zu < %zu)\n", n_in, n_in > 0 ? in_sizes[0] : -1, out_size, ws_size, (size_t)WS_END); grid = -1; return; }
        int dev = 0, cus = 0, per_cu = 0;
        if (hipGetDevice(&dev) != hipSuccess || hipDeviceGetAttribute(&cus, hipDeviceAttributeMultiprocessorCount, dev) != hipSuccess) { grid = -1; return; }
        if (hipFuncSetAttribute((const void*)mk_fwd, hipFuncAttributeMaxDynamicSharedMemorySize, LDS_BYTES) != hipSuccess) { fprintf(stderr, "kernel_launch: hipFuncSetAttribute failed\n"); grid = -1; return; }
        if (hipOccupancyMaxActiveBlocksPerMultiprocessor(&per_cu, (const void*)mk_fwd, NWAVES * 64, LDS_BYTES) != hipSuccess || per_cu < 1) { fprintf(stderr, "kernel_launch: occupancy query says %d blocks per CU\n", per_cu); }
        (void)hipGetLastError();
        grid = cus;
    }
    if (grid < 0) return;
    if (hipMemsetAsync((char*)d_ws + WS_CTL, 0, CTL_ZERO_BYTES, stream) != hipSuccess) return;
    Args a{};
    for (int i = 0; i < 22; ++i) a.in[i] = (const float*)d_in[i];
    a.out = (float*)d_out; a.ws = (unsigned char*)d_ws; a.pad = 0;
#if MK_ONE_LAUNCH
    a.ph_lo = 0; a.ph_hi = N_PHASES; a.use_bar = 1;
    hipLaunchKernelGGL(mk_fwd, dim3(grid), dim3(NWAVES * 64), LDS_BYTES, stream, a);
    for (int p = 0; p < N_PHASES; ++p) if ((MK_PROBE_MASK >> p) & 1) { a.ph_lo = p; a.ph_hi = p + 1; a.use_bar = 0; a.pad = MK_PROBE_SUB;
        hipLaunchKernelGGL(mk_fwd, dim3(grid), dim3(NWAVES * 64), LDS_BYTES, stream, a); }
#else
    for (int p = 0; p < N_PHASES; ++p) { a.ph_lo = p; a.ph_hi = p + 1; a.use_bar = 0;
        hipLaunchKernelGGL(mk_fwd, dim3(grid), dim3(NWAVES * 64), LDS_BYTES, stream, a); }
#endif
}
```

```cpp
#include <hip/hip_runtime.h>
#include <cstdio>
#include <cstdint>

namespace pg8 {
#define PG8_LAS __attribute__((address_space(3)))
typedef unsigned short bf16_t;
typedef short bf16x8 __attribute__((ext_vector_type(8)));
typedef float f32x4 __attribute__((ext_vector_type(4)));
typedef unsigned u32x4 __attribute__((ext_vector_type(4)));
constexpr int BM = 256, BK = 64, HALF = 128, HTB = HALF * BK * 2  , STAGE_BYTES = 8 * HTB, NXCD = 8, WGM = 8;

__host__ __device__ __forceinline__ int lds_byte(int r, int c) { const int st = (r >> 4) * 2 + (c >> 5), rr = r & 15, cc = c & 31, ob = rr * 64 + cc * 2; return st * 1024 + (ob ^ (((ob >> 9) & 1) << 5)); }
__host__ __device__ __forceinline__ void stage_rc(int b, int& R, int& C) { const int st = b / 1024, sb = b % 1024, swz = sb ^ (((sb >> 9) & 1) << 5); R = (st >> 1) * 16 + swz / 64; C = (st & 1) * 32 + (swz % 64) / 2; }
__host__ __device__ __forceinline__ int perm32(int rho) { const int n = rho >> 4, i = rho & 15; return 8 * (i >> 2) + 4 * n + (i & 3); }

struct Unit { int pm, pn, ks, sl; };
struct Gemm { const bf16_t* A; const bf16_t* Bt; int K, kt; };

struct StaticOrder {
    int nM, nN, nwg, G, c;
    __device__ void init(int nM_, int nN_, int G_, int c_) { nM = nM_; nN = nN_; nwg = nM * nN; G = G_; c = c_; }
    __device__ bool next(int i, Unit& u) const {
        const long L = (long)i * G + c; if (L >= nwg) return false;
        int wgid = (int)L; { const int q = nwg / NXCD, r = nwg % NXCD, xcd = wgid % NXCD, off = wgid / NXCD; wgid = (xcd < r ? xcd * (q + 1) : r * (q + 1) + (xcd - r) * q) + off; }
        const int nig = WGM * nN, gid = wgid / nig, fm = gid * WGM, gsz = (nM - fm) < WGM ? (nM - fm) : WGM;
        u.pm = fm + ((wgid % nig) % gsz); u.pn = (wgid % nig) / gsz; u.ks = 0; u.sl = 0; return true;
    }
    __device__ __forceinline__ const char* a_base(const Gemm& g, const Unit& u) const { return (const char*)g.A + (size_t)u.pm * ((size_t)BM * g.K * 2); }
    __device__ __forceinline__ const char* b_base(const Gemm& g, const Unit& u) const { return (const char*)g.Bt + (size_t)u.pn * ((size_t)BM * g.K * 2); }
    __device__ __forceinline__ void a_ready(const Unit&) const {}
    __device__ __forceinline__ void done(const Unit&) const {}
};
struct MoeOrder : StaticOrder {
    const int* tile_e; size_t estride;
    __device__ __forceinline__ const char* b_base(const Gemm& g, const Unit& u) const { return (const char*)g.Bt + (size_t)tile_e[u.pm] * estride + (size_t)u.pn * ((size_t)BM * g.K * 2); }
};
struct MoeSplitOrder {
    int nM, nN, nwg0, ntail, nsp, G, c; const int* tile_e; size_t estride;
    __device__ bool next(int i, Unit& u) const {
        const long L = (long)i * G + c; if (L >= (long)ntail * nsp) return false;
        const int j = (int)L / nsp, wgid = nwg0 + j;
        const int nig = WGM * nN, gid = wgid / nig, fm = gid * WGM, gsz = (nM - fm) < WGM ? (nM - fm) : WGM;
        u.pm = fm + ((wgid % nig) % gsz); u.pn = (wgid % nig) / gsz; u.ks = (int)L % nsp; u.sl = (int)L; return true;
    }
    __device__ __forceinline__ const char* a_base(const Gemm& g, const Unit& u) const { return (const char*)g.A + (size_t)u.pm * ((size_t)BM * g.K * 2) + (size_t)u.ks * g.kt * (BK * 2); }
    __device__ __forceinline__ const char* b_base(const Gemm& g, const Unit& u) const { return (const char*)g.Bt + (size_t)tile_e[u.pm] * estride + (size_t)u.pn * ((size_t)BM * g.K * 2) + (size_t)u.ks * g.kt * (BK * 2); }
    __device__ __forceinline__ void a_ready(const Unit&) const {}
    __device__ __forceinline__ void done(const Unit&) const {}
};

__device__ __forceinline__ unsigned cvt_pk_bf16(float lo, float hi) { unsigned r; asm volatile("v_cvt_pk_bf16_f32 %0, %1, %2" : "=v"(r) : "v"(lo), "v"(hi)); return r; }

struct EpiBf16 {
    static constexpr bool PERM = true, AFTER_DRAIN = false;
    bf16_t* O; int ldc;
    __device__ __forceinline__ void operator()(const f32x4 (&acc)[2][2][4][2], const Unit& u, int wr, int wc, int fr, int fq) const {
        const int row0 = u.pm * BM + wr * 64 + fr, col0 = u.pn * BM + wc * 32 + 8 * fq;
#pragma unroll
        for (int ai = 0; ai < 2; ++ai)
#pragma unroll
            for (int m = 0; m < 4; ++m) { bf16_t* rowp = O + (size_t)(row0 + ai * HALF + m * 16) * ldc + col0;
#pragma unroll
                for (int bj = 0; bj < 2; ++bj) { const f32x4 v0 = acc[ai][bj][m][0], v1 = acc[ai][bj][m][1];
                    u32x4 w; w.x = cvt_pk_bf16(v0[0], v0[1]); w.y = cvt_pk_bf16(v0[2], v0[3]); w.z = cvt_pk_bf16(v1[0], v1[1]); w.w = cvt_pk_bf16(v1[2], v1[3]);
                    *(u32x4*)(rowp + bj * HALF) = w; } }
    }
};
struct EpiSwiglu {
    static constexpr bool PERM = true, AFTER_DRAIN = false;
    bf16_t* O; int ldc;
    __device__ __forceinline__ void operator()(const f32x4 (&acc)[2][2][4][2], const Unit& u, int wr, int wc, int fr, int fq) const {
        const int row0 = u.pm * BM + wr * 64 + fr, col0 = u.pn * HALF + wc * 32 + 8 * fq;
#pragma unroll
        for (int ai = 0; ai < 2; ++ai)
#pragma unroll
            for (int m = 0; m < 4; ++m) { bf16_t* rowp = O + (size_t)(row0 + ai * HALF + m * 16) * ldc + col0;
                float h[8];
#pragma unroll
                for (int n = 0; n < 2; ++n)
#pragma unroll
                    for (int j = 0; j < 4; ++j) { const float gq = acc[ai][0][m][n][j], uq = acc[ai][1][m][n][j];
                        const float sg = __builtin_amdgcn_rcpf(1.0f + __builtin_amdgcn_exp2f(-1.4426950408889634f * gq));
                        h[n * 4 + j] = gq * sg * uq; }
                u32x4 w; w.x = cvt_pk_bf16(h[0], h[1]); w.y = cvt_pk_bf16(h[2], h[3]); w.z = cvt_pk_bf16(h[4], h[5]); w.w = cvt_pk_bf16(h[6], h[7]);
                *(u32x4*)rowp = w; }
    }
};
struct EpiPartF32 {
    static constexpr bool PERM = false, AFTER_DRAIN = false;
    float* slab; int* tmap;
    __device__ __forceinline__ void operator()(const f32x4 (&acc)[2][2][4][2], const Unit& u, int wr, int wc, int fr, int fq) const {
        float* base = slab + (size_t)u.sl * (BM * BM) + (size_t)(wr * 64 + fr) * BM + wc * 32 + 4 * fq;
        if (u.ks == 0 && threadIdx.x == 0) tmap[u.pm * 8 + u.pn] = u.sl + 1;
#pragma unroll
        for (int ai = 0; ai < 2; ++ai)
#pragma unroll
            for (int m = 0; m < 4; ++m) { float* rowp = base + (size_t)(ai * HALF + m * 16) * BM;
#pragma unroll
                for (int bj = 0; bj < 2; ++bj)
#pragma unroll
                    for (int n = 0; n < 2; ++n) *(f32x4*)(rowp + bj * HALF + n * 16) = acc[ai][bj][m][n]; }
    }
};
struct EpiResF32 {
    static constexpr bool PERM = false, AFTER_DRAIN = false;
    const float* base; float* out; int ldc;
    __device__ __forceinline__ void operator()(const f32x4 (&acc)[2][2][4][2], const Unit& u, int wr, int wc, int fr, int fq) const {
        const int row0 = u.pm * BM + wr * 64 + fr, col0 = u.pn * BM + wc * 32 + 4 * fq;
#pragma unroll
        for (int ai = 0; ai < 2; ++ai)
#pragma unroll
            for (int m = 0; m < 4; ++m) { const size_t off = (size_t)(row0 + ai * HALF + m * 16) * ldc + col0;
#pragma unroll
                for (int bj = 0; bj < 2; ++bj)
#pragma unroll
                    for (int n = 0; n < 2; ++n) { const f32x4 b = *(const f32x4*)(base + off + bj * HALF + n * 16); *(f32x4*)(out + off + bj * HALF + n * 16) = b + acc[ai][bj][m][n]; } }
    }
};
template <class Epi, class Sched, bool ALIGN_EPI = false, bool SP2 = false>
__device__ __forceinline__ void gemm_phase(PG8_LAS unsigned char* lds, const Gemm g, const Sched& S, const Epi& E) {
    int tid = threadIdx.x; asm volatile("" : "+v"(tid));
    const int wid = __builtin_amdgcn_readfirstlane(tid >> 6), lane = tid & 63, wr = wid >> 2, wc = wid & 3, fr = lane & 15, fq = lane >> 4;
    const int K = g.K, nt = g.kt;
    unsigned voffA[2], voffB[2];
#pragma unroll
    for (int i = 0; i < 2; ++i) { int R, C; stage_rc(tid * 16 + i * 8192, R, C); const int Rb = Epi::PERM ? ((R & ~31) + perm32(R & 31)) : R;
        voffA[i] = (unsigned)(R * K + C) * 2u; voffB[i] = (unsigned)(Rb * K + C) * 2u; }
    const size_t kstep = (size_t)(BK * 2);
    const size_t hstep = (size_t)HALF * K * 2;
    const unsigned ldsw = (unsigned)wid * 1024u;
    const int aoff = lds_byte(wr * 64 + fr, fq * 8), boff = lds_byte(wc * 32 + fr, fq * 8);
#define PG8_SA(b, h) (((b) * 2 + (h)) * HTB)
#define PG8_SB(b, h) ((4 + (b) * 2 + (h)) * HTB)
#define PG8_STAGE(bufoff, gbase, voff) do { _Pragma("unroll") for (int _i = 0; _i < 2; ++_i) \
        __builtin_amdgcn_global_load_lds((const unsigned*)((const char*)(gbase) + (voff)[_i]), (PG8_LAS unsigned*)(lds + (bufoff) + ldsw + _i * 8192), 16, 0, 0); } while (0)
#define PG8_LDA(dst, b, h) do { _Pragma("unroll") for (int m = 0; m < 4; ++m) _Pragma("unroll") for (int k = 0; k < 2; ++k) dst[m][k] = *(const PG8_LAS bf16x8*)(lds + PG8_SA(b, h) + aoff + m * 2048 + k * 1024); } while (0)
#define PG8_LDB(dst, b, h) do { _Pragma("unroll") for (int n = 0; n < 2; ++n) _Pragma("unroll") for (int k = 0; k < 2; ++k) dst[n][k] = *(const PG8_LAS bf16x8*)(lds + PG8_SB(b, h) + boff + n * 2048 + k * 1024); } while (0)
#define PG8_MMA(ai, bj, At, Bt) do { __builtin_amdgcn_s_setprio(1); _Pragma("unroll") for (int m = 0; m < 4; ++m) _Pragma("unroll") for (int n = 0; n < 2; ++n) _Pragma("unroll") for (int k = 0; k < 2; ++k) \
        acc[ai][bj][m][n] = __builtin_amdgcn_mfma_f32_16x16x32_bf16(Bt[n][k], At[m][k], acc[ai][bj][m][n], 0, 0, 0); __builtin_amdgcn_s_setprio(0); } while (0)
#define PG8_WAIT_V(n) asm volatile("s_waitcnt vmcnt(" #n ")" ::: "memory")
#define PG8_WAIT_L(n) asm volatile("s_waitcnt lgkmcnt(" #n ")" ::: "memory")
#define PG8_BAR __builtin_amdgcn_s_barrier()
#define PG8_SCHED __builtin_amdgcn_sched_barrier(0)
    Unit cur, nxt; int ui = 0;
    if (!S.next(0, cur)) return;
    f32x4 acc[2][2][4][2];
#pragma unroll
    for (int a = 0; a < 2; ++a)
#pragma unroll
        for (int b = 0; b < 2; ++b)
#pragma unroll
            for (int m = 0; m < 4; ++m)
#pragma unroll
                for (int n = 0; n < 2; ++n) acc[a][b][m][n] = (f32x4){0.f, 0.f, 0.f, 0.f};
    bf16x8 At[4][2], B0[2][2], B1[2][2];
    const char* cA = S.a_base(g, cur); const char* cB = S.b_base(g, cur);
    S.a_ready(cur);
    if constexpr (SP2) {
        PG8_STAGE(PG8_SB(0, 0), cB, voffB); PG8_STAGE(PG8_SB(0, 1), cB + hstep, voffB); PG8_STAGE(PG8_SA(0, 0), cA, voffA); PG8_STAGE(PG8_SA(0, 1), cA + hstep, voffA);
        if (wr == 1) PG8_BAR;
        PG8_WAIT_V(2); PG8_BAR;
        PG8_STAGE(PG8_SB(1, 0), cB + kstep, voffB); PG8_STAGE(PG8_SA(1, 0), cA + kstep, voffA); PG8_STAGE(PG8_SB(1, 1), cB + hstep + kstep, voffB);
        PG8_WAIT_V(6); PG8_BAR;
    } else {
        PG8_STAGE(PG8_SB(0, 0), cB, voffB); PG8_STAGE(PG8_SA(0, 0), cA, voffA); PG8_STAGE(PG8_SB(0, 1), cB + hstep, voffB); PG8_STAGE(PG8_SA(0, 1), cA + hstep, voffA);
        if (wr == 1) PG8_BAR;
        PG8_WAIT_V(4); PG8_BAR;
        PG8_STAGE(PG8_SB(1, 0), cB + kstep, voffB); PG8_STAGE(PG8_SA(1, 0), cA + kstep, voffA); PG8_STAGE(PG8_SB(1, 1), cB + hstep + kstep, voffB);
        PG8_WAIT_V(6); PG8_BAR;
    }
    for (;;) {
        const bool has_next = S.next(ui + 1, nxt);
        const char* nA = has_next ? S.a_base(g, nxt) : cA; const char* nB = has_next ? S.b_base(g, nxt) : cB;
        for (int t = 0; t < nt; t += 2) {
            const bool last = (t == nt - 2);
            const char* a1 = cA + (size_t)(t + 1) * kstep;
            const char* a2 = last ? nA : cA + (size_t)(t + 2) * kstep; const char* b2 = last ? nB : cB + (size_t)(t + 2) * kstep;
            const char* a3 = a2 + kstep; const char* b3 = b2 + kstep;
            if (last && has_next) S.a_ready(nxt);
            if constexpr (SP2) {
            PG8_LDB(B0, 0, 0); PG8_LDB(B1, 0, 1); PG8_SCHED; PG8_LDA(At, 0, 0); PG8_STAGE(PG8_SA(1, 1), a1 + hstep, voffA);
            PG8_WAIT_V(8); PG8_WAIT_L(0); PG8_BAR; PG8_MMA(0, 0, At, B0); PG8_MMA(0, 1, At, B1); PG8_BAR; PG8_SCHED;
            PG8_LDA(At, 0, 1); PG8_STAGE(PG8_SB(0, 0), b2, voffB); PG8_STAGE(PG8_SB(0, 1), b2 + hstep, voffB); PG8_STAGE(PG8_SA(0, 0), a2, voffA);
            PG8_WAIT_V(8); PG8_WAIT_L(0); PG8_BAR; PG8_MMA(1, 0, At, B0); PG8_MMA(1, 1, At, B1); PG8_BAR; PG8_SCHED;
            PG8_LDB(B0, 1, 0); PG8_LDB(B1, 1, 1); PG8_SCHED; PG8_LDA(At, 1, 0); PG8_STAGE(PG8_SA(0, 1), a2 + hstep, voffA);
            PG8_WAIT_V(8); PG8_WAIT_L(0); PG8_BAR; PG8_MMA(0, 0, At, B0); PG8_MMA(0, 1, At, B1); PG8_BAR; PG8_SCHED;
            PG8_LDA(At, 1, 1); PG8_STAGE(PG8_SB(1, 0), b3, voffB); PG8_STAGE(PG8_SB(1, 1), b3 + hstep, voffB); PG8_STAGE(PG8_SA(1, 0), a3, voffA);
            PG8_WAIT_V(8); PG8_WAIT_L(0); PG8_BAR; PG8_MMA(1, 0, At, B0); PG8_MMA(1, 1, At, B1); PG8_BAR; PG8_SCHED;
            } else {
            PG8_LDB(B0, 0, 0); PG8_SCHED; PG8_LDA(At, 0, 0); PG8_STAGE(PG8_SA(1, 1), a1 + hstep, voffA);
            PG8_WAIT_L(8); PG8_BAR; PG8_WAIT_L(0); PG8_MMA(0, 0, At, B0); PG8_BAR; PG8_SCHED;
            PG8_LDB(B1, 0, 1); PG8_STAGE(PG8_SB(0, 0), b2, voffB);
            PG8_BAR; PG8_WAIT_L(0); PG8_MMA(0, 1, At, B1); PG8_BAR;
            PG8_LDA(At, 0, 1); PG8_STAGE(PG8_SA(0, 0), a2, voffA);
            PG8_BAR; PG8_WAIT_L(0); PG8_MMA(1, 0, At, B0); PG8_BAR; PG8_SCHED;
            PG8_STAGE(PG8_SB(0, 1), b2 + hstep, voffB);
            PG8_WAIT_V(6); PG8_BAR; PG8_MMA(1, 1, At, B1); PG8_BAR;
            PG8_LDB(B0, 1, 0); PG8_SCHED; PG8_LDA(At, 1, 0); PG8_STAGE(PG8_SA(0, 1), a2 + hstep, voffA);
            PG8_WAIT_L(8); PG8_BAR; PG8_WAIT_L(0); PG8_MMA(0, 0, At, B0); PG8_BAR; PG8_SCHED;
            PG8_LDB(B1, 1, 1); PG8_STAGE(PG8_SB(1, 0), b3, voffB);
            PG8_BAR; PG8_WAIT_L(0); PG8_MMA(0, 1, At, B1); PG8_BAR;
            PG8_LDA(At, 1, 1); PG8_STAGE(PG8_SA(1, 0), a3, voffA);
            PG8_BAR; PG8_WAIT_L(0); PG8_MMA(1, 0, At, B0); PG8_BAR; PG8_SCHED;
            PG8_STAGE(PG8_SB(1, 1), b3 + hstep, voffB);
            PG8_WAIT_V(6); PG8_BAR; PG8_MMA(1, 1, At, B1); PG8_BAR;
            }
        }
        if constexpr (ALIGN_EPI) { if (wr == 0) PG8_BAR; }
        if constexpr (!Epi::AFTER_DRAIN) { E(acc, cur, wr, wc, fr, fq); S.done(cur); }
        if (!has_next) break;
#pragma unroll
        for (int a = 0; a < 2; ++a)
#pragma unroll
            for (int b = 0; b < 2; ++b)
#pragma unroll
                for (int m = 0; m < 4; ++m)
#pragma unroll
                    for (int n = 0; n < 2; ++n) acc[a][b][m][n] = (f32x4){0.f, 0.f, 0.f, 0.f};
        cur = nxt; cA = nA; cB = nB; ++ui;
        if constexpr (ALIGN_EPI) { if (wr == 1) PG8_BAR; }
    }
    PG8_WAIT_V(0);
    if constexpr (!ALIGN_EPI) { if (wr == 0) PG8_BAR; }
    PG8_BAR;
    if constexpr (Epi::AFTER_DRAIN) { E.fused(acc, cur, wr, wc, fr, fq, lds, wid, lane); S.done(cur); }
#undef PG8_SA
#undef PG8_SB
#undef PG8_STAGE
#undef PG8_LDA
#undef PG8_LDB
#undef PG8_MMA
#undef PG8_WAIT_V
#undef PG8_WAIT_L
#undef PG8_BAR
#undef PG8_SCHED
}
}


constexpr int T = 8192, DM = 2048, HD = 128, NMIX = 12, NMEMH = 4, NG = 3, MEMT = 256, FF = 7168, NE = 8;
constexpr int A_IN_W = 4388, NA = 4608;
constexpr int NB = 5120;
constexpr int CA_Q = 0, CA_KC = 1536, CA_VC = 1920, CA_KS = 2304, CA_VS = 2688, CA_KW = 3072, CA_VW = 3456, CA_QM = 3840, CA_GT = 4352;
constexpr int CB_Q = 0, CB_QM = 1536, CB_K = 2048, CB_V = 3584;
constexpr int NCMP = 511, NCMP_P = 512;
constexpr int MOE_MAXT = 72;
constexpr float EPS = 1e-6f;
constexpr float QSCALE = 0.08838834764831845f;

constexpr size_t MiB = 1u << 20;
constexpr size_t WS_CTL = 0, CTL_ZERO_BYTES = 1 * MiB;
constexpr size_t WS_WT_INA = 2 * MiB;
constexpr size_t WS_WT_MEM = 20 * MiB;
constexpr size_t WS_WT_OUT = 28 * MiB;
constexpr size_t WS_WT_FGU = 44 * MiB;
constexpr size_t WS_WT_FDN = 100 * MiB;
constexpr size_t WS_WT_INB = 128 * MiB;
constexpr size_t WS_WT_MGU = 148 * MiB;
constexpr size_t WS_WT_MDN = 596 * MiB;
constexpr size_t WS_XN = 820 * MiB;
constexpr size_t WS_MEMN = 852 * MiB;
constexpr size_t WS_MKV = 853 * MiB;
constexpr size_t WS_PA = 854 * MiB;
constexpr size_t WS_KCMP = 926 * MiB;
constexpr size_t WS_MIX = 927 * MiB;
constexpr size_t WS_X1 = 959 * MiB;
constexpr size_t WS_X2 = 1023 * MiB;
constexpr size_t WS_X3 = 1087 * MiB;
constexpr size_t WS_HFF = 1151 * MiB;
constexpr size_t WS_PB = 1263 * MiB;
constexpr size_t WS_AMOE = 1343 * MiB;
constexpr size_t WS_HMOE = 1415 * MiB;
constexpr size_t WS_YMOE = 1667 * MiB;
constexpr size_t WS_ROUTE = 1739 * MiB;
constexpr size_t WS_WT_CMP = 1740 * MiB;
constexpr size_t WS_OACC = 1742 * MiB;
constexpr size_t WS_SLAB = 1790 * MiB;
constexpr size_t WS_END = 1854 * MiB;
constexpr size_t RT_TOPI = 0;
constexpr size_t RT_TOPW = 65536;
constexpr size_t RT_ROW = 131072;
constexpr size_t RT_HIST = 196608;
constexpr size_t RT_TILE = 204800;
constexpr int CW_TMO = 0, CW_CODE = 1, CW_BAR = 4096;

constexpr int RING_OFF = 0, RING_BYTES = 135168;
constexpr int LDSCTL_OFF = RING_BYTES, MISC_OFF = LDSCTL_OFF + 320;
constexpr int LDS_BYTES = 147456;
static_assert(MISC_OFF + 128 <= LDS_BYTES, "LDS map");
constexpr int NWAVES = 8;

#define GAS __attribute__((address_space(1)))
#define LAS __attribute__((address_space(3)))
typedef unsigned short bf16;
typedef unsigned v4u __attribute__((ext_vector_type(4)));
typedef unsigned v2u __attribute__((ext_vector_type(2)));
typedef float f32x4 __attribute__((ext_vector_type(4)));
typedef GAS unsigned gu32;
#define RLX_AGENT __ATOMIC_RELAXED, __HIP_MEMORY_SCOPE_AGENT
#define LDS_WAIT() asm volatile("s_waitcnt lgkmcnt(0)" ::: "memory")
#define VM_WAIT() asm volatile("s_waitcnt vmcnt(0)" ::: "memory")
__device__ __forceinline__ float bf2f(unsigned b) { return __uint_as_float(b << 16); }
__device__ __forceinline__ unsigned pk2(float lo, float hi) { return pg8::cvt_pk_bf16(lo, hi); }
__device__ __forceinline__ void unpack8(v4u w, float* f) {
    f[0] = __uint_as_float(w.x << 16); f[1] = __uint_as_float(w.x & 0xffff0000u); f[2] = __uint_as_float(w.y << 16); f[3] = __uint_as_float(w.y & 0xffff0000u);
    f[4] = __uint_as_float(w.z << 16); f[5] = __uint_as_float(w.z & 0xffff0000u); f[6] = __uint_as_float(w.w << 16); f[7] = __uint_as_float(w.w & 0xffff0000u); }
__device__ __forceinline__ float wave_sum(float v) {
#pragma unroll
    for (int o = 1; o < 64; o <<= 1) v += __shfl_xor(v, o);
    return v;
}
__device__ __forceinline__ float fast_exp(float x) { return __builtin_amdgcn_exp2f(x * 1.4426950408889634f); }

#define XB_TMO      128
#define XB_XCNT(j)  (256  + 64 * (j))
#define XB_XSUB(j)  (1280 + 64 * (j))
#define XB_XGEN(j)  (2304 + 64 * (j))
#define XB_TOP      3328
#define XB_TOPGEN   3392
#define XCD_BAR_WORDS 3456
#define XB_SPIN_CAP (1u << 18)
__device__ __forceinline__ unsigned xb_ld(unsigned* p)              { return __hip_atomic_load(p, __ATOMIC_RELAXED, __HIP_MEMORY_SCOPE_AGENT); }
__device__ __forceinline__ unsigned xb_add(unsigned* p, unsigned v) { return __hip_atomic_fetch_add(p, v, __ATOMIC_RELAXED, __HIP_MEMORY_SCOPE_AGENT); }
__device__ __forceinline__ unsigned xb_xcc_id() { return (unsigned)__builtin_amdgcn_s_getreg((3 << 11) | 20) & 0xFu; }
#define XB_SPIN(cond, bar) do { unsigned _sp = 0; while (cond) { __builtin_amdgcn_s_sleep(1); \
    if ((++_sp & 255u) == 0u) { if (xb_ld(&(bar)[XB_TMO])) break; if (_sp > XB_SPIN_CAP) { atomicAdd(&(bar)[XB_TMO], 1u); break; } } } } while (0)
struct XcdBarrier { unsigned* bar; unsigned x; volatile LAS unsigned* st; };
__device__ __forceinline__ XcdBarrier xcd_barrier_post(unsigned* bar, volatile LAS unsigned* st) {
    XcdBarrier b; b.bar = bar; b.x = xb_xcc_id(); b.st = st;
    if (threadIdx.x == 0) (void)xb_add(&bar[XB_XCNT(b.x)], 1u);
    return b;
}
__device__ __forceinline__ void xcd_barrier_complete(unsigned* bar, unsigned x, unsigned& nloc, unsigned& nx) {
    const unsigned G = gridDim.x * gridDim.y * gridDim.z;
    unsigned sum, cnt, mine, sp = 0u;
    for (;;) {
        sum = 0u; cnt = 0u; mine = 0u;
#pragma unroll
        for (unsigned j = 0; j < 16; ++j) { const unsigned c = xb_ld(&bar[XB_XCNT(j)]); sum += c; cnt += (c > 0u) ? 1u : 0u; mine = (j == x) ? c : mine; }
        if (sum == G) break;
        __builtin_amdgcn_s_sleep(1);
        if ((++sp & 255u) == 0u) { if (xb_ld(&bar[XB_TMO])) break; if (sp > XB_SPIN_CAP) { atomicAdd(&bar[XB_TMO], 1u); break; } }
    }
    nloc = mine > 0u ? mine : 1u; nx = cnt > 0u ? cnt : 1u;
}
__device__ __forceinline__ void xcd_barrier(const XcdBarrier& b) {
    asm volatile("s_waitcnt vmcnt(0)" ::: "memory");
    __syncthreads();
    if (threadIdx.x == 0) {
        unsigned* bar = b.bar;
        __builtin_amdgcn_s_waitcnt(0);
        unsigned nloc = b.st[0], nx = b.st[1];
        if (nloc == 0u) { xcd_barrier_complete(bar, b.x, nloc, nx); b.st[0] = nloc; b.st[1] = nx; }
        const unsigned old = xb_add(&bar[XB_XSUB(b.x)], 1u);
        const unsigned gen = old / nloc;
        if (old + 1u == (gen + 1u) * nloc) {
            __builtin_amdgcn_fence(__ATOMIC_RELEASE, "agent");
            asm volatile("s_waitcnt vmcnt(0)" ::: "memory");
            const unsigned og = xb_add(&bar[XB_TOP], 1u);
            const unsigned tg = og / nx;
            if (og + 1u == (tg + 1u) * nx) xb_add(&bar[XB_TOPGEN], 1u);
            else XB_SPIN(xb_ld(&bar[XB_TOPGEN]) == tg, bar);
            __builtin_amdgcn_fence(__ATOMIC_ACQUIRE, "agent");
            xb_add(&bar[XB_XGEN(b.x)], 1u);
            asm volatile("s_waitcnt vmcnt(0)" ::: "memory");
        } else {
            XB_SPIN(xb_ld(&bar[XB_XGEN(b.x)]) == gen, bar);
            __builtin_amdgcn_fence(__ATOMIC_ACQUIRE, "agent");
            asm volatile("s_waitcnt vmcnt(0)" ::: "memory");
        }
    }
    __syncthreads();
}

struct Frame {
    LAS unsigned char* lds;
    volatile LAS unsigned* MISC;
    gu32* ctl;
    int tid, wave;
    int vcu, G;
    unsigned char* ws;
    const float* in[22];
    float* out;
};
#define WSP(T_, off) ((T_*)(F.ws + (off)))
__device__ __forceinline__ int lane_of(const Frame& F) { int t = F.tid; asm volatile("" : "+v"(t)); return t & 63; }

constexpr int CV_INA = 0, CV_MEM = CV_INA + 32 * 72, CV_CMP = CV_MEM + 2 * 32 * 16, CV_OUT = CV_CMP + 2 * 64 * 2, CV_FGU = CV_OUT + 2 * 32 * 32, CV_FDN = CV_FGU + 32 * 224,
              CV_INB = CV_FDN + 112 * 32, CV_KVB = CV_INB + 32 * 32, CV_MGU = CV_KVB + 32 * 48, CV_MDN = CV_MGU + 8 * 32 * 224, CV_TOTAL = CV_MDN + 8 * 112 * 32;
struct ConvIt { const float* src; bf16* dst; const float* gain; int K, Nsrc, sc0, n0, k0, nvalid; };
__device__ __forceinline__ void conv_decode(Frame& F, int g, ConvIt& c) {
    int loc, nnb, mode = 0, batch = 0; c.gain = nullptr;
    if (g < CV_MEM) { loc = g - CV_INA; c.src = F.in[5]; c.dst = WSP(bf16, WS_WT_INA); c.gain = F.in[2]; c.K = DM; c.Nsrc = A_IN_W; nnb = NA / 64; mode = 2; }
    else if (g < CV_CMP) { loc = g - CV_MEM; batch = loc / (32 * 16); loc -= batch * 32 * 16; c.src = F.in[13] + (size_t)batch * DM * 1024; c.dst = WSP(bf16, WS_WT_MEM) + (size_t)batch * 1024 * DM; c.gain = F.in[3] + batch * DM; c.K = DM; c.Nsrc = 1024; nnb = 16; }
    else if (g < CV_OUT) { loc = g - CV_CMP; batch = loc / 128; loc -= batch * 128; c.src = F.in[6] + (size_t)batch * 4096 * HD; c.dst = WSP(bf16, WS_WT_CMP) + (size_t)batch * HD * 4096; c.K = 4096; c.Nsrc = HD; nnb = 2; }
    else if (g < CV_FGU) { loc = g - CV_OUT; batch = loc / 1024; loc -= batch * 1024; c.src = F.in[15] + (size_t)batch * DM * DM; c.dst = WSP(bf16, WS_WT_OUT) + (size_t)batch * DM * DM; c.K = DM; c.Nsrc = DM; nnb = 32; }
    else if (g < CV_FDN) { loc = g - CV_FGU; c.src = F.in[16]; c.dst = WSP(bf16, WS_WT_FGU); c.gain = F.in[4]; c.K = DM; c.Nsrc = 2 * FF; nnb = 224; mode = 1; }
    else if (g < CV_INB) { loc = g - CV_FDN; c.src = F.in[17]; c.dst = WSP(bf16, WS_WT_FDN); c.K = FF; c.Nsrc = DM; nnb = 32; }
    else if (g < CV_KVB) { loc = g - CV_INB; c.src = F.in[10]; c.dst = WSP(bf16, WS_WT_INB); c.gain = F.in[2] + DM; c.K = DM; c.Nsrc = DM; nnb = 32; }
    else if (g < CV_MGU) { loc = g - CV_KVB; c.src = F.in[12]; c.dst = WSP(bf16, WS_WT_INB) + (size_t)2048 * DM; c.gain = F.in[11]; c.K = DM; c.Nsrc = 3072; nnb = 48; }
    else if (g < CV_MDN) { loc = g - CV_MGU; batch = loc / 7168; loc -= batch * 7168; c.src = F.in[20] + (size_t)batch * DM * 2 * FF; c.dst = WSP(bf16, WS_WT_MGU) + (size_t)batch * 2 * FF * DM; c.gain = F.in[4] + DM; c.K = DM; c.Nsrc = 2 * FF; nnb = 224; mode = 1; }
    else { loc = g - CV_MDN; batch = loc / 3584; loc -= batch * 3584; c.src = F.in[21] + (size_t)batch * FF * DM; c.dst = WSP(bf16, WS_WT_MDN) + (size_t)batch * DM * FF; c.K = FF; c.Nsrc = DM; nnb = 32; }
    const int kb = loc / nnb, nb = loc - kb * nnb;
    c.k0 = kb * 64; c.n0 = nb * 64; c.nvalid = nnb * 64;
    if (mode == 1) { const int j = c.n0 >> 8, r = c.n0 & 255; c.sc0 = (r < 128) ? 128 * j + r : 7168 + 128 * j + (r - 128); }
    else if (mode == 2) { if (c.n0 < 3840) c.sc0 = c.n0; else if (c.n0 < 4352) c.sc0 = c.n0 + 36; else if (c.n0 < 4416) { c.sc0 = c.n0 - 512; c.nvalid = 4388; } else { c.sc0 = 0; c.nvalid = 0; } }
    else c.sc0 = c.n0;
}
struct ConvRegs { f32x4 v[16]; float gn[8]; };
__device__ __forceinline__ void conv_load(const ConvIt& c, ConvRegs& R, int lane) {
    const int kr = lane >> 4, nc = (lane & 15) * 4;
    const bool ok = (c.n0 + nc) < c.nvalid;
    const int cc = ok ? c.sc0 + nc : 0;
    const float* p = c.src + (size_t)(c.k0 + kr) * c.Nsrc + cc;
#pragma unroll
    for (int i = 0; i < 16; ++i) { const f32x4 t = __builtin_nontemporal_load((const f32x4*)(p + (size_t)(4 * i) * c.Nsrc)); R.v[i] = ok ? t : (f32x4){0.f, 0.f, 0.f, 0.f}; }
    const int c8 = lane & 7;
#pragma unroll
    for (int i = 0; i < 8; ++i) R.gn[i] = c.gain ? c.gain[c.k0 + 8 * c8 + i] : 1.0f;
}
__device__ __forceinline__ void conv_proc(const ConvIt& c, const ConvRegs& R, LAS float* scr, int lane) {
    const int kr = lane >> 4, nc = (lane & 15) * 4;
#pragma unroll
    for (int i = 0; i < 16; ++i) { LAS float* s = scr + (4 * i + kr) * 65 + nc; s[0] = R.v[i][0]; s[1] = R.v[i][1]; s[2] = R.v[i][2]; s[3] = R.v[i][3]; }
    LDS_WAIT(); asm volatile("" ::: "memory");
    const int c8 = lane & 7, nl = lane >> 3;
#pragma unroll
    for (int j = 0; j < 8; ++j) {
        const int n = nl + 8 * j; const LAS float* s = scr + (8 * c8) * 65 + n;
        v4u o; o.x = pk2(s[0 * 65] * R.gn[0], s[1 * 65] * R.gn[1]); o.y = pk2(s[2 * 65] * R.gn[2], s[3 * 65] * R.gn[3]); o.z = pk2(s[4 * 65] * R.gn[4], s[5 * 65] * R.gn[5]); o.w = pk2(s[6 * 65] * R.gn[6], s[7 * 65] * R.gn[7]);
        *(v4u*)(c.dst + (size_t)(c.n0 + n) * c.K + c.k0 + 8 * c8) = o;
    }
    LDS_WAIT(); asm volatile("" ::: "memory");
}
__device__ __forceinline__ void conv_list(Frame& F, int first, int stride, int g_hi) {
    LAS float* scr = (LAS float*)(F.lds + RING_OFF + F.wave * 16640);
    int g = first;
    if (g >= g_hi) return;
    ConvIt cA, cB; ConvRegs RA, RB;
    conv_decode(F, g, cA); conv_load(cA, RA, lane_of(F));
    for (;;) {
        const int g1 = g + stride; const bool h1 = g1 < g_hi;
        if (h1) { conv_decode(F, g1, cB); conv_load(cB, RB, lane_of(F)); }
        asm volatile("" ::: "memory");
        conv_proc(cA, RA, scr, lane_of(F));
        if (!h1) break;
        const int g2 = g1 + stride; const bool h2 = g2 < g_hi;
        if (h2) { conv_decode(F, g2, cA); conv_load(cA, RA, lane_of(F)); }
        asm volatile("" ::: "memory");
        conv_proc(cB, RB, scr, lane_of(F));
        if (!h2) break;
        g = g2;
    }
}
constexpr int CV_DEFER0 = CV_MGU, CV_CHUNK = 32;
constexpr int CW_TMAP = 12288;
constexpr int CW_CVNEXT = 8192, CW_DONE0 = 8192 + 64;
__device__ __forceinline__ bool conv_grab(Frame& F) {
    volatile LAS int* sh = (volatile LAS int*)(F.lds + LDSCTL_OFF + 64);
    if (F.tid == 0) sh[0] = CV_DEFER0 + (int)__hip_atomic_fetch_add((unsigned*)(F.ctl + CW_CVNEXT), (unsigned)CV_CHUNK, __ATOMIC_RELAXED, __HIP_MEMORY_SCOPE_AGENT);
    __syncthreads();
    const int base = sh[0];
    __syncthreads();
    if (base >= CV_TOTAL) return false;
    const int hi = base + CV_CHUNK < CV_TOTAL ? base + CV_CHUNK : CV_TOTAL;
    conv_list(F, base + F.wave, NWAVES, hi);
    return true;
}
__device__ __forceinline__ void idle_fill(Frame& F, int ph) {
    volatile LAS int* sh = (volatile LAS int*)(F.lds + LDSCTL_OFF + 64);
    asm volatile("s_waitcnt vmcnt(0)" ::: "memory");
    __syncthreads();
    if (F.tid == 0) __hip_atomic_fetch_add((unsigned*)(F.ctl + CW_DONE0 + 64 * ph), 1u, __ATOMIC_RELAXED, __HIP_MEMORY_SCOPE_AGENT);
    for (;;) {
        if (F.tid == 0) sh[1] = (__hip_atomic_load((unsigned*)(F.ctl + CW_DONE0 + 64 * ph), __ATOMIC_RELAXED, __HIP_MEMORY_SCOPE_AGENT) >= (unsigned)F.G) ? 1 : 0;
        __syncthreads();
        const int alld = sh[1];
        __syncthreads();
        if (alld) break;
        if (!conv_grab(F)) break;
    }
}
__device__ __forceinline__ void conv_drain(Frame& F) { while (conv_grab(F)) {} }
__device__ __forceinline__ float row_rstd_to_bf16(const float* xrow, bf16* orow, int lane) {
    const f32x4* xr = (const f32x4*)xrow + lane;
    f32x4 v[8]; float s = 0.f;
#pragma unroll
    for (int j = 0; j < 8; ++j) { v[j] = xr[64 * j]; s += (v[j].x * v[j].x + v[j].y * v[j].y) + (v[j].z * v[j].z + v[j].w * v[j].w); }
    const float rstd = 1.0f / sqrtf(wave_sum(s) * (1.f / DM) + EPS);
    v2u* o8 = (v2u*)orow + lane;
#pragma unroll
    for (int j = 0; j < 8; ++j) { v2u w; w.x = pk2(v[j].x * rstd, v[j].y * rstd); w.y = pk2(v[j].z * rstd, v[j].w * rstd); o8[64 * j] = w; }
    return rstd;
}
__device__ __forceinline__ void rmsnorm_rows(Frame& F, const float* X, bf16* XN, int rows) {
    const int gw = F.vcu * NWAVES + F.wave, NGW = F.G * NWAVES;
    for (int m = gw; m < rows; m += NGW) row_rstd_to_bf16(X + (size_t)m * DM, XN + (size_t)m * DM, lane_of(F));
}
__device__ __forceinline__ void p0_prologue(Frame& F) {
    conv_list(F, F.vcu * NWAVES + F.wave, F.G * NWAVES, CV_DEFER0);
    rmsnorm_rows(F, F.in[0], WSP(bf16, WS_XN), T);
    rmsnorm_rows(F, F.in[1], WSP(bf16, WS_MEMN), MEMT);
}

__device__ __forceinline__ void p2_compress(Frame& F) {
    typedef short bf16x8 __attribute__((ext_vector_type(8)));
    const bf16* PA = WSP(bf16, WS_PA); const bf16* WC = WSP(bf16, WS_WT_CMP);
    LAS float* red = (LAS float*)(F.lds + RING_OFF);
    LAS float* posl = red + 16 * 132;
    const int lane = lane_of(F), w = F.wave, fr = lane & 15, fq = lane >> 4;
    for (int i = F.tid; i < 2 * 4096 / 4; i += NWAVES * 64) *(LAS f32x4*)(posl + 4 * i) = *(const f32x4*)(F.in[7] + 4 * i);
    __syncthreads();
    const int nitems = 2 * NG * 32;
    for (int it = F.vcu; it < nitems; it += F.G) {
        const int kv = it / (NG * 32), g = (it / 32) % NG, jt = it % 32;
        const int j = 16 * jt + fr;
        const LAS float* pos = posl + kv * 4096;
        const int col = (kv ? CA_VC : CA_KC) + g * HD;
        const bf16* wrow = WC + ((size_t)kv * HD + 16 * w + fr) * 4096;
        f32x4 acc = {0.f, 0.f, 0.f, 0.f};
        for (int ks0 = 0; ks0 < 128; ks0 += 16) {
            v4u xa[16], wb[16];
#pragma unroll
            for (int u = 0; u < 16; ++u) {
                const int k = 32 * (ks0 + u) + 8 * fq, i = k >> 7, d = k & 127;
                int trow = 16 * j + i; trow = trow < T ? trow : T - 1;
                xa[u] = *(const v4u*)(PA + (size_t)trow * NA + col + d);
                wb[u] = *(const v4u*)(wrow + k);
            }
            asm volatile("" ::: "memory");
#pragma unroll
            for (int u = 0; u < 16; ++u) {
                const int k = 32 * (ks0 + u) + 8 * fq;
                const f32x4 pa = *(const LAS f32x4*)(pos + k), pb = *(const LAS f32x4*)(pos + k + 4);
                float xf[8]; unpack8(xa[u], xf);
                v4u av; av.x = pk2(xf[0] + pa[0], xf[1] + pa[1]); av.y = pk2(xf[2] + pa[2], xf[3] + pa[3]); av.z = pk2(xf[4] + pb[0], xf[5] + pb[1]); av.w = pk2(xf[6] + pb[2], xf[7] + pb[3]);
                acc = __builtin_amdgcn_mfma_f32_16x16x32_bf16(*reinterpret_cast<const bf16x8*>(&av), *reinterpret_cast<const bf16x8*>(&wb[u]), acc, 0, 0, 0);
            }
        }
#pragma unroll
        for (int r = 0; r < 4; ++r) red[(4 * fq + r) * 132 + 16 * w + fr] = acc[r];
        __syncthreads();
        {
            const int row = F.tid >> 5, cp = F.tid & 31, jj = 16 * jt + row;
            float v[4]; float ss = 0.f;
#pragma unroll
            for (int e = 0; e < 4; ++e) { v[e] = red[row * 132 + 4 * cp + e]; ss += v[e] * v[e]; }
            ss += __shfl_xor(ss, 1); ss += __shfl_xor(ss, 2); ss += __shfl_xor(ss, 4); ss += __shfl_xor(ss, 8); ss += __shfl_xor(ss, 16);
            if (kv == 0) { const float rs = 1.0f / sqrtf(ss * (1.f / HD) + EPS); const float* gp = F.in[9] + 4 * cp;
#pragma unroll
                for (int e = 0; e < 4; ++e) v[e] = v[e] * rs * gp[e]; }
            if (jj >= NCMP) {
#pragma unroll
                for (int e = 0; e < 4; ++e) v[e] = 0.f; }
            v2u o; o.x = pk2(v[0], v[1]); o.y = pk2(v[2], v[3]);
            *(v2u*)(WSP(bf16, WS_KCMP) + (size_t)kv * NG * NCMP_P * HD + ((size_t)g * NCMP_P + jj) * HD + 4 * cp) = o;
        }
        __syncthreads();
    }
}
__device__ __forceinline__ void norm_slot(bf16* p, const float* gain, int l16) {
    v4u w = *(const v4u*)(p + l16 * 8); float f[8]; unpack8(w, f);
    float s = 0.f;
#pragma unroll
    for (int e = 0; e < 8; ++e) s += f[e] * f[e];
    s += __shfl_xor(s, 1); s += __shfl_xor(s, 2); s += __shfl_xor(s, 4); s += __shfl_xor(s, 8);
    const float r = 1.0f / sqrtf(s * (1.f / HD) + EPS);
    const float* gp = gain + l16 * 8;
    v4u o; o.x = pk2(f[0] * r * gp[0], f[1] * r * gp[1]); o.y = pk2(f[2] * r * gp[2], f[3] * r * gp[3]); o.z = pk2(f[4] * r * gp[4], f[5] * r * gp[5]); o.w = pk2(f[6] * r * gp[6], f[7] * r * gp[7]);
    *(v4u*)(p + l16 * 8) = o;
}
__device__ __forceinline__ void norm_vals(v4u w, bf16* p, const float* gain, int l16) {
    float f[8]; unpack8(w, f);
    float s = 0.f;
#pragma unroll
    for (int e = 0; e < 8; ++e) s += f[e] * f[e];
    s += __shfl_xor(s, 1); s += __shfl_xor(s, 2); s += __shfl_xor(s, 4); s += __shfl_xor(s, 8);
    const float r = 1.0f / sqrtf(s * (1.f / HD) + EPS);
    const float* gp = gain + l16 * 8;
    v4u o; o.x = pk2(f[0] * r * gp[0], f[1] * r * gp[1]); o.y = pk2(f[2] * r * gp[2], f[3] * r * gp[3]); o.z = pk2(f[4] * r * gp[4], f[5] * r * gp[5]); o.w = pk2(f[6] * r * gp[6], f[7] * r * gp[7]);
    *(v4u*)(p + l16 * 8) = o;
}
__device__ __forceinline__ void p2_qknorm(Frame& F) {
    bf16* PA = WSP(bf16, WS_PA); bf16* MKV = WSP(bf16, WS_MKV);
    const int gs = (F.vcu * NWAVES + F.wave) * 4 + (lane_of(F) >> 4), NS = F.G * NWAVES * 4, l16 = lane_of(F) & 15;
    for (int s0 = gs; s0 < T * 18; s0 += 6 * NS) {
        bf16* ptr[6]; const float* gn[6]; v4u w[6];
#pragma unroll
        for (int u = 0; u < 6; ++u) {
            int s = s0 + u * NS; s = s < T * 18 ? s : gs;
            const int t = s / 18, k = s % 18;
            int col; const float* gain;
            if (k < 12) { col = CA_Q + k * HD; gain = F.in[8]; }
            else if (k < 15) { col = CA_KS + (k - 12) * HD; gain = F.in[9] + HD; }
            else { col = CA_KW + (k - 15) * HD; gain = F.in[9] + 2 * HD; }
            ptr[u] = PA + (size_t)t * NA + col; gn[u] = gain; w[u] = *(const v4u*)(ptr[u] + l16 * 8);
        }
        asm volatile("" ::: "memory");
#pragma unroll
        for (int u = 0; u < 6; ++u) if (s0 + u * NS < T * 18) norm_vals(w[u], ptr[u], gn[u], l16);
    }
    for (int s = gs; s < MEMT * 8; s += NS) {
        const int m = s / 8, k = s % 8, l = k >> 2, h = k & 3;
        norm_slot(MKV + (size_t)m * 2048 + l * 1024 + h * HD, F.in[14] + (size_t)(l * 2 + 1) * HD, l16);
    }
}

__device__ __forceinline__ void ld32(const bf16* p, float* f) {
#pragma unroll
    for (int i = 0; i < 4; ++i) { const v4u w = *(const v4u*)(p + 8 * i); unpack8(w, f + 8 * i); }
}
__device__ __forceinline__ float dot32q(const float* q, const bf16* kp) {
    float kf[32]; ld32(kp, kf); float s = 0.f;
#pragma unroll
    for (int i = 0; i < 32; ++i) s += q[i] * kf[i];
    s += __shfl_xor(s, 1); s += __shfl_xor(s, 2);
    return s;
}
__device__ __forceinline__ void axpy32(float* o, float p, const bf16* vp) {
    float vf[32]; ld32(vp, vf);
#pragma unroll
    for (int i = 0; i < 32; ++i) o[i] += p * vf[i];
}
__device__ __forceinline__ void st32(bf16* p, const float* f) {
#pragma unroll
    for (int i = 0; i < 4; ++i) { v4u w; w.x = pk2(f[8 * i], f[8 * i + 1]); w.y = pk2(f[8 * i + 2], f[8 * i + 3]); w.z = pk2(f[8 * i + 4], f[8 * i + 5]); w.w = pk2(f[8 * i + 6], f[8 * i + 7]); *(v4u*)(p + 8 * i) = w; }
}
#define OSM_STEP(s_, valid_, vptr_) do { if (valid_) { const float mn_ = fmaxf(m, (s_)); const float al_ = fast_exp(m - mn_); const float pp_ = fast_exp((s_) - mn_); \
        l = l * al_ + pp_; _Pragma("unroll") for (int i_ = 0; i_ < 32; ++i_) o[i_] *= al_; axpy32(o, pp_, (vptr_)); m = mn_; } } while (0)

__device__ __forceinline__ void p3_nsa_naive(Frame& F) {
    const bf16* PA = WSP(bf16, WS_PA); const bf16* KC = WSP(bf16, WS_KCMP); const bf16* VC = KC + (size_t)NG * NCMP_P * HD; bf16* MIX = WSP(bf16, WS_MIX);
    LAS float* IMP = (LAS float*)(F.lds + RING_OFF + F.wave * 4096);
    LAS unsigned long long* SELW = (LAS unsigned long long*)(F.lds + RING_OFF + F.wave * 4096 + 2048);
    const int gw = F.vcu * NWAVES + F.wave, NGW = F.G * NWAVES;
    const int dq = lane_of(F) & 3, p = (lane_of(F) >> 2) & 3, ql = lane_of(F) >> 4;
    for (int it = gw; it < NG * (T / 4); it += NGW) {
        const int g = it / (T / 4), tq = it % (T / 4), t = 4 * tq + ql, head = g * 4 + p;
        const float slope = exp2f(-8.0f * (float)(head + 1) / 12.0f);
        float q[32]; ld32(PA + (size_t)t * NA + CA_Q + head * HD + dq * 32, q);
#pragma unroll
        for (int i = 0; i < 32; ++i) q[i] *= QSCALE;
        const float g0 = 1.0f / (1.0f + fast_exp(-bf2f(PA[(size_t)t * NA + CA_GT + head * 3 + 0])));
        const float g1 = 1.0f / (1.0f + fast_exp(-bf2f(PA[(size_t)t * NA + CA_GT + head * 3 + 1])));
        const float g2 = 1.0f / (1.0f + fast_exp(-bf2f(PA[(size_t)t * NA + CA_GT + head * 3 + 2])));
        float otot[32];
#pragma unroll
        for (int i = 0; i < 32; ++i) otot[i] = 0.f;
        for (int i = lane_of(F); i < 512; i += 64) IMP[i] = 0.f;
        LDS_WAIT(); asm volatile("" ::: "memory");
        const int jmax = (t >= 31) ? (t - 31) / 16 : -1;
        const int jmax_w = (4 * tq + 3 >= 31) ? (4 * tq + 3 - 31) / 16 : -1;
        const bf16* kcg = KC + (size_t)g * NCMP_P * HD + dq * 32; const bf16* vcg = VC + (size_t)g * NCMP_P * HD + dq * 32;
        {
            float m = -1e30f, l = 0.f;
            for (int j = 0; j <= jmax_w; ++j) {
                const float s = dot32q(q, kcg + (size_t)j * HD) - slope * (float)(t - (16 * j + 31));
                if (j <= jmax) { const float mn = fmaxf(m, s); l = l * fast_exp(m - mn) + fast_exp(s - mn); m = mn; }
            }
            const float rl = (l > 0.f) ? 1.0f / l : 0.f;
            float o[32];
#pragma unroll
            for (int i = 0; i < 32; ++i) o[i] = 0.f;
            for (int j = 0; j <= jmax_w; ++j) {
                const float s = dot32q(q, kcg + (size_t)j * HD) - slope * (float)(t - (16 * j + 31));
                const float pj = (j <= jmax) ? fast_exp(s - m) * rl : 0.f;
                axpy32(o, pj, vcg + (size_t)j * HD);
                float ps = pj; ps += __shfl_xor(ps, 4); ps += __shfl_xor(ps, 8);
                if (dq == 0 && p == 0) { IMP[ql * 128 + (j >> 2)] += ps; if ((j & 3) == 3 && (j >> 2) + 1 < 128) IMP[ql * 128 + (j >> 2) + 1] += ps; }
            }
#pragma unroll
            for (int i = 0; i < 32; ++i) otot[i] += g0 * o[i];
        }
        LDS_WAIT(); asm volatile("" ::: "memory");
        for (int qq = 0; qq < 4; ++qq) {
            const int tt = 4 * tq + qq, cur = tt >> 6;
            const int b0 = lane_of(F), b1 = lane_of(F) + 64;
            const float s0 = (b0 == cur) ? 2e6f : (b0 == 0 ? 1e6f : (b0 * 64 <= tt ? IMP[qq * 128 + b0] : -1e6f));
            const float s1 = (b1 == cur) ? 2e6f : (b1 * 64 <= tt ? IMP[qq * 128 + b1] : -1e6f);
            int r0 = 0, r1 = 0;
            for (int b = 0; b < 128; ++b) {
                const float sb = (b == cur) ? 2e6f : (b == 0 ? 1e6f : (b * 64 <= tt ? IMP[qq * 128 + b] : -1e6f));
                r0 += (sb > s0 || (sb == s0 && b < b0)) ? 1 : 0;
                r1 += (sb > s1 || (sb == s1 && b < b1)) ? 1 : 0;
            }
            const unsigned long long m0 = __ballot(r0 < 16 && b0 * 64 <= tt), m1 = __ballot(r1 < 16 && b1 * 64 <= tt);
            if (lane_of(F) == 0) { SELW[qq * 2] = m0; SELW[qq * 2 + 1] = m1; }
        }
        LDS_WAIT(); asm volatile("" ::: "memory");
        {
            const unsigned long long my0 = SELW[ql * 2], my1 = SELW[ql * 2 + 1];
            const unsigned long long u0v = SELW[0] | SELW[2] | SELW[4] | SELW[6], u1v = SELW[1] | SELW[3] | SELW[5] | SELW[7];
            const unsigned long long u0 = ((unsigned long long)(unsigned)__builtin_amdgcn_readfirstlane((int)(u0v >> 32)) << 32) | (unsigned)__builtin_amdgcn_readfirstlane((int)(unsigned)u0v);
            const unsigned long long u1 = ((unsigned long long)(unsigned)__builtin_amdgcn_readfirstlane((int)(u1v >> 32)) << 32) | (unsigned)__builtin_amdgcn_readfirstlane((int)(unsigned)u1v);
            float m = -1e30f, l = 0.f, o[32];
#pragma unroll
            for (int i = 0; i < 32; ++i) o[i] = 0.f;
            const bf16* kg = PA + CA_KS + g * HD + dq * 32; const bf16* vg = PA + CA_VS + g * HD + dq * 32;
            for (int b = 0; b < 128; ++b) {
                const bool inu = (b < 64) ? ((u0 >> b) & 1ull) : ((u1 >> (b - 64)) & 1ull);
                if (!inu) continue;
                const bool mine = (b < 64) ? ((my0 >> b) & 1ull) : ((my1 >> (b - 64)) & 1ull);
                for (int k = 0; k < 64; ++k) {
                    const int kp = b * 64 + k;
                    const float s = dot32q(q, kg + (size_t)kp * NA) - slope * (float)(t - kp);
                    const bool valid = mine && kp <= t;
                    OSM_STEP(s, valid, vg + (size_t)kp * NA);
                }
            }
            const float sc = (l > 0.f) ? g1 / l : 0.f;
#pragma unroll
            for (int i = 0; i < 32; ++i) otot[i] += sc * o[i];
        }
        {
            float m = -1e30f, l = 0.f, o[32];
#pragma unroll
            for (int i = 0; i < 32; ++i) o[i] = 0.f;
            const bf16* kg = PA + CA_KW + g * HD + dq * 32; const bf16* vg = PA + CA_VW + g * HD + dq * 32;
            const int klo = (4 * tq - 511 > 0) ? 4 * tq - 511 : 0, khi = 4 * tq + 3;
            for (int kp = klo; kp <= khi; ++kp) {
                const float s = dot32q(q, kg + (size_t)kp * NA) - slope * (float)(t - kp);
                const bool valid = kp <= t && (t - kp) < 512;
                OSM_STEP(s, valid, vg + (size_t)kp * NA);
            }
            const float sc = (l > 0.f) ? g2 / l : 0.f;
#pragma unroll
            for (int i = 0; i < 32; ++i) otot[i] += sc * o[i];
        }
        st32(MIX + (size_t)t * DM + head * HD + dq * 32, otot);
    }
}
__device__ __forceinline__ void mem_attn_naive(Frame& F, const bf16* P, int ldp, int qcol, const float* qg, int layer) {
    const bf16* MKV = WSP(bf16, WS_MKV); bf16* MIX = WSP(bf16, WS_MIX);
    const int gw = F.vcu * NWAVES + F.wave, NGW = F.G * NWAVES;
    const int dq = lane_of(F) & 3, r = lane_of(F) >> 2;
    for (int it = gw; it < NMEMH * (T / 16); it += NGW) {
        const int hm = it / (T / 16), t = 16 * (it % (T / 16)) + r;
        float q[32]; ld32(P + (size_t)t * ldp + qcol + hm * HD + dq * 32, q);
        float ss = 0.f;
#pragma unroll
        for (int i = 0; i < 32; ++i) ss += q[i] * q[i];
        ss += __shfl_xor(ss, 1); ss += __shfl_xor(ss, 2);
        const float rs = (1.0f / sqrtf(ss * (1.f / HD) + EPS)) * QSCALE;
#pragma unroll
        for (int i = 0; i < 32; ++i) q[i] = q[i] * rs * qg[dq * 32 + i];
        float m = -1e30f, l = 0.f, o[32];
#pragma unroll
        for (int i = 0; i < 32; ++i) o[i] = 0.f;
        const bf16* kg = MKV + layer * 1024 + hm * HD + dq * 32; const bf16* vg = kg + 512;
        for (int k = 0; k < MEMT; ++k) {
            const float s = dot32q(q, kg + (size_t)k * 2048);
            OSM_STEP(s, true, vg + (size_t)k * 2048);
        }
        const float sc = 1.0f / l;
#pragma unroll
        for (int i = 0; i < 32; ++i) o[i] *= sc;
        st32(MIX + (size_t)t * DM + NMIX * HD + hm * HD + dq * 32, o);
    }
}
__device__ __forceinline__ void stick_naive(Frame& F) {
    const bf16* PB = WSP(bf16, WS_PB); bf16* MIX = WSP(bf16, WS_MIX);
    const int gw = F.vcu * NWAVES + F.wave, NGW = F.G * NWAVES;
    const int dq = lane_of(F) & 3, r = lane_of(F) >> 2;
    for (int it = gw; it < NMIX * (T / 16); it += NGW) {
        const int h = it / (T / 16), t = 16 * (it % (T / 16)) + r;
        float q[32]; ld32(PB + (size_t)t * NB + CB_Q + h * HD + dq * 32, q);
#pragma unroll
        for (int i = 0; i < 32; ++i) q[i] *= QSCALE;
        float R = 0.f, o[32];
#pragma unroll
        for (int i = 0; i < 32; ++i) o[i] = 0.f;
        const bf16* kg = PB + CB_K + h * HD + dq * 32; const bf16* vg = PB + CB_V + h * HD + dq * 32;
        for (int i = 1; ; ++i) {
            const int s = t - i;
            const bool act = s >= 0 && R > -80.f;
            if (!__any(act)) break;
            const int sc = s >= 0 ? s : 0;
            const float z = dot32q(q, kg + (size_t)sc * NB);
            const float sp = fmaxf(z, 0.f) + __logf(1.0f + fast_exp(-fabsf(z)));
            if (act) { const float a = fast_exp(z - sp + R); axpy32(o, a, vg + (size_t)sc * NB); R -= sp; }
        }
        st32(MIX + (size_t)t * DM + h * HD + dq * 32, o);
    }
}

__device__ __forceinline__ void p12_router(Frame& F) {
    const float* X3 = WSP(float, WS_X3); bf16* XN = WSP(bf16, WS_XN);
    int* TOPI = (int*)(F.ws + WS_ROUTE + RT_TOPI); float* TOPW = (float*)(F.ws + WS_ROUTE + RT_TOPW); int* HIST = (int*)(F.ws + WS_ROUTE + RT_HIST);
    const float* rw = F.in[18]; const float* rb = F.in[19]; const float* gn = F.in[4] + DM;
    LAS int* hist = (LAS int*)(F.lds + RING_OFF);
    for (int c = F.vcu; c < 256; c += F.G) {
        if (F.tid < 8) hist[F.tid] = 0;
        __syncthreads();
        for (int i = 0; i < 4; ++i) {
            const int t = 32 * c + 4 * F.wave + i;
            const f32x4* xr = (const f32x4*)(X3 + (size_t)t * DM) + lane_of(F);
            f32x4 v[8]; float s = 0.f;
#pragma unroll
            for (int j = 0; j < 8; ++j) { v[j] = xr[64 * j]; s += (v[j].x * v[j].x + v[j].y * v[j].y) + (v[j].z * v[j].z + v[j].w * v[j].w); }
            const float rstd = 1.0f / sqrtf(wave_sum(s) * (1.f / DM) + EPS);
            v2u* o8 = (v2u*)(XN + (size_t)t * DM) + lane_of(F);
            float lg[8];
#pragma unroll
            for (int e = 0; e < 8; ++e) lg[e] = 0.f;
#pragma unroll
            for (int j = 0; j < 8; ++j) {
                v2u w; w.x = pk2(v[j].x * rstd, v[j].y * rstd); w.y = pk2(v[j].z * rstd, v[j].w * rstd); o8[64 * j] = w;
                const int k0 = 4 * (lane_of(F) + 64 * j);
#pragma unroll
                for (int e4 = 0; e4 < 4; ++e4) {
                    const float xg = v[j][e4] * gn[k0 + e4];
                    const f32x4 ra = *(const f32x4*)(rw + (size_t)(k0 + e4) * 8), rb4 = *(const f32x4*)(rw + (size_t)(k0 + e4) * 8 + 4);
                    lg[0] += xg * ra.x; lg[1] += xg * ra.y; lg[2] += xg * ra.z; lg[3] += xg * ra.w; lg[4] += xg * rb4.x; lg[5] += xg * rb4.y; lg[6] += xg * rb4.z; lg[7] += xg * rb4.w;
                }
            }
#pragma unroll
            for (int e = 0; e < 8; ++e) lg[e] = wave_sum(lg[e]) * rstd;
            if (lane_of(F) == 0) {
                int i0 = 0; float b0 = lg[0] + rb[0];
#pragma unroll
                for (int e = 1; e < 8; ++e) { const float b = lg[e] + rb[e]; if (b > b0) { b0 = b; i0 = e; } }
                int i1 = -1; float b1 = -3.0e38f;
#pragma unroll
                for (int e = 0; e < 8; ++e) { const float b = lg[e] + rb[e]; if (e != i0 && b > b1) { b1 = b; i1 = e; } }
                float l0 = 0.f, l1 = 0.f;
#pragma unroll
                for (int e = 0; e < 8; ++e) { l0 = (e == i0) ? lg[e] : l0; l1 = (e == i1) ? lg[e] : l1; }
                const float w0 = 1.0f / (1.0f + expf(l1 - l0));
                TOPI[2 * t] = i0; TOPI[2 * t + 1] = i1; TOPW[2 * t] = w0; TOPW[2 * t + 1] = 1.0f - w0;
                atomicAdd((int*)&hist[i0], 1); atomicAdd((int*)&hist[i1], 1);
            }
        }
        __syncthreads();
        if (F.tid < 8) HIST[c * 8 + F.tid] = hist[F.tid];
        __syncthreads();
    }
}
__device__ __forceinline__ void p13_assign(Frame& F) {
    const bf16* XN = WSP(bf16, WS_XN); bf16* AM = WSP(bf16, WS_AMOE);
    const int* TOPI = (const int*)(F.ws + WS_ROUTE + RT_TOPI); int* ROW = (int*)(F.ws + WS_ROUTE + RT_ROW); const int* HIST = (const int*)(F.ws + WS_ROUTE + RT_HIST);
    int* TILE = (int*)(F.ws + WS_ROUTE + RT_TILE);
    LAS int* sh = (LAS int*)(F.lds + RING_OFF);
    for (int c = F.vcu; c < 256; c += F.G) {
        if (F.tid < 16) sh[16 + F.tid] = 0;
        __syncthreads();
        for (int i = F.tid; i < 2048; i += 512) { const int v = HIST[i], cc = i >> 3, ee = i & 7;
            __hip_atomic_fetch_add(&sh[16 + ee], v, __ATOMIC_RELAXED, __HIP_MEMORY_SCOPE_WORKGROUP);
            if (cc < c) __hip_atomic_fetch_add(&sh[24 + ee], v, __ATOMIC_RELAXED, __HIP_MEMORY_SCOPE_WORKGROUP); }
        __syncthreads();
        if (F.tid < 8) {
            const int e = F.tid; int off = 0;
            for (int ee = 0; ee < 8; ++ee) { if (ee == e) break; off += (sh[16 + ee] + 255) & ~255; }
            sh[e] = off + sh[24 + e];
            if (c == 0 && e == 0) {
                int nt = 0;
                for (int ee = 0; ee < 8; ++ee) { const int n = (sh[16 + ee] + 255) >> 8; for (int i = 0; i < n; ++i) TILE[16 + nt + i] = ee; nt += n; }
                TILE[0] = nt;
            }
        }
        __syncthreads();
        if (F.wave == 0) {
            const int tl = lane_of(F) >> 1, sl = lane_of(F) & 1, t = 32 * c + tl;
            const int e = TOPI[2 * t + sl];
            int row = 0;
            for (int ee = 0; ee < 8; ++ee) {
                const unsigned long long mk = __ballot(e == ee);
                if (e == ee) row = sh[ee] + __popcll(mk & ((1ull << lane_of(F)) - 1ull));
            }
            ROW[2 * t + sl] = row; sh[64 + lane_of(F)] = row;
        }
        __syncthreads();
        for (int i = 0; i < 8; ++i) {
            const int idx = 8 * F.wave + i, t = 32 * c + (idx >> 1), row = sh[64 + idx];
            const v4u* src = (const v4u*)(XN + (size_t)t * DM); v4u* dst = (v4u*)(AM + (size_t)row * DM);
#pragma unroll
            for (int j = 0; j < 4; ++j) dst[lane_of(F) + 64 * j] = src[lane_of(F) + 64 * j];
        }
        __syncthreads();
    }
}
__device__ __forceinline__ int moe_nsplit(int tail, int G) {
    const int cand[7] = {28, 14, 8, 7, 4, 2, 1};
    int s = 1;
#pragma unroll
    for (int i = 6; i >= 0; --i) if (tail * cand[i] <= G) s = cand[i];
    return s;
}
__device__ __forceinline__ void p16_combine(Frame& F) {
    const float* X3 = WSP(float, WS_X3); const bf16* Y = WSP(bf16, WS_YMOE); const float* SLAB = WSP(float, WS_SLAB);
    const int* ROW = (const int*)(F.ws + WS_ROUTE + RT_ROW); const float* TOPW = (const float*)(F.ws + WS_ROUTE + RT_TOPW); const int* TMAP = (const int*)(F.ctl + CW_TMAP);
    const int* TILE = (const int*)(F.ws + WS_ROUTE + RT_TILE);
    const int U = TILE[0] * (DM / 256), tail = U - (U / F.G) * F.G, nsp = tail > 0 ? moe_nsplit(tail, F.G) : 1;
    const int gw = F.vcu * NWAVES + F.wave, NGW = F.G * NWAVES, lane = lane_of(F);
    for (int t = gw; t < T; t += NGW) {
        const int r0 = ROW[2 * t], r1 = ROW[2 * t + 1]; const float w0 = TOPW[2 * t], w1 = TOPW[2 * t + 1];
        const f32x4* xr = (const f32x4*)(X3 + (size_t)t * DM); f32x4* orow = (f32x4*)(F.out + (size_t)t * DM);
#pragma unroll
        for (int j = 0; j < 4; ++j) {
            const int c8 = lane + 64 * j, pn = c8 >> 5, cc = (c8 & 31) * 8;
            float a[8], b[8];
            { const int tm = TMAP[(r0 >> 8) * 8 + pn];
              if (tm == 0) unpack8(*(const v4u*)(Y + (size_t)r0 * DM + 8 * c8), a);
              else { const float* sp = SLAB + (size_t)(tm - 1) * 65536 + (size_t)(r0 & 255) * 256 + cc; f32x4 u0 = {0.f, 0.f, 0.f, 0.f}, u1 = u0;
                     for (int sI = 0; sI < nsp; ++sI) { u0 += *(const f32x4*)(sp + (size_t)sI * 65536); u1 += *(const f32x4*)(sp + (size_t)sI * 65536 + 4); }
                     a[0] = u0[0]; a[1] = u0[1]; a[2] = u0[2]; a[3] = u0[3]; a[4] = u1[0]; a[5] = u1[1]; a[6] = u1[2]; a[7] = u1[3]; } }
            { const int tm = TMAP[(r1 >> 8) * 8 + pn];
              if (tm == 0) unpack8(*(const v4u*)(Y + (size_t)r1 * DM + 8 * c8), b);
              else { const float* sp = SLAB + (size_t)(tm - 1) * 65536 + (size_t)(r1 & 255) * 256 + cc; f32x4 u0 = {0.f, 0.f, 0.f, 0.f}, u1 = u0;
                     for (int sI = 0; sI < nsp; ++sI) { u0 += *(const f32x4*)(sp + (size_t)sI * 65536); u1 += *(const f32x4*)(sp + (size_t)sI * 65536 + 4); }
                     b[0] = u0[0]; b[1] = u0[1]; b[2] = u0[2]; b[3] = u0[3]; b[4] = u1[0]; b[5] = u1[1]; b[6] = u1[2]; b[7] = u1[3]; } }
            const f32x4 xa = xr[2 * c8], xb = xr[2 * c8 + 1];
            orow[2 * c8] = (f32x4){xa.x + w0 * a[0] + w1 * b[0], xa.y + w0 * a[1] + w1 * b[1], xa.z + w0 * a[2] + w1 * b[2], xa.w + w0 * a[3] + w1 * b[3]};
            orow[2 * c8 + 1] = (f32x4){xb.x + w0 * a[4] + w1 * b[4], xb.y + w0 * a[5] + w1 * b[5], xb.z + w0 * a[6] + w1 * b[6], xb.w + w0 * a[7] + w1 * b[7]};
        }
    }
}

namespace at {
typedef short bf16x8 __attribute__((ext_vector_type(8)));
typedef short s16x4 __attribute__((ext_vector_type(4)));
typedef float f32x16 __attribute__((ext_vector_type(16)));
constexpr int SHM_T = 16384;
constexpr int L_V = 0, L_K = 2 * SHM_T, L_WS = 4 * SHM_T, L_IMP = L_WS + 8 * 256, L_SEL = L_IMP + 64 * 128 * 4, L_PS = L_SEL + 1024, L_WU = L_PS + 8 * 2176, L_LIST = L_WU + 128, L_DONE = L_LIST + 512, L_END = L_DONE + 64;
static_assert(L_END <= RING_BYTES, "attention LDS map");
constexpr float C2 = 0.08838834764831845f * 1.4426950408889634f;
constexpr float LOG2E = 1.4426950408889634f;

#define KSWZ(row, colB) ((row) * 256 + ((colB) ^ (((row) & 7) << 4)))
#define SBAR() __builtin_amdgcn_sched_barrier(0)
__device__ __forceinline__ int v_st(int k, int c) { const int kk = (k & ~0xC) | ((k & 4) << 1) | ((k & 8) >> 1); return ((kk >> 3) * 4 + (c >> 5)) * 512 + ((kk & 7) * 32 + (c & 31)) * 2; }
__device__ __forceinline__ int v_rd_base(int lane) { return ((lane & 3) << 3) | (((lane >> 2) & 3) << 6) | (((lane >> 4) & 1) << 5) | (((lane >> 5) & 1) << 8); }
constexpr int v_rd_off(int d0, int ks, int half) { return d0 * 512 + ks * 4096 + half * 2048; }
__device__ __forceinline__ int crow(int r, int hi) { return (r & 3) + 8 * (r >> 2) + 4 * hi; }
__device__ __forceinline__ unsigned cvtpk(float lo, float hi) { unsigned r; asm volatile("v_cvt_pk_bf16_f32 %0, %1, %2" : "=v"(r) : "v"(lo), "v"(hi)); return r; }
__device__ __forceinline__ float xhalf_max(float v) { auto rr = __builtin_amdgcn_permlane32_swap(__float_as_uint(v), __float_as_uint(v), false, false); return fmaxf(__uint_as_float(rr[0]), __uint_as_float(rr[1])); }
__device__ __forceinline__ float xhalf_sum(float v) { auto rr = __builtin_amdgcn_permlane32_swap(__float_as_uint(v), __float_as_uint(v), false, false); return __uint_as_float(rr[0]) + __uint_as_float(rr[1]); }
__device__ __forceinline__ float quad_sum(float x) {
    x += __int_as_float(__builtin_amdgcn_update_dpp(0, __float_as_int(x), 0xB1, 0xF, 0xF, true));
    x += __int_as_float(__builtin_amdgcn_update_dpp(0, __float_as_int(x), 0x4E, 0xF, 0xF, true));
    return x;
}
__device__ __forceinline__ void pack_p(const f32x16& p0, const f32x16& p1, bf16x8& pa0, bf16x8& pa1, bf16x8& pa2, bf16x8& pa3) {
#define PK4(P, B_, OUT) do { unsigned a0 = cvtpk(P[B_+0], P[B_+1]), a1 = cvtpk(P[B_+2], P[B_+3]);                          \
        unsigned b0 = cvtpk(P[B_+4], P[B_+5]), b1 = cvtpk(P[B_+6], P[B_+7]);                                             \
        auto r0 = __builtin_amdgcn_permlane32_swap(a0, b0, false, false); auto r1 = __builtin_amdgcn_permlane32_swap(a1, b1, false, false); \
        v4u w = {r0[0], r1[0], r0[1], r1[1]}; OUT = *reinterpret_cast<bf16x8*>(&w); } while (0)
    PK4(p0, 0, pa0); PK4(p0, 8, pa1); PK4(p1, 0, pa2); PK4(p1, 8, pa3);
#undef PK4
}
template <int KB>
__device__ __forceinline__ void qkt(f32x16& p0, f32x16& p1, LAS unsigned char* lds, int r32, int hi, const bf16x8* qr) {
    p0 = f32x16{}; p1 = f32x16{};
    LAS unsigned char* kb[4];
#pragma unroll
    for (int dd = 0; dd < 4; ++dd) kb[dd] = lds + L_K + KB * SHM_T + KSWZ(r32, (dd * 16 + hi * 8) * 2);
#pragma unroll
    for (int d0 = 0; d0 < 8; ++d0) { LAS unsigned char* a = kb[d0 & 3] + (d0 >> 2) * 128;
        const bf16x8 b0 = *(const LAS bf16x8*)a;
        const bf16x8 b1 = *(const LAS bf16x8*)(a + 32 * 256);
        p0 = __builtin_amdgcn_mfma_f32_32x32x16_bf16(b0, qr[d0], p0, 0, 0, 0);
        p1 = __builtin_amdgcn_mfma_f32_32x32x16_bf16(b1, qr[d0], p1, 0, 0, 0); }
}
template <int VB>
__device__ __forceinline__ void pv_tile(f32x16* o, int vb0, bf16x8 pa0, bf16x8 pa1, bf16x8 pa2, bf16x8 pa3) {
#define TRRD(dst, off) asm volatile("ds_read_b64_tr_b16 %0, %1 offset:%2" : "=&v"(dst) : "v"(vb0), "i"(off) : "memory")
#define PV_D0(d0) do { s16x4 l0, l1, l2, l3, h0, h1, h2, h3; constexpr int b_ = VB * SHM_T + v_rd_off(d0, 0, 0); \
        TRRD(l0, b_); TRRD(h0, b_ + 2048); TRRD(l1, b_ + 4096); TRRD(h1, b_ + 6144); TRRD(l2, b_ + 8192); TRRD(h2, b_ + 10240); TRRD(l3, b_ + 12288); TRRD(h3, b_ + 14336); \
        asm volatile("s_waitcnt lgkmcnt(0)" ::: "memory"); SBAR();   \
        o[d0] = __builtin_amdgcn_mfma_f32_32x32x16_bf16(pa0, (bf16x8){l0[0], l0[1], l0[2], l0[3], h0[0], h0[1], h0[2], h0[3]}, o[d0], 0, 0, 0);   \
        o[d0] = __builtin_amdgcn_mfma_f32_32x32x16_bf16(pa1, (bf16x8){l1[0], l1[1], l1[2], l1[3], h1[0], h1[1], h1[2], h1[3]}, o[d0], 0, 0, 0);   \
        o[d0] = __builtin_amdgcn_mfma_f32_32x32x16_bf16(pa2, (bf16x8){l2[0], l2[1], l2[2], l2[3], h2[0], h2[1], h2[2], h2[3]}, o[d0], 0, 0, 0);   \
        o[d0] = __builtin_amdgcn_mfma_f32_32x32x16_bf16(pa3, (bf16x8){l3[0], l3[1], l3[2], l3[3], h3[0], h3[1], h3[2], h3[3]}, o[d0], 0, 0, 0); } while (0)
    PV_D0(0); PV_D0(1); PV_D0(2); PV_D0(3);
#undef PV_D0
#undef TRRD
}
struct Stg { v4u a, b; };
struct Tile { const bf16* K; const bf16* V; size_t ld; };
__device__ __forceinline__ void stg_load(Stg& S, const bf16* base, size_t ld, int sr, int sc) {
    S.a = *(const v4u*)(base + (size_t)sr * ld + sc); S.b = *(const v4u*)(base + (size_t)(32 + sr) * ld + sc);
}
template <int BUF> __device__ __forceinline__ void stg_write_k(const Stg& S, LAS unsigned char* lds, int sr, int sc) {
    const int kws = KSWZ(sr, sc * 2);
    *(LAS v4u*)(lds + L_K + BUF * SHM_T + kws) = S.a; *(LAS v4u*)(lds + L_K + BUF * SHM_T + kws + 32 * 256) = S.b;
}
template <int BUF> __device__ __forceinline__ void stg_write_v(const Stg& S, LAS unsigned char* lds, int sr, int sc) {
    *(LAS v4u*)(lds + L_V + BUF * SHM_T + v_st(sr, sc)) = S.a; *(LAS v4u*)(lds + L_V + BUF * SHM_T + v_st(32 + sr, sc)) = S.b;
}

template <int PASS, int KB, class Br>
__device__ __forceinline__ void step(Br& br, int i, Stg& S, LAS unsigned char* lds, int tid, const bf16x8* qr, float& m2, float& l, float f, f32x16* o) {
    int tz = tid; asm volatile("" : "+v"(tz));
    const int lane = tz & 63, sr = tz >> 4, sc = (tz & 15) * 8, r32 = lane & 31, hi = lane >> 5;
    const int vb0 = (int)(uintptr_t)(lds + L_V) + v_rd_base(lane);
    const bool more = (i + 1 < br.nt);
    Tile nx = br.tile(more ? i + 1 : i);
    if (more) stg_load(S, nx.K, nx.ld, sr, sc);
    SBAR();
    if (br.act(i)) {
        f32x16 p0, p1;
        qkt<KB>(p0, p1, lds, r32, hi, qr);
        SBAR();
        br.scores(p0, p1, i, lane);
        if (PASS == 1) {
            float pmax = p0[0];
#pragma unroll
            for (int r = 1; r < 16; ++r) pmax = fmaxf(pmax, p0[r]);
#pragma unroll
            for (int r = 0; r < 16; ++r) pmax = fmaxf(pmax, p1[r]);
            pmax = xhalf_max(pmax);
            const float mn = fmaxf(m2, pmax);
            float ps = 0.f;
#pragma unroll
            for (int r = 0; r < 16; ++r) ps += __builtin_amdgcn_exp2f(p0[r] - mn) + __builtin_amdgcn_exp2f(p1[r] - mn);
            ps = xhalf_sum(ps);
            l = l * __builtin_amdgcn_exp2f(m2 - mn) + ps; m2 = mn;
        } else {
            if (PASS == 2) {
#pragma unroll
                for (int r = 0; r < 16; ++r) { p0[r] = __builtin_amdgcn_exp2f(p0[r] - m2) * f; p1[r] = __builtin_amdgcn_exp2f(p1[r] - m2) * f; }
                br.hook(p0, p1, i, lane);
            } else {
                float ps = 0.f;
#pragma unroll
                for (int r = 0; r < 16; ++r) { p0[r] = __builtin_amdgcn_exp2f(p0[r] - m2); p1[r] = __builtin_amdgcn_exp2f(p1[r] - m2); ps += p0[r] + p1[r]; }
                l += xhalf_sum(ps);
            }
            SBAR();
            if (more) { stg_write_k<KB ^ 1>(S, lds, sr, sc); SBAR(); stg_load(S, nx.V, nx.ld, sr, sc); SBAR(); }
            bf16x8 pa0, pa1, pa2, pa3; pack_p(p0, p1, pa0, pa1, pa2, pa3);
            SBAR();
            pv_tile<KB>(o, vb0, pa0, pa1, pa2, pa3);
            SBAR();
            if (more) stg_write_v<KB ^ 1>(S, lds, sr, sc);
        }
    } else if (PASS >= 2) { if (more) { stg_write_k<KB ^ 1>(S, lds, sr, sc); SBAR(); stg_load(S, nx.V, nx.ld, sr, sc); SBAR(); stg_write_v<KB ^ 1>(S, lds, sr, sc); } }
    SBAR();
    if (PASS == 1) { if (more) stg_write_k<KB ^ 1>(S, lds, sr, sc); }
    __syncthreads();
}
template <int PASS, class Br>
__device__ __forceinline__ void run_pass(Br& br, LAS unsigned char* lds, int tid, const bf16x8* qr, float& m2, float& l, float f, f32x16* o) {
    if (br.nt <= 0) return;
    const int sr = tid >> 4, sc = (tid & 15) * 8;
    Stg S;
    { const Tile t0 = br.tile(0); stg_load(S, t0.K, t0.ld, sr, sc); stg_write_k<0>(S, lds, sr, sc);
      if (PASS >= 2) { stg_load(S, t0.V, t0.ld, sr, sc); stg_write_v<0>(S, lds, sr, sc); } }
    __syncthreads();
    for (int i = 0; i < br.nt; i += 2) {
        step<PASS, 0>(br, i, S, lds, tid, qr, m2, l, f, o);
        if (i + 1 < br.nt) step<PASS, 1>(br, i + 1, S, lds, tid, qr, m2, l, f, o);
    }
}
__device__ __forceinline__ void scale_rows(f32x16* o, float frow, LAS float* ws, int lane) {
    const int r32 = lane & 31, hi = lane >> 5;
    if (hi == 0) ws[r32] = frow;
    LDS_WAIT(); asm volatile("" ::: "memory");
#pragma unroll
    for (int r = 0; r < 16; ++r) { const float a = ws[crow(r, hi)];
#pragma unroll
        for (int d0 = 0; d0 < 4; ++d0) o[d0][r] *= a; }
    LDS_WAIT(); asm volatile("" ::: "memory");
}
__device__ __forceinline__ float gain_absmax(const float* g, int lane) {
    float a = fmaxf(fabsf(g[lane]), fabsf(g[lane + 64]));
#pragma unroll
    for (int o = 1; o < 64; o <<= 1) a = fmaxf(a, __shfl_xor(a, o));
    return __uint_as_float((unsigned)__builtin_amdgcn_readfirstlane((int)__float_as_uint(a)));
}
__device__ __forceinline__ void o_store(const f32x16* o, float* blk, int lane) {
#pragma unroll
    for (int d0 = 0; d0 < 4; ++d0) {
        float* b = blk + d0 * 1024 + lane; asm volatile("" : "+v"(b));
#pragma unroll
        for (int r = 0; r < 16; ++r) b[r * 64] = o[d0][r];
    }
}
__device__ __forceinline__ void o_addload(f32x16* o, const float* blk, int lane) {
#pragma unroll
    for (int d0 = 0; d0 < 4; ++d0) {
        const float* b = blk + d0 * 1024 + lane; asm volatile("" : "+v"(b));
#pragma unroll
        for (int r = 0; r < 16; ++r) o[d0][r] += b[r * 64];
        asm volatile("" : "+v"(o[d0]) :: "memory");
    }
}
__device__ __forceinline__ void load_q(bf16x8* qr, const bf16* qrow, int hi) {
#pragma unroll
    for (int d0 = 0; d0 < 8; ++d0) { const v4u w = *(const v4u*)(qrow + d0 * 16 + hi * 8); qr[d0] = *reinterpret_cast<const bf16x8*>(&w); }
}

struct RowNsa { int t; float slope2; };
struct BrCmp {
    int nt; const bf16* K; const bf16* V; int jmax_w; RowNsa R;
    LAS float* ps; LAS float* imp;
    __device__ __forceinline__ Tile tile(int i) const { return Tile{K + (size_t)i * 64 * HD, V + (size_t)i * 64 * HD, (size_t)HD}; }
    __device__ __forceinline__ bool act(int i) const { return 64 * i <= jmax_w; }
    __device__ __forceinline__ void scores(f32x16& p0, f32x16& p1, int i, int lane) const {
        const float NEG = -__builtin_inff(); const int hi = lane >> 5;
        float sl = R.slope2; asm volatile("" : "+v"(sl));
        int tt = R.t; asm volatile("" : "+v"(tt));
        const int jmax = (tt >= 31) ? ((tt - 31) >> 4) : -1;
        const int jm = jmax - 64 * i - 4 * hi;
        const float b0 = -sl * (float)(tt - 31 - 16 * (64 * i + 4 * hi));
#pragma unroll
        for (int r = 0; r < 16; ++r) { const int c = (r & 3) + 8 * (r >> 2);
            p0[r] = (c <= jm) ? fmaf(p0[r], C2, fmaf(sl, (float)(16 * c), b0)) : NEG;
            p1[r] = (c + 32 <= jm) ? fmaf(p1[r], C2, fmaf(sl, (float)(16 * c + 512), b0)) : NEG; }
    }
    __device__ __forceinline__ void hook(const f32x16& p0, const f32x16& p1, int i, int lane) const {
        const int r32 = lane & 31, hi = lane >> 5, pp = r32 & 3, ql = r32 >> 2;
#pragma unroll
        for (int qd = 0; qd < 4; ++qd) {
            f32x4 a, b;
#pragma unroll
            for (int e = 0; e < 4; ++e) { a[e] = quad_sum(p0[4 * qd + e]); b[e] = quad_sum(p1[4 * qd + e]); }
            if (pp == qd) { *(LAS f32x4*)(ps + ql * 68 + 4 + 8 * qd + 4 * hi) = a; *(LAS f32x4*)(ps + ql * 68 + 4 + 32 + 8 * qd + 4 * hi) = b; }
        }
        LDS_WAIT(); asm volatile("" ::: "memory");
#pragma unroll
        for (int h2 = 0; h2 < 2; ++h2) { const int idx = lane + 64 * h2, q8 = idx >> 4, mq = idx & 15;
            const f32x4 v = *(const LAS f32x4*)(ps + q8 * 68 + 4 + 4 * mq); const float pv = ps[q8 * 68 + 3 + 4 * mq];
            imp[q8 * 128 + 16 * i + mq] = (v[0] + v[1]) + (v[2] + v[3]) + pv; }
        LDS_WAIT(); asm volatile("" ::: "memory");
        if (lane < 8) ps[lane * 68 + 3] = ps[lane * 68 + 4 + 63];
        LDS_WAIT(); asm volatile("" ::: "memory");
    }
};
struct BrSlc {
    int nt; const bf16* K; const bf16* V; RowNsa R;
    const LAS int* list; const LAS unsigned long long* sel; const LAS unsigned long long* wu;
    __device__ __forceinline__ int blk(int i) const { return list[i]; }
    __device__ __forceinline__ Tile tile(int i) const { const int b = __builtin_amdgcn_readfirstlane(blk(i)); return Tile{K + (size_t)b * 64 * NA, V + (size_t)b * 64 * NA, (size_t)NA}; }
    __device__ __forceinline__ bool act(int i) const { const int b = __builtin_amdgcn_readfirstlane(blk(i)); const unsigned long long u = wu[b >> 6]; return (u >> (b & 63)) & 1ull; }
    __device__ __forceinline__ void scores(f32x16& p0, f32x16& p1, int i, int lane) const {
        const float NEG = -__builtin_inff(); const int b = __builtin_amdgcn_readfirstlane(blk(i)); const int hi = lane >> 5, ql = (lane & 31) >> 2;
        const unsigned long long mm = sel[ql * 2 + (b >> 6)];
        const bool mine = (mm >> (b & 63)) & 1ull;
        float sl = R.slope2; asm volatile("" : "+v"(sl));
        int tt = R.t; asm volatile("" : "+v"(tt));
        const int dm = mine ? (tt - 64 * b - 4 * hi) : -1;
        const float b0 = -sl * (float)dm;
#pragma unroll
        for (int r = 0; r < 16; ++r) { const int c = (r & 3) + 8 * (r >> 2);
            p0[r] = (c <= dm) ? fmaf(p0[r], C2, fmaf(sl, (float)c, b0)) : NEG;
            p1[r] = (c + 32 <= dm) ? fmaf(p1[r], C2, fmaf(sl, (float)(c + 32), b0)) : NEG; }
    }
    __device__ __forceinline__ void hook(const f32x16&, const f32x16&, int, int) const {}
};
struct BrWin {
    int nt; const bf16* K; const bf16* V; RowNsa R; int kb0;
    __device__ __forceinline__ Tile tile(int i) const { return Tile{K + (size_t)(kb0 + i) * 64 * NA, V + (size_t)(kb0 + i) * 64 * NA, (size_t)NA}; }
    __device__ __forceinline__ bool act(int) const { return true; }
    __device__ __forceinline__ void scores(f32x16& p0, f32x16& p1, int i, int lane) const {
        const float NEG = -__builtin_inff(); const int hi = lane >> 5;
        float sl = R.slope2; asm volatile("" : "+v"(sl));
        int tt = R.t; asm volatile("" : "+v"(tt));
        const int dm = tt - 64 * (kb0 + i) - 4 * hi;
        const float b0 = -sl * (float)dm;
#pragma unroll
        for (int r = 0; r < 16; ++r) { const int c = (r & 3) + 8 * (r >> 2);
            p0[r] = ((unsigned)(dm - c) < 512u) ? fmaf(p0[r], C2, fmaf(sl, (float)c, b0)) : NEG;
            p1[r] = ((unsigned)(dm - c - 32) < 512u) ? fmaf(p1[r], C2, fmaf(sl, (float)(c + 32), b0)) : NEG; }
    }
    __device__ __forceinline__ void hook(const f32x16&, const f32x16&, int, int) const {}
};
struct BrMem {
    int nt; const bf16* K; const bf16* V;
    __device__ __forceinline__ Tile tile(int i) const { return Tile{K + (size_t)i * 64 * 2048, V + (size_t)i * 64 * 2048, (size_t)2048}; }
    __device__ __forceinline__ bool act(int) const { return true; }
    __device__ __forceinline__ void scores(f32x16& p0, f32x16& p1, int, int) const {
#pragma unroll
        for (int r = 0; r < 16; ++r) { p0[r] *= C2; p1[r] *= C2; }
    }
    __device__ __forceinline__ void hook(const f32x16&, const f32x16&, int, int) const {}
};
template <class RP> __device__ __forceinline__ void store_o(const f32x16* o, int lane, RP rowptr) {
    const int r32 = lane & 31, hi = lane >> 5;
#pragma unroll
    for (int r = 0; r < 16; ++r) { bf16* rp = rowptr(crow(r, hi));
#pragma unroll
        for (int d0 = 0; d0 < 4; ++d0) { const float v = o[d0][r]; const float vn = __shfl_xor(v, 1);
            if ((r32 & 1) == 0) *(unsigned*)(rp + d0 * 32 + r32) = cvtpk(v, vn); } }
}
}

__device__ __forceinline__ void topk_select(unsigned k0, unsigned k1, int need, int lane, unsigned long long& s0, unsigned long long& s1) {
    unsigned thr = 0u;
    for (int bit = 31; bit >= 0; --bit) {
        const unsigned cand = thr | (1u << bit);
        const int cnt = __popcll(__ballot(k0 >= cand)) + __popcll(__ballot(k1 >= cand));
        if (cnt >= need) thr = cand;
    }
    const unsigned long long g0 = __ballot(k0 > thr), g1 = __ballot(k1 > thr), e0 = __ballot(k0 == thr && thr != 0u), e1 = __ballot(k1 == thr && thr != 0u);
    const int rem = need - (__popcll(g0) + __popcll(g1));
    const unsigned long long lt = (1ull << lane) - 1ull;
    const bool t0 = (k0 == thr && thr != 0u) && (__popcll(e0 & lt) < rem);
    const bool t1 = (k1 == thr && thr != 0u) && (__popcll(e0) + __popcll(e1 & lt) < rem);
    s0 = g0 | __ballot(t0); s1 = g1 | __ballot(t1);
}

__device__ __forceinline__ void nsa_item(Frame& F, int g, int qb, float mb_slc, float mb_win) {
    using namespace at;
    LAS unsigned char* lds = F.lds + RING_OFF;
    const bf16* PA = WSP(bf16, WS_PA); const bf16* KC = WSP(bf16, WS_KCMP) + (size_t)g * NCMP_P * HD; const bf16* VC = KC + (size_t)NG * NCMP_P * HD; bf16* MIX = WSP(bf16, WS_MIX);
    int tz = F.tid; asm volatile("" : "+v"(tz));
    const int lane = tz & 63, w = F.wave, r32 = lane & 31, hi = lane >> 5;
    const int t0 = 64 * qb, tw = t0 + 8 * w, ql = r32 >> 2, pp = r32 & 3, t = tw + ql, head = 4 * g + pp;
    LAS float* ws = (LAS float*)(lds + L_WS + w * 256);
    LAS float* IMP = (LAS float*)(lds + L_IMP) + w * 8 * 128;
    LAS float* PS = (LAS float*)(lds + L_PS + w * 2176);
    LAS unsigned long long* SEL = (LAS unsigned long long*)(lds + L_SEL);
    LAS unsigned long long* WU = (LAS unsigned long long*)(lds + L_WU);
    LAS int* LIST = (LAS int*)(lds + L_LIST);
    float* oacc = WSP(float, WS_OACC) + ((size_t)((g * 128 + qb) * 8 + w)) * 4096;
    RowNsa R; R.t = t; R.slope2 = exp2f(-8.0f * (float)(head + 1) / 12.0f) * LOG2E;
    bf16x8 qr[8]; load_q(qr, PA + (size_t)t * NA + CA_Q + head * HD, hi);
#define GATE(br_) (1.0f / (1.0f + fast_exp(-bf2f(PA[(size_t)t * NA + CA_GT + head * 3 + (br_)]))))
    f32x16 o[4] = {};
    for (int i = lane; i < 8 * 128; i += 64) IMP[i] = 0.f;
    if (lane < 8) PS[lane * 68 + 3] = 0.f;
    LDS_WAIT(); asm volatile("" ::: "memory");
    {
        BrCmp br; br.K = KC; br.V = VC; br.R = R; br.ps = PS; br.imp = IMP;
        br.jmax_w = (tw + 7 >= 31) ? (tw + 7 - 31) / 16 : -1;
        const int jmax_b = (t0 + 63 - 31) / 16;
        br.nt = jmax_b / 64 + 1;
        float m2 = -1e30f, l = 0.f;
        run_pass<1>(br, lds, tz, qr, m2, l, 0.f, o);
        const float f = (l > 0.f) ? 1.0f / l : 0.f;
        run_pass<2>(br, lds, tz, qr, m2, l, f, o);
        scale_rows(o, GATE(0), ws, lane);
        o_store(o, oacc, lane);
#pragma unroll
        for (int d0 = 0; d0 < 4; ++d0) o[d0] = f32x16{};
    }
    for (int qq = 0; qq < 8; ++qq) {
        const int tt = tw + qq, cur = tt >> 6;
        const int b0 = lane, b1 = lane + 64;
        unsigned long long s0 = 0ull, s1 = 0ull;
        const int ncand = cur - 1;
        const bool c0 = (b0 >= 1 && b0 < cur), c1 = (b1 < cur);
        if (ncand <= 14) { s0 = __ballot(c0); s1 = __ballot(c1); }
        else {
            const unsigned k0 = c0 ? (__float_as_uint(IMP[qq * 128 + b0]) + 1u) : 0u, k1 = c1 ? (__float_as_uint(IMP[qq * 128 + b1]) + 1u) : 0u;
            topk_select(k0, k1, 14, lane, s0, s1);
        }
        s0 |= 1ull;
        if (cur < 64) s0 |= (1ull << cur); else s1 |= (1ull << (cur - 64));
        if (lane == 0) { SEL[(8 * w + qq) * 2] = s0; SEL[(8 * w + qq) * 2 + 1] = s1; }
    }
    LDS_WAIT(); asm volatile("" ::: "memory");
    unsigned long long wu0 = 0ull, wu1 = 0ull;
#pragma unroll
    for (int qq = 0; qq < 8; ++qq) { wu0 |= SEL[(8 * w + qq) * 2]; wu1 |= SEL[(8 * w + qq) * 2 + 1]; }
    if (lane == 0) { WU[2 * w] = wu0; WU[2 * w + 1] = wu1; }
    __syncthreads();
    int nsl = 0;
    {
        unsigned long long u0 = 0ull, u1 = 0ull;
#pragma unroll
        for (int ww = 0; ww < 8; ++ww) { u0 |= WU[2 * ww]; u1 |= WU[2 * ww + 1]; }
        nsl = __popcll(u0) + __popcll(u1);
        if (w == 0) {
            const unsigned long long lt = (1ull << lane) - 1ull;
            if ((u0 >> lane) & 1ull) LIST[__popcll(u0 & lt)] = lane;
            if ((u1 >> lane) & 1ull) LIST[__popcll(u0) + __popcll(u1 & lt)] = lane + 64;
        }
    }
    __syncthreads();
    {
        BrSlc br; br.K = PA + CA_KS + g * HD; br.V = PA + CA_VS + g * HD; br.R = R; br.list = LIST; br.nt = nsl;
        br.sel = SEL + 16 * w; br.wu = WU + 2 * w;
        float m2 = mb_slc, l = 0.f;
        run_pass<3>(br, lds, tz, qr, m2, l, 0.f, o);
        scale_rows(o, (l > 0.f) ? GATE(1) / l : 0.f, ws, lane);
        o_addload(o, oacc, lane); o_store(o, oacc, lane);
#pragma unroll
        for (int d0 = 0; d0 < 4; ++d0) o[d0] = f32x16{};
    }
    {
        BrWin br; br.K = PA + CA_KW + g * HD; br.V = PA + CA_VW + g * HD; br.R = R;
        br.kb0 = (t0 - 511 > 0) ? ((t0 - 511) >> 6) : 0; br.nt = qb - br.kb0 + 1;
        float m2 = mb_win, l = 0.f;
        run_pass<3>(br, lds, tz, qr, m2, l, 0.f, o);
        scale_rows(o, (l > 0.f) ? GATE(2) / l : 0.f, ws, lane);
        o_addload(o, oacc, lane);
    }
    store_o(o, lane, [&](int row) { return MIX + (size_t)(tw + (row >> 2)) * DM + (4 * g + (row & 3)) * HD; });
#undef GATE
}
__device__ __forceinline__ void mem_item(Frame& F, const bf16* P, int ldp, int qcol, const float* qg, int layer, int hm, int qb, float mb_mem) {
    using namespace at;
    LAS unsigned char* lds = F.lds + RING_OFF;
    const bf16* MKV = WSP(bf16, WS_MKV); bf16* MIX = WSP(bf16, WS_MIX);
    int tz = F.tid; asm volatile("" : "+v"(tz));
    const int lane = tz & 63, w = F.wave, r32 = lane & 31, hi = lane >> 5;
    const int tw = 256 * qb + 32 * w, t = tw + r32;
    bf16x8 qr[8];
    {
        const bf16* qrow = P + (size_t)t * ldp + qcol + hm * HD;
        float qf[64]; float ss = 0.f;
#pragma unroll
        for (int d0 = 0; d0 < 8; ++d0) { const v4u wv = *(const v4u*)(qrow + d0 * 16 + hi * 8); unpack8(wv, qf + 8 * d0); }
#pragma unroll
        for (int i = 0; i < 64; ++i) ss += qf[i] * qf[i];
        ss = xhalf_sum(ss);
        const float rs = 1.0f / sqrtf(ss * (1.f / HD) + EPS);
#pragma unroll
        for (int d0 = 0; d0 < 8; ++d0) { const float* gp = qg + d0 * 16 + hi * 8;
            v4u wv; wv.x = cvtpk(qf[8 * d0] * rs * gp[0], qf[8 * d0 + 1] * rs * gp[1]); wv.y = cvtpk(qf[8 * d0 + 2] * rs * gp[2], qf[8 * d0 + 3] * rs * gp[3]);
            wv.z = cvtpk(qf[8 * d0 + 4] * rs * gp[4], qf[8 * d0 + 5] * rs * gp[5]); wv.w = cvtpk(qf[8 * d0 + 6] * rs * gp[6], qf[8 * d0 + 7] * rs * gp[7]);
            qr[d0] = *reinterpret_cast<const bf16x8*>(&wv); }
    }
    f32x16 o[4] = {};
    BrMem br; br.nt = 4; br.K = MKV + layer * 1024 + hm * HD; br.V = br.K + 512;
    float m2 = mb_mem, l = 0.f;
    run_pass<3>(br, lds, tz, qr, m2, l, 0.f, o);
    scale_rows(o, 1.0f / l, (LAS float*)(lds + L_WS + w * 256), lane);
    store_o(o, lane, [&](int row) { return MIX + (size_t)(tw + row) * DM + NMIX * HD + hm * HD; });
}
__device__ __forceinline__ void p3_attn(Frame& F) {
    const int ln = lane_of(F);
    using at::gain_absmax; using at::C2;
    const float gq = gain_absmax(F.in[8], ln);
    const float mb_slc = 128.f * C2 * 1.01f * gq * gain_absmax(F.in[9] + HD, ln), mb_win = 128.f * C2 * 1.01f * gq * gain_absmax(F.in[9] + 2 * HD, ln);
    const float mb_mem = 128.f * C2 * 1.01f * gain_absmax(F.in[14], ln) * gain_absmax(F.in[14] + HD, ln);
    for (int it = F.vcu; it < 384 + 128; it += F.G) {
        if (it < 384) { const int g = it % 3, qb = 127 - it / 3; nsa_item(F, g, qb, mb_slc, mb_win); }
        else { const int j = it - 384; mem_item(F, WSP(bf16, WS_PA), NA, CA_QM, F.in[14], 0, j & 3, j >> 2, mb_mem); }
        __syncthreads();
    }
}

__device__ __forceinline__ void stick_tile(at::f32x16& p0, at::f32x16& p1, int k0, int t, int hi, float& R2) {
    using namespace at;
    float L0[16], L1[16];
    const float NEG = -__builtin_inff();
#pragma unroll
    for (int r = 0; r < 16; ++r) {
        const int kk = k0 + crow(r, hi);
        { const float z = p0[r] * C2; const float sp = fmaxf(z, 0.f) + __builtin_amdgcn_logf(1.0f + __builtin_amdgcn_exp2f(-fabsf(z))); const bool v = kk < t; L0[r] = v ? -sp : 0.f; p0[r] = v ? z - sp : NEG; }
        { const float z = p1[r] * C2; const float sp = fmaxf(z, 0.f) + __builtin_amdgcn_logf(1.0f + __builtin_amdgcn_exp2f(-fabsf(z))); const bool v = kk + 32 < t; L1[r] = v ? -sp : 0.f; p1[r] = v ? z - sp : NEG; }
    }
    float ct[8], pt[8];
#pragma unroll
    for (int c = 0; c < 4; ++c) { ct[c] = (L0[4 * c] + L0[4 * c + 1]) + (L0[4 * c + 2] + L0[4 * c + 3]); ct[4 + c] = (L1[4 * c] + L1[4 * c + 1]) + (L1[4 * c + 2] + L1[4 * c + 3]); }
#pragma unroll
    for (int c = 0; c < 8; ++c) { auto rr = __builtin_amdgcn_permlane32_swap(__float_as_uint(ct[c]), __float_as_uint(ct[c]), false, false); pt[c] = __uint_as_float(hi ? rr[0] : rr[1]); }
    float E[8]; float run = 0.f;
#pragma unroll
    for (int c = 7; c >= 0; --c) { E[c] = run + (hi == 0 ? pt[c] : 0.f); run += ct[c] + pt[c]; }
#pragma unroll
    for (int c = 0; c < 4; ++c) {
        { const float a3 = R2 + E[c], a2 = a3 + L0[4 * c + 3], a1 = a2 + L0[4 * c + 2], a0 = a1 + L0[4 * c + 1];
          p0[4 * c + 3] = __builtin_amdgcn_exp2f(p0[4 * c + 3] + a3); p0[4 * c + 2] = __builtin_amdgcn_exp2f(p0[4 * c + 2] + a2); p0[4 * c + 1] = __builtin_amdgcn_exp2f(p0[4 * c + 1] + a1); p0[4 * c] = __builtin_amdgcn_exp2f(p0[4 * c] + a0); }
        { const float a3 = R2 + E[4 + c], a2 = a3 + L1[4 * c + 3], a1 = a2 + L1[4 * c + 2], a0 = a1 + L1[4 * c + 1];
          p1[4 * c + 3] = __builtin_amdgcn_exp2f(p1[4 * c + 3] + a3); p1[4 * c + 2] = __builtin_amdgcn_exp2f(p1[4 * c + 2] + a2); p1[4 * c + 1] = __builtin_amdgcn_exp2f(p1[4 * c + 1] + a1); p1[4 * c] = __builtin_amdgcn_exp2f(p1[4 * c] + a0); }
    }
    R2 += run;
}
template <int KB>
__device__ __forceinline__ bool stick_step(int kb, int kb_w, at::Stg& S, LAS unsigned char* lds, int tid, const bf16* Kh, const bf16* Vh, const at::bf16x8* qr, at::f32x16* o, int tw, float& R2, LAS int* DONE) {
    using namespace at;
    int tz = tid; asm volatile("" : "+v"(tz));
    const int lane = tz & 63, w = __builtin_amdgcn_readfirstlane(tz >> 6), r32 = lane & 31, hi = lane >> 5, sr = tz >> 4, sc = (tz & 15) * 8;
    const int vb0 = (int)(uintptr_t)(lds + L_V) + v_rd_base(lane);
    int t = tw + r32; asm volatile("" : "+v"(t));
    const float THR2 = -100.f;
    const bool more = kb > 0;
    const bf16* Kn = Kh + (size_t)(more ? kb - 1 : kb) * 64 * NB; const bf16* Vn = Vh + (size_t)(more ? kb - 1 : kb) * 64 * NB;
    if (more) stg_load(S, Kn, NB, sr, sc);
    SBAR();
    bool wdone = false, kdone = false;
    if (kb <= kb_w) {
        if (__any(R2 > THR2)) {
            f32x16 p0, p1; qkt<KB>(p0, p1, lds, r32, hi, qr);
            SBAR();
            stick_tile(p0, p1, 64 * kb, t, hi, R2);
            SBAR();
            if (more) { stg_write_k<KB ^ 1>(S, lds, sr, sc); SBAR(); stg_load(S, Vn, NB, sr, sc); SBAR(); } kdone = true;
            bf16x8 pa0, pa1, pa2, pa3; pack_p(p0, p1, pa0, pa1, pa2, pa3);
            SBAR();
            pv_tile<KB>(o, vb0, pa0, pa1, pa2, pa3);
            SBAR();
        }
        wdone = !__any(R2 > THR2);
    }
    if (lane == 0) DONE[(kb & 1) * 8 + w] = wdone ? 1 : 0;
    if (more) { if (!kdone) { stg_write_k<KB ^ 1>(S, lds, sr, sc); SBAR(); stg_load(S, Vn, NB, sr, sc); SBAR(); } stg_write_v<KB ^ 1>(S, lds, sr, sc); }
    __syncthreads();
    int alld = 1;
#pragma unroll
    for (int ww = 0; ww < 8; ++ww) alld &= DONE[(kb & 1) * 8 + ww];
    return more && !alld;
}
__device__ __forceinline__ void stick_item(Frame& F, int h, int qb) {
    using namespace at;
    LAS unsigned char* lds = F.lds + RING_OFF;
    const bf16* PB = WSP(bf16, WS_PB); bf16* MIX = WSP(bf16, WS_MIX);
    int tid = F.tid; asm volatile("" : "+v"(tid));
    const int lane = tid & 63, w = F.wave, r32 = lane & 31, hi = lane >> 5, sr = tid >> 4, sc = (tid & 15) * 8;
    const int q0 = 256 * qb, tw = q0 + 32 * w, t = tw + r32;
    LAS int* DONE = (LAS int*)(lds + L_DONE);
    bf16x8 qr[8]; load_q(qr, PB + (size_t)t * NB + CB_Q + h * HD, hi);
    f32x16 o[4] = {};
    const bf16* Kh = PB + CB_K + h * HD; const bf16* Vh = PB + CB_V + h * HD;
    const int kb_hi = q0 / 64 + 3, kb_w = q0 / 64 + (w >> 1);
    float R2 = 0.f;
    Stg S;
    stg_load(S, Kh + (size_t)kb_hi * 64 * NB, NB, sr, sc); stg_write_k<0>(S, lds, sr, sc);
    stg_load(S, Vh + (size_t)kb_hi * 64 * NB, NB, sr, sc); stg_write_v<0>(S, lds, sr, sc);
    __syncthreads();
    for (int kb = kb_hi; ; kb -= 2) {
        if (!stick_step<0>(kb, kb_w, S, lds, tid, Kh, Vh, qr, o, tw, R2, DONE)) break;
        if (!stick_step<1>(kb - 1, kb_w, S, lds, tid, Kh, Vh, qr, o, tw, R2, DONE)) break;
    }
    store_o(o, lane, [&](int row) { return MIX + (size_t)(tw + row) * DM + h * HD; });
}
__device__ __forceinline__ void p10_attn(Frame& F) {
    const int ln = lane_of(F);
    const float mb_mem = 128.f * at::C2 * 1.01f * at::gain_absmax(F.in[14] + 2 * HD, ln) * at::gain_absmax(F.in[14] + 3 * HD, ln);
    for (int it = F.vcu; it < 384 + 128; it += F.G) {
        if (it < 384) { const int h = it % 12, qb = 31 - it / 12; stick_item(F, h, qb); }
        else { const int j = it - 384; mem_item(F, WSP(bf16, WS_PB), NB, CB_QM, F.in[14] + 2 * HD, 1, j & 3, j >> 2, mb_mem); }
        __syncthreads();
    }
}

constexpr int N_PHASES = 17;
#ifndef MK_PROBE_SUB
#define MK_PROBE_SUB 0
#endif
#ifndef MK_PROBE_MASK
#define MK_PROBE_MASK 0
#endif
#ifndef MK_NAIVE_P3
#define MK_NAIVE_P3 0
#endif
#ifndef MK_NAIVE_P10
#define MK_NAIVE_P10 0
#endif
struct Args { const float* in[22]; float* out; unsigned char* ws; int ph_lo, ph_hi, use_bar, pad; };
__global__ void __launch_bounds__(NWAVES * 64, 2) mk_fwd(Args args) {
    extern __shared__ __attribute__((aligned(16))) unsigned char lds[];
    Frame F;
    F.lds = (LAS unsigned char*)lds;
    F.MISC = (volatile LAS unsigned*)(F.lds + MISC_OFF);
    F.tid = threadIdx.x;  F.wave = __builtin_amdgcn_readfirstlane(F.tid >> 6);
    F.G = gridDim.x; { const int bx = blockIdx.x; F.vcu = (F.G % 8 == 0) ? (bx % 8) * (F.G / 8) + bx / 8 : bx; }
    F.ws = args.ws; F.ctl = (gu32*)(args.ws + WS_CTL); F.out = args.out;
#pragma unroll
    for (int i = 0; i < 22; ++i) F.in[i] = args.in[i];
    for (int u = F.tid; u < (LDS_BYTES - LDSCTL_OFF) / 4; u += NWAVES * 64) ((LAS unsigned*)(F.lds + LDSCTL_OFF))[u] = 0u;
    __syncthreads();
    XcdBarrier bar; bar.bar = (unsigned*)(F.ctl + CW_BAR); bar.x = 0; bar.st = nullptr;
    if (args.use_bar) bar = xcd_barrier_post((unsigned*)(F.ctl + CW_BAR), F.MISC + 8);
#define GRID_BAR() do { if (args.use_bar) xcd_barrier(bar); F.tid = threadIdx.x; asm volatile("" : "+v"(F.tid));  } while (0)
    const int lo = args.ph_lo, hi = args.ph_hi;
#ifdef MK_ONLY_PHASE
#define IN(k) ((k) == MK_ONLY_PHASE && lo <= (k) && (k) < hi)
#else
#define IN(k) (lo <= (k) && (k) < hi)
#endif
#define BOTH(k) (IN(k) && IN((k) + 1))
    typedef pg8::StaticOrder SO;

    if (IN(0)) { p0_prologue(F); if (!args.use_bar) conv_list(F, CV_DEFER0 + F.vcu * NWAVES + F.wave, F.G * NWAVES, CV_TOTAL); if (BOTH(0)) GRID_BAR(); }
    if (IN(1)) {
        { pg8::Gemm g{WSP(bf16, WS_XN), WSP(bf16, WS_WT_INA), DM, DM / 64}; SO S; S.init(T / 256, NA / 256, F.G, (int)blockIdx.x);
          pg8::EpiBf16 E{WSP(bf16, WS_PA), NA}; pg8::gemm_phase<pg8::EpiBf16, SO, true, true>(F.lds + RING_OFF, g, S, E); }
        { pg8::Gemm g{WSP(bf16, WS_MEMN), WSP(bf16, WS_WT_MEM), DM, DM / 64}; SO S; S.init(1, 8, F.G, (int)(F.G - 1 - blockIdx.x));
          pg8::EpiBf16 E{WSP(bf16, WS_MKV), 2048}; pg8::gemm_phase<pg8::EpiBf16, SO, true, true>(F.lds + RING_OFF, g, S, E); }
        if (args.use_bar) idle_fill(F, 1);
        if (BOTH(1)) GRID_BAR();
    }
    if (IN(2)) { if (args.pad != 2) p2_compress(F); if (args.pad != 1) p2_qknorm(F); if (args.use_bar) idle_fill(F, 2); if (BOTH(2)) GRID_BAR(); }
#if MK_NAIVE_P3
    if (IN(3)) { p3_nsa_naive(F); mem_attn_naive(F, WSP(bf16, WS_PA), NA, CA_QM, F.in[14], 0); if (BOTH(3)) GRID_BAR(); }
#else
    if (IN(3)) { p3_attn(F); if (args.use_bar) idle_fill(F, 3); if (BOTH(3)) GRID_BAR(); }
#endif
    if (IN(4)) { pg8::Gemm g{WSP(bf16, WS_MIX), WSP(bf16, WS_WT_OUT), DM, DM / 64}; SO S; S.init(T / 256, DM / 256, F.G, (int)blockIdx.x);
        pg8::EpiResF32 E{F.in[0], WSP(float, WS_X1), DM}; pg8::gemm_phase<pg8::EpiResF32, SO, true, true>(F.lds + RING_OFF, g, S, E); if (BOTH(4)) GRID_BAR(); }
    if (IN(5)) { rmsnorm_rows(F, WSP(float, WS_X1), WSP(bf16, WS_XN), T); if (BOTH(5)) GRID_BAR(); }
    if (IN(6)) { pg8::Gemm g{WSP(bf16, WS_XN), WSP(bf16, WS_WT_FGU), DM, DM / 64}; SO S; S.init(T / 256, 2 * FF / 256, F.G, (int)blockIdx.x);
        pg8::EpiSwiglu E{WSP(bf16, WS_HFF), FF}; pg8::gemm_phase<pg8::EpiSwiglu, SO, true, true>(F.lds + RING_OFF, g, S, E); if (BOTH(6)) GRID_BAR(); }
    if (IN(7)) { pg8::Gemm g{WSP(bf16, WS_HFF), WSP(bf16, WS_WT_FDN), FF, FF / 64}; SO S; S.init(T / 256, DM / 256, F.G, (int)blockIdx.x);
        pg8::EpiResF32 E{WSP(float, WS_X1), WSP(float, WS_X2), DM}; pg8::gemm_phase<pg8::EpiResF32, SO, true, true>(F.lds + RING_OFF, g, S, E); if (BOTH(7)) GRID_BAR(); }
    if (IN(8)) { rmsnorm_rows(F, WSP(float, WS_X2), WSP(bf16, WS_XN), T); if (BOTH(8)) GRID_BAR(); }
    if (IN(9)) { pg8::Gemm g{WSP(bf16, WS_XN), WSP(bf16, WS_WT_INB), DM, DM / 64}; SO S; S.init(T / 256, NB / 256, F.G, (int)blockIdx.x);
        pg8::EpiBf16 E{WSP(bf16, WS_PB), NB}; pg8::gemm_phase<pg8::EpiBf16, SO, true, true>(F.lds + RING_OFF, g, S, E); if (args.use_bar) idle_fill(F, 9); if (BOTH(9)) GRID_BAR(); }
#if MK_NAIVE_P10
    if (IN(10)) { stick_naive(F); mem_attn_naive(F, WSP(bf16, WS_PB), NB, CB_QM, F.in[14] + 2 * HD, 1); if (BOTH(10)) GRID_BAR(); }
#else
    if (IN(10)) { p10_attn(F); if (args.use_bar) idle_fill(F, 10); if (BOTH(10)) GRID_BAR(); }
#endif
    if (IN(11)) { pg8::Gemm g{WSP(bf16, WS_MIX), WSP(bf16, WS_WT_OUT) + (size_t)DM * DM, DM, DM / 64}; SO S; S.init(T / 256, DM / 256, F.G, (int)blockIdx.x);
        pg8::EpiResF32 E{WSP(float, WS_X2), WSP(float, WS_X3), DM}; pg8::gemm_phase<pg8::EpiResF32, SO, true, true>(F.lds + RING_OFF, g, S, E); if (BOTH(11)) GRID_BAR(); }
    if (IN(12)) { p12_router(F); if (BOTH(12)) GRID_BAR(); }
    if (IN(13)) { p13_assign(F); if (args.use_bar) conv_drain(F); if (BOTH(13)) GRID_BAR(); }
    if (IN(14)) { const int* TILE = (const int*)(F.ws + WS_ROUTE + RT_TILE); const int ntl = TILE[0];
        pg8::Gemm g{WSP(bf16, WS_AMOE), WSP(bf16, WS_WT_MGU), DM, DM / 64}; pg8::MoeOrder S; S.init(ntl, 2 * FF / 256, F.G, (int)blockIdx.x); S.tile_e = TILE + 16; S.estride = (size_t)2 * FF * DM * 2;
        pg8::EpiSwiglu E{WSP(bf16, WS_HMOE), FF}; pg8::gemm_phase<pg8::EpiSwiglu, pg8::MoeOrder, true, true>(F.lds + RING_OFF, g, S, E); if (BOTH(14)) GRID_BAR(); }
    if (IN(15)) { const int* TILE = (const int*)(F.ws + WS_ROUTE + RT_TILE); const int ntl = TILE[0];
        const int U = ntl * (DM / 256), full = (U / F.G) * F.G, tail = U - full;
        { pg8::Gemm g{WSP(bf16, WS_HMOE), WSP(bf16, WS_WT_MDN), FF, FF / 64}; pg8::MoeOrder S; S.init(ntl, DM / 256, F.G, (int)blockIdx.x); S.nwg = full; S.tile_e = TILE + 16; S.estride = (size_t)DM * FF * 2;
          pg8::EpiBf16 E{WSP(bf16, WS_YMOE), DM}; pg8::gemm_phase<pg8::EpiBf16, pg8::MoeOrder, true, true>(F.lds + RING_OFF, g, S, E); }
        if (tail > 0) { const int nsp = moe_nsplit(tail, F.G);
          pg8::Gemm g{WSP(bf16, WS_HMOE), WSP(bf16, WS_WT_MDN), FF, (FF / 64) / nsp}; pg8::MoeSplitOrder S; S.nM = ntl; S.nN = DM / 256; S.nwg0 = full; S.ntail = tail; S.nsp = nsp; S.G = F.G; S.c = (int)blockIdx.x; S.tile_e = TILE + 16; S.estride = (size_t)DM * FF * 2;
          pg8::EpiPartF32 E{WSP(float, WS_SLAB), (int*)(F.ctl + CW_TMAP)}; pg8::gemm_phase<pg8::EpiPartF32, pg8::MoeSplitOrder, true, true>(F.lds + RING_OFF, g, S, E); }
        if (BOTH(15)) GRID_BAR(); }
    if (IN(16)) { p16_combine(F); }
#undef IN
#undef BOTH
}

#ifndef MK_ONE_LAUNCH
#define MK_ONE_LAUNCH 1
#endif
extern "C" void kernel_launch(void* const* d_in, const int* in_sizes, int n_in, void* d_out, int out_size, void* d_ws, size_t ws_size, hipStream_t stream) {
    static int grid = 0;
    if (grid == 0) {
        if (n_in != 22 || in_sizes[0] != T * DM || out_size != T * DM || ws_size < WS_END) { fprintf(stderr, "kernel_launch: unexpected shapes (n_in %d, in0 %d, out %d, ws %zu < %zu)\n", n_in, n_in > 0 ? in_sizes[0] : -1, out_size, ws_size, (size_t)WS_END); grid = -1; return; }
        int dev = 0, cus = 0, per_cu = 0;
        if (hipGetDevice(&dev) != hipSuccess || hipDeviceGetAttribute(&cus, hipDeviceAttributeMultiprocessorCount, dev) != hipSuccess) { grid = -1; return; }
        if (hipFuncSetAttribute((const void*)mk_fwd, hipFuncAttributeMaxDynamicSharedMemorySize, LDS_BYTES) != hipSuccess) { fprintf(stderr, "kernel_launch: hipFuncSetAttribute failed\n"); grid = -1; return; }
        if (hipOccupancyMaxActiveBlocksPerMultiprocessor(&per_cu, (const void*)mk_fwd, NWAVES * 64, LDS_BYTES) != hipSuccess || per_cu < 1) { fprintf(stderr, "kernel_launch: occupancy query says %d blocks per CU\n", per_cu); }
        (void)hipGetLastError();
        grid = cus;
    }
    if (grid < 0) return;
    if (hipMemsetAsync((char*)d_ws + WS_CTL, 0, CTL_ZERO_BYTES, stream) != hipSuccess) return;
    Args a{};
    for (int i = 0; i < 22; ++i) a.in[i] = (const float*)d_in[i];
    a.out = (float*)d_out; a.ws = (unsigned char*)d_ws; a.pad = 0;
#if MK_ONE_LAUNCH
    a.ph_lo = 0; a.ph_hi = N_PHASES; a.use_bar = 1;
    hipLaunchKernelGGL(mk_fwd, dim3(grid), dim3(NWAVES * 64), LDS_BYTES, stream, a);
    for (int p = 0; p < N_PHASES; ++p) if ((MK_PROBE_MASK >> p) & 1) { a.ph_lo = p; a.ph_hi = p + 1; a.use_bar = 0; a.pad = MK_PROBE_SUB;
        hipLaunchKernelGGL(mk_fwd, dim3(grid), dim3(NWAVES * 64), LDS_BYTES, stream, a); }
#else
    for (int p = 0; p < N_PHASES; ++p) { a.ph_lo = p; a.ph_hi = p + 1; a.use_bar = 0;
        hipLaunchKernelGGL(mk_fwd, dim3(grid), dim3(NWAVES * 64), LDS_BYTES, stream, a); }
#endif
}
```

```cpp
#include <hip/hip_runtime.h>
#include <cstdio>
#include <cstdint>

namespace pg8 {
#define PG8_LAS __attribute__((address_space(3)))
typedef unsigned short bf16_t;
typedef short bf16x8 __attribute__((ext_vector_type(8)));
typedef float f32x4 __attribute__((ext_vector_type(4)));
typedef unsigned u32x4 __attribute__((ext_vector_type(4)));
constexpr int BM = 256, BK = 64, HALF = 128, HTB = HALF * BK * 2  , STAGE_BYTES = 8 * HTB, NXCD = 8, WGM = 8;

__host__ __device__ __forceinline__ int lds_byte(int r, int c) { const int st = (r >> 4) * 2 + (c >> 5), rr = r & 15, cc = c & 31, ob = rr * 64 + cc * 2; return st * 1024 + (ob ^ (((ob >> 9) & 1) << 5)); }
__host__ __device__ __forceinline__ void stage_rc(int b, int& R, int& C) { const int st = b / 1024, sb = b % 1024, swz = sb ^ (((sb >> 9) & 1) << 5); R = (st >> 1) * 16 + swz / 64; C = (st & 1) * 32 + (swz % 64) / 2; }
__host__ __device__ __forceinline__ int perm32(int rho) { const int n = rho >> 4, i = rho & 15; return 8 * (i >> 2) + 4 * n + (i & 3); }

struct Unit { int pm, pn, ks, sl; };
struct Gemm { const bf16_t* A; const bf16_t* Bt; int K, kt; };

struct StaticOrder {
    int nM, nN, nwg, G, c;
    __device__ void init(int nM_, int nN_, int G_, int c_) { nM = nM_; nN = nN_; nwg = nM * nN; G = G_; c = c_; }
    __device__ bool next(int i, Unit& u) const {
        const long L = (long)i * G + c; if (L >= nwg) return false;
        int wgid = (int)L; { const int q = nwg / NXCD, r = nwg % NXCD, xcd = wgid % NXCD, off = wgid / NXCD; wgid = (xcd < r ? xcd * (q + 1) : r * (q + 1) + (xcd - r) * q) + off; }
        const int nig = WGM * nN, gid = wgid / nig, fm = gid * WGM, gsz = (nM - fm) < WGM ? (nM - fm) : WGM;
        u.pm = fm + ((wgid % nig) % gsz); u.pn = (wgid % nig) / gsz; u.ks = 0; u.sl = 0; return true;
    }
    __device__ __forceinline__ const char* a_base(const Gemm& g, const Unit& u) const { return (const char*)g.A + (size_t)u.pm * ((size_t)BM * g.K * 2); }
    __device__ __forceinline__ const char* b_base(const Gemm& g, const Unit& u) const { return (const char*)g.Bt + (size_t)u.pn * ((size_t)BM * g.K * 2); }
    __device__ __forceinline__ void a_ready(const Unit&) const {}
    __device__ __forceinline__ void done(const Unit&) const {}
};
struct MoeOrder : StaticOrder {
    const PG8_LAS int* tile_e; size_t estride;
    __device__ __forceinline__ const char* b_base(const Gemm& g, const Unit& u) const { return (const char*)g.Bt + (size_t)tile_e[u.pm] * estride + (size_t)u.pn * ((size_t)BM * g.K * 2); }
};
struct MoeSplitOrder {
    int nM, nN, nwg0, ntail, nsp, G, c, koff; const PG8_LAS int* tile_e; size_t estride;
    __device__ bool next(int i, Unit& u) const {
        const long L = (long)i * G + c; if (L >= (long)ntail * nsp) return false;
        const int j = (int)L / nsp, wgid = nwg0 + j;
        const int nig = WGM * nN, gid = wgid / nig, fm = gid * WGM, gsz = (nM - fm) < WGM ? (nM - fm) : WGM;
        u.pm = fm + ((wgid % nig) % gsz); u.pn = (wgid % nig) / gsz; u.ks = (int)L % nsp; u.sl = (int)L; return true;
    }
    __device__ __forceinline__ const char* a_base(const Gemm& g, const Unit& u) const { return (const char*)g.A + (size_t)u.pm * ((size_t)BM * g.K * 2) + (size_t)koff * (BK * 2); }
    __device__ __forceinline__ const char* b_base(const Gemm& g, const Unit& u) const { return (const char*)g.Bt + (size_t)tile_e[u.pm] * estride + (size_t)u.pn * ((size_t)BM * g.K * 2) + (size_t)koff * (BK * 2); }
    __device__ __forceinline__ void a_ready(const Unit&) const {}
    __device__ __forceinline__ void done(const Unit&) const {}
};

__device__ __forceinline__ unsigned cvt_pk_bf16(float lo, float hi) { unsigned r; asm volatile("v_cvt_pk_bf16_f32 %0, %1, %2" : "=v"(r) : "v"(lo), "v"(hi)); return r; }

struct EpiBf16 {
    static constexpr bool PERM = true, AFTER_DRAIN = false;
    bf16_t* O; int ldc; const unsigned long long* ss;
    __device__ __forceinline__ void operator()(const f32x4 (&acc)[2][2][4][2], const Unit& u, int wr, int wc, int fr, int fq) const {
        const int row0 = u.pm * BM + wr * 64 + fr, col0 = u.pn * BM + wc * 32 + 8 * fq;
#pragma unroll
        for (int ai = 0; ai < 2; ++ai)
#pragma unroll
            for (int m = 0; m < 4; ++m) { bf16_t* rowp = O + (size_t)(row0 + ai * HALF + m * 16) * ldc + col0;
                const float rs = ss ? __builtin_amdgcn_rsqf((float)ss[row0 + ai * HALF + m * 16] * (1.0f / (2048.0f * 16777216.0f)) + 1e-6f) : 1.0f;
#pragma unroll
                for (int bj = 0; bj < 2; ++bj) { const f32x4 v0 = acc[ai][bj][m][0] * rs, v1 = acc[ai][bj][m][1] * rs;
                    u32x4 w; w.x = cvt_pk_bf16(v0[0], v0[1]); w.y = cvt_pk_bf16(v0[2], v0[3]); w.z = cvt_pk_bf16(v1[0], v1[1]); w.w = cvt_pk_bf16(v1[2], v1[3]);
                    *(u32x4*)(rowp + bj * HALF) = w; } }
    }
};
struct EpiSwiglu {
    static constexpr bool PERM = true, AFTER_DRAIN = false;
    bf16_t* O; int ldc; const unsigned long long* ss;
    __device__ __forceinline__ void operator()(const f32x4 (&acc)[2][2][4][2], const Unit& u, int wr, int wc, int fr, int fq) const {
        const int row0 = u.pm * BM + wr * 64 + fr, col0 = u.pn * HALF + wc * 32 + 8 * fq;
#pragma unroll
        for (int ai = 0; ai < 2; ++ai)
#pragma unroll
            for (int m = 0; m < 4; ++m) { bf16_t* rowp = O + (size_t)(row0 + ai * HALF + m * 16) * ldc + col0;
                const float rs = ss ? __builtin_amdgcn_rsqf((float)ss[row0 + ai * HALF + m * 16] * (1.0f / (2048.0f * 16777216.0f)) + 1e-6f) : 1.0f;
                float h[8];
#pragma unroll
                for (int n = 0; n < 2; ++n)
#pragma unroll
                    for (int j = 0; j < 4; ++j) { const float gq = acc[ai][0][m][n][j] * rs, uq = acc[ai][1][m][n][j] * rs;
                        const float sg = __builtin_amdgcn_rcpf(1.0f + __builtin_amdgcn_exp2f(-1.4426950408889634f * gq));
                        h[n * 4 + j] = gq * sg * uq; }
                u32x4 w; w.x = cvt_pk_bf16(h[0], h[1]); w.y = cvt_pk_bf16(h[2], h[3]); w.z = cvt_pk_bf16(h[4], h[5]); w.w = cvt_pk_bf16(h[6], h[7]);
                *(u32x4*)rowp = w; }
    }
};
struct EpiPartF32 {
    static constexpr bool PERM = false, AFTER_DRAIN = false;
    float* slab; int* tmap;
    __device__ __forceinline__ void operator()(const f32x4 (&acc)[2][2][4][2], const Unit& u, int wr, int wc, int fr, int fq) const {
        float* base = slab + (size_t)u.sl * (BM * BM) + (size_t)(wr * 64 + fr) * BM + wc * 32 + 4 * fq;
        if (u.ks == 0 && threadIdx.x == 0) tmap[u.pm * 8 + u.pn] = u.sl + 1;
#pragma unroll
        for (int ai = 0; ai < 2; ++ai)
#pragma unroll
            for (int m = 0; m < 4; ++m) { float* rowp = base + (size_t)(ai * HALF + m * 16) * BM;
#pragma unroll
                for (int bj = 0; bj < 2; ++bj)
#pragma unroll
                    for (int n = 0; n < 2; ++n) *(f32x4*)(rowp + bj * HALF + n * 16) = acc[ai][bj][m][n]; }
    }
};
struct EpiResNorm {
    static constexpr bool PERM = false, AFTER_DRAIN = false;
    const float* base; float* out; bf16_t* xb; unsigned long long* ss; int ldc;
    __device__ __forceinline__ void operator()(const f32x4 (&acc)[2][2][4][2], const Unit& u, int wr, int wc, int fr, int fq) const {
        const int row0 = u.pm * BM + wr * 64 + fr, col0 = u.pn * BM + wc * 32 + 4 * fq;
#pragma unroll
        for (int ai = 0; ai < 2; ++ai)
#pragma unroll
            for (int m = 0; m < 4; ++m) { const size_t off = (size_t)(row0 + ai * HALF + m * 16) * ldc + col0; float sq = 0.f;
#pragma unroll
                for (int bj = 0; bj < 2; ++bj)
#pragma unroll
                    for (int n = 0; n < 2; ++n) { const f32x4 b = *(const f32x4*)(base + off + bj * HALF + n * 16); const f32x4 v = b + acc[ai][bj][m][n];
                        *(f32x4*)(out + off + bj * HALF + n * 16) = v; sq += (v[0] * v[0] + v[1] * v[1]) + (v[2] * v[2] + v[3] * v[3]);
                        unsigned w0 = cvt_pk_bf16(v[0], v[1]), w1 = cvt_pk_bf16(v[2], v[3]); typedef unsigned u32x2 __attribute__((ext_vector_type(2)));
                        *(u32x2*)(xb + off + bj * HALF + n * 16) = (u32x2){w0, w1}; }
                sq += __shfl_xor(sq, 16); sq += __shfl_xor(sq, 32);
                if (fq == 0) atomicAdd(ss + row0 + ai * HALF + m * 16, (unsigned long long)(sq * 16777216.0f + 0.5f)); }
    }
};
struct EpiResF32 {
    static constexpr bool PERM = false, AFTER_DRAIN = false;
    const float* base; float* out; int ldc;
    __device__ __forceinline__ void operator()(const f32x4 (&acc)[2][2][4][2], const Unit& u, int wr, int wc, int fr, int fq) const {
        const int row0 = u.pm * BM + wr * 64 + fr, col0 = u.pn * BM + wc * 32 + 4 * fq;
#pragma unroll
        for (int ai = 0; ai < 2; ++ai)
#pragma unroll
            for (int m = 0; m < 4; ++m) { const size_t off = (size_t)(row0 + ai * HALF + m * 16) * ldc + col0;
#pragma unroll
                for (int bj = 0; bj < 2; ++bj)
#pragma unroll
                    for (int n = 0; n < 2; ++n) { const f32x4 b = *(const f32x4*)(base + off + bj * HALF + n * 16); *(f32x4*)(out + off + bj * HALF + n * 16) = b + acc[ai][bj][m][n]; } }
    }
};
template <class Epi, class Sched, bool ALIGN_EPI = false, bool SP2 = false>
__device__ __forceinline__ void gemm_phase(PG8_LAS unsigned char* lds, const Gemm g, const Sched& S, const Epi& E) {
    int tid = threadIdx.x; asm volatile("" : "+v"(tid));
    const int wid = __builtin_amdgcn_readfirstlane(tid >> 6), lane = tid & 63, wr = wid >> 2, wc = wid & 3, fr = lane & 15, fq = lane >> 4;
    const int K = g.K, nt = g.kt;
    unsigned voffA[2], voffB[2];
#pragma unroll
    for (int i = 0; i < 2; ++i) { int R, C; stage_rc(tid * 16 + i * 8192, R, C); const int Rb = Epi::PERM ? ((R & ~31) + perm32(R & 31)) : R;
        voffA[i] = (unsigned)(R * K + C) * 2u; voffB[i] = (unsigned)(Rb * K + C) * 2u; }
    const size_t kstep = (size_t)(BK * 2);
    const size_t hstep = (size_t)HALF * K * 2;
    const unsigned ldsw = (unsigned)wid * 1024u;
    const int aoff = lds_byte(wr * 64 + fr, fq * 8), boff = lds_byte(wc * 32 + fr, fq * 8);
#define PG8_SA(b, h) (((b) * 2 + (h)) * HTB)
#define PG8_SB(b, h) ((4 + (b) * 2 + (h)) * HTB)
#define PG8_STAGE(bufoff, gbase, voff) do { _Pragma("unroll") for (int _i = 0; _i < 2; ++_i) \
        __builtin_amdgcn_global_load_lds((const unsigned*)((const char*)(gbase) + (voff)[_i]), (PG8_LAS unsigned*)(lds + (bufoff) + ldsw + _i * 8192), 16, 0, 0); } while (0)
#define PG8_LDA(dst, b, h) do { _Pragma("unroll") for (int m = 0; m < 4; ++m) _Pragma("unroll") for (int k = 0; k < 2; ++k) dst[m][k] = *(const PG8_LAS bf16x8*)(lds + PG8_SA(b, h) + aoff + m * 2048 + k * 1024); } while (0)
#define PG8_LDB(dst, b, h) do { _Pragma("unroll") for (int n = 0; n < 2; ++n) _Pragma("unroll") for (int k = 0; k < 2; ++k) dst[n][k] = *(const PG8_LAS bf16x8*)(lds + PG8_SB(b, h) + boff + n * 2048 + k * 1024); } while (0)
#define PG8_MMA(ai, bj, At, Bt) do { __builtin_amdgcn_s_setprio(1); _Pragma("unroll") for (int m = 0; m < 4; ++m) _Pragma("unroll") for (int n = 0; n < 2; ++n) _Pragma("unroll") for (int k = 0; k < 2; ++k) \
        acc[ai][bj][m][n] = __builtin_amdgcn_mfma_f32_16x16x32_bf16(Bt[n][k], At[m][k], acc[ai][bj][m][n], 0, 0, 0); __builtin_amdgcn_s_setprio(0); } while (0)
#define PG8_WAIT_V(n) asm volatile("s_waitcnt vmcnt(" #n ")" ::: "memory")
#define PG8_WAIT_L(n) asm volatile("s_waitcnt lgkmcnt(" #n ")" ::: "memory")
#define PG8_BAR __builtin_amdgcn_s_barrier()
#define PG8_SCHED __builtin_amdgcn_sched_barrier(0)
    Unit cur, nxt; int ui = 0;
    if (!S.next(0, cur)) return;
    f32x4 acc[2][2][4][2];
#pragma unroll
    for (int a = 0; a < 2; ++a)
#pragma unroll
        for (int b = 0; b < 2; ++b)
#pragma unroll
            for (int m = 0; m < 4; ++m)
#pragma unroll
                for (int n = 0; n < 2; ++n) acc[a][b][m][n] = (f32x4){0.f, 0.f, 0.f, 0.f};
    bf16x8 At[4][2], B0[2][2], B1[2][2];
    const char* cA = S.a_base(g, cur); const char* cB = S.b_base(g, cur);
    S.a_ready(cur);
    if constexpr (SP2) {
        PG8_STAGE(PG8_SB(0, 0), cB, voffB); PG8_STAGE(PG8_SB(0, 1), cB + hstep, voffB); PG8_STAGE(PG8_SA(0, 0), cA, voffA); PG8_STAGE(PG8_SA(0, 1), cA + hstep, voffA);
        if (wr == 1) PG8_BAR;
        PG8_WAIT_V(2); PG8_BAR;
        PG8_STAGE(PG8_SB(1, 0), cB + kstep, voffB); PG8_STAGE(PG8_SA(1, 0), cA + kstep, voffA); PG8_STAGE(PG8_SB(1, 1), cB + hstep + kstep, voffB);
        PG8_WAIT_V(6); PG8_BAR;
    } else {
        PG8_STAGE(PG8_SB(0, 0), cB, voffB); PG8_STAGE(PG8_SA(0, 0), cA, voffA); PG8_STAGE(PG8_SB(0, 1), cB + hstep, voffB); PG8_STAGE(PG8_SA(0, 1), cA + hstep, voffA);
        if (wr == 1) PG8_BAR;
        PG8_WAIT_V(4); PG8_BAR;
        PG8_STAGE(PG8_SB(1, 0), cB + kstep, voffB); PG8_STAGE(PG8_SA(1, 0), cA + kstep, voffA); PG8_STAGE(PG8_SB(1, 1), cB + hstep + kstep, voffB);
        PG8_WAIT_V(6); PG8_BAR;
    }
    for (;;) {
        const bool has_next = S.next(ui + 1, nxt);
        const char* nA = has_next ? S.a_base(g, nxt) : cA; const char* nB = has_next ? S.b_base(g, nxt) : cB;
        for (int t = 0; t < nt; t += 2) {
            const bool last = (t == nt - 2);
            const char* a1 = cA + (size_t)(t + 1) * kstep;
            const char* a2 = last ? nA : cA + (size_t)(t + 2) * kstep; const char* b2 = last ? nB : cB + (size_t)(t + 2) * kstep;
            const char* a3 = a2 + kstep; const char* b3 = b2 + kstep;
            if (last && has_next) S.a_ready(nxt);
            if constexpr (SP2) {
            PG8_LDB(B0, 0, 0); PG8_LDB(B1, 0, 1); PG8_SCHED; PG8_LDA(At, 0, 0); PG8_STAGE(PG8_SA(1, 1), a1 + hstep, voffA);
            PG8_WAIT_V(8); PG8_WAIT_L(0); PG8_BAR; PG8_MMA(0, 0, At, B0); PG8_MMA(0, 1, At, B1); PG8_BAR; PG8_SCHED;
            PG8_LDA(At, 0, 1); PG8_STAGE(PG8_SB(0, 0), b2, voffB); PG8_STAGE(PG8_SB(0, 1), b2 + hstep, voffB); PG8_STAGE(PG8_SA(0, 0), a2, voffA);
            PG8_WAIT_V(8); PG8_WAIT_L(0); PG8_BAR; PG8_MMA(1, 0, At, B0); PG8_MMA(1, 1, At, B1); PG8_BAR; PG8_SCHED;
            PG8_LDB(B0, 1, 0); PG8_LDB(B1, 1, 1); PG8_SCHED; PG8_LDA(At, 1, 0); PG8_STAGE(PG8_SA(0, 1), a2 + hstep, voffA);
            PG8_WAIT_V(8); PG8_WAIT_L(0); PG8_BAR; PG8_MMA(0, 0, At, B0); PG8_MMA(0, 1, At, B1); PG8_BAR; PG8_SCHED;
            PG8_LDA(At, 1, 1); PG8_STAGE(PG8_SB(1, 0), b3, voffB); PG8_STAGE(PG8_SB(1, 1), b3 + hstep, voffB); PG8_STAGE(PG8_SA(1, 0), a3, voffA);
            PG8_WAIT_V(8); PG8_WAIT_L(0); PG8_BAR; PG8_MMA(1, 0, At, B0); PG8_MMA(1, 1, At, B1); PG8_BAR; PG8_SCHED;
            } else {
            PG8_LDB(B0, 0, 0); PG8_SCHED; PG8_LDA(At, 0, 0); PG8_STAGE(PG8_SA(1, 1), a1 + hstep, voffA);
            PG8_WAIT_L(8); PG8_BAR; PG8_WAIT_L(0); PG8_MMA(0, 0, At, B0); PG8_BAR; PG8_SCHED;
            PG8_LDB(B1, 0, 1); PG8_STAGE(PG8_SB(0, 0), b2, voffB);
            PG8_BAR; PG8_WAIT_L(0); PG8_MMA(0, 1, At, B1); PG8_BAR;
            PG8_LDA(At, 0, 1); PG8_STAGE(PG8_SA(0, 0), a2, voffA);
            PG8_BAR; PG8_WAIT_L(0); PG8_MMA(1, 0, At, B0); PG8_BAR; PG8_SCHED;
            PG8_STAGE(PG8_SB(0, 1), b2 + hstep, voffB);
            PG8_WAIT_V(6); PG8_BAR; PG8_MMA(1, 1, At, B1); PG8_BAR;
            PG8_LDB(B0, 1, 0); PG8_SCHED; PG8_LDA(At, 1, 0); PG8_STAGE(PG8_SA(0, 1), a2 + hstep, voffA);
            PG8_WAIT_L(8); PG8_BAR; PG8_WAIT_L(0); PG8_MMA(0, 0, At, B0); PG8_BAR; PG8_SCHED;
            PG8_LDB(B1, 1, 1); PG8_STAGE(PG8_SB(1, 0), b3, voffB);
            PG8_BAR; PG8_WAIT_L(0); PG8_MMA(0, 1, At, B1); PG8_BAR;
            PG8_LDA(At, 1, 1); PG8_STAGE(PG8_SA(1, 0), a3, voffA);
            PG8_BAR; PG8_WAIT_L(0); PG8_MMA(1, 0, At, B0); PG8_BAR; PG8_SCHED;
            PG8_STAGE(PG8_SB(1, 1), b3 + hstep, voffB);
            PG8_WAIT_V(6); PG8_BAR; PG8_MMA(1, 1, At, B1); PG8_BAR;
            }
        }
        if constexpr (ALIGN_EPI) { if (wr == 0) PG8_BAR; }
        if constexpr (!Epi::AFTER_DRAIN) { E(acc, cur, wr, wc, fr, fq); S.done(cur); }
        if (!has_next) break;
#pragma unroll
        for (int a = 0; a < 2; ++a)
#pragma unroll
            for (int b = 0; b < 2; ++b)
#pragma unroll
                for (int m = 0; m < 4; ++m)
#pragma unroll
                    for (int n = 0; n < 2; ++n) acc[a][b][m][n] = (f32x4){0.f, 0.f, 0.f, 0.f};
        cur = nxt; cA = nA; cB = nB; ++ui;
        if constexpr (ALIGN_EPI) { if (wr == 1) PG8_BAR; }
    }
    PG8_WAIT_V(0);
    if constexpr (!ALIGN_EPI) { if (wr == 0) PG8_BAR; }
    PG8_BAR;
    if constexpr (Epi::AFTER_DRAIN) { E.fused(acc, cur, wr, wc, fr, fq, lds, wid, lane); S.done(cur); }
#undef PG8_SA
#undef PG8_SB
#undef PG8_STAGE
#undef PG8_LDA
#undef PG8_LDB
#undef PG8_MMA
#undef PG8_WAIT_V
#undef PG8_WAIT_L
#undef PG8_BAR
#undef PG8_SCHED
}
}


constexpr int T = 8192, DM = 2048, HD = 128, NMIX = 12, NMEMH = 4, NG = 3, MEMT = 256, FF = 7168, NE = 8;
constexpr int A_IN_W = 4388, NA = 4608;
constexpr int NB = 5120;
constexpr int CA_Q = 0, CA_KC = 1536, CA_VC = 1920, CA_KS = 2304, CA_VS = 2688, CA_KW = 3072, CA_VW = 3456, CA_QM = 3840, CA_GT = 4352;
constexpr int CB_Q = 0, CB_QM = 1536, CB_K = 2048, CB_V = 3584;
constexpr int NCMP = 511, NCMP_P = 512;
constexpr int MOE_MAXT = 72;
constexpr float EPS = 1e-6f;
constexpr float QSCALE = 0.08838834764831845f;

constexpr size_t MiB = 1u << 20;
constexpr size_t WS_CTL = 0, CTL_ZERO_BYTES = 1 * MiB;
constexpr size_t WS_WT_INA = 2 * MiB;
constexpr size_t WS_WT_MEM = 20 * MiB;
constexpr size_t WS_WT_OUT = 28 * MiB;
constexpr size_t WS_WT_FGU = 44 * MiB;
constexpr size_t WS_WT_FDN = 100 * MiB;
constexpr size_t WS_WT_INB = 128 * MiB;
constexpr size_t WS_WT_MGU = 148 * MiB;
constexpr size_t WS_WT_MDN = 596 * MiB;
constexpr size_t WS_XN = 820 * MiB;
constexpr size_t WS_MEMN = 852 * MiB;
constexpr size_t WS_MKV = 853 * MiB;
constexpr size_t WS_PA = 854 * MiB;
constexpr size_t WS_KCMP = 926 * MiB;
constexpr size_t WS_MIX = 927 * MiB;
constexpr size_t WS_X1 = 959 * MiB;
constexpr size_t WS_X2 = 1023 * MiB;
constexpr size_t WS_X3 = 1087 * MiB;
constexpr size_t WS_HFF = 1151 * MiB;
constexpr size_t WS_PB = 1263 * MiB;
constexpr size_t WS_AMOE = 1343 * MiB;
constexpr size_t WS_HMOE = 1415 * MiB;
constexpr size_t WS_YMOE = 1667 * MiB;
constexpr size_t WS_ROUTE = 1739 * MiB;
constexpr size_t WS_WT_CMP = 1740 * MiB;
constexpr size_t WS_OACC = 1742 * MiB;
constexpr size_t WS_SLAB = 1790 * MiB;
constexpr size_t WS_END = 1854 * MiB;
constexpr size_t RT_TOPI = 0;
constexpr size_t RT_TOPW = 65536;
constexpr size_t RT_ROW = 131072;
constexpr size_t RT_HIST = 196608;
constexpr size_t RT_TILE = 204800;
constexpr int CW_TMO = 0, CW_CODE = 1, CW_BAR = 4096;

constexpr int RING_OFF = 0, RING_BYTES = 135168;
constexpr int LDSCTL_OFF = RING_BYTES, MISC_OFF = LDSCTL_OFF + 320;
constexpr int LDS_BYTES = 147456;
static_assert(MISC_OFF + 128 <= LDS_BYTES, "LDS map");
constexpr int NWAVES = 8;

#define GAS __attribute__((address_space(1)))
#define LAS __attribute__((address_space(3)))
typedef unsigned short bf16;
typedef unsigned v4u __attribute__((ext_vector_type(4)));
typedef unsigned v2u __attribute__((ext_vector_type(2)));
typedef float f32x4 __attribute__((ext_vector_type(4)));
typedef GAS unsigned gu32;
#define RLX_AGENT __ATOMIC_RELAXED, __HIP_MEMORY_SCOPE_AGENT
#define LDS_WAIT() asm volatile("s_waitcnt lgkmcnt(0)" ::: "memory")
#define VM_WAIT() asm volatile("s_waitcnt vmcnt(0)" ::: "memory")
__device__ __forceinline__ float bf2f(unsigned b) { return __uint_as_float(b << 16); }
__device__ __forceinline__ unsigned pk2(float lo, float hi) { return pg8::cvt_pk_bf16(lo, hi); }
__device__ __forceinline__ void unpack8(v4u w, float* f) {
    f[0] = __uint_as_float(w.x << 16); f[1] = __uint_as_float(w.x & 0xffff0000u); f[2] = __uint_as_float(w.y << 16); f[3] = __uint_as_float(w.y & 0xffff0000u);
    f[4] = __uint_as_float(w.z << 16); f[5] = __uint_as_float(w.z & 0xffff0000u); f[6] = __uint_as_float(w.w << 16); f[7] = __uint_as_float(w.w & 0xffff0000u); }
__device__ __forceinline__ float wave_sum(float v) {
#pragma unroll
    for (int o = 1; o < 64; o <<= 1) v += __shfl_xor(v, o);
    return v;
}
__device__ __forceinline__ float fast_exp(float x) { return __builtin_amdgcn_exp2f(x * 1.4426950408889634f); }

#define XB_TMO      128
#define XB_XCNT(j)  (256  + 64 * (j))
#define XB_XSUB(j)  (1280 + 64 * (j))
#define XB_XGEN(j)  (2304 + 64 * (j))
#define XB_TOP      3328
#define XB_TOPGEN   3392
#define XCD_BAR_WORDS 3456
#define XB_SPIN_CAP (1u << 18)
__device__ __forceinline__ unsigned xb_ld(unsigned* p)              { return __hip_atomic_load(p, __ATOMIC_RELAXED, __HIP_MEMORY_SCOPE_AGENT); }
__device__ __forceinline__ unsigned xb_add(unsigned* p, unsigned v) { return __hip_atomic_fetch_add(p, v, __ATOMIC_RELAXED, __HIP_MEMORY_SCOPE_AGENT); }
__device__ __forceinline__ unsigned xb_xcc_id() { return (unsigned)__builtin_amdgcn_s_getreg((3 << 11) | 20) & 0xFu; }
#define XB_SPIN(cond, bar) do { unsigned _sp = 0; while (cond) { __builtin_amdgcn_s_sleep(1); \
    if ((++_sp & 255u) == 0u) { if (xb_ld(&(bar)[XB_TMO])) break; if (_sp > XB_SPIN_CAP) { atomicAdd(&(bar)[XB_TMO], 1u); break; } } } } while (0)
struct XcdBarrier { unsigned* bar; unsigned x; volatile LAS unsigned* st; };
__device__ __forceinline__ XcdBarrier xcd_barrier_post(unsigned* bar, volatile LAS unsigned* st) {
    XcdBarrier b; b.bar = bar; b.x = xb_xcc_id(); b.st = st;
    if (threadIdx.x == 0) (void)xb_add(&bar[XB_XCNT(b.x)], 1u);
    return b;
}
__device__ __forceinline__ void xcd_barrier_complete(unsigned* bar, unsigned x, unsigned& nloc, unsigned& nx) {
    const unsigned G = gridDim.x * gridDim.y * gridDim.z;
    unsigned sum, cnt, mine, sp = 0u;
    for (;;) {
        sum = 0u; cnt = 0u; mine = 0u;
#pragma unroll
        for (unsigned j = 0; j < 16; ++j) { const unsigned c = xb_ld(&bar[XB_XCNT(j)]); sum += c; cnt += (c > 0u) ? 1u : 0u; mine = (j == x) ? c : mine; }
        if (sum == G) break;
        __builtin_amdgcn_s_sleep(1);
        if ((++sp & 255u) == 0u) { if (xb_ld(&bar[XB_TMO])) break; if (sp > XB_SPIN_CAP) { atomicAdd(&bar[XB_TMO], 1u); break; } }
    }
    nloc = mine > 0u ? mine : 1u; nx = cnt > 0u ? cnt : 1u;
}
__device__ __forceinline__ void xcd_barrier(const XcdBarrier& b) {
    asm volatile("s_waitcnt vmcnt(0)" ::: "memory");
    __syncthreads();
    if (threadIdx.x == 0) {
        unsigned* bar = b.bar;
        __builtin_amdgcn_s_waitcnt(0);
        unsigned nloc = b.st[0], nx = b.st[1];
        if (nloc == 0u) { xcd_barrier_complete(bar, b.x, nloc, nx); b.st[0] = nloc; b.st[1] = nx; }
        const unsigned old = xb_add(&bar[XB_XSUB(b.x)], 1u);
        const unsigned gen = old / nloc;
        if (old + 1u == (gen + 1u) * nloc) {
            __builtin_amdgcn_fence(__ATOMIC_RELEASE, "agent");
            asm volatile("s_waitcnt vmcnt(0)" ::: "memory");
            const unsigned og = xb_add(&bar[XB_TOP], 1u);
            const unsigned tg = og / nx;
            if (og + 1u == (tg + 1u) * nx) xb_add(&bar[XB_TOPGEN], 1u);
            else XB_SPIN(xb_ld(&bar[XB_TOPGEN]) == tg, bar);
            __builtin_amdgcn_fence(__ATOMIC_ACQUIRE, "agent");
            xb_add(&bar[XB_XGEN(b.x)], 1u);
            asm volatile("s_waitcnt vmcnt(0)" ::: "memory");
        } else {
            XB_SPIN(xb_ld(&bar[XB_XGEN(b.x)]) == gen, bar);
            __builtin_amdgcn_fence(__ATOMIC_ACQUIRE, "agent");
            asm volatile("s_waitcnt vmcnt(0)" ::: "memory");
        }
    }
    __syncthreads();
}

struct Frame {
    LAS unsigned char* lds;
    volatile LAS unsigned* MISC;
    gu32* ctl;
    int tid, wave;
    int vcu, G;
    unsigned char* ws;
    const float* in[22];
    float* out;
};
#define WSP(T_, off) ((T_*)(F.ws + (off)))
__device__ __forceinline__ int lane_of(const Frame& F) { int t = F.tid; asm volatile("" : "+v"(t)); return t & 63; }

constexpr int CV_INA = 0, CV_MEM = CV_INA + 32 * 72, CV_CMP = CV_MEM + 2 * 32 * 16, CV_OUT = CV_CMP + 2 * 64 * 2, CV_FGU = CV_OUT + 2 * 32 * 32, CV_FDN = CV_FGU + 32 * 224,
              CV_INB = CV_FDN + 112 * 32, CV_KVB = CV_INB + 32 * 32, CV_MGU = CV_KVB + 32 * 48, CV_MDN = CV_MGU + 8 * 32 * 224, CV_TOTAL = CV_MDN + 8 * 112 * 32;
struct ConvIt { const float* src; bf16* dst; const float* gain; int K, Nsrc, sc0, n0, k0, nvalid; };
__device__ __forceinline__ void conv_decode(Frame& F, int g, ConvIt& c) {
    int loc, nnb, mode = 0, batch = 0; c.gain = nullptr;
    if (g < CV_MEM) { loc = g - CV_INA; c.src = F.in[5]; c.dst = WSP(bf16, WS_WT_INA); c.gain = F.in[2]; c.K = DM; c.Nsrc = A_IN_W; nnb = NA / 64; mode = 2; }
    else if (g < CV_CMP) { loc = g - CV_MEM; batch = loc / (32 * 16); loc -= batch * 32 * 16; c.src = F.in[13] + (size_t)batch * DM * 1024; c.dst = WSP(bf16, WS_WT_MEM) + (size_t)batch * 1024 * DM; c.gain = F.in[3] + batch * DM; c.K = DM; c.Nsrc = 1024; nnb = 16; }
    else if (g < CV_OUT) { loc = g - CV_CMP; batch = loc / 128; loc -= batch * 128; c.src = F.in[6] + (size_t)batch * 4096 * HD; c.dst = WSP(bf16, WS_WT_CMP) + (size_t)batch * HD * 4096; c.K = 4096; c.Nsrc = HD; nnb = 2; }
    else if (g < CV_FGU) { loc = g - CV_OUT; batch = loc / 1024; loc -= batch * 1024; c.src = F.in[15] + (size_t)batch * DM * DM; c.dst = WSP(bf16, WS_WT_OUT) + (size_t)batch * DM * DM; c.K = DM; c.Nsrc = DM; nnb = 32; }
    else if (g < CV_FDN) { loc = g - CV_FGU; c.src = F.in[16]; c.dst = WSP(bf16, WS_WT_FGU); c.gain = F.in[4]; c.K = DM; c.Nsrc = 2 * FF; nnb = 224; mode = 1; }
    else if (g < CV_INB) { loc = g - CV_FDN; c.src = F.in[17]; c.dst = WSP(bf16, WS_WT_FDN); c.K = FF; c.Nsrc = DM; nnb = 32; }
    else if (g < CV_KVB) { loc = g - CV_INB; c.src = F.in[10]; c.dst = WSP(bf16, WS_WT_INB); c.gain = F.in[2] + DM; c.K = DM; c.Nsrc = DM; nnb = 32; }
    else if (g < CV_MGU) { loc = g - CV_KVB; c.src = F.in[12]; c.dst = WSP(bf16, WS_WT_INB) + (size_t)2048 * DM; c.gain = F.in[11]; c.K = DM; c.Nsrc = 3072; nnb = 48; }
    else if (g < CV_MDN) { loc = g - CV_MGU; batch = loc / 7168; loc -= batch * 7168; c.src = F.in[20] + (size_t)batch * DM * 2 * FF; c.dst = WSP(bf16, WS_WT_MGU) + (size_t)batch * 2 * FF * DM; c.gain = F.in[4] + DM; c.K = DM; c.Nsrc = 2 * FF; nnb = 224; mode = 1; }
    else { loc = g - CV_MDN; batch = loc / 3584; loc -= batch * 3584; c.src = F.in[21] + (size_t)batch * FF * DM; c.dst = WSP(bf16, WS_WT_MDN) + (size_t)batch * DM * FF; c.K = FF; c.Nsrc = DM; nnb = 32; }
    const int kb = loc / nnb, nb = loc - kb * nnb;
    c.k0 = kb * 64; c.n0 = nb * 64; c.nvalid = nnb * 64;
    if (mode == 1) { const int j = c.n0 >> 8, r = c.n0 & 255; c.sc0 = (r < 128) ? 128 * j + r : 7168 + 128 * j + (r - 128); }
    else if (mode == 2) { if (c.n0 < 3840) c.sc0 = c.n0; else if (c.n0 < 4352) c.sc0 = c.n0 + 36; else if (c.n0 < 4416) { c.sc0 = c.n0 - 512; c.nvalid = 4388; } else { c.sc0 = 0; c.nvalid = 0; } }
    else c.sc0 = c.n0;
}
struct ConvRegs { f32x4 v[16]; float gn[8]; };
__device__ __forceinline__ void conv_load(const ConvIt& c, ConvRegs& R, int lane) {
    const int kr = lane >> 4, nc = (lane & 15) * 4;
    const bool ok = (c.n0 + nc) < c.nvalid;
    const int cc = ok ? c.sc0 + nc : 0;
    const float* p = c.src + (size_t)(c.k0 + kr) * c.Nsrc + cc;
#pragma unroll
    for (int i = 0; i < 16; ++i) R.v[i] = __builtin_nontemporal_load((const f32x4*)(p + (size_t)(4 * i) * c.Nsrc));
    if (c.n0 + 64 > c.nvalid) {
#pragma unroll
        for (int i = 0; i < 16; ++i) R.v[i] = ok ? R.v[i] : (f32x4){0.f, 0.f, 0.f, 0.f}; }
    const int c8 = lane & 7;
    if (c.gain) {
#pragma unroll
        for (int i = 0; i < 8; ++i) R.gn[i] = c.gain[c.k0 + 8 * c8 + i]; }
}
__device__ __forceinline__ void conv_proc(const ConvIt& c, const ConvRegs& R, LAS float* scr, int lane) {
    const int kr = lane >> 4, nc = (lane & 15) * 4;
#pragma unroll
    for (int i = 0; i < 16; ++i) { LAS float* s = scr + (4 * i + kr) * 65 + nc; s[0] = R.v[i][0]; s[1] = R.v[i][1]; s[2] = R.v[i][2]; s[3] = R.v[i][3]; }
    LDS_WAIT(); asm volatile("" ::: "memory");
    const int c8 = lane & 7, nl = lane >> 3;
#pragma unroll
    for (int j = 0; j < 8; ++j) {
        const int n = nl + 8 * j; const LAS float* s = scr + (8 * c8) * 65 + n;
        v4u o;
        if (c.gain) { o.x = pk2(s[0 * 65] * R.gn[0], s[1 * 65] * R.gn[1]); o.y = pk2(s[2 * 65] * R.gn[2], s[3 * 65] * R.gn[3]); o.z = pk2(s[4 * 65] * R.gn[4], s[5 * 65] * R.gn[5]); o.w = pk2(s[6 * 65] * R.gn[6], s[7 * 65] * R.gn[7]); }
        else { o.x = pk2(s[0 * 65], s[1 * 65]); o.y = pk2(s[2 * 65], s[3 * 65]); o.z = pk2(s[4 * 65], s[5 * 65]); o.w = pk2(s[6 * 65], s[7 * 65]); }
        __builtin_nontemporal_store(o, (v4u*)(c.dst + (size_t)(c.n0 + n) * c.K + c.k0 + 8 * c8));
    }
    LDS_WAIT(); asm volatile("" ::: "memory");
}
__device__ __forceinline__ void conv_list(Frame& F, int first, int stride, int g_hi) {
    LAS float* scr = (LAS float*)(F.lds + RING_OFF + F.wave * 16640);
    int g = first;
    if (g >= g_hi) return;
    ConvIt cA, cB; ConvRegs RA, RB;
    conv_decode(F, g, cA); conv_load(cA, RA, lane_of(F));
    for (;;) {
        const int g1 = g + stride; const bool h1 = g1 < g_hi;
        if (h1) { conv_decode(F, g1, cB); conv_load(cB, RB, lane_of(F)); }
        asm volatile("" ::: "memory");
        conv_proc(cA, RA, scr, lane_of(F));
        if (!h1) break;
        const int g2 = g1 + stride; const bool h2 = g2 < g_hi;
        if (h2) { conv_decode(F, g2, cA); conv_load(cA, RA, lane_of(F)); }
        asm volatile("" ::: "memory");
        conv_proc(cB, RB, scr, lane_of(F));
        if (!h2) break;
        g = g2;
    }
}
constexpr int CV_DEFER0 = CV_FGU, CV_CHUNK = 8;
constexpr int CW_DBG = 16;
constexpr int CW_SS = 65536;
constexpr int CW_TMAP = 12288;
constexpr int CW_CVNEXT = 8192, CW_DONE0 = 8192 + 64;
__device__ __forceinline__ bool conv_grab(Frame& F) {
    volatile LAS int* sh = (volatile LAS int*)(F.lds + LDSCTL_OFF + 64);
    if (F.tid == 0) sh[0] = CV_DEFER0 + (int)__hip_atomic_fetch_add((unsigned*)(F.ctl + CW_CVNEXT), (unsigned)CV_CHUNK, __ATOMIC_RELAXED, __HIP_MEMORY_SCOPE_AGENT);
    __syncthreads();
    const int base = sh[0];
    __syncthreads();
    if (base >= CV_TOTAL) return false;
    const int hi = base + CV_CHUNK < CV_TOTAL ? base + CV_CHUNK : CV_TOTAL;
    conv_list(F, base + F.wave, NWAVES, hi);
    return true;
}
__device__ __forceinline__ void idle_fill(Frame& F, int ph) {
    volatile LAS int* sh = (volatile LAS int*)(F.lds + LDSCTL_OFF + 64);
    asm volatile("s_waitcnt vmcnt(0)" ::: "memory");
    __syncthreads();
    if (F.tid == 0) __hip_atomic_fetch_add((unsigned*)(F.ctl + CW_DONE0 + 64 * ph), 1u, __ATOMIC_RELAXED, __HIP_MEMORY_SCOPE_AGENT);
    for (;;) {
        if (F.tid == 0) sh[1] = (__hip_atomic_load((unsigned*)(F.ctl + CW_DONE0 + 64 * ph), __ATOMIC_RELAXED, __HIP_MEMORY_SCOPE_AGENT) >= (unsigned)F.G) ? 1 : 0;
        __syncthreads();
        const int alld = sh[1];
        __syncthreads();
        if (alld) break;
        if (!conv_grab(F)) break;
    }
}
__device__ __forceinline__ void conv_drain(Frame& F, int limit) {
    volatile LAS int* sh = (volatile LAS int*)(F.lds + LDSCTL_OFF + 64);
    asm volatile("s_waitcnt vmcnt(0)" ::: "memory");
    __syncthreads();
    for (;;) {
        if (F.tid == 0) sh[1] = (CV_DEFER0 + (int)__hip_atomic_load((unsigned*)(F.ctl + CW_CVNEXT), __ATOMIC_RELAXED, __HIP_MEMORY_SCOPE_AGENT) >= limit) ? 1 : 0;
        __syncthreads();
        const int enough = sh[1];
        __syncthreads();
        if (enough) break;
        if (!conv_grab(F)) break;
    }
}
__device__ __forceinline__ float row_rstd_to_bf16(const float* xrow, bf16* orow, int lane) {
    const f32x4* xr = (const f32x4*)xrow + lane;
    f32x4 v[8]; float s = 0.f;
#pragma unroll
    for (int j = 0; j < 8; ++j) { v[j] = xr[64 * j]; s += (v[j].x * v[j].x + v[j].y * v[j].y) + (v[j].z * v[j].z + v[j].w * v[j].w); }
    const float rstd = 1.0f / sqrtf(wave_sum(s) * (1.f / DM) + EPS);
    v2u* o8 = (v2u*)orow + lane;
#pragma unroll
    for (int j = 0; j < 8; ++j) { v2u w; w.x = pk2(v[j].x * rstd, v[j].y * rstd); w.y = pk2(v[j].z * rstd, v[j].w * rstd); o8[64 * j] = w; }
    return rstd;
}
__device__ __forceinline__ void rmsnorm_rows(Frame& F, const float* X, bf16* XN, int rows) {
    const int gw = F.vcu * NWAVES + F.wave, NGW = F.G * NWAVES;
    for (int m = gw; m < rows; m += NGW) row_rstd_to_bf16(X + (size_t)m * DM, XN + (size_t)m * DM, lane_of(F));
}
__device__ __forceinline__ void p0_prologue(Frame& F) {
    conv_list(F, F.vcu * NWAVES + F.wave, F.G * NWAVES, CV_DEFER0);
    rmsnorm_rows(F, F.in[0], WSP(bf16, WS_XN), T);
    rmsnorm_rows(F, F.in[1], WSP(bf16, WS_MEMN), MEMT);
}

__device__ __forceinline__ void p2_compress(Frame& F) {
    typedef short bf16x8 __attribute__((ext_vector_type(8)));
    const bf16* PA = WSP(bf16, WS_PA); const bf16* WC = WSP(bf16, WS_WT_CMP);
    LAS float* red = (LAS float*)(F.lds + RING_OFF);
    LAS float* posl = red + 8 * 16 * 132;
    const int lane = lane_of(F), w = F.wave, fr = lane & 15, fq = lane >> 4;
    for (int i = F.tid; i < 2 * 4096 / 4; i += NWAVES * 64) *(LAS f32x4*)(posl + 4 * i) = *(const f32x4*)(F.in[7] + 4 * i);
    __syncthreads();
    const int nitems = 2 * NG * 32;
    for (int it = F.vcu; it < nitems; it += F.G) {
        const int kv = it / (NG * 32), g = (it / 32) % NG, jt = it % 32;
        const int j = 16 * jt + fr;
        const LAS float* pos = posl + kv * 4096 + 512 * w + 8 * fq;
        const int col = (kv ? CA_VC : CA_KC) + g * HD;
        const bf16* wrow = WC + ((size_t)kv * HD + fr) * 4096 + 512 * w + 8 * fq;
        f32x4 acc[8];
#pragma unroll
        for (int c = 0; c < 8; ++c) acc[c] = f32x4{0.f, 0.f, 0.f, 0.f};
        for (int u0 = 0; u0 < 16; u0 += 4) {
            v4u xa[4], wb[4][8];
#pragma unroll
            for (int u = 0; u < 4; ++u) {
                const int kl = 32 * (u0 + u) + 8 * fq, i = 4 * w + (kl >> 7), d = kl & 127;
                int trow = 16 * j + i; trow = trow < T ? trow : T - 1;
                xa[u] = *(const v4u*)(PA + (size_t)trow * NA + col + d);
#pragma unroll
                for (int c = 0; c < 8; ++c) wb[u][c] = *(const v4u*)(wrow + (size_t)c * 16 * 4096 + 32 * (u0 + u));
            }
            asm volatile("" ::: "memory");
#pragma unroll
            for (int u = 0; u < 4; ++u) {
                const f32x4 pa = *(const LAS f32x4*)(pos + 32 * (u0 + u)), pb = *(const LAS f32x4*)(pos + 32 * (u0 + u) + 4);
                float xf[8]; unpack8(xa[u], xf);
                v4u av; av.x = pk2(xf[0] + pa[0], xf[1] + pa[1]); av.y = pk2(xf[2] + pa[2], xf[3] + pa[3]); av.z = pk2(xf[4] + pb[0], xf[5] + pb[1]); av.w = pk2(xf[6] + pb[2], xf[7] + pb[3]);
#pragma unroll
                for (int c = 0; c < 8; ++c)
                    acc[c] = __builtin_amdgcn_mfma_f32_16x16x32_bf16(*reinterpret_cast<const bf16x8*>(&av), *reinterpret_cast<const bf16x8*>(&wb[u][c]), acc[c], 0, 0, 0);
            }
        }
#pragma unroll
        for (int c = 0; c < 8; ++c)
#pragma unroll
            for (int r = 0; r < 4; ++r) red[(w * 16 + 4 * fq + r) * 132 + 16 * c + fr] = acc[c][r];
        __syncthreads();
        {
            const int row = F.tid >> 5, cp = F.tid & 31, jj = 16 * jt + row;
            float v[4] = {0.f, 0.f, 0.f, 0.f}; float ss = 0.f;
#pragma unroll
            for (int ww = 0; ww < 8; ++ww) { const f32x4 p = *(const LAS f32x4*)(red + (ww * 16 + row) * 132 + 4 * cp); v[0] += p[0]; v[1] += p[1]; v[2] += p[2]; v[3] += p[3]; }
#pragma unroll
            for (int e = 0; e < 4; ++e) ss += v[e] * v[e];
            ss += __shfl_xor(ss, 1); ss += __shfl_xor(ss, 2); ss += __shfl_xor(ss, 4); ss += __shfl_xor(ss, 8); ss += __shfl_xor(ss, 16);
            if (kv == 0) { const float rs = 1.0f / sqrtf(ss * (1.f / HD) + EPS); const float* gp = F.in[9] + 4 * cp;
#pragma unroll
                for (int e = 0; e < 4; ++e) v[e] = v[e] * rs * gp[e]; }
            if (jj >= NCMP) {
#pragma unroll
                for (int e = 0; e < 4; ++e) v[e] = 0.f; }
            v2u o; o.x = pk2(v[0], v[1]); o.y = pk2(v[2], v[3]);
            *(v2u*)(WSP(bf16, WS_KCMP) + (size_t)kv * NG * NCMP_P * HD + ((size_t)g * NCMP_P + jj) * HD + 4 * cp) = o;
        }
        __syncthreads();
    }
}
__device__ __forceinline__ void norm_slot(bf16* p, const float* gain, int l16) {
    v4u w = *(const v4u*)(p + l16 * 8); float f[8]; unpack8(w, f);
    float s = 0.f;
#pragma unroll
    for (int e = 0; e < 8; ++e) s += f[e] * f[e];
    s += __shfl_xor(s, 1); s += __shfl_xor(s, 2); s += __shfl_xor(s, 4); s += __shfl_xor(s, 8);
    const float r = 1.0f / sqrtf(s * (1.f / HD) + EPS);
    const float* gp = gain + l16 * 8;
    v4u o; o.x = pk2(f[0] * r * gp[0], f[1] * r * gp[1]); o.y = pk2(f[2] * r * gp[2], f[3] * r * gp[3]); o.z = pk2(f[4] * r * gp[4], f[5] * r * gp[5]); o.w = pk2(f[6] * r * gp[6], f[7] * r * gp[7]);
    *(v4u*)(p + l16 * 8) = o;
}
__device__ __forceinline__ void norm_vals(v4u w, bf16* p, const float* gain, int l16) {
    float f[8]; unpack8(w, f);
    float s = 0.f;
#pragma unroll
    for (int e = 0; e < 8; ++e) s += f[e] * f[e];
    s += __shfl_xor(s, 1); s += __shfl_xor(s, 2); s += __shfl_xor(s, 4); s += __shfl_xor(s, 8);
    const float r = 1.0f / sqrtf(s * (1.f / HD) + EPS);
    const float* gp = gain + l16 * 8;
    v4u o; o.x = pk2(f[0] * r * gp[0], f[1] * r * gp[1]); o.y = pk2(f[2] * r * gp[2], f[3] * r * gp[3]); o.z = pk2(f[4] * r * gp[4], f[5] * r * gp[5]); o.w = pk2(f[6] * r * gp[6], f[7] * r * gp[7]);
    *(v4u*)(p + l16 * 8) = o;
}
constexpr int CW_QKN = 8192 + 32;
__device__ __forceinline__ void p2_qknorm(Frame& F) {
    bf16* PA = WSP(bf16, WS_PA); bf16* MKV = WSP(bf16, WS_MKV);
    const int sub = F.wave * 4 + (lane_of(F) >> 4), l16 = lane_of(F) & 15;
    for (int s = F.vcu * 32 + sub; s < MEMT * 8; s += F.G * 32) {
        const int m = s / 8, k = s % 8, l = k >> 2, h = k & 3;
        norm_slot(MKV + (size_t)m * 2048 + l * 1024 + h * HD, F.in[14] + (size_t)(l * 2 + 1) * HD, l16);
    }
    constexpr int NCH = T * 18 / 192;
    volatile LAS int* sh = (volatile LAS int*)(F.lds + LDSCTL_OFF + 64);
    if (F.tid == 0) sh[2] = (int)__hip_atomic_fetch_add((unsigned*)(F.ctl + CW_QKN), 1u, __ATOMIC_RELAXED, __HIP_MEMORY_SCOPE_AGENT);
    __syncthreads();
    int ch = sh[2];
    __syncthreads();
    while (ch < NCH) {
        if (F.tid == 0) sh[2] = (int)__hip_atomic_fetch_add((unsigned*)(F.ctl + CW_QKN), 1u, __ATOMIC_RELAXED, __HIP_MEMORY_SCOPE_AGENT);
        bf16* ptr[6]; const float* gn[6]; v4u w[6];
        const int s0 = ch * 192 + sub;
#pragma unroll
        for (int u = 0; u < 6; ++u) {
            const int s = s0 + u * 32;
            const int t = s / 18, k = s % 18;
            int col; const float* gain;
            if (k < 12) { col = CA_Q + k * HD; gain = F.in[8]; }
            else if (k < 15) { col = CA_KS + (k - 12) * HD; gain = F.in[9] + HD; }
            else { col = CA_KW + (k - 15) * HD; gain = F.in[9] + 2 * HD; }
            ptr[u] = PA + (size_t)t * NA + col; gn[u] = gain; w[u] = *(const v4u*)(ptr[u] + l16 * 8);
        }
        asm volatile("" ::: "memory");
#pragma unroll
        for (int u = 0; u < 6; ++u) norm_vals(w[u], ptr[u], gn[u], l16);
        __syncthreads();
        ch = sh[2];
        __syncthreads();
    }
}

__device__ __forceinline__ void ld32(const bf16* p, float* f) {
#pragma unroll
    for (int i = 0; i < 4; ++i) { const v4u w = *(const v4u*)(p + 8 * i); unpack8(w, f + 8 * i); }
}
__device__ __forceinline__ float dot32q(const float* q, const bf16* kp) {
    float kf[32]; ld32(kp, kf); float s = 0.f;
#pragma unroll
    for (int i = 0; i < 32; ++i) s += q[i] * kf[i];
    s += __shfl_xor(s, 1); s += __shfl_xor(s, 2);
    return s;
}
__device__ __forceinline__ void axpy32(float* o, float p, const bf16* vp) {
    float vf[32]; ld32(vp, vf);
#pragma unroll
    for (int i = 0; i < 32; ++i) o[i] += p * vf[i];
}
__device__ __forceinline__ void st32(bf16* p, const float* f) {
#pragma unroll
    for (int i = 0; i < 4; ++i) { v4u w; w.x = pk2(f[8 * i], f[8 * i + 1]); w.y = pk2(f[8 * i + 2], f[8 * i + 3]); w.z = pk2(f[8 * i + 4], f[8 * i + 5]); w.w = pk2(f[8 * i + 6], f[8 * i + 7]); *(v4u*)(p + 8 * i) = w; }
}
#define OSM_STEP(s_, valid_, vptr_) do { if (valid_) { const float mn_ = fmaxf(m, (s_)); const float al_ = fast_exp(m - mn_); const float pp_ = fast_exp((s_) - mn_); \
        l = l * al_ + pp_; _Pragma("unroll") for (int i_ = 0; i_ < 32; ++i_) o[i_] *= al_; axpy32(o, pp_, (vptr_)); m = mn_; } } while (0)

__device__ __forceinline__ void p3_nsa_naive(Frame& F) {
    const bf16* PA = WSP(bf16, WS_PA); const bf16* KC = WSP(bf16, WS_KCMP); const bf16* VC = KC + (size_t)NG * NCMP_P * HD; bf16* MIX = WSP(bf16, WS_MIX);
    LAS float* IMP = (LAS float*)(F.lds + RING_OFF + F.wave * 4096);
    LAS unsigned long long* SELW = (LAS unsigned long long*)(F.lds + RING_OFF + F.wave * 4096 + 2048);
    const int gw = F.vcu * NWAVES + F.wave, NGW = F.G * NWAVES;
    const int dq = lane_of(F) & 3, p = (lane_of(F) >> 2) & 3, ql = lane_of(F) >> 4;
    for (int it = gw; it < NG * (T / 4); it += NGW) {
        const int g = it / (T / 4), tq = it % (T / 4), t = 4 * tq + ql, head = g * 4 + p;
        const float slope = exp2f(-8.0f * (float)(head + 1) / 12.0f);
        float q[32]; ld32(PA + (size_t)t * NA + CA_Q + head * HD + dq * 32, q);
#pragma unroll
        for (int i = 0; i < 32; ++i) q[i] *= QSCALE;
        const float g0 = 1.0f / (1.0f + fast_exp(-bf2f(PA[(size_t)t * NA + CA_GT + head * 3 + 0])));
        const float g1 = 1.0f / (1.0f + fast_exp(-bf2f(PA[(size_t)t * NA + CA_GT + head * 3 + 1])));
        const float g2 = 1.0f / (1.0f + fast_exp(-bf2f(PA[(size_t)t * NA + CA_GT + head * 3 + 2])));
        float otot[32];
#pragma unroll
        for (int i = 0; i < 32; ++i) otot[i] = 0.f;
        for (int i = lane_of(F); i < 512; i += 64) IMP[i] = 0.f;
        LDS_WAIT(); asm volatile("" ::: "memory");
        const int jmax = (t >= 31) ? (t - 31) / 16 : -1;
        const int jmax_w = (4 * tq + 3 >= 31) ? (4 * tq + 3 - 31) / 16 : -1;
        const bf16* kcg = KC + (size_t)g * NCMP_P * HD + dq * 32; const bf16* vcg = VC + (size_t)g * NCMP_P * HD + dq * 32;
        {
            float m = -1e30f, l = 0.f;
            for (int j = 0; j <= jmax_w; ++j) {
                const float s = dot32q(q, kcg + (size_t)j * HD) - slope * (float)(t - (16 * j + 31));
                if (j <= jmax) { const float mn = fmaxf(m, s); l = l * fast_exp(m - mn) + fast_exp(s - mn); m = mn; }
            }
            const float rl = (l > 0.f) ? 1.0f / l : 0.f;
            float o[32];
#pragma unroll
            for (int i = 0; i < 32; ++i) o[i] = 0.f;
            for (int j = 0; j <= jmax_w; ++j) {
                const float s = dot32q(q, kcg + (size_t)j * HD) - slope * (float)(t - (16 * j + 31));
                const float pj = (j <= jmax) ? fast_exp(s - m) * rl : 0.f;
                axpy32(o, pj, vcg + (size_t)j * HD);
                float ps = pj; ps += __shfl_xor(ps, 4); ps += __shfl_xor(ps, 8);
                if (dq == 0 && p == 0) { IMP[ql * 128 + (j >> 2)] += ps; if ((j & 3) == 3 && (j >> 2) + 1 < 128) IMP[ql * 128 + (j >> 2) + 1] += ps; }
            }
#pragma unroll
            for (int i = 0; i < 32; ++i) otot[i] += g0 * o[i];
        }
        LDS_WAIT(); asm volatile("" ::: "memory");
        for (int qq = 0; qq < 4; ++qq) {
            const int tt = 4 * tq + qq, cur = tt >> 6;
            const int b0 = lane_of(F), b1 = lane_of(F) + 64;
            const float s0 = (b0 == cur) ? 2e6f : (b0 == 0 ? 1e6f : (b0 * 64 <= tt ? IMP[qq * 128 + b0] : -1e6f));
            const float s1 = (b1 == cur) ? 2e6f : (b1 * 64 <= tt ? IMP[qq * 128 + b1] : -1e6f);
            int r0 = 0, r1 = 0;
            for (int b = 0; b < 128; ++b) {
                const float sb = (b == cur) ? 2e6f : (b == 0 ? 1e6f : (b * 64 <= tt ? IMP[qq * 128 + b] : -1e6f));
                r0 += (sb > s0 || (sb == s0 && b < b0)) ? 1 : 0;
                r1 += (sb > s1 || (sb == s1 && b < b1)) ? 1 : 0;
            }
            const unsigned long long m0 = __ballot(r0 < 16 && b0 * 64 <= tt), m1 = __ballot(r1 < 16 && b1 * 64 <= tt);
            if (lane_of(F) == 0) { SELW[qq * 2] = m0; SELW[qq * 2 + 1] = m1; }
        }
        LDS_WAIT(); asm volatile("" ::: "memory");
        {
            const unsigned long long my0 = SELW[ql * 2], my1 = SELW[ql * 2 + 1];
            const unsigned long long u0v = SELW[0] | SELW[2] | SELW[4] | SELW[6], u1v = SELW[1] | SELW[3] | SELW[5] | SELW[7];
            const unsigned long long u0 = ((unsigned long long)(unsigned)__builtin_amdgcn_readfirstlane((int)(u0v >> 32)) << 32) | (unsigned)__builtin_amdgcn_readfirstlane((int)(unsigned)u0v);
            const unsigned long long u1 = ((unsigned long long)(unsigned)__builtin_amdgcn_readfirstlane((int)(u1v >> 32)) << 32) | (unsigned)__builtin_amdgcn_readfirstlane((int)(unsigned)u1v);
            float m = -1e30f, l = 0.f, o[32];
#pragma unroll
            for (int i = 0; i < 32; ++i) o[i] = 0.f;
            const bf16* kg = PA + CA_KS + g * HD + dq * 32; const bf16* vg = PA + CA_VS + g * HD + dq * 32;
            for (int b = 0; b < 128; ++b) {
                const bool inu = (b < 64) ? ((u0 >> b) & 1ull) : ((u1 >> (b - 64)) & 1ull);
                if (!inu) continue;
                const bool mine = (b < 64) ? ((my0 >> b) & 1ull) : ((my1 >> (b - 64)) & 1ull);
                for (int k = 0; k < 64; ++k) {
                    const int kp = b * 64 + k;
                    const float s = dot32q(q, kg + (size_t)kp * NA) - slope * (float)(t - kp);
                    const bool valid = mine && kp <= t;
                    OSM_STEP(s, valid, vg + (size_t)kp * NA);
                }
            }
            const float sc = (l > 0.f) ? g1 / l : 0.f;
#pragma unroll
            for (int i = 0; i < 32; ++i) otot[i] += sc * o[i];
        }
        {
            float m = -1e30f, l = 0.f, o[32];
#pragma unroll
            for (int i = 0; i < 32; ++i) o[i] = 0.f;
            const bf16* kg = PA + CA_KW + g * HD + dq * 32; const bf16* vg = PA + CA_VW + g * HD + dq * 32;
            const int klo = (4 * tq - 511 > 0) ? 4 * tq - 511 : 0, khi = 4 * tq + 3;
            for (int kp = klo; kp <= khi; ++kp) {
                const float s = dot32q(q, kg + (size_t)kp * NA) - slope * (float)(t - kp);
                const bool valid = kp <= t && (t - kp) < 512;
                OSM_STEP(s, valid, vg + (size_t)kp * NA);
            }
            const float sc = (l > 0.f) ? g2 / l : 0.f;
#pragma unroll
            for (int i = 0; i < 32; ++i) otot[i] += sc * o[i];
        }
        st32(MIX + (size_t)t * DM + head * HD + dq * 32, otot);
    }
}
__device__ __forceinline__ void mem_attn_naive(Frame& F, const bf16* P, int ldp, int qcol, const float* qg, int layer) {
    const bf16* MKV = WSP(bf16, WS_MKV); bf16* MIX = WSP(bf16, WS_MIX);
    const int gw = F.vcu * NWAVES + F.wave, NGW = F.G * NWAVES;
    const int dq = lane_of(F) & 3, r = lane_of(F) >> 2;
    for (int it = gw; it < NMEMH * (T / 16); it += NGW) {
        const int hm = it / (T / 16), t = 16 * (it % (T / 16)) + r;
        float q[32]; ld32(P + (size_t)t * ldp + qcol + hm * HD + dq * 32, q);
        float ss = 0.f;
#pragma unroll
        for (int i = 0; i < 32; ++i) ss += q[i] * q[i];
        ss += __shfl_xor(ss, 1); ss += __shfl_xor(ss, 2);
        const float rs = (1.0f / sqrtf(ss * (1.f / HD) + EPS)) * QSCALE;
#pragma unroll
        for (int i = 0; i < 32; ++i) q[i] = q[i] * rs * qg[dq * 32 + i];
        float m = -1e30f, l = 0.f, o[32];
#pragma unroll
        for (int i = 0; i < 32; ++i) o[i] = 0.f;
        const bf16* kg = MKV + layer * 1024 + hm * HD + dq * 32; const bf16* vg = kg + 512;
        for (int k = 0; k < MEMT; ++k) {
            const float s = dot32q(q, kg + (size_t)k * 2048);
            OSM_STEP(s, true, vg + (size_t)k * 2048);
        }
        const float sc = 1.0f / l;
#pragma unroll
        for (int i = 0; i < 32; ++i) o[i] *= sc;
        st32(MIX + (size_t)t * DM + NMIX * HD + hm * HD + dq * 32, o);
    }
}
__device__ __forceinline__ void stick_naive(Frame& F) {
    const bf16* PB = WSP(bf16, WS_PB); bf16* MIX = WSP(bf16, WS_MIX);
    const int gw = F.vcu * NWAVES + F.wave, NGW = F.G * NWAVES;
    const int dq = lane_of(F) & 3, r = lane_of(F) >> 2;
    for (int it = gw; it < NMIX * (T / 16); it += NGW) {
        const int h = it / (T / 16), t = 16 * (it % (T / 16)) + r;
        float q[32]; ld32(PB + (size_t)t * NB + CB_Q + h * HD + dq * 32, q);
#pragma unroll
        for (int i = 0; i < 32; ++i) q[i] *= QSCALE;
        float R = 0.f, o[32];
#pragma unroll
        for (int i = 0; i < 32; ++i) o[i] = 0.f;
        const bf16* kg = PB + CB_K + h * HD + dq * 32; const bf16* vg = PB + CB_V + h * HD + dq * 32;
        for (int i = 1; ; ++i) {
            const int s = t - i;
            const bool act = s >= 0 && R > -80.f;
            if (!__any(act)) break;
            const int sc = s >= 0 ? s : 0;
            const float z = dot32q(q, kg + (size_t)sc * NB);
            const float sp = fmaxf(z, 0.f) + __logf(1.0f + fast_exp(-fabsf(z)));
            if (act) { const float a = fast_exp(z - sp + R); axpy32(o, a, vg + (size_t)sc * NB); R -= sp; }
        }
        st32(MIX + (size_t)t * DM + h * HD + dq * 32, o);
    }
}

__device__ __forceinline__ void p12_router(Frame& F) {
    const float* X3 = WSP(float, WS_X3); bf16* XN = WSP(bf16, WS_XN);
    int* TOPI = (int*)(F.ws + WS_ROUTE + RT_TOPI); float* TOPW = (float*)(F.ws + WS_ROUTE + RT_TOPW); int* HIST = (int*)(F.ws + WS_ROUTE + RT_HIST);
    const float* rw = F.in[18]; const float* rb = F.in[19]; const float* gn = F.in[4] + DM;
    LAS int* hist = (LAS int*)(F.lds + RING_OFF);
    LAS float* GL = (LAS float*)(F.lds + RING_OFF + 1024);
    for (int i = F.tid; i < DM * 8; i += NWAVES * 64) { const int k = i >> 3, e = i & 7; GL[e * DM + k] = gn[k] * rw[i]; }
    __syncthreads();
    const int lane = lane_of(F);
    for (int c = F.vcu; c < 256; c += F.G) {
        if (F.tid < 8) hist[F.tid] = 0;
        __syncthreads();
#pragma unroll
        for (int ip = 0; ip < 2; ++ip) {
            f32x4 v[2][8];
#pragma unroll
            for (int u = 0; u < 2; ++u) { const f32x4* xr = (const f32x4*)(X3 + (size_t)(32 * c + 4 * F.wave + 2 * ip + u) * DM) + lane;
#pragma unroll
                for (int j = 0; j < 8; ++j) v[u][j] = xr[64 * j]; }
#pragma unroll
            for (int u = 0; u < 2; ++u) {
                const int t = 32 * c + 4 * F.wave + 2 * ip + u;
                float s = 0.f;
#pragma unroll
                for (int j = 0; j < 8; ++j) s += (v[u][j].x * v[u][j].x + v[u][j].y * v[u][j].y) + (v[u][j].z * v[u][j].z + v[u][j].w * v[u][j].w);
                const float rstd = 1.0f / sqrtf(wave_sum(s) * (1.f / DM) + EPS);
                v2u* o8 = (v2u*)(XN + (size_t)t * DM) + lane;
                float lg[8];
#pragma unroll
                for (int e = 0; e < 8; ++e) lg[e] = 0.f;
#pragma unroll
                for (int j = 0; j < 8; ++j) {
                    v2u w; w.x = pk2(v[u][j].x * rstd, v[u][j].y * rstd); w.y = pk2(v[u][j].z * rstd, v[u][j].w * rstd); o8[64 * j] = w;
#pragma unroll
                    for (int e = 0; e < 8; ++e) { const f32x4 gq = *(const LAS f32x4*)(GL + e * DM + 4 * (lane + 64 * j));
                        lg[e] += (v[u][j].x * gq.x + v[u][j].y * gq.y) + (v[u][j].z * gq.z + v[u][j].w * gq.w); }
                }
#pragma unroll
                for (int e = 0; e < 8; ++e) lg[e] = wave_sum(lg[e]) * rstd;
                if (lane == 0) {
                    int i0 = 0; float b0 = lg[0] + rb[0];
#pragma unroll
                    for (int e = 1; e < 8; ++e) { const float b = lg[e] + rb[e]; if (b > b0) { b0 = b; i0 = e; } }
                    int i1 = -1; float b1 = -3.0e38f;
#pragma unroll
                    for (int e = 0; e < 8; ++e) { const float b = lg[e] + rb[e]; if (e != i0 && b > b1) { b1 = b; i1 = e; } }
                    float l0 = 0.f, l1 = 0.f;
#pragma unroll
                    for (int e = 0; e < 8; ++e) { l0 = (e == i0) ? lg[e] : l0; l1 = (e == i1) ? lg[e] : l1; }
                    const float w0 = 1.0f / (1.0f + expf(l1 - l0));
                    TOPI[2 * t] = i0; TOPI[2 * t + 1] = i1; TOPW[2 * t] = w0; TOPW[2 * t + 1] = 1.0f - w0;
                    atomicAdd((int*)&hist[i0], 1); atomicAdd((int*)&hist[i1], 1);
                }
            }
        }
        __syncthreads();
        if (F.tid < 8) HIST[c * 8 + F.tid] = hist[F.tid];
        __syncthreads();
    }
}
__device__ __forceinline__ void p13_assign(Frame& F) {
    const bf16* XN = WSP(bf16, WS_XN); bf16* AM = WSP(bf16, WS_AMOE);
    const int* TOPI = (const int*)(F.ws + WS_ROUTE + RT_TOPI); int* ROW = (int*)(F.ws + WS_ROUTE + RT_ROW); const int* HIST = (const int*)(F.ws + WS_ROUTE + RT_HIST);
    int* TILE = (int*)(F.ws + WS_ROUTE + RT_TILE);
    LAS int* sh = (LAS int*)(F.lds + RING_OFF);
    for (int c = F.vcu; c < 256; c += F.G) {
        if (F.tid < 16) sh[16 + F.tid] = 0;
        __syncthreads();
        for (int i = F.tid; i < 2048; i += 512) { const int v = HIST[i], cc = i >> 3, ee = i & 7;
            __hip_atomic_fetch_add(&sh[16 + ee], v, __ATOMIC_RELAXED, __HIP_MEMORY_SCOPE_WORKGROUP);
            if (cc < c) __hip_atomic_fetch_add(&sh[24 + ee], v, __ATOMIC_RELAXED, __HIP_MEMORY_SCOPE_WORKGROUP); }
        __syncthreads();
        if (F.tid < 8) {
            const int e = F.tid; int off = 0;
            for (int ee = 0; ee < 8; ++ee) { if (ee == e) break; off += (sh[16 + ee] + 255) & ~255; }
            sh[e] = off + sh[24 + e];
            if (c == 0 && e == 0) {
                int nt = 0;
                for (int ee = 0; ee < 8; ++ee) { const int n = (sh[16 + ee] + 255) >> 8; for (int i = 0; i < n; ++i) TILE[16 + nt + i] = ee; nt += n; }
                TILE[0] = nt;
            }
        }
        __syncthreads();
        if (F.wave == 0) {
            const int tl = lane_of(F) >> 1, sl = lane_of(F) & 1, t = 32 * c + tl;
            const int e = TOPI[2 * t + sl];
            int row = 0;
            for (int ee = 0; ee < 8; ++ee) {
                const unsigned long long mk = __ballot(e == ee);
                if (e == ee) row = sh[ee] + __popcll(mk & ((1ull << lane_of(F)) - 1ull));
            }
            ROW[2 * t + sl] = row; sh[64 + lane_of(F)] = row;
        }
        __syncthreads();
        for (int i = 0; i < 8; ++i) {
            const int idx = 8 * F.wave + i, t = 32 * c + (idx >> 1), row = sh[64 + idx];
            const v4u* src = (const v4u*)(XN + (size_t)t * DM); v4u* dst = (v4u*)(AM + (size_t)row * DM);
#pragma unroll
            for (int j = 0; j < 4; ++j) dst[lane_of(F) + 64 * j] = src[lane_of(F) + 64 * j];
        }
        __syncthreads();
    }
}
__device__ __forceinline__ int moe_nsplit(int tail, int G) {
    const int cand[7] = {28, 14, 8, 7, 4, 2, 1};
    int s = 1;
#pragma unroll
    for (int i = 6; i >= 0; --i) if (tail * cand[i] <= G) s = cand[i];
    return s;
}
__device__ __forceinline__ void p16_combine(Frame& F, float dbg_scale) {
    const float* X3 = WSP(float, WS_X3); const bf16* Y = WSP(bf16, WS_YMOE); const float* SLAB = WSP(float, WS_SLAB);
    const int* ROW = (const int*)(F.ws + WS_ROUTE + RT_ROW); const float* TOPW = (const float*)(F.ws + WS_ROUTE + RT_TOPW); const int* TMAP = (const int*)(F.ctl + CW_TMAP);
    const int* TILE = (const int*)(F.ws + WS_ROUTE + RT_TILE);
    const int U = TILE[0] * (DM / 256), tail = U - (U / F.G) * F.G, nsp = tail > 0 ? moe_nsplit(tail, F.G) : 1;
    const int gw = F.vcu * NWAVES + F.wave, NGW = F.G * NWAVES, lane = lane_of(F);
    auto slab_sum = [&](const float* sp, float* d) {
        f32x4 u0 = {0.f, 0.f, 0.f, 0.f}, u1 = u0; int sI = 0;
        for (; sI + 4 <= nsp; sI += 4) {
            f32x4 p[8];
#pragma unroll
            for (int q = 0; q < 4; ++q) { p[2 * q] = *(const f32x4*)(sp + (size_t)(sI + q) * 65536); p[2 * q + 1] = *(const f32x4*)(sp + (size_t)(sI + q) * 65536 + 4); }
#pragma unroll
            for (int q = 0; q < 4; ++q) { u0 += p[2 * q]; u1 += p[2 * q + 1]; }
        }
        for (; sI < nsp; ++sI) { u0 += *(const f32x4*)(sp + (size_t)sI * 65536); u1 += *(const f32x4*)(sp + (size_t)sI * 65536 + 4); }
        d[0] = u0[0]; d[1] = u0[1]; d[2] = u0[2]; d[3] = u0[3]; d[4] = u1[0]; d[5] = u1[1]; d[6] = u1[2]; d[7] = u1[3];
    };
    for (int t = gw; t < T; t += NGW) {
        const int r0 = ROW[2 * t], r1 = ROW[2 * t + 1]; const float w0 = TOPW[2 * t], w1 = TOPW[2 * t + 1];
        const f32x4* xr = (const f32x4*)(X3 + (size_t)t * DM); f32x4* orow = (f32x4*)(F.out + (size_t)t * DM);
        int tm0[4], tm1[4]; v4u ya[4], yb[4]; f32x4 xa[4], xb[4];
#pragma unroll
        for (int j = 0; j < 4; ++j) {
            const int c8 = lane + 64 * j, pn = c8 >> 5;
            tm0[j] = TMAP[(r0 >> 8) * 8 + pn]; tm1[j] = TMAP[(r1 >> 8) * 8 + pn];
            ya[j] = *(const v4u*)(Y + (size_t)r0 * DM + 8 * c8); yb[j] = *(const v4u*)(Y + (size_t)r1 * DM + 8 * c8);
            xa[j] = xr[2 * c8]; xb[j] = xr[2 * c8 + 1];
        }
#pragma unroll
        for (int j = 0; j < 4; ++j) {
            const int c8 = lane + 64 * j, cc = (c8 & 31) * 8;
            float a[8], b[8];
            unpack8(ya[j], a); unpack8(yb[j], b);
            if (tm0[j] != 0) slab_sum(SLAB + (size_t)(tm0[j] - 1) * 65536 + (size_t)(r0 & 255) * 256 + cc, a);
            if (tm1[j] != 0) slab_sum(SLAB + (size_t)(tm1[j] - 1) * 65536 + (size_t)(r1 & 255) * 256 + cc, b);
            orow[2 * c8] = (f32x4){xa[j].x + w0 * a[0] + w1 * b[0], xa[j].y + w0 * a[1] + w1 * b[1], xa[j].z + w0 * a[2] + w1 * b[2], xa[j].w + w0 * a[3] + w1 * b[3]} * dbg_scale;
            orow[2 * c8 + 1] = (f32x4){xb[j].x + w0 * a[4] + w1 * b[4], xb[j].y + w0 * a[5] + w1 * b[5], xb[j].z + w0 * a[6] + w1 * b[6], xb[j].w + w0 * a[7] + w1 * b[7]} * dbg_scale;
        }
    }
}

namespace at {
typedef short bf16x8 __attribute__((ext_vector_type(8)));
typedef short s16x4 __attribute__((ext_vector_type(4)));
typedef float f32x16 __attribute__((ext_vector_type(16)));
constexpr int SHM_T = 16384;
constexpr int L_V = 0, L_K = 2 * SHM_T, L_WS = 4 * SHM_T, L_IMP = L_WS + 8 * 256, L_SEL = L_IMP + 64 * 128 * 4, L_PS = L_SEL + 1024, L_WU = L_PS + 8 * 2176, L_LIST = L_WU + 128, L_DONE = L_LIST + 512, L_END = L_DONE + 64;
static_assert(L_END <= RING_BYTES, "attention LDS map");
constexpr float C2 = 0.08838834764831845f * 1.4426950408889634f;
constexpr float LOG2E = 1.4426950408889634f;

#define KSWZ(row, colB) ((row) * 256 + ((colB) ^ (((row) & 7) << 4)))
#define SBAR() __builtin_amdgcn_sched_barrier(0)
__device__ __forceinline__ int v_st(int k, int c) { const int kk = (k & ~0xC) | ((k & 4) << 1) | ((k & 8) >> 1); return ((kk >> 3) * 4 + (c >> 5)) * 512 + ((kk & 7) * 32 + (c & 31)) * 2; }
__device__ __forceinline__ int v_rd_base(int lane) { return ((lane & 3) << 3) | (((lane >> 2) & 3) << 6) | (((lane >> 4) & 1) << 5) | (((lane >> 5) & 1) << 8); }
constexpr int v_rd_off(int d0, int ks, int half) { return d0 * 512 + ks * 4096 + half * 2048; }
__device__ __forceinline__ int crow(int r, int hi) { return (r & 3) + 8 * (r >> 2) + 4 * hi; }
__device__ __forceinline__ unsigned cvtpk(float lo, float hi) { unsigned r; asm volatile("v_cvt_pk_bf16_f32 %0, %1, %2" : "=v"(r) : "v"(lo), "v"(hi)); return r; }
__device__ __forceinline__ float xhalf_max(float v) { auto rr = __builtin_amdgcn_permlane32_swap(__float_as_uint(v), __float_as_uint(v), false, false); return fmaxf(__uint_as_float(rr[0]), __uint_as_float(rr[1])); }
__device__ __forceinline__ float xhalf_sum(float v) { auto rr = __builtin_amdgcn_permlane32_swap(__float_as_uint(v), __float_as_uint(v), false, false); return __uint_as_float(rr[0]) + __uint_as_float(rr[1]); }
__device__ __forceinline__ float quad_sum(float x) {
    x += __int_as_float(__builtin_amdgcn_update_dpp(0, __float_as_int(x), 0xB1, 0xF, 0xF, true));
    x += __int_as_float(__builtin_amdgcn_update_dpp(0, __float_as_int(x), 0x4E, 0xF, 0xF, true));
    return x;
}
__device__ __forceinline__ void pack_p(const f32x16& p0, const f32x16& p1, bf16x8& pa0, bf16x8& pa1, bf16x8& pa2, bf16x8& pa3) {
#define PK4(P, B_, OUT) do { unsigned a0 = cvtpk(P[B_+0], P[B_+1]), a1 = cvtpk(P[B_+2], P[B_+3]);                          \
        unsigned b0 = cvtpk(P[B_+4], P[B_+5]), b1 = cvtpk(P[B_+6], P[B_+7]);                                             \
        auto r0 = __builtin_amdgcn_permlane32_swap(a0, b0, false, false); auto r1 = __builtin_amdgcn_permlane32_swap(a1, b1, false, false); \
        v4u w = {r0[0], r1[0], r0[1], r1[1]}; OUT = *reinterpret_cast<bf16x8*>(&w); } while (0)
    PK4(p0, 0, pa0); PK4(p0, 8, pa1); PK4(p1, 0, pa2); PK4(p1, 8, pa3);
#undef PK4
}
template <int KB>
__device__ __forceinline__ void qkt(f32x16& p0, f32x16& p1, LAS unsigned char* lds, int r32, int hi, const bf16x8* qr) {
    p0 = f32x16{}; p1 = f32x16{};
    LAS unsigned char* kb[4];
#pragma unroll
    for (int dd = 0; dd < 4; ++dd) kb[dd] = lds + L_K + KB * SHM_T + KSWZ(r32, (dd * 16 + hi * 8) * 2);
#pragma unroll
    for (int d0 = 0; d0 < 8; ++d0) { LAS unsigned char* a = kb[d0 & 3] + (d0 >> 2) * 128;
        const bf16x8 b0 = *(const LAS bf16x8*)a;
        const bf16x8 b1 = *(const LAS bf16x8*)(a + 32 * 256);
        p0 = __builtin_amdgcn_mfma_f32_32x32x16_bf16(b0, qr[d0], p0, 0, 0, 0);
        p1 = __builtin_amdgcn_mfma_f32_32x32x16_bf16(b1, qr[d0], p1, 0, 0, 0); }
}
template <int VB>
__device__ __forceinline__ void pv_tile(f32x16* o, int vb0, bf16x8 pa0, bf16x8 pa1, bf16x8 pa2, bf16x8 pa3) {
#define TRRD(dst, off) asm volatile("ds_read_b64_tr_b16 %0, %1 offset:%2" : "=&v"(dst) : "v"(vb0), "i"(off) : "memory")
#define PV_RD(S_, d0) do { constexpr int b_ = VB * SHM_T + v_rd_off(d0, 0, 0); \
        TRRD(S_##l0, b_); TRRD(S_##h0, b_ + 2048); TRRD(S_##l1, b_ + 4096); TRRD(S_##h1, b_ + 6144); TRRD(S_##l2, b_ + 8192); TRRD(S_##h2, b_ + 10240); TRRD(S_##l3, b_ + 12288); TRRD(S_##h3, b_ + 14336); } while (0)
#define PV_MM(S_, d0) do { \
        o[d0] = __builtin_amdgcn_mfma_f32_32x32x16_bf16(pa0, (bf16x8){S_##l0[0], S_##l0[1], S_##l0[2], S_##l0[3], S_##h0[0], S_##h0[1], S_##h0[2], S_##h0[3]}, o[d0], 0, 0, 0);   \
        o[d0] = __builtin_amdgcn_mfma_f32_32x32x16_bf16(pa1, (bf16x8){S_##l1[0], S_##l1[1], S_##l1[2], S_##l1[3], S_##h1[0], S_##h1[1], S_##h1[2], S_##h1[3]}, o[d0], 0, 0, 0);   \
        o[d0] = __builtin_amdgcn_mfma_f32_32x32x16_bf16(pa2, (bf16x8){S_##l2[0], S_##l2[1], S_##l2[2], S_##l2[3], S_##h2[0], S_##h2[1], S_##h2[2], S_##h2[3]}, o[d0], 0, 0, 0);   \
        o[d0] = __builtin_amdgcn_mfma_f32_32x32x16_bf16(pa3, (bf16x8){S_##l3[0], S_##l3[1], S_##l3[2], S_##l3[3], S_##h3[0], S_##h3[1], S_##h3[2], S_##h3[3]}, o[d0], 0, 0, 0); } while (0)
    s16x4 Al0, Al1, Al2, Al3, Ah0, Ah1, Ah2, Ah3, Bl0, Bl1, Bl2, Bl3, Bh0, Bh1, Bh2, Bh3;
    PV_RD(A, 0);
    PV_RD(B, 1); asm volatile("s_waitcnt lgkmcnt(8)" ::: "memory"); SBAR(); PV_MM(A, 0); SBAR();
    PV_RD(A, 2); asm volatile("s_waitcnt lgkmcnt(8)" ::: "memory"); SBAR(); PV_MM(B, 1); SBAR();
    PV_RD(B, 3); asm volatile("s_waitcnt lgkmcnt(8)" ::: "memory"); SBAR(); PV_MM(A, 2); SBAR();
    asm volatile("s_waitcnt lgkmcnt(0)" ::: "memory"); SBAR(); PV_MM(B, 3);
#undef PV_MM
#undef PV_RD
#undef TRRD
}
struct Stg { v4u a, b; };
struct Tile { const bf16* K; const bf16* V; size_t ld; };
__device__ __forceinline__ void stg_load(Stg& S, const bf16* base, size_t ld, int sr, int sc) {
    S.a = *(const v4u*)(base + (size_t)sr * ld + sc); S.b = *(const v4u*)(base + (size_t)(32 + sr) * ld + sc);
}
template <int BUF> __device__ __forceinline__ void stg_write_k(const Stg& S, LAS unsigned char* lds, int sr, int sc) {
    const int kws = KSWZ(sr, sc * 2);
    *(LAS v4u*)(lds + L_K + BUF * SHM_T + kws) = S.a; *(LAS v4u*)(lds + L_K + BUF * SHM_T + kws + 32 * 256) = S.b;
}
template <int BUF> __device__ __forceinline__ void stg_write_v(const Stg& S, LAS unsigned char* lds, int sr, int sc) {
    *(LAS v4u*)(lds + L_V + BUF * SHM_T + v_st(sr, sc)) = S.a; *(LAS v4u*)(lds + L_V + BUF * SHM_T + v_st(32 + sr, sc)) = S.b;
}

template <int PASS, int KB, class Br>
__device__ __forceinline__ void step(Br& br, int i, Stg& SK, Stg& SV, LAS unsigned char* lds, int tid, const bf16x8* qr, float& m2, float& l, float f, f32x16* o) {
    int tz = tid; asm volatile("" : "+v"(tz));
    const int lane = tz & 63, sr = tz >> 4, sc = (tz & 15) * 8, r32 = lane & 31, hi = lane >> 5;
    const int vb0 = (int)(uintptr_t)(lds + L_V) + v_rd_base(lane);
    if (i + 1 < br.nt) {
        stg_write_k<KB ^ 1>(SK, lds, sr, sc);
        if (PASS >= 2) stg_write_v<KB ^ 1>(SV, lds, sr, sc);
        if (i + 2 < br.nt) { const Tile nx = br.tile(i + 2); stg_load(SK, nx.K, nx.ld, sr, sc); if (PASS >= 2) stg_load(SV, nx.V, nx.ld, sr, sc); }
    }
    SBAR();
    if (br.act(i)) {
        f32x16 p0, p1;
        qkt<KB>(p0, p1, lds, r32, hi, qr);
        SBAR();
        if (PASS == 3) br.probs(p0, p1, i, lane, m2); else br.scores(p0, p1, i, lane);
        if (PASS == 1) {
            float pmax = p0[0];
#pragma unroll
            for (int r = 1; r < 16; ++r) pmax = fmaxf(pmax, p0[r]);
#pragma unroll
            for (int r = 0; r < 16; ++r) pmax = fmaxf(pmax, p1[r]);
            pmax = xhalf_max(pmax);
            const float mn = fmaxf(m2, pmax);
            float ps = 0.f;
#pragma unroll
            for (int r = 0; r < 16; ++r) ps += __builtin_amdgcn_exp2f(p0[r] - mn) + __builtin_amdgcn_exp2f(p1[r] - mn);
            ps = xhalf_sum(ps);
            l = l * __builtin_amdgcn_exp2f(m2 - mn) + ps; m2 = mn;
        } else {
            if (PASS == 2) {
#pragma unroll
                for (int r = 0; r < 16; ++r) { p0[r] = __builtin_amdgcn_exp2f(p0[r] - m2) * f; p1[r] = __builtin_amdgcn_exp2f(p1[r] - m2) * f; }
                br.hook(p0, p1, i, lane);
            } else {
                float ps = 0.f;
#pragma unroll
                for (int r = 0; r < 16; ++r) ps += p0[r] + p1[r];
                l += xhalf_sum(ps);
            }
            SBAR();
            bf16x8 pa0, pa1, pa2, pa3; pack_p(p0, p1, pa0, pa1, pa2, pa3);
            SBAR();
            pv_tile<KB>(o, vb0, pa0, pa1, pa2, pa3);
        }
    }
    __syncthreads();
}
template <int PASS, class Br>
__device__ __forceinline__ void run_pass(Br& br, LAS unsigned char* lds, int tid, const bf16x8* qr, float& m2, float& l, float f, f32x16* o) {
    if (br.nt <= 0) return;
    const int sr = tid >> 4, sc = (tid & 15) * 8;
    Stg SK, SV;
    { const Tile t0 = br.tile(0); stg_load(SK, t0.K, t0.ld, sr, sc); if (PASS >= 2) stg_load(SV, t0.V, t0.ld, sr, sc);
      stg_write_k<0>(SK, lds, sr, sc); if (PASS >= 2) stg_write_v<0>(SV, lds, sr, sc); }
    if (br.nt > 1) { const Tile t1 = br.tile(1); stg_load(SK, t1.K, t1.ld, sr, sc); if (PASS >= 2) stg_load(SV, t1.V, t1.ld, sr, sc); }
    __syncthreads();
    for (int i = 0; i < br.nt; i += 2) {
        step<PASS, 0>(br, i, SK, SV, lds, tid, qr, m2, l, f, o);
        if (i + 1 < br.nt) step<PASS, 1>(br, i + 1, SK, SV, lds, tid, qr, m2, l, f, o);
    }
}
__device__ __forceinline__ void scale_rows(f32x16* o, float frow, LAS float* ws, int lane) {
    const int r32 = lane & 31, hi = lane >> 5;
    if (hi == 0) ws[r32] = frow;
    LDS_WAIT(); asm volatile("" ::: "memory");
#pragma unroll
    for (int r = 0; r < 16; ++r) { const float a = ws[crow(r, hi)];
#pragma unroll
        for (int d0 = 0; d0 < 4; ++d0) o[d0][r] *= a; }
    LDS_WAIT(); asm volatile("" ::: "memory");
}
__device__ __forceinline__ float gain_absmax(const float* g, int lane) {
    float a = fmaxf(fabsf(g[lane]), fabsf(g[lane + 64]));
#pragma unroll
    for (int o = 1; o < 64; o <<= 1) a = fmaxf(a, __shfl_xor(a, o));
    return __uint_as_float((unsigned)__builtin_amdgcn_readfirstlane((int)__float_as_uint(a)));
}
__device__ __forceinline__ void o_store(const f32x16* o, float* blk, int lane) {
#pragma unroll
    for (int d0 = 0; d0 < 4; ++d0) {
        float* b = blk + d0 * 1024 + lane; asm volatile("" : "+v"(b));
#pragma unroll
        for (int r = 0; r < 16; ++r) b[r * 64] = o[d0][r];
    }
}
__device__ __forceinline__ void o_addload(f32x16* o, const float* blk, int lane) {
#pragma unroll
    for (int d0 = 0; d0 < 4; ++d0) {
        const float* b = blk + d0 * 1024 + lane; asm volatile("" : "+v"(b));
#pragma unroll
        for (int r = 0; r < 16; ++r) o[d0][r] += b[r * 64];
        asm volatile("" : "+v"(o[d0]) :: "memory");
    }
}
__device__ __forceinline__ void load_q(bf16x8* qr, const bf16* qrow, int hi) {
#pragma unroll
    for (int d0 = 0; d0 < 8; ++d0) { const v4u w = *(const v4u*)(qrow + d0 * 16 + hi * 8); qr[d0] = *reinterpret_cast<const bf16x8*>(&w); }
}

struct RowNsa { int t; float slope2; };
struct BrCmp {
    int nt; const bf16* K; const bf16* V; int jmax_w; RowNsa R;
    LAS float* ps; LAS float* imp;
    __device__ __forceinline__ Tile tile(int i) const { return Tile{K + (size_t)i * 64 * HD, V + (size_t)i * 64 * HD, (size_t)HD}; }
    __device__ __forceinline__ bool act(int i) const { return 64 * i <= jmax_w; }
    __device__ __forceinline__ void scores(f32x16& p0, f32x16& p1, int i, int lane) const {
        const float NEG = -__builtin_inff(); const int hi = lane >> 5;
        float sl = R.slope2; asm volatile("" : "+v"(sl));
        int tt = R.t; asm volatile("" : "+v"(tt));
        const int jmax = (tt >= 31) ? ((tt - 31) >> 4) : -1;
        const int jm = jmax - 64 * i - 4 * hi;
        const float b0 = -sl * (float)(tt - 31 - 16 * (64 * i + 4 * hi));
#pragma unroll
        for (int r = 0; r < 16; ++r) { const int c = (r & 3) + 8 * (r >> 2);
            p0[r] = (c <= jm) ? fmaf(p0[r], C2, fmaf(sl, (float)(16 * c), b0)) : NEG;
            p1[r] = (c + 32 <= jm) ? fmaf(p1[r], C2, fmaf(sl, (float)(16 * c + 512), b0)) : NEG; }
    }
    __device__ __forceinline__ void probs(f32x16&, f32x16&, int, int, float) const {}
    __device__ __forceinline__ void hook(const f32x16& p0, const f32x16& p1, int i, int lane) const {
        const int r32 = lane & 31, hi = lane >> 5, pp = r32 & 3, ql = r32 >> 2;
#pragma unroll
        for (int qd = 0; qd < 4; ++qd) {
            f32x4 a, b;
#pragma unroll
            for (int e = 0; e < 4; ++e) { a[e] = quad_sum(p0[4 * qd + e]); b[e] = quad_sum(p1[4 * qd + e]); }
            if (pp == qd) { *(LAS f32x4*)(ps + ql * 68 + 4 + 8 * qd + 4 * hi) = a; *(LAS f32x4*)(ps + ql * 68 + 4 + 32 + 8 * qd + 4 * hi) = b; }
        }
        LDS_WAIT(); asm volatile("" ::: "memory");
#pragma unroll
        for (int h2 = 0; h2 < 2; ++h2) { const int idx = lane + 64 * h2, q8 = idx >> 4, mq = idx & 15;
            const f32x4 v = *(const LAS f32x4*)(ps + q8 * 68 + 4 + 4 * mq); const float pv = ps[q8 * 68 + 3 + 4 * mq];
            imp[q8 * 128 + 16 * i + mq] = (v[0] + v[1]) + (v[2] + v[3]) + pv; }
        LDS_WAIT(); asm volatile("" ::: "memory");
        if (lane < 8) ps[lane * 68 + 3] = ps[lane * 68 + 4 + 63];
        LDS_WAIT(); asm volatile("" ::: "memory");
    }
};
struct BrSlc {
    int nt; const bf16* K; const bf16* V; RowNsa R; int cur;
    const LAS int* list; const LAS unsigned long long* sel; const LAS unsigned long long* wu;
    __device__ __forceinline__ int blk(int i) const { return list[i]; }
    __device__ __forceinline__ Tile tile(int i) const { const int b = __builtin_amdgcn_readfirstlane(blk(i)); return Tile{K + (size_t)b * 64 * NA, V + (size_t)b * 64 * NA, (size_t)NA}; }
    __device__ __forceinline__ bool act(int i) const { const int b = __builtin_amdgcn_readfirstlane(blk(i)); const unsigned long long u = wu[b >> 6]; return (u >> (b & 63)) & 1ull; }
    __device__ __forceinline__ void scores(f32x16& p0, f32x16& p1, int i, int lane) const {
        const float NEG = -__builtin_inff(); const int b = __builtin_amdgcn_readfirstlane(blk(i)); const int hi = lane >> 5, ql = (lane & 31) >> 2;
        const unsigned long long mm = sel[ql * 2 + (b >> 6)];
        const bool mine = (mm >> (b & 63)) & 1ull;
        float sl = R.slope2; asm volatile("" : "+v"(sl));
        int tt = R.t; asm volatile("" : "+v"(tt));
        const int dm = mine ? (tt - 64 * b - 4 * hi) : -1;
        const float b0 = -sl * (float)dm;
#pragma unroll
        for (int r = 0; r < 16; ++r) { const int c = (r & 3) + 8 * (r >> 2);
            p0[r] = (c <= dm) ? fmaf(p0[r], C2, fmaf(sl, (float)c, b0)) : NEG;
            p1[r] = (c + 32 <= dm) ? fmaf(p1[r], C2, fmaf(sl, (float)(c + 32), b0)) : NEG; }
    }
    __device__ __forceinline__ void probs(f32x16& p0, f32x16& p1, int i, int lane, float m2) const {
        const int b = __builtin_amdgcn_readfirstlane(blk(i)); const int hi = lane >> 5, ql = (lane & 31) >> 2;
        const unsigned long long mm = sel[ql * 2 + (b >> 6)];
        const bool mine = (mm >> (b & 63)) & 1ull;
        float sl = R.slope2; asm volatile("" : "+v"(sl));
        int tt = R.t; asm volatile("" : "+v"(tt));
        const int dm = tt - 64 * b - 4 * hi;
        const float base = mine ? (-sl * (float)dm - m2) : -__builtin_inff();
        if (b < cur) {
#pragma unroll
            for (int r = 0; r < 16; ++r) { const int c = (r & 3) + 8 * (r >> 2);
                p0[r] = __builtin_amdgcn_exp2f(fmaf(p0[r], C2, fmaf(sl, (float)c, base)));
                p1[r] = __builtin_amdgcn_exp2f(fmaf(p1[r], C2, fmaf(sl, (float)(c + 32), base))); }
        } else {
#pragma unroll
            for (int r = 0; r < 16; ++r) { const int c = (r & 3) + 8 * (r >> 2);
                p0[r] = (c <= dm) ? __builtin_amdgcn_exp2f(fmaf(p0[r], C2, fmaf(sl, (float)c, base))) : 0.f;
                p1[r] = (c + 32 <= dm) ? __builtin_amdgcn_exp2f(fmaf(p1[r], C2, fmaf(sl, (float)(c + 32), base))) : 0.f; }
        }
    }
    __device__ __forceinline__ void hook(const f32x16&, const f32x16&, int, int) const {}
};
struct BrWin {
    int nt; const bf16* K; const bf16* V; RowNsa R; int kb0, tw;
    __device__ __forceinline__ Tile tile(int i) const { return Tile{K + (size_t)(kb0 + i) * 64 * NA, V + (size_t)(kb0 + i) * 64 * NA, (size_t)NA}; }
    __device__ __forceinline__ bool act(int) const { return true; }
    __device__ __forceinline__ void scores(f32x16& p0, f32x16& p1, int i, int lane) const {
        const float NEG = -__builtin_inff(); const int hi = lane >> 5;
        float sl = R.slope2; asm volatile("" : "+v"(sl));
        int tt = R.t; asm volatile("" : "+v"(tt));
        const int dm = tt - 64 * (kb0 + i) - 4 * hi;
        const float b0 = -sl * (float)dm;
#pragma unroll
        for (int r = 0; r < 16; ++r) { const int c = (r & 3) + 8 * (r >> 2);
            p0[r] = ((unsigned)(dm - c) < 512u) ? fmaf(p0[r], C2, fmaf(sl, (float)c, b0)) : NEG;
            p1[r] = ((unsigned)(dm - c - 32) < 512u) ? fmaf(p1[r], C2, fmaf(sl, (float)(c + 32), b0)) : NEG; }
    }
    __device__ __forceinline__ void probs(f32x16& p0, f32x16& p1, int i, int lane, float m2) const {
        const int hi = lane >> 5;
        float sl = R.slope2; asm volatile("" : "+v"(sl));
        int tt = R.t; asm volatile("" : "+v"(tt));
        const int kb = kb0 + i, dm = tt - 64 * kb - 4 * hi;
        const float base = -sl * (float)dm - m2;
        if (64 * kb + 63 <= tw && 64 * kb >= tw + 7 - 511) {
#pragma unroll
            for (int r = 0; r < 16; ++r) { const int c = (r & 3) + 8 * (r >> 2);
                p0[r] = __builtin_amdgcn_exp2f(fmaf(p0[r], C2, fmaf(sl, (float)c, base)));
                p1[r] = __builtin_amdgcn_exp2f(fmaf(p1[r], C2, fmaf(sl, (float)(c + 32), base))); }
        } else {
#pragma unroll
            for (int r = 0; r < 16; ++r) { const int c = (r & 3) + 8 * (r >> 2);
                p0[r] = ((unsigned)(dm - c) < 512u) ? __builtin_amdgcn_exp2f(fmaf(p0[r], C2, fmaf(sl, (float)c, base))) : 0.f;
                p1[r] = ((unsigned)(dm - c - 32) < 512u) ? __builtin_amdgcn_exp2f(fmaf(p1[r], C2, fmaf(sl, (float)(c + 32), base))) : 0.f; }
        }
    }
    __device__ __forceinline__ void hook(const f32x16&, const f32x16&, int, int) const {}
};
struct BrMem {
    int nt; const bf16* K; const bf16* V;
    __device__ __forceinline__ Tile tile(int i) const { return Tile{K + (size_t)i * 64 * 2048, V + (size_t)i * 64 * 2048, (size_t)2048}; }
    __device__ __forceinline__ bool act(int) const { return true; }
    __device__ __forceinline__ void scores(f32x16& p0, f32x16& p1, int, int) const {
#pragma unroll
        for (int r = 0; r < 16; ++r) { p0[r] *= C2; p1[r] *= C2; }
    }
    __device__ __forceinline__ void probs(f32x16& p0, f32x16& p1, int, int, float m2) const {
#pragma unroll
        for (int r = 0; r < 16; ++r) { p0[r] = __builtin_amdgcn_exp2f(fmaf(p0[r], C2, -m2)); p1[r] = __builtin_amdgcn_exp2f(fmaf(p1[r], C2, -m2)); }
    }
    __device__ __forceinline__ void hook(const f32x16&, const f32x16&, int, int) const {}
};
template <class RP> __device__ __forceinline__ void store_o(const f32x16* o, int lane, RP rowptr) {
    const int r32 = lane & 31, hi = lane >> 5;
#pragma unroll
    for (int r = 0; r < 16; ++r) { bf16* rp = rowptr(crow(r, hi));
#pragma unroll
        for (int d0 = 0; d0 < 4; ++d0) { const float v = o[d0][r]; const float vn = __shfl_xor(v, 1);
            if ((r32 & 1) == 0) *(unsigned*)(rp + d0 * 32 + r32) = cvtpk(v, vn); } }
}
}

__device__ __forceinline__ void topk_select(unsigned k0, unsigned k1, int need, int lane, unsigned long long& s0, unsigned long long& s1) {
    unsigned thr = 0u;
    for (int bit = 31; bit >= 0; --bit) {
        const unsigned cand = thr | (1u << bit);
        const int cnt = __popcll(__ballot(k0 >= cand)) + __popcll(__ballot(k1 >= cand));
        if (cnt >= need) thr = cand;
    }
    const unsigned long long g0 = __ballot(k0 > thr), g1 = __ballot(k1 > thr), e0 = __ballot(k0 == thr && thr != 0u), e1 = __ballot(k1 == thr && thr != 0u);
    const int rem = need - (__popcll(g0) + __popcll(g1));
    const unsigned long long lt = (1ull << lane) - 1ull;
    const bool t0 = (k0 == thr && thr != 0u) && (__popcll(e0 & lt) < rem);
    const bool t1 = (k1 == thr && thr != 0u) && (__popcll(e0) + __popcll(e1 & lt) < rem);
    s0 = g0 | __ballot(t0); s1 = g1 | __ballot(t1);
}

__device__ __forceinline__ void nsa_item(Frame& F, int g, int qb, float mb_cmp, float mb_slc, float mb_win) {
    using namespace at;
    LAS unsigned char* lds = F.lds + RING_OFF;
    const bf16* PA = WSP(bf16, WS_PA); const bf16* KC = WSP(bf16, WS_KCMP) + (size_t)g * NCMP_P * HD; const bf16* VC = KC + (size_t)NG * NCMP_P * HD; bf16* MIX = WSP(bf16, WS_MIX);
    int tz = F.tid; asm volatile("" : "+v"(tz));
    const int lane = tz & 63, w = F.wave, r32 = lane & 31, hi = lane >> 5;
    const int t0 = 64 * qb, tw = t0 + 8 * w, ql = r32 >> 2, pp = r32 & 3, t = tw + ql, head = 4 * g + pp;
    LAS float* ws = (LAS float*)(lds + L_WS + w * 256);
    LAS float* IMP = (LAS float*)(lds + L_IMP) + w * 8 * 128;
    LAS float* PS = (LAS float*)(lds + L_PS + w * 2176);
    LAS unsigned long long* SEL = (LAS unsigned long long*)(lds + L_SEL);
    LAS unsigned long long* WU = (LAS unsigned long long*)(lds + L_WU);
    LAS int* LIST = (LAS int*)(lds + L_LIST);
    float* oacc = WSP(float, WS_OACC) + ((size_t)((g * 128 + qb) * 8 + w)) * 4096;
    RowNsa R; R.t = t; R.slope2 = exp2f(-8.0f * (float)(head + 1) / 12.0f) * LOG2E;
    int i0c, bmin;
    { const float slope_min2 = exp2f(-8.0f * (float)(4 * g + 4) / 12.0f) * LOG2E;
      const int Dc = (int)((149.f + 2.f * mb_cmp) / slope_min2) + 17, xc = t0 - Dc - 1039;
      const int Ds = (int)((149.f + 2.f * mb_slc) / slope_min2) + 2, xs = t0 - Ds - 63;
      i0c = __builtin_amdgcn_readfirstlane(xc > 0 ? (xc + 1023) / 1024 : 0); bmin = __builtin_amdgcn_readfirstlane(xs > 0 ? (xs + 63) / 64 : 0); }
    bf16x8 qr[8]; load_q(qr, PA + (size_t)t * NA + CA_Q + head * HD, hi);
#define GATE(br_) (1.0f / (1.0f + fast_exp(-bf2f(PA[(size_t)t * NA + CA_GT + head * 3 + (br_)]))))
    f32x16 o[4] = {};
    for (int i = lane; i < 8 * 128; i += 64) IMP[i] = 0.f;
    if (lane < 8) PS[lane * 68 + 3] = 0.f;
    LDS_WAIT(); asm volatile("" ::: "memory");
    {
        const int jmax_b = (t0 + 63 - 31) / 16;
        const int ntf = jmax_b / 64 + 1, i0 = i0c < ntf - 1 ? i0c : ntf - 1;
        BrCmp br; br.K = KC + (size_t)i0 * 64 * HD; br.V = VC + (size_t)i0 * 64 * HD; br.R = R; br.R.t = t - 1024 * i0; br.ps = PS; br.imp = IMP + 16 * i0;
        br.jmax_w = ((tw + 7 >= 31) ? (tw + 7 - 31) / 16 : -1) - 64 * i0;
        br.nt = ntf - i0;
        float m2 = -1e30f, l = 0.f;
        run_pass<1>(br, lds, tz, qr, m2, l, 0.f, o);
        const float f = (l > 0.f) ? 1.0f / l : 0.f;
        run_pass<2>(br, lds, tz, qr, m2, l, f, o);
        scale_rows(o, GATE(0), ws, lane);
        o_store(o, oacc, lane);
#pragma unroll
        for (int d0 = 0; d0 < 4; ++d0) o[d0] = f32x16{};
    }
    for (int qq = 0; qq < 8; ++qq) {
        const int tt = tw + qq, cur = tt >> 6;
        const int b0 = lane, b1 = lane + 64;
        unsigned long long s0 = 0ull, s1 = 0ull;
        const int ncand = cur - 1;
        const bool c0 = (b0 >= 1 && b0 < cur), c1 = (b1 < cur);
        if (ncand <= 14) { s0 = __ballot(c0); s1 = __ballot(c1); }
        else {
            const unsigned k0 = c0 ? (__float_as_uint(IMP[qq * 128 + b0]) + 1u) : 0u, k1 = c1 ? (__float_as_uint(IMP[qq * 128 + b1]) + 1u) : 0u;
            topk_select(k0, k1, 14, lane, s0, s1);
        }
        s0 |= 1ull;
        if (cur < 64) s0 |= (1ull << cur); else s1 |= (1ull << (cur - 64));
        if (lane == 0) { SEL[(8 * w + qq) * 2] = s0; SEL[(8 * w + qq) * 2 + 1] = s1; }
    }
    LDS_WAIT(); asm volatile("" ::: "memory");
    unsigned long long wu0 = 0ull, wu1 = 0ull;
#pragma unroll
    for (int qq = 0; qq < 8; ++qq) { wu0 |= SEL[(8 * w + qq) * 2]; wu1 |= SEL[(8 * w + qq) * 2 + 1]; }
    if (lane == 0) { WU[2 * w] = wu0; WU[2 * w + 1] = wu1; }
    __syncthreads();
    int nsl = 0;
    {
        unsigned long long u0 = 0ull, u1 = 0ull;
#pragma unroll
        for (int ww = 0; ww < 8; ++ww) { u0 |= WU[2 * ww]; u1 |= WU[2 * ww + 1]; }
        if (bmin >= 64) { u0 = 0ull; u1 &= ~((1ull << (bmin - 64)) - 1ull); } else if (bmin > 0) u0 &= ~((1ull << bmin) - 1ull);
        nsl = __popcll(u0) + __popcll(u1);
        if (w == 0) {
            const unsigned long long lt = (1ull << lane) - 1ull;
            if ((u0 >> lane) & 1ull) LIST[__popcll(u0 & lt)] = lane;
            if ((u1 >> lane) & 1ull) LIST[__popcll(u0) + __popcll(u1 & lt)] = lane + 64;
        }
    }
    __syncthreads();
    {
        BrSlc br; br.K = PA + CA_KS + g * HD; br.V = PA + CA_VS + g * HD; br.R = R; br.list = LIST; br.nt = nsl; br.cur = qb;
        br.sel = SEL + 16 * w; br.wu = WU + 2 * w;
        float m2 = mb_slc, l = 0.f;
        run_pass<3>(br, lds, tz, qr, m2, l, 0.f, o);
        scale_rows(o, (l > 0.f) ? GATE(1) / l : 0.f, ws, lane);
        o_addload(o, oacc, lane); o_store(o, oacc, lane);
#pragma unroll
        for (int d0 = 0; d0 < 4; ++d0) o[d0] = f32x16{};
    }
    {
        BrWin br; br.K = PA + CA_KW + g * HD; br.V = PA + CA_VW + g * HD; br.R = R; br.tw = tw;
        br.kb0 = (t0 - 511 > 0) ? ((t0 - 511) >> 6) : 0; br.nt = qb - br.kb0 + 1;
        float m2 = mb_win, l = 0.f;
        run_pass<3>(br, lds, tz, qr, m2, l, 0.f, o);
        scale_rows(o, (l > 0.f) ? GATE(2) / l : 0.f, ws, lane);
        o_addload(o, oacc, lane);
    }
    store_o(o, lane, [&](int row) { return MIX + (size_t)(tw + (row >> 2)) * DM + (4 * g + (row & 3)) * HD; });
#undef GATE
}
__device__ __forceinline__ void mem_item(Frame& F, const bf16* P, int ldp, int qcol, const float* qg, int layer, int hm, int qb, float mb_mem) {
    using namespace at;
    LAS unsigned char* lds = F.lds + RING_OFF;
    const bf16* MKV = WSP(bf16, WS_MKV); bf16* MIX = WSP(bf16, WS_MIX);
    int tz = F.tid; asm volatile("" : "+v"(tz));
    const int lane = tz & 63, w = F.wave, r32 = lane & 31, hi = lane >> 5;
    const int tw = 256 * qb + 32 * w, t = tw + r32;
    bf16x8 qr[8];
    {
        const bf16* qrow = P + (size_t)t * ldp + qcol + hm * HD;
        float qf[64]; float ss = 0.f;
#pragma unroll
        for (int d0 = 0; d0 < 8; ++d0) { const v4u wv = *(const v4u*)(qrow + d0 * 16 + hi * 8); unpack8(wv, qf + 8 * d0); }
#pragma unroll
        for (int i = 0; i < 64; ++i) ss += qf[i] * qf[i];
        ss = xhalf_sum(ss);
        const float rs = 1.0f / sqrtf(ss * (1.f / HD) + EPS);
#pragma unroll
        for (int d0 = 0; d0 < 8; ++d0) { const float* gp = qg + d0 * 16 + hi * 8;
            v4u wv; wv.x = cvtpk(qf[8 * d0] * rs * gp[0], qf[8 * d0 + 1] * rs * gp[1]); wv.y = cvtpk(qf[8 * d0 + 2] * rs * gp[2], qf[8 * d0 + 3] * rs * gp[3]);
            wv.z = cvtpk(qf[8 * d0 + 4] * rs * gp[4], qf[8 * d0 + 5] * rs * gp[5]); wv.w = cvtpk(qf[8 * d0 + 6] * rs * gp[6], qf[8 * d0 + 7] * rs * gp[7]);
            qr[d0] = *reinterpret_cast<const bf16x8*>(&wv); }
    }
    f32x16 o[4] = {};
    BrMem br; br.nt = 4; br.K = MKV + layer * 1024 + hm * HD; br.V = br.K + 512;
    float m2 = mb_mem, l = 0.f;
    run_pass<3>(br, lds, tz, qr, m2, l, 0.f, o);
    scale_rows(o, 1.0f / l, (LAS float*)(lds + L_WS + w * 256), lane);
    store_o(o, lane, [&](int row) { return MIX + (size_t)(tw + row) * DM + NMIX * HD + hm * HD; });
}
__device__ __forceinline__ void p3_attn(Frame& F) {
    const int ln = lane_of(F);
    using at::gain_absmax; using at::C2;
    const float gq = gain_absmax(F.in[8], ln);
    const float mb_slc = 128.f * C2 * 1.01f * gq * gain_absmax(F.in[9] + HD, ln), mb_win = 128.f * C2 * 1.01f * gq * gain_absmax(F.in[9] + 2 * HD, ln);
    const float mb_cmp = 128.f * C2 * 1.01f * gq * gain_absmax(F.in[9], ln);
    const float mb_mem = 128.f * C2 * 1.01f * gain_absmax(F.in[14], ln) * gain_absmax(F.in[14] + HD, ln);
    if (F.G == 256) {
        if (F.vcu < 192) { for (int it = F.vcu; it < 384; it += 192) { const int g = it % 3, qb = 127 - it / 3; nsa_item(F, g, qb, mb_cmp, mb_slc, mb_win); __syncthreads(); } }
        else { for (int j = F.vcu - 192; j < 128; j += 64) { mem_item(F, WSP(bf16, WS_PA), NA, CA_QM, F.in[14], 0, j & 3, j >> 2, mb_mem); __syncthreads(); } }
        return;
    }
    for (int it = F.vcu; it < 384 + 128; it += F.G) {
        if (it < 384) { const int g = it % 3, qb = 127 - it / 3; nsa_item(F, g, qb, mb_cmp, mb_slc, mb_win); }
        else { const int j = it - 384; mem_item(F, WSP(bf16, WS_PA), NA, CA_QM, F.in[14], 0, j & 3, j >> 2, mb_mem); }
        __syncthreads();
    }
}

__device__ __forceinline__ void stick_tile(at::f32x16& p0, at::f32x16& p1, int k0, int t, int hi, float& R2) {
    using namespace at;
    float L0[16], L1[16];
    const float NEG = -__builtin_inff();
#pragma unroll
    for (int r = 0; r < 16; ++r) {
        const int kk = k0 + crow(r, hi);
        { const float z = p0[r] * C2; const float sp = fmaxf(z, 0.f) + __builtin_amdgcn_logf(1.0f + __builtin_amdgcn_exp2f(-fabsf(z))); const bool v = kk < t; L0[r] = v ? -sp : 0.f; p0[r] = v ? z - sp : NEG; }
        { const float z = p1[r] * C2; const float sp = fmaxf(z, 0.f) + __builtin_amdgcn_logf(1.0f + __builtin_amdgcn_exp2f(-fabsf(z))); const bool v = kk + 32 < t; L1[r] = v ? -sp : 0.f; p1[r] = v ? z - sp : NEG; }
    }
    float ct[8], pt[8];
#pragma unroll
    for (int c = 0; c < 4; ++c) { ct[c] = (L0[4 * c] + L0[4 * c + 1]) + (L0[4 * c + 2] + L0[4 * c + 3]); ct[4 + c] = (L1[4 * c] + L1[4 * c + 1]) + (L1[4 * c + 2] + L1[4 * c + 3]); }
#pragma unroll
    for (int c = 0; c < 8; ++c) { auto rr = __builtin_amdgcn_permlane32_swap(__float_as_uint(ct[c]), __float_as_uint(ct[c]), false, false); pt[c] = __uint_as_float(hi ? rr[0] : rr[1]); }
    float E[8]; float run = 0.f;
#pragma unroll
    for (int c = 7; c >= 0; --c) { E[c] = run + (hi == 0 ? pt[c] : 0.f); run += ct[c] + pt[c]; }
#pragma unroll
    for (int c = 0; c < 4; ++c) {
        { const float a3 = R2 + E[c], a2 = a3 + L0[4 * c + 3], a1 = a2 + L0[4 * c + 2], a0 = a1 + L0[4 * c + 1];
          p0[4 * c + 3] = __builtin_amdgcn_exp2f(p0[4 * c + 3] + a3); p0[4 * c + 2] = __builtin_amdgcn_exp2f(p0[4 * c + 2] + a2); p0[4 * c + 1] = __builtin_amdgcn_exp2f(p0[4 * c + 1] + a1); p0[4 * c] = __builtin_amdgcn_exp2f(p0[4 * c] + a0); }
        { const float a3 = R2 + E[4 + c], a2 = a3 + L1[4 * c + 3], a1 = a2 + L1[4 * c + 2], a0 = a1 + L1[4 * c + 1];
          p1[4 * c + 3] = __builtin_amdgcn_exp2f(p1[4 * c + 3] + a3); p1[4 * c + 2] = __builtin_amdgcn_exp2f(p1[4 * c + 2] + a2); p1[4 * c + 1] = __builtin_amdgcn_exp2f(p1[4 * c + 1] + a1); p1[4 * c] = __builtin_amdgcn_exp2f(p1[4 * c] + a0); }
    }
    R2 += run;
}
template <int KB>
__device__ __forceinline__ bool stick_step(int kb, int kb_w, at::Stg& S, LAS unsigned char* lds, int tid, const bf16* Kh, const bf16* Vh, const at::bf16x8* qr, at::f32x16* o, int tw, float& R2, LAS int* DONE) {
    using namespace at;
    int tz = tid; asm volatile("" : "+v"(tz));
    const int lane = tz & 63, w = __builtin_amdgcn_readfirstlane(tz >> 6), r32 = lane & 31, hi = lane >> 5, sr = tz >> 4, sc = (tz & 15) * 8;
    const int vb0 = (int)(uintptr_t)(lds + L_V) + v_rd_base(lane);
    int t = tw + r32; asm volatile("" : "+v"(t));
    const float THR2 = -100.f;
    const bool more = kb > 0;
    const bf16* Kn = Kh + (size_t)(more ? kb - 1 : kb) * 64 * NB; const bf16* Vn = Vh + (size_t)(more ? kb - 1 : kb) * 64 * NB;
    if (more) stg_load(S, Kn, NB, sr, sc);
    SBAR();
    bool wdone = false, kdone = false;
    if (kb <= kb_w) {
        if (__any(R2 > THR2)) {
            f32x16 p0, p1; qkt<KB>(p0, p1, lds, r32, hi, qr);
            SBAR();
            stick_tile(p0, p1, 64 * kb, t, hi, R2);
            SBAR();
            if (more) { stg_write_k<KB ^ 1>(S, lds, sr, sc); SBAR(); stg_load(S, Vn, NB, sr, sc); SBAR(); } kdone = true;
            bf16x8 pa0, pa1, pa2, pa3; pack_p(p0, p1, pa0, pa1, pa2, pa3);
            SBAR();
            pv_tile<KB>(o, vb0, pa0, pa1, pa2, pa3);
            SBAR();
        }
        wdone = !__any(R2 > THR2);
    }
    if (lane == 0) DONE[(kb & 1) * 8 + w] = wdone ? 1 : 0;
    if (more) { if (!kdone) { stg_write_k<KB ^ 1>(S, lds, sr, sc); SBAR(); stg_load(S, Vn, NB, sr, sc); SBAR(); } stg_write_v<KB ^ 1>(S, lds, sr, sc); }
    __syncthreads();
    int alld = 1;
#pragma unroll
    for (int ww = 0; ww < 8; ++ww) alld &= DONE[(kb & 1) * 8 + ww];
    return more && !alld;
}
__device__ __forceinline__ void stick_item(Frame& F, int h, int qb) {
    using namespace at;
    LAS unsigned char* lds = F.lds + RING_OFF;
    const bf16* PB = WSP(bf16, WS_PB); bf16* MIX = WSP(bf16, WS_MIX);
    int tid = F.tid; asm volatile("" : "+v"(tid));
    const int lane = tid & 63, w = F.wave, r32 = lane & 31, hi = lane >> 5, sr = tid >> 4, sc = (tid & 15) * 8;
    const int q0 = 256 * qb, tw = q0 + 32 * w, t = tw + r32;
    LAS int* DONE = (LAS int*)(lds + L_DONE);
    bf16x8 qr[8]; load_q(qr, PB + (size_t)t * NB + CB_Q + h * HD, hi);
    f32x16 o[4] = {};
    const bf16* Kh = PB + CB_K + h * HD; const bf16* Vh = PB + CB_V + h * HD;
    const int kb_hi = q0 / 64 + 3, kb_w = q0 / 64 + (w >> 1);
    float R2 = 0.f;
    Stg S;
    stg_load(S, Kh + (size_t)kb_hi * 64 * NB, NB, sr, sc); stg_write_k<0>(S, lds, sr, sc);
    stg_load(S, Vh + (size_t)kb_hi * 64 * NB, NB, sr, sc); stg_write_v<0>(S, lds, sr, sc);
    __syncthreads();
    for (int kb = kb_hi; ; kb -= 2) {
        if (!stick_step<0>(kb, kb_w, S, lds, tid, Kh, Vh, qr, o, tw, R2, DONE)) break;
        if (!stick_step<1>(kb - 1, kb_w, S, lds, tid, Kh, Vh, qr, o, tw, R2, DONE)) break;
    }
    store_o(o, lane, [&](int row) { return MIX + (size_t)(tw + row) * DM + h * HD; });
}
__device__ __forceinline__ void p10_attn(Frame& F) {
    const int ln = lane_of(F);
    const float mb_mem = 128.f * at::C2 * 1.01f * at::gain_absmax(F.in[14] + 2 * HD, ln) * at::gain_absmax(F.in[14] + 3 * HD, ln);
    if (F.G == 256) {
        if (F.vcu < 192) { for (int it = F.vcu; it < 384; it += 192) { const int h = it % 12, qb = 31 - it / 12; stick_item(F, h, qb); __syncthreads(); } }
        else { for (int j = F.vcu - 192; j < 128; j += 64) { mem_item(F, WSP(bf16, WS_PB), NB, CB_QM, F.in[14] + 2 * HD, 1, j & 3, j >> 2, mb_mem); __syncthreads(); } }
        return;
    }
    for (int it = F.vcu; it < 384 + 128; it += F.G) {
        if (it < 384) { const int h = it % 12, qb = 31 - it / 12; stick_item(F, h, qb); }
        else { const int j = it - 384; mem_item(F, WSP(bf16, WS_PB), NB, CB_QM, F.in[14] + 2 * HD, 1, j & 3, j >> 2, mb_mem); }
        __syncthreads();
    }
}

constexpr int N_PHASES = 17;
#ifndef MK_FILL_P1
#define MK_FILL_P1 0
#endif
#ifndef MK_FILL_P2
#define MK_FILL_P2 0
#endif
#ifndef MK_DBG
#define MK_DBG 0
#endif
#ifndef MK_PROBE_SUB
#define MK_PROBE_SUB 0
#endif
#ifndef MK_PROBE_MASK
#define MK_PROBE_MASK 0
#endif
#ifndef MK_NAIVE_P3
#define MK_NAIVE_P3 0
#endif
#ifndef MK_NAIVE_P10
#define MK_NAIVE_P10 0
#endif
struct Args { const float* in[22]; float* out; unsigned char* ws; int ph_lo, ph_hi, use_bar, pad; };
__global__ void __launch_bounds__(NWAVES * 64, 2) mk_fwd(Args args) {
    extern __shared__ __attribute__((aligned(16))) unsigned char lds[];
    Frame F;
    F.lds = (LAS unsigned char*)lds;
    F.MISC = (volatile LAS unsigned*)(F.lds + MISC_OFF);
    F.tid = threadIdx.x;  F.wave = __builtin_amdgcn_readfirstlane(F.tid >> 6);
    F.G = gridDim.x; { const int bx = blockIdx.x; F.vcu = (F.G % 8 == 0) ? (bx % 8) * (F.G / 8) + bx / 8 : bx; }
    F.ws = args.ws; F.ctl = (gu32*)(args.ws + WS_CTL); F.out = args.out;
#pragma unroll
    for (int i = 0; i < 22; ++i) F.in[i] = args.in[i];
    for (int u = F.tid; u < (LDS_BYTES - LDSCTL_OFF) / 4; u += NWAVES * 64) ((LAS unsigned*)(F.lds + LDSCTL_OFF))[u] = 0u;
    __syncthreads();
    XcdBarrier bar; bar.bar = (unsigned*)(F.ctl + CW_BAR); bar.x = 0; bar.st = nullptr;
    if (args.use_bar) bar = xcd_barrier_post((unsigned*)(F.ctl + CW_BAR), F.MISC + 8);
#if MK_DBG >= 100
    unsigned long long dbg_t = wall_clock64(); int dbg_n = 0;
#define GRID_BAR() do { if (args.use_bar) xcd_barrier(bar); F.tid = threadIdx.x; asm volatile("" : "+v"(F.tid)); \
        { const unsigned long long now_ = wall_clock64(); if (dbg_n == (MK_DBG % 100) && blockIdx.x == 0 && F.tid == 0) ((float*)F.ctl)[CW_DBG] = (float)(now_ - dbg_t) * (MK_DBG >= 300 ? 0.00125f : MK_DBG >= 200 ? 0.02f : 0.005f); dbg_t = now_; ++dbg_n; } } while (0)
#else
#define GRID_BAR() do { if (args.use_bar) xcd_barrier(bar); F.tid = threadIdx.x; asm volatile("" : "+v"(F.tid)); } while (0)
#endif
    const int lo = args.ph_lo, hi = args.ph_hi;
#ifdef MK_ONLY_PHASE
#define IN(k) ((k) == MK_ONLY_PHASE && lo <= (k) && (k) < hi)
#else
#define IN(k) (lo <= (k) && (k) < hi)
#endif
#define BOTH(k) (IN(k) && IN((k) + 1))
    typedef pg8::StaticOrder SO;

    if (IN(0)) { p0_prologue(F); if (!args.use_bar) conv_list(F, CV_DEFER0 + F.vcu * NWAVES + F.wave, F.G * NWAVES, CV_TOTAL); if (BOTH(0)) GRID_BAR(); }
    if (IN(1)) {
        const int Ge = (args.use_bar && F.G >= 128) ? F.G - 56 : F.G;
        if ((int)blockIdx.x < Ge) {
        { pg8::Gemm g{WSP(bf16, WS_XN), WSP(bf16, WS_WT_INA), DM, DM / 64}; SO S; S.init(T / 256, NA / 256, Ge, (int)blockIdx.x);
          pg8::EpiBf16 E{WSP(bf16, WS_PA), NA, nullptr}; pg8::gemm_phase<pg8::EpiBf16, SO, true, true>(F.lds + RING_OFF, g, S, E); }
        { pg8::Gemm g{WSP(bf16, WS_MEMN), WSP(bf16, WS_WT_MEM), DM, DM / 64}; SO S; S.init(1, 8, Ge, (int)(Ge - 1 - blockIdx.x));
          pg8::EpiBf16 E{WSP(bf16, WS_MKV), 2048, nullptr}; pg8::gemm_phase<pg8::EpiBf16, SO, true, true>(F.lds + RING_OFF, g, S, E); }
        }
        if (args.use_bar) idle_fill(F, 1);
        if (BOTH(1)) GRID_BAR();
    }
    if (IN(2)) { if (args.pad != 2) p2_compress(F); if (args.pad != 1) p2_qknorm(F); if (args.use_bar && MK_FILL_P2) idle_fill(F, 2); if (BOTH(2)) GRID_BAR(); }
#if MK_NAIVE_P3
    if (IN(3)) { p3_nsa_naive(F); mem_attn_naive(F, WSP(bf16, WS_PA), NA, CA_QM, F.in[14], 0); if (BOTH(3)) GRID_BAR(); }
#else
#if MK_DBG == 4 || (MK_DBG >= 6 && MK_DBG <= 8)
    const unsigned long long t3 = wall_clock64();
#endif
    if (IN(3)) { p3_attn(F);
#if MK_DBG >= 6 && MK_DBG <= 8
        if (F.vcu == MK_DBG - 6 && F.tid == 0) ((float*)F.ctl)[CW_DBG] = (float)(wall_clock64() - t3) * 0.01f;
#endif
        if (args.use_bar) idle_fill(F, 3); if (BOTH(3)) GRID_BAR();
#if MK_DBG == 4
        if (blockIdx.x == 0 && F.tid == 0) ((float*)F.ctl)[CW_DBG] = (float)(wall_clock64() - t3) * 0.01f;
#endif
    }
#endif
    if (IN(4)) { pg8::Gemm g{WSP(bf16, WS_MIX), WSP(bf16, WS_WT_OUT), DM, DM / 64}; SO S; S.init(T / 256, DM / 256, F.G, (int)blockIdx.x);
        pg8::EpiResNorm E{F.in[0], WSP(float, WS_X1), WSP(bf16, WS_XN), (unsigned long long*)(F.ctl + CW_SS), DM}; pg8::gemm_phase<pg8::EpiResNorm, SO, true, true>(F.lds + RING_OFF, g, S, E);
        if (args.use_bar) conv_drain(F, CV_INB); if (BOTH(4)) GRID_BAR(); }
#if MK_DBG == 3
    const unsigned long long t6 = wall_clock64();
#endif
    if (IN(6)) { const int Ge = (args.use_bar && F.G >= 64) ? F.G - 32 : F.G;
        if ((int)blockIdx.x < Ge) { pg8::Gemm g{WSP(bf16, WS_XN), WSP(bf16, WS_WT_FGU), DM, DM / 64}; SO S; S.init(T / 256, 2 * FF / 256, Ge, (int)blockIdx.x);
            pg8::EpiSwiglu E{WSP(bf16, WS_HFF), FF, (const unsigned long long*)(F.ctl + CW_SS)}; pg8::gemm_phase<pg8::EpiSwiglu, SO, true, true>(F.lds + RING_OFF, g, S, E); }
        if (args.use_bar) idle_fill(F, 6);
        if (BOTH(6)) GRID_BAR();
#if MK_DBG == 3
        if (blockIdx.x == 0 && F.tid == 0) ((float*)F.ctl)[CW_DBG] = (float)(wall_clock64() - t6) * 0.005f;
#endif
    }
    if (IN(7)) { pg8::Gemm g{WSP(bf16, WS_HFF), WSP(bf16, WS_WT_FDN), FF, FF / 64}; SO S; S.init(T / 256, DM / 256, F.G, (int)blockIdx.x);
        pg8::EpiResNorm E{WSP(float, WS_X1), WSP(float, WS_X2), WSP(bf16, WS_XN), (unsigned long long*)(F.ctl + CW_SS) + T, DM}; pg8::gemm_phase<pg8::EpiResNorm, SO, true, true>(F.lds + RING_OFF, g, S, E);
        if (args.use_bar) conv_drain(F, CV_MGU); if (BOTH(7)) GRID_BAR(); }
    if (IN(9)) { pg8::Gemm g{WSP(bf16, WS_XN), WSP(bf16, WS_WT_INB), DM, DM / 64}; SO S; S.init(T / 256, NB / 256, F.G, (int)blockIdx.x);
        pg8::EpiBf16 E{WSP(bf16, WS_PB), NB, (const unsigned long long*)(F.ctl + CW_SS) + T}; pg8::gemm_phase<pg8::EpiBf16, SO, true, true>(F.lds + RING_OFF, g, S, E); if (args.use_bar) idle_fill(F, 9); if (BOTH(9)) GRID_BAR(); }
#if MK_NAIVE_P10
    if (IN(10)) { stick_naive(F); mem_attn_naive(F, WSP(bf16, WS_PB), NB, CB_QM, F.in[14] + 2 * HD, 1); if (BOTH(10)) GRID_BAR(); }
#else
    if (IN(10)) { p10_attn(F); if (args.use_bar) idle_fill(F, 10); if (BOTH(10)) GRID_BAR(); }
#endif
    if (IN(11)) { pg8::Gemm g{WSP(bf16, WS_MIX), WSP(bf16, WS_WT_OUT) + (size_t)DM * DM, DM, DM / 64}; SO S; S.init(T / 256, DM / 256, F.G, (int)blockIdx.x);
        pg8::EpiResF32 E{WSP(float, WS_X2), WSP(float, WS_X3), DM}; pg8::gemm_phase<pg8::EpiResF32, SO, true, true>(F.lds + RING_OFF, g, S, E); if (BOTH(11)) GRID_BAR(); }
    if (IN(12)) { p12_router(F); if (BOTH(12)) GRID_BAR(); }
    if (IN(13)) { p13_assign(F);
#if MK_DBG == 1
        const unsigned long long t0 = wall_clock64();
#endif
#if MK_DBG == 2
        if (blockIdx.x == 0 && F.tid == 0) { const unsigned c = __hip_atomic_load((unsigned*)(F.ctl + CW_CVNEXT), __ATOMIC_RELAXED, __HIP_MEMORY_SCOPE_AGENT); ((float*)F.ctl)[CW_DBG] = 500.f * (float)c / (float)(CV_TOTAL - CV_DEFER0); }
#endif
        if (args.use_bar) conv_drain(F, CV_MDN);
#if MK_DBG == 1
        if (blockIdx.x == 0 && F.tid == 0) ((float*)F.ctl)[CW_DBG] = (float)(wall_clock64() - t0) * 0.01f;
#endif
        if (BOTH(13)) GRID_BAR(); }
    if (IN(14)) { const int* TILE = (const int*)(F.ws + WS_ROUTE + RT_TILE); const int ntl = TILE[0];
        LAS int* TE = (LAS int*)(F.lds + LDSCTL_OFF + 1024);
        if (F.tid < MOE_MAXT) TE[F.tid] = TILE[16 + F.tid];
        __syncthreads();
        int Ge = F.G;
        if (args.use_bar && F.G >= 64) { const int U = ntl * (2 * FF / 256); if ((U + F.G - 9) / (F.G - 8) == (U + F.G - 1) / F.G) Ge = F.G - 8; }
        if ((int)blockIdx.x < Ge) { pg8::Gemm g{WSP(bf16, WS_AMOE), WSP(bf16, WS_WT_MGU), DM, DM / 64}; pg8::MoeOrder S; S.init(ntl, 2 * FF / 256, Ge, (int)blockIdx.x); S.tile_e = TE; S.estride = (size_t)2 * FF * DM * 2;
            pg8::EpiSwiglu E{WSP(bf16, WS_HMOE), FF, nullptr}; pg8::gemm_phase<pg8::EpiSwiglu, pg8::MoeOrder, true, true>(F.lds + RING_OFF, g, S, E); }
#if MK_DBG == 5
        const unsigned long long t14 = wall_clock64();
#endif
        if (args.use_bar) { idle_fill(F, 14); conv_drain(F, CV_TOTAL); }
#if MK_DBG == 5
        if (blockIdx.x == 0 && F.tid == 0) ((float*)F.ctl)[CW_DBG] = (float)(wall_clock64() - t14) * 0.01f;
#endif
        if (BOTH(14)) GRID_BAR(); }
    if (IN(15)) { const int* TILE = (const int*)(F.ws + WS_ROUTE + RT_TILE); const int ntl = TILE[0];
        LAS int* TE = (LAS int*)(F.lds + LDSCTL_OFF + 1024);
        if (F.tid < MOE_MAXT) TE[F.tid] = TILE[16 + F.tid];
        __syncthreads();
        const int U = ntl * (DM / 256), full = (U / F.G) * F.G, tail = U - full;
        { pg8::Gemm g{WSP(bf16, WS_HMOE), WSP(bf16, WS_WT_MDN), FF, FF / 64}; pg8::MoeOrder S; S.init(ntl, DM / 256, F.G, (int)blockIdx.x); S.nwg = full; S.tile_e = TE; S.estride = (size_t)DM * FF * 2;
          pg8::EpiBf16 E{WSP(bf16, WS_YMOE), DM, nullptr}; pg8::gemm_phase<pg8::EpiBf16, pg8::MoeOrder, true, true>(F.lds + RING_OFF, g, S, E); }
        if (tail > 0) { const int nsp = moe_nsplit(tail, F.G);
          const int sp = (int)blockIdx.x % nsp, q = (FF / 128) / nsp, r = (FF / 128) % nsp, len = q + (sp < r ? 1 : 0), st = sp * q + (sp < r ? sp : r);
          pg8::Gemm g{WSP(bf16, WS_HMOE), WSP(bf16, WS_WT_MDN), FF, 2 * len}; pg8::MoeSplitOrder S; S.nM = ntl; S.nN = DM / 256; S.nwg0 = full; S.ntail = tail; S.nsp = nsp; S.G = F.G; S.c = (int)blockIdx.x; S.koff = 2 * st; S.tile_e = TE; S.estride = (size_t)DM * FF * 2;
          pg8::EpiPartF32 E{WSP(float, WS_SLAB), (int*)(F.ctl + CW_TMAP)}; pg8::gemm_phase<pg8::EpiPartF32, pg8::MoeSplitOrder, true, true>(F.lds + RING_OFF, g, S, E); }
        if (BOTH(15)) GRID_BAR(); }
    if (IN(16)) { p16_combine(F, MK_DBG ? 1.0f + 1e-4f * ((const float*)F.ctl)[CW_DBG] : 1.0f); }
#undef IN
#undef BOTH
}

#ifndef MK_ONE_LAUNCH
#define MK_ONE_LAUNCH 1
#endif
extern "C" void kernel_launch(void* const* d_in, const int* in_sizes, int n_in, void* d_out, int out_size, void* d_ws, size_t ws_size, hipStream_t stream) {
    static int grid = 0;
    if (grid == 0) {
        if (n_in != 22 || in_sizes[0] != T * DM || out_size != T * DM || ws_size < WS_END) { fprintf(stderr, "kernel_launch: unexpected shapes (n_in %d, in0 %d, out %d, ws %zu < %zu)\n", n_in, n_in > 0 ? in_sizes[0] : -1, out_size, ws_size, (size_t)WS_END); grid = -1; return; }
        int dev = 0, cus = 0, per_cu = 0;
        if (hipGetDevice(&dev) != hipSuccess || hipDeviceGetAttribute(&cus, hipDeviceAttributeMultiprocessorCount, dev) != hipSuccess) { grid = -1; return; }
        if (hipFuncSetAttribute((const void*)mk_fwd, hipFuncAttributeMaxDynamicSharedMemorySize, LDS_BYTES) != hipSuccess) { fprintf(stderr, "kernel_launch: hipFuncSetAttribute failed\n"); grid = -1; return; }
        if (hipOccupancyMaxActiveBlocksPerMultiprocessor(&per_cu, (const void*)mk_fwd, NWAVES * 64, LDS_BYTES) != hipSuccess || per_cu < 1) { fprintf(stderr, "kernel_launch: occupancy query says %d blocks per CU\n", per_cu); }
        (void)hipGetLastError();
        grid = cus;
    }
    if (grid < 0) return;
    if (hipMemsetAsync((char*)d_ws + WS_CTL, 0, CTL_ZERO_BYTES, stream) != hipSuccess) return;
    Args a{};
    for (int i = 0; i < 22; ++i) a.in[i] = (const float*)d_in[i];
    a.out = (float*)d_out; a.ws = (unsigned char*)d_ws; a.pad = 0;
#if MK_ONE_LAUNCH
    a.ph_lo = 0; a.ph_hi = N_PHASES; a.use_bar = 1;
    hipLaunchKernelGGL(mk_fwd, dim3(grid), dim3(NWAVES * 64), LDS_BYTES, stream, a);
    for (int p = 0; p < N_PHASES; ++p) if ((MK_PROBE_MASK >> p) & 1) { a.ph_lo = p; a.ph_hi = p + 1; a.use_bar = 0; a.pad = MK_PROBE_SUB;
        hipLaunchKernelGGL(mk_fwd, dim3(grid), dim3(NWAVES * 64), LDS_BYTES, stream, a); }
#else
    for (int p = 0; p < N_PHASES; ++p) { a.ph_lo = p; a.ph_hi = p + 1; a.use_bar = 0;
        hipLaunchKernelGGL(mk_fwd, dim3(grid), dim3(NWAVES * 64), LDS_BYTES, stream, a); }
#endif
}
```

```cpp
#include <hip/hip_runtime.h>
#include <cstdio>
#include <cstdint>

namespace pg8 {
#define PG8_LAS __attribute__((address_space(3)))
typedef unsigned short bf16_t;
typedef short bf16x8 __attribute__((ext_vector_type(8)));
typedef float f32x4 __attribute__((ext_vector_type(4)));
typedef unsigned u32x4 __attribute__((ext_vector_type(4)));
constexpr int BM = 256, BK = 64, HALF = 128, HTB = HALF * BK * 2  , STAGE_BYTES = 8 * HTB, NXCD = 8, WGM = 8;

__host__ __device__ __forceinline__ int lds_byte(int r, int c) { const int st = (r >> 4) * 2 + (c >> 5), rr = r & 15, cc = c & 31, ob = rr * 64 + cc * 2; return st * 1024 + (ob ^ (((ob >> 9) & 1) << 5)); }
__host__ __device__ __forceinline__ void stage_rc(int b, int& R, int& C) { const int st = b / 1024, sb = b % 1024, swz = sb ^ (((sb >> 9) & 1) << 5); R = (st >> 1) * 16 + swz / 64; C = (st & 1) * 32 + (swz % 64) / 2; }
__host__ __device__ __forceinline__ int perm32(int rho) { const int n = rho >> 4, i = rho & 15; return 8 * (i >> 2) + 4 * n + (i & 3); }

struct Unit { int pm, pn, ks, sl; };
struct Gemm { const bf16_t* A; const bf16_t* Bt; int K, kt; };

struct StaticOrder {
    int nM, nN, nwg, G, c;
    __device__ void init(int nM_, int nN_, int G_, int c_) { nM = nM_; nN = nN_; nwg = nM * nN; G = G_; c = c_; }
    __device__ bool next(int i, Unit& u) const {
        const long L = (long)i * G + c; if (L >= nwg) return false;
        int wgid = (int)L; { const int q = nwg / NXCD, r = nwg % NXCD, xcd = wgid % NXCD, off = wgid / NXCD; wgid = (xcd < r ? xcd * (q + 1) : r * (q + 1) + (xcd - r) * q) + off; }
        const int nig = WGM * nN, gid = wgid / nig, fm = gid * WGM, gsz = (nM - fm) < WGM ? (nM - fm) : WGM;
        u.pm = fm + ((wgid % nig) % gsz); u.pn = (wgid % nig) / gsz; u.ks = 0; u.sl = 0; return true;
    }
    __device__ __forceinline__ const char* a_base(const Gemm& g, const Unit& u) const { return (const char*)g.A + (size_t)u.pm * ((size_t)BM * g.K * 2); }
    __device__ __forceinline__ const char* b_base(const Gemm& g, const Unit& u) const { return (const char*)g.Bt + (size_t)u.pn * ((size_t)BM * g.K * 2); }
    __device__ __forceinline__ void a_ready(const Unit&) const {}
    __device__ __forceinline__ void done(const Unit&) const {}
};
struct MoeOrder : StaticOrder {
    const PG8_LAS int* tile_e; size_t estride;
    __device__ __forceinline__ const char* b_base(const Gemm& g, const Unit& u) const { return (const char*)g.Bt + (size_t)tile_e[u.pm] * estride + (size_t)u.pn * ((size_t)BM * g.K * 2); }
};
struct MoeSplitOrder {
    int nM, nN, nwg0, ntail, nsp, G, c, koff; const PG8_LAS int* tile_e; size_t estride;
    __device__ bool next(int i, Unit& u) const {
        const long L = (long)i * G + c; if (L >= (long)ntail * nsp) return false;
        const int j = (int)L / nsp, wgid = nwg0 + j;
        const int nig = WGM * nN, gid = wgid / nig, fm = gid * WGM, gsz = (nM - fm) < WGM ? (nM - fm) : WGM;
        u.pm = fm + ((wgid % nig) % gsz); u.pn = (wgid % nig) / gsz; u.ks = (int)L % nsp; u.sl = (int)L; return true;
    }
    __device__ __forceinline__ const char* a_base(const Gemm& g, const Unit& u) const { return (const char*)g.A + (size_t)u.pm * ((size_t)BM * g.K * 2) + (size_t)koff * (BK * 2); }
    __device__ __forceinline__ const char* b_base(const Gemm& g, const Unit& u) const { return (const char*)g.Bt + (size_t)tile_e[u.pm] * estride + (size_t)u.pn * ((size_t)BM * g.K * 2) + (size_t)koff * (BK * 2); }
    __device__ __forceinline__ void a_ready(const Unit&) const {}
    __device__ __forceinline__ void done(const Unit&) const {}
};

__device__ __forceinline__ unsigned cvt_pk_bf16(float lo, float hi) { unsigned r; asm volatile("v_cvt_pk_bf16_f32 %0, %1, %2" : "=v"(r) : "v"(lo), "v"(hi)); return r; }

struct EpiBf16 {
    static constexpr bool PERM = true, AFTER_DRAIN = false;
    bf16_t* O; int ldc; const unsigned long long* ss;
    __device__ __forceinline__ void operator()(const f32x4 (&acc)[2][2][4][2], const Unit& u, int wr, int wc, int fr, int fq) const {
        const int row0 = u.pm * BM + wr * 64 + fr, col0 = u.pn * BM + wc * 32 + 8 * fq;
#pragma unroll
        for (int ai = 0; ai < 2; ++ai)
#pragma unroll
            for (int m = 0; m < 4; ++m) { bf16_t* rowp = O + (size_t)(row0 + ai * HALF + m * 16) * ldc + col0;
                const float rs = ss ? __builtin_amdgcn_rsqf((float)ss[row0 + ai * HALF + m * 16] * (1.0f / (2048.0f * 16777216.0f)) + 1e-6f) : 1.0f;
#pragma unroll
                for (int bj = 0; bj < 2; ++bj) { const f32x4 v0 = acc[ai][bj][m][0] * rs, v1 = acc[ai][bj][m][1] * rs;
                    u32x4 w; w.x = cvt_pk_bf16(v0[0], v0[1]); w.y = cvt_pk_bf16(v0[2], v0[3]); w.z = cvt_pk_bf16(v1[0], v1[1]); w.w = cvt_pk_bf16(v1[2], v1[3]);
                    *(u32x4*)(rowp + bj * HALF) = w; } }
    }
};
struct EpiSwiglu {
    static constexpr bool PERM = true, AFTER_DRAIN = false;
    bf16_t* O; int ldc; const unsigned long long* ss;
    __device__ __forceinline__ void operator()(const f32x4 (&acc)[2][2][4][2], const Unit& u, int wr, int wc, int fr, int fq) const {
        const int row0 = u.pm * BM + wr * 64 + fr, col0 = u.pn * HALF + wc * 32 + 8 * fq;
#pragma unroll
        for (int ai = 0; ai < 2; ++ai)
#pragma unroll
            for (int m = 0; m < 4; ++m) { bf16_t* rowp = O + (size_t)(row0 + ai * HALF + m * 16) * ldc + col0;
                const float rs = ss ? __builtin_amdgcn_rsqf((float)ss[row0 + ai * HALF + m * 16] * (1.0f / (2048.0f * 16777216.0f)) + 1e-6f) : 1.0f;
                float h[8];
#pragma unroll
                for (int n = 0; n < 2; ++n)
#pragma unroll
                    for (int j = 0; j < 4; ++j) { const float gq = acc[ai][0][m][n][j] * rs, uq = acc[ai][1][m][n][j] * rs;
                        const float sg = __builtin_amdgcn_rcpf(1.0f + __builtin_amdgcn_exp2f(-1.4426950408889634f * gq));
                        h[n * 4 + j] = gq * sg * uq; }
                u32x4 w; w.x = cvt_pk_bf16(h[0], h[1]); w.y = cvt_pk_bf16(h[2], h[3]); w.z = cvt_pk_bf16(h[4], h[5]); w.w = cvt_pk_bf16(h[6], h[7]);
                *(u32x4*)rowp = w; }
    }
};
struct EpiPartF32 {
    static constexpr bool PERM = false, AFTER_DRAIN = false;
    float* slab; int* tmap;
    __device__ __forceinline__ void operator()(const f32x4 (&acc)[2][2][4][2], const Unit& u, int wr, int wc, int fr, int fq) const {
        float* base = slab + (size_t)u.sl * (BM * BM) + (size_t)(wr * 64 + fr) * BM + wc * 32 + 4 * fq;
        if (u.ks == 0 && threadIdx.x == 0) tmap[u.pm * 8 + u.pn] = u.sl + 1;
#pragma unroll
        for (int ai = 0; ai < 2; ++ai)
#pragma unroll
            for (int m = 0; m < 4; ++m) { float* rowp = base + (size_t)(ai * HALF + m * 16) * BM;
#pragma unroll
                for (int bj = 0; bj < 2; ++bj)
#pragma unroll
                    for (int n = 0; n < 2; ++n) *(f32x4*)(rowp + bj * HALF + n * 16) = acc[ai][bj][m][n]; }
    }
};
template <bool BB> __device__ __forceinline__ f32x4 res_base(const void* base, size_t idx) {
    if constexpr (BB) { typedef unsigned u32x2_ __attribute__((ext_vector_type(2))); const u32x2_ w = *(const u32x2_*)((const bf16_t*)base + idx);
        return (f32x4){__uint_as_float(w[0] << 16), __uint_as_float(w[0] & 0xffff0000u), __uint_as_float(w[1] << 16), __uint_as_float(w[1] & 0xffff0000u)}; }
    else return *(const f32x4*)((const float*)base + idx);
}
template <bool BB>
struct EpiResNormT {
    static constexpr bool PERM = false, AFTER_DRAIN = false;
    const void* base; bf16_t* xb; unsigned long long* ss; int ldc;
    __device__ __forceinline__ void operator()(const f32x4 (&acc)[2][2][4][2], const Unit& u, int wr, int wc, int fr, int fq) const {
        const int row0 = u.pm * BM + wr * 64 + fr, col0 = u.pn * BM + wc * 32 + 4 * fq;
#pragma unroll
        for (int ai = 0; ai < 2; ++ai)
#pragma unroll
            for (int m = 0; m < 4; ++m) { const size_t off = (size_t)(row0 + ai * HALF + m * 16) * ldc + col0; float sq = 0.f;
#pragma unroll
                for (int bj = 0; bj < 2; ++bj)
#pragma unroll
                    for (int n = 0; n < 2; ++n) { const f32x4 v = res_base<BB>(base, off + bj * HALF + n * 16) + acc[ai][bj][m][n];
                        sq += (v[0] * v[0] + v[1] * v[1]) + (v[2] * v[2] + v[3] * v[3]);
                        unsigned w0 = cvt_pk_bf16(v[0], v[1]), w1 = cvt_pk_bf16(v[2], v[3]); typedef unsigned u32x2 __attribute__((ext_vector_type(2)));
                        *(u32x2*)(xb + off + bj * HALF + n * 16) = (u32x2){w0, w1}; }
                sq += __shfl_xor(sq, 16); sq += __shfl_xor(sq, 32);
                if (fq == 0) atomicAdd(ss + row0 + ai * HALF + m * 16, (unsigned long long)(sq * 16777216.0f + 0.5f)); }
    }
};
struct EpiResF32 {
    static constexpr bool PERM = false, AFTER_DRAIN = false;
    const bf16_t* base; float* out; int ldc;
    __device__ __forceinline__ void operator()(const f32x4 (&acc)[2][2][4][2], const Unit& u, int wr, int wc, int fr, int fq) const {
        const int row0 = u.pm * BM + wr * 64 + fr, col0 = u.pn * BM + wc * 32 + 4 * fq;
#pragma unroll
        for (int ai = 0; ai < 2; ++ai)
#pragma unroll
            for (int m = 0; m < 4; ++m) { const size_t off = (size_t)(row0 + ai * HALF + m * 16) * ldc + col0;
#pragma unroll
                for (int bj = 0; bj < 2; ++bj)
#pragma unroll
                    for (int n = 0; n < 2; ++n) { const f32x4 b = res_base<true>(base, off + bj * HALF + n * 16); *(f32x4*)(out + off + bj * HALF + n * 16) = b + acc[ai][bj][m][n]; } }
    }
};
template <class Epi, class Sched, bool ALIGN_EPI = false, bool SP2 = false>
__device__ __forceinline__ void gemm_phase(PG8_LAS unsigned char* lds, const Gemm g, const Sched& S, const Epi& E) {
    int tid = threadIdx.x; asm volatile("" : "+v"(tid));
    const int wid = __builtin_amdgcn_readfirstlane(tid >> 6), lane = tid & 63, wr = wid >> 2, wc = wid & 3, fr = lane & 15, fq = lane >> 4;
    const int K = g.K, nt = g.kt;
    unsigned voffA[2], voffB[2];
#pragma unroll
    for (int i = 0; i < 2; ++i) { int R, C; stage_rc(tid * 16 + i * 8192, R, C); const int Rb = Epi::PERM ? ((R & ~31) + perm32(R & 31)) : R;
        voffA[i] = (unsigned)(R * K + C) * 2u; voffB[i] = (unsigned)(Rb * K + C) * 2u; }
    const size_t kstep = (size_t)(BK * 2);
    const size_t hstep = (size_t)HALF * K * 2;
    const unsigned ldsw = (unsigned)wid * 1024u;
    const int aoff = lds_byte(wr * 64 + fr, fq * 8), boff = lds_byte(wc * 32 + fr, fq * 8);
#define PG8_SA(b, h) (((b) * 2 + (h)) * HTB)
#define PG8_SB(b, h) ((4 + (b) * 2 + (h)) * HTB)
#define PG8_STAGE(bufoff, gbase, voff) do { _Pragma("unroll") for (int _i = 0; _i < 2; ++_i) \
        __builtin_amdgcn_global_load_lds((const unsigned*)((const char*)(gbase) + (voff)[_i]), (PG8_LAS unsigned*)(lds + (bufoff) + ldsw + _i * 8192), 16, 0, 0); } while (0)
#define PG8_LDA(dst, b, h) do { _Pragma("unroll") for (int m = 0; m < 4; ++m) _Pragma("unroll") for (int k = 0; k < 2; ++k) dst[m][k] = *(const PG8_LAS bf16x8*)(lds + PG8_SA(b, h) + aoff + m * 2048 + k * 1024); } while (0)
#define PG8_LDB(dst, b, h) do { _Pragma("unroll") for (int n = 0; n < 2; ++n) _Pragma("unroll") for (int k = 0; k < 2; ++k) dst[n][k] = *(const PG8_LAS bf16x8*)(lds + PG8_SB(b, h) + boff + n * 2048 + k * 1024); } while (0)
#define PG8_MMA(ai, bj, At, Bt) do { __builtin_amdgcn_s_setprio(1); _Pragma("unroll") for (int m = 0; m < 4; ++m) _Pragma("unroll") for (int n = 0; n < 2; ++n) _Pragma("unroll") for (int k = 0; k < 2; ++k) \
        acc[ai][bj][m][n] = __builtin_amdgcn_mfma_f32_16x16x32_bf16(Bt[n][k], At[m][k], acc[ai][bj][m][n], 0, 0, 0); __builtin_amdgcn_s_setprio(0); } while (0)
#define PG8_WAIT_V(n) asm volatile("s_waitcnt vmcnt(" #n ")" ::: "memory")
#define PG8_WAIT_L(n) asm volatile("s_waitcnt lgkmcnt(" #n ")" ::: "memory")
#define PG8_BAR __builtin_amdgcn_s_barrier()
#define PG8_SCHED __builtin_amdgcn_sched_barrier(0)
    Unit cur, nxt; int ui = 0;
    if (!S.next(0, cur)) return;
    f32x4 acc[2][2][4][2];
#pragma unroll
    for (int a = 0; a < 2; ++a)
#pragma unroll
        for (int b = 0; b < 2; ++b)
#pragma unroll
            for (int m = 0; m < 4; ++m)
#pragma unroll
                for (int n = 0; n < 2; ++n) acc[a][b][m][n] = (f32x4){0.f, 0.f, 0.f, 0.f};
    bf16x8 At[4][2], B0[2][2], B1[2][2];
    const char* cA = S.a_base(g, cur); const char* cB = S.b_base(g, cur);
    S.a_ready(cur);
    if constexpr (SP2) {
        PG8_STAGE(PG8_SB(0, 0), cB, voffB); PG8_STAGE(PG8_SB(0, 1), cB + hstep, voffB); PG8_STAGE(PG8_SA(0, 0), cA, voffA); PG8_STAGE(PG8_SA(0, 1), cA + hstep, voffA);
        if (wr == 1) PG8_BAR;
        PG8_WAIT_V(2); PG8_BAR;
        PG8_STAGE(PG8_SB(1, 0), cB + kstep, voffB); PG8_STAGE(PG8_SA(1, 0), cA + kstep, voffA); PG8_STAGE(PG8_SB(1, 1), cB + hstep + kstep, voffB);
        PG8_WAIT_V(6); PG8_BAR;
    } else {
        PG8_STAGE(PG8_SB(0, 0), cB, voffB); PG8_STAGE(PG8_SA(0, 0), cA, voffA); PG8_STAGE(PG8_SB(0, 1), cB + hstep, voffB); PG8_STAGE(PG8_SA(0, 1), cA + hstep, voffA);
        if (wr == 1) PG8_BAR;
        PG8_WAIT_V(4); PG8_BAR;
        PG8_STAGE(PG8_SB(1, 0), cB + kstep, voffB); PG8_STAGE(PG8_SA(1, 0), cA + kstep, voffA); PG8_STAGE(PG8_SB(1, 1), cB + hstep + kstep, voffB);
        PG8_WAIT_V(6); PG8_BAR;
    }
    for (;;) {
        const bool has_next = S.next(ui + 1, nxt);
        const char* nA = has_next ? S.a_base(g, nxt) : cA; const char* nB = has_next ? S.b_base(g, nxt) : cB;
        for (int t = 0; t < nt; t += 2) {
            const bool last = (t == nt - 2);
            const char* a1 = cA + (size_t)(t + 1) * kstep;
            const char* a2 = last ? nA : cA + (size_t)(t + 2) * kstep; const char* b2 = last ? nB : cB + (size_t)(t + 2) * kstep;
            const char* a3 = a2 + kstep; const char* b3 = b2 + kstep;
            if (last && has_next) S.a_ready(nxt);
            if constexpr (SP2) {
            PG8_LDB(B0, 0, 0); PG8_LDB(B1, 0, 1); PG8_SCHED; PG8_LDA(At, 0, 0); PG8_STAGE(PG8_SA(1, 1), a1 + hstep, voffA);
            PG8_WAIT_V(8); PG8_WAIT_L(0); PG8_BAR; PG8_MMA(0, 0, At, B0); PG8_MMA(0, 1, At, B1); PG8_BAR; PG8_SCHED;
            PG8_LDA(At, 0, 1); PG8_STAGE(PG8_SB(0, 0), b2, voffB); PG8_STAGE(PG8_SB(0, 1), b2 + hstep, voffB); PG8_STAGE(PG8_SA(0, 0), a2, voffA);
            PG8_WAIT_V(8); PG8_WAIT_L(0); PG8_BAR; PG8_MMA(1, 0, At, B0); PG8_MMA(1, 1, At, B1); PG8_BAR; PG8_SCHED;
            PG8_LDB(B0, 1, 0); PG8_LDB(B1, 1, 1); PG8_SCHED; PG8_LDA(At, 1, 0); PG8_STAGE(PG8_SA(0, 1), a2 + hstep, voffA);
            PG8_WAIT_V(8); PG8_WAIT_L(0); PG8_BAR; PG8_MMA(0, 0, At, B0); PG8_MMA(0, 1, At, B1); PG8_BAR; PG8_SCHED;
            PG8_LDA(At, 1, 1); PG8_STAGE(PG8_SB(1, 0), b3, voffB); PG8_STAGE(PG8_SB(1, 1), b3 + hstep, voffB); PG8_STAGE(PG8_SA(1, 0), a3, voffA);
            PG8_WAIT_V(8); PG8_WAIT_L(0); PG8_BAR; PG8_MMA(1, 0, At, B0); PG8_MMA(1, 1, At, B1); PG8_BAR; PG8_SCHED;
            } else {
            PG8_LDB(B0, 0, 0); PG8_SCHED; PG8_LDA(At, 0, 0); PG8_STAGE(PG8_SA(1, 1), a1 + hstep, voffA);
            PG8_WAIT_L(8); PG8_BAR; PG8_WAIT_L(0); PG8_MMA(0, 0, At, B0); PG8_BAR; PG8_SCHED;
            PG8_LDB(B1, 0, 1); PG8_STAGE(PG8_SB(0, 0), b2, voffB);
            PG8_BAR; PG8_WAIT_L(0); PG8_MMA(0, 1, At, B1); PG8_BAR;
            PG8_LDA(At, 0, 1); PG8_STAGE(PG8_SA(0, 0), a2, voffA);
            PG8_BAR; PG8_WAIT_L(0); PG8_MMA(1, 0, At, B0); PG8_BAR; PG8_SCHED;
            PG8_STAGE(PG8_SB(0, 1), b2 + hstep, voffB);
            PG8_WAIT_V(6); PG8_BAR; PG8_MMA(1, 1, At, B1); PG8_BAR;
            PG8_LDB(B0, 1, 0); PG8_SCHED; PG8_LDA(At, 1, 0); PG8_STAGE(PG8_SA(0, 1), a2 + hstep, voffA);
            PG8_WAIT_L(8); PG8_BAR; PG8_WAIT_L(0); PG8_MMA(0, 0, At, B0); PG8_BAR; PG8_SCHED;
            PG8_LDB(B1, 1, 1); PG8_STAGE(PG8_SB(1, 0), b3, voffB);
            PG8_BAR; PG8_WAIT_L(0); PG8_MMA(0, 1, At, B1); PG8_BAR;
            PG8_LDA(At, 1, 1); PG8_STAGE(PG8_SA(1, 0), a3, voffA);
            PG8_BAR; PG8_WAIT_L(0); PG8_MMA(1, 0, At, B0); PG8_BAR; PG8_SCHED;
            PG8_STAGE(PG8_SB(1, 1), b3 + hstep, voffB);
            PG8_WAIT_V(6); PG8_BAR; PG8_MMA(1, 1, At, B1); PG8_BAR;
            }
        }
        if constexpr (ALIGN_EPI) { if (wr == 0) PG8_BAR; }
        if constexpr (!Epi::AFTER_DRAIN) { E(acc, cur, wr, wc, fr, fq); S.done(cur); }
        if (!has_next) break;
#pragma unroll
        for (int a = 0; a < 2; ++a)
#pragma unroll
            for (int b = 0; b < 2; ++b)
#pragma unroll
                for (int m = 0; m < 4; ++m)
#pragma unroll
                    for (int n = 0; n < 2; ++n) acc[a][b][m][n] = (f32x4){0.f, 0.f, 0.f, 0.f};
        cur = nxt; cA = nA; cB = nB; ++ui;
        if constexpr (ALIGN_EPI) { if (wr == 1) PG8_BAR; }
    }
    PG8_WAIT_V(0);
    if constexpr (!ALIGN_EPI) { if (wr == 0) PG8_BAR; }
    PG8_BAR;
    if constexpr (Epi::AFTER_DRAIN) { E.fused(acc, cur, wr, wc, fr, fq, lds, wid, lane); S.done(cur); }
#undef PG8_SA
#undef PG8_SB
#undef PG8_STAGE
#undef PG8_LDA
#undef PG8_LDB
#undef PG8_MMA
#undef PG8_WAIT_V
#undef PG8_WAIT_L
#undef PG8_BAR
#undef PG8_SCHED
}
}


constexpr int T = 8192, DM = 2048, HD = 128, NMIX = 12, NMEMH = 4, NG = 3, MEMT = 256, FF = 7168, NE = 8;
constexpr int A_IN_W = 4388, NA = 4608;
constexpr int NB = 5120;
constexpr int CA_Q = 0, CA_KC = 1536, CA_VC = 1920, CA_KS = 2304, CA_VS = 2688, CA_KW = 3072, CA_VW = 3456, CA_QM = 3840, CA_GT = 4352;
constexpr int CB_Q = 0, CB_QM = 1536, CB_K = 2048, CB_V = 3584;
constexpr int NCMP = 511, NCMP_P = 512;
constexpr int MOE_MAXT = 72;
constexpr float EPS = 1e-6f;
constexpr float QSCALE = 0.08838834764831845f;

constexpr size_t MiB = 1u << 20;
constexpr size_t WS_CTL = 0, CTL_ZERO_BYTES = 1 * MiB;
constexpr size_t WS_WT_INA = 2 * MiB;
constexpr size_t WS_WT_MEM = 20 * MiB;
constexpr size_t WS_WT_OUT = 28 * MiB;
constexpr size_t WS_WT_FGU = 44 * MiB;
constexpr size_t WS_WT_FDN = 100 * MiB;
constexpr size_t WS_WT_INB = 128 * MiB;
constexpr size_t WS_WT_MGU = 148 * MiB;
constexpr size_t WS_WT_MDN = 596 * MiB;
constexpr size_t WS_XN = 820 * MiB;
constexpr size_t WS_MEMN = 852 * MiB;
constexpr size_t WS_MKV = 853 * MiB;
constexpr size_t WS_PA = 854 * MiB;
constexpr size_t WS_KCMP = 926 * MiB;
constexpr size_t WS_MIX = 927 * MiB;
constexpr size_t WS_X1 = 959 * MiB;
constexpr size_t WS_X2 = 1023 * MiB;
constexpr size_t WS_X3 = 1087 * MiB;
constexpr size_t WS_HFF = 1151 * MiB;
constexpr size_t WS_PB = 1263 * MiB;
constexpr size_t WS_AMOE = 1343 * MiB;
constexpr size_t WS_HMOE = 1415 * MiB;
constexpr size_t WS_YMOE = 1667 * MiB;
constexpr size_t WS_ROUTE = 1739 * MiB;
constexpr size_t WS_WT_CMP = 1740 * MiB;
constexpr size_t WS_OACC = 1742 * MiB;
constexpr size_t WS_SLAB = 1790 * MiB;
constexpr size_t WS_END = 1854 * MiB;
constexpr size_t RT_TOPI = 0;
constexpr size_t RT_TOPW = 65536;
constexpr size_t RT_ROW = 131072;
constexpr size_t RT_HIST = 196608;
constexpr size_t RT_TILE = 204800;
constexpr int CW_TMO = 0, CW_CODE = 1, CW_BAR = 4096;

constexpr int RING_OFF = 0, RING_BYTES = 135168;
constexpr int LDSCTL_OFF = RING_BYTES, MISC_OFF = LDSCTL_OFF + 320;
constexpr int LDS_BYTES = 147456;
static_assert(MISC_OFF + 128 <= LDS_BYTES, "LDS map");
constexpr int NWAVES = 8;

#define GAS __attribute__((address_space(1)))
#define LAS __attribute__((address_space(3)))
typedef unsigned short bf16;
typedef unsigned v4u __attribute__((ext_vector_type(4)));
typedef unsigned v2u __attribute__((ext_vector_type(2)));
typedef float f32x4 __attribute__((ext_vector_type(4)));
typedef GAS unsigned gu32;
#define RLX_AGENT __ATOMIC_RELAXED, __HIP_MEMORY_SCOPE_AGENT
#define LDS_WAIT() asm volatile("s_waitcnt lgkmcnt(0)" ::: "memory")
#define VM_WAIT() asm volatile("s_waitcnt vmcnt(0)" ::: "memory")
__device__ __forceinline__ float bf2f(unsigned b) { return __uint_as_float(b << 16); }
__device__ __forceinline__ unsigned pk2(float lo, float hi) { return pg8::cvt_pk_bf16(lo, hi); }
__device__ __forceinline__ void unpack8(v4u w, float* f) {
    f[0] = __uint_as_float(w.x << 16); f[1] = __uint_as_float(w.x & 0xffff0000u); f[2] = __uint_as_float(w.y << 16); f[3] = __uint_as_float(w.y & 0xffff0000u);
    f[4] = __uint_as_float(w.z << 16); f[5] = __uint_as_float(w.z & 0xffff0000u); f[6] = __uint_as_float(w.w << 16); f[7] = __uint_as_float(w.w & 0xffff0000u); }
__device__ __forceinline__ float wave_sum(float v) {
#pragma unroll
    for (int o = 1; o < 64; o <<= 1) v += __shfl_xor(v, o);
    return v;
}
__device__ __forceinline__ float fast_exp(float x) { return __builtin_amdgcn_exp2f(x * 1.4426950408889634f); }

#define XB_TMO      128
#define XB_XCNT(j)  (256  + 64 * (j))
#define XB_XSUB(j)  (1280 + 64 * (j))
#define XB_XGEN(j)  (2304 + 64 * (j))
#define XB_TOP      3328
#define XB_TOPGEN   3392
#define XCD_BAR_WORDS 3456
#define XB_SPIN_CAP (1u << 18)
__device__ __forceinline__ unsigned xb_ld(unsigned* p)              { return __hip_atomic_load(p, __ATOMIC_RELAXED, __HIP_MEMORY_SCOPE_AGENT); }
__device__ __forceinline__ unsigned xb_add(unsigned* p, unsigned v) { return __hip_atomic_fetch_add(p, v, __ATOMIC_RELAXED, __HIP_MEMORY_SCOPE_AGENT); }
__device__ __forceinline__ unsigned xb_xcc_id() { return (unsigned)__builtin_amdgcn_s_getreg((3 << 11) | 20) & 0xFu; }
#define XB_SPIN(cond, bar) do { unsigned _sp = 0; while (cond) { __builtin_amdgcn_s_sleep(1); \
    if ((++_sp & 255u) == 0u) { if (xb_ld(&(bar)[XB_TMO])) break; if (_sp > XB_SPIN_CAP) { atomicAdd(&(bar)[XB_TMO], 1u); break; } } } } while (0)
struct XcdBarrier { unsigned* bar; unsigned x; volatile LAS unsigned* st; };
__device__ __forceinline__ XcdBarrier xcd_barrier_post(unsigned* bar, volatile LAS unsigned* st) {
    XcdBarrier b; b.bar = bar; b.x = xb_xcc_id(); b.st = st;
    if (threadIdx.x == 0) (void)xb_add(&bar[XB_XCNT(b.x)], 1u);
    return b;
}
__device__ __forceinline__ void xcd_barrier_complete(unsigned* bar, unsigned x, unsigned& nloc, unsigned& nx) {
    const unsigned G = gridDim.x * gridDim.y * gridDim.z;
    unsigned sum, cnt, mine, sp = 0u;
    for (;;) {
        sum = 0u; cnt = 0u; mine = 0u;
#pragma unroll
        for (unsigned j = 0; j < 16; ++j) { const unsigned c = xb_ld(&bar[XB_XCNT(j)]); sum += c; cnt += (c > 0u) ? 1u : 0u; mine = (j == x) ? c : mine; }
        if (sum == G) break;
        __builtin_amdgcn_s_sleep(1);
        if ((++sp & 255u) == 0u) { if (xb_ld(&bar[XB_TMO])) break; if (sp > XB_SPIN_CAP) { atomicAdd(&bar[XB_TMO], 1u); break; } }
    }
    nloc = mine > 0u ? mine : 1u; nx = cnt > 0u ? cnt : 1u;
}
__device__ __forceinline__ void xcd_barrier(const XcdBarrier& b) {
    asm volatile("s_waitcnt vmcnt(0)" ::: "memory");
    __syncthreads();
    if (threadIdx.x == 0) {
        unsigned* bar = b.bar;
        __builtin_amdgcn_s_waitcnt(0);
        unsigned nloc = b.st[0], nx = b.st[1];
        if (nloc == 0u) { xcd_barrier_complete(bar, b.x, nloc, nx); b.st[0] = nloc; b.st[1] = nx; }
        const unsigned old = xb_add(&bar[XB_XSUB(b.x)], 1u);
        const unsigned gen = old / nloc;
        if (old + 1u == (gen + 1u) * nloc) {
            __builtin_amdgcn_fence(__ATOMIC_RELEASE, "agent");
            asm volatile("s_waitcnt vmcnt(0)" ::: "memory");
            const unsigned og = xb_add(&bar[XB_TOP], 1u);
            const unsigned tg = og / nx;
            if (og + 1u == (tg + 1u) * nx) xb_add(&bar[XB_TOPGEN], 1u);
            else XB_SPIN(xb_ld(&bar[XB_TOPGEN]) == tg, bar);
            __builtin_amdgcn_fence(__ATOMIC_ACQUIRE, "agent");
            xb_add(&bar[XB_XGEN(b.x)], 1u);
            asm volatile("s_waitcnt vmcnt(0)" ::: "memory");
        } else {
            XB_SPIN(xb_ld(&bar[XB_XGEN(b.x)]) == gen, bar);
            __builtin_amdgcn_fence(__ATOMIC_ACQUIRE, "agent");
            asm volatile("s_waitcnt vmcnt(0)" ::: "memory");
        }
    }
    __syncthreads();
}

struct Frame {
    LAS unsigned char* lds;
    volatile LAS unsigned* MISC;
    gu32* ctl;
    int tid, wave;
    int vcu, G;
    unsigned char* ws;
    const float* in[22];
    float* out;
};
#define WSP(T_, off) ((T_*)(F.ws + (off)))
__device__ __forceinline__ int lane_of(const Frame& F) { int t = F.tid; asm volatile("" : "+v"(t)); return t & 63; }

constexpr int CV_INA = 0, CV_MEM = CV_INA + 32 * 72, CV_CMP = CV_MEM + 2 * 32 * 16, CV_OUT = CV_CMP + 2 * 64 * 2, CV_FGU = CV_OUT + 2 * 32 * 32, CV_FDN = CV_FGU + 32 * 224,
              CV_INB = CV_FDN + 112 * 32, CV_KVB = CV_INB + 32 * 32, CV_MGU = CV_KVB + 32 * 48, CV_MDN = CV_MGU + 8 * 32 * 224, CV_TOTAL = CV_MDN + 8 * 112 * 32;
struct ConvIt { const float* src; bf16* dst; const float* gain; int K, Nsrc, sc0, n0, k0, nvalid; };
__device__ __forceinline__ void conv_decode(Frame& F, int g, ConvIt& c) {
    int loc, nnb, mode = 0, batch = 0; c.gain = nullptr;
    if (g < CV_MEM) { loc = g - CV_INA; c.src = F.in[5]; c.dst = WSP(bf16, WS_WT_INA); c.gain = F.in[2]; c.K = DM; c.Nsrc = A_IN_W; nnb = NA / 64; mode = 2; }
    else if (g < CV_CMP) { loc = g - CV_MEM; batch = loc / (32 * 16); loc -= batch * 32 * 16; c.src = F.in[13] + (size_t)batch * DM * 1024; c.dst = WSP(bf16, WS_WT_MEM) + (size_t)batch * 1024 * DM; c.gain = F.in[3] + batch * DM; c.K = DM; c.Nsrc = 1024; nnb = 16; }
    else if (g < CV_OUT) { loc = g - CV_CMP; batch = loc / 128; loc -= batch * 128; c.src = F.in[6] + (size_t)batch * 4096 * HD; c.dst = WSP(bf16, WS_WT_CMP) + (size_t)batch * HD * 4096; c.K = 4096; c.Nsrc = HD; nnb = 2; }
    else if (g < CV_FGU) { loc = g - CV_OUT; batch = loc / 1024; loc -= batch * 1024; c.src = F.in[15] + (size_t)batch * DM * DM; c.dst = WSP(bf16, WS_WT_OUT) + (size_t)batch * DM * DM; c.K = DM; c.Nsrc = DM; nnb = 32; }
    else if (g < CV_FDN) { loc = g - CV_FGU; c.src = F.in[16]; c.dst = WSP(bf16, WS_WT_FGU); c.gain = F.in[4]; c.K = DM; c.Nsrc = 2 * FF; nnb = 224; mode = 1; }
    else if (g < CV_INB) { loc = g - CV_FDN; c.src = F.in[17]; c.dst = WSP(bf16, WS_WT_FDN); c.K = FF; c.Nsrc = DM; nnb = 32; }
    else if (g < CV_KVB) { loc = g - CV_INB; c.src = F.in[10]; c.dst = WSP(bf16, WS_WT_INB); c.gain = F.in[2] + DM; c.K = DM; c.Nsrc = DM; nnb = 32; }
    else if (g < CV_MGU) { loc = g - CV_KVB; c.src = F.in[12]; c.dst = WSP(bf16, WS_WT_INB) + (size_t)2048 * DM; c.gain = F.in[11]; c.K = DM; c.Nsrc = 3072; nnb = 48; }
    else if (g < CV_MDN) { loc = g - CV_MGU; batch = loc / 7168; loc -= batch * 7168; c.src = F.in[20] + (size_t)batch * DM * 2 * FF; c.dst = WSP(bf16, WS_WT_MGU) + (size_t)batch * 2 * FF * DM; c.gain = F.in[4] + DM; c.K = DM; c.Nsrc = 2 * FF; nnb = 224; mode = 1; }
    else { loc = g - CV_MDN; batch = loc / 3584; loc -= batch * 3584; c.src = F.in[21] + (size_t)batch * FF * DM; c.dst = WSP(bf16, WS_WT_MDN) + (size_t)batch * DM * FF; c.K = FF; c.Nsrc = DM; nnb = 32; }
    const int kb = loc / nnb, nb = loc - kb * nnb;
    c.k0 = kb * 64; c.n0 = nb * 64; c.nvalid = nnb * 64;
    if (mode == 1) { const int j = c.n0 >> 8, r = c.n0 & 255; c.sc0 = (r < 128) ? 128 * j + r : 7168 + 128 * j + (r - 128); }
    else if (mode == 2) { if (c.n0 < 3840) c.sc0 = c.n0; else if (c.n0 < 4352) c.sc0 = c.n0 + 36; else if (c.n0 < 4416) { c.sc0 = c.n0 - 512; c.nvalid = 4388; } else { c.sc0 = 0; c.nvalid = 0; } }
    else c.sc0 = c.n0;
}
struct ConvRegs { f32x4 v[16]; float gn[8]; };
__device__ __forceinline__ void conv_load(const ConvIt& c, ConvRegs& R, int lane) {
    const int kr = lane >> 4, nc = (lane & 15) * 4;
    const bool ok = (c.n0 + nc) < c.nvalid;
    const int cc = ok ? c.sc0 + nc : 0;
    const float* p = c.src + (size_t)(c.k0 + kr) * c.Nsrc + cc;
#pragma unroll
    for (int i = 0; i < 16; ++i) R.v[i] = __builtin_nontemporal_load((const f32x4*)(p + (size_t)(4 * i) * c.Nsrc));
    if (c.n0 + 64 > c.nvalid) {
#pragma unroll
        for (int i = 0; i < 16; ++i) R.v[i] = ok ? R.v[i] : (f32x4){0.f, 0.f, 0.f, 0.f}; }
    const int c8 = lane & 7;
    if (c.gain) {
#pragma unroll
        for (int i = 0; i < 8; ++i) R.gn[i] = c.gain[c.k0 + 8 * c8 + i]; }
}
__device__ __forceinline__ void conv_proc(const ConvIt& c, const ConvRegs& R, LAS float* scr, int lane) {
    const int kr = lane >> 4, nc = (lane & 15) * 4;
#pragma unroll
    for (int i = 0; i < 16; ++i) { LAS float* s = scr + (4 * i + kr) * 65 + nc; s[0] = R.v[i][0]; s[1] = R.v[i][1]; s[2] = R.v[i][2]; s[3] = R.v[i][3]; }
    LDS_WAIT(); asm volatile("" ::: "memory");
    const int c8 = lane & 7, nl = lane >> 3;
#pragma unroll
    for (int j = 0; j < 8; ++j) {
        const int n = nl + 8 * j; const LAS float* s = scr + (8 * c8) * 65 + n;
        v4u o;
        if (c.gain) { o.x = pk2(s[0 * 65] * R.gn[0], s[1 * 65] * R.gn[1]); o.y = pk2(s[2 * 65] * R.gn[2], s[3 * 65] * R.gn[3]); o.z = pk2(s[4 * 65] * R.gn[4], s[5 * 65] * R.gn[5]); o.w = pk2(s[6 * 65] * R.gn[6], s[7 * 65] * R.gn[7]); }
        else { o.x = pk2(s[0 * 65], s[1 * 65]); o.y = pk2(s[2 * 65], s[3 * 65]); o.z = pk2(s[4 * 65], s[5 * 65]); o.w = pk2(s[6 * 65], s[7 * 65]); }
        __builtin_nontemporal_store(o, (v4u*)(c.dst + (size_t)(c.n0 + n) * c.K + c.k0 + 8 * c8));
    }
    LDS_WAIT(); asm volatile("" ::: "memory");
}
__device__ __forceinline__ void conv_list(Frame& F, int first, int stride, int g_hi) {
    LAS float* scr = (LAS float*)(F.lds + RING_OFF + F.wave * 16640);
    int g = first;
    if (g >= g_hi) return;
    ConvIt cA, cB; ConvRegs RA, RB;
    conv_decode(F, g, cA); conv_load(cA, RA, lane_of(F));
    for (;;) {
        const int g1 = g + stride; const bool h1 = g1 < g_hi;
        if (h1) { conv_decode(F, g1, cB); conv_load(cB, RB, lane_of(F)); }
        asm volatile("" ::: "memory");
        conv_proc(cA, RA, scr, lane_of(F));
        if (!h1) break;
        const int g2 = g1 + stride; const bool h2 = g2 < g_hi;
        if (h2) { conv_decode(F, g2, cA); conv_load(cA, RA, lane_of(F)); }
        asm volatile("" ::: "memory");
        conv_proc(cB, RB, scr, lane_of(F));
        if (!h2) break;
        g = g2;
    }
}
constexpr int CV_DEFER0 = CV_FGU, CV_CHUNK = 8;
constexpr int CW_DBG = 16;
constexpr int CW_SS = 65536;
constexpr int CW_TMAP = 12288;
constexpr int CW_CVNEXT = 8192, CW_DONE0 = 8192 + 64;
__device__ __forceinline__ bool conv_grab(Frame& F) {
    volatile LAS int* sh = (volatile LAS int*)(F.lds + LDSCTL_OFF + 64);
    if (F.tid == 0) sh[0] = CV_DEFER0 + (int)__hip_atomic_fetch_add((unsigned*)(F.ctl + CW_CVNEXT), (unsigned)CV_CHUNK, __ATOMIC_RELAXED, __HIP_MEMORY_SCOPE_AGENT);
    __syncthreads();
    const int base = sh[0];
    __syncthreads();
    if (base >= CV_TOTAL) return false;
    const int hi = base + CV_CHUNK < CV_TOTAL ? base + CV_CHUNK : CV_TOTAL;
    conv_list(F, base + F.wave, NWAVES, hi);
    return true;
}
__device__ __forceinline__ void idle_fill(Frame& F, int ph) {
    volatile LAS int* sh = (volatile LAS int*)(F.lds + LDSCTL_OFF + 64);
    asm volatile("s_waitcnt vmcnt(0)" ::: "memory");
    __syncthreads();
    if (F.tid == 0) __hip_atomic_fetch_add((unsigned*)(F.ctl + CW_DONE0 + 64 * ph), 1u, __ATOMIC_RELAXED, __HIP_MEMORY_SCOPE_AGENT);
    for (;;) {
        if (F.tid == 0) sh[1] = (__hip_atomic_load((unsigned*)(F.ctl + CW_DONE0 + 64 * ph), __ATOMIC_RELAXED, __HIP_MEMORY_SCOPE_AGENT) >= (unsigned)F.G) ? 1 : 0;
        __syncthreads();
        const int alld = sh[1];
        __syncthreads();
        if (alld) break;
        if (!conv_grab(F)) break;
    }
}
__device__ __forceinline__ void conv_drain(Frame& F, int limit) {
    volatile LAS int* sh = (volatile LAS int*)(F.lds + LDSCTL_OFF + 64);
    asm volatile("s_waitcnt vmcnt(0)" ::: "memory");
    __syncthreads();
    for (;;) {
        if (F.tid == 0) sh[1] = (CV_DEFER0 + (int)__hip_atomic_load((unsigned*)(F.ctl + CW_CVNEXT), __ATOMIC_RELAXED, __HIP_MEMORY_SCOPE_AGENT) >= limit) ? 1 : 0;
        __syncthreads();
        const int enough = sh[1];
        __syncthreads();
        if (enough) break;
        if (!conv_grab(F)) break;
    }
}
__device__ __forceinline__ float row_rstd_to_bf16(const float* xrow, bf16* orow, int lane) {
    const f32x4* xr = (const f32x4*)xrow + lane;
    f32x4 v[8]; float s = 0.f;
#pragma unroll
    for (int j = 0; j < 8; ++j) { v[j] = xr[64 * j]; s += (v[j].x * v[j].x + v[j].y * v[j].y) + (v[j].z * v[j].z + v[j].w * v[j].w); }
    const float rstd = 1.0f / sqrtf(wave_sum(s) * (1.f / DM) + EPS);
    v2u* o8 = (v2u*)orow + lane;
#pragma unroll
    for (int j = 0; j < 8; ++j) { v2u w; w.x = pk2(v[j].x * rstd, v[j].y * rstd); w.y = pk2(v[j].z * rstd, v[j].w * rstd); o8[64 * j] = w; }
    return rstd;
}
__device__ __forceinline__ void rmsnorm_rows(Frame& F, const float* X, bf16* XN, int rows) {
    const int gw = F.vcu * NWAVES + F.wave, NGW = F.G * NWAVES;
    for (int m = gw; m < rows; m += NGW) row_rstd_to_bf16(X + (size_t)m * DM, XN + (size_t)m * DM, lane_of(F));
}
__device__ __forceinline__ void p0_prologue(Frame& F) {
    conv_list(F, F.vcu * NWAVES + F.wave, F.G * NWAVES, CV_DEFER0);
    rmsnorm_rows(F, F.in[0], WSP(bf16, WS_XN), T);
    rmsnorm_rows(F, F.in[1], WSP(bf16, WS_MEMN), MEMT);
}

__device__ __forceinline__ void p2_compress(Frame& F) {
    typedef short bf16x8 __attribute__((ext_vector_type(8)));
    const bf16* PA = WSP(bf16, WS_PA); const bf16* WC = WSP(bf16, WS_WT_CMP);
    LAS float* red = (LAS float*)(F.lds + RING_OFF);
    LAS float* posl = red + 8 * 16 * 132;
    const int lane = lane_of(F), w = F.wave, fr = lane & 15, fq = lane >> 4;
    for (int i = F.tid; i < 2 * 4096 / 4; i += NWAVES * 64) *(LAS f32x4*)(posl + 4 * i) = *(const f32x4*)(F.in[7] + 4 * i);
    __syncthreads();
    const int nitems = 2 * NG * 32;
    for (int it = F.vcu; it < nitems; it += F.G) {
        const int kv = it / (NG * 32), g = (it / 32) % NG, jt = it % 32;
        const int j = 16 * jt + fr;
        const LAS float* pos = posl + kv * 4096 + 512 * w + 8 * fq;
        const int col = (kv ? CA_VC : CA_KC) + g * HD;
        const bf16* wrow = WC + ((size_t)kv * HD + fr) * 4096 + 512 * w + 8 * fq;
        f32x4 acc[8];
#pragma unroll
        for (int c = 0; c < 8; ++c) acc[c] = f32x4{0.f, 0.f, 0.f, 0.f};
        for (int u0 = 0; u0 < 16; u0 += 4) {
            v4u xa[4], wb[4][8];
#pragma unroll
            for (int u = 0; u < 4; ++u) {
                const int kl = 32 * (u0 + u) + 8 * fq, i = 4 * w + (kl >> 7), d = kl & 127;
                int trow = 16 * j + i; trow = trow < T ? trow : T - 1;
                xa[u] = *(const v4u*)(PA + (size_t)trow * NA + col + d);
#pragma unroll
                for (int c = 0; c < 8; ++c) wb[u][c] = *(const v4u*)(wrow + (size_t)c * 16 * 4096 + 32 * (u0 + u));
            }
            asm volatile("" ::: "memory");
#pragma unroll
            for (int u = 0; u < 4; ++u) {
                const f32x4 pa = *(const LAS f32x4*)(pos + 32 * (u0 + u)), pb = *(const LAS f32x4*)(pos + 32 * (u0 + u) + 4);
                float xf[8]; unpack8(xa[u], xf);
                v4u av; av.x = pk2(xf[0] + pa[0], xf[1] + pa[1]); av.y = pk2(xf[2] + pa[2], xf[3] + pa[3]); av.z = pk2(xf[4] + pb[0], xf[5] + pb[1]); av.w = pk2(xf[6] + pb[2], xf[7] + pb[3]);
#pragma unroll
                for (int c = 0; c < 8; ++c)
                    acc[c] = __builtin_amdgcn_mfma_f32_16x16x32_bf16(*reinterpret_cast<const bf16x8*>(&av), *reinterpret_cast<const bf16x8*>(&wb[u][c]), acc[c], 0, 0, 0);
            }
        }
#pragma unroll
        for (int c = 0; c < 8; ++c)
#pragma unroll
            for (int r = 0; r < 4; ++r) red[(w * 16 + 4 * fq + r) * 132 + 16 * c + fr] = acc[c][r];
        __syncthreads();
        {
            const int row = F.tid >> 5, cp = F.tid & 31, jj = 16 * jt + row;
            float v[4] = {0.f, 0.f, 0.f, 0.f}; float ss = 0.f;
#pragma unroll
            for (int ww = 0; ww < 8; ++ww) { const f32x4 p = *(const LAS f32x4*)(red + (ww * 16 + row) * 132 + 4 * cp); v[0] += p[0]; v[1] += p[1]; v[2] += p[2]; v[3] += p[3]; }
#pragma unroll
            for (int e = 0; e < 4; ++e) ss += v[e] * v[e];
            ss += __shfl_xor(ss, 1); ss += __shfl_xor(ss, 2); ss += __shfl_xor(ss, 4); ss += __shfl_xor(ss, 8); ss += __shfl_xor(ss, 16);
            if (kv == 0) { const float rs = 1.0f / sqrtf(ss * (1.f / HD) + EPS); const float* gp = F.in[9] + 4 * cp;
#pragma unroll
                for (int e = 0; e < 4; ++e) v[e] = v[e] * rs * gp[e]; }
            if (jj >= NCMP) {
#pragma unroll
                for (int e = 0; e < 4; ++e) v[e] = 0.f; }
            v2u o; o.x = pk2(v[0], v[1]); o.y = pk2(v[2], v[3]);
            *(v2u*)(WSP(bf16, WS_KCMP) + (size_t)kv * NG * NCMP_P * HD + ((size_t)g * NCMP_P + jj) * HD + 4 * cp) = o;
        }
        __syncthreads();
    }
}
__device__ __forceinline__ void norm_slot(bf16* p, const float* gain, int l16) {
    v4u w = *(const v4u*)(p + l16 * 8); float f[8]; unpack8(w, f);
    float s = 0.f;
#pragma unroll
    for (int e = 0; e < 8; ++e) s += f[e] * f[e];
    s += __shfl_xor(s, 1); s += __shfl_xor(s, 2); s += __shfl_xor(s, 4); s += __shfl_xor(s, 8);
    const float r = 1.0f / sqrtf(s * (1.f / HD) + EPS);
    const float* gp = gain + l16 * 8;
    v4u o; o.x = pk2(f[0] * r * gp[0], f[1] * r * gp[1]); o.y = pk2(f[2] * r * gp[2], f[3] * r * gp[3]); o.z = pk2(f[4] * r * gp[4], f[5] * r * gp[5]); o.w = pk2(f[6] * r * gp[6], f[7] * r * gp[7]);
    *(v4u*)(p + l16 * 8) = o;
}
__device__ __forceinline__ void norm_vals(v4u w, bf16* p, const float* gain, int l16) {
    float f[8]; unpack8(w, f);
    float s = 0.f;
#pragma unroll
    for (int e = 0; e < 8; ++e) s += f[e] * f[e];
    s += __shfl_xor(s, 1); s += __shfl_xor(s, 2); s += __shfl_xor(s, 4); s += __shfl_xor(s, 8);
    const float r = 1.0f / sqrtf(s * (1.f / HD) + EPS);
    const float* gp = gain + l16 * 8;
    v4u o; o.x = pk2(f[0] * r * gp[0], f[1] * r * gp[1]); o.y = pk2(f[2] * r * gp[2], f[3] * r * gp[3]); o.z = pk2(f[4] * r * gp[4], f[5] * r * gp[5]); o.w = pk2(f[6] * r * gp[6], f[7] * r * gp[7]);
    *(v4u*)(p + l16 * 8) = o;
}
constexpr int CW_QKN = 8192 + 32;
__device__ __forceinline__ void p2_qknorm(Frame& F) {
    bf16* PA = WSP(bf16, WS_PA); bf16* MKV = WSP(bf16, WS_MKV);
    const int sub = F.wave * 4 + (lane_of(F) >> 4), l16 = lane_of(F) & 15;
    for (int s = F.vcu * 32 + sub; s < MEMT * 8; s += F.G * 32) {
        const int m = s / 8, k = s % 8, l = k >> 2, h = k & 3;
        norm_slot(MKV + (size_t)m * 2048 + l * 1024 + h * HD, F.in[14] + (size_t)(l * 2 + 1) * HD, l16);
    }
    constexpr int NCH = T * 18 / 192;
    volatile LAS int* sh = (volatile LAS int*)(F.lds + LDSCTL_OFF + 64);
    if (F.tid == 0) sh[2] = (int)__hip_atomic_fetch_add((unsigned*)(F.ctl + CW_QKN), 1u, __ATOMIC_RELAXED, __HIP_MEMORY_SCOPE_AGENT);
    __syncthreads();
    int ch = sh[2];
    __syncthreads();
    while (ch < NCH) {
        if (F.tid == 0) sh[2] = (int)__hip_atomic_fetch_add((unsigned*)(F.ctl + CW_QKN), 1u, __ATOMIC_RELAXED, __HIP_MEMORY_SCOPE_AGENT);
        bf16* ptr[6]; const float* gn[6]; v4u w[6];
        const int s0 = ch * 192 + sub;
#pragma unroll
        for (int u = 0; u < 6; ++u) {
            const int s = s0 + u * 32;
            const int t = s / 18, k = s % 18;
            int col; const float* gain;
            if (k < 12) { col = CA_Q + k * HD; gain = F.in[8]; }
            else if (k < 15) { col = CA_KS + (k - 12) * HD; gain = F.in[9] + HD; }
            else { col = CA_KW + (k - 15) * HD; gain = F.in[9] + 2 * HD; }
            ptr[u] = PA + (size_t)t * NA + col; gn[u] = gain; w[u] = *(const v4u*)(ptr[u] + l16 * 8);
        }
        asm volatile("" ::: "memory");
#pragma unroll
        for (int u = 0; u < 6; ++u) norm_vals(w[u], ptr[u], gn[u], l16);
        __syncthreads();
        ch = sh[2];
        __syncthreads();
    }
}

__device__ __forceinline__ void ld32(const bf16* p, float* f) {
#pragma unroll
    for (int i = 0; i < 4; ++i) { const v4u w = *(const v4u*)(p + 8 * i); unpack8(w, f + 8 * i); }
}
__device__ __forceinline__ float dot32q(const float* q, const bf16* kp) {
    float kf[32]; ld32(kp, kf); float s = 0.f;
#pragma unroll
    for (int i = 0; i < 32; ++i) s += q[i] * kf[i];
    s += __shfl_xor(s, 1); s += __shfl_xor(s, 2);
    return s;
}
__device__ __forceinline__ void axpy32(float* o, float p, const bf16* vp) {
    float vf[32]; ld32(vp, vf);
#pragma unroll
    for (int i = 0; i < 32; ++i) o[i] += p * vf[i];
}
__device__ __forceinline__ void st32(bf16* p, const float* f) {
#pragma unroll
    for (int i = 0; i < 4; ++i) { v4u w; w.x = pk2(f[8 * i], f[8 * i + 1]); w.y = pk2(f[8 * i + 2], f[8 * i + 3]); w.z = pk2(f[8 * i + 4], f[8 * i + 5]); w.w = pk2(f[8 * i + 6], f[8 * i + 7]); *(v4u*)(p + 8 * i) = w; }
}
#define OSM_STEP(s_, valid_, vptr_) do { if (valid_) { const float mn_ = fmaxf(m, (s_)); const float al_ = fast_exp(m - mn_); const float pp_ = fast_exp((s_) - mn_); \
        l = l * al_ + pp_; _Pragma("unroll") for (int i_ = 0; i_ < 32; ++i_) o[i_] *= al_; axpy32(o, pp_, (vptr_)); m = mn_; } } while (0)

__device__ __forceinline__ void p3_nsa_naive(Frame& F) {
    const bf16* PA = WSP(bf16, WS_PA); const bf16* KC = WSP(bf16, WS_KCMP); const bf16* VC = KC + (size_t)NG * NCMP_P * HD; bf16* MIX = WSP(bf16, WS_MIX);
    LAS float* IMP = (LAS float*)(F.lds + RING_OFF + F.wave * 4096);
    LAS unsigned long long* SELW = (LAS unsigned long long*)(F.lds + RING_OFF + F.wave * 4096 + 2048);
    const int gw = F.vcu * NWAVES + F.wave, NGW = F.G * NWAVES;
    const int dq = lane_of(F) & 3, p = (lane_of(F) >> 2) & 3, ql = lane_of(F) >> 4;
    for (int it = gw; it < NG * (T / 4); it += NGW) {
        const int g = it / (T / 4), tq = it % (T / 4), t = 4 * tq + ql, head = g * 4 + p;
        const float slope = exp2f(-8.0f * (float)(head + 1) / 12.0f);
        float q[32]; ld32(PA + (size_t)t * NA + CA_Q + head * HD + dq * 32, q);
#pragma unroll
        for (int i = 0; i < 32; ++i) q[i] *= QSCALE;
        const float g0 = 1.0f / (1.0f + fast_exp(-bf2f(PA[(size_t)t * NA + CA_GT + head * 3 + 0])));
        const float g1 = 1.0f / (1.0f + fast_exp(-bf2f(PA[(size_t)t * NA + CA_GT + head * 3 + 1])));
        const float g2 = 1.0f / (1.0f + fast_exp(-bf2f(PA[(size_t)t * NA + CA_GT + head * 3 + 2])));
        float otot[32];
#pragma unroll
        for (int i = 0; i < 32; ++i) otot[i] = 0.f;
        for (int i = lane_of(F); i < 512; i += 64) IMP[i] = 0.f;
        LDS_WAIT(); asm volatile("" ::: "memory");
        const int jmax = (t >= 31) ? (t - 31) / 16 : -1;
        const int jmax_w = (4 * tq + 3 >= 31) ? (4 * tq + 3 - 31) / 16 : -1;
        const bf16* kcg = KC + (size_t)g * NCMP_P * HD + dq * 32; const bf16* vcg = VC + (size_t)g * NCMP_P * HD + dq * 32;
        {
            float m = -1e30f, l = 0.f;
            for (int j = 0; j <= jmax_w; ++j) {
                const float s = dot32q(q, kcg + (size_t)j * HD) - slope * (float)(t - (16 * j + 31));
                if (j <= jmax) { const float mn = fmaxf(m, s); l = l * fast_exp(m - mn) + fast_exp(s - mn); m = mn; }
            }
            const float rl = (l > 0.f) ? 1.0f / l : 0.f;
            float o[32];
#pragma unroll
            for (int i = 0; i < 32; ++i) o[i] = 0.f;
            for (int j = 0; j <= jmax_w; ++j) {
                const float s = dot32q(q, kcg + (size_t)j * HD) - slope * (float)(t - (16 * j + 31));
                const float pj = (j <= jmax) ? fast_exp(s - m) * rl : 0.f;
                axpy32(o, pj, vcg + (size_t)j * HD);
                float ps = pj; ps += __shfl_xor(ps, 4); ps += __shfl_xor(ps, 8);
                if (dq == 0 && p == 0) { IMP[ql * 128 + (j >> 2)] += ps; if ((j & 3) == 3 && (j >> 2) + 1 < 128) IMP[ql * 128 + (j >> 2) + 1] += ps; }
            }
#pragma unroll
            for (int i = 0; i < 32; ++i) otot[i] += g0 * o[i];
        }
        LDS_WAIT(); asm volatile("" ::: "memory");
        for (int qq = 0; qq < 4; ++qq) {
            const int tt = 4 * tq + qq, cur = tt >> 6;
            const int b0 = lane_of(F), b1 = lane_of(F) + 64;
            const float s0 = (b0 == cur) ? 2e6f : (b0 == 0 ? 1e6f : (b0 * 64 <= tt ? IMP[qq * 128 + b0] : -1e6f));
            const float s1 = (b1 == cur) ? 2e6f : (b1 * 64 <= tt ? IMP[qq * 128 + b1] : -1e6f);
            int r0 = 0, r1 = 0;
            for (int b = 0; b < 128; ++b) {
                const float sb = (b == cur) ? 2e6f : (b == 0 ? 1e6f : (b * 64 <= tt ? IMP[qq * 128 + b] : -1e6f));
                r0 += (sb > s0 || (sb == s0 && b < b0)) ? 1 : 0;
                r1 += (sb > s1 || (sb == s1 && b < b1)) ? 1 : 0;
            }
            const unsigned long long m0 = __ballot(r0 < 16 && b0 * 64 <= tt), m1 = __ballot(r1 < 16 && b1 * 64 <= tt);
            if (lane_of(F) == 0) { SELW[qq * 2] = m0; SELW[qq * 2 + 1] = m1; }
        }
        LDS_WAIT(); asm volatile("" ::: "memory");
        {
            const unsigned long long my0 = SELW[ql * 2], my1 = SELW[ql * 2 + 1];
            const unsigned long long u0v = SELW[0] | SELW[2] | SELW[4] | SELW[6], u1v = SELW[1] | SELW[3] | SELW[5] | SELW[7];
            const unsigned long long u0 = ((unsigned long long)(unsigned)__builtin_amdgcn_readfirstlane((int)(u0v >> 32)) << 32) | (unsigned)__builtin_amdgcn_readfirstlane((int)(unsigned)u0v);
            const unsigned long long u1 = ((unsigned long long)(unsigned)__builtin_amdgcn_readfirstlane((int)(u1v >> 32)) << 32) | (unsigned)__builtin_amdgcn_readfirstlane((int)(unsigned)u1v);
            float m = -1e30f, l = 0.f, o[32];
#pragma unroll
            for (int i = 0; i < 32; ++i) o[i] = 0.f;
            const bf16* kg = PA + CA_KS + g * HD + dq * 32; const bf16* vg = PA + CA_VS + g * HD + dq * 32;
            for (int b = 0; b < 128; ++b) {
                const bool inu = (b < 64) ? ((u0 >> b) & 1ull) : ((u1 >> (b - 64)) & 1ull);
                if (!inu) continue;
                const bool mine = (b < 64) ? ((my0 >> b) & 1ull) : ((my1 >> (b - 64)) & 1ull);
                for (int k = 0; k < 64; ++k) {
                    const int kp = b * 64 + k;
                    const float s = dot32q(q, kg + (size_t)kp * NA) - slope * (float)(t - kp);
                    const bool valid = mine && kp <= t;
                    OSM_STEP(s, valid, vg + (size_t)kp * NA);
                }
            }
            const float sc = (l > 0.f) ? g1 / l : 0.f;
#pragma unroll
            for (int i = 0; i < 32; ++i) otot[i] += sc * o[i];
        }
        {
            float m = -1e30f, l = 0.f, o[32];
#pragma unroll
            for (int i = 0; i < 32; ++i) o[i] = 0.f;
            const bf16* kg = PA + CA_KW + g * HD + dq * 32; const bf16* vg = PA + CA_VW + g * HD + dq * 32;
            const int klo = (4 * tq - 511 > 0) ? 4 * tq - 511 : 0, khi = 4 * tq + 3;
            for (int kp = klo; kp <= khi; ++kp) {
                const float s = dot32q(q, kg + (size_t)kp * NA) - slope * (float)(t - kp);
                const bool valid = kp <= t && (t - kp) < 512;
                OSM_STEP(s, valid, vg + (size_t)kp * NA);
            }
            const float sc = (l > 0.f) ? g2 / l : 0.f;
#pragma unroll
            for (int i = 0; i < 32; ++i) otot[i] += sc * o[i];
        }
        st32(MIX + (size_t)t * DM + head * HD + dq * 32, otot);
    }
}
__device__ __forceinline__ void mem_attn_naive(Frame& F, const bf16* P, int ldp, int qcol, const float* qg, int layer) {
    const bf16* MKV = WSP(bf16, WS_MKV); bf16* MIX = WSP(bf16, WS_MIX);
    const int gw = F.vcu * NWAVES + F.wave, NGW = F.G * NWAVES;
    const int dq = lane_of(F) & 3, r = lane_of(F) >> 2;
    for (int it = gw; it < NMEMH * (T / 16); it += NGW) {
        const int hm = it / (T / 16), t = 16 * (it % (T / 16)) + r;
        float q[32]; ld32(P + (size_t)t * ldp + qcol + hm * HD + dq * 32, q);
        float ss = 0.f;
#pragma unroll
        for (int i = 0; i < 32; ++i) ss += q[i] * q[i];
        ss += __shfl_xor(ss, 1); ss += __shfl_xor(ss, 2);
        const float rs = (1.0f / sqrtf(ss * (1.f / HD) + EPS)) * QSCALE;
#pragma unroll
        for (int i = 0; i < 32; ++i) q[i] = q[i] * rs * qg[dq * 32 + i];
        float m = -1e30f, l = 0.f, o[32];
#pragma unroll
        for (int i = 0; i < 32; ++i) o[i] = 0.f;
        const bf16* kg = MKV + layer * 1024 + hm * HD + dq * 32; const bf16* vg = kg + 512;
        for (int k = 0; k < MEMT; ++k) {
            const float s = dot32q(q, kg + (size_t)k * 2048);
            OSM_STEP(s, true, vg + (size_t)k * 2048);
        }
        const float sc = 1.0f / l;
#pragma unroll
        for (int i = 0; i < 32; ++i) o[i] *= sc;
        st32(MIX + (size_t)t * DM + NMIX * HD + hm * HD + dq * 32, o);
    }
}
__device__ __forceinline__ void stick_naive(Frame& F) {
    const bf16* PB = WSP(bf16, WS_PB); bf16* MIX = WSP(bf16, WS_MIX);
    const int gw = F.vcu * NWAVES + F.wave, NGW = F.G * NWAVES;
    const int dq = lane_of(F) & 3, r = lane_of(F) >> 2;
    for (int it = gw; it < NMIX * (T / 16); it += NGW) {
        const int h = it / (T / 16), t = 16 * (it % (T / 16)) + r;
        float q[32]; ld32(PB + (size_t)t * NB + CB_Q + h * HD + dq * 32, q);
#pragma unroll
        for (int i = 0; i < 32; ++i) q[i] *= QSCALE;
        float R = 0.f, o[32];
#pragma unroll
        for (int i = 0; i < 32; ++i) o[i] = 0.f;
        const bf16* kg = PB + CB_K + h * HD + dq * 32; const bf16* vg = PB + CB_V + h * HD + dq * 32;
        for (int i = 1; ; ++i) {
            const int s = t - i;
            const bool act = s >= 0 && R > -80.f;
            if (!__any(act)) break;
            const int sc = s >= 0 ? s : 0;
            const float z = dot32q(q, kg + (size_t)sc * NB);
            const float sp = fmaxf(z, 0.f) + __logf(1.0f + fast_exp(-fabsf(z)));
            if (act) { const float a = fast_exp(z - sp + R); axpy32(o, a, vg + (size_t)sc * NB); R -= sp; }
        }
        st32(MIX + (size_t)t * DM + h * HD + dq * 32, o);
    }
}

__device__ __forceinline__ void p12_router(Frame& F) {
    const float* X3 = WSP(float, WS_X3); bf16* XN = WSP(bf16, WS_XN);
    int* TOPI = (int*)(F.ws + WS_ROUTE + RT_TOPI); float* TOPW = (float*)(F.ws + WS_ROUTE + RT_TOPW); int* HIST = (int*)(F.ws + WS_ROUTE + RT_HIST);
    const float* rw = F.in[18]; const float* rb = F.in[19]; const float* gn = F.in[4] + DM;
    LAS int* hist = (LAS int*)(F.lds + RING_OFF);
    LAS float* GL = (LAS float*)(F.lds + RING_OFF + 1024);
    for (int i = F.tid; i < DM * 8; i += NWAVES * 64) { const int k = i >> 3, e = i & 7; GL[e * DM + k] = gn[k] * rw[i]; }
    __syncthreads();
    const int lane = lane_of(F);
    for (int c = F.vcu; c < 256; c += F.G) {
        if (F.tid < 8) hist[F.tid] = 0;
        __syncthreads();
#pragma unroll
        for (int ip = 0; ip < 2; ++ip) {
            f32x4 v[2][8];
#pragma unroll
            for (int u = 0; u < 2; ++u) { const f32x4* xr = (const f32x4*)(X3 + (size_t)(32 * c + 4 * F.wave + 2 * ip + u) * DM) + lane;
#pragma unroll
                for (int j = 0; j < 8; ++j) v[u][j] = xr[64 * j]; }
#pragma unroll
            for (int u = 0; u < 2; ++u) {
                const int t = 32 * c + 4 * F.wave + 2 * ip + u;
                float s = 0.f;
#pragma unroll
                for (int j = 0; j < 8; ++j) s += (v[u][j].x * v[u][j].x + v[u][j].y * v[u][j].y) + (v[u][j].z * v[u][j].z + v[u][j].w * v[u][j].w);
                const float rstd = 1.0f / sqrtf(wave_sum(s) * (1.f / DM) + EPS);
                v2u* o8 = (v2u*)(XN + (size_t)t * DM) + lane;
                float lg[8];
#pragma unroll
                for (int e = 0; e < 8; ++e) lg[e] = 0.f;
#pragma unroll
                for (int j = 0; j < 8; ++j) {
                    v2u w; w.x = pk2(v[u][j].x * rstd, v[u][j].y * rstd); w.y = pk2(v[u][j].z * rstd, v[u][j].w * rstd); o8[64 * j] = w;
#pragma unroll
                    for (int e = 0; e < 8; ++e) { const f32x4 gq = *(const LAS f32x4*)(GL + e * DM + 4 * (lane + 64 * j));
                        lg[e] += (v[u][j].x * gq.x + v[u][j].y * gq.y) + (v[u][j].z * gq.z + v[u][j].w * gq.w); }
                }
#pragma unroll
                for (int e = 0; e < 8; ++e) lg[e] = wave_sum(lg[e]) * rstd;
                if (lane == 0) {
                    int i0 = 0; float b0 = lg[0] + rb[0];
#pragma unroll
                    for (int e = 1; e < 8; ++e) { const float b = lg[e] + rb[e]; if (b > b0) { b0 = b; i0 = e; } }
                    int i1 = -1; float b1 = -3.0e38f;
#pragma unroll
                    for (int e = 0; e < 8; ++e) { const float b = lg[e] + rb[e]; if (e != i0 && b > b1) { b1 = b; i1 = e; } }
                    float l0 = 0.f, l1 = 0.f;
#pragma unroll
                    for (int e = 0; e < 8; ++e) { l0 = (e == i0) ? lg[e] : l0; l1 = (e == i1) ? lg[e] : l1; }
                    const float w0 = 1.0f / (1.0f + expf(l1 - l0));
                    TOPI[2 * t] = i0; TOPI[2 * t + 1] = i1; TOPW[2 * t] = w0; TOPW[2 * t + 1] = 1.0f - w0;
                    atomicAdd((int*)&hist[i0], 1); atomicAdd((int*)&hist[i1], 1);
                }
            }
        }
        __syncthreads();
        if (F.tid < 8) HIST[c * 8 + F.tid] = hist[F.tid];
        __syncthreads();
    }
}
__device__ __forceinline__ void p13_assign(Frame& F) {
    const bf16* XN = WSP(bf16, WS_XN); bf16* AM = WSP(bf16, WS_AMOE);
    const int* TOPI = (const int*)(F.ws + WS_ROUTE + RT_TOPI); int* ROW = (int*)(F.ws + WS_ROUTE + RT_ROW); const int* HIST = (const int*)(F.ws + WS_ROUTE + RT_HIST);
    int* TILE = (int*)(F.ws + WS_ROUTE + RT_TILE);
    LAS int* sh = (LAS int*)(F.lds + RING_OFF);
    for (int c = F.vcu; c < 256; c += F.G) {
        if (F.tid < 16) sh[16 + F.tid] = 0;
        __syncthreads();
        for (int i = F.tid; i < 2048; i += 512) { const int v = HIST[i], cc = i >> 3, ee = i & 7;
            __hip_atomic_fetch_add(&sh[16 + ee], v, __ATOMIC_RELAXED, __HIP_MEMORY_SCOPE_WORKGROUP);
            if (cc < c) __hip_atomic_fetch_add(&sh[24 + ee], v, __ATOMIC_RELAXED, __HIP_MEMORY_SCOPE_WORKGROUP); }
        __syncthreads();
        if (F.tid < 8) {
            const int e = F.tid; int off = 0;
            for (int ee = 0; ee < 8; ++ee) { if (ee == e) break; off += (sh[16 + ee] + 255) & ~255; }
            sh[e] = off + sh[24 + e];
            if (c == 0 && e == 0) {
                int nt = 0;
                for (int ee = 0; ee < 8; ++ee) { const int n = (sh[16 + ee] + 255) >> 8; for (int i = 0; i < n; ++i) TILE[16 + nt + i] = ee; nt += n; }
                TILE[0] = nt;
            }
        }
        __syncthreads();
        if (F.wave == 0) {
            const int tl = lane_of(F) >> 1, sl = lane_of(F) & 1, t = 32 * c + tl;
            const int e = TOPI[2 * t + sl];
            int row = 0;
            for (int ee = 0; ee < 8; ++ee) {
                const unsigned long long mk = __ballot(e == ee);
                if (e == ee) row = sh[ee] + __popcll(mk & ((1ull << lane_of(F)) - 1ull));
            }
            ROW[2 * t + sl] = row; sh[64 + lane_of(F)] = row;
        }
        __syncthreads();
        for (int i = 0; i < 8; ++i) {
            const int idx = 8 * F.wave + i, t = 32 * c + (idx >> 1), row = sh[64 + idx];
            const v4u* src = (const v4u*)(XN + (size_t)t * DM); v4u* dst = (v4u*)(AM + (size_t)row * DM);
#pragma unroll
            for (int j = 0; j < 4; ++j) dst[lane_of(F) + 64 * j] = src[lane_of(F) + 64 * j];
        }
        __syncthreads();
    }
}
__device__ __forceinline__ int moe_nsplit(int tail, int G) {
    const int cand[7] = {28, 14, 8, 7, 4, 2, 1};
    int s = 1;
#pragma unroll
    for (int i = 6; i >= 0; --i) if (tail * cand[i] <= G) s = cand[i];
    return s;
}
__device__ __forceinline__ void p16_combine(Frame& F, float dbg_scale) {
    const float* X3 = WSP(float, WS_X3); const bf16* Y = WSP(bf16, WS_YMOE); const float* SLAB = WSP(float, WS_SLAB);
    const int* ROW = (const int*)(F.ws + WS_ROUTE + RT_ROW); const float* TOPW = (const float*)(F.ws + WS_ROUTE + RT_TOPW); const int* TMAP = (const int*)(F.ctl + CW_TMAP);
    const int* TILE = (const int*)(F.ws + WS_ROUTE + RT_TILE);
    const int U = TILE[0] * (DM / 256), tail = U - (U / F.G) * F.G, nsp = tail > 0 ? moe_nsplit(tail, F.G) : 1;
    const int gw = F.vcu * NWAVES + F.wave, NGW = F.G * NWAVES, lane = lane_of(F);
    auto slab_sum = [&](const float* sp, float* d) {
        f32x4 u0 = {0.f, 0.f, 0.f, 0.f}, u1 = u0; int sI = 0;
        for (; sI + 4 <= nsp; sI += 4) {
            f32x4 p[8];
#pragma unroll
            for (int q = 0; q < 4; ++q) { p[2 * q] = *(const f32x4*)(sp + (size_t)(sI + q) * 65536); p[2 * q + 1] = *(const f32x4*)(sp + (size_t)(sI + q) * 65536 + 4); }
#pragma unroll
            for (int q = 0; q < 4; ++q) { u0 += p[2 * q]; u1 += p[2 * q + 1]; }
        }
        for (; sI < nsp; ++sI) { u0 += *(const f32x4*)(sp + (size_t)sI * 65536); u1 += *(const f32x4*)(sp + (size_t)sI * 65536 + 4); }
        d[0] = u0[0]; d[1] = u0[1]; d[2] = u0[2]; d[3] = u0[3]; d[4] = u1[0]; d[5] = u1[1]; d[6] = u1[2]; d[7] = u1[3];
    };
    for (int t = gw; t < T; t += NGW) {
        const int r0 = ROW[2 * t], r1 = ROW[2 * t + 1]; const float w0 = TOPW[2 * t], w1 = TOPW[2 * t + 1];
        const f32x4* xr = (const f32x4*)(X3 + (size_t)t * DM); f32x4* orow = (f32x4*)(F.out + (size_t)t * DM);
        int tm0[4], tm1[4]; v4u ya[4], yb[4]; f32x4 xa[4], xb[4];
#pragma unroll
        for (int j = 0; j < 4; ++j) {
            const int c8 = lane + 64 * j, pn = c8 >> 5;
            tm0[j] = TMAP[(r0 >> 8) * 8 + pn]; tm1[j] = TMAP[(r1 >> 8) * 8 + pn];
            ya[j] = *(const v4u*)(Y + (size_t)r0 * DM + 8 * c8); yb[j] = *(const v4u*)(Y + (size_t)r1 * DM + 8 * c8);
            xa[j] = xr[2 * c8]; xb[j] = xr[2 * c8 + 1];
        }
#pragma unroll
        for (int j = 0; j < 4; ++j) {
            const int c8 = lane + 64 * j, cc = (c8 & 31) * 8;
            float a[8], b[8];
            unpack8(ya[j], a); unpack8(yb[j], b);
            if (tm0[j] != 0) slab_sum(SLAB + (size_t)(tm0[j] - 1) * 65536 + (size_t)(r0 & 255) * 256 + cc, a);
            if (tm1[j] != 0) slab_sum(SLAB + (size_t)(tm1[j] - 1) * 65536 + (size_t)(r1 & 255) * 256 + cc, b);
            orow[2 * c8] = (f32x4){xa[j].x + w0 * a[0] + w1 * b[0], xa[j].y + w0 * a[1] + w1 * b[1], xa[j].z + w0 * a[2] + w1 * b[2], xa[j].w + w0 * a[3] + w1 * b[3]} * dbg_scale;
            orow[2 * c8 + 1] = (f32x4){xb[j].x + w0 * a[4] + w1 * b[4], xb[j].y + w0 * a[5] + w1 * b[5], xb[j].z + w0 * a[6] + w1 * b[6], xb[j].w + w0 * a[7] + w1 * b[7]} * dbg_scale;
        }
    }
}

namespace at {
typedef short bf16x8 __attribute__((ext_vector_type(8)));
typedef short s16x4 __attribute__((ext_vector_type(4)));
typedef float f32x16 __attribute__((ext_vector_type(16)));
constexpr int SHM_T = 16384;
constexpr int L_V = 0, L_K = 2 * SHM_T, L_WS = 4 * SHM_T, L_IMP = L_WS + 8 * 256, L_SEL = L_IMP + 64 * 128 * 4, L_PS = L_SEL + 1024, L_WU = L_PS + 8 * 2176, L_LIST = L_WU + 128, L_DONE = L_LIST + 512, L_END = L_DONE + 64;
static_assert(L_END <= RING_BYTES, "attention LDS map");
constexpr float C2 = 0.08838834764831845f * 1.4426950408889634f;
constexpr float LOG2E = 1.4426950408889634f;

#define KSWZ(row, colB) ((row) * 256 + ((colB) ^ (((row) & 7) << 4)))
#define SBAR() __builtin_amdgcn_sched_barrier(0)
__device__ __forceinline__ int v_st(int k, int c) { const int kk = (k & ~0xC) | ((k & 4) << 1) | ((k & 8) >> 1); return ((kk >> 3) * 4 + (c >> 5)) * 512 + ((kk & 7) * 32 + (c & 31)) * 2; }
__device__ __forceinline__ int v_rd_base(int lane) { return ((lane & 3) << 3) | (((lane >> 2) & 3) << 6) | (((lane >> 4) & 1) << 5) | (((lane >> 5) & 1) << 8); }
constexpr int v_rd_off(int d0, int ks, int half) { return d0 * 512 + ks * 4096 + half * 2048; }
__device__ __forceinline__ int crow(int r, int hi) { return (r & 3) + 8 * (r >> 2) + 4 * hi; }
__device__ __forceinline__ unsigned cvtpk(float lo, float hi) { unsigned r; asm volatile("v_cvt_pk_bf16_f32 %0, %1, %2" : "=v"(r) : "v"(lo), "v"(hi)); return r; }
__device__ __forceinline__ float xhalf_max(float v) { auto rr = __builtin_amdgcn_permlane32_swap(__float_as_uint(v), __float_as_uint(v), false, false); return fmaxf(__uint_as_float(rr[0]), __uint_as_float(rr[1])); }
__device__ __forceinline__ float xhalf_sum(float v) { auto rr = __builtin_amdgcn_permlane32_swap(__float_as_uint(v), __float_as_uint(v), false, false); return __uint_as_float(rr[0]) + __uint_as_float(rr[1]); }
__device__ __forceinline__ float quad_sum(float x) {
    x += __int_as_float(__builtin_amdgcn_update_dpp(0, __float_as_int(x), 0xB1, 0xF, 0xF, true));
    x += __int_as_float(__builtin_amdgcn_update_dpp(0, __float_as_int(x), 0x4E, 0xF, 0xF, true));
    return x;
}
__device__ __forceinline__ void pack_p(const f32x16& p0, const f32x16& p1, bf16x8& pa0, bf16x8& pa1, bf16x8& pa2, bf16x8& pa3) {
#define PK4(P, B_, OUT) do { unsigned a0 = cvtpk(P[B_+0], P[B_+1]), a1 = cvtpk(P[B_+2], P[B_+3]);                          \
        unsigned b0 = cvtpk(P[B_+4], P[B_+5]), b1 = cvtpk(P[B_+6], P[B_+7]);                                             \
        auto r0 = __builtin_amdgcn_permlane32_swap(a0, b0, false, false); auto r1 = __builtin_amdgcn_permlane32_swap(a1, b1, false, false); \
        v4u w = {r0[0], r1[0], r0[1], r1[1]}; OUT = *reinterpret_cast<bf16x8*>(&w); } while (0)
    PK4(p0, 0, pa0); PK4(p0, 8, pa1); PK4(p1, 0, pa2); PK4(p1, 8, pa3);
#undef PK4
}
template <int KB>
__device__ __forceinline__ void qkt(f32x16& p0, f32x16& p1, LAS unsigned char* lds, int r32, int hi, const bf16x8* qr) {
    p0 = f32x16{}; p1 = f32x16{};
    LAS unsigned char* kb[4];
#pragma unroll
    for (int dd = 0; dd < 4; ++dd) kb[dd] = lds + L_K + KB * SHM_T + KSWZ(r32, (dd * 16 + hi * 8) * 2);
#pragma unroll
    for (int d0 = 0; d0 < 8; ++d0) { LAS unsigned char* a = kb[d0 & 3] + (d0 >> 2) * 128;
        const bf16x8 b0 = *(const LAS bf16x8*)a;
        const bf16x8 b1 = *(const LAS bf16x8*)(a + 32 * 256);
        p0 = __builtin_amdgcn_mfma_f32_32x32x16_bf16(b0, qr[d0], p0, 0, 0, 0);
        p1 = __builtin_amdgcn_mfma_f32_32x32x16_bf16(b1, qr[d0], p1, 0, 0, 0); }
}
template <int VB>
__device__ __forceinline__ void pv_tile(f32x16* o, int vb0, bf16x8 pa0, bf16x8 pa1, bf16x8 pa2, bf16x8 pa3) {
#define TRRD(dst, off) asm volatile("ds_read_b64_tr_b16 %0, %1 offset:%2" : "=&v"(dst) : "v"(vb0), "i"(off) : "memory")
#define PV_RD(S_, d0) do { constexpr int b_ = VB * SHM_T + v_rd_off(d0, 0, 0); \
        TRRD(S_##l0, b_); TRRD(S_##h0, b_ + 2048); TRRD(S_##l1, b_ + 4096); TRRD(S_##h1, b_ + 6144); TRRD(S_##l2, b_ + 8192); TRRD(S_##h2, b_ + 10240); TRRD(S_##l3, b_ + 12288); TRRD(S_##h3, b_ + 14336); } while (0)
#define PV_MM(S_, d0) do { \
        o[d0] = __builtin_amdgcn_mfma_f32_32x32x16_bf16(pa0, (bf16x8){S_##l0[0], S_##l0[1], S_##l0[2], S_##l0[3], S_##h0[0], S_##h0[1], S_##h0[2], S_##h0[3]}, o[d0], 0, 0, 0);   \
        o[d0] = __builtin_amdgcn_mfma_f32_32x32x16_bf16(pa1, (bf16x8){S_##l1[0], S_##l1[1], S_##l1[2], S_##l1[3], S_##h1[0], S_##h1[1], S_##h1[2], S_##h1[3]}, o[d0], 0, 0, 0);   \
        o[d0] = __builtin_amdgcn_mfma_f32_32x32x16_bf16(pa2, (bf16x8){S_##l2[0], S_##l2[1], S_##l2[2], S_##l2[3], S_##h2[0], S_##h2[1], S_##h2[2], S_##h2[3]}, o[d0], 0, 0, 0);   \
        o[d0] = __builtin_amdgcn_mfma_f32_32x32x16_bf16(pa3, (bf16x8){S_##l3[0], S_##l3[1], S_##l3[2], S_##l3[3], S_##h3[0], S_##h3[1], S_##h3[2], S_##h3[3]}, o[d0], 0, 0, 0); } while (0)
    s16x4 Al0, Al1, Al2, Al3, Ah0, Ah1, Ah2, Ah3, Bl0, Bl1, Bl2, Bl3, Bh0, Bh1, Bh2, Bh3;
    PV_RD(A, 0);
    PV_RD(B, 1); asm volatile("s_waitcnt lgkmcnt(8)" ::: "memory"); SBAR(); PV_MM(A, 0); SBAR();
    PV_RD(A, 2); asm volatile("s_waitcnt lgkmcnt(8)" ::: "memory"); SBAR(); PV_MM(B, 1); SBAR();
    PV_RD(B, 3); asm volatile("s_waitcnt lgkmcnt(8)" ::: "memory"); SBAR(); PV_MM(A, 2); SBAR();
    asm volatile("s_waitcnt lgkmcnt(0)" ::: "memory"); SBAR(); PV_MM(B, 3);
#undef PV_MM
#undef PV_RD
#undef TRRD
}
struct Stg { v4u a, b; };
struct Tile { const bf16* K; const bf16* V; size_t ld; };
__device__ __forceinline__ void stg_load(Stg& S, const bf16* base, size_t ld, int sr, int sc) {
    S.a = *(const v4u*)(base + (size_t)sr * ld + sc); S.b = *(const v4u*)(base + (size_t)(32 + sr) * ld + sc);
}
template <int BUF> __device__ __forceinline__ void stg_write_k(const Stg& S, LAS unsigned char* lds, int sr, int sc) {
    const int kws = KSWZ(sr, sc * 2);
    *(LAS v4u*)(lds + L_K + BUF * SHM_T + kws) = S.a; *(LAS v4u*)(lds + L_K + BUF * SHM_T + kws + 32 * 256) = S.b;
}
template <int BUF> __device__ __forceinline__ void stg_write_v(const Stg& S, LAS unsigned char* lds, int sr, int sc) {
    *(LAS v4u*)(lds + L_V + BUF * SHM_T + v_st(sr, sc)) = S.a; *(LAS v4u*)(lds + L_V + BUF * SHM_T + v_st(32 + sr, sc)) = S.b;
}

template <int PASS, int KB, class Br>
__device__ __forceinline__ void step(Br& br, int i, Stg& SK, Stg& SV, LAS unsigned char* lds, int tid, const bf16x8* qr, float& m2, float& l, float f, f32x16* o) {
    int tz = tid; asm volatile("" : "+v"(tz));
    const int lane = tz & 63, sr = tz >> 4, sc = (tz & 15) * 8, r32 = lane & 31, hi = lane >> 5;
    const int vb0 = (int)(uintptr_t)(lds + L_V) + v_rd_base(lane);
    if (i + 1 < br.nt) {
        stg_write_k<KB ^ 1>(SK, lds, sr, sc);
        if (PASS >= 2) stg_write_v<KB ^ 1>(SV, lds, sr, sc);
        if (i + 2 < br.nt) { const Tile nx = br.tile(i + 2); stg_load(SK, nx.K, nx.ld, sr, sc); if (PASS >= 2) stg_load(SV, nx.V, nx.ld, sr, sc); }
    }
    SBAR();
    if (br.act(i)) {
        f32x16 p0, p1;
        qkt<KB>(p0, p1, lds, r32, hi, qr);
        SBAR();
        if (PASS == 3) br.probs(p0, p1, i, lane, m2); else br.scores(p0, p1, i, lane);
        if (PASS == 1) {
            float pmax = p0[0];
#pragma unroll
            for (int r = 1; r < 16; ++r) pmax = fmaxf(pmax, p0[r]);
#pragma unroll
            for (int r = 0; r < 16; ++r) pmax = fmaxf(pmax, p1[r]);
            pmax = xhalf_max(pmax);
            const float mn = fmaxf(m2, pmax);
            float ps = 0.f;
#pragma unroll
            for (int r = 0; r < 16; ++r) ps += __builtin_amdgcn_exp2f(p0[r] - mn) + __builtin_amdgcn_exp2f(p1[r] - mn);
            ps = xhalf_sum(ps);
            l = l * __builtin_amdgcn_exp2f(m2 - mn) + ps; m2 = mn;
        } else {
            if (PASS == 2) {
#pragma unroll
                for (int r = 0; r < 16; ++r) { p0[r] = __builtin_amdgcn_exp2f(p0[r] - m2) * f; p1[r] = __builtin_amdgcn_exp2f(p1[r] - m2) * f; }
                br.hook(p0, p1, i, lane);
            } else {
                float ps = 0.f;
#pragma unroll
                for (int r = 0; r < 16; ++r) ps += p0[r] + p1[r];
                l += xhalf_sum(ps);
            }
            SBAR();
            bf16x8 pa0, pa1, pa2, pa3; pack_p(p0, p1, pa0, pa1, pa2, pa3);
            SBAR();
            pv_tile<KB>(o, vb0, pa0, pa1, pa2, pa3);
        }
    }
    __syncthreads();
}
template <int PASS, class Br>
__device__ __forceinline__ void run_pass(Br& br, LAS unsigned char* lds, int tid, const bf16x8* qr, float& m2, float& l, float f, f32x16* o) {
    if (br.nt <= 0) return;
    const int sr = tid >> 4, sc = (tid & 15) * 8;
    Stg SK, SV;
    { const Tile t0 = br.tile(0); stg_load(SK, t0.K, t0.ld, sr, sc); if (PASS >= 2) stg_load(SV, t0.V, t0.ld, sr, sc);
      stg_write_k<0>(SK, lds, sr, sc); if (PASS >= 2) stg_write_v<0>(SV, lds, sr, sc); }
    if (br.nt > 1) { const Tile t1 = br.tile(1); stg_load(SK, t1.K, t1.ld, sr, sc); if (PASS >= 2) stg_load(SV, t1.V, t1.ld, sr, sc); }
    __syncthreads();
    for (int i = 0; i < br.nt; i += 2) {
        step<PASS, 0>(br, i, SK, SV, lds, tid, qr, m2, l, f, o);
        if (i + 1 < br.nt) step<PASS, 1>(br, i + 1, SK, SV, lds, tid, qr, m2, l, f, o);
    }
}
__device__ __forceinline__ void scale_rows(f32x16* o, float frow, LAS float* ws, int lane) {
    const int r32 = lane & 31, hi = lane >> 5;
    if (hi == 0) ws[r32] = frow;
    LDS_WAIT(); asm volatile("" ::: "memory");
#pragma unroll
    for (int r = 0; r < 16; ++r) { const float a = ws[crow(r, hi)];
#pragma unroll
        for (int d0 = 0; d0 < 4; ++d0) o[d0][r] *= a; }
    LDS_WAIT(); asm volatile("" ::: "memory");
}
__device__ __forceinline__ float gain_absmax(const float* g, int lane) {
    float a = fmaxf(fabsf(g[lane]), fabsf(g[lane + 64]));
#pragma unroll
    for (int o = 1; o < 64; o <<= 1) a = fmaxf(a, __shfl_xor(a, o));
    return __uint_as_float((unsigned)__builtin_amdgcn_readfirstlane((int)__float_as_uint(a)));
}
__device__ __forceinline__ void o_store(const f32x16* o, float* blk, int lane) {
#pragma unroll
    for (int d0 = 0; d0 < 4; ++d0) {
        float* b = blk + d0 * 1024 + lane; asm volatile("" : "+v"(b));
#pragma unroll
        for (int r = 0; r < 16; ++r) b[r * 64] = o[d0][r];
    }
}
__device__ __forceinline__ void o_addload(f32x16* o, const float* blk, int lane) {
#pragma unroll
    for (int d0 = 0; d0 < 4; ++d0) {
        const float* b = blk + d0 * 1024 + lane; asm volatile("" : "+v"(b));
#pragma unroll
        for (int r = 0; r < 16; ++r) o[d0][r] += b[r * 64];
        asm volatile("" : "+v"(o[d0]) :: "memory");
    }
}
__device__ __forceinline__ void load_q(bf16x8* qr, const bf16* qrow, int hi) {
#pragma unroll
    for (int d0 = 0; d0 < 8; ++d0) { const v4u w = *(const v4u*)(qrow + d0 * 16 + hi * 8); qr[d0] = *reinterpret_cast<const bf16x8*>(&w); }
}

struct RowNsa { int t; float slope2; };
struct BrCmp {
    int nt; const bf16* K; const bf16* V; int jmax_w; RowNsa R;
    LAS float* ps; LAS float* imp;
    __device__ __forceinline__ Tile tile(int i) const { return Tile{K + (size_t)i * 64 * HD, V + (size_t)i * 64 * HD, (size_t)HD}; }
    __device__ __forceinline__ bool act(int i) const { return 64 * i <= jmax_w; }
    __device__ __forceinline__ void scores(f32x16& p0, f32x16& p1, int i, int lane) const {
        const float NEG = -__builtin_inff(); const int hi = lane >> 5;
        float sl = R.slope2; asm volatile("" : "+v"(sl));
        int tt = R.t; asm volatile("" : "+v"(tt));
        const int jmax = (tt >= 31) ? ((tt - 31) >> 4) : -1;
        const int jm = jmax - 64 * i - 4 * hi;
        const float b0 = -sl * (float)(tt - 31 - 16 * (64 * i + 4 * hi));
#pragma unroll
        for (int r = 0; r < 16; ++r) { const int c = (r & 3) + 8 * (r >> 2);
            p0[r] = (c <= jm) ? fmaf(p0[r], C2, fmaf(sl, (float)(16 * c), b0)) : NEG;
            p1[r] = (c + 32 <= jm) ? fmaf(p1[r], C2, fmaf(sl, (float)(16 * c + 512), b0)) : NEG; }
    }
    __device__ __forceinline__ void probs(f32x16&, f32x16&, int, int, float) const {}
    __device__ __forceinline__ void hook(const f32x16& p0, const f32x16& p1, int i, int lane) const {
        const int r32 = lane & 31, hi = lane >> 5, pp = r32 & 3, ql = r32 >> 2;
#pragma unroll
        for (int qd = 0; qd < 4; ++qd) {
            f32x4 a, b;
#pragma unroll
            for (int e = 0; e < 4; ++e) { a[e] = quad_sum(p0[4 * qd + e]); b[e] = quad_sum(p1[4 * qd + e]); }
            if (pp == qd) { *(LAS f32x4*)(ps + ql * 68 + 4 + 8 * qd + 4 * hi) = a; *(LAS f32x4*)(ps + ql * 68 + 4 + 32 + 8 * qd + 4 * hi) = b; }
        }
        LDS_WAIT(); asm volatile("" ::: "memory");
#pragma unroll
        for (int h2 = 0; h2 < 2; ++h2) { const int idx = lane + 64 * h2, q8 = idx >> 4, mq = idx & 15;
            const f32x4 v = *(const LAS f32x4*)(ps + q8 * 68 + 4 + 4 * mq); const float pv = ps[q8 * 68 + 3 + 4 * mq];
            imp[q8 * 128 + 16 * i + mq] = (v[0] + v[1]) + (v[2] + v[3]) + pv; }
        LDS_WAIT(); asm volatile("" ::: "memory");
        if (lane < 8) ps[lane * 68 + 3] = ps[lane * 68 + 4 + 63];
        LDS_WAIT(); asm volatile("" ::: "memory");
    }
};
struct BrSlc {
    int nt; const bf16* K; const bf16* V; RowNsa R; int cur;
    const LAS int* list; const LAS unsigned long long* sel; const LAS unsigned long long* wu;
    __device__ __forceinline__ int blk(int i) const { return list[i]; }
    __device__ __forceinline__ Tile tile(int i) const { const int b = __builtin_amdgcn_readfirstlane(blk(i)); return Tile{K + (size_t)b * 64 * NA, V + (size_t)b * 64 * NA, (size_t)NA}; }
    __device__ __forceinline__ bool act(int i) const { const int b = __builtin_amdgcn_readfirstlane(blk(i)); const unsigned long long u = wu[b >> 6]; return (u >> (b & 63)) & 1ull; }
    __device__ __forceinline__ void scores(f32x16& p0, f32x16& p1, int i, int lane) const {
        const float NEG = -__builtin_inff(); const int b = __builtin_amdgcn_readfirstlane(blk(i)); const int hi = lane >> 5, ql = (lane & 31) >> 2;
        const unsigned long long mm = sel[ql * 2 + (b >> 6)];
        const bool mine = (mm >> (b & 63)) & 1ull;
        float sl = R.slope2; asm volatile("" : "+v"(sl));
        int tt = R.t; asm volatile("" : "+v"(tt));
        const int dm = mine ? (tt - 64 * b - 4 * hi) : -1;
        const float b0 = -sl * (float)dm;
#pragma unroll
        for (int r = 0; r < 16; ++r) { const int c = (r & 3) + 8 * (r >> 2);
            p0[r] = (c <= dm) ? fmaf(p0[r], C2, fmaf(sl, (float)c, b0)) : NEG;
            p1[r] = (c + 32 <= dm) ? fmaf(p1[r], C2, fmaf(sl, (float)(c + 32), b0)) : NEG; }
    }
    __device__ __forceinline__ void probs(f32x16& p0, f32x16& p1, int i, int lane, float m2) const {
        const int b = __builtin_amdgcn_readfirstlane(blk(i)); const int hi = lane >> 5, ql = (lane & 31) >> 2;
        const unsigned long long mm = sel[ql * 2 + (b >> 6)];
        const bool mine = (mm >> (b & 63)) & 1ull;
        float sl = R.slope2; asm volatile("" : "+v"(sl));
        int tt = R.t; asm volatile("" : "+v"(tt));
        const int dm = tt - 64 * b - 4 * hi;
        const float base = mine ? (-sl * (float)dm - m2) : -__builtin_inff();
        if (b < cur) {
#pragma unroll
            for (int r = 0; r < 16; ++r) { const int c = (r & 3) + 8 * (r >> 2);
                p0[r] = __builtin_amdgcn_exp2f(fmaf(p0[r], C2, fmaf(sl, (float)c, base)));
                p1[r] = __builtin_amdgcn_exp2f(fmaf(p1[r], C2, fmaf(sl, (float)(c + 32), base))); }
        } else {
#pragma unroll
            for (int r = 0; r < 16; ++r) { const int c = (r & 3) + 8 * (r >> 2);
                p0[r] = (c <= dm) ? __builtin_amdgcn_exp2f(fmaf(p0[r], C2, fmaf(sl, (float)c, base))) : 0.f;
                p1[r] = (c + 32 <= dm) ? __builtin_amdgcn_exp2f(fmaf(p1[r], C2, fmaf(sl, (float)(c + 32), base))) : 0.f; }
        }
    }
    __device__ __forceinline__ void hook(const f32x16&, const f32x16&, int, int) const {}
};
struct BrWin {
    int nt; const bf16* K; const bf16* V; RowNsa R; int kb0, tw;
    __device__ __forceinline__ Tile tile(int i) const { return Tile{K + (size_t)(kb0 + i) * 64 * NA, V + (size_t)(kb0 + i) * 64 * NA, (size_t)NA}; }
    __device__ __forceinline__ bool act(int) const { return true; }
    __device__ __forceinline__ void scores(f32x16& p0, f32x16& p1, int i, int lane) const {
        const float NEG = -__builtin_inff(); const int hi = lane >> 5;
        float sl = R.slope2; asm volatile("" : "+v"(sl));
        int tt = R.t; asm volatile("" : "+v"(tt));
        const int dm = tt - 64 * (kb0 + i) - 4 * hi;
        const float b0 = -sl * (float)dm;
#pragma unroll
        for (int r = 0; r < 16; ++r) { const int c = (r & 3) + 8 * (r >> 2);
            p0[r] = ((unsigned)(dm - c) < 512u) ? fmaf(p0[r], C2, fmaf(sl, (float)c, b0)) : NEG;
            p1[r] = ((unsigned)(dm - c - 32) < 512u) ? fmaf(p1[r], C2, fmaf(sl, (float)(c + 32), b0)) : NEG; }
    }
    __device__ __forceinline__ void probs(f32x16& p0, f32x16& p1, int i, int lane, float m2) const {
        const int hi = lane >> 5;
        float sl = R.slope2; asm volatile("" : "+v"(sl));
        int tt = R.t; asm volatile("" : "+v"(tt));
        const int kb = kb0 + i, dm = tt - 64 * kb - 4 * hi;
        const float base = -sl * (float)dm - m2;
        if (64 * kb + 63 <= tw && 64 * kb >= tw + 7 - 511) {
#pragma unroll
            for (int r = 0; r < 16; ++r) { const int c = (r & 3) + 8 * (r >> 2);
                p0[r] = __builtin_amdgcn_exp2f(fmaf(p0[r], C2, fmaf(sl, (float)c, base)));
                p1[r] = __builtin_amdgcn_exp2f(fmaf(p1[r], C2, fmaf(sl, (float)(c + 32), base))); }
        } else {
#pragma unroll
            for (int r = 0; r < 16; ++r) { const int c = (r & 3) + 8 * (r >> 2);
                p0[r] = ((unsigned)(dm - c) < 512u) ? __builtin_amdgcn_exp2f(fmaf(p0[r], C2, fmaf(sl, (float)c, base))) : 0.f;
                p1[r] = ((unsigned)(dm - c - 32) < 512u) ? __builtin_amdgcn_exp2f(fmaf(p1[r], C2, fmaf(sl, (float)(c + 32), base))) : 0.f; }
        }
    }
    __device__ __forceinline__ void hook(const f32x16&, const f32x16&, int, int) const {}
};
struct BrMem {
    int nt; const bf16* K; const bf16* V;
    __device__ __forceinline__ Tile tile(int i) const { return Tile{K + (size_t)i * 64 * 2048, V + (size_t)i * 64 * 2048, (size_t)2048}; }
    __device__ __forceinline__ bool act(int) const { return true; }
    __device__ __forceinline__ void scores(f32x16& p0, f32x16& p1, int, int) const {
#pragma unroll
        for (int r = 0; r < 16; ++r) { p0[r] *= C2; p1[r] *= C2; }
    }
    __device__ __forceinline__ void probs(f32x16& p0, f32x16& p1, int, int, float m2) const {
#pragma unroll
        for (int r = 0; r < 16; ++r) { p0[r] = __builtin_amdgcn_exp2f(fmaf(p0[r], C2, -m2)); p1[r] = __builtin_amdgcn_exp2f(fmaf(p1[r], C2, -m2)); }
    }
    __device__ __forceinline__ void hook(const f32x16&, const f32x16&, int, int) const {}
};
template <class RP> __device__ __forceinline__ void store_o(const f32x16* o, int lane, RP rowptr) {
    const int r32 = lane & 31, hi = lane >> 5;
#pragma unroll
    for (int r = 0; r < 16; ++r) { bf16* rp = rowptr(crow(r, hi));
#pragma unroll
        for (int d0 = 0; d0 < 4; ++d0) { const float v = o[d0][r]; const float vn = __shfl_xor(v, 1);
            if ((r32 & 1) == 0) *(unsigned*)(rp + d0 * 32 + r32) = cvtpk(v, vn); } }
}
}

__device__ __forceinline__ void topk_select(unsigned k0, unsigned k1, int need, int lane, unsigned long long& s0, unsigned long long& s1) {
    unsigned thr = 0u;
    for (int bit = 31; bit >= 0; --bit) {
        const unsigned cand = thr | (1u << bit);
        const int cnt = __popcll(__ballot(k0 >= cand)) + __popcll(__ballot(k1 >= cand));
        if (cnt >= need) thr = cand;
    }
    const unsigned long long g0 = __ballot(k0 > thr), g1 = __ballot(k1 > thr), e0 = __ballot(k0 == thr && thr != 0u), e1 = __ballot(k1 == thr && thr != 0u);
    const int rem = need - (__popcll(g0) + __popcll(g1));
    const unsigned long long lt = (1ull << lane) - 1ull;
    const bool t0 = (k0 == thr && thr != 0u) && (__popcll(e0 & lt) < rem);
    const bool t1 = (k1 == thr && thr != 0u) && (__popcll(e0) + __popcll(e1 & lt) < rem);
    s0 = g0 | __ballot(t0); s1 = g1 | __ballot(t1);
}

__device__ __forceinline__ void nsa_item(Frame& F, int g, int qb, float mb_cmp, float mb_slc, float mb_win) {
    using namespace at;
    LAS unsigned char* lds = F.lds + RING_OFF;
    const bf16* PA = WSP(bf16, WS_PA); const bf16* KC = WSP(bf16, WS_KCMP) + (size_t)g * NCMP_P * HD; const bf16* VC = KC + (size_t)NG * NCMP_P * HD; bf16* MIX = WSP(bf16, WS_MIX);
    int tz = F.tid; asm volatile("" : "+v"(tz));
    const int lane = tz & 63, w = F.wave, r32 = lane & 31, hi = lane >> 5;
    const int t0 = 64 * qb, tw = t0 + 8 * w, ql = r32 >> 2, pp = r32 & 3, t = tw + ql, head = 4 * g + pp;
    LAS float* ws = (LAS float*)(lds + L_WS + w * 256);
    LAS float* IMP = (LAS float*)(lds + L_IMP) + w * 8 * 128;
    LAS float* PS = (LAS float*)(lds + L_PS + w * 2176);
    LAS unsigned long long* SEL = (LAS unsigned long long*)(lds + L_SEL);
    LAS unsigned long long* WU = (LAS unsigned long long*)(lds + L_WU);
    LAS int* LIST = (LAS int*)(lds + L_LIST);
    float* oacc = WSP(float, WS_OACC) + ((size_t)((g * 128 + qb) * 8 + w)) * 4096;
    RowNsa R; R.t = t; R.slope2 = exp2f(-8.0f * (float)(head + 1) / 12.0f) * LOG2E;
    int i0c, bmin;
    { const float slope_min2 = exp2f(-8.0f * (float)(4 * g + 4) / 12.0f) * LOG2E;
      const int Dc = (int)((149.f + 2.f * mb_cmp) / slope_min2) + 17, xc = t0 - Dc - 1039;
      const int Ds = (int)((149.f + 2.f * mb_slc) / slope_min2) + 2, xs = t0 - Ds - 63;
      i0c = __builtin_amdgcn_readfirstlane(xc > 0 ? (xc + 1023) / 1024 : 0); bmin = __builtin_amdgcn_readfirstlane(xs > 0 ? (xs + 63) / 64 : 0); }
    bf16x8 qr[8]; load_q(qr, PA + (size_t)t * NA + CA_Q + head * HD, hi);
#define GATE(br_) (1.0f / (1.0f + fast_exp(-bf2f(PA[(size_t)t * NA + CA_GT + head * 3 + (br_)]))))
    f32x16 o[4] = {};
    for (int i = lane; i < 8 * 128; i += 64) IMP[i] = 0.f;
    if (lane < 8) PS[lane * 68 + 3] = 0.f;
    LDS_WAIT(); asm volatile("" ::: "memory");
    {
        const int jmax_b = (t0 + 63 - 31) / 16;
        const int ntf = jmax_b / 64 + 1, i0 = i0c < ntf - 1 ? i0c : ntf - 1;
        BrCmp br; br.K = KC + (size_t)i0 * 64 * HD; br.V = VC + (size_t)i0 * 64 * HD; br.R = R; br.R.t = t - 1024 * i0; br.ps = PS; br.imp = IMP + 16 * i0;
        br.jmax_w = ((tw + 7 >= 31) ? (tw + 7 - 31) / 16 : -1) - 64 * i0;
        br.nt = ntf - i0;
        float m2 = -1e30f, l = 0.f;
        run_pass<1>(br, lds, tz, qr, m2, l, 0.f, o);
        const float f = (l > 0.f) ? 1.0f / l : 0.f;
        run_pass<2>(br, lds, tz, qr, m2, l, f, o);
        scale_rows(o, GATE(0), ws, lane);
        o_store(o, oacc, lane);
#pragma unroll
        for (int d0 = 0; d0 < 4; ++d0) o[d0] = f32x16{};
    }
    for (int qq = 0; qq < 8; ++qq) {
        const int tt = tw + qq, cur = tt >> 6;
        const int b0 = lane, b1 = lane + 64;
        unsigned long long s0 = 0ull, s1 = 0ull;
        const int ncand = cur - 1;
        const bool c0 = (b0 >= 1 && b0 < cur), c1 = (b1 < cur);
        if (ncand <= 14) { s0 = __ballot(c0); s1 = __ballot(c1); }
        else {
            const unsigned k0 = c0 ? (__float_as_uint(IMP[qq * 128 + b0]) + 1u) : 0u, k1 = c1 ? (__float_as_uint(IMP[qq * 128 + b1]) + 1u) : 0u;
            topk_select(k0, k1, 14, lane, s0, s1);
        }
        s0 |= 1ull;
        if (cur < 64) s0 |= (1ull << cur); else s1 |= (1ull << (cur - 64));
        if (lane == 0) { SEL[(8 * w + qq) * 2] = s0; SEL[(8 * w + qq) * 2 + 1] = s1; }
    }
    LDS_WAIT(); asm volatile("" ::: "memory");
    unsigned long long wu0 = 0ull, wu1 = 0ull;
#pragma unroll
    for (int qq = 0; qq < 8; ++qq) { wu0 |= SEL[(8 * w + qq) * 2]; wu1 |= SEL[(8 * w + qq) * 2 + 1]; }
    if (lane == 0) { WU[2 * w] = wu0; WU[2 * w + 1] = wu1; }
    __syncthreads();
    int nsl = 0;
    {
        unsigned long long u0 = 0ull, u1 = 0ull;
#pragma unroll
        for (int ww = 0; ww < 8; ++ww) { u0 |= WU[2 * ww]; u1 |= WU[2 * ww + 1]; }
        if (bmin >= 64) { u0 = 0ull; u1 &= ~((1ull << (bmin - 64)) - 1ull); } else if (bmin > 0) u0 &= ~((1ull << bmin) - 1ull);
        nsl = __popcll(u0) + __popcll(u1);
        if (w == 0) {
            const unsigned long long lt = (1ull << lane) - 1ull;
            if ((u0 >> lane) & 1ull) LIST[__popcll(u0 & lt)] = lane;
            if ((u1 >> lane) & 1ull) LIST[__popcll(u0) + __popcll(u1 & lt)] = lane + 64;
        }
    }
    __syncthreads();
    {
        BrSlc br; br.K = PA + CA_KS + g * HD; br.V = PA + CA_VS + g * HD; br.R = R; br.list = LIST; br.nt = nsl; br.cur = qb;
        br.sel = SEL + 16 * w; br.wu = WU + 2 * w;
        float m2 = mb_slc, l = 0.f;
        run_pass<3>(br, lds, tz, qr, m2, l, 0.f, o);
        scale_rows(o, (l > 0.f) ? GATE(1) / l : 0.f, ws, lane);
        o_addload(o, oacc, lane); o_store(o, oacc, lane);
#pragma unroll
        for (int d0 = 0; d0 < 4; ++d0) o[d0] = f32x16{};
    }
    {
        BrWin br; br.K = PA + CA_KW + g * HD; br.V = PA + CA_VW + g * HD; br.R = R; br.tw = tw;
        br.kb0 = (t0 - 511 > 0) ? ((t0 - 511) >> 6) : 0; br.nt = qb - br.kb0 + 1;
        float m2 = mb_win, l = 0.f;
        run_pass<3>(br, lds, tz, qr, m2, l, 0.f, o);
        scale_rows(o, (l > 0.f) ? GATE(2) / l : 0.f, ws, lane);
        o_addload(o, oacc, lane);
    }
    store_o(o, lane, [&](int row) { return MIX + (size_t)(tw + (row >> 2)) * DM + (4 * g + (row & 3)) * HD; });
#undef GATE
}
__device__ __forceinline__ void mem_item(Frame& F, const bf16* P, int ldp, int qcol, const float* qg, int layer, int hm, int qb, float mb_mem) {
    using namespace at;
    LAS unsigned char* lds = F.lds + RING_OFF;
    const bf16* MKV = WSP(bf16, WS_MKV); bf16* MIX = WSP(bf16, WS_MIX);
    int tz = F.tid; asm volatile("" : "+v"(tz));
    const int lane = tz & 63, w = F.wave, r32 = lane & 31, hi = lane >> 5;
    const int tw = 256 * qb + 32 * w, t = tw + r32;
    bf16x8 qr[8];
    {
        const bf16* qrow = P + (size_t)t * ldp + qcol + hm * HD;
        float qf[64]; float ss = 0.f;
#pragma unroll
        for (int d0 = 0; d0 < 8; ++d0) { const v4u wv = *(const v4u*)(qrow + d0 * 16 + hi * 8); unpack8(wv, qf + 8 * d0); }
#pragma unroll
        for (int i = 0; i < 64; ++i) ss += qf[i] * qf[i];
        ss = xhalf_sum(ss);
        const float rs = 1.0f / sqrtf(ss * (1.f / HD) + EPS);
#pragma unroll
        for (int d0 = 0; d0 < 8; ++d0) { const float* gp = qg + d0 * 16 + hi * 8;
            v4u wv; wv.x = cvtpk(qf[8 * d0] * rs * gp[0], qf[8 * d0 + 1] * rs * gp[1]); wv.y = cvtpk(qf[8 * d0 + 2] * rs * gp[2], qf[8 * d0 + 3] * rs * gp[3]);
            wv.z = cvtpk(qf[8 * d0 + 4] * rs * gp[4], qf[8 * d0 + 5] * rs * gp[5]); wv.w = cvtpk(qf[8 * d0 + 6] * rs * gp[6], qf[8 * d0 + 7] * rs * gp[7]);
            qr[d0] = *reinterpret_cast<const bf16x8*>(&wv); }
    }
    f32x16 o[4] = {};
    BrMem br; br.nt = 4; br.K = MKV + layer * 1024 + hm * HD; br.V = br.K + 512;
    float m2 = mb_mem, l = 0.f;
    run_pass<3>(br, lds, tz, qr, m2, l, 0.f, o);
    scale_rows(o, 1.0f / l, (LAS float*)(lds + L_WS + w * 256), lane);
    store_o(o, lane, [&](int row) { return MIX + (size_t)(tw + row) * DM + NMIX * HD + hm * HD; });
}
__device__ __forceinline__ void p3_attn(Frame& F) {
    const int ln = lane_of(F);
    using at::gain_absmax; using at::C2;
    const float gq = gain_absmax(F.in[8], ln);
    const float mb_slc = 128.f * C2 * 1.01f * gq * gain_absmax(F.in[9] + HD, ln), mb_win = 128.f * C2 * 1.01f * gq * gain_absmax(F.in[9] + 2 * HD, ln);
    const float mb_cmp = 128.f * C2 * 1.01f * gq * gain_absmax(F.in[9], ln);
    const float mb_mem = 128.f * C2 * 1.01f * gain_absmax(F.in[14], ln) * gain_absmax(F.in[14] + HD, ln);
    if (F.G == 256) {
        if (F.vcu < 192) { for (int it = F.vcu; it < 384; it += 192) { const int g = it % 3, qb = 127 - it / 3; nsa_item(F, g, qb, mb_cmp, mb_slc, mb_win); __syncthreads(); } }
        else { for (int j = F.vcu - 192; j < 128; j += 64) { mem_item(F, WSP(bf16, WS_PA), NA, CA_QM, F.in[14], 0, j & 3, j >> 2, mb_mem); __syncthreads(); } }
        return;
    }
    for (int it = F.vcu; it < 384 + 128; it += F.G) {
        if (it < 384) { const int g = it % 3, qb = 127 - it / 3; nsa_item(F, g, qb, mb_cmp, mb_slc, mb_win); }
        else { const int j = it - 384; mem_item(F, WSP(bf16, WS_PA), NA, CA_QM, F.in[14], 0, j & 3, j >> 2, mb_mem); }
        __syncthreads();
    }
}

__device__ __forceinline__ void stick_tile(at::f32x16& p0, at::f32x16& p1, int k0, int t, int hi, float& R2) {
    using namespace at;
    float L0[16], L1[16];
    const float NEG = -__builtin_inff();
#pragma unroll
    for (int r = 0; r < 16; ++r) {
        const int kk = k0 + crow(r, hi);
        { const float z = p0[r] * C2; const float sp = fmaxf(z, 0.f) + __builtin_amdgcn_logf(1.0f + __builtin_amdgcn_exp2f(-fabsf(z))); const bool v = kk < t; L0[r] = v ? -sp : 0.f; p0[r] = v ? z - sp : NEG; }
        { const float z = p1[r] * C2; const float sp = fmaxf(z, 0.f) + __builtin_amdgcn_logf(1.0f + __builtin_amdgcn_exp2f(-fabsf(z))); const bool v = kk + 32 < t; L1[r] = v ? -sp : 0.f; p1[r] = v ? z - sp : NEG; }
    }
    float ct[8], pt[8];
#pragma unroll
    for (int c = 0; c < 4; ++c) { ct[c] = (L0[4 * c] + L0[4 * c + 1]) + (L0[4 * c + 2] + L0[4 * c + 3]); ct[4 + c] = (L1[4 * c] + L1[4 * c + 1]) + (L1[4 * c + 2] + L1[4 * c + 3]); }
#pragma unroll
    for (int c = 0; c < 8; ++c) { auto rr = __builtin_amdgcn_permlane32_swap(__float_as_uint(ct[c]), __float_as_uint(ct[c]), false, false); pt[c] = __uint_as_float(hi ? rr[0] : rr[1]); }
    float E[8]; float run = 0.f;
#pragma unroll
    for (int c = 7; c >= 0; --c) { E[c] = run + (hi == 0 ? pt[c] : 0.f); run += ct[c] + pt[c]; }
#pragma unroll
    for (int c = 0; c < 4; ++c) {
        { const float a3 = R2 + E[c], a2 = a3 + L0[4 * c + 3], a1 = a2 + L0[4 * c + 2], a0 = a1 + L0[4 * c + 1];
          p0[4 * c + 3] = __builtin_amdgcn_exp2f(p0[4 * c + 3] + a3); p0[4 * c + 2] = __builtin_amdgcn_exp2f(p0[4 * c + 2] + a2); p0[4 * c + 1] = __builtin_amdgcn_exp2f(p0[4 * c + 1] + a1); p0[4 * c] = __builtin_amdgcn_exp2f(p0[4 * c] + a0); }
        { const float a3 = R2 + E[4 + c], a2 = a3 + L1[4 * c + 3], a1 = a2 + L1[4 * c + 2], a0 = a1 + L1[4 * c + 1];
          p1[4 * c + 3] = __builtin_amdgcn_exp2f(p1[4 * c + 3] + a3); p1[4 * c + 2] = __builtin_amdgcn_exp2f(p1[4 * c + 2] + a2); p1[4 * c + 1] = __builtin_amdgcn_exp2f(p1[4 * c + 1] + a1); p1[4 * c] = __builtin_amdgcn_exp2f(p1[4 * c] + a0); }
    }
    R2 += run;
}
template <int KB>
__device__ __forceinline__ bool stick_step(int kb, int kb_w, at::Stg& S, LAS unsigned char* lds, int tid, const bf16* Kh, const bf16* Vh, const at::bf16x8* qr, at::f32x16* o, int tw, float& R2, LAS int* DONE) {
    using namespace at;
    int tz = tid; asm volatile("" : "+v"(tz));
    const int lane = tz & 63, w = __builtin_amdgcn_readfirstlane(tz >> 6), r32 = lane & 31, hi = lane >> 5, sr = tz >> 4, sc = (tz & 15) * 8;
    const int vb0 = (int)(uintptr_t)(lds + L_V) + v_rd_base(lane);
    int t = tw + r32; asm volatile("" : "+v"(t));
    const float THR2 = -100.f;
    const bool more = kb > 0;
    const bf16* Kn = Kh + (size_t)(more ? kb - 1 : kb) * 64 * NB; const bf16* Vn = Vh + (size_t)(more ? kb - 1 : kb) * 64 * NB;
    if (more) stg_load(S, Kn, NB, sr, sc);
    SBAR();
    bool wdone = false, kdone = false;
    if (kb <= kb_w) {
        if (__any(R2 > THR2)) {
            f32x16 p0, p1; qkt<KB>(p0, p1, lds, r32, hi, qr);
            SBAR();
            stick_tile(p0, p1, 64 * kb, t, hi, R2);
            SBAR();
            if (more) { stg_write_k<KB ^ 1>(S, lds, sr, sc); SBAR(); stg_load(S, Vn, NB, sr, sc); SBAR(); } kdone = true;
            bf16x8 pa0, pa1, pa2, pa3; pack_p(p0, p1, pa0, pa1, pa2, pa3);
            SBAR();
            pv_tile<KB>(o, vb0, pa0, pa1, pa2, pa3);
            SBAR();
        }
        wdone = !__any(R2 > THR2);
    }
    if (lane == 0) DONE[(kb & 1) * 8 + w] = wdone ? 1 : 0;
    if (more) { if (!kdone) { stg_write_k<KB ^ 1>(S, lds, sr, sc); SBAR(); stg_load(S, Vn, NB, sr, sc); SBAR(); } stg_write_v<KB ^ 1>(S, lds, sr, sc); }
    __syncthreads();
    int alld = 1;
#pragma unroll
    for (int ww = 0; ww < 8; ++ww) alld &= DONE[(kb & 1) * 8 + ww];
    return more && !alld;
}
__device__ __forceinline__ void stick_item(Frame& F, int h, int qb) {
    using namespace at;
    LAS unsigned char* lds = F.lds + RING_OFF;
    const bf16* PB = WSP(bf16, WS_PB); bf16* MIX = WSP(bf16, WS_MIX);
    int tid = F.tid; asm volatile("" : "+v"(tid));
    const int lane = tid & 63, w = F.wave, r32 = lane & 31, hi = lane >> 5, sr = tid >> 4, sc = (tid & 15) * 8;
    const int q0 = 256 * qb, tw = q0 + 32 * w, t = tw + r32;
    LAS int* DONE = (LAS int*)(lds + L_DONE);
    bf16x8 qr[8]; load_q(qr, PB + (size_t)t * NB + CB_Q + h * HD, hi);
    f32x16 o[4] = {};
    const bf16* Kh = PB + CB_K + h * HD; const bf16* Vh = PB + CB_V + h * HD;
    const int kb_hi = q0 / 64 + 3, kb_w = q0 / 64 + (w >> 1);
    float R2 = 0.f;
    Stg S;
    stg_load(S, Kh + (size_t)kb_hi * 64 * NB, NB, sr, sc); stg_write_k<0>(S, lds, sr, sc);
    stg_load(S, Vh + (size_t)kb_hi * 64 * NB, NB, sr, sc); stg_write_v<0>(S, lds, sr, sc);
    __syncthreads();
    for (int kb = kb_hi; ; kb -= 2) {
        if (!stick_step<0>(kb, kb_w, S, lds, tid, Kh, Vh, qr, o, tw, R2, DONE)) break;
        if (!stick_step<1>(kb - 1, kb_w, S, lds, tid, Kh, Vh, qr, o, tw, R2, DONE)) break;
    }
    store_o(o, lane, [&](int row) { return MIX + (size_t)(tw + row) * DM + h * HD; });
}
__device__ __forceinline__ void p10_attn(Frame& F) {
    const int ln = lane_of(F);
    const float mb_mem = 128.f * at::C2 * 1.01f * at::gain_absmax(F.in[14] + 2 * HD, ln) * at::gain_absmax(F.in[14] + 3 * HD, ln);
    if (F.G == 256) {
        if (F.vcu < 192) { for (int it = F.vcu; it < 384; it += 192) { const int h = it % 12, qb = 31 - it / 12; stick_item(F, h, qb); __syncthreads(); } }
        else { for (int j = F.vcu - 192; j < 128; j += 64) { mem_item(F, WSP(bf16, WS_PB), NB, CB_QM, F.in[14] + 2 * HD, 1, j & 3, j >> 2, mb_mem); __syncthreads(); } }
        return;
    }
    for (int it = F.vcu; it < 384 + 128; it += F.G) {
        if (it < 384) { const int h = it % 12, qb = 31 - it / 12; stick_item(F, h, qb); }
        else { const int j = it - 384; mem_item(F, WSP(bf16, WS_PB), NB, CB_QM, F.in[14] + 2 * HD, 1, j & 3, j >> 2, mb_mem); }
        __syncthreads();
    }
}

constexpr int N_PHASES = 17;
#ifndef MK_FILL_P1
#define MK_FILL_P1 0
#endif
#ifndef MK_FILL_P2
#define MK_FILL_P2 0
#endif
#ifndef MK_DBG
#define MK_DBG 0
#endif
#ifndef MK_PROBE_SUB
#define MK_PROBE_SUB 0
#endif
#ifndef MK_PROBE_MASK
#define MK_PROBE_MASK 0
#endif
#ifndef MK_NAIVE_P3
#define MK_NAIVE_P3 0
#endif
#ifndef MK_NAIVE_P10
#define MK_NAIVE_P10 0
#endif
struct Args { const float* in[22]; float* out; unsigned char* ws; int ph_lo, ph_hi, use_bar, pad; };
__global__ void __launch_bounds__(NWAVES * 64, 2) mk_fwd(Args args) {
    extern __shared__ __attribute__((aligned(16))) unsigned char lds[];
    Frame F;
    F.lds = (LAS unsigned char*)lds;
    F.MISC = (volatile LAS unsigned*)(F.lds + MISC_OFF);
    F.tid = threadIdx.x;  F.wave = __builtin_amdgcn_readfirstlane(F.tid >> 6);
    F.G = gridDim.x; { const int bx = blockIdx.x; F.vcu = (F.G % 8 == 0) ? (bx % 8) * (F.G / 8) + bx / 8 : bx; }
    F.ws = args.ws; F.ctl = (gu32*)(args.ws + WS_CTL); F.out = args.out;
#pragma unroll
    for (int i = 0; i < 22; ++i) F.in[i] = args.in[i];
    for (int u = F.tid; u < (LDS_BYTES - LDSCTL_OFF) / 4; u += NWAVES * 64) ((LAS unsigned*)(F.lds + LDSCTL_OFF))[u] = 0u;
    __syncthreads();
    XcdBarrier bar; bar.bar = (unsigned*)(F.ctl + CW_BAR); bar.x = 0; bar.st = nullptr;
    if (args.use_bar) bar = xcd_barrier_post((unsigned*)(F.ctl + CW_BAR), F.MISC + 8);
#if MK_DBG >= 100
    unsigned long long dbg_t = wall_clock64(); int dbg_n = 0;
#define GRID_BAR() do { if (args.use_bar) xcd_barrier(bar); F.tid = threadIdx.x; asm volatile("" : "+v"(F.tid)); \
        { const unsigned long long now_ = wall_clock64(); if (dbg_n == (MK_DBG % 100) && blockIdx.x == 0 && F.tid == 0) ((float*)F.ctl)[CW_DBG] = (float)(now_ - dbg_t) * (MK_DBG >= 300 ? 0.00125f : MK_DBG >= 200 ? 0.02f : 0.005f); dbg_t = now_; ++dbg_n; } } while (0)
#else
#define GRID_BAR() do { if (args.use_bar) xcd_barrier(bar); F.tid = threadIdx.x; asm volatile("" : "+v"(F.tid)); } while (0)
#endif
    const int lo = args.ph_lo, hi = args.ph_hi;
#ifdef MK_ONLY_PHASE
#define IN(k) ((k) == MK_ONLY_PHASE && lo <= (k) && (k) < hi)
#else
#define IN(k) (lo <= (k) && (k) < hi)
#endif
#define BOTH(k) (IN(k) && IN((k) + 1))
    typedef pg8::StaticOrder SO;

    if (IN(0)) { p0_prologue(F); if (!args.use_bar) conv_list(F, CV_DEFER0 + F.vcu * NWAVES + F.wave, F.G * NWAVES, CV_TOTAL); if (BOTH(0)) GRID_BAR(); }
    if (IN(1)) {
        const int Ge = (args.use_bar && F.G >= 128) ? F.G - 56 : F.G;
        if ((int)blockIdx.x < Ge) {
        { pg8::Gemm g{WSP(bf16, WS_XN), WSP(bf16, WS_WT_INA), DM, DM / 64}; SO S; S.init(T / 256, NA / 256, Ge, (int)blockIdx.x);
          pg8::EpiBf16 E{WSP(bf16, WS_PA), NA, nullptr}; pg8::gemm_phase<pg8::EpiBf16, SO, true, true>(F.lds + RING_OFF, g, S, E); }
        { pg8::Gemm g{WSP(bf16, WS_MEMN), WSP(bf16, WS_WT_MEM), DM, DM / 64}; SO S; S.init(1, 8, Ge, (int)(Ge - 1 - blockIdx.x));
          pg8::EpiBf16 E{WSP(bf16, WS_MKV), 2048, nullptr}; pg8::gemm_phase<pg8::EpiBf16, SO, true, true>(F.lds + RING_OFF, g, S, E); }
        }
        if (args.use_bar) idle_fill(F, 1);
        if (BOTH(1)) GRID_BAR();
    }
    if (IN(2)) { if (args.pad != 2) p2_compress(F); if (args.pad != 1) p2_qknorm(F); if (args.use_bar && MK_FILL_P2) idle_fill(F, 2); if (BOTH(2)) GRID_BAR(); }
#if MK_NAIVE_P3
    if (IN(3)) { p3_nsa_naive(F); mem_attn_naive(F, WSP(bf16, WS_PA), NA, CA_QM, F.in[14], 0); if (BOTH(3)) GRID_BAR(); }
#else
#if MK_DBG == 4 || (MK_DBG >= 6 && MK_DBG <= 8)
    const unsigned long long t3 = wall_clock64();
#endif
    if (IN(3)) { p3_attn(F);
#if MK_DBG >= 6 && MK_DBG <= 8
        if (F.vcu == MK_DBG - 6 && F.tid == 0) ((float*)F.ctl)[CW_DBG] = (float)(wall_clock64() - t3) * 0.01f;
#endif
        if (args.use_bar) idle_fill(F, 3); if (BOTH(3)) GRID_BAR();
#if MK_DBG == 4
        if (blockIdx.x == 0 && F.tid == 0) ((float*)F.ctl)[CW_DBG] = (float)(wall_clock64() - t3) * 0.01f;
#endif
    }
#endif
    if (IN(4)) { pg8::Gemm g{WSP(bf16, WS_MIX), WSP(bf16, WS_WT_OUT), DM, DM / 64}; SO S; S.init(T / 256, DM / 256, F.G, (int)blockIdx.x);
        pg8::EpiResNormT<false> E{F.in[0], WSP(bf16, WS_XN), (unsigned long long*)(F.ctl + CW_SS), DM}; pg8::gemm_phase<pg8::EpiResNormT<false>, SO, true, true>(F.lds + RING_OFF, g, S, E);
        if (args.use_bar) conv_drain(F, CV_INB); if (BOTH(4)) GRID_BAR(); }
#if MK_DBG == 3
    const unsigned long long t6 = wall_clock64();
#endif
    if (IN(6)) { const int Ge = (args.use_bar && F.G >= 64) ? F.G - 32 : F.G;
        if ((int)blockIdx.x < Ge) { pg8::Gemm g{WSP(bf16, WS_XN), WSP(bf16, WS_WT_FGU), DM, DM / 64}; SO S; S.init(T / 256, 2 * FF / 256, Ge, (int)blockIdx.x);
            pg8::EpiSwiglu E{WSP(bf16, WS_HFF), FF, (const unsigned long long*)(F.ctl + CW_SS)}; pg8::gemm_phase<pg8::EpiSwiglu, SO, true, true>(F.lds + RING_OFF, g, S, E); }
        if (args.use_bar) idle_fill(F, 6);
        if (BOTH(6)) GRID_BAR();
#if MK_DBG == 3
        if (blockIdx.x == 0 && F.tid == 0) ((float*)F.ctl)[CW_DBG] = (float)(wall_clock64() - t6) * 0.005f;
#endif
    }
    if (IN(7)) { pg8::Gemm g{WSP(bf16, WS_HFF), WSP(bf16, WS_WT_FDN), FF, FF / 64}; SO S; S.init(T / 256, DM / 256, F.G, (int)blockIdx.x);
        pg8::EpiResNormT<true> E{WSP(bf16, WS_XN), WSP(bf16, WS_XN), (unsigned long long*)(F.ctl + CW_SS) + T, DM}; pg8::gemm_phase<pg8::EpiResNormT<true>, SO, true, true>(F.lds + RING_OFF, g, S, E);
        if (args.use_bar) conv_drain(F, CV_MGU); if (BOTH(7)) GRID_BAR(); }
    if (IN(9)) { pg8::Gemm g{WSP(bf16, WS_XN), WSP(bf16, WS_WT_INB), DM, DM / 64}; SO S; S.init(T / 256, NB / 256, F.G, (int)blockIdx.x);
        pg8::EpiBf16 E{WSP(bf16, WS_PB), NB, (const unsigned long long*)(F.ctl + CW_SS) + T}; pg8::gemm_phase<pg8::EpiBf16, SO, true, true>(F.lds + RING_OFF, g, S, E); if (args.use_bar) idle_fill(F, 9); if (BOTH(9)) GRID_BAR(); }
#if MK_NAIVE_P10
    if (IN(10)) { stick_naive(F); mem_attn_naive(F, WSP(bf16, WS_PB), NB, CB_QM, F.in[14] + 2 * HD, 1); if (BOTH(10)) GRID_BAR(); }
#else
    if (IN(10)) { p10_attn(F); if (args.use_bar) idle_fill(F, 10); if (BOTH(10)) GRID_BAR(); }
#endif
    if (IN(11)) { pg8::Gemm g{WSP(bf16, WS_MIX), WSP(bf16, WS_WT_OUT) + (size_t)DM * DM, DM, DM / 64}; SO S; S.init(T / 256, DM / 256, F.G, (int)blockIdx.x);
        pg8::EpiResF32 E{WSP(bf16, WS_XN), WSP(float, WS_X3), DM}; pg8::gemm_phase<pg8::EpiResF32, SO, true, true>(F.lds + RING_OFF, g, S, E); if (BOTH(11)) GRID_BAR(); }
    if (IN(12)) { p12_router(F); if (BOTH(12)) GRID_BAR(); }
    if (IN(13)) { p13_assign(F);
#if MK_DBG == 1
        const unsigned long long t0 = wall_clock64();
#endif
#if MK_DBG == 2
        if (blockIdx.x == 0 && F.tid == 0) { const unsigned c = __hip_atomic_load((unsigned*)(F.ctl + CW_CVNEXT), __ATOMIC_RELAXED, __HIP_MEMORY_SCOPE_AGENT); ((float*)F.ctl)[CW_DBG] = 500.f * (float)c / (float)(CV_TOTAL - CV_DEFER0); }
#endif
        if (args.use_bar) conv_drain(F, CV_MDN);
#if MK_DBG == 1
        if (blockIdx.x == 0 && F.tid == 0) ((float*)F.ctl)[CW_DBG] = (float)(wall_clock64() - t0) * 0.01f;
#endif
        if (BOTH(13)) GRID_BAR(); }
    if (IN(14)) { const int* TILE = (const int*)(F.ws + WS_ROUTE + RT_TILE); const int ntl = TILE[0];
        LAS int* TE = (LAS int*)(F.lds + LDSCTL_OFF + 1024);
        if (F.tid < MOE_MAXT) TE[F.tid] = TILE[16 + F.tid];
        __syncthreads();
        int Ge = F.G;
        if (args.use_bar && F.G >= 64) { const int U = ntl * (2 * FF / 256); if ((U + F.G - 9) / (F.G - 8) == (U + F.G - 1) / F.G) Ge = F.G - 8; }
        if ((int)blockIdx.x < Ge) { pg8::Gemm g{WSP(bf16, WS_AMOE), WSP(bf16, WS_WT_MGU), DM, DM / 64}; pg8::MoeOrder S; S.init(ntl, 2 * FF / 256, Ge, (int)blockIdx.x); S.tile_e = TE; S.estride = (size_t)2 * FF * DM * 2;
            pg8::EpiSwiglu E{WSP(bf16, WS_HMOE), FF, nullptr}; pg8::gemm_phase<pg8::EpiSwiglu, pg8::MoeOrder, true, true>(F.lds + RING_OFF, g, S, E); }
#if MK_DBG == 5
        const unsigned long long t14 = wall_clock64();
#endif
        if (args.use_bar) { idle_fill(F, 14); conv_drain(F, CV_TOTAL); }
#if MK_DBG == 5
        if (blockIdx.x == 0 && F.tid == 0) ((float*)F.ctl)[CW_DBG] = (float)(wall_clock64() - t14) * 0.01f;
#endif
        if (BOTH(14)) GRID_BAR(); }
    if (IN(15)) { const int* TILE = (const int*)(F.ws + WS_ROUTE + RT_TILE); const int ntl = TILE[0];
        LAS int* TE = (LAS int*)(F.lds + LDSCTL_OFF + 1024);
        if (F.tid < MOE_MAXT) TE[F.tid] = TILE[16 + F.tid];
        __syncthreads();
        const int U = ntl * (DM / 256), full = (U / F.G) * F.G, tail = U - full;
        { pg8::Gemm g{WSP(bf16, WS_HMOE), WSP(bf16, WS_WT_MDN), FF, FF / 64}; pg8::MoeOrder S; S.init(ntl, DM / 256, F.G, (int)blockIdx.x); S.nwg = full; S.tile_e = TE; S.estride = (size_t)DM * FF * 2;
          pg8::EpiBf16 E{WSP(bf16, WS_YMOE), DM, nullptr}; pg8::gemm_phase<pg8::EpiBf16, pg8::MoeOrder, true, true>(F.lds + RING_OFF, g, S, E); }
        if (tail > 0) { const int nsp = moe_nsplit(tail, F.G);
          const int sp = (int)blockIdx.x % nsp, q = (FF / 128) / nsp, r = (FF / 128) % nsp, len = q + (sp < r ? 1 : 0), st = sp * q + (sp < r ? sp : r);
          pg8::Gemm g{WSP(bf16, WS_HMOE), WSP(bf16, WS_WT_MDN), FF, 2 * len}; pg8::MoeSplitOrder S; S.nM = ntl; S.nN = DM / 256; S.nwg0 = full; S.ntail = tail; S.nsp = nsp; S.G = F.G; S.c = (int)blockIdx.x; S.koff = 2 * st; S.tile_e = TE; S.estride = (size_t)DM * FF * 2;
          pg8::EpiPartF32 E{WSP(float, WS_SLAB), (int*)(F.ctl + CW_TMAP)}; pg8::gemm_phase<pg8::EpiPartF32, pg8::MoeSplitOrder, true, true>(F.lds + RING_OFF, g, S, E); }
        if (BOTH(15)) GRID_BAR(); }
    if (IN(16)) { p16_combine(F, MK_DBG ? 1.0f + 1e-4f * ((const float*)F.ctl)[CW_DBG] : 1.0f); }
#undef IN
#undef BOTH
}

#ifndef MK_ONE_LAUNCH
#define MK_ONE_LAUNCH 1
#endif
extern "C" void kernel_launch(void* const* d_in, const int* in_sizes, int n_in, void* d_out, int out_size, void* d_ws, size_t ws_size, hipStream_t stream) {
    static int grid = 0;
    if (grid == 0) {
        if (n_in != 22 || in_sizes[0] != T * DM || out_size != T * DM || ws_size < WS_END) { fprintf(stderr, "kernel_launch: unexpected shapes (n_in %d, in0 %d, out %d, ws %zu < %zu)\n", n_in, n_in > 0 ? in_sizes[0] : -1, out_size, ws_size, (size_t)WS_END); grid = -1; return; }
        int dev = 0, cus = 0, per_cu = 0;
        if (hipGetDevice(&dev) != hipSuccess || hipDeviceGetAttribute(&cus, hipDeviceAttributeMultiprocessorCount, dev) != hipSuccess) { grid = -1; return; }
        if (hipFuncSetAttribute((const void*)mk_fwd, hipFuncAttributeMaxDynamicSharedMemorySize, LDS_BYTES) != hipSuccess) { fprintf(stderr, "kernel_launch: hipFuncSetAttribute failed\n"); grid = -1; return; }
        if (hipOccupancyMaxActiveBlocksPerMultiprocessor(&per_cu, (const void*)mk_fwd, NWAVES * 64, LDS_BYTES) != hipSuccess || per_cu < 1) { fprintf(stderr, "kernel_launch: occupancy query says %d blocks per CU\n", per_cu); }
        (void)hipGetLastError();
        grid = cus;
    }
    if (grid < 0) return;
    if (hipMemsetAsync((char*)d_ws + WS_CTL, 0, CTL_ZERO_BYTES, stream) != hipSuccess) return;
    Args a{};
    for (int i = 0; i < 22; ++i) a.in[i] = (const float*)d_in[i];
    a.out = (float*)d_out; a.ws = (unsigned char*)d_ws; a.pad = 0;
#if MK_ONE_LAUNCH
    a.ph_lo = 0; a.ph_hi = N_PHASES; a.use_bar = 1;
    hipLaunchKernelGGL(mk_fwd, dim3(grid), dim3(NWAVES * 64), LDS_BYTES, stream, a);
    for (int p = 0; p < N_PHASES; ++p) if ((MK_PROBE_MASK >> p) & 1) { a.ph_lo = p; a.ph_hi = p + 1; a.use_bar = 0; a.pad = MK_PROBE_SUB;
        hipLaunchKernelGGL(mk_fwd, dim3(grid), dim3(NWAVES * 64), LDS_BYTES, stream, a); }
#else
    for (int p = 0; p < N_PHASES; ++p) { a.ph_lo = p; a.ph_hi = p + 1; a.use_bar = 0;
        hipLaunchKernelGGL(mk_fwd, dim3(grid), dim3(NWAVES * 64), LDS_BYTES, stream, a); }
#endif
}
```

```cpp
#include <hip/hip_runtime.h>
#include <cstdio>
#include <cstdint>

namespace pg8 {
#define PG8_LAS __attribute__((address_space(3)))
typedef unsigned short bf16_t;
typedef short bf16x8 __attribute__((ext_vector_type(8)));
typedef float f32x4 __attribute__((ext_vector_type(4)));
typedef unsigned u32x4 __attribute__((ext_vector_type(4)));
constexpr int BM = 256, BK = 64, HALF = 128, HTB = HALF * BK * 2  , STAGE_BYTES = 8 * HTB, NXCD = 8, WGM = 8;

__host__ __device__ __forceinline__ int lds_byte(int r, int c) { const int st = (r >> 4) * 2 + (c >> 5), rr = r & 15, cc = c & 31, ob = rr * 64 + cc * 2; return st * 1024 + (ob ^ (((ob >> 9) & 1) << 5)); }
__host__ __device__ __forceinline__ void stage_rc(int b, int& R, int& C) { const int st = b / 1024, sb = b % 1024, swz = sb ^ (((sb >> 9) & 1) << 5); R = (st >> 1) * 16 + swz / 64; C = (st & 1) * 32 + (swz % 64) / 2; }
__host__ __device__ __forceinline__ int perm32(int rho) { const int n = rho >> 4, i = rho & 15; return 8 * (i >> 2) + 4 * n + (i & 3); }

struct Unit { int pm, pn, ks, sl; };
struct Gemm { const bf16_t* A; const bf16_t* Bt; int K, kt; };

struct StaticOrder {
    int nM, nN, nwg, G, c;
    __device__ void init(int nM_, int nN_, int G_, int c_) { nM = nM_; nN = nN_; nwg = nM * nN; G = G_; c = c_; }
    __device__ bool next(int i, Unit& u) const {
        const long L = (long)i * G + c; if (L >= nwg) return false;
        int wgid = (int)L; { const int q = nwg / NXCD, r = nwg % NXCD, xcd = wgid % NXCD, off = wgid / NXCD; wgid = (xcd < r ? xcd * (q + 1) : r * (q + 1) + (xcd - r) * q) + off; }
        const int nig = WGM * nN, gid = wgid / nig, fm = gid * WGM, gsz = (nM - fm) < WGM ? (nM - fm) : WGM;
        u.pm = fm + ((wgid % nig) % gsz); u.pn = (wgid % nig) / gsz; u.ks = 0; u.sl = 0; return true;
    }
    __device__ __forceinline__ const char* a_base(const Gemm& g, const Unit& u) const { return (const char*)g.A + (size_t)u.pm * ((size_t)BM * g.K * 2); }
    __device__ __forceinline__ const char* b_base(const Gemm& g, const Unit& u) const { return (const char*)g.Bt + (size_t)u.pn * ((size_t)BM * g.K * 2); }
    __device__ __forceinline__ void a_ready(const Unit&) const {}
    __device__ __forceinline__ void done(const Unit&) const {}
};
struct MoeOrder : StaticOrder {
    const PG8_LAS int* tile_e; size_t estride;
    __device__ __forceinline__ const char* b_base(const Gemm& g, const Unit& u) const { return (const char*)g.Bt + (size_t)tile_e[u.pm] * estride + (size_t)u.pn * ((size_t)BM * g.K * 2); }
};
struct MoeSplitOrder {
    int nM, nN, nwg0, ntail, nsp, G, c, koff; const PG8_LAS int* tile_e; size_t estride;
    __device__ bool next(int i, Unit& u) const {
        const long L = (long)i * G + c; if (L >= (long)ntail * nsp) return false;
        const int j = (int)L / nsp, wgid = nwg0 + j;
        const int nig = WGM * nN, gid = wgid / nig, fm = gid * WGM, gsz = (nM - fm) < WGM ? (nM - fm) : WGM;
        u.pm = fm + ((wgid % nig) % gsz); u.pn = (wgid % nig) / gsz; u.ks = (int)L % nsp; u.sl = (int)L; return true;
    }
    __device__ __forceinline__ const char* a_base(const Gemm& g, const Unit& u) const { return (const char*)g.A + (size_t)u.pm * ((size_t)BM * g.K * 2) + (size_t)koff * (BK * 2); }
    __device__ __forceinline__ const char* b_base(const Gemm& g, const Unit& u) const { return (const char*)g.Bt + (size_t)tile_e[u.pm] * estride + (size_t)u.pn * ((size_t)BM * g.K * 2) + (size_t)koff * (BK * 2); }
    __device__ __forceinline__ void a_ready(const Unit&) const {}
    __device__ __forceinline__ void done(const Unit&) const {}
};

__device__ __forceinline__ unsigned cvt_pk_bf16(float lo, float hi) { unsigned r; asm volatile("v_cvt_pk_bf16_f32 %0, %1, %2" : "=v"(r) : "v"(lo), "v"(hi)); return r; }

struct EpiBf16 {
    static constexpr bool PERM = true, AFTER_DRAIN = false;
    bf16_t* O; int ldc; const unsigned long long* ss;
    __device__ __forceinline__ void operator()(const f32x4 (&acc)[2][2][4][2], const Unit& u, int wr, int wc, int fr, int fq) const {
        const int row0 = u.pm * BM + wr * 64 + fr, col0 = u.pn * BM + wc * 32 + 8 * fq;
#pragma unroll
        for (int ai = 0; ai < 2; ++ai)
#pragma unroll
            for (int m = 0; m < 4; ++m) { bf16_t* rowp = O + (size_t)(row0 + ai * HALF + m * 16) * ldc + col0;
                const float rs = ss ? __builtin_amdgcn_rsqf((float)ss[row0 + ai * HALF + m * 16] * (1.0f / (2048.0f * 16777216.0f)) + 1e-6f) : 1.0f;
#pragma unroll
                for (int bj = 0; bj < 2; ++bj) { const f32x4 v0 = acc[ai][bj][m][0] * rs, v1 = acc[ai][bj][m][1] * rs;
                    u32x4 w; w.x = cvt_pk_bf16(v0[0], v0[1]); w.y = cvt_pk_bf16(v0[2], v0[3]); w.z = cvt_pk_bf16(v1[0], v1[1]); w.w = cvt_pk_bf16(v1[2], v1[3]);
                    *(u32x4*)(rowp + bj * HALF) = w; } }
    }
};
struct EpiSwiglu {
    static constexpr bool PERM = true, AFTER_DRAIN = false;
    bf16_t* O; int ldc; const unsigned long long* ss;
    __device__ __forceinline__ void operator()(const f32x4 (&acc)[2][2][4][2], const Unit& u, int wr, int wc, int fr, int fq) const {
        const int row0 = u.pm * BM + wr * 64 + fr, col0 = u.pn * HALF + wc * 32 + 8 * fq;
#pragma unroll
        for (int ai = 0; ai < 2; ++ai)
#pragma unroll
            for (int m = 0; m < 4; ++m) { bf16_t* rowp = O + (size_t)(row0 + ai * HALF + m * 16) * ldc + col0;
                const float rs = ss ? __builtin_amdgcn_rsqf((float)ss[row0 + ai * HALF + m * 16] * (1.0f / (2048.0f * 16777216.0f)) + 1e-6f) : 1.0f;
                float h[8];
#pragma unroll
                for (int n = 0; n < 2; ++n)
#pragma unroll
                    for (int j = 0; j < 4; ++j) { const float gq = acc[ai][0][m][n][j] * rs, uq = acc[ai][1][m][n][j] * rs;
                        const float sg = __builtin_amdgcn_rcpf(1.0f + __builtin_amdgcn_exp2f(-1.4426950408889634f * gq));
                        h[n * 4 + j] = gq * sg * uq; }
                u32x4 w; w.x = cvt_pk_bf16(h[0], h[1]); w.y = cvt_pk_bf16(h[2], h[3]); w.z = cvt_pk_bf16(h[4], h[5]); w.w = cvt_pk_bf16(h[6], h[7]);
                *(u32x4*)rowp = w; }
    }
};
struct EpiPartF32 {
    static constexpr bool PERM = false, AFTER_DRAIN = false;
    float* slab; int* tmap;
    __device__ __forceinline__ void operator()(const f32x4 (&acc)[2][2][4][2], const Unit& u, int wr, int wc, int fr, int fq) const {
        float* base = slab + (size_t)u.sl * (BM * BM) + (size_t)(wr * 64 + fr) * BM + wc * 32 + 4 * fq;
        if (u.ks == 0 && threadIdx.x == 0) tmap[u.pm * 8 + u.pn] = u.sl + 1;
#pragma unroll
        for (int ai = 0; ai < 2; ++ai)
#pragma unroll
            for (int m = 0; m < 4; ++m) { float* rowp = base + (size_t)(ai * HALF + m * 16) * BM;
#pragma unroll
                for (int bj = 0; bj < 2; ++bj)
#pragma unroll
                    for (int n = 0; n < 2; ++n) *(f32x4*)(rowp + bj * HALF + n * 16) = acc[ai][bj][m][n]; }
    }
};
template <bool BB> __device__ __forceinline__ f32x4 res_base(const void* base, size_t idx) {
    if constexpr (BB) { typedef unsigned u32x2_ __attribute__((ext_vector_type(2))); const u32x2_ w = *(const u32x2_*)((const bf16_t*)base + idx);
        return (f32x4){__uint_as_float(w[0] << 16), __uint_as_float(w[0] & 0xffff0000u), __uint_as_float(w[1] << 16), __uint_as_float(w[1] & 0xffff0000u)}; }
    else return *(const f32x4*)((const float*)base + idx);
}
template <bool BB>
struct EpiResNormT {
    static constexpr bool PERM = false, AFTER_DRAIN = false;
    const void* base; bf16_t* xb; unsigned long long* ss; int ldc;
    __device__ __forceinline__ void operator()(const f32x4 (&acc)[2][2][4][2], const Unit& u, int wr, int wc, int fr, int fq) const {
        const int row0 = u.pm * BM + wr * 64 + fr, col0 = u.pn * BM + wc * 32 + 4 * fq;
#pragma unroll
        for (int ai = 0; ai < 2; ++ai)
#pragma unroll
            for (int m = 0; m < 4; ++m) { const size_t off = (size_t)(row0 + ai * HALF + m * 16) * ldc + col0; float sq = 0.f;
#pragma unroll
                for (int bj = 0; bj < 2; ++bj)
#pragma unroll
                    for (int n = 0; n < 2; ++n) { const f32x4 v = res_base<BB>(base, off + bj * HALF + n * 16) + acc[ai][bj][m][n];
                        sq += (v[0] * v[0] + v[1] * v[1]) + (v[2] * v[2] + v[3] * v[3]);
                        unsigned w0 = cvt_pk_bf16(v[0], v[1]), w1 = cvt_pk_bf16(v[2], v[3]); typedef unsigned u32x2 __attribute__((ext_vector_type(2)));
                        *(u32x2*)(xb + off + bj * HALF + n * 16) = (u32x2){w0, w1}; }
                sq += __shfl_xor(sq, 16); sq += __shfl_xor(sq, 32);
                if (fq == 0) atomicAdd(ss + row0 + ai * HALF + m * 16, (unsigned long long)(sq * 16777216.0f + 0.5f)); }
    }
};
struct EpiResF32 {
    static constexpr bool PERM = false, AFTER_DRAIN = false;
    const bf16_t* base; float* out; int ldc;
    __device__ __forceinline__ void operator()(const f32x4 (&acc)[2][2][4][2], const Unit& u, int wr, int wc, int fr, int fq) const {
        const int row0 = u.pm * BM + wr * 64 + fr, col0 = u.pn * BM + wc * 32 + 4 * fq;
#pragma unroll
        for (int ai = 0; ai < 2; ++ai)
#pragma unroll
            for (int m = 0; m < 4; ++m) { const size_t off = (size_t)(row0 + ai * HALF + m * 16) * ldc + col0;
#pragma unroll
                for (int bj = 0; bj < 2; ++bj)
#pragma unroll
                    for (int n = 0; n < 2; ++n) { const f32x4 b = res_base<true>(base, off + bj * HALF + n * 16); *(f32x4*)(out + off + bj * HALF + n * 16) = b + acc[ai][bj][m][n]; } }
    }
};
template <class Epi, class Sched, bool ALIGN_EPI = false, bool SP2 = false>
__device__ __forceinline__ void gemm_phase(PG8_LAS unsigned char* lds, const Gemm g, const Sched& S, const Epi& E) {
    int tid = threadIdx.x; asm volatile("" : "+v"(tid));
    const int wid = __builtin_amdgcn_readfirstlane(tid >> 6), lane = tid & 63, wr = wid >> 2, wc = wid & 3, fr = lane & 15, fq = lane >> 4;
    const int K = g.K, nt = g.kt;
    unsigned voffA[2], voffB[2];
#pragma unroll
    for (int i = 0; i < 2; ++i) { int R, C; stage_rc(tid * 16 + i * 8192, R, C); const int Rb = Epi::PERM ? ((R & ~31) + perm32(R & 31)) : R;
        voffA[i] = (unsigned)(R * K + C) * 2u; voffB[i] = (unsigned)(Rb * K + C) * 2u; }
    const size_t kstep = (size_t)(BK * 2);
    const size_t hstep = (size_t)HALF * K * 2;
    const unsigned ldsw = (unsigned)wid * 1024u;
    const int aoff = lds_byte(wr * 64 + fr, fq * 8), boff = lds_byte(wc * 32 + fr, fq * 8);
#define PG8_SA(b, h) (((b) * 2 + (h)) * HTB)
#define PG8_SB(b, h) ((4 + (b) * 2 + (h)) * HTB)
#define PG8_STAGE(bufoff, gbase, voff) do { _Pragma("unroll") for (int _i = 0; _i < 2; ++_i) \
        __builtin_amdgcn_global_load_lds((const unsigned*)((const char*)(gbase) + (voff)[_i]), (PG8_LAS unsigned*)(lds + (bufoff) + ldsw + _i * 8192), 16, 0, 0); } while (0)
#define PG8_LDA(dst, b, h) do { _Pragma("unroll") for (int m = 0; m < 4; ++m) _Pragma("unroll") for (int k = 0; k < 2; ++k) dst[m][k] = *(const PG8_LAS bf16x8*)(lds + PG8_SA(b, h) + aoff + m * 2048 + k * 1024); } while (0)
#define PG8_LDB(dst, b, h) do { _Pragma("unroll") for (int n = 0; n < 2; ++n) _Pragma("unroll") for (int k = 0; k < 2; ++k) dst[n][k] = *(const PG8_LAS bf16x8*)(lds + PG8_SB(b, h) + boff + n * 2048 + k * 1024); } while (0)
#define PG8_MMA(ai, bj, At, Bt) do { __builtin_amdgcn_s_setprio(1); _Pragma("unroll") for (int m = 0; m < 4; ++m) _Pragma("unroll") for (int n = 0; n < 2; ++n) _Pragma("unroll") for (int k = 0; k < 2; ++k) \
        acc[ai][bj][m][n] = __builtin_amdgcn_mfma_f32_16x16x32_bf16(Bt[n][k], At[m][k], acc[ai][bj][m][n], 0, 0, 0); __builtin_amdgcn_s_setprio(0); } while (0)
#define PG8_WAIT_V(n) asm volatile("s_waitcnt vmcnt(" #n ")" ::: "memory")
#define PG8_WAIT_L(n) asm volatile("s_waitcnt lgkmcnt(" #n ")" ::: "memory")
#define PG8_BAR __builtin_amdgcn_s_barrier()
#define PG8_SCHED __builtin_amdgcn_sched_barrier(0)
    Unit cur, nxt; int ui = 0;
    if (!S.next(0, cur)) return;
    f32x4 acc[2][2][4][2];
#pragma unroll
    for (int a = 0; a < 2; ++a)
#pragma unroll
        for (int b = 0; b < 2; ++b)
#pragma unroll
            for (int m = 0; m < 4; ++m)
#pragma unroll
                for (int n = 0; n < 2; ++n) acc[a][b][m][n] = (f32x4){0.f, 0.f, 0.f, 0.f};
    bf16x8 At[4][2], B0[2][2], B1[2][2];
    const char* cA = S.a_base(g, cur); const char* cB = S.b_base(g, cur);
    S.a_ready(cur);
    if constexpr (SP2) {
        PG8_STAGE(PG8_SB(0, 0), cB, voffB); PG8_STAGE(PG8_SB(0, 1), cB + hstep, voffB); PG8_STAGE(PG8_SA(0, 0), cA, voffA); PG8_STAGE(PG8_SA(0, 1), cA + hstep, voffA);
        if (wr == 1) PG8_BAR;
        PG8_WAIT_V(2); PG8_BAR;
        PG8_STAGE(PG8_SB(1, 0), cB + kstep, voffB); PG8_STAGE(PG8_SA(1, 0), cA + kstep, voffA); PG8_STAGE(PG8_SB(1, 1), cB + hstep + kstep, voffB);
        PG8_WAIT_V(6); PG8_BAR;
    } else {
        PG8_STAGE(PG8_SB(0, 0), cB, voffB); PG8_STAGE(PG8_SA(0, 0), cA, voffA); PG8_STAGE(PG8_SB(0, 1), cB + hstep, voffB); PG8_STAGE(PG8_SA(0, 1), cA + hstep, voffA);
        if (wr == 1) PG8_BAR;
        PG8_WAIT_V(4); PG8_BAR;
        PG8_STAGE(PG8_SB(1, 0), cB + kstep, voffB); PG8_STAGE(PG8_SA(1, 0), cA + kstep, voffA); PG8_STAGE(PG8_SB(1, 1), cB + hstep + kstep, voffB);
        PG8_WAIT_V(6); PG8_BAR;
    }
    for (;;) {
        const bool has_next = S.next(ui + 1, nxt);
        const char* nA = has_next ? S.a_base(g, nxt) : cA; const char* nB = has_next ? S.b_base(g, nxt) : cB;
        for (int t = 0; t < nt; t += 2) {
            const bool last = (t == nt - 2);
            const char* a1 = cA + (size_t)(t + 1) * kstep;
            const char* a2 = last ? nA : cA + (size_t)(t + 2) * kstep; const char* b2 = last ? nB : cB + (size_t)(t + 2) * kstep;
            const char* a3 = a2 + kstep; const char* b3 = b2 + kstep;
            if (last && has_next) S.a_ready(nxt);
            if constexpr (SP2) {
            PG8_LDB(B0, 0, 0); PG8_LDB(B1, 0, 1); PG8_SCHED; PG8_LDA(At, 0, 0); PG8_STAGE(PG8_SA(1, 1), a1 + hstep, voffA);
            PG8_WAIT_V(8); PG8_WAIT_L(0); PG8_BAR; PG8_MMA(0, 0, At, B0); PG8_MMA(0, 1, At, B1); PG8_BAR; PG8_SCHED;
            PG8_LDA(At, 0, 1); PG8_STAGE(PG8_SB(0, 0), b2, voffB); PG8_STAGE(PG8_SB(0, 1), b2 + hstep, voffB); PG8_STAGE(PG8_SA(0, 0), a2, voffA);
            PG8_WAIT_V(8); PG8_WAIT_L(0); PG8_BAR; PG8_MMA(1, 0, At, B0); PG8_MMA(1, 1, At, B1); PG8_BAR; PG8_SCHED;
            PG8_LDB(B0, 1, 0); PG8_LDB(B1, 1, 1); PG8_SCHED; PG8_LDA(At, 1, 0); PG8_STAGE(PG8_SA(0, 1), a2 + hstep, voffA);
            PG8_WAIT_V(8); PG8_WAIT_L(0); PG8_BAR; PG8_MMA(0, 0, At, B0); PG8_MMA(0, 1, At, B1); PG8_BAR; PG8_SCHED;
            PG8_LDA(At, 1, 1); PG8_STAGE(PG8_SB(1, 0), b3, voffB); PG8_STAGE(PG8_SB(1, 1), b3 + hstep, voffB); PG8_STAGE(PG8_SA(1, 0), a3, voffA);
            PG8_WAIT_V(8); PG8_WAIT_L(0); PG8_BAR; PG8_MMA(1, 0, At, B0); PG8_MMA(1, 1, At, B1); PG8_BAR; PG8_SCHED;
            } else {
            PG8_LDB(B0, 0, 0); PG8_SCHED; PG8_LDA(At, 0, 0); PG8_STAGE(PG8_SA(1, 1), a1 + hstep, voffA);
            PG8_WAIT_L(8); PG8_BAR; PG8_WAIT_L(0); PG8_MMA(0, 0, At, B0); PG8_BAR; PG8_SCHED;
            PG8_LDB(B1, 0, 1); PG8_STAGE(PG8_SB(0, 0), b2, voffB);
            PG8_BAR; PG8_WAIT_L(0); PG8_MMA(0, 1, At, B1); PG8_BAR;
            PG8_LDA(At, 0, 1); PG8_STAGE(PG8_SA(0, 0), a2, voffA);
            PG8_BAR; PG8_WAIT_L(0); PG8_MMA(1, 0, At, B0); PG8_BAR; PG8_SCHED;
            PG8_STAGE(PG8_SB(0, 1), b2 + hstep, voffB);
            PG8_WAIT_V(6); PG8_BAR; PG8_MMA(1, 1, At, B1); PG8_BAR;
            PG8_LDB(B0, 1, 0); PG8_SCHED; PG8_LDA(At, 1, 0); PG8_STAGE(PG8_SA(0, 1), a2 + hstep, voffA);
            PG8_WAIT_L(8); PG8_BAR; PG8_WAIT_L(0); PG8_MMA(0, 0, At, B0); PG8_BAR; PG8_SCHED;
            PG8_LDB(B1, 1, 1); PG8_STAGE(PG8_SB(1, 0), b3, voffB);
            PG8_BAR; PG8_WAIT_L(0); PG8_MMA(0, 1, At, B1); PG8_BAR;
            PG8_LDA(At, 1, 1); PG8_STAGE(PG8_SA(1, 0), a3, voffA);
            PG8_BAR; PG8_WAIT_L(0); PG8_MMA(1, 0, At, B0); PG8_BAR; PG8_SCHED;
            PG8_STAGE(PG8_SB(1, 1), b3 + hstep, voffB);
            PG8_WAIT_V(6); PG8_BAR; PG8_MMA(1, 1, At, B1); PG8_BAR;
            }
        }
        if constexpr (ALIGN_EPI) { if (wr == 0) PG8_BAR; }
        if constexpr (!Epi::AFTER_DRAIN) { E(acc, cur, wr, wc, fr, fq); S.done(cur); }
        if (!has_next) break;
#pragma unroll
        for (int a = 0; a < 2; ++a)
#pragma unroll
            for (int b = 0; b < 2; ++b)
#pragma unroll
                for (int m = 0; m < 4; ++m)
#pragma unroll
                    for (int n = 0; n < 2; ++n) acc[a][b][m][n] = (f32x4){0.f, 0.f, 0.f, 0.f};
        cur = nxt; cA = nA; cB = nB; ++ui;
        if constexpr (ALIGN_EPI) { if (wr == 1) PG8_BAR; }
    }
    PG8_WAIT_V(0);
    if constexpr (!ALIGN_EPI) { if (wr == 0) PG8_BAR; }
    PG8_BAR;
    if constexpr (Epi::AFTER_DRAIN) { E.fused(acc, cur, wr, wc, fr, fq, lds, wid, lane); S.done(cur); }
#undef PG8_SA
#undef PG8_SB
#undef PG8_STAGE
#undef PG8_LDA
#undef PG8_LDB
#undef PG8_MMA
#undef PG8_WAIT_V
#undef PG8_WAIT_L
#undef PG8_BAR
#undef PG8_SCHED
}
}


constexpr int T = 8192, DM = 2048, HD = 128, NMIX = 12, NMEMH = 4, NG = 3, MEMT = 256, FF = 7168, NE = 8;
constexpr int A_IN_W = 4388, NA = 4608;
constexpr int NB = 5120;
constexpr int CA_Q = 0, CA_KC = 1536, CA_VC = 1920, CA_KS = 2304, CA_VS = 2688, CA_KW = 3072, CA_VW = 3456, CA_QM = 3840, CA_GT = 4352;
constexpr int CB_Q = 0, CB_QM = 1536, CB_K = 2048, CB_V = 3584;
constexpr int NCMP = 511, NCMP_P = 512;
constexpr int MOE_MAXT = 72;
constexpr float EPS = 1e-6f;
constexpr float QSCALE = 0.08838834764831845f;

constexpr size_t MiB = 1u << 20;
constexpr size_t WS_CTL = 0, CTL_ZERO_BYTES = 1 * MiB;
constexpr size_t WS_WT_INA = 2 * MiB;
constexpr size_t WS_WT_MEM = 20 * MiB;
constexpr size_t WS_WT_OUT = 28 * MiB;
constexpr size_t WS_WT_FGU = 44 * MiB;
constexpr size_t WS_WT_FDN = 100 * MiB;
constexpr size_t WS_WT_INB = 128 * MiB;
constexpr size_t WS_WT_MGU = 148 * MiB;
constexpr size_t WS_WT_MDN = 596 * MiB;
constexpr size_t WS_XN = 820 * MiB;
constexpr size_t WS_MEMN = 852 * MiB;
constexpr size_t WS_MKV = 853 * MiB;
constexpr size_t WS_PA = 854 * MiB;
constexpr size_t WS_KCMP = 926 * MiB;
constexpr size_t WS_MIX = 927 * MiB;
constexpr size_t WS_X1 = 959 * MiB;
constexpr size_t WS_X2 = 1023 * MiB;
constexpr size_t WS_X3 = 1087 * MiB;
constexpr size_t WS_HFF = 1151 * MiB;
constexpr size_t WS_PB = 1263 * MiB;
constexpr size_t WS_AMOE = 1343 * MiB;
constexpr size_t WS_HMOE = 1415 * MiB;
constexpr size_t WS_YMOE = 1667 * MiB;
constexpr size_t WS_ROUTE = 1739 * MiB;
constexpr size_t WS_WT_CMP = 1740 * MiB;
constexpr size_t WS_OACC = 1742 * MiB;
constexpr size_t WS_SLAB = 1790 * MiB;
constexpr size_t WS_END = 1854 * MiB;
constexpr size_t RT_TOPI = 0;
constexpr size_t RT_TOPW = 65536;
constexpr size_t RT_ROW = 131072;
constexpr size_t RT_HIST = 196608;
constexpr size_t RT_TILE = 204800;
constexpr int CW_TMO = 0, CW_CODE = 1, CW_BAR = 4096;

constexpr int RING_OFF = 0, RING_BYTES = 135168;
constexpr int LDSCTL_OFF = RING_BYTES, MISC_OFF = LDSCTL_OFF + 320;
constexpr int LDS_BYTES = 147456;
static_assert(MISC_OFF + 128 <= LDS_BYTES, "LDS map");
constexpr int NWAVES = 8;

#define GAS __attribute__((address_space(1)))
#define LAS __attribute__((address_space(3)))
typedef unsigned short bf16;
typedef unsigned v4u __attribute__((ext_vector_type(4)));
typedef unsigned v2u __attribute__((ext_vector_type(2)));
typedef float f32x4 __attribute__((ext_vector_type(4)));
typedef GAS unsigned gu32;
#define RLX_AGENT __ATOMIC_RELAXED, __HIP_MEMORY_SCOPE_AGENT
#define LDS_WAIT() asm volatile("s_waitcnt lgkmcnt(0)" ::: "memory")
#define VM_WAIT() asm volatile("s_waitcnt vmcnt(0)" ::: "memory")
__device__ __forceinline__ float bf2f(unsigned b) { return __uint_as_float(b << 16); }
__device__ __forceinline__ unsigned pk2(float lo, float hi) { return pg8::cvt_pk_bf16(lo, hi); }
__device__ __forceinline__ void unpack8(v4u w, float* f) {
    f[0] = __uint_as_float(w.x << 16); f[1] = __uint_as_float(w.x & 0xffff0000u); f[2] = __uint_as_float(w.y << 16); f[3] = __uint_as_float(w.y & 0xffff0000u);
    f[4] = __uint_as_float(w.z << 16); f[5] = __uint_as_float(w.z & 0xffff0000u); f[6] = __uint_as_float(w.w << 16); f[7] = __uint_as_float(w.w & 0xffff0000u); }
__device__ __forceinline__ float wave_sum(float v) {
#pragma unroll
    for (int o = 1; o < 64; o <<= 1) v += __shfl_xor(v, o);
    return v;
}
__device__ __forceinline__ float fast_exp(float x) { return __builtin_amdgcn_exp2f(x * 1.4426950408889634f); }

#define XB_TMO      128
#define XB_XCNT(j)  (256  + 64 * (j))
#define XB_XSUB(j)  (1280 + 64 * (j))
#define XB_XGEN(j)  (2304 + 64 * (j))
#define XB_TOP      3328
#define XB_TOPGEN   3392
#define XCD_BAR_WORDS 3456
#define XB_SPIN_CAP (1u << 18)
__device__ __forceinline__ unsigned xb_ld(unsigned* p)              { return __hip_atomic_load(p, __ATOMIC_RELAXED, __HIP_MEMORY_SCOPE_AGENT); }
__device__ __forceinline__ unsigned xb_add(unsigned* p, unsigned v) { return __hip_atomic_fetch_add(p, v, __ATOMIC_RELAXED, __HIP_MEMORY_SCOPE_AGENT); }
__device__ __forceinline__ unsigned xb_xcc_id() { return (unsigned)__builtin_amdgcn_s_getreg((3 << 11) | 20) & 0xFu; }
#define XB_SPIN(cond, bar) do { unsigned _sp = 0; while (cond) { __builtin_amdgcn_s_sleep(1); \
    if ((++_sp & 255u) == 0u) { if (xb_ld(&(bar)[XB_TMO])) break; if (_sp > XB_SPIN_CAP) { atomicAdd(&(bar)[XB_TMO], 1u); break; } } } } while (0)
struct XcdBarrier { unsigned* bar; unsigned x; volatile LAS unsigned* st; };
__device__ __forceinline__ XcdBarrier xcd_barrier_post(unsigned* bar, volatile LAS unsigned* st) {
    XcdBarrier b; b.bar = bar; b.x = xb_xcc_id(); b.st = st;
    if (threadIdx.x == 0) (void)xb_add(&bar[XB_XCNT(b.x)], 1u);
    return b;
}
__device__ __forceinline__ void xcd_barrier_complete(unsigned* bar, unsigned x, unsigned& nloc, unsigned& nx) {
    const unsigned G = gridDim.x * gridDim.y * gridDim.z;
    unsigned sum, cnt, mine, sp = 0u;
    for (;;) {
        sum = 0u; cnt = 0u; mine = 0u;
#pragma unroll
        for (unsigned j = 0; j < 16; ++j) { const unsigned c = xb_ld(&bar[XB_XCNT(j)]); sum += c; cnt += (c > 0u) ? 1u : 0u; mine = (j == x) ? c : mine; }
        if (sum == G) break;
        __builtin_amdgcn_s_sleep(1);
        if ((++sp & 255u) == 0u) { if (xb_ld(&bar[XB_TMO])) break; if (sp > XB_SPIN_CAP) { atomicAdd(&bar[XB_TMO], 1u); break; } }
    }
    nloc = mine > 0u ? mine : 1u; nx = cnt > 0u ? cnt : 1u;
}
__device__ __forceinline__ void xcd_barrier(const XcdBarrier& b) {
    asm volatile("s_waitcnt vmcnt(0)" ::: "memory");
    __syncthreads();
    if (threadIdx.x == 0) {
        unsigned* bar = b.bar;
        __builtin_amdgcn_s_waitcnt(0);
        unsigned nloc = b.st[0], nx = b.st[1];
        if (nloc == 0u) { xcd_barrier_complete(bar, b.x, nloc, nx); b.st[0] = nloc; b.st[1] = nx; }
        const unsigned old = xb_add(&bar[XB_XSUB(b.x)], 1u);
        const unsigned gen = old / nloc;
        if (old + 1u == (gen + 1u) * nloc) {
            __builtin_amdgcn_fence(__ATOMIC_RELEASE, "agent");
            asm volatile("s_waitcnt vmcnt(0)" ::: "memory");
            const unsigned og = xb_add(&bar[XB_TOP], 1u);
            const unsigned tg = og / nx;
            if (og + 1u == (tg + 1u) * nx) xb_add(&bar[XB_TOPGEN], 1u);
            else XB_SPIN(xb_ld(&bar[XB_TOPGEN]) == tg, bar);
            __builtin_amdgcn_fence(__ATOMIC_ACQUIRE, "agent");
            xb_add(&bar[XB_XGEN(b.x)], 1u);
            asm volatile("s_waitcnt vmcnt(0)" ::: "memory");
        } else {
            XB_SPIN(xb_ld(&bar[XB_XGEN(b.x)]) == gen, bar);
            __builtin_amdgcn_fence(__ATOMIC_ACQUIRE, "agent");
            asm volatile("s_waitcnt vmcnt(0)" ::: "memory");
        }
    }
    __syncthreads();
}

struct Frame {
    LAS unsigned char* lds;
    volatile LAS unsigned* MISC;
    gu32* ctl;
    int tid, wave;
    int vcu, G;
    unsigned char* ws;
    const float* in[22];
    float* out;
};
#define WSP(T_, off) ((T_*)(F.ws + (off)))
__device__ __forceinline__ int lane_of(const Frame& F) { int t = F.tid; asm volatile("" : "+v"(t)); return t & 63; }

constexpr int CV_INA = 0, CV_MEM = CV_INA + 32 * 72, CV_CMP = CV_MEM + 2 * 32 * 16, CV_OUT = CV_CMP + 2 * 64 * 2, CV_FGU = CV_OUT + 2 * 32 * 32, CV_FDN = CV_FGU + 32 * 224,
              CV_INB = CV_FDN + 112 * 32, CV_KVB = CV_INB + 32 * 32, CV_MGU = CV_KVB + 32 * 48, CV_MDN = CV_MGU + 8 * 32 * 224, CV_TOTAL = CV_MDN + 8 * 112 * 32;
struct ConvIt { const float* src; bf16* dst; const float* gain; int K, Nsrc, sc0, n0, k0, nvalid; };
__device__ __forceinline__ void conv_decode(Frame& F, int g, ConvIt& c) {
    int loc, nnb, mode = 0, batch = 0; c.gain = nullptr;
    if (g < CV_MEM) { loc = g - CV_INA; c.src = F.in[5]; c.dst = WSP(bf16, WS_WT_INA); c.gain = F.in[2]; c.K = DM; c.Nsrc = A_IN_W; nnb = NA / 64; mode = 2; }
    else if (g < CV_CMP) { loc = g - CV_MEM; batch = loc / (32 * 16); loc -= batch * 32 * 16; c.src = F.in[13] + (size_t)batch * DM * 1024; c.dst = WSP(bf16, WS_WT_MEM) + (size_t)batch * 1024 * DM; c.gain = F.in[3] + batch * DM; c.K = DM; c.Nsrc = 1024; nnb = 16; }
    else if (g < CV_OUT) { loc = g - CV_CMP; batch = loc / 128; loc -= batch * 128; c.src = F.in[6] + (size_t)batch * 4096 * HD; c.dst = WSP(bf16, WS_WT_CMP) + (size_t)batch * HD * 4096; c.K = 4096; c.Nsrc = HD; nnb = 2; }
    else if (g < CV_FGU) { loc = g - CV_OUT; batch = loc / 1024; loc -= batch * 1024; c.src = F.in[15] + (size_t)batch * DM * DM; c.dst = WSP(bf16, WS_WT_OUT) + (size_t)batch * DM * DM; c.K = DM; c.Nsrc = DM; nnb = 32; }
    else if (g < CV_FDN) { loc = g - CV_FGU; c.src = F.in[16]; c.dst = WSP(bf16, WS_WT_FGU); c.gain = F.in[4]; c.K = DM; c.Nsrc = 2 * FF; nnb = 224; mode = 1; }
    else if (g < CV_INB) { loc = g - CV_FDN; c.src = F.in[17]; c.dst = WSP(bf16, WS_WT_FDN); c.K = FF; c.Nsrc = DM; nnb = 32; }
    else if (g < CV_KVB) { loc = g - CV_INB; c.src = F.in[10]; c.dst = WSP(bf16, WS_WT_INB); c.gain = F.in[2] + DM; c.K = DM; c.Nsrc = DM; nnb = 32; }
    else if (g < CV_MGU) { loc = g - CV_KVB; c.src = F.in[12]; c.dst = WSP(bf16, WS_WT_INB) + (size_t)2048 * DM; c.gain = F.in[11]; c.K = DM; c.Nsrc = 3072; nnb = 48; }
    else if (g < CV_MDN) { loc = g - CV_MGU; batch = loc / 7168; loc -= batch * 7168; c.src = F.in[20] + (size_t)batch * DM * 2 * FF; c.dst = WSP(bf16, WS_WT_MGU) + (size_t)batch * 2 * FF * DM; c.gain = F.in[4] + DM; c.K = DM; c.Nsrc = 2 * FF; nnb = 224; mode = 1; }
    else { loc = g - CV_MDN; batch = loc / 3584; loc -= batch * 3584; c.src = F.in[21] + (size_t)batch * FF * DM; c.dst = WSP(bf16, WS_WT_MDN) + (size_t)batch * DM * FF; c.K = FF; c.Nsrc = DM; nnb = 32; }
    const int kb = loc / nnb, nb = loc - kb * nnb;
    c.k0 = kb * 64; c.n0 = nb * 64; c.nvalid = nnb * 64;
    if (mode == 1) { const int j = c.n0 >> 8, r = c.n0 & 255; c.sc0 = (r < 128) ? 128 * j + r : 7168 + 128 * j + (r - 128); }
    else if (mode == 2) { if (c.n0 < 3840) c.sc0 = c.n0; else if (c.n0 < 4352) c.sc0 = c.n0 + 36; else if (c.n0 < 4416) { c.sc0 = c.n0 - 512; c.nvalid = 4388; } else { c.sc0 = 0; c.nvalid = 0; } }
    else c.sc0 = c.n0;
}
struct ConvRegs { f32x4 v[16]; float gn[8]; };
__device__ __forceinline__ void conv_load(const ConvIt& c, ConvRegs& R, int lane) {
    const int kr = lane >> 4, nc = (lane & 15) * 4;
    const bool ok = (c.n0 + nc) < c.nvalid;
    const int cc = ok ? c.sc0 + nc : 0;
    const float* p = c.src + (size_t)(c.k0 + kr) * c.Nsrc + cc;
#pragma unroll
    for (int i = 0; i < 16; ++i) R.v[i] = __builtin_nontemporal_load((const f32x4*)(p + (size_t)(4 * i) * c.Nsrc));
    if (c.n0 + 64 > c.nvalid) {
#pragma unroll
        for (int i = 0; i < 16; ++i) R.v[i] = ok ? R.v[i] : (f32x4){0.f, 0.f, 0.f, 0.f}; }
    const int c8 = lane & 7;
    if (c.gain) {
#pragma unroll
        for (int i = 0; i < 8; ++i) R.gn[i] = c.gain[c.k0 + 8 * c8 + i]; }
}
__device__ __forceinline__ void conv_proc(const ConvIt& c, const ConvRegs& R, LAS float* scr, int lane) {
    const int kr = lane >> 4, nc = (lane & 15) * 4;
#pragma unroll
    for (int i = 0; i < 16; ++i) { LAS float* s = scr + (4 * i + kr) * 65 + nc; s[0] = R.v[i][0]; s[1] = R.v[i][1]; s[2] = R.v[i][2]; s[3] = R.v[i][3]; }
    LDS_WAIT(); asm volatile("" ::: "memory");
    const int c8 = lane & 7, nl = lane >> 3;
#pragma unroll
    for (int j = 0; j < 8; ++j) {
        const int n = nl + 8 * j; const LAS float* s = scr + (8 * c8) * 65 + n;
        v4u o;
        if (c.gain) { o.x = pk2(s[0 * 65] * R.gn[0], s[1 * 65] * R.gn[1]); o.y = pk2(s[2 * 65] * R.gn[2], s[3 * 65] * R.gn[3]); o.z = pk2(s[4 * 65] * R.gn[4], s[5 * 65] * R.gn[5]); o.w = pk2(s[6 * 65] * R.gn[6], s[7 * 65] * R.gn[7]); }
        else { o.x = pk2(s[0 * 65], s[1 * 65]); o.y = pk2(s[2 * 65], s[3 * 65]); o.z = pk2(s[4 * 65], s[5 * 65]); o.w = pk2(s[6 * 65], s[7 * 65]); }
        __builtin_nontemporal_store(o, (v4u*)(c.dst + (size_t)(c.n0 + n) * c.K + c.k0 + 8 * c8));
    }
    LDS_WAIT(); asm volatile("" ::: "memory");
}
__device__ __forceinline__ void conv_list(Frame& F, int first, int stride, int g_hi) {
    LAS float* scr = (LAS float*)(F.lds + RING_OFF + F.wave * 16640);
    int g = first;
    if (g >= g_hi) return;
    ConvIt cA, cB; ConvRegs RA, RB;
    conv_decode(F, g, cA); conv_load(cA, RA, lane_of(F));
    for (;;) {
        const int g1 = g + stride; const bool h1 = g1 < g_hi;
        if (h1) { conv_decode(F, g1, cB); conv_load(cB, RB, lane_of(F)); }
        asm volatile("" ::: "memory");
        conv_proc(cA, RA, scr, lane_of(F));
        if (!h1) break;
        const int g2 = g1 + stride; const bool h2 = g2 < g_hi;
        if (h2) { conv_decode(F, g2, cA); conv_load(cA, RA, lane_of(F)); }
        asm volatile("" ::: "memory");
        conv_proc(cB, RB, scr, lane_of(F));
        if (!h2) break;
        g = g2;
    }
}
constexpr int CV_DEFER0 = CV_FGU, CV_CHUNK = 8;
constexpr int CW_DBG = 16;
constexpr int CW_SS = 65536;
constexpr int CW_TMAP = 12288;
constexpr int CW_CVNEXT = 8192, CW_DONE0 = 8192 + 64;
__device__ __forceinline__ bool conv_grab(Frame& F) {
    volatile LAS int* sh = (volatile LAS int*)(F.lds + LDSCTL_OFF + 64);
    if (F.tid == 0) sh[0] = CV_DEFER0 + (int)__hip_atomic_fetch_add((unsigned*)(F.ctl + CW_CVNEXT), (unsigned)CV_CHUNK, __ATOMIC_RELAXED, __HIP_MEMORY_SCOPE_AGENT);
    __syncthreads();
    const int base = sh[0];
    __syncthreads();
    if (base >= CV_TOTAL) return false;
    const int hi = base + CV_CHUNK < CV_TOTAL ? base + CV_CHUNK : CV_TOTAL;
    conv_list(F, base + F.wave, NWAVES, hi);
    return true;
}
__device__ __forceinline__ void idle_fill(Frame& F, int ph) {
    volatile LAS int* sh = (volatile LAS int*)(F.lds + LDSCTL_OFF + 64);
    asm volatile("s_waitcnt vmcnt(0)" ::: "memory");
    __syncthreads();
    if (F.tid == 0) __hip_atomic_fetch_add((unsigned*)(F.ctl + CW_DONE0 + 64 * ph), 1u, __ATOMIC_RELAXED, __HIP_MEMORY_SCOPE_AGENT);
    for (;;) {
        if (F.tid == 0) sh[1] = (__hip_atomic_load((unsigned*)(F.ctl + CW_DONE0 + 64 * ph), __ATOMIC_RELAXED, __HIP_MEMORY_SCOPE_AGENT) >= (unsigned)F.G) ? 1 : 0;
        __syncthreads();
        const int alld = sh[1];
        __syncthreads();
        if (alld) break;
        if (!conv_grab(F)) break;
    }
}
__device__ __forceinline__ void conv_drain(Frame& F, int limit) {
    volatile LAS int* sh = (volatile LAS int*)(F.lds + LDSCTL_OFF + 64);
    asm volatile("s_waitcnt vmcnt(0)" ::: "memory");
    __syncthreads();
    for (;;) {
        if (F.tid == 0) sh[1] = (CV_DEFER0 + (int)__hip_atomic_load((unsigned*)(F.ctl + CW_CVNEXT), __ATOMIC_RELAXED, __HIP_MEMORY_SCOPE_AGENT) >= limit) ? 1 : 0;
        __syncthreads();
        const int enough = sh[1];
        __syncthreads();
        if (enough) break;
        if (!conv_grab(F)) break;
    }
}
__device__ __forceinline__ float row_rstd_to_bf16(const float* xrow, bf16* orow, int lane) {
    const f32x4* xr = (const f32x4*)xrow + lane;
    f32x4 v[8]; float s = 0.f;
#pragma unroll
    for (int j = 0; j < 8; ++j) { v[j] = xr[64 * j]; s += (v[j].x * v[j].x + v[j].y * v[j].y) + (v[j].z * v[j].z + v[j].w * v[j].w); }
    const float rstd = 1.0f / sqrtf(wave_sum(s) * (1.f / DM) + EPS);
    v2u* o8 = (v2u*)orow + lane;
#pragma unroll
    for (int j = 0; j < 8; ++j) { v2u w; w.x = pk2(v[j].x * rstd, v[j].y * rstd); w.y = pk2(v[j].z * rstd, v[j].w * rstd); o8[64 * j] = w; }
    return rstd;
}
__device__ __forceinline__ void rmsnorm_rows(Frame& F, const float* X, bf16* XN, int rows) {
    const int gw = F.vcu * NWAVES + F.wave, NGW = F.G * NWAVES;
    for (int m = gw; m < rows; m += NGW) row_rstd_to_bf16(X + (size_t)m * DM, XN + (size_t)m * DM, lane_of(F));
}
__device__ __forceinline__ void p0_prologue(Frame& F) {
    conv_list(F, F.vcu * NWAVES + F.wave, F.G * NWAVES, CV_DEFER0);
    rmsnorm_rows(F, F.in[0], WSP(bf16, WS_XN), T);
    rmsnorm_rows(F, F.in[1], WSP(bf16, WS_MEMN), MEMT);
}

__device__ __forceinline__ void p2_compress(Frame& F) {
    typedef short bf16x8 __attribute__((ext_vector_type(8)));
    const bf16* PA = WSP(bf16, WS_PA); const bf16* WC = WSP(bf16, WS_WT_CMP);
    LAS float* red = (LAS float*)(F.lds + RING_OFF);
    LAS float* posl = red + 8 * 16 * 132;
    const int lane = lane_of(F), w = F.wave, fr = lane & 15, fq = lane >> 4;
    for (int i = F.tid; i < 2 * 4096 / 4; i += NWAVES * 64) *(LAS f32x4*)(posl + 4 * i) = *(const f32x4*)(F.in[7] + 4 * i);
    __syncthreads();
    const int nitems = 2 * NG * 32;
    for (int it = F.vcu; it < nitems; it += F.G) {
        const int kv = it / (NG * 32), g = (it / 32) % NG, jt = it % 32;
        const int j = 16 * jt + fr;
        const LAS float* pos = posl + kv * 4096 + 512 * w + 8 * fq;
        const int col = (kv ? CA_VC : CA_KC) + g * HD;
        const bf16* wrow = WC + ((size_t)kv * HD + fr) * 4096 + 512 * w + 8 * fq;
        f32x4 acc[8];
#pragma unroll
        for (int c = 0; c < 8; ++c) acc[c] = f32x4{0.f, 0.f, 0.f, 0.f};
        for (int u0 = 0; u0 < 16; u0 += 4) {
            v4u xa[4], wb[4][8];
#pragma unroll
            for (int u = 0; u < 4; ++u) {
                const int kl = 32 * (u0 + u) + 8 * fq, i = 4 * w + (kl >> 7), d = kl & 127;
                int trow = 16 * j + i; trow = trow < T ? trow : T - 1;
                xa[u] = *(const v4u*)(PA + (size_t)trow * NA + col + d);
#pragma unroll
                for (int c = 0; c < 8; ++c) wb[u][c] = *(const v4u*)(wrow + (size_t)c * 16 * 4096 + 32 * (u0 + u));
            }
            asm volatile("" ::: "memory");
#pragma unroll
            for (int u = 0; u < 4; ++u) {
                const f32x4 pa = *(const LAS f32x4*)(pos + 32 * (u0 + u)), pb = *(const LAS f32x4*)(pos + 32 * (u0 + u) + 4);
                float xf[8]; unpack8(xa[u], xf);
                v4u av; av.x = pk2(xf[0] + pa[0], xf[1] + pa[1]); av.y = pk2(xf[2] + pa[2], xf[3] + pa[3]); av.z = pk2(xf[4] + pb[0], xf[5] + pb[1]); av.w = pk2(xf[6] + pb[2], xf[7] + pb[3]);
#pragma unroll
                for (int c = 0; c < 8; ++c)
                    acc[c] = __builtin_amdgcn_mfma_f32_16x16x32_bf16(*reinterpret_cast<const bf16x8*>(&av), *reinterpret_cast<const bf16x8*>(&wb[u][c]), acc[c], 0, 0, 0);
            }
        }
#pragma unroll
        for (int c = 0; c < 8; ++c)
#pragma unroll
            for (int r = 0; r < 4; ++r) red[(w * 16 + 4 * fq + r) * 132 + 16 * c + fr] = acc[c][r];
        __syncthreads();
        {
            const int row = F.tid >> 5, cp = F.tid & 31, jj = 16 * jt + row;
            float v[4] = {0.f, 0.f, 0.f, 0.f}; float ss = 0.f;
#pragma unroll
            for (int ww = 0; ww < 8; ++ww) { const f32x4 p = *(const LAS f32x4*)(red + (ww * 16 + row) * 132 + 4 * cp); v[0] += p[0]; v[1] += p[1]; v[2] += p[2]; v[3] += p[3]; }
#pragma unroll
            for (int e = 0; e < 4; ++e) ss += v[e] * v[e];
            ss += __shfl_xor(ss, 1); ss += __shfl_xor(ss, 2); ss += __shfl_xor(ss, 4); ss += __shfl_xor(ss, 8); ss += __shfl_xor(ss, 16);
            if (kv == 0) { const float rs = 1.0f / sqrtf(ss * (1.f / HD) + EPS); const float* gp = F.in[9] + 4 * cp;
#pragma unroll
                for (int e = 0; e < 4; ++e) v[e] = v[e] * rs * gp[e]; }
            if (jj >= NCMP) {
#pragma unroll
                for (int e = 0; e < 4; ++e) v[e] = 0.f; }
            v2u o; o.x = pk2(v[0], v[1]); o.y = pk2(v[2], v[3]);
            *(v2u*)(WSP(bf16, WS_KCMP) + (size_t)kv * NG * NCMP_P * HD + ((size_t)g * NCMP_P + jj) * HD + 4 * cp) = o;
        }
        __syncthreads();
    }
}
__device__ __forceinline__ void norm_slot(bf16* p, const float* gain, int l16) {
    v4u w = *(const v4u*)(p + l16 * 8); float f[8]; unpack8(w, f);
    float s = 0.f;
#pragma unroll
    for (int e = 0; e < 8; ++e) s += f[e] * f[e];
    s += __shfl_xor(s, 1); s += __shfl_xor(s, 2); s += __shfl_xor(s, 4); s += __shfl_xor(s, 8);
    const float r = 1.0f / sqrtf(s * (1.f / HD) + EPS);
    const float* gp = gain + l16 * 8;
    v4u o; o.x = pk2(f[0] * r * gp[0], f[1] * r * gp[1]); o.y = pk2(f[2] * r * gp[2], f[3] * r * gp[3]); o.z = pk2(f[4] * r * gp[4], f[5] * r * gp[5]); o.w = pk2(f[6] * r * gp[6], f[7] * r * gp[7]);
    *(v4u*)(p + l16 * 8) = o;
}
__device__ __forceinline__ void norm_vals(v4u w, bf16* p, const float* gain, int l16) {
    float f[8]; unpack8(w, f);
    float s = 0.f;
#pragma unroll
    for (int e = 0; e < 8; ++e) s += f[e] * f[e];
    s += __shfl_xor(s, 1); s += __shfl_xor(s, 2); s += __shfl_xor(s, 4); s += __shfl_xor(s, 8);
    const float r = 1.0f / sqrtf(s * (1.f / HD) + EPS);
    const float* gp = gain + l16 * 8;
    v4u o; o.x = pk2(f[0] * r * gp[0], f[1] * r * gp[1]); o.y = pk2(f[2] * r * gp[2], f[3] * r * gp[3]); o.z = pk2(f[4] * r * gp[4], f[5] * r * gp[5]); o.w = pk2(f[6] * r * gp[6], f[7] * r * gp[7]);
    *(v4u*)(p + l16 * 8) = o;
}
constexpr int CW_QKN = 8192 + 32;
__device__ __forceinline__ void p2_qknorm(Frame& F) {
    bf16* PA = WSP(bf16, WS_PA); bf16* MKV = WSP(bf16, WS_MKV);
    const int sub = F.wave * 4 + (lane_of(F) >> 4), l16 = lane_of(F) & 15;
    for (int s = F.vcu * 32 + sub; s < MEMT * 8; s += F.G * 32) {
        const int m = s / 8, k = s % 8, l = k >> 2, h = k & 3;
        norm_slot(MKV + (size_t)m * 2048 + l * 1024 + h * HD, F.in[14] + (size_t)(l * 2 + 1) * HD, l16);
    }
    constexpr int NCH = T * 18 / 192;
    volatile LAS int* sh = (volatile LAS int*)(F.lds + LDSCTL_OFF + 64);
    if (F.tid == 0) sh[2] = (int)__hip_atomic_fetch_add((unsigned*)(F.ctl + CW_QKN), 1u, __ATOMIC_RELAXED, __HIP_MEMORY_SCOPE_AGENT);
    __syncthreads();
    int ch = sh[2];
    __syncthreads();
    while (ch < NCH) {
        if (F.tid == 0) sh[2] = (int)__hip_atomic_fetch_add((unsigned*)(F.ctl + CW_QKN), 1u, __ATOMIC_RELAXED, __HIP_MEMORY_SCOPE_AGENT);
        bf16* ptr[6]; const float* gn[6]; v4u w[6];
        const int s0 = ch * 192 + sub;
#pragma unroll
        for (int u = 0; u < 6; ++u) {
            const int s = s0 + u * 32;
            const int t = s / 18, k = s % 18;
            int col; const float* gain;
            if (k < 12) { col = CA_Q + k * HD; gain = F.in[8]; }
            else if (k < 15) { col = CA_KS + (k - 12) * HD; gain = F.in[9] + HD; }
            else { col = CA_KW + (k - 15) * HD; gain = F.in[9] + 2 * HD; }
            ptr[u] = PA + (size_t)t * NA + col; gn[u] = gain; w[u] = *(const v4u*)(ptr[u] + l16 * 8);
        }
        asm volatile("" ::: "memory");
#pragma unroll
        for (int u = 0; u < 6; ++u) norm_vals(w[u], ptr[u], gn[u], l16);
        __syncthreads();
        ch = sh[2];
        __syncthreads();
    }
}

__device__ __forceinline__ void ld32(const bf16* p, float* f) {
#pragma unroll
    for (int i = 0; i < 4; ++i) { const v4u w = *(const v4u*)(p + 8 * i); unpack8(w, f + 8 * i); }
}
__device__ __forceinline__ float dot32q(const float* q, const bf16* kp) {
    float kf[32]; ld32(kp, kf); float s = 0.f;
#pragma unroll
    for (int i = 0; i < 32; ++i) s += q[i] * kf[i];
    s += __shfl_xor(s, 1); s += __shfl_xor(s, 2);
    return s;
}
__device__ __forceinline__ void axpy32(float* o, float p, const bf16* vp) {
    float vf[32]; ld32(vp, vf);
#pragma unroll
    for (int i = 0; i < 32; ++i) o[i] += p * vf[i];
}
__device__ __forceinline__ void st32(bf16* p, const float* f) {
#pragma unroll
    for (int i = 0; i < 4; ++i) { v4u w; w.x = pk2(f[8 * i], f[8 * i + 1]); w.y = pk2(f[8 * i + 2], f[8 * i + 3]); w.z = pk2(f[8 * i + 4], f[8 * i + 5]); w.w = pk2(f[8 * i + 6], f[8 * i + 7]); *(v4u*)(p + 8 * i) = w; }
}
#define OSM_STEP(s_, valid_, vptr_) do { if (valid_) { const float mn_ = fmaxf(m, (s_)); const float al_ = fast_exp(m - mn_); const float pp_ = fast_exp((s_) - mn_); \
        l = l * al_ + pp_; _Pragma("unroll") for (int i_ = 0; i_ < 32; ++i_) o[i_] *= al_; axpy32(o, pp_, (vptr_)); m = mn_; } } while (0)

__device__ __forceinline__ void p3_nsa_naive(Frame& F) {
    const bf16* PA = WSP(bf16, WS_PA); const bf16* KC = WSP(bf16, WS_KCMP); const bf16* VC = KC + (size_t)NG * NCMP_P * HD; bf16* MIX = WSP(bf16, WS_MIX);
    LAS float* IMP = (LAS float*)(F.lds + RING_OFF + F.wave * 4096);
    LAS unsigned long long* SELW = (LAS unsigned long long*)(F.lds + RING_OFF + F.wave * 4096 + 2048);
    const int gw = F.vcu * NWAVES + F.wave, NGW = F.G * NWAVES;
    const int dq = lane_of(F) & 3, p = (lane_of(F) >> 2) & 3, ql = lane_of(F) >> 4;
    for (int it = gw; it < NG * (T / 4); it += NGW) {
        const int g = it / (T / 4), tq = it % (T / 4), t = 4 * tq + ql, head = g * 4 + p;
        const float slope = exp2f(-8.0f * (float)(head + 1) / 12.0f);
        float q[32]; ld32(PA + (size_t)t * NA + CA_Q + head * HD + dq * 32, q);
#pragma unroll
        for (int i = 0; i < 32; ++i) q[i] *= QSCALE;
        const float g0 = 1.0f / (1.0f + fast_exp(-bf2f(PA[(size_t)t * NA + CA_GT + head * 3 + 0])));
        const float g1 = 1.0f / (1.0f + fast_exp(-bf2f(PA[(size_t)t * NA + CA_GT + head * 3 + 1])));
        const float g2 = 1.0f / (1.0f + fast_exp(-bf2f(PA[(size_t)t * NA + CA_GT + head * 3 + 2])));
        float otot[32];
#pragma unroll
        for (int i = 0; i < 32; ++i) otot[i] = 0.f;
        for (int i = lane_of(F); i < 512; i += 64) IMP[i] = 0.f;
        LDS_WAIT(); asm volatile("" ::: "memory");
        const int jmax = (t >= 31) ? (t - 31) / 16 : -1;
        const int jmax_w = (4 * tq + 3 >= 31) ? (4 * tq + 3 - 31) / 16 : -1;
        const bf16* kcg = KC + (size_t)g * NCMP_P * HD + dq * 32; const bf16* vcg = VC + (size_t)g * NCMP_P * HD + dq * 32;
        {
            float m = -1e30f, l = 0.f;
            for (int j = 0; j <= jmax_w; ++j) {
                const float s = dot32q(q, kcg + (size_t)j * HD) - slope * (float)(t - (16 * j + 31));
                if (j <= jmax) { const float mn = fmaxf(m, s); l = l * fast_exp(m - mn) + fast_exp(s - mn); m = mn; }
            }
            const float rl = (l > 0.f) ? 1.0f / l : 0.f;
            float o[32];
#pragma unroll
            for (int i = 0; i < 32; ++i) o[i] = 0.f;
            for (int j = 0; j <= jmax_w; ++j) {
                const float s = dot32q(q, kcg + (size_t)j * HD) - slope * (float)(t - (16 * j + 31));
                const float pj = (j <= jmax) ? fast_exp(s - m) * rl : 0.f;
                axpy32(o, pj, vcg + (size_t)j * HD);
                float ps = pj; ps += __shfl_xor(ps, 4); ps += __shfl_xor(ps, 8);
                if (dq == 0 && p == 0) { IMP[ql * 128 + (j >> 2)] += ps; if ((j & 3) == 3 && (j >> 2) + 1 < 128) IMP[ql * 128 + (j >> 2) + 1] += ps; }
            }
#pragma unroll
            for (int i = 0; i < 32; ++i) otot[i] += g0 * o[i];
        }
        LDS_WAIT(); asm volatile("" ::: "memory");
        for (int qq = 0; qq < 4; ++qq) {
            const int tt = 4 * tq + qq, cur = tt >> 6;
            const int b0 = lane_of(F), b1 = lane_of(F) + 64;
            const float s0 = (b0 == cur) ? 2e6f : (b0 == 0 ? 1e6f : (b0 * 64 <= tt ? IMP[qq * 128 + b0] : -1e6f));
            const float s1 = (b1 == cur) ? 2e6f : (b1 * 64 <= tt ? IMP[qq * 128 + b1] : -1e6f);
            int r0 = 0, r1 = 0;
            for (int b = 0; b < 128; ++b) {
                const float sb = (b == cur) ? 2e6f : (b == 0 ? 1e6f : (b * 64 <= tt ? IMP[qq * 128 + b] : -1e6f));
                r0 += (sb > s0 || (sb == s0 && b < b0)) ? 1 : 0;
                r1 += (sb > s1 || (sb == s1 && b < b1)) ? 1 : 0;
            }
            const unsigned long long m0 = __ballot(r0 < 16 && b0 * 64 <= tt), m1 = __ballot(r1 < 16 && b1 * 64 <= tt);
            if (lane_of(F) == 0) { SELW[qq * 2] = m0; SELW[qq * 2 + 1] = m1; }
        }
        LDS_WAIT(); asm volatile("" ::: "memory");
        {
            const unsigned long long my0 = SELW[ql * 2], my1 = SELW[ql * 2 + 1];
            const unsigned long long u0v = SELW[0] | SELW[2] | SELW[4] | SELW[6], u1v = SELW[1] | SELW[3] | SELW[5] | SELW[7];
            const unsigned long long u0 = ((unsigned long long)(unsigned)__builtin_amdgcn_readfirstlane((int)(u0v >> 32)) << 32) | (unsigned)__builtin_amdgcn_readfirstlane((int)(unsigned)u0v);
            const unsigned long long u1 = ((unsigned long long)(unsigned)__builtin_amdgcn_readfirstlane((int)(u1v >> 32)) << 32) | (unsigned)__builtin_amdgcn_readfirstlane((int)(unsigned)u1v);
            float m = -1e30f, l = 0.f, o[32];
#pragma unroll
            for (int i = 0; i < 32; ++i) o[i] = 0.f;
            const bf16* kg = PA + CA_KS + g * HD + dq * 32; const bf16* vg = PA + CA_VS + g * HD + dq * 32;
            for (int b = 0; b < 128; ++b) {
                const bool inu = (b < 64) ? ((u0 >> b) & 1ull) : ((u1 >> (b - 64)) & 1ull);
                if (!inu) continue;
                const bool mine = (b < 64) ? ((my0 >> b) & 1ull) : ((my1 >> (b - 64)) & 1ull);
                for (int k = 0; k < 64; ++k) {
                    const int kp = b * 64 + k;
                    const float s = dot32q(q, kg + (size_t)kp * NA) - slope * (float)(t - kp);
                    const bool valid = mine && kp <= t;
                    OSM_STEP(s, valid, vg + (size_t)kp * NA);
                }
            }
            const float sc = (l > 0.f) ? g1 / l : 0.f;
#pragma unroll
            for (int i = 0; i < 32; ++i) otot[i] += sc * o[i];
        }
        {
            float m = -1e30f, l = 0.f, o[32];
#pragma unroll
            for (int i = 0; i < 32; ++i) o[i] = 0.f;
            const bf16* kg = PA + CA_KW + g * HD + dq * 32; const bf16* vg = PA + CA_VW + g * HD + dq * 32;
            const int klo = (4 * tq - 511 > 0) ? 4 * tq - 511 : 0, khi = 4 * tq + 3;
            for (int kp = klo; kp <= khi; ++kp) {
                const float s = dot32q(q, kg + (size_t)kp * NA) - slope * (float)(t - kp);
                const bool valid = kp <= t && (t - kp) < 512;
                OSM_STEP(s, valid, vg + (size_t)kp * NA);
            }
            const float sc = (l > 0.f) ? g2 / l : 0.f;
#pragma unroll
            for (int i = 0; i < 32; ++i) otot[i] += sc * o[i];
        }
        st32(MIX + (size_t)t * DM + head * HD + dq * 32, otot);
    }
}
__device__ __forceinline__ void mem_attn_naive(Frame& F, const bf16* P, int ldp, int qcol, const float* qg, int layer) {
    const bf16* MKV = WSP(bf16, WS_MKV); bf16* MIX = WSP(bf16, WS_MIX);
    const int gw = F.vcu * NWAVES + F.wave, NGW = F.G * NWAVES;
    const int dq = lane_of(F) & 3, r = lane_of(F) >> 2;
    for (int it = gw; it < NMEMH * (T / 16); it += NGW) {
        const int hm = it / (T / 16), t = 16 * (it % (T / 16)) + r;
        float q[32]; ld32(P + (size_t)t * ldp + qcol + hm * HD + dq * 32, q);
        float ss = 0.f;
#pragma unroll
        for (int i = 0; i < 32; ++i) ss += q[i] * q[i];
        ss += __shfl_xor(ss, 1); ss += __shfl_xor(ss, 2);
        const float rs = (1.0f / sqrtf(ss * (1.f / HD) + EPS)) * QSCALE;
#pragma unroll
        for (int i = 0; i < 32; ++i) q[i] = q[i] * rs * qg[dq * 32 + i];
        float m = -1e30f, l = 0.f, o[32];
#pragma unroll
        for (int i = 0; i < 32; ++i) o[i] = 0.f;
        const bf16* kg = MKV + layer * 1024 + hm * HD + dq * 32; const bf16* vg = kg + 512;
        for (int k = 0; k < MEMT; ++k) {
            const float s = dot32q(q, kg + (size_t)k * 2048);
            OSM_STEP(s, true, vg + (size_t)k * 2048);
        }
        const float sc = 1.0f / l;
#pragma unroll
        for (int i = 0; i < 32; ++i) o[i] *= sc;
        st32(MIX + (size_t)t * DM + NMIX * HD + hm * HD + dq * 32, o);
    }
}
__device__ __forceinline__ void stick_naive(Frame& F) {
    const bf16* PB = WSP(bf16, WS_PB); bf16* MIX = WSP(bf16, WS_MIX);
    const int gw = F.vcu * NWAVES + F.wave, NGW = F.G * NWAVES;
    const int dq = lane_of(F) & 3, r = lane_of(F) >> 2;
    for (int it = gw; it < NMIX * (T / 16); it += NGW) {
        const int h = it / (T / 16), t = 16 * (it % (T / 16)) + r;
        float q[32]; ld32(PB + (size_t)t * NB + CB_Q + h * HD + dq * 32, q);
#pragma unroll
        for (int i = 0; i < 32; ++i) q[i] *= QSCALE;
        float R = 0.f, o[32];
#pragma unroll
        for (int i = 0; i < 32; ++i) o[i] = 0.f;
        const bf16* kg = PB + CB_K + h * HD + dq * 32; const bf16* vg = PB + CB_V + h * HD + dq * 32;
        for (int i = 1; ; ++i) {
            const int s = t - i;
            const bool act = s >= 0 && R > -80.f;
            if (!__any(act)) break;
            const int sc = s >= 0 ? s : 0;
            const float z = dot32q(q, kg + (size_t)sc * NB);
            const float sp = fmaxf(z, 0.f) + __logf(1.0f + fast_exp(-fabsf(z)));
            if (act) { const float a = fast_exp(z - sp + R); axpy32(o, a, vg + (size_t)sc * NB); R -= sp; }
        }
        st32(MIX + (size_t)t * DM + h * HD + dq * 32, o);
    }
}

__device__ __forceinline__ void p12_router(Frame& F) {
    const float* X3 = WSP(float, WS_X3); bf16* XN = WSP(bf16, WS_XN);
    int* TOPI = (int*)(F.ws + WS_ROUTE + RT_TOPI); float* TOPW = (float*)(F.ws + WS_ROUTE + RT_TOPW); int* HIST = (int*)(F.ws + WS_ROUTE + RT_HIST);
    const float* rw = F.in[18]; const float* rb = F.in[19]; const float* gn = F.in[4] + DM;
    LAS int* hist = (LAS int*)(F.lds + RING_OFF);
    LAS float* GL = (LAS float*)(F.lds + RING_OFF + 1024);
    for (int i = F.tid; i < DM * 8; i += NWAVES * 64) { const int k = i >> 3, e = i & 7; GL[e * DM + k] = gn[k] * rw[i]; }
    __syncthreads();
    const int lane = lane_of(F);
    for (int c = F.vcu; c < 256; c += F.G) {
        if (F.tid < 8) hist[F.tid] = 0;
        __syncthreads();
#pragma unroll
        for (int ip = 0; ip < 2; ++ip) {
            f32x4 v[2][8];
#pragma unroll
            for (int u = 0; u < 2; ++u) { const f32x4* xr = (const f32x4*)(X3 + (size_t)(32 * c + 4 * F.wave + 2 * ip + u) * DM) + lane;
#pragma unroll
                for (int j = 0; j < 8; ++j) v[u][j] = xr[64 * j]; }
#pragma unroll
            for (int u = 0; u < 2; ++u) {
                const int t = 32 * c + 4 * F.wave + 2 * ip + u;
                float s = 0.f;
#pragma unroll
                for (int j = 0; j < 8; ++j) s += (v[u][j].x * v[u][j].x + v[u][j].y * v[u][j].y) + (v[u][j].z * v[u][j].z + v[u][j].w * v[u][j].w);
                const float rstd = 1.0f / sqrtf(wave_sum(s) * (1.f / DM) + EPS);
                v2u* o8 = (v2u*)(XN + (size_t)t * DM) + lane;
                float lg[8];
#pragma unroll
                for (int e = 0; e < 8; ++e) lg[e] = 0.f;
#pragma unroll
                for (int j = 0; j < 8; ++j) {
                    v2u w; w.x = pk2(v[u][j].x * rstd, v[u][j].y * rstd); w.y = pk2(v[u][j].z * rstd, v[u][j].w * rstd); o8[64 * j] = w;
#pragma unroll
                    for (int e = 0; e < 8; ++e) { const f32x4 gq = *(const LAS f32x4*)(GL + e * DM + 4 * (lane + 64 * j));
                        lg[e] += (v[u][j].x * gq.x + v[u][j].y * gq.y) + (v[u][j].z * gq.z + v[u][j].w * gq.w); }
                }
#pragma unroll
                for (int e = 0; e < 8; ++e) lg[e] = wave_sum(lg[e]) * rstd;
                if (lane == 0) {
                    int i0 = 0; float b0 = lg[0] + rb[0];
#pragma unroll
                    for (int e = 1; e < 8; ++e) { const float b = lg[e] + rb[e]; if (b > b0) { b0 = b; i0 = e; } }
                    int i1 = -1; float b1 = -3.0e38f;
#pragma unroll
                    for (int e = 0; e < 8; ++e) { const float b = lg[e] + rb[e]; if (e != i0 && b > b1) { b1 = b; i1 = e; } }
                    float l0 = 0.f, l1 = 0.f;
#pragma unroll
                    for (int e = 0; e < 8; ++e) { l0 = (e == i0) ? lg[e] : l0; l1 = (e == i1) ? lg[e] : l1; }
                    const float w0 = 1.0f / (1.0f + expf(l1 - l0));
                    TOPI[2 * t] = i0; TOPI[2 * t + 1] = i1; TOPW[2 * t] = w0; TOPW[2 * t + 1] = 1.0f - w0;
                    atomicAdd((int*)&hist[i0], 1); atomicAdd((int*)&hist[i1], 1);
                }
            }
        }
        __syncthreads();
        if (F.tid < 8) HIST[c * 8 + F.tid] = hist[F.tid];
        __syncthreads();
    }
}
__device__ __forceinline__ void p13_assign(Frame& F) {
    const bf16* XN = WSP(bf16, WS_XN); bf16* AM = WSP(bf16, WS_AMOE);
    const int* TOPI = (const int*)(F.ws + WS_ROUTE + RT_TOPI); int* ROW = (int*)(F.ws + WS_ROUTE + RT_ROW); const int* HIST = (const int*)(F.ws + WS_ROUTE + RT_HIST);
    int* TILE = (int*)(F.ws + WS_ROUTE + RT_TILE);
    LAS int* sh = (LAS int*)(F.lds + RING_OFF);
    for (int c = F.vcu; c < 256; c += F.G) {
        if (F.tid < 16) sh[16 + F.tid] = 0;
        __syncthreads();
        for (int i = F.tid; i < 2048; i += 512) { const int v = HIST[i], cc = i >> 3, ee = i & 7;
            __hip_atomic_fetch_add(&sh[16 + ee], v, __ATOMIC_RELAXED, __HIP_MEMORY_SCOPE_WORKGROUP);
            if (cc < c) __hip_atomic_fetch_add(&sh[24 + ee], v, __ATOMIC_RELAXED, __HIP_MEMORY_SCOPE_WORKGROUP); }
        __syncthreads();
        if (F.tid < 8) {
            const int e = F.tid; int off = 0;
            for (int ee = 0; ee < 8; ++ee) { if (ee == e) break; off += (sh[16 + ee] + 255) & ~255; }
            sh[e] = off + sh[24 + e];
            if (c == 0 && e == 0) {
                int nt = 0;
                for (int ee = 0; ee < 8; ++ee) { const int n = (sh[16 + ee] + 255) >> 8; for (int i = 0; i < n; ++i) TILE[16 + nt + i] = ee; nt += n; }
                TILE[0] = nt;
            }
        }
        __syncthreads();
        if (F.wave == 0) {
            const int tl = lane_of(F) >> 1, sl = lane_of(F) & 1, t = 32 * c + tl;
            const int e = TOPI[2 * t + sl];
            int row = 0;
            for (int ee = 0; ee < 8; ++ee) {
                const unsigned long long mk = __ballot(e == ee);
                if (e == ee) row = sh[ee] + __popcll(mk & ((1ull << lane_of(F)) - 1ull));
            }
            ROW[2 * t + sl] = row; sh[64 + lane_of(F)] = row;
        }
        __syncthreads();
        for (int i0 = 0; i0 < 8; i0 += 4) {
            v4u buf[2][4]; int rows[4];
#pragma unroll
            for (int u = 0; u < 2; ++u) { const int idx = 8 * F.wave + i0 + 2 * u, t = 32 * c + (idx >> 1);
                rows[2 * u] = sh[64 + idx]; rows[2 * u + 1] = sh[64 + idx + 1];
                const v4u* src = (const v4u*)(XN + (size_t)t * DM);
#pragma unroll
                for (int j = 0; j < 4; ++j) buf[u][j] = src[lane_of(F) + 64 * j]; }
#pragma unroll
            for (int u = 0; u < 4; ++u) { v4u* dst = (v4u*)(AM + (size_t)rows[u] * DM);
#pragma unroll
                for (int j = 0; j < 4; ++j) dst[lane_of(F) + 64 * j] = buf[u >> 1][j]; }
        }
        __syncthreads();
    }
}
__device__ __forceinline__ int moe_nsplit(int tail, int G) {
    const int cand[7] = {28, 14, 8, 7, 4, 2, 1};
    int s = 1;
#pragma unroll
    for (int i = 6; i >= 0; --i) if (tail * cand[i] <= G) s = cand[i];
    return s;
}
__device__ __forceinline__ void p16_combine(Frame& F, float dbg_scale) {
    const float* X3 = WSP(float, WS_X3); const bf16* Y = WSP(bf16, WS_YMOE); const float* SLAB = WSP(float, WS_SLAB);
    const int* ROW = (const int*)(F.ws + WS_ROUTE + RT_ROW); const float* TOPW = (const float*)(F.ws + WS_ROUTE + RT_TOPW); const int* TMAP = (const int*)(F.ctl + CW_TMAP);
    const int* TILE = (const int*)(F.ws + WS_ROUTE + RT_TILE);
    const int U = TILE[0] * (DM / 256), tail = U - (U / F.G) * F.G, nsp = tail > 0 ? moe_nsplit(tail, F.G) : 1;
    const int gw = F.vcu * NWAVES + F.wave, NGW = F.G * NWAVES, lane = lane_of(F);
    auto slab_sum = [&](const float* sp, float* d) {
        f32x4 u0 = {0.f, 0.f, 0.f, 0.f}, u1 = u0; int sI = 0;
        for (; sI + 4 <= nsp; sI += 4) {
            f32x4 p[8];
#pragma unroll
            for (int q = 0; q < 4; ++q) { p[2 * q] = *(const f32x4*)(sp + (size_t)(sI + q) * 65536); p[2 * q + 1] = *(const f32x4*)(sp + (size_t)(sI + q) * 65536 + 4); }
#pragma unroll
            for (int q = 0; q < 4; ++q) { u0 += p[2 * q]; u1 += p[2 * q + 1]; }
        }
        for (; sI < nsp; ++sI) { u0 += *(const f32x4*)(sp + (size_t)sI * 65536); u1 += *(const f32x4*)(sp + (size_t)sI * 65536 + 4); }
        d[0] = u0[0]; d[1] = u0[1]; d[2] = u0[2]; d[3] = u0[3]; d[4] = u1[0]; d[5] = u1[1]; d[6] = u1[2]; d[7] = u1[3];
    };
    for (int t = gw; t < T; t += NGW) {
        const int r0 = ROW[2 * t], r1 = ROW[2 * t + 1]; const float w0 = TOPW[2 * t], w1 = TOPW[2 * t + 1];
        const f32x4* xr = (const f32x4*)(X3 + (size_t)t * DM); f32x4* orow = (f32x4*)(F.out + (size_t)t * DM);
        int tm0[4], tm1[4]; v4u ya[4], yb[4]; f32x4 xa[4], xb[4];
#pragma unroll
        for (int j = 0; j < 4; ++j) {
            const int c8 = lane + 64 * j, pn = c8 >> 5;
            tm0[j] = TMAP[(r0 >> 8) * 8 + pn]; tm1[j] = TMAP[(r1 >> 8) * 8 + pn];
            ya[j] = *(const v4u*)(Y + (size_t)r0 * DM + 8 * c8); yb[j] = *(const v4u*)(Y + (size_t)r1 * DM + 8 * c8);
            xa[j] = xr[2 * c8]; xb[j] = xr[2 * c8 + 1];
        }
#pragma unroll
        for (int j = 0; j < 4; ++j) {
            const int c8 = lane + 64 * j, cc = (c8 & 31) * 8;
            float a[8], b[8];
            unpack8(ya[j], a); unpack8(yb[j], b);
            if (tm0[j] != 0) slab_sum(SLAB + (size_t)(tm0[j] - 1) * 65536 + (size_t)(r0 & 255) * 256 + cc, a);
            if (tm1[j] != 0) slab_sum(SLAB + (size_t)(tm1[j] - 1) * 65536 + (size_t)(r1 & 255) * 256 + cc, b);
            orow[2 * c8] = (f32x4){xa[j].x + w0 * a[0] + w1 * b[0], xa[j].y + w0 * a[1] + w1 * b[1], xa[j].z + w0 * a[2] + w1 * b[2], xa[j].w + w0 * a[3] + w1 * b[3]} * dbg_scale;
            orow[2 * c8 + 1] = (f32x4){xb[j].x + w0 * a[4] + w1 * b[4], xb[j].y + w0 * a[5] + w1 * b[5], xb[j].z + w0 * a[6] + w1 * b[6], xb[j].w + w0 * a[7] + w1 * b[7]} * dbg_scale;
        }
    }
}

namespace at {
typedef short bf16x8 __attribute__((ext_vector_type(8)));
typedef short s16x4 __attribute__((ext_vector_type(4)));
typedef float f32x16 __attribute__((ext_vector_type(16)));
constexpr int SHM_T = 16384;
constexpr int L_V = 0, L_K = 2 * SHM_T, L_WS = 4 * SHM_T, L_IMP = L_WS + 8 * 256, L_SEL = L_IMP + 64 * 128 * 4, L_PS = L_SEL + 1024, L_WU = L_PS + 8 * 2176, L_LIST = L_WU + 128, L_DONE = L_LIST + 512, L_END = L_DONE + 64;
static_assert(L_END <= RING_BYTES, "attention LDS map");
constexpr float C2 = 0.08838834764831845f * 1.4426950408889634f;
constexpr float LOG2E = 1.4426950408889634f;

#define KSWZ(row, colB) ((row) * 256 + ((colB) ^ (((row) & 7) << 4)))
#define SBAR() __builtin_amdgcn_sched_barrier(0)
__device__ __forceinline__ int v_st(int k, int c) { const int kk = (k & ~0xC) | ((k & 4) << 1) | ((k & 8) >> 1); return ((kk >> 3) * 4 + (c >> 5)) * 512 + ((kk & 7) * 32 + (c & 31)) * 2; }
__device__ __forceinline__ int v_rd_base(int lane) { return ((lane & 3) << 3) | (((lane >> 2) & 3) << 6) | (((lane >> 4) & 1) << 5) | (((lane >> 5) & 1) << 8); }
constexpr int v_rd_off(int d0, int ks, int half) { return d0 * 512 + ks * 4096 + half * 2048; }
__device__ __forceinline__ int crow(int r, int hi) { return (r & 3) + 8 * (r >> 2) + 4 * hi; }
__device__ __forceinline__ unsigned cvtpk(float lo, float hi) { unsigned r; asm volatile("v_cvt_pk_bf16_f32 %0, %1, %2" : "=v"(r) : "v"(lo), "v"(hi)); return r; }
__device__ __forceinline__ float xhalf_max(float v) { auto rr = __builtin_amdgcn_permlane32_swap(__float_as_uint(v), __float_as_uint(v), false, false); return fmaxf(__uint_as_float(rr[0]), __uint_as_float(rr[1])); }
__device__ __forceinline__ float xhalf_sum(float v) { auto rr = __builtin_amdgcn_permlane32_swap(__float_as_uint(v), __float_as_uint(v), false, false); return __uint_as_float(rr[0]) + __uint_as_float(rr[1]); }
__device__ __forceinline__ float quad_sum(float x) {
    x += __int_as_float(__builtin_amdgcn_update_dpp(0, __float_as_int(x), 0xB1, 0xF, 0xF, true));
    x += __int_as_float(__builtin_amdgcn_update_dpp(0, __float_as_int(x), 0x4E, 0xF, 0xF, true));
    return x;
}
__device__ __forceinline__ void pack_p(const f32x16& p0, const f32x16& p1, bf16x8& pa0, bf16x8& pa1, bf16x8& pa2, bf16x8& pa3) {
#define PK4(P, B_, OUT) do { unsigned a0 = cvtpk(P[B_+0], P[B_+1]), a1 = cvtpk(P[B_+2], P[B_+3]);                          \
        unsigned b0 = cvtpk(P[B_+4], P[B_+5]), b1 = cvtpk(P[B_+6], P[B_+7]);                                             \
        auto r0 = __builtin_amdgcn_permlane32_swap(a0, b0, false, false); auto r1 = __builtin_amdgcn_permlane32_swap(a1, b1, false, false); \
        v4u w = {r0[0], r1[0], r0[1], r1[1]}; OUT = *reinterpret_cast<bf16x8*>(&w); } while (0)
    PK4(p0, 0, pa0); PK4(p0, 8, pa1); PK4(p1, 0, pa2); PK4(p1, 8, pa3);
#undef PK4
}
template <int KB>
__device__ __forceinline__ void qkt(f32x16& p0, f32x16& p1, LAS unsigned char* lds, int r32, int hi, const bf16x8* qr) {
    p0 = f32x16{}; p1 = f32x16{};
    LAS unsigned char* kb[4];
#pragma unroll
    for (int dd = 0; dd < 4; ++dd) kb[dd] = lds + L_K + KB * SHM_T + KSWZ(r32, (dd * 16 + hi * 8) * 2);
#pragma unroll
    for (int d0 = 0; d0 < 8; ++d0) { LAS unsigned char* a = kb[d0 & 3] + (d0 >> 2) * 128;
        const bf16x8 b0 = *(const LAS bf16x8*)a;
        const bf16x8 b1 = *(const LAS bf16x8*)(a + 32 * 256);
        p0 = __builtin_amdgcn_mfma_f32_32x32x16_bf16(b0, qr[d0], p0, 0, 0, 0);
        p1 = __builtin_amdgcn_mfma_f32_32x32x16_bf16(b1, qr[d0], p1, 0, 0, 0); }
}
template <int VB>
__device__ __forceinline__ void pv_tile(f32x16* o, int vb0, bf16x8 pa0, bf16x8 pa1, bf16x8 pa2, bf16x8 pa3) {
#define TRRD(dst, off) asm volatile("ds_read_b64_tr_b16 %0, %1 offset:%2" : "=&v"(dst) : "v"(vb0), "i"(off) : "memory")
#define PV_RD(S_, d0) do { constexpr int b_ = VB * SHM_T + v_rd_off(d0, 0, 0); \
        TRRD(S_##l0, b_); TRRD(S_##h0, b_ + 2048); TRRD(S_##l1, b_ + 4096); TRRD(S_##h1, b_ + 6144); TRRD(S_##l2, b_ + 8192); TRRD(S_##h2, b_ + 10240); TRRD(S_##l3, b_ + 12288); TRRD(S_##h3, b_ + 14336); } while (0)
#define PV_MM(S_, d0) do { \
        o[d0] = __builtin_amdgcn_mfma_f32_32x32x16_bf16(pa0, (bf16x8){S_##l0[0], S_##l0[1], S_##l0[2], S_##l0[3], S_##h0[0], S_##h0[1], S_##h0[2], S_##h0[3]}, o[d0], 0, 0, 0);   \
        o[d0] = __builtin_amdgcn_mfma_f32_32x32x16_bf16(pa1, (bf16x8){S_##l1[0], S_##l1[1], S_##l1[2], S_##l1[3], S_##h1[0], S_##h1[1], S_##h1[2], S_##h1[3]}, o[d0], 0, 0, 0);   \
        o[d0] = __builtin_amdgcn_mfma_f32_32x32x16_bf16(pa2, (bf16x8){S_##l2[0], S_##l2[1], S_##l2[2], S_##l2[3], S_##h2[0], S_##h2[1], S_##h2[2], S_##h2[3]}, o[d0], 0, 0, 0);   \
        o[d0] = __builtin_amdgcn_mfma_f32_32x32x16_bf16(pa3, (bf16x8){S_##l3[0], S_##l3[1], S_##l3[2], S_##l3[3], S_##h3[0], S_##h3[1], S_##h3[2], S_##h3[3]}, o[d0], 0, 0, 0); } while (0)
    s16x4 Al0, Al1, Al2, Al3, Ah0, Ah1, Ah2, Ah3, Bl0, Bl1, Bl2, Bl3, Bh0, Bh1, Bh2, Bh3;
    PV_RD(A, 0);
    PV_RD(B, 1); asm volatile("s_waitcnt lgkmcnt(8)" ::: "memory"); SBAR(); PV_MM(A, 0); SBAR();
    PV_RD(A, 2); asm volatile("s_waitcnt lgkmcnt(8)" ::: "memory"); SBAR(); PV_MM(B, 1); SBAR();
    PV_RD(B, 3); asm volatile("s_waitcnt lgkmcnt(8)" ::: "memory"); SBAR(); PV_MM(A, 2); SBAR();
    asm volatile("s_waitcnt lgkmcnt(0)" ::: "memory"); SBAR(); PV_MM(B, 3);
#undef PV_MM
#undef PV_RD
#undef TRRD
}
struct Stg { v4u a, b; };
struct Tile { const bf16* K; const bf16* V; size_t ld; };
__device__ __forceinline__ void stg_load(Stg& S, const bf16* base, size_t ld, int sr, int sc) {
    S.a = *(const v4u*)(base + (size_t)sr * ld + sc); S.b = *(const v4u*)(base + (size_t)(32 + sr) * ld + sc);
}
template <int BUF> __device__ __forceinline__ void stg_write_k(const Stg& S, LAS unsigned char* lds, int sr, int sc) {
    const int kws = KSWZ(sr, sc * 2);
    *(LAS v4u*)(lds + L_K + BUF * SHM_T + kws) = S.a; *(LAS v4u*)(lds + L_K + BUF * SHM_T + kws + 32 * 256) = S.b;
}
template <int BUF> __device__ __forceinline__ void stg_write_v(const Stg& S, LAS unsigned char* lds, int sr, int sc) {
    *(LAS v4u*)(lds + L_V + BUF * SHM_T + v_st(sr, sc)) = S.a; *(LAS v4u*)(lds + L_V + BUF * SHM_T + v_st(32 + sr, sc)) = S.b;
}

template <int PASS, int KB, class Br>
__device__ __forceinline__ void step(Br& br, int i, Stg& SK, Stg& SV, LAS unsigned char* lds, int tid, const bf16x8* qr, float& m2, float& l, float f, f32x16* o) {
    int tz = tid; asm volatile("" : "+v"(tz));
    const int lane = tz & 63, sr = tz >> 4, sc = (tz & 15) * 8, r32 = lane & 31, hi = lane >> 5;
    const int vb0 = (int)(uintptr_t)(lds + L_V) + v_rd_base(lane);
    if (i + 1 < br.nt) {
        stg_write_k<KB ^ 1>(SK, lds, sr, sc);
        if (PASS >= 2) stg_write_v<KB ^ 1>(SV, lds, sr, sc);
        if (i + 2 < br.nt) { const Tile nx = br.tile(i + 2); stg_load(SK, nx.K, nx.ld, sr, sc); if (PASS >= 2) stg_load(SV, nx.V, nx.ld, sr, sc); }
    }
    SBAR();
    if (br.act(i)) {
        f32x16 p0, p1;
        qkt<KB>(p0, p1, lds, r32, hi, qr);
        SBAR();
        if (PASS == 3) br.probs(p0, p1, i, lane, m2); else br.scores(p0, p1, i, lane);
        if (PASS == 1) {
            float pmax = p0[0];
#pragma unroll
            for (int r = 1; r < 16; ++r) pmax = fmaxf(pmax, p0[r]);
#pragma unroll
            for (int r = 0; r < 16; ++r) pmax = fmaxf(pmax, p1[r]);
            pmax = xhalf_max(pmax);
            const float mn = fmaxf(m2, pmax);
            float ps = 0.f;
#pragma unroll
            for (int r = 0; r < 16; ++r) ps += __builtin_amdgcn_exp2f(p0[r] - mn) + __builtin_amdgcn_exp2f(p1[r] - mn);
            ps = xhalf_sum(ps);
            l = l * __builtin_amdgcn_exp2f(m2 - mn) + ps; m2 = mn;
        } else {
            if (PASS == 2) {
#pragma unroll
                for (int r = 0; r < 16; ++r) { p0[r] = __builtin_amdgcn_exp2f(p0[r] - m2) * f; p1[r] = __builtin_amdgcn_exp2f(p1[r] - m2) * f; }
                br.hook(p0, p1, i, lane);
            } else {
                float ps = 0.f;
#pragma unroll
                for (int r = 0; r < 16; ++r) ps += p0[r] + p1[r];
                l += xhalf_sum(ps);
            }
            SBAR();
            bf16x8 pa0, pa1, pa2, pa3; pack_p(p0, p1, pa0, pa1, pa2, pa3);
            SBAR();
            pv_tile<KB>(o, vb0, pa0, pa1, pa2, pa3);
        }
    }
    __syncthreads();
}
template <int PASS, class Br>
__device__ __forceinline__ void run_pass(Br& br, LAS unsigned char* lds, int tid, const bf16x8* qr, float& m2, float& l, float f, f32x16* o) {
    if (br.nt <= 0) return;
    const int sr = tid >> 4, sc = (tid & 15) * 8;
    Stg SK, SV;
    { const Tile t0 = br.tile(0); stg_load(SK, t0.K, t0.ld, sr, sc); if (PASS >= 2) stg_load(SV, t0.V, t0.ld, sr, sc);
      stg_write_k<0>(SK, lds, sr, sc); if (PASS >= 2) stg_write_v<0>(SV, lds, sr, sc); }
    if (br.nt > 1) { const Tile t1 = br.tile(1); stg_load(SK, t1.K, t1.ld, sr, sc); if (PASS >= 2) stg_load(SV, t1.V, t1.ld, sr, sc); }
    __syncthreads();
    for (int i = 0; i < br.nt; i += 2) {
        step<PASS, 0>(br, i, SK, SV, lds, tid, qr, m2, l, f, o);
        if (i + 1 < br.nt) step<PASS, 1>(br, i + 1, SK, SV, lds, tid, qr, m2, l, f, o);
    }
}
__device__ __forceinline__ void scale_rows(f32x16* o, float frow, LAS float* ws, int lane) {
    const int r32 = lane & 31, hi = lane >> 5;
    if (hi == 0) ws[r32] = frow;
    LDS_WAIT(); asm volatile("" ::: "memory");
#pragma unroll
    for (int r = 0; r < 16; ++r) { const float a = ws[crow(r, hi)];
#pragma unroll
        for (int d0 = 0; d0 < 4; ++d0) o[d0][r] *= a; }
    LDS_WAIT(); asm volatile("" ::: "memory");
}
__device__ __forceinline__ float gain_absmax(const float* g, int lane) {
    float a = fmaxf(fabsf(g[lane]), fabsf(g[lane + 64]));
#pragma unroll
    for (int o = 1; o < 64; o <<= 1) a = fmaxf(a, __shfl_xor(a, o));
    return __uint_as_float((unsigned)__builtin_amdgcn_readfirstlane((int)__float_as_uint(a)));
}
__device__ __forceinline__ void o_store(const f32x16* o, float* blk, int lane) {
#pragma unroll
    for (int d0 = 0; d0 < 4; ++d0) {
        float* b = blk + d0 * 1024 + lane; asm volatile("" : "+v"(b));
#pragma unroll
        for (int r = 0; r < 16; ++r) b[r * 64] = o[d0][r];
    }
}
__device__ __forceinline__ void o_addload(f32x16* o, const float* blk, int lane) {
#pragma unroll
    for (int d0 = 0; d0 < 4; ++d0) {
        const float* b = blk + d0 * 1024 + lane; asm volatile("" : "+v"(b));
#pragma unroll
        for (int r = 0; r < 16; ++r) o[d0][r] += b[r * 64];
        asm volatile("" : "+v"(o[d0]) :: "memory");
    }
}
__device__ __forceinline__ void load_q(bf16x8* qr, const bf16* qrow, int hi) {
#pragma unroll
    for (int d0 = 0; d0 < 8; ++d0) { const v4u w = *(const v4u*)(qrow + d0 * 16 + hi * 8); qr[d0] = *reinterpret_cast<const bf16x8*>(&w); }
}

struct RowNsa { int t; float slope2; };
struct BrCmp {
    int nt; const bf16* K; const bf16* V; int jmax_w; RowNsa R;
    LAS float* ps; LAS float* imp;
    __device__ __forceinline__ Tile tile(int i) const { return Tile{K + (size_t)i * 64 * HD, V + (size_t)i * 64 * HD, (size_t)HD}; }
    __device__ __forceinline__ bool act(int i) const { return 64 * i <= jmax_w; }
    __device__ __forceinline__ void scores(f32x16& p0, f32x16& p1, int i, int lane) const {
        const float NEG = -__builtin_inff(); const int hi = lane >> 5;
        float sl = R.slope2; asm volatile("" : "+v"(sl));
        int tt = R.t; asm volatile("" : "+v"(tt));
        const int jmax = (tt >= 31) ? ((tt - 31) >> 4) : -1;
        const int jm = jmax - 64 * i - 4 * hi;
        const float b0 = -sl * (float)(tt - 31 - 16 * (64 * i + 4 * hi));
#pragma unroll
        for (int r = 0; r < 16; ++r) { const int c = (r & 3) + 8 * (r >> 2);
            p0[r] = (c <= jm) ? fmaf(p0[r], C2, fmaf(sl, (float)(16 * c), b0)) : NEG;
            p1[r] = (c + 32 <= jm) ? fmaf(p1[r], C2, fmaf(sl, (float)(16 * c + 512), b0)) : NEG; }
    }
    __device__ __forceinline__ void probs(f32x16&, f32x16&, int, int, float) const {}
    __device__ __forceinline__ void hook(const f32x16& p0, const f32x16& p1, int i, int lane) const {
        const int r32 = lane & 31, hi = lane >> 5, pp = r32 & 3, ql = r32 >> 2;
#pragma unroll
        for (int qd = 0; qd < 4; ++qd) {
            f32x4 a, b;
#pragma unroll
            for (int e = 0; e < 4; ++e) { a[e] = quad_sum(p0[4 * qd + e]); b[e] = quad_sum(p1[4 * qd + e]); }
            if (pp == qd) { *(LAS f32x4*)(ps + ql * 68 + 4 + 8 * qd + 4 * hi) = a; *(LAS f32x4*)(ps + ql * 68 + 4 + 32 + 8 * qd + 4 * hi) = b; }
        }
        LDS_WAIT(); asm volatile("" ::: "memory");
#pragma unroll
        for (int h2 = 0; h2 < 2; ++h2) { const int idx = lane + 64 * h2, q8 = idx >> 4, mq = idx & 15;
            const f32x4 v = *(const LAS f32x4*)(ps + q8 * 68 + 4 + 4 * mq); const float pv = ps[q8 * 68 + 3 + 4 * mq];
            imp[q8 * 128 + 16 * i + mq] = (v[0] + v[1]) + (v[2] + v[3]) + pv; }
        LDS_WAIT(); asm volatile("" ::: "memory");
        if (lane < 8) ps[lane * 68 + 3] = ps[lane * 68 + 4 + 63];
        LDS_WAIT(); asm volatile("" ::: "memory");
    }
};
struct BrSlc {
    int nt; const bf16* K; const bf16* V; RowNsa R; int cur;
    const LAS int* list; const LAS unsigned long long* sel; const LAS unsigned long long* wu;
    __device__ __forceinline__ int blk(int i) const { return list[i]; }
    __device__ __forceinline__ Tile tile(int i) const { const int b = __builtin_amdgcn_readfirstlane(blk(i)); return Tile{K + (size_t)b * 64 * NA, V + (size_t)b * 64 * NA, (size_t)NA}; }
    __device__ __forceinline__ bool act(int i) const { const int b = __builtin_amdgcn_readfirstlane(blk(i)); const unsigned long long u = wu[b >> 6]; return (u >> (b & 63)) & 1ull; }
    __device__ __forceinline__ void scores(f32x16& p0, f32x16& p1, int i, int lane) const {
        const float NEG = -__builtin_inff(); const int b = __builtin_amdgcn_readfirstlane(blk(i)); const int hi = lane >> 5, ql = (lane & 31) >> 2;
        const unsigned long long mm = sel[ql * 2 + (b >> 6)];
        const bool mine = (mm >> (b & 63)) & 1ull;
        float sl = R.slope2; asm volatile("" : "+v"(sl));
        int tt = R.t; asm volatile("" : "+v"(tt));
        const int dm = mine ? (tt - 64 * b - 4 * hi) : -1;
        const float b0 = -sl * (float)dm;
#pragma unroll
        for (int r = 0; r < 16; ++r) { const int c = (r & 3) + 8 * (r >> 2);
            p0[r] = (c <= dm) ? fmaf(p0[r], C2, fmaf(sl, (float)c, b0)) : NEG;
            p1[r] = (c + 32 <= dm) ? fmaf(p1[r], C2, fmaf(sl, (float)(c + 32), b0)) : NEG; }
    }
    __device__ __forceinline__ void probs(f32x16& p0, f32x16& p1, int i, int lane, float m2) const {
        const int b = __builtin_amdgcn_readfirstlane(blk(i)); const int hi = lane >> 5, ql = (lane & 31) >> 2;
        const unsigned long long mm = sel[ql * 2 + (b >> 6)];
        const bool mine = (mm >> (b & 63)) & 1ull;
        float sl = R.slope2; asm volatile("" : "+v"(sl));
        int tt = R.t; asm volatile("" : "+v"(tt));
        const int dm = tt - 64 * b - 4 * hi;
        const float base = mine ? (-sl * (float)dm - m2) : -__builtin_inff();
        if (b < cur) {
#pragma unroll
            for (int r = 0; r < 16; ++r) { const int c = (r & 3) + 8 * (r >> 2);
                p0[r] = __builtin_amdgcn_exp2f(fmaf(p0[r], C2, fmaf(sl, (float)c, base)));
                p1[r] = __builtin_amdgcn_exp2f(fmaf(p1[r], C2, fmaf(sl, (float)(c + 32), base))); }
        } else {
#pragma unroll
            for (int r = 0; r < 16; ++r) { const int c = (r & 3) + 8 * (r >> 2);
                p0[r] = (c <= dm) ? __builtin_amdgcn_exp2f(fmaf(p0[r], C2, fmaf(sl, (float)c, base))) : 0.f;
                p1[r] = (c + 32 <= dm) ? __builtin_amdgcn_exp2f(fmaf(p1[r], C2, fmaf(sl, (float)(c + 32), base))) : 0.f; }
        }
    }
    __device__ __forceinline__ void hook(const f32x16&, const f32x16&, int, int) const {}
};
struct BrWin {
    int nt; const bf16* K; const bf16* V; RowNsa R; int kb0, tw;
    __device__ __forceinline__ Tile tile(int i) const { return Tile{K + (size_t)(kb0 + i) * 64 * NA, V + (size_t)(kb0 + i) * 64 * NA, (size_t)NA}; }
    __device__ __forceinline__ bool act(int) const { return true; }
    __device__ __forceinline__ void scores(f32x16& p0, f32x16& p1, int i, int lane) const {
        const float NEG = -__builtin_inff(); const int hi = lane >> 5;
        float sl = R.slope2; asm volatile("" : "+v"(sl));
        int tt = R.t; asm volatile("" : "+v"(tt));
        const int dm = tt - 64 * (kb0 + i) - 4 * hi;
        const float b0 = -sl * (float)dm;
#pragma unroll
        for (int r = 0; r < 16; ++r) { const int c = (r & 3) + 8 * (r >> 2);
            p0[r] = ((unsigned)(dm - c) < 512u) ? fmaf(p0[r], C2, fmaf(sl, (float)c, b0)) : NEG;
            p1[r] = ((unsigned)(dm - c - 32) < 512u) ? fmaf(p1[r], C2, fmaf(sl, (float)(c + 32), b0)) : NEG; }
    }
    __device__ __forceinline__ void probs(f32x16& p0, f32x16& p1, int i, int lane, float m2) const {
        const int hi = lane >> 5;
        float sl = R.slope2; asm volatile("" : "+v"(sl));
        int tt = R.t; asm volatile("" : "+v"(tt));
        const int kb = kb0 + i, dm = tt - 64 * kb - 4 * hi;
        const float base = -sl * (float)dm - m2;
        if (64 * kb + 63 <= tw && 64 * kb >= tw + 7 - 511) {
#pragma unroll
            for (int r = 0; r < 16; ++r) { const int c = (r & 3) + 8 * (r >> 2);
                p0[r] = __builtin_amdgcn_exp2f(fmaf(p0[r], C2, fmaf(sl, (float)c, base)));
                p1[r] = __builtin_amdgcn_exp2f(fmaf(p1[r], C2, fmaf(sl, (float)(c + 32), base))); }
        } else {
#pragma unroll
            for (int r = 0; r < 16; ++r) { const int c = (r & 3) + 8 * (r >> 2);
                p0[r] = ((unsigned)(dm - c) < 512u) ? __builtin_amdgcn_exp2f(fmaf(p0[r], C2, fmaf(sl, (float)c, base))) : 0.f;
                p1[r] = ((unsigned)(dm - c - 32) < 512u) ? __builtin_amdgcn_exp2f(fmaf(p1[r], C2, fmaf(sl, (float)(c + 32), base))) : 0.f; }
        }
    }
    __device__ __forceinline__ void hook(const f32x16&, const f32x16&, int, int) const {}
};
struct BrMem {
    int nt; const bf16* K; const bf16* V;
    __device__ __forceinline__ Tile tile(int i) const { return Tile{K + (size_t)i * 64 * 2048, V + (size_t)i * 64 * 2048, (size_t)2048}; }
    __device__ __forceinline__ bool act(int) const { return true; }
    __device__ __forceinline__ void scores(f32x16& p0, f32x16& p1, int, int) const {
#pragma unroll
        for (int r = 0; r < 16; ++r) { p0[r] *= C2; p1[r] *= C2; }
    }
    __device__ __forceinline__ void probs(f32x16& p0, f32x16& p1, int, int, float m2) const {
#pragma unroll
        for (int r = 0; r < 16; ++r) { p0[r] = __builtin_amdgcn_exp2f(fmaf(p0[r], C2, -m2)); p1[r] = __builtin_amdgcn_exp2f(fmaf(p1[r], C2, -m2)); }
    }
    __device__ __forceinline__ void hook(const f32x16&, const f32x16&, int, int) const {}
};
template <class RP> __device__ __forceinline__ void store_o(const f32x16* o, int lane, RP rowptr) {
    const int r32 = lane & 31, hi = lane >> 5;
#pragma unroll
    for (int r = 0; r < 16; ++r) { bf16* rp = rowptr(crow(r, hi));
#pragma unroll
        for (int d0 = 0; d0 < 4; ++d0) { const float v = o[d0][r]; const float vn = __shfl_xor(v, 1);
            if ((r32 & 1) == 0) *(unsigned*)(rp + d0 * 32 + r32) = cvtpk(v, vn); } }
}
}

__device__ __forceinline__ void topk_select(unsigned k0, unsigned k1, int need, int lane, unsigned long long& s0, unsigned long long& s1) {
    unsigned thr = 0u;
    for (int bit = 31; bit >= 0; --bit) {
        const unsigned cand = thr | (1u << bit);
        const int cnt = __popcll(__ballot(k0 >= cand)) + __popcll(__ballot(k1 >= cand));
        if (cnt >= need) thr = cand;
    }
    const unsigned long long g0 = __ballot(k0 > thr), g1 = __ballot(k1 > thr), e0 = __ballot(k0 == thr && thr != 0u), e1 = __ballot(k1 == thr && thr != 0u);
    const int rem = need - (__popcll(g0) + __popcll(g1));
    const unsigned long long lt = (1ull << lane) - 1ull;
    const bool t0 = (k0 == thr && thr != 0u) && (__popcll(e0 & lt) < rem);
    const bool t1 = (k1 == thr && thr != 0u) && (__popcll(e0) + __popcll(e1 & lt) < rem);
    s0 = g0 | __ballot(t0); s1 = g1 | __ballot(t1);
}

__device__ __forceinline__ void nsa_item(Frame& F, int g, int qb, float mb_cmp, float mb_slc, float mb_win) {
    using namespace at;
    LAS unsigned char* lds = F.lds + RING_OFF;
    const bf16* PA = WSP(bf16, WS_PA); const bf16* KC = WSP(bf16, WS_KCMP) + (size_t)g * NCMP_P * HD; const bf16* VC = KC + (size_t)NG * NCMP_P * HD; bf16* MIX = WSP(bf16, WS_MIX);
    int tz = F.tid; asm volatile("" : "+v"(tz));
    const int lane = tz & 63, w = F.wave, r32 = lane & 31, hi = lane >> 5;
    const int t0 = 64 * qb, tw = t0 + 8 * w, ql = r32 >> 2, pp = r32 & 3, t = tw + ql, head = 4 * g + pp;
    LAS float* ws = (LAS float*)(lds + L_WS + w * 256);
    LAS float* IMP = (LAS float*)(lds + L_IMP) + w * 8 * 128;
    LAS float* PS = (LAS float*)(lds + L_PS + w * 2176);
    LAS unsigned long long* SEL = (LAS unsigned long long*)(lds + L_SEL);
    LAS unsigned long long* WU = (LAS unsigned long long*)(lds + L_WU);
    LAS int* LIST = (LAS int*)(lds + L_LIST);
    float* oacc = WSP(float, WS_OACC) + ((size_t)((g * 128 + qb) * 8 + w)) * 4096;
    RowNsa R; R.t = t; R.slope2 = exp2f(-8.0f * (float)(head + 1) / 12.0f) * LOG2E;
    int i0c, bmin;
    { const float slope_min2 = exp2f(-8.0f * (float)(4 * g + 4) / 12.0f) * LOG2E;
      const int Dc = (int)((149.f + 2.f * mb_cmp) / slope_min2) + 17, xc = t0 - Dc - 1039;
      const int Ds = (int)((149.f + 2.f * mb_slc) / slope_min2) + 2, xs = t0 - Ds - 63;
      i0c = __builtin_amdgcn_readfirstlane(xc > 0 ? (xc + 1023) / 1024 : 0); bmin = __builtin_amdgcn_readfirstlane(xs > 0 ? (xs + 63) / 64 : 0); }
    bf16x8 qr[8]; load_q(qr, PA + (size_t)t * NA + CA_Q + head * HD, hi);
#define GATE(br_) (1.0f / (1.0f + fast_exp(-bf2f(PA[(size_t)t * NA + CA_GT + head * 3 + (br_)]))))
    f32x16 o[4] = {};
    for (int i = lane; i < 8 * 128; i += 64) IMP[i] = 0.f;
    if (lane < 8) PS[lane * 68 + 3] = 0.f;
    LDS_WAIT(); asm volatile("" ::: "memory");
    {
        const int jmax_b = (t0 + 63 - 31) / 16;
        const int ntf = jmax_b / 64 + 1, i0 = i0c < ntf - 1 ? i0c : ntf - 1;
        BrCmp br; br.K = KC + (size_t)i0 * 64 * HD; br.V = VC + (size_t)i0 * 64 * HD; br.R = R; br.R.t = t - 1024 * i0; br.ps = PS; br.imp = IMP + 16 * i0;
        br.jmax_w = ((tw + 7 >= 31) ? (tw + 7 - 31) / 16 : -1) - 64 * i0;
        br.nt = ntf - i0;
        float m2 = -1e30f, l = 0.f;
        run_pass<1>(br, lds, tz, qr, m2, l, 0.f, o);
        const float f = (l > 0.f) ? 1.0f / l : 0.f;
        run_pass<2>(br, lds, tz, qr, m2, l, f, o);
        scale_rows(o, GATE(0), ws, lane);
        o_store(o, oacc, lane);
#pragma unroll
        for (int d0 = 0; d0 < 4; ++d0) o[d0] = f32x16{};
    }
    for (int qq = 0; qq < 8; ++qq) {
        const int tt = tw + qq, cur = tt >> 6;
        const int b0 = lane, b1 = lane + 64;
        unsigned long long s0 = 0ull, s1 = 0ull;
        const int ncand = cur - 1;
        const bool c0 = (b0 >= 1 && b0 < cur), c1 = (b1 < cur);
        if (ncand <= 14) { s0 = __ballot(c0); s1 = __ballot(c1); }
        else {
            const unsigned k0 = c0 ? (__float_as_uint(IMP[qq * 128 + b0]) + 1u) : 0u, k1 = c1 ? (__float_as_uint(IMP[qq * 128 + b1]) + 1u) : 0u;
            topk_select(k0, k1, 14, lane, s0, s1);
        }
        s0 |= 1ull;
        if (cur < 64) s0 |= (1ull << cur); else s1 |= (1ull << (cur - 64));
        if (lane == 0) { SEL[(8 * w + qq) * 2] = s0; SEL[(8 * w + qq) * 2 + 1] = s1; }
    }
    LDS_WAIT(); asm volatile("" ::: "memory");
    unsigned long long wu0 = 0ull, wu1 = 0ull;
#pragma unroll
    for (int qq = 0; qq < 8; ++qq) { wu0 |= SEL[(8 * w + qq) * 2]; wu1 |= SEL[(8 * w + qq) * 2 + 1]; }
    if (lane == 0) { WU[2 * w] = wu0; WU[2 * w + 1] = wu1; }
    __syncthreads();
    int nsl = 0;
    {
        unsigned long long u0 = 0ull, u1 = 0ull;
#pragma unroll
        for (int ww = 0; ww < 8; ++ww) { u0 |= WU[2 * ww]; u1 |= WU[2 * ww + 1]; }
        if (bmin >= 64) { u0 = 0ull; u1 &= ~((1ull << (bmin - 64)) - 1ull); } else if (bmin > 0) u0 &= ~((1ull << bmin) - 1ull);
        nsl = __popcll(u0) + __popcll(u1);
        if (w == 0) {
            const unsigned long long lt = (1ull << lane) - 1ull;
            if ((u0 >> lane) & 1ull) LIST[__popcll(u0 & lt)] = lane;
            if ((u1 >> lane) & 1ull) LIST[__popcll(u0) + __popcll(u1 & lt)] = lane + 64;
        }
    }
    __syncthreads();
    {
        BrSlc br; br.K = PA + CA_KS + g * HD; br.V = PA + CA_VS + g * HD; br.R = R; br.list = LIST; br.nt = nsl; br.cur = qb;
        br.sel = SEL + 16 * w; br.wu = WU + 2 * w;
        float m2 = mb_slc, l = 0.f;
        run_pass<3>(br, lds, tz, qr, m2, l, 0.f, o);
        scale_rows(o, (l > 0.f) ? GATE(1) / l : 0.f, ws, lane);
        o_addload(o, oacc, lane); o_store(o, oacc, lane);
#pragma unroll
        for (int d0 = 0; d0 < 4; ++d0) o[d0] = f32x16{};
    }
    {
        BrWin br; br.K = PA + CA_KW + g * HD; br.V = PA + CA_VW + g * HD; br.R = R; br.tw = tw;
        br.kb0 = (t0 - 511 > 0) ? ((t0 - 511) >> 6) : 0; br.nt = qb - br.kb0 + 1;
        float m2 = mb_win, l = 0.f;
        run_pass<3>(br, lds, tz, qr, m2, l, 0.f, o);
        scale_rows(o, (l > 0.f) ? GATE(2) / l : 0.f, ws, lane);
        o_addload(o, oacc, lane);
    }
    store_o(o, lane, [&](int row) { return MIX + (size_t)(tw + (row >> 2)) * DM + (4 * g + (row & 3)) * HD; });
#undef GATE
}
__device__ __forceinline__ void mem_item(Frame& F, const bf16* P, int ldp, int qcol, const float* qg, int layer, int hm, int qb, float mb_mem) {
    using namespace at;
    LAS unsigned char* lds = F.lds + RING_OFF;
    const bf16* MKV = WSP(bf16, WS_MKV); bf16* MIX = WSP(bf16, WS_MIX);
    int tz = F.tid; asm volatile("" : "+v"(tz));
    const int lane = tz & 63, w = F.wave, r32 = lane & 31, hi = lane >> 5;
    const int tw = 256 * qb + 32 * w, t = tw + r32;
    bf16x8 qr[8];
    {
        const bf16* qrow = P + (size_t)t * ldp + qcol + hm * HD;
        float qf[64]; float ss = 0.f;
#pragma unroll
        for (int d0 = 0; d0 < 8; ++d0) { const v4u wv = *(const v4u*)(qrow + d0 * 16 + hi * 8); unpack8(wv, qf + 8 * d0); }
#pragma unroll
        for (int i = 0; i < 64; ++i) ss += qf[i] * qf[i];
        ss = xhalf_sum(ss);
        const float rs = 1.0f / sqrtf(ss * (1.f / HD) + EPS);
#pragma unroll
        for (int d0 = 0; d0 < 8; ++d0) { const float* gp = qg + d0 * 16 + hi * 8;
            v4u wv; wv.x = cvtpk(qf[8 * d0] * rs * gp[0], qf[8 * d0 + 1] * rs * gp[1]); wv.y = cvtpk(qf[8 * d0 + 2] * rs * gp[2], qf[8 * d0 + 3] * rs * gp[3]);
            wv.z = cvtpk(qf[8 * d0 + 4] * rs * gp[4], qf[8 * d0 + 5] * rs * gp[5]); wv.w = cvtpk(qf[8 * d0 + 6] * rs * gp[6], qf[8 * d0 + 7] * rs * gp[7]);
            qr[d0] = *reinterpret_cast<const bf16x8*>(&wv); }
    }
    f32x16 o[4] = {};
    BrMem br; br.nt = 4; br.K = MKV + layer * 1024 + hm * HD; br.V = br.K + 512;
    float m2 = mb_mem, l = 0.f;
    run_pass<3>(br, lds, tz, qr, m2, l, 0.f, o);
    scale_rows(o, 1.0f / l, (LAS float*)(lds + L_WS + w * 256), lane);
    store_o(o, lane, [&](int row) { return MIX + (size_t)(tw + row) * DM + NMIX * HD + hm * HD; });
}
__device__ __forceinline__ void p3_attn(Frame& F) {
    const int ln = lane_of(F);
    using at::gain_absmax; using at::C2;
    const float gq = gain_absmax(F.in[8], ln);
    const float mb_slc = 128.f * C2 * 1.01f * gq * gain_absmax(F.in[9] + HD, ln), mb_win = 128.f * C2 * 1.01f * gq * gain_absmax(F.in[9] + 2 * HD, ln);
    const float mb_cmp = 128.f * C2 * 1.01f * gq * gain_absmax(F.in[9], ln);
    const float mb_mem = 128.f * C2 * 1.01f * gain_absmax(F.in[14], ln) * gain_absmax(F.in[14] + HD, ln);
    if (F.G == 256) {
        if (F.vcu < 192) { for (int it = F.vcu; it < 384; it += 192) { const int g = it % 3, qb = 127 - it / 3; nsa_item(F, g, qb, mb_cmp, mb_slc, mb_win); __syncthreads(); } }
        else { for (int j = F.vcu - 192; j < 128; j += 64) { mem_item(F, WSP(bf16, WS_PA), NA, CA_QM, F.in[14], 0, j & 3, j >> 2, mb_mem); __syncthreads(); } }
        return;
    }
    for (int it = F.vcu; it < 384 + 128; it += F.G) {
        if (it < 384) { const int g = it % 3, qb = 127 - it / 3; nsa_item(F, g, qb, mb_cmp, mb_slc, mb_win); }
        else { const int j = it - 384; mem_item(F, WSP(bf16, WS_PA), NA, CA_QM, F.in[14], 0, j & 3, j >> 2, mb_mem); }
        __syncthreads();
    }
}

__device__ __forceinline__ void stick_tile(at::f32x16& p0, at::f32x16& p1, int k0, int t, int hi, float& R2) {
    using namespace at;
    float L0[16], L1[16];
    const float NEG = -__builtin_inff();
#pragma unroll
    for (int r = 0; r < 16; ++r) {
        const int kk = k0 + crow(r, hi);
        { const float z = p0[r] * C2; const float sp = fmaxf(z, 0.f) + __builtin_amdgcn_logf(1.0f + __builtin_amdgcn_exp2f(-fabsf(z))); const bool v = kk < t; L0[r] = v ? -sp : 0.f; p0[r] = v ? z - sp : NEG; }
        { const float z = p1[r] * C2; const float sp = fmaxf(z, 0.f) + __builtin_amdgcn_logf(1.0f + __builtin_amdgcn_exp2f(-fabsf(z))); const bool v = kk + 32 < t; L1[r] = v ? -sp : 0.f; p1[r] = v ? z - sp : NEG; }
    }
    float ct[8], pt[8];
#pragma unroll
    for (int c = 0; c < 4; ++c) { ct[c] = (L0[4 * c] + L0[4 * c + 1]) + (L0[4 * c + 2] + L0[4 * c + 3]); ct[4 + c] = (L1[4 * c] + L1[4 * c + 1]) + (L1[4 * c + 2] + L1[4 * c + 3]); }
#pragma unroll
    for (int c = 0; c < 8; ++c) { auto rr = __builtin_amdgcn_permlane32_swap(__float_as_uint(ct[c]), __float_as_uint(ct[c]), false, false); pt[c] = __uint_as_float(hi ? rr[0] : rr[1]); }
    float E[8]; float run = 0.f;
#pragma unroll
    for (int c = 7; c >= 0; --c) { E[c] = run + (hi == 0 ? pt[c] : 0.f); run += ct[c] + pt[c]; }
#pragma unroll
    for (int c = 0; c < 4; ++c) {
        { const float a3 = R2 + E[c], a2 = a3 + L0[4 * c + 3], a1 = a2 + L0[4 * c + 2], a0 = a1 + L0[4 * c + 1];
          p0[4 * c + 3] = __builtin_amdgcn_exp2f(p0[4 * c + 3] + a3); p0[4 * c + 2] = __builtin_amdgcn_exp2f(p0[4 * c + 2] + a2); p0[4 * c + 1] = __builtin_amdgcn_exp2f(p0[4 * c + 1] + a1); p0[4 * c] = __builtin_amdgcn_exp2f(p0[4 * c] + a0); }
        { const float a3 = R2 + E[4 + c], a2 = a3 + L1[4 * c + 3], a1 = a2 + L1[4 * c + 2], a0 = a1 + L1[4 * c + 1];
          p1[4 * c + 3] = __builtin_amdgcn_exp2f(p1[4 * c + 3] + a3); p1[4 * c + 2] = __builtin_amdgcn_exp2f(p1[4 * c + 2] + a2); p1[4 * c + 1] = __builtin_amdgcn_exp2f(p1[4 * c + 1] + a1); p1[4 * c] = __builtin_amdgcn_exp2f(p1[4 * c] + a0); }
    }
    R2 += run;
}
template <int KB>
__device__ __forceinline__ bool stick_step(int kb, int kb_w, at::Stg& S, LAS unsigned char* lds, int tid, const bf16* Kh, const bf16* Vh, const at::bf16x8* qr, at::f32x16* o, int tw, float& R2, LAS int* DONE) {
    using namespace at;
    int tz = tid; asm volatile("" : "+v"(tz));
    const int lane = tz & 63, w = __builtin_amdgcn_readfirstlane(tz >> 6), r32 = lane & 31, hi = lane >> 5, sr = tz >> 4, sc = (tz & 15) * 8;
    const int vb0 = (int)(uintptr_t)(lds + L_V) + v_rd_base(lane);
    int t = tw + r32; asm volatile("" : "+v"(t));
    const float THR2 = -100.f;
    const bool more = kb > 0;
    const bf16* Kn = Kh + (size_t)(more ? kb - 1 : kb) * 64 * NB; const bf16* Vn = Vh + (size_t)(more ? kb - 1 : kb) * 64 * NB;
    if (more) stg_load(S, Kn, NB, sr, sc);
    SBAR();
    bool wdone = false, kdone = false;
    if (kb <= kb_w) {
        if (__any(R2 > THR2)) {
            f32x16 p0, p1; qkt<KB>(p0, p1, lds, r32, hi, qr);
            SBAR();
            stick_tile(p0, p1, 64 * kb, t, hi, R2);
            SBAR();
            if (more) { stg_write_k<KB ^ 1>(S, lds, sr, sc); SBAR(); stg_load(S, Vn, NB, sr, sc); SBAR(); } kdone = true;
            bf16x8 pa0, pa1, pa2, pa3; pack_p(p0, p1, pa0, pa1, pa2, pa3);
            SBAR();
            pv_tile<KB>(o, vb0, pa0, pa1, pa2, pa3);
            SBAR();
        }
        wdone = !__any(R2 > THR2);
    }
    if (lane == 0) DONE[(kb & 1) * 8 + w] = wdone ? 1 : 0;
    if (more) { if (!kdone) { stg_write_k<KB ^ 1>(S, lds, sr, sc); SBAR(); stg_load(S, Vn, NB, sr, sc); SBAR(); } stg_write_v<KB ^ 1>(S, lds, sr, sc); }
    __syncthreads();
    int alld = 1;
#pragma unroll
    for (int ww = 0; ww < 8; ++ww) alld &= DONE[(kb & 1) * 8 + ww];
    return more && !alld;
}
__device__ __forceinline__ void stick_item(Frame& F, int h, int qb) {
    using namespace at;
    LAS unsigned char* lds = F.lds + RING_OFF;
    const bf16* PB = WSP(bf16, WS_PB); bf16* MIX = WSP(bf16, WS_MIX);
    int tid = F.tid; asm volatile("" : "+v"(tid));
    const int lane = tid & 63, w = F.wave, r32 = lane & 31, hi = lane >> 5, sr = tid >> 4, sc = (tid & 15) * 8;
    const int q0 = 256 * qb, tw = q0 + 32 * w, t = tw + r32;
    LAS int* DONE = (LAS int*)(lds + L_DONE);
    bf16x8 qr[8]; load_q(qr, PB + (size_t)t * NB + CB_Q + h * HD, hi);
    f32x16 o[4] = {};
    const bf16* Kh = PB + CB_K + h * HD; const bf16* Vh = PB + CB_V + h * HD;
    const int kb_hi = q0 / 64 + 3, kb_w = q0 / 64 + (w >> 1);
    float R2 = 0.f;
    Stg S;
    stg_load(S, Kh + (size_t)kb_hi * 64 * NB, NB, sr, sc); stg_write_k<0>(S, lds, sr, sc);
    stg_load(S, Vh + (size_t)kb_hi * 64 * NB, NB, sr, sc); stg_write_v<0>(S, lds, sr, sc);
    __syncthreads();
    for (int kb = kb_hi; ; kb -= 2) {
        if (!stick_step<0>(kb, kb_w, S, lds, tid, Kh, Vh, qr, o, tw, R2, DONE)) break;
        if (!stick_step<1>(kb - 1, kb_w, S, lds, tid, Kh, Vh, qr, o, tw, R2, DONE)) break;
    }
    store_o(o, lane, [&](int row) { return MIX + (size_t)(tw + row) * DM + h * HD; });
}
__device__ __forceinline__ void p10_attn(Frame& F) {
    const int ln = lane_of(F);
    const float mb_mem = 128.f * at::C2 * 1.01f * at::gain_absmax(F.in[14] + 2 * HD, ln) * at::gain_absmax(F.in[14] + 3 * HD, ln);
    if (F.G == 256) {
        if (F.vcu < 192) { for (int it = F.vcu; it < 384; it += 192) { const int h = it % 12, qb = 31 - it / 12; stick_item(F, h, qb); __syncthreads(); } }
        else { for (int j = F.vcu - 192; j < 128; j += 64) { mem_item(F, WSP(bf16, WS_PB), NB, CB_QM, F.in[14] + 2 * HD, 1, j & 3, j >> 2, mb_mem); __syncthreads(); } }
        return;
    }
    for (int it = F.vcu; it < 384 + 128; it += F.G) {
        if (it < 384) { const int h = it % 12, qb = 31 - it / 12; stick_item(F, h, qb); }
        else { const int j = it - 384; mem_item(F, WSP(bf16, WS_PB), NB, CB_QM, F.in[14] + 2 * HD, 1, j & 3, j >> 2, mb_mem); }
        __syncthreads();
    }
}

constexpr int N_PHASES = 17;
#ifndef MK_FILL_P1
#define MK_FILL_P1 0
#endif
#ifndef MK_FILL_P2
#define MK_FILL_P2 0
#endif
#ifndef MK_DBG
#define MK_DBG 0
#endif
#ifndef MK_PROBE_SUB
#define MK_PROBE_SUB 0
#endif
#ifndef MK_PROBE_MASK
#define MK_PROBE_MASK 0
#endif
#ifndef MK_NAIVE_P3
#define MK_NAIVE_P3 0
#endif
#ifndef MK_NAIVE_P10
#define MK_NAIVE_P10 0
#endif
struct Args { const float* in[22]; float* out; unsigned char* ws; int ph_lo, ph_hi, use_bar, pad; };
__global__ void __launch_bounds__(NWAVES * 64, 2) mk_fwd(Args args) {
    extern __shared__ __attribute__((aligned(16))) unsigned char lds[];
    Frame F;
    F.lds = (LAS unsigned char*)lds;
    F.MISC = (volatile LAS unsigned*)(F.lds + MISC_OFF);
    F.tid = threadIdx.x;  F.wave = __builtin_amdgcn_readfirstlane(F.tid >> 6);
    F.G = gridDim.x; { const int bx = blockIdx.x; F.vcu = (F.G % 8 == 0) ? (bx % 8) * (F.G / 8) + bx / 8 : bx; }
    F.ws = args.ws; F.ctl = (gu32*)(args.ws + WS_CTL); F.out = args.out;
#pragma unroll
    for (int i = 0; i < 22; ++i) F.in[i] = args.in[i];
    for (int u = F.tid; u < (LDS_BYTES - LDSCTL_OFF) / 4; u += NWAVES * 64) ((LAS unsigned*)(F.lds + LDSCTL_OFF))[u] = 0u;
    __syncthreads();
    XcdBarrier bar; bar.bar = (unsigned*)(F.ctl + CW_BAR); bar.x = 0; bar.st = nullptr;
    if (args.use_bar) bar = xcd_barrier_post((unsigned*)(F.ctl + CW_BAR), F.MISC + 8);
#if MK_DBG >= 100
    unsigned long long dbg_t = wall_clock64(); int dbg_n = 0;
#define GRID_BAR() do { if (args.use_bar) xcd_barrier(bar); F.tid = threadIdx.x; asm volatile("" : "+v"(F.tid)); \
        { const unsigned long long now_ = wall_clock64(); if (dbg_n == (MK_DBG % 100) && blockIdx.x == 0 && F.tid == 0) ((float*)F.ctl)[CW_DBG] = (float)(now_ - dbg_t) * (MK_DBG >= 300 ? 0.00125f : MK_DBG >= 200 ? 0.02f : 0.005f); dbg_t = now_; ++dbg_n; } } while (0)
#else
#define GRID_BAR() do { if (args.use_bar) xcd_barrier(bar); F.tid = threadIdx.x; asm volatile("" : "+v"(F.tid)); } while (0)
#endif
    const int lo = args.ph_lo, hi = args.ph_hi;
#ifdef MK_ONLY_PHASE
#define IN(k) ((k) == MK_ONLY_PHASE && lo <= (k) && (k) < hi)
#else
#define IN(k) (lo <= (k) && (k) < hi)
#endif
#define BOTH(k) (IN(k) && IN((k) + 1))
    typedef pg8::StaticOrder SO;

    if (IN(0)) { p0_prologue(F); if (!args.use_bar) conv_list(F, CV_DEFER0 + F.vcu * NWAVES + F.wave, F.G * NWAVES, CV_TOTAL); if (BOTH(0)) GRID_BAR(); }
    if (IN(1)) {
        const int Ge = (args.use_bar && F.G >= 128) ? F.G - 56 : F.G;
        if ((int)blockIdx.x < Ge) {
        { pg8::Gemm g{WSP(bf16, WS_XN), WSP(bf16, WS_WT_INA), DM, DM / 64}; SO S; S.init(T / 256, NA / 256, Ge, (int)blockIdx.x);
          pg8::EpiBf16 E{WSP(bf16, WS_PA), NA, nullptr}; pg8::gemm_phase<pg8::EpiBf16, SO, true, true>(F.lds + RING_OFF, g, S, E); }
        { pg8::Gemm g{WSP(bf16, WS_MEMN), WSP(bf16, WS_WT_MEM), DM, DM / 64}; SO S; S.init(1, 8, Ge, (int)(Ge - 1 - blockIdx.x));
          pg8::EpiBf16 E{WSP(bf16, WS_MKV), 2048, nullptr}; pg8::gemm_phase<pg8::EpiBf16, SO, true, true>(F.lds + RING_OFF, g, S, E); }
        }
        if (args.use_bar) idle_fill(F, 1);
        if (BOTH(1)) GRID_BAR();
    }
    if (IN(2)) { if (args.pad != 2) p2_compress(F); if (args.pad != 1) p2_qknorm(F); if (args.use_bar && MK_FILL_P2) idle_fill(F, 2); if (BOTH(2)) GRID_BAR(); }
#if MK_NAIVE_P3
    if (IN(3)) { p3_nsa_naive(F); mem_attn_naive(F, WSP(bf16, WS_PA), NA, CA_QM, F.in[14], 0); if (BOTH(3)) GRID_BAR(); }
#else
#if MK_DBG == 4 || (MK_DBG >= 6 && MK_DBG <= 8)
    const unsigned long long t3 = wall_clock64();
#endif
    if (IN(3)) { p3_attn(F);
#if MK_DBG >= 6 && MK_DBG <= 8
        if (F.vcu == MK_DBG - 6 && F.tid == 0) ((float*)F.ctl)[CW_DBG] = (float)(wall_clock64() - t3) * 0.01f;
#endif
        if (args.use_bar) idle_fill(F, 3); if (BOTH(3)) GRID_BAR();
#if MK_DBG == 4
        if (blockIdx.x == 0 && F.tid == 0) ((float*)F.ctl)[CW_DBG] = (float)(wall_clock64() - t3) * 0.01f;
#endif
    }
#endif
    if (IN(4)) { pg8::Gemm g{WSP(bf16, WS_MIX), WSP(bf16, WS_WT_OUT), DM, DM / 64}; SO S; S.init(T / 256, DM / 256, F.G, (int)blockIdx.x);
        pg8::EpiResNormT<false> E{F.in[0], WSP(bf16, WS_XN), (unsigned long long*)(F.ctl + CW_SS), DM}; pg8::gemm_phase<pg8::EpiResNormT<false>, SO, true, true>(F.lds + RING_OFF, g, S, E);
        if (args.use_bar) conv_drain(F, CV_INB); if (BOTH(4)) GRID_BAR(); }
#if MK_DBG == 3
    const unsigned long long t6 = wall_clock64();
#endif
    if (IN(6)) { const int Ge = (args.use_bar && F.G >= 64) ? F.G - 32 : F.G;
        if ((int)blockIdx.x < Ge) { pg8::Gemm g{WSP(bf16, WS_XN), WSP(bf16, WS_WT_FGU), DM, DM / 64}; SO S; S.init(T / 256, 2 * FF / 256, Ge, (int)blockIdx.x);
            pg8::EpiSwiglu E{WSP(bf16, WS_HFF), FF, (const unsigned long long*)(F.ctl + CW_SS)}; pg8::gemm_phase<pg8::EpiSwiglu, SO, true, true>(F.lds + RING_OFF, g, S, E); }
        if (args.use_bar) idle_fill(F, 6);
        if (BOTH(6)) GRID_BAR();
#if MK_DBG == 3
        if (blockIdx.x == 0 && F.tid == 0) ((float*)F.ctl)[CW_DBG] = (float)(wall_clock64() - t6) * 0.005f;
#endif
    }
    if (IN(7)) { pg8::Gemm g{WSP(bf16, WS_HFF), WSP(bf16, WS_WT_FDN), FF, FF / 64}; SO S; S.init(T / 256, DM / 256, F.G, (int)blockIdx.x);
        pg8::EpiResNormT<true> E{WSP(bf16, WS_XN), WSP(bf16, WS_XN), (unsigned long long*)(F.ctl + CW_SS) + T, DM}; pg8::gemm_phase<pg8::EpiResNormT<true>, SO, true, true>(F.lds + RING_OFF, g, S, E);
        if (args.use_bar) conv_drain(F, CV_MGU); if (BOTH(7)) GRID_BAR(); }
    if (IN(9)) { pg8::Gemm g{WSP(bf16, WS_XN), WSP(bf16, WS_WT_INB), DM, DM / 64}; SO S; S.init(T / 256, NB / 256, F.G, (int)blockIdx.x);
        pg8::EpiBf16 E{WSP(bf16, WS_PB), NB, (const unsigned long long*)(F.ctl + CW_SS) + T}; pg8::gemm_phase<pg8::EpiBf16, SO, true, true>(F.lds + RING_OFF, g, S, E); if (args.use_bar) idle_fill(F, 9); if (BOTH(9)) GRID_BAR(); }
#if MK_NAIVE_P10
    if (IN(10)) { stick_naive(F); mem_attn_naive(F, WSP(bf16, WS_PB), NB, CB_QM, F.in[14] + 2 * HD, 1); if (BOTH(10)) GRID_BAR(); }
#else
    if (IN(10)) { p10_attn(F); if (args.use_bar) idle_fill(F, 10); if (BOTH(10)) GRID_BAR(); }
#endif
    if (IN(11)) { pg8::Gemm g{WSP(bf16, WS_MIX), WSP(bf16, WS_WT_OUT) + (size_t)DM * DM, DM, DM / 64}; SO S; S.init(T / 256, DM / 256, F.G, (int)blockIdx.x);
        pg8::EpiResF32 E{WSP(bf16, WS_XN), WSP(float, WS_X3), DM}; pg8::gemm_phase<pg8::EpiResF32, SO, true, true>(F.lds + RING_OFF, g, S, E); if (BOTH(11)) GRID_BAR(); }
    if (IN(12)) { p12_router(F); if (BOTH(12)) GRID_BAR(); }
    if (IN(13)) { p13_assign(F);
#if MK_DBG == 1
        const unsigned long long t0 = wall_clock64();
#endif
#if MK_DBG == 2
        if (blockIdx.x == 0 && F.tid == 0) { const unsigned c = __hip_atomic_load((unsigned*)(F.ctl + CW_CVNEXT), __ATOMIC_RELAXED, __HIP_MEMORY_SCOPE_AGENT); ((float*)F.ctl)[CW_DBG] = 500.f * (float)c / (float)(CV_TOTAL - CV_DEFER0); }
#endif
        if (args.use_bar) conv_drain(F, CV_MDN);
#if MK_DBG == 1
        if (blockIdx.x == 0 && F.tid == 0) ((float*)F.ctl)[CW_DBG] = (float)(wall_clock64() - t0) * 0.01f;
#endif
        if (BOTH(13)) GRID_BAR(); }
    if (IN(14)) { const int* TILE = (const int*)(F.ws + WS_ROUTE + RT_TILE); const int ntl = TILE[0];
        LAS int* TE = (LAS int*)(F.lds + LDSCTL_OFF + 1024);
        if (F.tid < MOE_MAXT) TE[F.tid] = TILE[16 + F.tid];
        __syncthreads();
        int Ge = F.G;
        if (args.use_bar && F.G >= 64) { const int U = ntl * (2 * FF / 256); if ((U + F.G - 9) / (F.G - 8) == (U + F.G - 1) / F.G) Ge = F.G - 8; }
        if ((int)blockIdx.x < Ge) { pg8::Gemm g{WSP(bf16, WS_AMOE), WSP(bf16, WS_WT_MGU), DM, DM / 64}; pg8::MoeOrder S; S.init(ntl, 2 * FF / 256, Ge, (int)blockIdx.x); S.tile_e = TE; S.estride = (size_t)2 * FF * DM * 2;
            pg8::EpiSwiglu E{WSP(bf16, WS_HMOE), FF, nullptr}; pg8::gemm_phase<pg8::EpiSwiglu, pg8::MoeOrder, true, true>(F.lds + RING_OFF, g, S, E); }
#if MK_DBG == 5
        const unsigned long long t14 = wall_clock64();
#endif
        if (args.use_bar) { idle_fill(F, 14); conv_drain(F, CV_TOTAL); }
#if MK_DBG == 5
        if (blockIdx.x == 0 && F.tid == 0) ((float*)F.ctl)[CW_DBG] = (float)(wall_clock64() - t14) * 0.01f;
#endif
        if (BOTH(14)) GRID_BAR(); }
    if (IN(15)) { const int* TILE = (const int*)(F.ws + WS_ROUTE + RT_TILE); const int ntl = TILE[0];
        LAS int* TE = (LAS int*)(F.lds + LDSCTL_OFF + 1024);
        if (F.tid < MOE_MAXT) TE[F.tid] = TILE[16 + F.tid];
        __syncthreads();
        const int U = ntl * (DM / 256), full = (U / F.G) * F.G, tail = U - full;
        { pg8::Gemm g{WSP(bf16, WS_HMOE), WSP(bf16, WS_WT_MDN), FF, FF / 64}; pg8::MoeOrder S; S.init(ntl, DM / 256, F.G, (int)blockIdx.x); S.nwg = full; S.tile_e = TE; S.estride = (size_t)DM * FF * 2;
          pg8::EpiBf16 E{WSP(bf16, WS_YMOE), DM, nullptr}; pg8::gemm_phase<pg8::EpiBf16, pg8::MoeOrder, true, true>(F.lds + RING_OFF, g, S, E); }
        if (tail > 0) { const int nsp = moe_nsplit(tail, F.G);
          const int sp = (int)blockIdx.x % nsp, q = (FF / 128) / nsp, r = (FF / 128) % nsp, len = q + (sp < r ? 1 : 0), st = sp * q + (sp < r ? sp : r);
          pg8::Gemm g{WSP(bf16, WS_HMOE), WSP(bf16, WS_WT_MDN), FF, 2 * len}; pg8::MoeSplitOrder S; S.nM = ntl; S.nN = DM / 256; S.nwg0 = full; S.ntail = tail; S.nsp = nsp; S.G = F.G; S.c = (int)blockIdx.x; S.koff = 2 * st; S.tile_e = TE; S.estride = (size_t)DM * FF * 2;
          pg8::EpiPartF32 E{WSP(float, WS_SLAB), (int*)(F.ctl + CW_TMAP)}; pg8::gemm_phase<pg8::EpiPartF32, pg8::MoeSplitOrder, true, true>(F.lds + RING_OFF, g, S, E); }
        if (BOTH(15)) GRID_BAR(); }
    if (IN(16)) { p16_combine(F, MK_DBG ? 1.0f + 1e-4f * ((const float*)F.ctl)[CW_DBG] : 1.0f); }
#undef IN
#undef BOTH
}

#ifndef MK_ONE_LAUNCH
#define MK_ONE_LAUNCH 1
#endif
extern "C" void kernel_launch(void* const* d_in, const int* in_sizes, int n_in, void* d_out, int out_size, void* d_ws, size_t ws_size, hipStream_t stream) {
    static int grid = 0;
    if (grid == 0) {
        if (n_in != 22 || in_sizes[0] != T * DM || out_size != T * DM || ws_size < WS_END) { fprintf(stderr, "kernel_launch: unexpected shapes (n_in %d, in0 %d, out %d, ws %zu < %zu)\n", n_in, n_in > 0 ? in_sizes[0] : -1, out_size, ws_size, (size_t)WS_END); grid = -1; return; }
        int dev = 0, cus = 0, per_cu = 0;
        if (hipGetDevice(&dev) != hipSuccess || hipDeviceGetAttribute(&cus, hipDeviceAttributeMultiprocessorCount, dev) != hipSuccess) { grid = -1; return; }
        if (hipFuncSetAttribute((const void*)mk_fwd, hipFuncAttributeMaxDynamicSharedMemorySize, LDS_BYTES) != hipSuccess) { fprintf(stderr, "kernel_launch: hipFuncSetAttribute failed\n"); grid = -1; return; }
        if (hipOccupancyMaxActiveBlocksPerMultiprocessor(&per_cu, (const void*)mk_fwd, NWAVES * 64, LDS_BYTES) != hipSuccess || per_cu < 1) { fprintf(stderr, "kernel_launch: occupancy query says %d blocks per CU\n", per_cu); }
        (void)hipGetLastError();
        grid = cus;
    }
    if (grid < 0) return;
    if (hipMemsetAsync((char*)d_ws + WS_CTL, 0, CTL_ZERO_BYTES, stream) != hipSuccess) return;
    Args a{};
    for (int i = 0; i < 22; ++i) a.in[i] = (const float*)d_in[i];
    a.out = (float*)d_out; a.ws = (unsigned char*)d_ws; a.pad = 0;
#if MK_ONE_LAUNCH
    a.ph_lo = 0; a.ph_hi = N_PHASES; a.use_bar = 1;
    hipLaunchKernelGGL(mk_fwd, dim3(grid), dim3(NWAVES * 64), LDS_BYTES, stream, a);
    for (int p = 0; p < N_PHASES; ++p) if ((MK_PROBE_MASK >> p) & 1) { a.ph_lo = p; a.ph_hi = p + 1; a.use_bar = 0; a.pad = MK_PROBE_SUB;
        hipLaunchKernelGGL(mk_fwd, dim3(grid), dim3(NWAVES * 64), LDS_BYTES, stream, a); }
#else
    for (int p = 0; p < N_PHASES; ++p) { a.ph_lo = p; a.ph_hi = p + 1; a.use_bar = 0;
        hipLaunchKernelGGL(mk_fwd, dim3(grid), dim3(NWAVES * 64), LDS_BYTES, stream, a); }
#endif
}
```
